# Optimizing an MI355X kernel written in HIP

```python
import math
import jax, jax.numpy as jnp
from jax import lax
import numpy as np

D_MODEL = 1024
BATCH = 16
SEQ = 256
DEPTH = 2
DEC_BATCH = 2
DEC_SEQ = 4096
PAST_LEN = 256

GRID_W = 64
N_ATT = (DEPTH + 1) // 2
N_CONV = DEPTH // 2
H_DIFF = 4
DH_DIFF = 64
DIFF_QK = H_DIFF * 2 * DH_DIFF
DIFF_V = H_DIFF * 2 * DH_DIFF
H_MLA = 8
Q_LORA = 256
KV_LORA = 128
QK_NOPE = 64
QK_ROPE = 32
V_MLA = 64
ATT_IN = 2 * DIFF_QK + DIFF_V + Q_LORA + KV_LORA + QK_ROPE
ATT_SPLITS = [DIFF_QK, 2 * DIFF_QK, 2 * DIFF_QK + DIFF_V, 2 * DIFF_QK + DIFF_V + Q_LORA,
              2 * DIFF_QK + DIFF_V + Q_LORA + KV_LORA]
ATT_OUT = DIFF_V + H_MLA * V_MLA
CONV_CH = 512
CONV_WIDTH = 31
POOL_CH = 512
POOL_WINDOWS = (2, 4, 8, 16)
POOL_GROUPS = len(POOL_WINDOWS)
POOL_GC = POOL_CH // POOL_GROUPS
CONV_IN = 2 * CONV_CH + POOL_CH
CONV_OUT = CONV_CH + POOL_CH
D_FF = 4 * D_MODEL
ROPE_BASE = 10000.0
Q_BLOCK = 128
NORM_EPS = 1e-5
DEEPNORM_ALPHA = (2 * DEPTH) ** 0.25
DEEPNORM_BETA = (8 * DEPTH) ** -0.25

kernel_name = 'hybrid_diffattn_mla_conformer_pool_dit'


def layer_norm(x, g, b):
    xf = x.astype(jnp.float32)
    mu = jnp.mean(xf, axis=-1, keepdims=True)
    var = jnp.mean(jnp.square(xf - mu), axis=-1, keepdims=True)
    return ((xf - mu) * lax.rsqrt(var + NORM_EPS) * g.astype(jnp.float32) + b.astype(jnp.float32)).astype(x.dtype)


def rms_norm(x, g):
    xf = x.astype(jnp.float32)
    ms = jnp.mean(jnp.square(xf), axis=-1, keepdims=True)
    return (xf * lax.rsqrt(ms + NORM_EPS) * g.astype(jnp.float32)).astype(x.dtype)


def rope_1d(x, pos):
    half = x.shape[-1] // 2
    inv = ROPE_BASE ** (-jnp.arange(half, dtype=jnp.float32) / half)
    ang = pos.astype(jnp.float32)[:, None] * inv[None, :]
    ang = ang.reshape(ang.shape[0], *([1] * (x.ndim - 3)), half)
    cos, sin = jnp.cos(ang), jnp.sin(ang)
    xf = x.astype(jnp.float32)
    x1, x2 = xf[..., :half], xf[..., half:]
    return jnp.concatenate([x1 * cos - x2 * sin, x1 * sin + x2 * cos], axis=-1).astype(x.dtype)


def rope_2d(x, row, col):
    n = x.shape[-1] // 2
    return jnp.concatenate([rope_1d(x[..., :n], row), rope_1d(x[..., n:], col)], axis=-1)


def sweep_query_blocks(fn, qs):
    b, t = qs[0].shape[:2]
    qb = Q_BLOCK if t % Q_BLOCK == 0 else t
    nb = t // qb
    blocks = tuple(jnp.moveaxis(q.reshape(b, nb, qb, *q.shape[2:]), 1, 0) for q in qs)
    out = lax.map(lambda blk: fn(*blk), blocks)
    out = jnp.moveaxis(out, 0, 1)
    return out.reshape(b, t, *out.shape[3:])


def diff_attend(q_segs, k_segs, v, lam):
    scale = DH_DIFF ** -0.5

    def blk(*qs):
        s = jnp.concatenate([jnp.einsum('bqhmd,bkhmd->bhmqk', q, k) for q, k in zip(qs, k_segs)], axis=-1)
        p = jax.nn.softmax(s.astype(jnp.float32) * scale, axis=-1)
        a = p[:, :, 0] - lam * p[:, :, 1]
        return jnp.einsum('bhqk,bkhe->bqhe', a, v.astype(jnp.float32)).astype(v.dtype)

    return sweep_query_blocks(blk, tuple(q_segs))


def mla_attend(q_nope, pe_q, k_nope, pe_k, v):
    scale = (QK_NOPE + QK_ROPE) ** -0.5

    def blk(qn, *qps):
        s_pe = jnp.concatenate([jnp.einsum('bqhr,bkr->bhqk', qp, kp) for qp, kp in zip(qps, pe_k)], axis=-1)
        s = jnp.einsum('bqhd,bkhd->bhqk', qn, k_nope) + s_pe
        p = jax.nn.softmax(s.astype(jnp.float32) * scale, axis=-1)
        return jnp.einsum('bhqk,bkhe->bqhe', p, v.astype(jnp.float32)).astype(v.dtype)

    return sweep_query_blocks(blk, (q_nope,) + tuple(pe_q))


def attention_mixer(h, w_in, w_uq, w_ukv, q_norm_g, kv_norm_g, lam, lam_init, diff_norm_g, w_out, ctx, pos):
    b, t, _ = h.shape
    q_d, k_d, v_d, cq, ckv, kpe = jnp.split(h @ w_in, ATT_SPLITS, axis=-1)
    q_d = q_d.reshape(b, t, H_DIFF, 2, DH_DIFF)
    k_d = k_d.reshape(b, t, H_DIFF, 2, DH_DIFF)
    v_d = v_d.reshape(b, t, H_DIFF, 2 * DH_DIFF)
    q_m = (rms_norm(cq, q_norm_g) @ w_uq).reshape(b, t, H_MLA, QK_NOPE + QK_ROPE)
    q_nope, q_pe = q_m[..., :QK_NOPE], q_m[..., QK_NOPE:]
    ckv = rms_norm(ckv, kv_norm_g)
    if ctx is None:
        v_all, ckv_all = v_d, ckv
        diff_q, diff_k = (q_d,), (k_d,)
        pe_q, pe_k = (q_pe,), (kpe,)
    else:
        row, col = pos
        k_ctx = ctx[0].reshape(b, -1, H_DIFF, 2, DH_DIFF)
        v_all = jnp.concatenate([ctx[1], v_d], axis=1)
        ckv_all = jnp.concatenate([ctx[2], ckv], axis=1)
        diff_q, diff_k = (q_d, rope_2d(q_d, row, col)), (k_ctx, rope_2d(k_d, row, col))
        pe_q, pe_k = (q_pe, rope_2d(q_pe, row, col)), (ctx[3], rope_2d(kpe, row, col))
    o_d = diff_attend(diff_q, diff_k, v_all, lam)
    kv = (ckv_all @ w_ukv).reshape(b, -1, H_MLA, QK_NOPE + V_MLA)
    o_m = mla_attend(q_nope, pe_q, kv[..., :QK_NOPE], pe_k, kv[..., QK_NOPE:])
    o_d = (rms_norm(o_d, diff_norm_g) * (1.0 - lam_init)).reshape(b, t, DIFF_V)
    y = jnp.concatenate([o_d, o_m.reshape(b, t, H_MLA * V_MLA)], axis=-1) @ w_out
    new_ctx = (k_d.reshape(b, t, H_DIFF, 2 * DH_DIFF), v_d, ckv, kpe)
    return y, new_ctx


def depthwise_conv(u, w, bias):
    out = lax.conv_general_dilated(u, w[:, None, :].astype(u.dtype), window_strides=(1,),
                                   padding=[(CONV_WIDTH // 2, CONV_WIDTH // 2)],
                                   dimension_numbers=('NWC', 'WIO', 'NWC'),
                                   feature_group_count=u.shape[-1])
    return out + bias


def multi_scale_pool(x):
    t_len = x.shape[1]
    t = jnp.arange(t_len)
    xf = x.astype(jnp.float32)
    cs = jnp.concatenate([jnp.zeros_like(xf[:, :1]), lax.cumsum(xf, axis=1)], axis=1)
    outs = []
    for g, w in enumerate(POOL_WINDOWS):
        lo = jnp.maximum(t - w // 2, 0)
        hi = jnp.minimum(t + w // 2 - 1, t_len - 1)
        csg = cs[..., g * POOL_GC:(g + 1) * POOL_GC]
        cnt = (hi - lo + 1).astype(jnp.float32)[None, :, None]
        outs.append((csg[:, hi + 1] - csg[:, lo]) / cnt)
    return jnp.concatenate(outs, axis=-1).astype(x.dtype)


def conv_pool_mixer(h, w_in, conv_w, conv_b, cn_g, cn_b, w_pool, pool_scale, w_out):
    b, t, _ = h.shape
    a, gate, pz = jnp.split(h @ w_in, [CONV_CH, 2 * CONV_CH], axis=-1)
    u = a * jax.nn.sigmoid(gate)
    u = jax.nn.silu(layer_norm(depthwise_conv(u, conv_w, conv_b), cn_g, cn_b))
    d = (multi_scale_pool(pz) - pz).reshape(b, t, POOL_GROUPS, POOL_GC)
    d = jnp.einsum('btgc,gce->btge', d, w_pool).reshape(b, t, POOL_CH) * pool_scale
    return jnp.concatenate([u, d], axis=-1) @ w_out


def squared_relu_mlp(h, w1, w2):
    return jnp.square(jax.nn.relu(h @ w1)) @ w2


def setup_inputs(seed: int = 0) -> dict:
    key = jax.random.key(seed)
    ks = jax.random.split(key, 40)
    cnt = [0]

    def nrm(shape, scale):
        k_ = ks[cnt[0]]
        cnt[0] += 1
        return scale * jax.random.normal(k_, shape, jnp.float32)

    d = D_MODEL
    return {
        'x_prompt': nrm((BATCH, SEQ, d), 1.0),
        'x_sample': nrm((DEC_BATCH, DEC_SEQ, d), 1.0),
        'cache_diff_k': nrm((DEC_BATCH, N_ATT, PAST_LEN, H_DIFF, 2 * DH_DIFF), 1.0),
        'cache_diff_v': nrm((DEC_BATCH, N_ATT, PAST_LEN, H_DIFF, 2 * DH_DIFF), 1.0),
        'cache_mla_ckv': nrm((DEC_BATCH, N_ATT, PAST_LEN, KV_LORA), 1.0),
        'cache_mla_krope': nrm((DEC_BATCH, N_ATT, PAST_LEN, QK_ROPE), 1.0),
        'c': nrm((DEC_BATCH, d), 1.0),
        'c_ctx': nrm((d,), 1.0),
        'w_ada': nrm((DEPTH, d, 6 * d), d ** -0.5),
        'b_ada': nrm((DEPTH, 6 * d), 0.02),
        'ln_mix_g': 1.0 + nrm((DEPTH, d), 0.02),
        'ln_mix_b': nrm((DEPTH, d), 0.02),
        'ln_mlp_g': 1.0 + nrm((DEPTH, d), 0.02),
        'ln_mlp_b': nrm((DEPTH, d), 0.02),
        'w_mlp_in': nrm((DEPTH, d, D_FF), d ** -0.5),
        'w_mlp_out': nrm((DEPTH, D_FF, d), D_FF ** -0.5 * DEEPNORM_BETA),
        'w_att_in': nrm((N_ATT, d, ATT_IN), d ** -0.5),
        'w_uq': nrm((N_ATT, Q_LORA, H_MLA * (QK_NOPE + QK_ROPE)), Q_LORA ** -0.5),
        'w_ukv': nrm((N_ATT, KV_LORA, H_MLA * (QK_NOPE + V_MLA)), KV_LORA ** -0.5),
        'q_norm_g': 1.0 + nrm((N_ATT, Q_LORA), 0.02),
        'kv_norm_g': 1.0 + nrm((N_ATT, KV_LORA), 0.02),
        'lam_q1': nrm((N_ATT, DH_DIFF), 0.1),
        'lam_k1': nrm((N_ATT, DH_DIFF), 0.1),
        'lam_q2': nrm((N_ATT, DH_DIFF), 0.1),
        'lam_k2': nrm((N_ATT, DH_DIFF), 0.1),
        'diff_norm_g': 1.0 + nrm((N_ATT, 2 * DH_DIFF), 0.02),
        'w_att_out': nrm((N_ATT, ATT_OUT, d), ATT_OUT ** -0.5 * DEEPNORM_BETA),
        'w_conv_in': nrm((N_CONV, d, CONV_IN), d ** -0.5),
        'conv_w': nrm((N_CONV, CONV_WIDTH, CONV_CH), CONV_WIDTH ** -0.5),
        'conv_b': nrm((N_CONV, CONV_CH), 0.02),
        'conv_norm_g': 1.0 + nrm((N_CONV, CONV_CH), 0.02),
        'conv_norm_b': nrm((N_CONV, CONV_CH), 0.02),
        'w_pool': nrm((N_CONV, POOL_GROUPS, POOL_GC, POOL_GC), POOL_GC ** -0.5),
        'pool_scale': 1.0 + nrm((N_CONV, POOL_CH), 0.1),
        'w_conv_out': nrm((N_CONV, CONV_OUT, d), CONV_OUT ** -0.5 * DEEPNORM_BETA),
    }


def reference(x_prompt, x_sample, cache_diff_k, cache_diff_v, cache_mla_ckv, cache_mla_krope, c, c_ctx,
              w_ada, b_ada, ln_mix_g, ln_mix_b, ln_mlp_g, ln_mlp_b, w_mlp_in, w_mlp_out,
              w_att_in, w_uq, w_ukv, q_norm_g, kv_norm_g, lam_q1, lam_k1, lam_q2, lam_k2, diff_norm_g, w_att_out,
              w_conv_in, conv_w, conv_b, conv_norm_g, conv_norm_b, w_pool, pool_scale, w_conv_out):
    t_lat = x_sample.shape[1]
    rows = t_lat // GRID_W
    row = jnp.repeat(jnp.arange(rows, dtype=jnp.int32), GRID_W)
    col = jnp.tile(jnp.arange(GRID_W, dtype=jnp.int32), rows)

    def mixer(l, h, ctx, pos):
        i = l // 2
        if l % 2 == 0:
            lam_init = 0.8 - 0.6 * math.exp(-0.3 * l)
            lam = (jnp.exp(jnp.sum(lam_q1[i].astype(jnp.float32) * lam_k1[i].astype(jnp.float32)))
                   - jnp.exp(jnp.sum(lam_q2[i].astype(jnp.float32) * lam_k2[i].astype(jnp.float32)))
                   + lam_init)
            return attention_mixer(h, w_att_in[i], w_uq[i], w_ukv[i], q_norm_g[i], kv_norm_g[i], lam, lam_init,
                                   diff_norm_g[i], w_att_out[i], ctx, pos)
        y = conv_pool_mixer(h, w_conv_in[i], conv_w[i], conv_b[i], conv_norm_g[i], conv_norm_b[i],
                            w_pool[i], pool_scale[i], w_conv_out[i])
        return y, None

    def run_layer(l, x, cond, ctx, pos):
        mods = jax.nn.silu(cond) @ w_ada[l] + b_ada[l]
        sh_m, sc_m, g_m, sh_f, sc_f, g_f = jnp.split(mods, 6, axis=-1)
        y, new_ctx = mixer(l, x * (1.0 + sc_m) + sh_m, ctx, pos)
        x = layer_norm(DEEPNORM_ALPHA * x + g_m * y, ln_mix_g[l], ln_mix_b[l])
        f = squared_relu_mlp(x * (1.0 + sc_f) + sh_f, w_mlp_in[l], w_mlp_out[l])
        x = layer_norm(DEEPNORM_ALPHA * x + g_f * f, ln_mlp_g[l], ln_mlp_b[l])
        return x, new_ctx

    xp = x_prompt
    ks_, vs_, ckvs_, kpes_ = [], [], [], []
    for l in range(DEPTH):
        xp, st = run_layer(l, xp, c_ctx, None, None)
        if st is not None:
            ks_.append(st[0])
            vs_.append(st[1])
            ckvs_.append(st[2])
            kpes_.append(st[3])
    new_diff_k = jnp.stack(ks_, axis=1)
    new_diff_v = jnp.stack(vs_, axis=1)
    new_mla_ckv = jnp.stack(ckvs_, axis=1)
    new_mla_krope = jnp.stack(kpes_, axis=1)

    xs = x_sample
    cond = c[:, None, :]
    for l in range(DEPTH):
        i = l // 2
        ctx = (cache_diff_k[:, i], cache_diff_v[:, i], cache_mla_ckv[:, i], cache_mla_krope[:, i]) if l % 2 == 0 else None
        xs, _ = run_layer(l, xs, cond, ctx, (row, col))

    return (xp, xs, new_diff_k, new_diff_v, new_mla_ckv, new_mla_krope)
```

```cpp
#include <hip/hip_runtime.h>
#include <hip/hip_cooperative_groups.h>
#include <cstdio>
#include <cstdint>
namespace cg = cooperative_groups;

typedef unsigned short bf16_t;
typedef short bf16x8 __attribute__((ext_vector_type(8)));
typedef short s16x4 __attribute__((ext_vector_type(4)));
typedef float f32x4 __attribute__((ext_vector_type(4)));
typedef float f32x2 __attribute__((ext_vector_type(2)));
typedef float f32x16 __attribute__((ext_vector_type(16)));
typedef unsigned u32x4 __attribute__((ext_vector_type(4)));
typedef unsigned u32x2 __attribute__((ext_vector_type(2)));
typedef __bf16 bf16v2 __attribute__((ext_vector_type(2)));
#define DI __device__ __forceinline__
#define LDS_AS __attribute__((address_space(3)))

constexpr int NTOK = 12288, NCTX = 4096, NKEY = 12800, TLAT = 4096, TKL = 4352;
constexpr int RLD = 1952;
constexpr float ALPHA = 1.41421356237f, EPS = 1e-5f;
constexpr int NPHASE = 18;

constexpr size_t al(size_t x) { return (x + 255) & ~(size_t)255; }
constexpr size_t O_CNT = 0;
constexpr size_t O_MODS = 256;
constexpr size_t O_SCAL = O_MODS + al(2 * 3 * 6144 * 4);
constexpr size_t O_C16 = O_SCAL + 256;
constexpr size_t O_S16 = O_C16 + 4096;
constexpr size_t O_C8 = O_S16 + 4096;
constexpr size_t O_S8 = O_C8 + 2048;
constexpr size_t O_WATTIN = O_S8 + 2048;
constexpr size_t O_WUQ = O_WATTIN + (size_t)2048 * 1024 * 2;
constexpr size_t O_WUKV = O_WUQ + (size_t)768 * 256 * 2;
constexpr size_t O_WATTOUT = O_WUKV + (size_t)1024 * 128 * 2;
constexpr size_t O_WMLPIN = O_WATTOUT + (size_t)1024 * 1024 * 2;
constexpr size_t O_WMLPOUT = O_WMLPIN + (size_t)2 * 4096 * 1024 * 2;
constexpr size_t O_WCONVIN = O_WMLPOUT + (size_t)2 * 4096 * 1024 * 2;
constexpr size_t O_WCONVOUT = O_WCONVIN + (size_t)1536 * 1024 * 2;
constexpr size_t O_HB = O_WCONVOUT + (size_t)1024 * 1024 * 2;
constexpr size_t O_BIG = O_HB + (size_t)NTOK * 1024 * 2;
constexpr size_t O_R = O_BIG;
constexpr size_t O_QMA = O_R;
constexpr size_t O_QMB = O_QMA + (size_t)NTOK * 768 * 2;
constexpr size_t O_QDA = O_R + al((size_t)NTOK * RLD * 2);
constexpr size_t O_QDB = O_QDA + (size_t)NTOK * 512 * 2;
constexpr size_t O_KD = O_QDB + (size_t)8192 * 512 * 2;
constexpr size_t O_VD = O_KD + (size_t)NKEY * 512 * 2;
constexpr size_t O_CQN = O_VD + (size_t)NKEY * 512 * 2;
constexpr size_t O_CKVN = O_CQN + (size_t)NTOK * 256 * 2;
constexpr size_t O_KMLA = O_CKVN + (size_t)NKEY * 128 * 2;
constexpr size_t O_VMLA = O_KMLA + (size_t)NKEY * 768 * 2;
constexpr size_t O_OTMP = O_VMLA + (size_t)NKEY * 512 * 2;
constexpr size_t O_ATT_END = O_OTMP + (size_t)512 * 16384 * 4;
constexpr size_t O_U = O_BIG;
constexpr size_t O_U_END = O_U + (size_t)NTOK * 4096 * 2;
constexpr size_t O_UG = O_BIG;
constexpr size_t O_PZ = O_UG + (size_t)NTOK * 512 * 2;
constexpr size_t WS_NEED = (O_ATT_END > O_U_END ? O_ATT_END : O_U_END);
static_assert(O_QMB + (size_t)8192 * 768 * 2 <= O_QDA, "Qm overlay must fit in R");
static_assert(WS_NEED <= (size_t)256 * 1024 * 1024, "workspace too large");

struct Params {
  const float *x_prompt, *x_sample, *cache_k, *cache_v, *cache_ckv, *cache_krope, *c, *c_ctx;
  const float *w_ada, *b_ada, *ln_mix_g, *ln_mix_b, *ln_mlp_g, *ln_mlp_b, *w_mlp_in, *w_mlp_out;
  const float *w_att_in, *w_uq, *w_ukv, *q_norm_g, *kv_norm_g, *lam_q1, *lam_k1, *lam_q2, *lam_k2, *diff_norm_g, *w_att_out;
  const float *w_conv_in, *conv_w, *conv_b, *conv_norm_g, *conv_norm_b, *w_pool, *pool_scale, *w_conv_out;
  float* out;
  char* ws;
};

DI unsigned pack2(float lo, float hi) { f32x2 v = {lo, hi}; bf16v2 b = __builtin_convertvector(v, bf16v2); return __builtin_bit_cast(unsigned, b); }
DI float bf2f(unsigned short u) { return __uint_as_float((unsigned)u << 16); }
DI float bflo(unsigned u) { return __uint_as_float(u << 16); }
DI float bfhi(unsigned u) { return __uint_as_float(u & 0xffff0000u); }
DI float wave_sum(float v) {
#pragma unroll
  for (int o = 32; o >= 1; o >>= 1) v += __shfl_xor(v, o);
  return v;
}
DI int cond_idx(int row) { return row < NCTX ? 0 : 1 + ((row - NCTX) >> 12); }

DI int swz(int row, int kc) { return row * 128 + ((kc ^ ((row >> 1) & 7)) << 4); }

template <class Epi>
DI void gemm_tile(const bf16_t* __restrict__ A, int lda, const bf16_t* __restrict__ Bt, int ldb, int K, int row0, int col0, char* smem, const Epi& epi) {
  const int tid = threadIdx.x, lane = tid & 63, wid = tid >> 6, wr = wid >> 1, wc = wid & 1;
  const int fr = lane & 15, fq = lane >> 4;
  f32x4 acc[4][4];
#pragma unroll
  for (int i = 0; i < 4; ++i)
#pragma unroll
    for (int j = 0; j < 4; ++j) acc[i][j] = (f32x4){0.f, 0.f, 0.f, 0.f};
  const int srow = tid >> 3, skc = tid & 7;
  const bf16_t* ga = A + (size_t)(row0 + srow) * lda + skc * 8;
  const bf16_t* gb = Bt + (size_t)(col0 + srow) * ldb + skc * 8;
  const int soff = swz(srow, skc);
  u32x4 ra[4], rb[4];
  const int nk = K >> 6;
#pragma unroll
  for (int i = 0; i < 4; ++i) { ra[i] = *(const u32x4*)(ga + (size_t)(32 * i) * lda); rb[i] = *(const u32x4*)(gb + (size_t)(32 * i) * ldb); }
#pragma unroll
  for (int i = 0; i < 4; ++i) { *(u32x4*)(smem + soff + i * 4096) = ra[i]; *(u32x4*)(smem + 16384 + soff + i * 4096) = rb[i]; }
  __syncthreads();
  for (int kt = 0; kt < nk; ++kt) {
    char* cur = smem + (kt & 1) * 32768;
    const bool more = (kt + 1 < nk);
    if (more) {
      const int k0 = (kt + 1) << 6;
#pragma unroll
      for (int i = 0; i < 4; ++i) { ra[i] = *(const u32x4*)(ga + (size_t)(32 * i) * lda + k0); rb[i] = *(const u32x4*)(gb + (size_t)(32 * i) * ldb + k0); }
    }
#pragma unroll
    for (int s = 0; s < 2; ++s) {
      bf16x8 af[4], bfr[4];
#pragma unroll
      for (int i = 0; i < 4; ++i) af[i] = *(const bf16x8*)(cur + swz(wr * 64 + i * 16 + fr, s * 4 + fq));
#pragma unroll
      for (int j = 0; j < 4; ++j) bfr[j] = *(const bf16x8*)(cur + 16384 + swz(wc * 64 + j * 16 + fr, s * 4 + fq));
#pragma unroll
      for (int i = 0; i < 4; ++i)
#pragma unroll
        for (int j = 0; j < 4; ++j) acc[i][j] = __builtin_amdgcn_mfma_f32_16x16x32_bf16(bfr[j], af[i], acc[i][j], 0, 0, 0);
    }
    if (more) {
      char* nxt = smem + ((kt + 1) & 1) * 32768;
#pragma unroll
      for (int i = 0; i < 4; ++i) { *(u32x4*)(nxt + soff + i * 4096) = ra[i]; *(u32x4*)(nxt + 16384 + soff + i * 4096) = rb[i]; }
    }
    __syncthreads();
  }
  epi(acc, row0 + wr * 64, col0 + wc * 64, lane);
}


struct EpiRaw {
  bf16_t* R;
  DI void operator()(f32x4 (&acc)[4][4], int rbase, int cbase, int lane) const {
    const int fr = lane & 15, fq = lane >> 4;
#pragma unroll
    for (int i = 0; i < 4; ++i)
#pragma unroll
      for (int j = 0; j < 4; ++j) {
        const int row = rbase + i * 16 + fr, col = cbase + j * 16 + fq * 4;
        if (col < RLD) { u32x2 w = {pack2(acc[i][j][0], acc[i][j][1]), pack2(acc[i][j][2], acc[i][j][3])}; *(u32x2*)(R + (size_t)row * RLD + col) = w; }
      }
  }
};

struct EpiUq {
  bf16_t *Qa, *Qb; const float *c8, *s8;
  DI void operator()(f32x4 (&acc)[4][4], int rbase, int cbase, int lane) const {
    const int fr = lane & 15, fq = lane >> 4;
    const bool lat = rbase >= NCTX;
#pragma unroll
    for (int i = 0; i < 4; ++i) {
      const int row = rbase + i * 16 + fr;
      const int t = (row - NCTX) & (TLAT - 1);
#pragma unroll
      for (int j = 0; j < 4; ++j) {
        const int cf = cbase + j * 16, col = cf + fq * 4;
        f32x4 v = acc[i][j];
        u32x2 w = {pack2(v[0], v[1]), pack2(v[2], v[3])};
        *(u32x2*)(Qa + (size_t)row * 768 + col) = w;
        if (lat) {
          const int w96 = cf % 96;
          if (w96 >= 64) {
            const int pos = (w96 == 64) ? (t >> 6) : (t & 63);
            f32x4 o;
#pragma unroll
            for (int e = 0; e < 4; ++e) {
              const float pv = __shfl_xor(v[e], 32);
              const int f = (fq & 1) * 4 + e;
              const float cs = c8[pos * 8 + f], sn = s8[pos * 8 + f];
              o[e] = (fq < 2) ? (v[e] * cs - pv * sn) : (pv * sn + v[e] * cs);
            }
            w = (u32x2){pack2(o[0], o[1]), pack2(o[2], o[3])};
          }
          *(u32x2*)(Qb + (size_t)(row - NCTX) * 768 + col) = w;
        }
      }
    }
  }
};

struct EpiUkv {
  bf16_t *Km, *Vm;
  DI void operator()(f32x4 (&acc)[4][4], int rbase, int cbase, int lane) const {
    const int fr = lane & 15, fq = lane >> 4;
    const int h = cbase >> 7, part = (cbase >> 6) & 1;
#pragma unroll
    for (int i = 0; i < 4; ++i)
#pragma unroll
      for (int j = 0; j < 4; ++j) {
        const int row = rbase + i * 16 + fr, c = j * 16 + fq * 4;
        u32x2 w = {pack2(acc[i][j][0], acc[i][j][1]), pack2(acc[i][j][2], acc[i][j][3])};
        if (part == 0) *(u32x2*)(Km + (size_t)row * 768 + h * 96 + c) = w;
        else *(u32x2*)(Vm + (size_t)row * 512 + h * 64 + c) = w;
      }
  }
};

struct EpiRes {
  const float *xin_ctx, *xin_lat, *gate  ; float* X;
  DI void operator()(f32x4 (&acc)[4][4], int rbase, int cbase, int lane) const {
    const int fr = lane & 15, fq = lane >> 4;
    const float* g = gate + cond_idx(rbase) * 6144;
#pragma unroll
    for (int i = 0; i < 4; ++i) {
      const int row = rbase + i * 16 + fr;
      const float* xin = row < NCTX ? xin_ctx + (size_t)row * 1024 : xin_lat + (size_t)(row - NCTX) * 1024;
#pragma unroll
      for (int j = 0; j < 4; ++j) {
        const int col = cbase + j * 16 + fq * 4;
        const f32x4 xv = *(const f32x4*)(xin + col), gv = *(const f32x4*)(g + col);
        f32x4 z;
#pragma unroll
        for (int e = 0; e < 4; ++e) z[e] = ALPHA * xv[e] + gv[e] * acc[i][j][e];
        *(f32x4*)(X + (size_t)row * 1024 + col) = z;
      }
    }
  }
};

struct EpiRelu2 {
  bf16_t* U;
  DI void operator()(f32x4 (&acc)[4][4], int rbase, int cbase, int lane) const {
    const int fr = lane & 15, fq = lane >> 4;
#pragma unroll
    for (int i = 0; i < 4; ++i)
#pragma unroll
      for (int j = 0; j < 4; ++j) {
        const int row = rbase + i * 16 + fr, col = cbase + j * 16 + fq * 4;
        f32x4 v = acc[i][j];
#pragma unroll
        for (int e = 0; e < 4; ++e) { const float r = fmaxf(v[e], 0.f); v[e] = r * r; }
        u32x2 w = {pack2(v[0], v[1]), pack2(v[2], v[3])};
        *(u32x2*)(U + (size_t)row * 4096 + col) = w;
      }
  }
};

struct EpiConv {
  bf16_t *Ug, *Pz;
  DI void operator()(f32x4 (&acc)[4][4], int rbase, int cbase, int lane) const {
    const int fr = lane & 15, fq = lane >> 4;
#pragma unroll
    for (int i = 0; i < 4; ++i) {
      const int row = rbase + i * 16 + fr;
      if (cbase < 1024) {
#pragma unroll
        for (int jp = 0; jp < 2; ++jp) {
          const f32x4 a = acc[i][2 * jp], gt = acc[i][2 * jp + 1];
          f32x4 u;
#pragma unroll
          for (int e = 0; e < 4; ++e) u[e] = a[e] / (1.f + __expf(-gt[e]));
          const int ch = ((cbase + 32 * jp) >> 5) * 16 + fq * 4;
          u32x2 w = {pack2(u[0], u[1]), pack2(u[2], u[3])};
          *(u32x2*)(Ug + (size_t)row * 512 + ch) = w;
        }
      } else {
#pragma unroll
        for (int j = 0; j < 4; ++j) {
          const int col = cbase - 1024 + j * 16 + fq * 4;
          u32x2 w = {pack2(acc[i][j][0], acc[i][j][1]), pack2(acc[i][j][2], acc[i][j][3])};
          *(u32x2*)(Pz + (size_t)row * 512 + col) = w;
        }
      }
    }
  }
};

template <class Epi>
DI void gemm_phase(const bf16_t* A, int lda, const bf16_t* Bt, int ldb, int K, int mt, int nt, const Epi& epi, char* smem, int tstart = 0, int ttotal = -1) {
  const int n = mt * nt;
  if (ttotal < 0) ttotal = n;
  for (int t = blockIdx.x; t < ttotal; t += gridDim.x) {
    const int u = t - tstart;
    if (u < 0 || u >= n) continue;
    const int pm = u / nt, pn = u - pm * nt;
    gemm_tile(A, lda, Bt, ldb, K, pm * 128, pn * 128, smem, epi);
  }
}

DI void rows_phase(const float* src_ctx, const float* src_lat, bool do_ln, const float* lg, const float* lb, float* Xdst,
                   const float* modsL, int sh_off, int sc_off, bf16_t* Hb) {
  const int lane = threadIdx.x & 63, gw = blockIdx.x * 4 + (threadIdx.x >> 6), nw = gridDim.x * 4;
  for (int row = gw; row < NTOK; row += nw) {
    const float* src = row < NCTX ? src_ctx + (size_t)row * 1024 : src_lat + (size_t)(row - NCTX) * 1024;
    f32x4 v[4];
#pragma unroll
    for (int i = 0; i < 4; ++i) v[i] = *(const f32x4*)(src + i * 256 + lane * 4);
    if (do_ln) {
      float s = 0.f;
#pragma unroll
      for (int i = 0; i < 4; ++i) s += (v[i][0] + v[i][1]) + (v[i][2] + v[i][3]);
      const float mean = wave_sum(s) * (1.f / 1024.f);
      float q = 0.f;
#pragma unroll
      for (int i = 0; i < 4; ++i)
#pragma unroll
        for (int e = 0; e < 4; ++e) { const float d = v[i][e] - mean; q += d * d; }
      const float rstd = rsqrtf(wave_sum(q) * (1.f / 1024.f) + EPS);
#pragma unroll
      for (int i = 0; i < 4; ++i) {
        const f32x4 g = *(const f32x4*)(lg + i * 256 + lane * 4), b = *(const f32x4*)(lb + i * 256 + lane * 4);
#pragma unroll
        for (int e = 0; e < 4; ++e) v[i][e] = (v[i][e] - mean) * rstd * g[e] + b[e];
        if (Xdst) *(f32x4*)(Xdst + (size_t)row * 1024 + i * 256 + lane * 4) = v[i];
      }
    }
    if (Hb) {
      const float* m = modsL + cond_idx(row) * 6144;
#pragma unroll
      for (int i = 0; i < 4; ++i) {
        const int col = i * 256 + lane * 4;
        const f32x4 sh = *(const f32x4*)(m + sh_off + col), sc = *(const f32x4*)(m + sc_off + col);
        f32x4 h;
#pragma unroll
        for (int e = 0; e < 4; ++e) h[e] = v[i][e] * (1.f + sc[e]) + sh[e];
        u32x2 w = {pack2(h[0], h[1]), pack2(h[2], h[3])};
        *(u32x2*)(Hb + (size_t)row * 1024 + col) = w;
      }
    }
  }
}

DI double sin_red(double r) {
  const double r2 = r * r; double t = -1.0 / 51090942171709440000.0;
  t = t * r2 + 1.0 / 121645100408832000.0; t = t * r2 - 1.0 / 355687428096000.0; t = t * r2 + 1.0 / 1307674368000.0; t = t * r2 - 1.0 / 6227020800.0;
  t = t * r2 + 1.0 / 39916800.0; t = t * r2 - 1.0 / 362880.0; t = t * r2 + 1.0 / 5040.0; t = t * r2 - 1.0 / 120.0; t = t * r2 + 1.0 / 6.0;
  return r * (1.0 - r2 * t);
}
DI double cos_red(double r) {
  const double r2 = r * r; double t = 1.0 / 1124000727777607680000.0;
  t = t * r2 - 1.0 / 2432902008176640000.0; t = t * r2 + 1.0 / 6402373705728000.0; t = t * r2 - 1.0 / 20922789888000.0; t = t * r2 + 1.0 / 87178291200.0;
  t = t * r2 - 1.0 / 479001600.0; t = t * r2 + 1.0 / 3628800.0; t = t * r2 - 1.0 / 40320.0; t = t * r2 + 1.0 / 720.0; t = t * r2 - 1.0 / 24.0; t = t * r2 + 0.5; t = t * r2 * -1.0 + 1.0;
  return t;
}

constexpr int J_MODS = 192, J_WEFF = 128, J_CACHE = 128, J_ROPE = 1;
constexpr int T_ATTIN = 16 * 32, T_UQ = 4 * 12, T_UKV = 2 * 16, T_ATTOUT = 256, T_MLPIN = 16 * 64, T_MLPOUT = 64 * 16, T_CONVIN = 16 * 24, T_CONVOUT = 8 * 16;
constexpr int J_TR = T_ATTIN + T_UQ + T_UKV + T_ATTOUT + 2 * T_MLPIN + 2 * T_MLPOUT + T_CONVIN + T_CONVOUT;
constexpr int J_TOTAL = J_MODS + J_WEFF + J_CACHE + J_ROPE + J_TR;

DI void tr_job(const float* __restrict__ src, int N, int nvalid, bf16_t* __restrict__ dst, int lddst, int perm, int kt, int nt, char* smem) {
  float* tile = (float*)smem;
  const int tid = threadIdx.x;
  {
    const int n = tid & 63, kb = tid >> 6;
    const int gn = nt * 64 + n;
#pragma unroll
    for (int i = 0; i < 16; ++i) {
      const int k = kb + 4 * i;
      tile[k * 65 + n] = (gn < nvalid) ? src[(size_t)(kt * 64 + k) * N + gn] : 0.f;
    }
  }
  __syncthreads();
  {
    const int n = tid >> 2, ks = (tid & 3) * 16;
    int gn = nt * 64 + n;
    if (perm) { if (gn < 512) gn = 32 * (gn >> 4) + (gn & 15); else if (gn < 1024) { const int c = gn - 512; gn = 32 * (c >> 4) + 16 + (c & 15); } }
    unsigned w[8];
#pragma unroll
    for (int e = 0; e < 8; ++e) w[e] = pack2(tile[(ks + 2 * e) * 65 + n], tile[(ks + 2 * e + 1) * 65 + n]);
    bf16_t* d = dst + (size_t)gn * lddst + kt * 64 + ks;
    *(u32x4*)d = (u32x4){w[0], w[1], w[2], w[3]};
    *(u32x4*)(d + 8) = (u32x4){w[4], w[5], w[6], w[7]};
  }
  __syncthreads();
}

DI void phase0(const Params& p, char* smem) {
  const int tid = threadIdx.x, lane = tid & 63, wid = tid >> 6;
  char* ws = p.ws;
  for (int job = blockIdx.x; job < J_TOTAL; job += gridDim.x) {
    int j = job;
    if (j < J_MODS) {
      const int l = j / 96, cc = j % 96;
      float* sc = (float*)smem;
      for (int i = tid; i < 3072; i += 256) { const int ci = i >> 10, k = i & 1023; const float x = ci == 0 ? p.c_ctx[k] : p.c[(ci - 1) * 1024 + k]; sc[i] = x / (1.f + __expf(-x)); }
      __syncthreads();
      const int kg = tid >> 6, cl = tid & 63;
      const float* w = p.w_ada + (size_t)l * 1024 * 6144 + cc * 64 + cl;
      float s0 = 0.f, s1 = 0.f, s2 = 0.f;
#pragma unroll 8
      for (int k = kg * 256; k < kg * 256 + 256; ++k) { const float wv = w[(size_t)k * 6144]; s0 += sc[k] * wv; s1 += sc[1024 + k] * wv; s2 += sc[2048 + k] * wv; }
      float* r = (float*)(smem + 12288);
      r[(kg * 3 + 0) * 64 + cl] = s0; r[(kg * 3 + 1) * 64 + cl] = s1; r[(kg * 3 + 2) * 64 + cl] = s2;
      __syncthreads();
      if (tid < 192) {
        const int ci = tid >> 6, c2 = tid & 63;
        const float s = r[(0 * 3 + ci) * 64 + c2] + r[(1 * 3 + ci) * 64 + c2] + r[(2 * 3 + ci) * 64 + c2] + r[(3 * 3 + ci) * 64 + c2];
        ((float*)(ws + O_MODS))[(size_t)(l * 3 + ci) * 6144 + cc * 64 + c2] = s + p.b_ada[l * 6144 + cc * 64 + c2];
      }
      __syncthreads();
      continue;
    }
    j -= J_MODS;
    if (j < J_WEFF) {
      const int g = j >> 5, cch = (j >> 2) & 7, nch = j & 3;
      float* wp = (float*)smem;
      for (int i = tid; i < 2048; i += 256) wp[i] = p.w_pool[(size_t)(g * 128 + cch * 16 + (i >> 7)) * 128 + (i & 127)];
      __syncthreads();
      const int n = nch * 256 + tid;
      float a[16];
#pragma unroll
      for (int c = 0; c < 16; ++c) a[c] = 0.f;
      for (int e = 0; e < 128; ++e) {
        const float wo = p.w_conv_out[(size_t)(512 + g * 128 + e) * 1024 + n] * p.pool_scale[g * 128 + e];
#pragma unroll
        for (int c = 0; c < 16; ++c) a[c] += wp[c * 128 + e] * wo;
      }
      bf16_t* d = (bf16_t*)(ws + O_WCONVOUT) + (size_t)n * 1024 + 512 + g * 128 + cch * 16;
      *(u32x4*)d = (u32x4){pack2(a[0], a[1]), pack2(a[2], a[3]), pack2(a[4], a[5]), pack2(a[6], a[7])};
      *(u32x4*)(d + 8) = (u32x4){pack2(a[8], a[9]), pack2(a[10], a[11]), pack2(a[12], a[13]), pack2(a[14], a[15])};
      __syncthreads();
      continue;
    }
    j -= J_WEFF;
    if (j < J_CACHE) {
      const int rr = j * 4 + wid, b = rr >> 8, t = rr & 255;
      const size_t kr = NCTX + (size_t)b * TKL + t;
      {
        const f32x4 a0 = *(const f32x4*)(p.cache_k + (size_t)rr * 512 + lane * 8), a1 = *(const f32x4*)(p.cache_k + (size_t)rr * 512 + lane * 8 + 4);
        *(u32x4*)((bf16_t*)(ws + O_KD) + kr * 512 + lane * 8) = (u32x4){pack2(a0[0], a0[1]), pack2(a0[2], a0[3]), pack2(a1[0], a1[1]), pack2(a1[2], a1[3])};
        const f32x4 b0 = *(const f32x4*)(p.cache_v + (size_t)rr * 512 + lane * 8), b1 = *(const f32x4*)(p.cache_v + (size_t)rr * 512 + lane * 8 + 4);
        *(u32x4*)((bf16_t*)(ws + O_VD) + kr * 512 + lane * 8) = (u32x4){pack2(b0[0], b0[1]), pack2(b0[2], b0[3]), pack2(b1[0], b1[1]), pack2(b1[2], b1[3])};
        const f32x2 cv = *(const f32x2*)(p.cache_ckv + (size_t)rr * 128 + lane * 2);
        *(unsigned*)((bf16_t*)(ws + O_CKVN) + kr * 128 + lane * 2) = pack2(cv[0], cv[1]);
        const int idx = lane & 31;
        const float x = p.cache_krope[(size_t)rr * 32 + idx];
        const unsigned pk = pack2(x, x);
#pragma unroll
        for (int k = 0; k < 4; ++k) { const int hh = (lane >> 5) + 2 * k; ((bf16_t*)(ws + O_KMLA))[kr * 768 + hh * 96 + 64 + idx] = (bf16_t)(pk & 0xffff); }
      }
      continue;
    }
    j -= J_CACHE;
    if (j < J_ROPE) {
      float* c16 = (float*)(ws + O_C16); float* s16 = (float*)(ws + O_S16); float* c8 = (float*)(ws + O_C8); float* s8 = (float*)(ws + O_S8);
      for (int i = tid; i < 1024 + 512; i += 256) {
        int pos, f, half;
        if (i < 1024) { pos = i >> 4; f = i & 15; half = 16; } else { const int q = i - 1024; pos = q >> 3; f = q & 7; half = 8; }
        const float inv = (float)exp(-9.210340371976184 * (double)f / (double)half);
        const float angf = (float)pos * inv;
        const double ang = (double)angf;
        const double r = ang - 6.283185307179586 * rint(ang * 0.15915494309189535);
        const float cs = (float)cos_red(r), sn = (float)sin_red(r);
        if (i < 1024) { c16[i] = cs; s16[i] = sn; } else { c8[i - 1024] = cs; s8[i - 1024] = sn; }
      }
      if (wid == 0) {
        const float d1 = wave_sum(p.lam_q1[lane] * p.lam_k1[lane]), d2 = wave_sum(p.lam_q2[lane] * p.lam_k2[lane]);
        if (lane == 0) ((float*)(ws + O_SCAL))[0] = expf(d1) - expf(d2) + 0.2f;
      }
      continue;
    }
    j -= J_ROPE;
    if (j < T_ATTIN) { tr_job(p.w_att_in, 1952, 1952, (bf16_t*)(ws + O_WATTIN), 1024, 0, j / 32, j % 32, smem); continue; }
    j -= T_ATTIN;
    if (j < T_UQ) { tr_job(p.w_uq, 768, 768, (bf16_t*)(ws + O_WUQ), 256, 0, j / 12, j % 12, smem); continue; }
    j -= T_UQ;
    if (j < T_UKV) { tr_job(p.w_ukv, 1024, 1024, (bf16_t*)(ws + O_WUKV), 128, 0, j / 16, j % 16, smem); continue; }
    j -= T_UKV;
    if (j < T_ATTOUT) { tr_job(p.w_att_out, 1024, 1024, (bf16_t*)(ws + O_WATTOUT), 1024, 0, j / 16, j % 16, smem); continue; }
    j -= T_ATTOUT;
    if (j < 2 * T_MLPIN) { const int l = j / T_MLPIN, u = j % T_MLPIN; tr_job(p.w_mlp_in + (size_t)l * 1024 * 4096, 4096, 4096, (bf16_t*)(ws + O_WMLPIN) + (size_t)l * 4096 * 1024, 1024, 0, u / 64, u % 64, smem); continue; }
    j -= 2 * T_MLPIN;
    if (j < 2 * T_MLPOUT) { const int l = j / T_MLPOUT, u = j % T_MLPOUT; tr_job(p.w_mlp_out + (size_t)l * 4096 * 1024, 1024, 1024, (bf16_t*)(ws + O_WMLPOUT) + (size_t)l * 4096 * 1024, 4096, 0, u / 16, u % 16, smem); continue; }
    j -= 2 * T_MLPOUT;
    if (j < T_CONVIN) { tr_job(p.w_conv_in, 1536, 1536, (bf16_t*)(ws + O_WCONVIN), 1024, 1, j / 24, j % 24, smem); continue; }
    j -= T_CONVIN;
    { tr_job(p.w_conv_out, 1024, 1024, (bf16_t*)(ws + O_WCONVOUT), 1024, 0, j / 16, j % 16, smem); }
  }
}

DI void rope8(const float (&x)[8], float (&o)[8], int lane, const float* c16, const float* s16, int prow, int pcol) {
  const int L = lane & 7;
  const int pos = (L & 4) ? pcol : prow;
  const bool second = (L & 2) != 0;
  const int fb = (L & 1) * 8;
#pragma unroll
  for (int e = 0; e < 8; ++e) {
    const float y = __shfl_xor(x[e], 2);
    const float cs = c16[pos * 16 + fb + e], sn = s16[pos * 16 + fb + e];
    o[e] = second ? (y * sn + x[e] * cs) : (x[e] * cs - y * sn);
  }
}
DI void unpack8(const u32x4 w, float (&x)[8]) {
#pragma unroll
  for (int e = 0; e < 4; ++e) { x[2 * e] = bflo(w[e]); x[2 * e + 1] = bfhi(w[e]); }
}
DI u32x4 pack8(const float (&x)[8]) { return (u32x4){pack2(x[0], x[1]), pack2(x[2], x[3]), pack2(x[4], x[5]), pack2(x[6], x[7])}; }

DI void phase3(const Params& p) {
  char* ws = p.ws;
  const bf16_t* R = (const bf16_t*)(ws + O_R);
  bf16_t* Qda = (bf16_t*)(ws + O_QDA); bf16_t* Qdb = (bf16_t*)(ws + O_QDB); bf16_t* Kd = (bf16_t*)(ws + O_KD); bf16_t* Vd = (bf16_t*)(ws + O_VD);
  bf16_t* cqn = (bf16_t*)(ws + O_CQN); bf16_t* ckvn = (bf16_t*)(ws + O_CKVN); bf16_t* Km = (bf16_t*)(ws + O_KMLA);
  const float* c16 = (const float*)(ws + O_C16); const float* s16 = (const float*)(ws + O_S16); const float* c8 = (const float*)(ws + O_C8); const float* s8 = (const float*)(ws + O_S8);
  float* o_k = p.out + (size_t)NTOK * 1024; float* o_v = o_k + (size_t)NCTX * 512; float* o_ckv = o_v + (size_t)NCTX * 512; float* o_kr = o_ckv + (size_t)NCTX * 128;
  const int lane = threadIdx.x & 63, gw = blockIdx.x * 4 + (threadIdx.x >> 6), nw = gridDim.x * 4;
  for (int row = gw; row < NTOK; row += nw) {
    const bool lat = row >= NCTX;
    const int rl = row - NCTX, b = rl >> 12, t = rl & (TLAT - 1), prow = t >> 6, pcol = t & 63;
    const size_t kr = lat ? (size_t)NCTX + (size_t)b * TKL + 256 + t : (size_t)row;
    const bf16_t* r = R + (size_t)row * RLD;
    float x[8], o[8];
    const u32x4 wq = *(const u32x4*)(r + lane * 8);
    *(u32x4*)(Qda + (size_t)row * 512 + lane * 8) = wq;
    if (lat) { unpack8(wq, x); rope8(x, o, lane, c16, s16, prow, pcol); *(u32x4*)(Qdb + (size_t)rl * 512 + lane * 8) = pack8(o); }
    const u32x4 wk = *(const u32x4*)(r + 512 + lane * 8);
    if (lat) { unpack8(wk, x); rope8(x, o, lane, c16, s16, prow, pcol); *(u32x4*)(Kd + kr * 512 + lane * 8) = pack8(o); }
    else {
      unpack8(wk, x);
      *(f32x4*)(o_k + (size_t)row * 512 + lane * 8) = (f32x4){x[0], x[1], x[2], x[3]};
      *(f32x4*)(o_k + (size_t)row * 512 + lane * 8 + 4) = (f32x4){x[4], x[5], x[6], x[7]};
      *(u32x4*)(Kd + kr * 512 + lane * 8) = wk;
    }
    const u32x4 wv = *(const u32x4*)(r + 1024 + lane * 8);
    *(u32x4*)(Vd + kr * 512 + lane * 8) = wv;
    if (!lat) {
      unpack8(wv, x);
      *(f32x4*)(o_v + (size_t)row * 512 + lane * 8) = (f32x4){x[0], x[1], x[2], x[3]};
      *(f32x4*)(o_v + (size_t)row * 512 + lane * 8 + 4) = (f32x4){x[4], x[5], x[6], x[7]};
    }
    {
      const u32x2 w = *(const u32x2*)(r + 1536 + lane * 4);
      const float a0 = bflo(w[0]), a1 = bfhi(w[0]), a2 = bflo(w[1]), a3 = bfhi(w[1]);
      const float ss = wave_sum(a0 * a0 + a1 * a1 + a2 * a2 + a3 * a3);
      const float sc = rsqrtf(ss * (1.f / 256.f) + EPS);
      const f32x4 g = *(const f32x4*)(p.q_norm_g + lane * 4);
      *(u32x2*)(cqn + (size_t)row * 256 + lane * 4) = (u32x2){pack2(a0 * sc * g[0], a1 * sc * g[1]), pack2(a2 * sc * g[2], a3 * sc * g[3])};
    }
    {
      const unsigned w = *(const unsigned*)(r + 1792 + lane * 2);
      const float a0 = bflo(w), a1 = bfhi(w);
      const float ss = wave_sum(a0 * a0 + a1 * a1);
      const float sc = rsqrtf(ss * (1.f / 128.f) + EPS);
      const f32x2 g = *(const f32x2*)(p.kv_norm_g + lane * 2);
      const float y0 = a0 * sc * g[0], y1 = a1 * sc * g[1];
      if (!lat) *(f32x2*)(o_ckv + (size_t)row * 128 + lane * 2) = (f32x2){y0, y1};
      *(unsigned*)(ckvn + kr * 128 + lane * 2) = pack2(y0, y1);
    }
    {
      const int idx = lane & 31;
      const float xv = bf2f(r[1920 + idx]);
      float ov = xv;
      if (lat) {
        const int pos = (idx & 16) ? pcol : prow;
        const int f = idx & 7;
        const float y = __shfl_xor(xv, 8);
        const float cs = c8[pos * 8 + f], sn = s8[pos * 8 + f];
        ov = (idx & 8) ? (y * sn + xv * cs) : (xv * cs - y * sn);
      } else if (lane < 32) o_kr[(size_t)row * 32 + idx] = xv;
      const bf16_t ob = (bf16_t)(pack2(ov, ov) & 0xffff);
#pragma unroll
      for (int k = 0; k < 4; ++k) { const int hh = (lane >> 5) + 2 * k; Km[kr * 768 + hh * 96 + 64 + idx] = ob; }
    }
  }
}

template <int DQK, int DV>
DI void attn_core(const bf16_t* __restrict__ Qa, const bf16_t* __restrict__ Qb, int ldq, const bf16_t* __restrict__ Kp, int ldk, const bf16_t* __restrict__ Vp, int ldv,
                  int Tk, int n_a, float c  , char* smem, f32x16 (&o)[DV / 32]) {
  constexpr int KS = DQK * 2 + 16, VS = DV * 2 + 16, BUF = 64 * (KS + VS);
  constexpr int KCH = DQK / 8, VCH = DV / 8, NKC = 64 * KCH / 256, NVC = 64 * VCH / 256;
  constexpr int NS = DQK / 16, NDT = DV / 32;
  const int tid = threadIdx.x, lane = tid & 63, wid = tid >> 6, h = lane >> 5, ql = lane & 31;
  bf16x8 qf[NS];
  {
    const bf16_t* q = Qa + (size_t)(wid * 32 + ql) * ldq + h * 8;
#pragma unroll
    for (int s = 0; s < NS; ++s) qf[s] = *(const bf16x8*)(q + s * 16);
  }
#pragma unroll
  for (int dt = 0; dt < NDT; ++dt)
#pragma unroll
    for (int r = 0; r < 16; ++r) o[dt][r] = 0.f;
  float m_run = -INFINITY, l_run = 0.f;
  u32x4 rk[NKC], rv[NVC];
  const int nt = Tk >> 6, ta = n_a >> 6;
  unsigned koff[NKC], voff[NVC];
#pragma unroll
  for (int i = 0; i < NKC; ++i) { const int ch = tid + 256 * i, row = ch / KCH, kc = ch % KCH; koff[i] = (unsigned)(row * ldk + kc * 8); }
#pragma unroll
  for (int i = 0; i < NVC; ++i) { const int ch = tid + 256 * i, row = ch / VCH, vc = ch % VCH; voff[i] = (unsigned)(row * ldv + vc * 8); }
  auto gload = [&](int t) {
    const bf16_t* kb = Kp + (size_t)t * 64 * ldk;
    const bf16_t* vbp = Vp + (size_t)t * 64 * ldv;
#pragma unroll
    for (int i = 0; i < NKC; ++i) rk[i] = *(const u32x4*)(kb + koff[i]);
#pragma unroll
    for (int i = 0; i < NVC; ++i) rv[i] = *(const u32x4*)(vbp + voff[i]);
  };
  auto lstoreK = [&](char* buf) {
#pragma unroll
    for (int i = 0; i < NKC; ++i) { const int ch = tid + 256 * i, row = ch / KCH, kc = ch % KCH; *(u32x4*)(buf + row * KS + kc * 16) = rk[i]; }
  };
  auto lstoreV = [&](char* buf) {
#pragma unroll
    for (int i = 0; i < NVC; ++i) { const int ch = tid + 256 * i, row = ch / VCH, vc = ch % VCH; *(u32x4*)(buf + 64 * KS + row * VS + vc * 16) = rv[i]; }
  };
  gload(0); lstoreK(smem); lstoreV(smem); __syncthreads();
  const int i16 = lane & 15, tq = i16 >> 2, tp = i16 & 3, G = (lane >> 4) & 1;
  for (int t = 0; t < nt; ++t) {
    char* cur = smem + (t & 1) * BUF;
    const bool more = t + 1 < nt;
    if (more) gload(t + 1);
    if (t == ta) {
      const bf16_t* q = Qb + (size_t)(wid * 32 + ql) * ldq + h * 8;
#pragma unroll
      for (int s = 0; s < NS; ++s) qf[s] = *(const bf16x8*)(q + s * 16);
    }
    f32x16 st[2];
#pragma unroll
    for (int kt = 0; kt < 2; ++kt) {
#pragma unroll
      for (int r = 0; r < 16; ++r) st[kt][r] = 0.f;
#pragma unroll
      for (int s = 0; s < NS; ++s) {
        const bf16x8 kf = *(const bf16x8*)(cur + (kt * 32 + ql) * KS + s * 32 + h * 16);
        st[kt] = __builtin_amdgcn_mfma_f32_32x32x16_bf16(kf, qf[s], st[kt], 0, 0, 0);
      }
      __builtin_amdgcn_sched_barrier(0);
    }
    if (more) lstoreK(smem + ((t + 1) & 1) * BUF);
    float mx = st[0][0];
#pragma unroll
    for (int kt = 0; kt < 2; ++kt)
#pragma unroll
      for (int r = 0; r < 16; ++r) mx = fmaxf(mx, st[kt][r]);
    mx = fmaxf(mx, __shfl_xor(mx, 32));
    const float m_new = fmaxf(m_run, mx);
    const float alpha = __builtin_amdgcn_exp2f((m_run - m_new) * c);
    const float mc = m_new * c;
    m_run = m_new;
    float ls = 0.f;
#pragma unroll
    for (int kt = 0; kt < 2; ++kt)
#pragma unroll
      for (int r = 0; r < 16; ++r) { const float pv = __builtin_amdgcn_exp2f(st[kt][r] * c - mc); st[kt][r] = pv; ls += pv; }
    l_run = l_run * alpha + ls;
#pragma unroll
    for (int dt = 0; dt < NDT; ++dt)
#pragma unroll
      for (int r = 0; r < 16; ++r) o[dt][r] *= alpha;
    bf16x8 pf[2][2];
#pragma unroll
    for (int kt = 0; kt < 2; ++kt)
#pragma unroll
      for (int s2 = 0; s2 < 2; ++s2) {
        u32x4 w = {pack2(st[kt][8 * s2 + 0], st[kt][8 * s2 + 1]), pack2(st[kt][8 * s2 + 2], st[kt][8 * s2 + 3]), pack2(st[kt][8 * s2 + 4], st[kt][8 * s2 + 5]), pack2(st[kt][8 * s2 + 6], st[kt][8 * s2 + 7])};
        pf[kt][s2] = __builtin_bit_cast(bf16x8, w);
      }
    const char* vb = cur + 64 * KS + (4 * h + tq) * VS + 32 * G + 8 * tp;
#pragma unroll
    for (int kt = 0; kt < 2; ++kt)
#pragma unroll
      for (int s2 = 0; s2 < 2; ++s2) {
        bf16x8 vf[NDT];
#pragma unroll
        for (int dt = 0; dt < NDT; ++dt) {
          const char* a0 = vb + (kt * 32 + 16 * s2) * VS + dt * 64;
          const s16x4 lo = __builtin_amdgcn_ds_read_tr16_b64_v4i16((LDS_AS s16x4*)(a0));
          const s16x4 hi = __builtin_amdgcn_ds_read_tr16_b64_v4i16((LDS_AS s16x4*)(a0 + 8 * VS));
          vf[dt] = __builtin_shufflevector(lo, hi, 0, 1, 2, 3, 4, 5, 6, 7);
        }
#pragma unroll
        for (int dt = 0; dt < NDT; ++dt) o[dt] = __builtin_amdgcn_mfma_f32_32x32x16_bf16(vf[dt], pf[kt][s2], o[dt], 0, 0, 0);
        __builtin_amdgcn_sched_barrier(0);
      }
    if (more) lstoreV(smem + ((t + 1) & 1) * BUF);
    __syncthreads();
  }
  const float l = l_run + __shfl_xor(l_run, 32);
  const float inv = 1.f / l;
#pragma unroll
  for (int dt = 0; dt < NDT; ++dt)
#pragma unroll
    for (int r = 0; r < 16; ++r) o[dt][r] *= inv;
}

constexpr int U_DBIG = 256, U_MBIG = 512, U_DCTX = 128, U_MCTX = 256, U_TOTAL = U_DBIG + U_MBIG + U_DCTX + U_MCTX;

DI void phase_attn(const Params& p, char* smem) {
  char* ws = p.ws;
  const bf16_t* Qda = (const bf16_t*)(ws + O_QDA); const bf16_t* Qdb = (const bf16_t*)(ws + O_QDB); const bf16_t* Kd = (const bf16_t*)(ws + O_KD); const bf16_t* Vd = (const bf16_t*)(ws + O_VD);
  const bf16_t* Qma = (const bf16_t*)(ws + O_QMA); const bf16_t* Qmb = (const bf16_t*)(ws + O_QMB); const bf16_t* Km = (const bf16_t*)(ws + O_KMLA); const bf16_t* Vm = (const bf16_t*)(ws + O_VMLA);
  bf16_t* cat = (bf16_t*)(ws + O_HB);
  float* otmp = (float*)(ws + O_OTMP) + (size_t)blockIdx.x * 16384;
  int* counter = (int*)(ws + O_CNT);
  int* s_unit = (int*)(smem + 65532);
  const int tid = threadIdx.x, lane = tid & 63, wid = tid >> 6, h2 = lane >> 5, ql = lane & 31;
  const float lam = ((const float*)(ws + O_SCAL))[0];
  for (;;) {
    if (tid == 0) *s_unit = atomicAdd(counter, 1);
    __syncthreads();
    int u = __builtin_amdgcn_readfirstlane(*s_unit);
    __syncthreads();
    if (u >= U_TOTAL) break;
    bool diff; int qrow0, krow0, Tk, n_a, head; bool lat;
    if (u < U_DBIG) { diff = true; lat = true; const int b = u >> 7, hh = (u >> 5) & 3, qb = u & 31; head = hh; qrow0 = NCTX + b * TLAT + qb * 128; krow0 = NCTX + b * TKL; Tk = TKL; n_a = 256; }
    else if (u < U_DBIG + U_MBIG) { u -= U_DBIG; diff = false; lat = true; const int b = u >> 8, hh = (u >> 5) & 7, qb = u & 31; head = hh; qrow0 = NCTX + b * TLAT + qb * 128; krow0 = NCTX + b * TKL; Tk = TKL; n_a = 256; }
    else if (u < U_DBIG + U_MBIG + U_DCTX) { u -= U_DBIG + U_MBIG; diff = true; lat = false; const int sq = u >> 3, hh = (u >> 1) & 3, qb = u & 1; head = hh; qrow0 = sq * 256 + qb * 128; krow0 = sq * 256; Tk = 256; n_a = 256; }
    else { u -= U_DBIG + U_MBIG + U_DCTX; diff = false; lat = false; const int sq = u >> 4, hh = (u >> 1) & 7, qb = u & 1; head = hh; qrow0 = sq * 256 + qb * 128; krow0 = sq * 256; Tk = 256; n_a = 256; }
    const int qrowb = lat ? qrow0 - NCTX : 0;
    if (diff) {
      f32x16 o[4];
      const float c = 0.125f * 1.4426950408889634f;
#pragma unroll 1
      for (int m = 0; m < 2; ++m) {
        attn_core<64, 128>(Qda + (size_t)qrow0 * 512 + head * 128 + m * 64, Qdb + (size_t)qrowb * 512 + head * 128 + m * 64, 512,
                           Kd + (size_t)krow0 * 512 + head * 128 + m * 64, 512, Vd + (size_t)krow0 * 512 + head * 128, 512, Tk, n_a, c, smem, o);
        if (m == 0) {
#pragma unroll
          for (int dt = 0; dt < 4; ++dt)
#pragma unroll
            for (int rq = 0; rq < 4; ++rq) *(f32x4*)(otmp + tid * 64 + dt * 16 + rq * 4) = (f32x4){o[dt][4 * rq], o[dt][4 * rq + 1], o[dt][4 * rq + 2], o[dt][4 * rq + 3]};
        }
      }
      float ss = 0.f;
#pragma unroll
      for (int dt = 0; dt < 4; ++dt)
#pragma unroll
        for (int rq = 0; rq < 4; ++rq) {
          const f32x4 o0 = *(const f32x4*)(otmp + tid * 64 + dt * 16 + rq * 4);
#pragma unroll
          for (int e = 0; e < 4; ++e) { const float v = o0[e] - lam * o[dt][4 * rq + e]; o[dt][4 * rq + e] = v; ss += v * v; }
        }
      ss += __shfl_xor(ss, 32);
      const float sc = rsqrtf(ss * (1.f / 128.f) + EPS) * 0.8f;
      bf16_t* dst = cat + (size_t)(qrow0 + wid * 32 + ql) * 1024 + head * 128;
#pragma unroll
      for (int dt = 0; dt < 4; ++dt)
#pragma unroll
        for (int rq = 0; rq < 4; ++rq) {
          const int dv = dt * 32 + 8 * rq + 4 * h2;
          const f32x4 g = *(const f32x4*)(p.diff_norm_g + dv);
          u32x2 w = {pack2(o[dt][4 * rq] * sc * g[0], o[dt][4 * rq + 1] * sc * g[1]), pack2(o[dt][4 * rq + 2] * sc * g[2], o[dt][4 * rq + 3] * sc * g[3])};
          *(u32x2*)(dst + dv) = w;
        }
    } else {
      f32x16 o[2];
      const float c = 0.10206207261596575f * 1.4426950408889634f;
      attn_core<96, 64>(Qma + (size_t)qrow0 * 768 + head * 96, Qmb + (size_t)qrowb * 768 + head * 96, 768,
                        Km + (size_t)krow0 * 768 + head * 96, 768, Vm + (size_t)krow0 * 512 + head * 64, 512, Tk, n_a, c, smem, o);
      bf16_t* dst = cat + (size_t)(qrow0 + wid * 32 + ql) * 1024 + 512 + head * 64;
#pragma unroll
      for (int dt = 0; dt < 2; ++dt)
#pragma unroll
        for (int rq = 0; rq < 4; ++rq) {
          const int dv = dt * 32 + 8 * rq + 4 * h2;
          u32x2 w = {pack2(o[dt][4 * rq], o[dt][4 * rq + 1]), pack2(o[dt][4 * rq + 2], o[dt][4 * rq + 3])};
          *(u32x2*)(dst + dv) = w;
        }
    }
  }
}

DI void phase_conv(const Params& p, char* smem) {
  char* ws = p.ws;
  const bf16_t* Ug = (const bf16_t*)(ws + O_UG); const bf16_t* Pz = (const bf16_t*)(ws + O_PZ);
  bf16_t* cat = (bf16_t*)(ws + O_HB);
  float* tile = (float*)smem;
  const int tid = threadIdx.x, lane = tid & 63, wid = tid >> 6;
  for (int u = blockIdx.x; u < NTOK / 16; u += gridDim.x) {
    const int t0 = u * 16;
    const int s0 = t0 < NCTX ? (t0 & ~255) : NCTX + ((t0 - NCTX) & ~(TLAT - 1));
    const int s1 = t0 < NCTX ? s0 + 256 : s0 + TLAT;
    {
      const int ch = tid * 2;
      float a0[16], a1[16];
#pragma unroll
      for (int o = 0; o < 16; ++o) { a0[o] = 0.f; a1[o] = 0.f; }
      f32x2 w[31];
#pragma unroll
      for (int j = 0; j < 31; ++j) w[j] = *(const f32x2*)(p.conv_w + j * 512 + ch);
#pragma unroll
      for (int i = 0; i < 46; ++i) {
        const int r = t0 - 15 + i;
        float u0 = 0.f, u1 = 0.f;
        if (r >= s0 && r < s1) { const unsigned v = *(const unsigned*)(Ug + (size_t)r * 512 + ch); u0 = bflo(v); u1 = bfhi(v); }
#pragma unroll
        for (int o = 0; o < 16; ++o) {
          const int j = i - o;
          if (j >= 0 && j <= 30) { a0[o] += u0 * w[j][0]; a1[o] += u1 * w[j][1]; }
        }
      }
      const f32x2 bias = *(const f32x2*)(p.conv_b + ch);
#pragma unroll
      for (int o = 0; o < 16; ++o) *(f32x2*)(tile + o * 512 + ch) = (f32x2){a0[o] + bias[0], a1[o] + bias[1]};
    }
    __syncthreads();
#pragma unroll 1
    for (int k = 0; k < 4; ++k) {
      const int o = wid * 4 + k, row = t0 + o;
      const f32x4 v0 = *(const f32x4*)(tile + o * 512 + lane * 4), v1 = *(const f32x4*)(tile + o * 512 + 256 + lane * 4);
      const float mean = wave_sum((v0[0] + v0[1]) + (v0[2] + v0[3]) + (v1[0] + v1[1]) + (v1[2] + v1[3])) * (1.f / 512.f);
      float q = 0.f;
#pragma unroll
      for (int e = 0; e < 4; ++e) { const float d0 = v0[e] - mean, d1 = v1[e] - mean; q += d0 * d0 + d1 * d1; }
      const float rstd = rsqrtf(wave_sum(q) * (1.f / 512.f) + EPS);
#pragma unroll
      for (int hlf = 0; hlf < 2; ++hlf) {
        const int col = hlf * 256 + lane * 4;
        const f32x4 v = hlf ? v1 : v0;
        const f32x4 g = *(const f32x4*)(p.conv_norm_g + col), bb = *(const f32x4*)(p.conv_norm_b + col);
        float y[4];
#pragma unroll
        for (int e = 0; e < 4; ++e) { const float z = (v[e] - mean) * rstd * g[e] + bb[e]; y[e] = z / (1.f + __expf(-z)); }
        *(u32x2*)(cat + (size_t)row * 1024 + col) = (u32x2){pack2(y[0], y[1]), pack2(y[2], y[3])};
      }
    }
    {
      const int ch = tid * 2, hw = 1 << wid;
#pragma unroll 1
      for (int o = 0; o < 16; ++o) {
        const int r = t0 + o;
        const int lo = max(r - hw, s0), hi = min(r + hw - 1, s1 - 1);
        float a0 = 0.f, a1 = 0.f;
        for (int q = lo; q <= hi; ++q) { const unsigned v = *(const unsigned*)(Pz + (size_t)q * 512 + ch); a0 += bflo(v); a1 += bfhi(v); }
        const unsigned vc = *(const unsigned*)(Pz + (size_t)r * 512 + ch);
        const float ic = 1.f / (float)(hi - lo + 1);
        *(unsigned*)(cat + (size_t)r * 1024 + 512 + ch) = pack2(a0 * ic - bflo(vc), a1 * ic - bfhi(vc));
      }
    }
    __syncthreads();
  }
}

__global__ void __launch_bounds__(256, 2) fwd_kernel(Params p, int ph_lo, int ph_hi) {
  __shared__ __attribute__((aligned(16))) char smem[65536];
  cg::grid_group grid = cg::this_grid();
  char* ws = p.ws;
  float* mods = (float*)(ws + O_MODS);
  bf16_t* Hb = (bf16_t*)(ws + O_HB);
  float* X = p.out;
#define PH_BEGIN(n) if (ph_lo <= n && n < ph_hi) { if (n > ph_lo) grid.sync();
#define PH_END }
  PH_BEGIN(0) { phase0(p, smem); } PH_END
  PH_BEGIN(1) { rows_phase(p.x_prompt, p.x_sample, false, nullptr, nullptr, nullptr, mods, 0, 1024, Hb); } PH_END
  PH_BEGIN(2) { gemm_phase(Hb, 1024, (const bf16_t*)(ws + O_WATTIN), 1024, 1024, 96, 16, EpiRaw{(bf16_t*)(ws + O_R)}, smem); } PH_END
  PH_BEGIN(3) { phase3(p); } PH_END
  PH_BEGIN(4) {
        const int n1 = 96 * 6, n2 = 100 * 8;
        gemm_phase((const bf16_t*)(ws + O_CQN), 256, (const bf16_t*)(ws + O_WUQ), 256, 256, 96, 6,
                   EpiUq{(bf16_t*)(ws + O_QMA), (bf16_t*)(ws + O_QMB), (const float*)(ws + O_C8), (const float*)(ws + O_S8)}, smem, 0, n1 + n2);
        gemm_phase((const bf16_t*)(ws + O_CKVN), 128, (const bf16_t*)(ws + O_WUKV), 128, 128, 100, 8,
                   EpiUkv{(bf16_t*)(ws + O_KMLA), (bf16_t*)(ws + O_VMLA)}, smem, n1, n1 + n2);
  } PH_END
  PH_BEGIN(5) { phase_attn(p, smem); } PH_END
  PH_BEGIN(6) { gemm_phase(Hb, 1024, (const bf16_t*)(ws + O_WATTOUT), 1024, 1024, 96, 8, EpiRes{p.x_prompt, p.x_sample, mods + 2048, X}, smem); } PH_END
  PH_BEGIN(7) { rows_phase(X, X + (size_t)NCTX * 1024, true, p.ln_mix_g, p.ln_mix_b, X, mods, 3072, 4096, Hb); } PH_END
  PH_BEGIN(8) { gemm_phase(Hb, 1024, (const bf16_t*)(ws + O_WMLPIN), 1024, 1024, 96, 32, EpiRelu2{(bf16_t*)(ws + O_U)}, smem); } PH_END
  PH_BEGIN(9) { gemm_phase((const bf16_t*)(ws + O_U), 4096, (const bf16_t*)(ws + O_WMLPOUT), 4096, 4096, 96, 8, EpiRes{X, X + (size_t)NCTX * 1024, mods + 5120, X}, smem); } PH_END
  PH_BEGIN(10) { rows_phase(X, X + (size_t)NCTX * 1024, true, p.ln_mlp_g, p.ln_mlp_b, X, mods + 3 * 6144, 0, 1024, Hb); } PH_END
  PH_BEGIN(11) { gemm_phase(Hb, 1024, (const bf16_t*)(ws + O_WCONVIN), 1024, 1024, 96, 12, EpiConv{(bf16_t*)(ws + O_UG), (bf16_t*)(ws + O_PZ)}, smem); } PH_END
  PH_BEGIN(12) { phase_conv(p, smem); } PH_END
  PH_BEGIN(13) { gemm_phase(Hb, 1024, (const bf16_t*)(ws + O_WCONVOUT), 1024, 1024, 96, 8, EpiRes{X, X + (size_t)NCTX * 1024, mods + 3 * 6144 + 2048, X}, smem); } PH_END
  PH_BEGIN(14) { rows_phase(X, X + (size_t)NCTX * 1024, true, p.ln_mix_g + 1024, p.ln_mix_b + 1024, X, mods + 3 * 6144, 3072, 4096, Hb); } PH_END
  PH_BEGIN(15) { gemm_phase(Hb, 1024, (const bf16_t*)(ws + O_WMLPIN) + (size_t)4096 * 1024, 1024, 1024, 96, 32, EpiRelu2{(bf16_t*)(ws + O_U)}, smem); } PH_END
  PH_BEGIN(16) { gemm_phase((const bf16_t*)(ws + O_U), 4096, (const bf16_t*)(ws + O_WMLPOUT) + (size_t)4096 * 1024, 4096, 4096, 96, 8, EpiRes{X, X + (size_t)NCTX * 1024, mods + 3 * 6144 + 5120, X}, smem); } PH_END
  PH_BEGIN(17) { rows_phase(X, X + (size_t)NCTX * 1024, true, p.ln_mlp_g + 1024, p.ln_mlp_b + 1024, X, nullptr, 0, 0, nullptr); } PH_END

}

extern "C" void kernel_launch(void* const* d_in, const int* in_sizes, int n_in, void* d_out, int out_size, void* d_ws, size_t ws_size, hipStream_t stream) {
  static int grid_blocks = 0;
  if (!grid_blocks) {
    int dev = 0, cus = 0, per_cu = 0;
    hipGetDevice(&dev);
    hipDeviceGetAttribute(&cus, hipDeviceAttributeMultiprocessorCount, dev);
    hipOccupancyMaxActiveBlocksPerMultiprocessor(&per_cu, fwd_kernel, 256, 0);
    if (per_cu > 2) per_cu = 2;
    if (per_cu < 1) per_cu = 1;
    grid_blocks = cus * per_cu;
    if (grid_blocks > 512) grid_blocks = 512;
  }
  if (ws_size < WS_NEED) { fprintf(stderr, "workspace too small: %zu < %zu\n", ws_size, (size_t)WS_NEED); return; }
  Params p{};
  const float** f = (const float**)&p;
  for (int i = 0; i < 35; ++i) f[i] = (const float*)d_in[i];
  p.out = (float*)d_out;
  p.ws = (char*)d_ws;
  hipMemsetAsync(d_ws, 0, 256, stream);
  int lo = 0, hi = NPHASE;
  void* args[] = {&p, &lo, &hi};
  hipError_t e = hipLaunchCooperativeKernel((void*)fwd_kernel, dim3(grid_blocks), dim3(256), args, 0, stream);
  if (e != hipSuccess) fprintf(stderr, "cooperative launch failed: %s (grid %d)\n", hipGetErrorString(e), grid_blocks);
}
```

```cpp
#include <hip/hip_runtime.h>
#include <hip/hip_cooperative_groups.h>
#include <cstdio>
#include <cstdint>
namespace cg = cooperative_groups;

typedef unsigned short bf16_t;
typedef short bf16x8 __attribute__((ext_vector_type(8)));
typedef short s16x4 __attribute__((ext_vector_type(4)));
typedef float f32x4 __attribute__((ext_vector_type(4)));
typedef float f32x2 __attribute__((ext_vector_type(2)));
typedef float f32x16 __attribute__((ext_vector_type(16)));
typedef unsigned u32x4 __attribute__((ext_vector_type(4)));
typedef unsigned u32x2 __attribute__((ext_vector_type(2)));
typedef __bf16 bf16v2 __attribute__((ext_vector_type(2)));
#define DI __device__ __forceinline__
#define LDS_AS __attribute__((address_space(3)))

constexpr int NTOK = 12288, NCTX = 4096, NKEY = 12800, TLAT = 4096, TKL = 4352;
constexpr int RLD = 1952;
constexpr float ALPHA = 1.41421356237f, EPS = 1e-5f;
constexpr int NPHASE = 18;

constexpr size_t al(size_t x) { return (x + 255) & ~(size_t)255; }
constexpr size_t O_CNT = 0;
constexpr size_t O_BAR = 256;
constexpr size_t O_MODS = 16384;
constexpr size_t O_SCAL = O_MODS + al(2 * 3 * 6144 * 4);
constexpr size_t O_C16 = O_SCAL + 256;
constexpr size_t O_S16 = O_C16 + 4096;
constexpr size_t O_C8 = O_S16 + 4096;
constexpr size_t O_S8 = O_C8 + 2048;
constexpr size_t O_WATTIN = O_S8 + 2048;
constexpr size_t O_WUQ = O_WATTIN + (size_t)2048 * 1024 * 2;
constexpr size_t O_WUKV = O_WUQ + (size_t)768 * 256 * 2;
constexpr size_t O_WATTOUT = O_WUKV + (size_t)1024 * 128 * 2;
constexpr size_t O_WMLPIN = O_WATTOUT + (size_t)1024 * 1024 * 2;
constexpr size_t O_WMLPOUT = O_WMLPIN + (size_t)2 * 4096 * 1024 * 2;
constexpr size_t O_WCONVIN = O_WMLPOUT + (size_t)2 * 4096 * 1024 * 2;
constexpr size_t O_WCONVOUT = O_WCONVIN + (size_t)1536 * 1024 * 2;
constexpr size_t O_HB = O_WCONVOUT + (size_t)1024 * 1024 * 2;
constexpr size_t O_BIG = O_HB + (size_t)NTOK * 1024 * 2;
constexpr size_t O_R = O_BIG;
constexpr size_t O_QMA = O_R;
constexpr size_t O_QMB = O_QMA + (size_t)NTOK * 768 * 2;
constexpr size_t O_QDA = O_R + al((size_t)NTOK * RLD * 2);
constexpr size_t O_QDB = O_QDA + (size_t)NTOK * 512 * 2;
constexpr size_t O_KD = O_QDB + (size_t)8192 * 512 * 2;
constexpr size_t O_VD = O_KD + (size_t)NKEY * 512 * 2;
constexpr size_t O_CQN = O_VD + (size_t)NKEY * 512 * 2;
constexpr size_t O_CKVN = O_CQN + (size_t)NTOK * 256 * 2;
constexpr size_t O_KMLA = O_CKVN + (size_t)NKEY * 128 * 2;
constexpr size_t O_VMLA = O_KMLA + (size_t)NKEY * 768 * 2;
constexpr size_t O_OTMP = O_VMLA + (size_t)NKEY * 512 * 2;
constexpr size_t O_ATT_END = O_OTMP + (size_t)512 * 16384 * 4;
constexpr size_t O_U = O_BIG;
constexpr size_t O_U_END = O_U + (size_t)NTOK * 4096 * 2;
constexpr size_t O_UG = O_BIG;
constexpr size_t O_PZ = O_UG + (size_t)NTOK * 512 * 2;
constexpr size_t WS_NEED = (O_ATT_END > O_U_END ? O_ATT_END : O_U_END);
static_assert(O_QMB + (size_t)8192 * 768 * 2 <= O_QDA, "Qm overlay must fit in R");
static_assert(WS_NEED <= (size_t)256 * 1024 * 1024, "workspace too large");

struct Params {
  const float *x_prompt, *x_sample, *cache_k, *cache_v, *cache_ckv, *cache_krope, *c, *c_ctx;
  const float *w_ada, *b_ada, *ln_mix_g, *ln_mix_b, *ln_mlp_g, *ln_mlp_b, *w_mlp_in, *w_mlp_out;
  const float *w_att_in, *w_uq, *w_ukv, *q_norm_g, *kv_norm_g, *lam_q1, *lam_k1, *lam_q2, *lam_k2, *diff_norm_g, *w_att_out;
  const float *w_conv_in, *conv_w, *conv_b, *conv_norm_g, *conv_norm_b, *w_pool, *pool_scale, *w_conv_out;
  float* out;
  char* ws;
};

DI unsigned pack2(float lo, float hi) { f32x2 v = {lo, hi}; bf16v2 b = __builtin_convertvector(v, bf16v2); return __builtin_bit_cast(unsigned, b); }
DI float bf2f(unsigned short u) { return __uint_as_float((unsigned)u << 16); }
DI float bflo(unsigned u) { return __uint_as_float(u << 16); }
DI float bfhi(unsigned u) { return __uint_as_float(u & 0xffff0000u); }
DI float wave_sum(float v) {
#pragma unroll
  for (int o = 32; o >= 1; o >>= 1) v += __shfl_xor(v, o);
  return v;
}
DI int cond_idx(int row) { return row < NCTX ? 0 : 1 + ((row - NCTX) >> 12); }


#define XB_TMO      128
#define XB_XCNT(j)  (256  + 64 * (j))
#define XB_XSUB(j)  (1280 + 64 * (j))
#define XB_XGEN(j)  (2304 + 64 * (j))
#define XB_TOP      3328
#define XB_TOPGEN   3392
#define XCD_BAR_WORDS 3456
#define XB_SPIN_CAP (1u << 18)
DI unsigned xb_ld(unsigned* p)              { return __hip_atomic_load(p, __ATOMIC_RELAXED, __HIP_MEMORY_SCOPE_AGENT); }
DI unsigned xb_add(unsigned* p, unsigned v) { return __hip_atomic_fetch_add(p, v, __ATOMIC_RELAXED, __HIP_MEMORY_SCOPE_AGENT); }
DI unsigned xb_xcc_id() { return (unsigned)__builtin_amdgcn_s_getreg((3 << 11) | 20) & 0xFu; }
#define XB_SPIN(cond, bar) do { unsigned _sp = 0; while (cond) { __builtin_amdgcn_s_sleep(1); \
    if ((++_sp & 255u) == 0u) { if (xb_ld(&(bar)[XB_TMO])) break; if (_sp > XB_SPIN_CAP) { atomicAdd(&(bar)[XB_TMO], 1u); break; } } } } while (0)
struct XcdBarrier { unsigned* bar; unsigned x; volatile LDS_AS unsigned* st; };
DI XcdBarrier xcd_barrier_post(unsigned* bar, volatile LDS_AS unsigned* st) {
  XcdBarrier b; b.bar = bar; b.x = xb_xcc_id(); b.st = st;
  if (threadIdx.x == 0) (void)xb_add(&bar[XB_XCNT(b.x)], 1u);
  return b;
}
DI void xcd_barrier_complete(unsigned* bar, unsigned x, unsigned& nloc, unsigned& nx) {
  const unsigned G = gridDim.x * gridDim.y * gridDim.z;
  unsigned sum, cnt, mine, sp = 0u;
  for (;;) {
    sum = 0u; cnt = 0u; mine = 0u;
#pragma unroll
    for (unsigned j = 0; j < 16; ++j) { const unsigned c = xb_ld(&bar[XB_XCNT(j)]); sum += c; cnt += (c > 0u) ? 1u : 0u; mine = (j == x) ? c : mine; }
    if (sum == G) break;
    __builtin_amdgcn_s_sleep(1);
    if ((++sp & 255u) == 0u) { if (xb_ld(&bar[XB_TMO])) break; if (sp > XB_SPIN_CAP) { atomicAdd(&bar[XB_TMO], 1u); break; } }
  }
  nloc = mine > 0u ? mine : 1u; nx = cnt > 0u ? cnt : 1u;
}
DI void xcd_barrier(const XcdBarrier& b) {
  asm volatile("s_waitcnt vmcnt(0)" ::: "memory");
  __syncthreads();
  if (threadIdx.x == 0) {
    unsigned* bar = b.bar;
    __builtin_amdgcn_s_waitcnt(0);
    unsigned nloc = b.st[0], nx = b.st[1];
    if (nloc == 0u) { xcd_barrier_complete(bar, b.x, nloc, nx); b.st[0] = nloc; b.st[1] = nx; }
    const unsigned old = xb_add(&bar[XB_XSUB(b.x)], 1u);
    const unsigned gen = old / nloc;
    if (old + 1u == (gen + 1u) * nloc) {
      __builtin_amdgcn_fence(__ATOMIC_RELEASE, "agent");
      asm volatile("s_waitcnt vmcnt(0)" ::: "memory");
      const unsigned og = xb_add(&bar[XB_TOP], 1u);
      const unsigned tg = og / nx;
      if (og + 1u == (tg + 1u) * nx) xb_add(&bar[XB_TOPGEN], 1u);
      else XB_SPIN(xb_ld(&bar[XB_TOPGEN]) == tg, bar);
      __builtin_amdgcn_fence(__ATOMIC_ACQUIRE, "agent");
      xb_add(&bar[XB_XGEN(b.x)], 1u);
      asm volatile("s_waitcnt vmcnt(0)" ::: "memory");
    } else {
      XB_SPIN(xb_ld(&bar[XB_XGEN(b.x)]) == gen, bar);
      __builtin_amdgcn_fence(__ATOMIC_ACQUIRE, "agent");
      asm volatile("s_waitcnt vmcnt(0)" ::: "memory");
    }
  }
  __syncthreads();
}

DI int swz(int row, int kc) { return row * 128 + ((kc ^ ((row >> 1) & 7)) << 4); }

template <class Epi>
DI void gemm_tile(const bf16_t* __restrict__ A, int lda, const bf16_t* __restrict__ Bt, int ldb, int K, int row0, int col0, char* smem, const Epi& epi) {
  const int tid = threadIdx.x, lane = tid & 63, wid = tid >> 6, wr = wid >> 1, wc = wid & 1;
  const int fr = lane & 15, fq = lane >> 4;
  f32x4 acc[4][4];
#pragma unroll
  for (int i = 0; i < 4; ++i)
#pragma unroll
    for (int j = 0; j < 4; ++j) acc[i][j] = (f32x4){0.f, 0.f, 0.f, 0.f};
  const int srow = tid >> 3, skc = tid & 7;
  const bf16_t* ga = A + (size_t)(row0 + srow) * lda + skc * 8;
  const bf16_t* gb = Bt + (size_t)(col0 + srow) * ldb + skc * 8;
  const int soff = swz(srow, skc);
  u32x4 ra[4], rb[4];
  const int nk = K >> 6;
#pragma unroll
  for (int i = 0; i < 4; ++i) { ra[i] = *(const u32x4*)(ga + (size_t)(32 * i) * lda); rb[i] = *(const u32x4*)(gb + (size_t)(32 * i) * ldb); }
#pragma unroll
  for (int i = 0; i < 4; ++i) { *(u32x4*)(smem + soff + i * 4096) = ra[i]; *(u32x4*)(smem + 16384 + soff + i * 4096) = rb[i]; }
  __syncthreads();
  for (int kt = 0; kt < nk; ++kt) {
    char* cur = smem + (kt & 1) * 32768;
    const bool more = (kt + 1 < nk);
    if (more) {
      const int k0 = (kt + 1) << 6;
#pragma unroll
      for (int i = 0; i < 4; ++i) { ra[i] = *(const u32x4*)(ga + (size_t)(32 * i) * lda + k0); rb[i] = *(const u32x4*)(gb + (size_t)(32 * i) * ldb + k0); }
    }
#pragma unroll
    for (int s = 0; s < 2; ++s) {
      bf16x8 af[4], bfr[4];
#pragma unroll
      for (int i = 0; i < 4; ++i) af[i] = *(const bf16x8*)(cur + swz(wr * 64 + i * 16 + fr, s * 4 + fq));
#pragma unroll
      for (int j = 0; j < 4; ++j) bfr[j] = *(const bf16x8*)(cur + 16384 + swz(wc * 64 + j * 16 + fr, s * 4 + fq));
#pragma unroll
      for (int i = 0; i < 4; ++i)
#pragma unroll
        for (int j = 0; j < 4; ++j) acc[i][j] = __builtin_amdgcn_mfma_f32_16x16x32_bf16(bfr[j], af[i], acc[i][j], 0, 0, 0);
    }
    if (more) {
      char* nxt = smem + ((kt + 1) & 1) * 32768;
#pragma unroll
      for (int i = 0; i < 4; ++i) { *(u32x4*)(nxt + soff + i * 4096) = ra[i]; *(u32x4*)(nxt + 16384 + soff + i * 4096) = rb[i]; }
    }
    __syncthreads();
  }
  epi(acc, row0 + wr * 64, col0 + wc * 64, lane);
}


struct EpiRaw {
  bf16_t* R;
  DI void operator()(f32x4 (&acc)[4][4], int rbase, int cbase, int lane) const {
    const int fr = lane & 15, fq = lane >> 4;
#pragma unroll
    for (int i = 0; i < 4; ++i)
#pragma unroll
      for (int j = 0; j < 4; ++j) {
        const int row = rbase + i * 16 + fr, col = cbase + j * 16 + fq * 4;
        if (col < RLD) { u32x2 w = {pack2(acc[i][j][0], acc[i][j][1]), pack2(acc[i][j][2], acc[i][j][3])}; *(u32x2*)(R + (size_t)row * RLD + col) = w; }
      }
  }
};

struct EpiUq {
  bf16_t *Qa, *Qb; const float *c8, *s8;
  DI void operator()(f32x4 (&acc)[4][4], int rbase, int cbase, int lane) const {
    const int fr = lane & 15, fq = lane >> 4;
    const bool lat = rbase >= NCTX;
#pragma unroll
    for (int i = 0; i < 4; ++i) {
      const int row = rbase + i * 16 + fr;
      const int t = (row - NCTX) & (TLAT - 1);
#pragma unroll
      for (int j = 0; j < 4; ++j) {
        const int cf = cbase + j * 16, col = cf + fq * 4;
        f32x4 v = acc[i][j];
        u32x2 w = {pack2(v[0], v[1]), pack2(v[2], v[3])};
        *(u32x2*)(Qa + (size_t)row * 768 + col) = w;
        if (lat) {
          const int w96 = cf % 96;
          if (w96 >= 64) {
            const int pos = (w96 == 64) ? (t >> 6) : (t & 63);
            f32x4 o;
#pragma unroll
            for (int e = 0; e < 4; ++e) {
              const float pv = __shfl_xor(v[e], 32);
              const int f = (fq & 1) * 4 + e;
              const float cs = c8[pos * 8 + f], sn = s8[pos * 8 + f];
              o[e] = (fq < 2) ? (v[e] * cs - pv * sn) : (pv * sn + v[e] * cs);
            }
            w = (u32x2){pack2(o[0], o[1]), pack2(o[2], o[3])};
          }
          *(u32x2*)(Qb + (size_t)(row - NCTX) * 768 + col) = w;
        }
      }
    }
  }
};

struct EpiUkv {
  bf16_t *Km, *Vm;
  DI void operator()(f32x4 (&acc)[4][4], int rbase, int cbase, int lane) const {
    const int fr = lane & 15, fq = lane >> 4;
    const int h = cbase >> 7, part = (cbase >> 6) & 1;
#pragma unroll
    for (int i = 0; i < 4; ++i)
#pragma unroll
      for (int j = 0; j < 4; ++j) {
        const int row = rbase + i * 16 + fr, c = j * 16 + fq * 4;
        u32x2 w = {pack2(acc[i][j][0], acc[i][j][1]), pack2(acc[i][j][2], acc[i][j][3])};
        if (part == 0) *(u32x2*)(Km + (size_t)row * 768 + h * 96 + c) = w;
        else *(u32x2*)(Vm + (size_t)row * 512 + h * 64 + c) = w;
      }
  }
};

struct EpiRes {
  const float *xin_ctx, *xin_lat, *gate  ; float* X;
  DI void operator()(f32x4 (&acc)[4][4], int rbase, int cbase, int lane) const {
    const int fr = lane & 15, fq = lane >> 4;
    const float* g = gate + cond_idx(rbase) * 6144;
#pragma unroll
    for (int i = 0; i < 4; ++i) {
      const int row = rbase + i * 16 + fr;
      const float* xin = row < NCTX ? xin_ctx + (size_t)row * 1024 : xin_lat + (size_t)(row - NCTX) * 1024;
#pragma unroll
      for (int j = 0; j < 4; ++j) {
        const int col = cbase + j * 16 + fq * 4;
        const f32x4 xv = *(const f32x4*)(xin + col), gv = *(const f32x4*)(g + col);
        f32x4 z;
#pragma unroll
        for (int e = 0; e < 4; ++e) z[e] = ALPHA * xv[e] + gv[e] * acc[i][j][e];
        *(f32x4*)(X + (size_t)row * 1024 + col) = z;
      }
    }
  }
};

struct EpiRelu2 {
  bf16_t* U;
  DI void operator()(f32x4 (&acc)[4][4], int rbase, int cbase, int lane) const {
    const int fr = lane & 15, fq = lane >> 4;
#pragma unroll
    for (int i = 0; i < 4; ++i)
#pragma unroll
      for (int j = 0; j < 4; ++j) {
        const int row = rbase + i * 16 + fr, col = cbase + j * 16 + fq * 4;
        f32x4 v = acc[i][j];
#pragma unroll
        for (int e = 0; e < 4; ++e) { const float r = fmaxf(v[e], 0.f); v[e] = r * r; }
        u32x2 w = {pack2(v[0], v[1]), pack2(v[2], v[3])};
        *(u32x2*)(U + (size_t)row * 4096 + col) = w;
      }
  }
};

struct EpiConv {
  bf16_t *Ug, *Pz;
  DI void operator()(f32x4 (&acc)[4][4], int rbase, int cbase, int lane) const {
    const int fr = lane & 15, fq = lane >> 4;
#pragma unroll
    for (int i = 0; i < 4; ++i) {
      const int row = rbase + i * 16 + fr;
      if (cbase < 1024) {
#pragma unroll
        for (int jp = 0; jp < 2; ++jp) {
          const f32x4 a = acc[i][2 * jp], gt = acc[i][2 * jp + 1];
          f32x4 u;
#pragma unroll
          for (int e = 0; e < 4; ++e) u[e] = a[e] / (1.f + __expf(-gt[e]));
          const int ch = ((cbase + 32 * jp) >> 5) * 16 + fq * 4;
          u32x2 w = {pack2(u[0], u[1]), pack2(u[2], u[3])};
          *(u32x2*)(Ug + (size_t)row * 512 + ch) = w;
        }
      } else {
#pragma unroll
        for (int j = 0; j < 4; ++j) {
          const int col = cbase - 1024 + j * 16 + fq * 4;
          u32x2 w = {pack2(acc[i][j][0], acc[i][j][1]), pack2(acc[i][j][2], acc[i][j][3])};
          *(u32x2*)(Pz + (size_t)row * 512 + col) = w;
        }
      }
    }
  }
};

template <class Epi>
DI void gemm_phase(const bf16_t* A, int lda, const bf16_t* Bt, int ldb, int K, int mt, int nt, const Epi& epi, char* smem, int tstart = 0, int ttotal = -1) {
  const int n = mt * nt;
  if (ttotal < 0) ttotal = n;
  for (int t = blockIdx.x; t < ttotal; t += gridDim.x) {
    const int u = t - tstart;
    if (u < 0 || u >= n) continue;
    const int pm = u / nt, pn = u - pm * nt;
    gemm_tile(A, lda, Bt, ldb, K, pm * 128, pn * 128, smem, epi);
  }
}

DI void rows_phase(const float* src_ctx, const float* src_lat, bool do_ln, const float* lg, const float* lb, float* Xdst,
                   const float* modsL, int sh_off, int sc_off, bf16_t* Hb) {
  const int lane = threadIdx.x & 63, gw = blockIdx.x * 4 + (threadIdx.x >> 6), nw = gridDim.x * 4;
  for (int row = gw; row < NTOK; row += nw) {
    const float* src = row < NCTX ? src_ctx + (size_t)row * 1024 : src_lat + (size_t)(row - NCTX) * 1024;
    f32x4 v[4];
#pragma unroll
    for (int i = 0; i < 4; ++i) v[i] = *(const f32x4*)(src + i * 256 + lane * 4);
    if (do_ln) {
      float s = 0.f;
#pragma unroll
      for (int i = 0; i < 4; ++i) s += (v[i][0] + v[i][1]) + (v[i][2] + v[i][3]);
      const float mean = wave_sum(s) * (1.f / 1024.f);
      float q = 0.f;
#pragma unroll
      for (int i = 0; i < 4; ++i)
#pragma unroll
        for (int e = 0; e < 4; ++e) { const float d = v[i][e] - mean; q += d * d; }
      const float rstd = rsqrtf(wave_sum(q) * (1.f / 1024.f) + EPS);
#pragma unroll
      for (int i = 0; i < 4; ++i) {
        const f32x4 g = *(const f32x4*)(lg + i * 256 + lane * 4), b = *(const f32x4*)(lb + i * 256 + lane * 4);
#pragma unroll
        for (int e = 0; e < 4; ++e) v[i][e] = (v[i][e] - mean) * rstd * g[e] + b[e];
        if (Xdst) *(f32x4*)(Xdst + (size_t)row * 1024 + i * 256 + lane * 4) = v[i];
      }
    }
    if (Hb) {
      const float* m = modsL + cond_idx(row) * 6144;
#pragma unroll
      for (int i = 0; i < 4; ++i) {
        const int col = i * 256 + lane * 4;
        const f32x4 sh = *(const f32x4*)(m + sh_off + col), sc = *(const f32x4*)(m + sc_off + col);
        f32x4 h;
#pragma unroll
        for (int e = 0; e < 4; ++e) h[e] = v[i][e] * (1.f + sc[e]) + sh[e];
        u32x2 w = {pack2(h[0], h[1]), pack2(h[2], h[3])};
        *(u32x2*)(Hb + (size_t)row * 1024 + col) = w;
      }
    }
  }
}

DI double sin_red(double r) {
  const double r2 = r * r; double t = -1.0 / 51090942171709440000.0;
  t = t * r2 + 1.0 / 121645100408832000.0; t = t * r2 - 1.0 / 355687428096000.0; t = t * r2 + 1.0 / 1307674368000.0; t = t * r2 - 1.0 / 6227020800.0;
  t = t * r2 + 1.0 / 39916800.0; t = t * r2 - 1.0 / 362880.0; t = t * r2 + 1.0 / 5040.0; t = t * r2 - 1.0 / 120.0; t = t * r2 + 1.0 / 6.0;
  return r * (1.0 - r2 * t);
}
DI double cos_red(double r) {
  const double r2 = r * r; double t = 1.0 / 1124000727777607680000.0;
  t = t * r2 - 1.0 / 2432902008176640000.0; t = t * r2 + 1.0 / 6402373705728000.0; t = t * r2 - 1.0 / 20922789888000.0; t = t * r2 + 1.0 / 87178291200.0;
  t = t * r2 - 1.0 / 479001600.0; t = t * r2 + 1.0 / 3628800.0; t = t * r2 - 1.0 / 40320.0; t = t * r2 + 1.0 / 720.0; t = t * r2 - 1.0 / 24.0; t = t * r2 + 0.5; t = t * r2 * -1.0 + 1.0;
  return t;
}

constexpr int J_MODS = 192, J_WEFF = 128, J_CACHE = 128, J_ROPE = 1;
constexpr int T_ATTIN = 16 * 32, T_UQ = 4 * 12, T_UKV = 2 * 16, T_ATTOUT = 256, T_MLPIN = 16 * 64, T_MLPOUT = 64 * 16, T_CONVIN = 16 * 24, T_CONVOUT = 8 * 16;
constexpr int J_TR = T_ATTIN + T_UQ + T_UKV + T_ATTOUT + 2 * T_MLPIN + 2 * T_MLPOUT + T_CONVIN + T_CONVOUT;
constexpr int J_TOTAL = J_MODS + J_WEFF + J_CACHE + J_ROPE + J_TR;

DI void tr_job(const float* __restrict__ src, int N, int nvalid, bf16_t* __restrict__ dst, int lddst, int perm, int kt, int nt, char* smem) {
  float* tile = (float*)smem;
  const int tid = threadIdx.x;
  {
    const int n = tid & 63, kb = tid >> 6;
    const int gn = nt * 64 + n;
#pragma unroll
    for (int i = 0; i < 16; ++i) {
      const int k = kb + 4 * i;
      tile[k * 65 + n] = (gn < nvalid) ? src[(size_t)(kt * 64 + k) * N + gn] : 0.f;
    }
  }
  __syncthreads();
  {
    const int n = tid >> 2, ks = (tid & 3) * 16;
    int gn = nt * 64 + n;
    if (perm) { if (gn < 512) gn = 32 * (gn >> 4) + (gn & 15); else if (gn < 1024) { const int c = gn - 512; gn = 32 * (c >> 4) + 16 + (c & 15); } }
    unsigned w[8];
#pragma unroll
    for (int e = 0; e < 8; ++e) w[e] = pack2(tile[(ks + 2 * e) * 65 + n], tile[(ks + 2 * e + 1) * 65 + n]);
    bf16_t* d = dst + (size_t)gn * lddst + kt * 64 + ks;
    *(u32x4*)d = (u32x4){w[0], w[1], w[2], w[3]};
    *(u32x4*)(d + 8) = (u32x4){w[4], w[5], w[6], w[7]};
  }
  __syncthreads();
}

DI void phase0(const Params& p, char* smem) {
  const int tid = threadIdx.x, lane = tid & 63, wid = tid >> 6;
  char* ws = p.ws;
  for (int job = blockIdx.x; job < J_TOTAL; job += gridDim.x) {
    int j = job;
    if (j < J_MODS) {
      const int l = j / 96, cc = j % 96;
      float* sc = (float*)smem;
      for (int i = tid; i < 3072; i += 256) { const int ci = i >> 10, k = i & 1023; const float x = ci == 0 ? p.c_ctx[k] : p.c[(ci - 1) * 1024 + k]; sc[i] = x / (1.f + __expf(-x)); }
      __syncthreads();
      const int kg = tid >> 6, cl = tid & 63;
      const float* w = p.w_ada + (size_t)l * 1024 * 6144 + cc * 64 + cl;
      float s0 = 0.f, s1 = 0.f, s2 = 0.f;
#pragma unroll 8
      for (int k = kg * 256; k < kg * 256 + 256; ++k) { const float wv = w[(size_t)k * 6144]; s0 += sc[k] * wv; s1 += sc[1024 + k] * wv; s2 += sc[2048 + k] * wv; }
      float* r = (float*)(smem + 12288);
      r[(kg * 3 + 0) * 64 + cl] = s0; r[(kg * 3 + 1) * 64 + cl] = s1; r[(kg * 3 + 2) * 64 + cl] = s2;
      __syncthreads();
      if (tid < 192) {
        const int ci = tid >> 6, c2 = tid & 63;
        const float s = r[(0 * 3 + ci) * 64 + c2] + r[(1 * 3 + ci) * 64 + c2] + r[(2 * 3 + ci) * 64 + c2] + r[(3 * 3 + ci) * 64 + c2];
        ((float*)(ws + O_MODS))[(size_t)(l * 3 + ci) * 6144 + cc * 64 + c2] = s + p.b_ada[l * 6144 + cc * 64 + c2];
      }
      __syncthreads();
      continue;
    }
    j -= J_MODS;
    if (j < J_WEFF) {
      const int g = j >> 5, cch = (j >> 2) & 7, nch = j & 3;
      float* wp = (float*)smem;
      for (int i = tid; i < 2048; i += 256) wp[i] = p.w_pool[(size_t)(g * 128 + cch * 16 + (i >> 7)) * 128 + (i & 127)];
      __syncthreads();
      const int n = nch * 256 + tid;
      float a[16];
#pragma unroll
      for (int c = 0; c < 16; ++c) a[c] = 0.f;
      for (int e = 0; e < 128; ++e) {
        const float wo = p.w_conv_out[(size_t)(512 + g * 128 + e) * 1024 + n] * p.pool_scale[g * 128 + e];
#pragma unroll
        for (int c = 0; c < 16; ++c) a[c] += wp[c * 128 + e] * wo;
      }
      bf16_t* d = (bf16_t*)(ws + O_WCONVOUT) + (size_t)n * 1024 + 512 + g * 128 + cch * 16;
      *(u32x4*)d = (u32x4){pack2(a[0], a[1]), pack2(a[2], a[3]), pack2(a[4], a[5]), pack2(a[6], a[7])};
      *(u32x4*)(d + 8) = (u32x4){pack2(a[8], a[9]), pack2(a[10], a[11]), pack2(a[12], a[13]), pack2(a[14], a[15])};
      __syncthreads();
      continue;
    }
    j -= J_WEFF;
    if (j < J_CACHE) {
      const int rr = j * 4 + wid, b = rr >> 8, t = rr & 255;
      const size_t kr = NCTX + (size_t)b * TKL + t;
      {
        const f32x4 a0 = *(const f32x4*)(p.cache_k + (size_t)rr * 512 + lane * 8), a1 = *(const f32x4*)(p.cache_k + (size_t)rr * 512 + lane * 8 + 4);
        *(u32x4*)((bf16_t*)(ws + O_KD) + kr * 512 + lane * 8) = (u32x4){pack2(a0[0], a0[1]), pack2(a0[2], a0[3]), pack2(a1[0], a1[1]), pack2(a1[2], a1[3])};
        const f32x4 b0 = *(const f32x4*)(p.cache_v + (size_t)rr * 512 + lane * 8), b1 = *(const f32x4*)(p.cache_v + (size_t)rr * 512 + lane * 8 + 4);
        *(u32x4*)((bf16_t*)(ws + O_VD) + kr * 512 + lane * 8) = (u32x4){pack2(b0[0], b0[1]), pack2(b0[2], b0[3]), pack2(b1[0], b1[1]), pack2(b1[2], b1[3])};
        const f32x2 cv = *(const f32x2*)(p.cache_ckv + (size_t)rr * 128 + lane * 2);
        *(unsigned*)((bf16_t*)(ws + O_CKVN) + kr * 128 + lane * 2) = pack2(cv[0], cv[1]);
        const int idx = lane & 31;
        const float x = p.cache_krope[(size_t)rr * 32 + idx];
        const unsigned pk = pack2(x, x);
#pragma unroll
        for (int k = 0; k < 4; ++k) { const int hh = (lane >> 5) + 2 * k; ((bf16_t*)(ws + O_KMLA))[kr * 768 + hh * 96 + 64 + idx] = (bf16_t)(pk & 0xffff); }
      }
      continue;
    }
    j -= J_CACHE;
    if (j < J_ROPE) {
      float* c16 = (float*)(ws + O_C16); float* s16 = (float*)(ws + O_S16); float* c8 = (float*)(ws + O_C8); float* s8 = (float*)(ws + O_S8);
      for (int i = tid; i < 1024 + 512; i += 256) {
        int pos, f, half;
        if (i < 1024) { pos = i >> 4; f = i & 15; half = 16; } else { const int q = i - 1024; pos = q >> 3; f = q & 7; half = 8; }
        const float inv = (float)exp(-9.210340371976184 * (double)f / (double)half);
        const float angf = (float)pos * inv;
        const double ang = (double)angf;
        const double r = ang - 6.283185307179586 * rint(ang * 0.15915494309189535);
        const float cs = (float)cos_red(r), sn = (float)sin_red(r);
        if (i < 1024) { c16[i] = cs; s16[i] = sn; } else { c8[i - 1024] = cs; s8[i - 1024] = sn; }
      }
      if (wid == 0) {
        const float d1 = wave_sum(p.lam_q1[lane] * p.lam_k1[lane]), d2 = wave_sum(p.lam_q2[lane] * p.lam_k2[lane]);
        if (lane == 0) ((float*)(ws + O_SCAL))[0] = expf(d1) - expf(d2) + 0.2f;
      }
      continue;
    }
    j -= J_ROPE;
    if (j < T_ATTIN) { tr_job(p.w_att_in, 1952, 1952, (bf16_t*)(ws + O_WATTIN), 1024, 0, j / 32, j % 32, smem); continue; }
    j -= T_ATTIN;
    if (j < T_UQ) { tr_job(p.w_uq, 768, 768, (bf16_t*)(ws + O_WUQ), 256, 0, j / 12, j % 12, smem); continue; }
    j -= T_UQ;
    if (j < T_UKV) { tr_job(p.w_ukv, 1024, 1024, (bf16_t*)(ws + O_WUKV), 128, 0, j / 16, j % 16, smem); continue; }
    j -= T_UKV;
    if (j < T_ATTOUT) { tr_job(p.w_att_out, 1024, 1024, (bf16_t*)(ws + O_WATTOUT), 1024, 0, j / 16, j % 16, smem); continue; }
    j -= T_ATTOUT;
    if (j < 2 * T_MLPIN) { const int l = j / T_MLPIN, u = j % T_MLPIN; tr_job(p.w_mlp_in + (size_t)l * 1024 * 4096, 4096, 4096, (bf16_t*)(ws + O_WMLPIN) + (size_t)l * 4096 * 1024, 1024, 0, u / 64, u % 64, smem); continue; }
    j -= 2 * T_MLPIN;
    if (j < 2 * T_MLPOUT) { const int l = j / T_MLPOUT, u = j % T_MLPOUT; tr_job(p.w_mlp_out + (size_t)l * 4096 * 1024, 1024, 1024, (bf16_t*)(ws + O_WMLPOUT) + (size_t)l * 4096 * 1024, 4096, 0, u / 16, u % 16, smem); continue; }
    j -= 2 * T_MLPOUT;
    if (j < T_CONVIN) { tr_job(p.w_conv_in, 1536, 1536, (bf16_t*)(ws + O_WCONVIN), 1024, 1, j / 24, j % 24, smem); continue; }
    j -= T_CONVIN;
    { tr_job(p.w_conv_out, 1024, 1024, (bf16_t*)(ws + O_WCONVOUT), 1024, 0, j / 16, j % 16, smem); }
  }
}

DI void rope8(const float (&x)[8], float (&o)[8], int lane, const float* c16, const float* s16, int prow, int pcol) {
  const int L = lane & 7;
  const int pos = (L & 4) ? pcol : prow;
  const bool second = (L & 2) != 0;
  const int fb = (L & 1) * 8;
#pragma unroll
  for (int e = 0; e < 8; ++e) {
    const float y = __shfl_xor(x[e], 2);
    const float cs = c16[pos * 16 + fb + e], sn = s16[pos * 16 + fb + e];
    o[e] = second ? (y * sn + x[e] * cs) : (x[e] * cs - y * sn);
  }
}
DI void unpack8(const u32x4 w, float (&x)[8]) {
#pragma unroll
  for (int e = 0; e < 4; ++e) { x[2 * e] = bflo(w[e]); x[2 * e + 1] = bfhi(w[e]); }
}
DI u32x4 pack8(const float (&x)[8]) { return (u32x4){pack2(x[0], x[1]), pack2(x[2], x[3]), pack2(x[4], x[5]), pack2(x[6], x[7])}; }

DI void phase3(const Params& p) {
  char* ws = p.ws;
  const bf16_t* R = (const bf16_t*)(ws + O_R);
  bf16_t* Qda = (bf16_t*)(ws + O_QDA); bf16_t* Qdb = (bf16_t*)(ws + O_QDB); bf16_t* Kd = (bf16_t*)(ws + O_KD); bf16_t* Vd = (bf16_t*)(ws + O_VD);
  bf16_t* cqn = (bf16_t*)(ws + O_CQN); bf16_t* ckvn = (bf16_t*)(ws + O_CKVN); bf16_t* Km = (bf16_t*)(ws + O_KMLA);
  const float* c16 = (const float*)(ws + O_C16); const float* s16 = (const float*)(ws + O_S16); const float* c8 = (const float*)(ws + O_C8); const float* s8 = (const float*)(ws + O_S8);
  float* o_k = p.out + (size_t)NTOK * 1024; float* o_v = o_k + (size_t)NCTX * 512; float* o_ckv = o_v + (size_t)NCTX * 512; float* o_kr = o_ckv + (size_t)NCTX * 128;
  const int lane = threadIdx.x & 63, gw = blockIdx.x * 4 + (threadIdx.x >> 6), nw = gridDim.x * 4;
  for (int row = gw; row < NTOK; row += nw) {
    const bool lat = row >= NCTX;
    const int rl = row - NCTX, b = rl >> 12, t = rl & (TLAT - 1), prow = t >> 6, pcol = t & 63;
    const size_t kr = lat ? (size_t)NCTX + (size_t)b * TKL + 256 + t : (size_t)row;
    const bf16_t* r = R + (size_t)row * RLD;
    float x[8], o[8];
    const u32x4 wq = *(const u32x4*)(r + lane * 8);
    *(u32x4*)(Qda + (size_t)row * 512 + lane * 8) = wq;
    if (lat) { unpack8(wq, x); rope8(x, o, lane, c16, s16, prow, pcol); *(u32x4*)(Qdb + (size_t)rl * 512 + lane * 8) = pack8(o); }
    const u32x4 wk = *(const u32x4*)(r + 512 + lane * 8);
    if (lat) { unpack8(wk, x); rope8(x, o, lane, c16, s16, prow, pcol); *(u32x4*)(Kd + kr * 512 + lane * 8) = pack8(o); }
    else {
      unpack8(wk, x);
      *(f32x4*)(o_k + (size_t)row * 512 + lane * 8) = (f32x4){x[0], x[1], x[2], x[3]};
      *(f32x4*)(o_k + (size_t)row * 512 + lane * 8 + 4) = (f32x4){x[4], x[5], x[6], x[7]};
      *(u32x4*)(Kd + kr * 512 + lane * 8) = wk;
    }
    const u32x4 wv = *(const u32x4*)(r + 1024 + lane * 8);
    *(u32x4*)(Vd + kr * 512 + lane * 8) = wv;
    if (!lat) {
      unpack8(wv, x);
      *(f32x4*)(o_v + (size_t)row * 512 + lane * 8) = (f32x4){x[0], x[1], x[2], x[3]};
      *(f32x4*)(o_v + (size_t)row * 512 + lane * 8 + 4) = (f32x4){x[4], x[5], x[6], x[7]};
    }
    {
      const u32x2 w = *(const u32x2*)(r + 1536 + lane * 4);
      const float a0 = bflo(w[0]), a1 = bfhi(w[0]), a2 = bflo(w[1]), a3 = bfhi(w[1]);
      const float ss = wave_sum(a0 * a0 + a1 * a1 + a2 * a2 + a3 * a3);
      const float sc = rsqrtf(ss * (1.f / 256.f) + EPS);
      const f32x4 g = *(const f32x4*)(p.q_norm_g + lane * 4);
      *(u32x2*)(cqn + (size_t)row * 256 + lane * 4) = (u32x2){pack2(a0 * sc * g[0], a1 * sc * g[1]), pack2(a2 * sc * g[2], a3 * sc * g[3])};
    }
    {
      const unsigned w = *(const unsigned*)(r + 1792 + lane * 2);
      const float a0 = bflo(w), a1 = bfhi(w);
      const float ss = wave_sum(a0 * a0 + a1 * a1);
      const float sc = rsqrtf(ss * (1.f / 128.f) + EPS);
      const f32x2 g = *(const f32x2*)(p.kv_norm_g + lane * 2);
      const float y0 = a0 * sc * g[0], y1 = a1 * sc * g[1];
      if (!lat) *(f32x2*)(o_ckv + (size_t)row * 128 + lane * 2) = (f32x2){y0, y1};
      *(unsigned*)(ckvn + kr * 128 + lane * 2) = pack2(y0, y1);
    }
    {
      const int idx = lane & 31;
      const float xv = bf2f(r[1920 + idx]);
      float ov = xv;
      if (lat) {
        const int pos = (idx & 16) ? pcol : prow;
        const int f = idx & 7;
        const float y = __shfl_xor(xv, 8);
        const float cs = c8[pos * 8 + f], sn = s8[pos * 8 + f];
        ov = (idx & 8) ? (y * sn + xv * cs) : (xv * cs - y * sn);
      } else if (lane < 32) o_kr[(size_t)row * 32 + idx] = xv;
      const bf16_t ob = (bf16_t)(pack2(ov, ov) & 0xffff);
#pragma unroll
      for (int k = 0; k < 4; ++k) { const int hh = (lane >> 5) + 2 * k; Km[kr * 768 + hh * 96 + 64 + idx] = ob; }
    }
  }
}

template <int DQK, int DV>
DI void attn_core(const bf16_t* __restrict__ Qa, const bf16_t* __restrict__ Qb, int ldq, const bf16_t* __restrict__ Kp, int ldk, const bf16_t* __restrict__ Vp, int ldv,
                  int Tk, int n_a, float c  , char* smem, f32x16 (&o)[DV / 32]) {
  constexpr int KS = DQK * 2 + 16, VS = DV * 2 + 16, BUF = 64 * (KS + VS);
  constexpr int KCH = DQK / 8, VCH = DV / 8, NKC = 64 * KCH / 256, NVC = 64 * VCH / 256;
  constexpr int NS = DQK / 16, NDT = DV / 32;
  const int tid = threadIdx.x, lane = tid & 63, wid = tid >> 6, h = lane >> 5, ql = lane & 31;
  bf16x8 qf[NS];
  {
    const bf16_t* q = Qa + (size_t)(wid * 32 + ql) * ldq + h * 8;
#pragma unroll
    for (int s = 0; s < NS; ++s) qf[s] = *(const bf16x8*)(q + s * 16);
  }
#pragma unroll
  for (int dt = 0; dt < NDT; ++dt)
#pragma unroll
    for (int r = 0; r < 16; ++r) o[dt][r] = 0.f;
  float m_run = -INFINITY, l_run = 0.f;
  u32x4 rk[NKC], rv[NVC];
  const int nt = Tk >> 6, ta = n_a >> 6;
  unsigned koff[NKC], voff[NVC];
#pragma unroll
  for (int i = 0; i < NKC; ++i) { const int ch = tid + 256 * i, row = ch / KCH, kc = ch % KCH; koff[i] = (unsigned)(row * ldk + kc * 8); }
#pragma unroll
  for (int i = 0; i < NVC; ++i) { const int ch = tid + 256 * i, row = ch / VCH, vc = ch % VCH; voff[i] = (unsigned)(row * ldv + vc * 8); }
  auto gload = [&](int t) {
    const bf16_t* kb = Kp + (size_t)t * 64 * ldk;
    const bf16_t* vbp = Vp + (size_t)t * 64 * ldv;
#pragma unroll
    for (int i = 0; i < NKC; ++i) rk[i] = *(const u32x4*)(kb + koff[i]);
#pragma unroll
    for (int i = 0; i < NVC; ++i) rv[i] = *(const u32x4*)(vbp + voff[i]);
  };
  auto lstoreK = [&](char* buf) {
#pragma unroll
    for (int i = 0; i < NKC; ++i) { const int ch = tid + 256 * i, row = ch / KCH, kc = ch % KCH; *(u32x4*)(buf + row * KS + kc * 16) = rk[i]; }
  };
  auto lstoreV = [&](char* buf) {
#pragma unroll
    for (int i = 0; i < NVC; ++i) { const int ch = tid + 256 * i, row = ch / VCH, vc = ch % VCH; *(u32x4*)(buf + 64 * KS + row * VS + vc * 16) = rv[i]; }
  };
  gload(0); lstoreK(smem); lstoreV(smem); __syncthreads();
  const int i16 = lane & 15, tq = i16 >> 2, tp = i16 & 3, G = (lane >> 4) & 1;
  for (int t = 0; t < nt; ++t) {
    char* cur = smem + (t & 1) * BUF;
    const bool more = t + 1 < nt;
    if (more) gload(t + 1);
    if (t == ta) {
      const bf16_t* q = Qb + (size_t)(wid * 32 + ql) * ldq + h * 8;
#pragma unroll
      for (int s = 0; s < NS; ++s) qf[s] = *(const bf16x8*)(q + s * 16);
    }
    f32x16 st[2];
#pragma unroll
    for (int kt = 0; kt < 2; ++kt) {
#pragma unroll
      for (int r = 0; r < 16; ++r) st[kt][r] = 0.f;
#pragma unroll
      for (int s = 0; s < NS; ++s) {
        const bf16x8 kf = *(const bf16x8*)(cur + (kt * 32 + ql) * KS + s * 32 + h * 16);
        st[kt] = __builtin_amdgcn_mfma_f32_32x32x16_bf16(kf, qf[s], st[kt], 0, 0, 0);
      }
      __builtin_amdgcn_sched_barrier(0);
    }
    if (more) lstoreK(smem + ((t + 1) & 1) * BUF);
    float mx = st[0][0];
#pragma unroll
    for (int kt = 0; kt < 2; ++kt)
#pragma unroll
      for (int r = 0; r < 16; ++r) mx = fmaxf(mx, st[kt][r]);
    mx = fmaxf(mx, __shfl_xor(mx, 32));
    const float m_new = fmaxf(m_run, mx);
    const float alpha = __builtin_amdgcn_exp2f((m_run - m_new) * c);
    const float mc = m_new * c;
    m_run = m_new;
    float ls = 0.f;
#pragma unroll
    for (int kt = 0; kt < 2; ++kt)
#pragma unroll
      for (int r = 0; r < 16; ++r) { const float pv = __builtin_amdgcn_exp2f(st[kt][r] * c - mc); st[kt][r] = pv; ls += pv; }
    l_run = l_run * alpha + ls;
#pragma unroll
    for (int dt = 0; dt < NDT; ++dt)
#pragma unroll
      for (int r = 0; r < 16; ++r) o[dt][r] *= alpha;
    bf16x8 pf[2][2];
#pragma unroll
    for (int kt = 0; kt < 2; ++kt)
#pragma unroll
      for (int s2 = 0; s2 < 2; ++s2) {
        u32x4 w = {pack2(st[kt][8 * s2 + 0], st[kt][8 * s2 + 1]), pack2(st[kt][8 * s2 + 2], st[kt][8 * s2 + 3]), pack2(st[kt][8 * s2 + 4], st[kt][8 * s2 + 5]), pack2(st[kt][8 * s2 + 6], st[kt][8 * s2 + 7])};
        pf[kt][s2] = __builtin_bit_cast(bf16x8, w);
      }
    const char* vb = cur + 64 * KS + (4 * h + tq) * VS + 32 * G + 8 * tp;
#pragma unroll
    for (int kt = 0; kt < 2; ++kt)
#pragma unroll
      for (int s2 = 0; s2 < 2; ++s2) {
        bf16x8 vf[NDT];
#pragma unroll
        for (int dt = 0; dt < NDT; ++dt) {
          const char* a0 = vb + (kt * 32 + 16 * s2) * VS + dt * 64;
          const s16x4 lo = __builtin_amdgcn_ds_read_tr16_b64_v4i16((LDS_AS s16x4*)(a0));
          const s16x4 hi = __builtin_amdgcn_ds_read_tr16_b64_v4i16((LDS_AS s16x4*)(a0 + 8 * VS));
          vf[dt] = __builtin_shufflevector(lo, hi, 0, 1, 2, 3, 4, 5, 6, 7);
        }
#pragma unroll
        for (int dt = 0; dt < NDT; ++dt) o[dt] = __builtin_amdgcn_mfma_f32_32x32x16_bf16(vf[dt], pf[kt][s2], o[dt], 0, 0, 0);
        __builtin_amdgcn_sched_barrier(0);
      }
    if (more) lstoreV(smem + ((t + 1) & 1) * BUF);
    __syncthreads();
  }
  const float l = l_run + __shfl_xor(l_run, 32);
  const float inv = 1.f / l;
#pragma unroll
  for (int dt = 0; dt < NDT; ++dt)
#pragma unroll
    for (int r = 0; r < 16; ++r) o[dt][r] *= inv;
}

constexpr int U_DBIG = 256, U_MBIG = 512, U_DCTX = 128, U_MCTX = 256, U_TOTAL = U_DBIG + U_MBIG + U_DCTX + U_MCTX;

DI void phase_attn(const Params& p, char* smem, int cidx) {
  char* ws = p.ws;
  const bf16_t* Qda = (const bf16_t*)(ws + O_QDA); const bf16_t* Qdb = (const bf16_t*)(ws + O_QDB); const bf16_t* Kd = (const bf16_t*)(ws + O_KD); const bf16_t* Vd = (const bf16_t*)(ws + O_VD);
  const bf16_t* Qma = (const bf16_t*)(ws + O_QMA); const bf16_t* Qmb = (const bf16_t*)(ws + O_QMB); const bf16_t* Km = (const bf16_t*)(ws + O_KMLA); const bf16_t* Vm = (const bf16_t*)(ws + O_VMLA);
  bf16_t* cat = (bf16_t*)(ws + O_HB);
  float* otmp = (float*)(ws + O_OTMP) + (size_t)blockIdx.x * 16384;
  int* counter = (int*)(ws + O_CNT) + cidx;
  int* s_unit = (int*)(smem + 65532);
  const int tid = threadIdx.x, lane = tid & 63, wid = tid >> 6, h2 = lane >> 5, ql = lane & 31;
  const float lam = ((const float*)(ws + O_SCAL))[0];
  for (;;) {
    if (tid == 0) *s_unit = atomicAdd(counter, 1);
    __syncthreads();
    int u = __builtin_amdgcn_readfirstlane(*s_unit);
    __syncthreads();
    if (u >= U_TOTAL) break;
    bool diff; int qrow0, krow0, Tk, n_a, head; bool lat;
    if (u < U_DBIG) { diff = true; lat = true; const int b = u >> 7, hh = (u >> 5) & 3, qb = u & 31; head = hh; qrow0 = NCTX + b * TLAT + qb * 128; krow0 = NCTX + b * TKL; Tk = TKL; n_a = 256; }
    else if (u < U_DBIG + U_MBIG) { u -= U_DBIG; diff = false; lat = true; const int b = u >> 8, hh = (u >> 5) & 7, qb = u & 31; head = hh; qrow0 = NCTX + b * TLAT + qb * 128; krow0 = NCTX + b * TKL; Tk = TKL; n_a = 256; }
    else if (u < U_DBIG + U_MBIG + U_DCTX) { u -= U_DBIG + U_MBIG; diff = true; lat = false; const int sq = u >> 3, hh = (u >> 1) & 3, qb = u & 1; head = hh; qrow0 = sq * 256 + qb * 128; krow0 = sq * 256; Tk = 256; n_a = 256; }
    else { u -= U_DBIG + U_MBIG + U_DCTX; diff = false; lat = false; const int sq = u >> 4, hh = (u >> 1) & 7, qb = u & 1; head = hh; qrow0 = sq * 256 + qb * 128; krow0 = sq * 256; Tk = 256; n_a = 256; }
    const int qrowb = lat ? qrow0 - NCTX : 0;
    if (diff) {
      f32x16 o[4];
      const float c = 0.125f * 1.4426950408889634f;
#pragma unroll 1
      for (int m = 0; m < 2; ++m) {
        attn_core<64, 128>(Qda + (size_t)qrow0 * 512 + head * 128 + m * 64, Qdb + (size_t)qrowb * 512 + head * 128 + m * 64, 512,
                           Kd + (size_t)krow0 * 512 + head * 128 + m * 64, 512, Vd + (size_t)krow0 * 512 + head * 128, 512, Tk, n_a, c, smem, o);
        if (m == 0) {
#pragma unroll
          for (int dt = 0; dt < 4; ++dt)
#pragma unroll
            for (int rq = 0; rq < 4; ++rq) *(f32x4*)(otmp + tid * 64 + dt * 16 + rq * 4) = (f32x4){o[dt][4 * rq], o[dt][4 * rq + 1], o[dt][4 * rq + 2], o[dt][4 * rq + 3]};
        }
      }
      float ss = 0.f;
#pragma unroll
      for (int dt = 0; dt < 4; ++dt)
#pragma unroll
        for (int rq = 0; rq < 4; ++rq) {
          const f32x4 o0 = *(const f32x4*)(otmp + tid * 64 + dt * 16 + rq * 4);
#pragma unroll
          for (int e = 0; e < 4; ++e) { const float v = o0[e] - lam * o[dt][4 * rq + e]; o[dt][4 * rq + e] = v; ss += v * v; }
        }
      ss += __shfl_xor(ss, 32);
      const float sc = rsqrtf(ss * (1.f / 128.f) + EPS) * 0.8f;
      bf16_t* dst = cat + (size_t)(qrow0 + wid * 32 + ql) * 1024 + head * 128;
#pragma unroll
      for (int dt = 0; dt < 4; ++dt)
#pragma unroll
        for (int rq = 0; rq < 4; ++rq) {
          const int dv = dt * 32 + 8 * rq + 4 * h2;
          const f32x4 g = *(const f32x4*)(p.diff_norm_g + dv);
          u32x2 w = {pack2(o[dt][4 * rq] * sc * g[0], o[dt][4 * rq + 1] * sc * g[1]), pack2(o[dt][4 * rq + 2] * sc * g[2], o[dt][4 * rq + 3] * sc * g[3])};
          *(u32x2*)(dst + dv) = w;
        }
    } else {
      f32x16 o[2];
      const float c = 0.10206207261596575f * 1.4426950408889634f;
      attn_core<96, 64>(Qma + (size_t)qrow0 * 768 + head * 96, Qmb + (size_t)qrowb * 768 + head * 96, 768,
                        Km + (size_t)krow0 * 768 + head * 96, 768, Vm + (size_t)krow0 * 512 + head * 64, 512, Tk, n_a, c, smem, o);
      bf16_t* dst = cat + (size_t)(qrow0 + wid * 32 + ql) * 1024 + 512 + head * 64;
#pragma unroll
      for (int dt = 0; dt < 2; ++dt)
#pragma unroll
        for (int rq = 0; rq < 4; ++rq) {
          const int dv = dt * 32 + 8 * rq + 4 * h2;
          u32x2 w = {pack2(o[dt][4 * rq], o[dt][4 * rq + 1]), pack2(o[dt][4 * rq + 2], o[dt][4 * rq + 3])};
          *(u32x2*)(dst + dv) = w;
        }
    }
  }
}

DI void phase_conv(const Params& p, char* smem) {
  char* ws = p.ws;
  const bf16_t* Ug = (const bf16_t*)(ws + O_UG); const bf16_t* Pz = (const bf16_t*)(ws + O_PZ);
  bf16_t* cat = (bf16_t*)(ws + O_HB);
  float* tile = (float*)smem;
  const int tid = threadIdx.x, lane = tid & 63, wid = tid >> 6;
  for (int u = blockIdx.x; u < NTOK / 16; u += gridDim.x) {
    const int t0 = u * 16;
    const int s0 = t0 < NCTX ? (t0 & ~255) : NCTX + ((t0 - NCTX) & ~(TLAT - 1));
    const int s1 = t0 < NCTX ? s0 + 256 : s0 + TLAT;
    {
      const int ch = tid * 2;
      float a0[16], a1[16];
#pragma unroll
      for (int o = 0; o < 16; ++o) { a0[o] = 0.f; a1[o] = 0.f; }
      f32x2 w[31];
#pragma unroll
      for (int j = 0; j < 31; ++j) w[j] = *(const f32x2*)(p.conv_w + j * 512 + ch);
#pragma unroll
      for (int i = 0; i < 46; ++i) {
        const int r = t0 - 15 + i;
        float u0 = 0.f, u1 = 0.f;
        if (r >= s0 && r < s1) { const unsigned v = *(const unsigned*)(Ug + (size_t)r * 512 + ch); u0 = bflo(v); u1 = bfhi(v); }
#pragma unroll
        for (int o = 0; o < 16; ++o) {
          const int j = i - o;
          if (j >= 0 && j <= 30) { a0[o] += u0 * w[j][0]; a1[o] += u1 * w[j][1]; }
        }
      }
      const f32x2 bias = *(const f32x2*)(p.conv_b + ch);
#pragma unroll
      for (int o = 0; o < 16; ++o) *(f32x2*)(tile + o * 512 + ch) = (f32x2){a0[o] + bias[0], a1[o] + bias[1]};
    }
    __syncthreads();
#pragma unroll 1
    for (int k = 0; k < 4; ++k) {
      const int o = wid * 4 + k, row = t0 + o;
      const f32x4 v0 = *(const f32x4*)(tile + o * 512 + lane * 4), v1 = *(const f32x4*)(tile + o * 512 + 256 + lane * 4);
      const float mean = wave_sum((v0[0] + v0[1]) + (v0[2] + v0[3]) + (v1[0] + v1[1]) + (v1[2] + v1[3])) * (1.f / 512.f);
      float q = 0.f;
#pragma unroll
      for (int e = 0; e < 4; ++e) { const float d0 = v0[e] - mean, d1 = v1[e] - mean; q += d0 * d0 + d1 * d1; }
      const float rstd = rsqrtf(wave_sum(q) * (1.f / 512.f) + EPS);
#pragma unroll
      for (int hlf = 0; hlf < 2; ++hlf) {
        const int col = hlf * 256 + lane * 4;
        const f32x4 v = hlf ? v1 : v0;
        const f32x4 g = *(const f32x4*)(p.conv_norm_g + col), bb = *(const f32x4*)(p.conv_norm_b + col);
        float y[4];
#pragma unroll
        for (int e = 0; e < 4; ++e) { const float z = (v[e] - mean) * rstd * g[e] + bb[e]; y[e] = z / (1.f + __expf(-z)); }
        *(u32x2*)(cat + (size_t)row * 1024 + col) = (u32x2){pack2(y[0], y[1]), pack2(y[2], y[3])};
      }
    }
    {
      const int ch = tid * 2, hw = 1 << wid;
#pragma unroll 1
      for (int o = 0; o < 16; ++o) {
        const int r = t0 + o;
        const int lo = max(r - hw, s0), hi = min(r + hw - 1, s1 - 1);
        float a0 = 0.f, a1 = 0.f;
        for (int q = lo; q <= hi; ++q) { const unsigned v = *(const unsigned*)(Pz + (size_t)q * 512 + ch); a0 += bflo(v); a1 += bfhi(v); }
        const unsigned vc = *(const unsigned*)(Pz + (size_t)r * 512 + ch);
        const float ic = 1.f / (float)(hi - lo + 1);
        *(unsigned*)(cat + (size_t)r * 1024 + 512 + ch) = pack2(a0 * ic - bflo(vc), a1 * ic - bfhi(vc));
      }
    }
    __syncthreads();
  }
}

__global__ void __launch_bounds__(256, 2) fwd_kernel(Params p, int ph_lo, int ph_hi) {
  __shared__ __attribute__((aligned(16))) char smem[65536];
  __shared__ uint4 xb_words;
  cg::grid_group grid = cg::this_grid();
  char* ws = p.ws;
  if (threadIdx.x == 0) xb_words = make_uint4(0u, 0u, 0u, 0u);
  __syncthreads();
  const XcdBarrier xb = xcd_barrier_post((unsigned*)(ws + O_BAR), (volatile LDS_AS unsigned*)&xb_words);
  if (ph_lo > 1000) grid.sync();
  float* mods = (float*)(ws + O_MODS);
  bf16_t* Hb = (bf16_t*)(ws + O_HB);
  float* X = p.out;
#define GSYNC() xcd_barrier(xb)
#define PH_BEGIN(n) if (ph_lo <= n && n < ph_hi) { if (n > ph_lo) GSYNC();
#define PH_END }
#ifndef PROBE_DUP
#define PROBE_DUP 0
#endif
#ifndef PROBE_SYNCS
#define PROBE_SYNCS 0
#endif
#define DUP(n, ...) __VA_ARGS__; if ((PROBE_DUP >> n) & 1) { GSYNC(); __VA_ARGS__; }
  for (int i = 0; i < PROBE_SYNCS; ++i) GSYNC();
  PH_BEGIN(0) { DUP(0, phase0(p, smem)); } PH_END
  PH_BEGIN(1) { DUP(1, rows_phase(p.x_prompt, p.x_sample, false, nullptr, nullptr, nullptr, mods, 0, 1024, Hb)); } PH_END
  PH_BEGIN(2) { DUP(2, gemm_phase(Hb, 1024, (const bf16_t*)(ws + O_WATTIN), 1024, 1024, 96, 16, EpiRaw{(bf16_t*)(ws + O_R)}, smem)); } PH_END
  PH_BEGIN(3) { DUP(3, phase3(p)); } PH_END
  PH_BEGIN(4) {
        const int n1 = 96 * 6, n2 = 100 * 8;
        gemm_phase((const bf16_t*)(ws + O_CQN), 256, (const bf16_t*)(ws + O_WUQ), 256, 256, 96, 6,
                   EpiUq{(bf16_t*)(ws + O_QMA), (bf16_t*)(ws + O_QMB), (const float*)(ws + O_C8), (const float*)(ws + O_S8)}, smem, 0, n1 + n2);
        gemm_phase((const bf16_t*)(ws + O_CKVN), 128, (const bf16_t*)(ws + O_WUKV), 128, 128, 100, 8,
                   EpiUkv{(bf16_t*)(ws + O_KMLA), (bf16_t*)(ws + O_VMLA)}, smem, n1, n1 + n2);
  } PH_END
  PH_BEGIN(5) { phase_attn(p, smem, 0); if ((PROBE_DUP >> 5) & 1) { GSYNC(); phase_attn(p, smem, 1); } } PH_END
  PH_BEGIN(6) { DUP(6, gemm_phase(Hb, 1024, (const bf16_t*)(ws + O_WATTOUT), 1024, 1024, 96, 8, EpiRes{p.x_prompt, p.x_sample, mods + 2048, X}, smem)); } PH_END
  PH_BEGIN(7) { rows_phase(X, X + (size_t)NCTX * 1024, true, p.ln_mix_g, p.ln_mix_b, X, mods, 3072, 4096, Hb); } PH_END
  PH_BEGIN(8) { DUP(8, gemm_phase(Hb, 1024, (const bf16_t*)(ws + O_WMLPIN), 1024, 1024, 96, 32, EpiRelu2{(bf16_t*)(ws + O_U)}, smem)); } PH_END
  PH_BEGIN(9) { gemm_phase((const bf16_t*)(ws + O_U), 4096, (const bf16_t*)(ws + O_WMLPOUT), 4096, 4096, 96, 8, EpiRes{X, X + (size_t)NCTX * 1024, mods + 5120, X}, smem); } PH_END
  PH_BEGIN(10) { rows_phase(X, X + (size_t)NCTX * 1024, true, p.ln_mlp_g, p.ln_mlp_b, X, mods + 3 * 6144, 0, 1024, Hb); } PH_END
  PH_BEGIN(11) { DUP(11, gemm_phase(Hb, 1024, (const bf16_t*)(ws + O_WCONVIN), 1024, 1024, 96, 12, EpiConv{(bf16_t*)(ws + O_UG), (bf16_t*)(ws + O_PZ)}, smem)); } PH_END
  PH_BEGIN(12) { DUP(12, phase_conv(p, smem)); } PH_END
  PH_BEGIN(13) { gemm_phase(Hb, 1024, (const bf16_t*)(ws + O_WCONVOUT), 1024, 1024, 96, 8, EpiRes{X, X + (size_t)NCTX * 1024, mods + 3 * 6144 + 2048, X}, smem); } PH_END
  PH_BEGIN(14) { rows_phase(X, X + (size_t)NCTX * 1024, true, p.ln_mix_g + 1024, p.ln_mix_b + 1024, X, mods + 3 * 6144, 3072, 4096, Hb); } PH_END
  PH_BEGIN(15) { DUP(15, gemm_phase(Hb, 1024, (const bf16_t*)(ws + O_WMLPIN) + (size_t)4096 * 1024, 1024, 1024, 96, 32, EpiRelu2{(bf16_t*)(ws + O_U)}, smem)); } PH_END
  PH_BEGIN(16) { gemm_phase((const bf16_t*)(ws + O_U), 4096, (const bf16_t*)(ws + O_WMLPOUT) + (size_t)4096 * 1024, 4096, 4096, 96, 8, EpiRes{X, X + (size_t)NCTX * 1024, mods + 3 * 6144 + 5120, X}, smem); } PH_END
  PH_BEGIN(17) { rows_phase(X, X + (size_t)NCTX * 1024, true, p.ln_mlp_g + 1024, p.ln_mlp_b + 1024, X, nullptr, 0, 0, nullptr); } PH_END

}

extern "C" void kernel_launch(void* const* d_in, const int* in_sizes, int n_in, void* d_out, int out_size, void* d_ws, size_t ws_size, hipStream_t stream) {
  static int grid_blocks = 0;
  if (!grid_blocks) {
    int dev = 0, cus = 0, per_cu = 0;
    hipGetDevice(&dev);
    hipDeviceGetAttribute(&cus, hipDeviceAttributeMultiprocessorCount, dev);
    hipOccupancyMaxActiveBlocksPerMultiprocessor(&per_cu, fwd_kernel, 256, 0);
    if (per_cu > 2) per_cu = 2;
    if (per_cu < 1) per_cu = 1;
    grid_blocks = cus * per_cu;
    if (grid_blocks > 512) grid_blocks = 512;
  }
  if (ws_size < WS_NEED) { fprintf(stderr, "workspace too small: %zu < %zu\n", ws_size, (size_t)WS_NEED); return; }
  Params p{};
  const float** f = (const float**)&p;
  for (int i = 0; i < 35; ++i) f[i] = (const float*)d_in[i];
  p.out = (float*)d_out;
  p.ws = (char*)d_ws;
  hipMemsetAsync(d_ws, 0, 16384, stream);
  int lo = 0, hi = NPHASE;
  void* args[] = {&p, &lo, &hi};
  hipError_t e = hipLaunchCooperativeKernel((void*)fwd_kernel, dim3(grid_blocks), dim3(256), args, 0, stream);
  if (e != hipSuccess) fprintf(stderr, "cooperative launch failed: %s (grid %d)\n", hipGetErrorString(e), grid_blocks);
}
```

```cpp
#include <hip/hip_runtime.h>
#include <hip/hip_cooperative_groups.h>
#include <cstdio>
#include <cstdint>
namespace cg = cooperative_groups;

typedef unsigned short bf16_t;
typedef short bf16x8 __attribute__((ext_vector_type(8)));
typedef short s16x4 __attribute__((ext_vector_type(4)));
typedef float f32x4 __attribute__((ext_vector_type(4)));
typedef float f32x2 __attribute__((ext_vector_type(2)));
typedef float f32x16 __attribute__((ext_vector_type(16)));
typedef unsigned u32x4 __attribute__((ext_vector_type(4)));
typedef unsigned u32x2 __attribute__((ext_vector_type(2)));
typedef __bf16 bf16v2 __attribute__((ext_vector_type(2)));
#define DI __device__ __forceinline__
#define LDS_AS __attribute__((address_space(3)))

constexpr int NTOK = 12288, NCTX = 4096, NKEY = 12800, TLAT = 4096, TKL = 4352;
constexpr int RLD = 1952;
constexpr float ALPHA = 1.41421356237f, EPS = 1e-5f;
constexpr int NPHASE = 18;
constexpr int NT = 512, NWAVE = 8;

constexpr size_t al(size_t x) { return (x + 255) & ~(size_t)255; }
constexpr size_t O_CNT = 0;
constexpr size_t O_BAR = 256;
constexpr size_t O_MODS = 16384;
constexpr size_t O_SCAL = O_MODS + al(2 * 3 * 6144 * 4);
constexpr size_t O_C16 = O_SCAL + 256;
constexpr size_t O_S16 = O_C16 + 4096;
constexpr size_t O_C8 = O_S16 + 4096;
constexpr size_t O_S8 = O_C8 + 2048;
constexpr size_t O_WATTIN = O_S8 + 2048;
constexpr size_t O_WUQ = O_WATTIN + (size_t)2048 * 1024 * 2;
constexpr size_t O_WUKV = O_WUQ + (size_t)768 * 256 * 2;
constexpr size_t O_WATTOUT = O_WUKV + (size_t)1024 * 128 * 2;
constexpr size_t O_WMLPIN = O_WATTOUT + (size_t)1024 * 1024 * 2;
constexpr size_t O_WMLPOUT = O_WMLPIN + (size_t)2 * 4096 * 1024 * 2;
constexpr size_t O_WCONVIN = O_WMLPOUT + (size_t)2 * 4096 * 1024 * 2;
constexpr size_t O_WCONVOUT = O_WCONVIN + (size_t)1536 * 1024 * 2;
constexpr size_t O_HB = O_WCONVOUT + (size_t)1024 * 1024 * 2;
constexpr size_t O_BIG = O_HB + (size_t)NTOK * 1024 * 2;
constexpr size_t O_R = O_BIG;
constexpr size_t O_QMA = O_R;
constexpr size_t O_QMB = O_QMA + (size_t)NTOK * 768 * 2;
constexpr size_t O_QDA = O_R + al((size_t)NTOK * RLD * 2);
constexpr size_t O_QDB = O_QDA + (size_t)NTOK * 512 * 2;
constexpr size_t O_KD = O_QDB + (size_t)8192 * 512 * 2;
constexpr size_t O_VD = O_KD + (size_t)NKEY * 512 * 2;
constexpr size_t O_CQN = O_VD + (size_t)NKEY * 512 * 2;
constexpr size_t O_CKVN = O_CQN + (size_t)NTOK * 256 * 2;
constexpr size_t O_KMLA = O_CKVN + (size_t)NKEY * 128 * 2;
constexpr size_t O_VMLA = O_KMLA + (size_t)NKEY * 768 * 2;
constexpr size_t O_OTMP = O_VMLA + (size_t)NKEY * 512 * 2;
constexpr size_t O_ATT_END = O_OTMP + (size_t)512 * 16384 * 4;
constexpr size_t O_U = O_BIG;
constexpr size_t O_U_END = O_U + (size_t)NTOK * 4096 * 2;
constexpr size_t O_UG = O_BIG;
constexpr size_t O_PZ = O_UG + (size_t)NTOK * 512 * 2;
constexpr size_t WS_NEED = (O_ATT_END > O_U_END ? O_ATT_END : O_U_END);
static_assert(O_QMB + (size_t)8192 * 768 * 2 <= O_QDA, "Qm overlay must fit in R");
static_assert(WS_NEED <= (size_t)256 * 1024 * 1024, "workspace too large");

struct Params {
  const float *x_prompt, *x_sample, *cache_k, *cache_v, *cache_ckv, *cache_krope, *c, *c_ctx;
  const float *w_ada, *b_ada, *ln_mix_g, *ln_mix_b, *ln_mlp_g, *ln_mlp_b, *w_mlp_in, *w_mlp_out;
  const float *w_att_in, *w_uq, *w_ukv, *q_norm_g, *kv_norm_g, *lam_q1, *lam_k1, *lam_q2, *lam_k2, *diff_norm_g, *w_att_out;
  const float *w_conv_in, *conv_w, *conv_b, *conv_norm_g, *conv_norm_b, *w_pool, *pool_scale, *w_conv_out;
  float* out;
  char* ws;
};

DI unsigned pack2(float lo, float hi) { f32x2 v = {lo, hi}; bf16v2 b = __builtin_convertvector(v, bf16v2); return __builtin_bit_cast(unsigned, b); }
DI float bf2f(unsigned short u) { return __uint_as_float((unsigned)u << 16); }
DI float bflo(unsigned u) { return __uint_as_float(u << 16); }
DI float bfhi(unsigned u) { return __uint_as_float(u & 0xffff0000u); }
DI float wave_sum(float v) {
#pragma unroll
  for (int o = 32; o >= 1; o >>= 1) v += __shfl_xor(v, o);
  return v;
}
DI int cond_idx(int row) { return row < NCTX ? 0 : 1 + ((row - NCTX) >> 12); }


#define XB_TMO      128
#define XB_XCNT(j)  (256  + 64 * (j))
#define XB_XSUB(j)  (1280 + 64 * (j))
#define XB_XGEN(j)  (2304 + 64 * (j))
#define XB_TOP      3328
#define XB_TOPGEN   3392
#define XCD_BAR_WORDS 3456
#define XB_SPIN_CAP (1u << 18)
DI unsigned xb_ld(unsigned* p)              { return __hip_atomic_load(p, __ATOMIC_RELAXED, __HIP_MEMORY_SCOPE_AGENT); }
DI unsigned xb_add(unsigned* p, unsigned v) { return __hip_atomic_fetch_add(p, v, __ATOMIC_RELAXED, __HIP_MEMORY_SCOPE_AGENT); }
DI unsigned xb_xcc_id() { return (unsigned)__builtin_amdgcn_s_getreg((3 << 11) | 20) & 0xFu; }
#define XB_SPIN(cond, bar) do { unsigned _sp = 0; while (cond) { __builtin_amdgcn_s_sleep(1); \
    if ((++_sp & 255u) == 0u) { if (xb_ld(&(bar)[XB_TMO])) break; if (_sp > XB_SPIN_CAP) { atomicAdd(&(bar)[XB_TMO], 1u); break; } } } } while (0)
struct XcdBarrier { unsigned* bar; unsigned x; volatile LDS_AS unsigned* st; };
DI XcdBarrier xcd_barrier_post(unsigned* bar, volatile LDS_AS unsigned* st) {
  XcdBarrier b; b.bar = bar; b.x = xb_xcc_id(); b.st = st;
  if (threadIdx.x == 0) (void)xb_add(&bar[XB_XCNT(b.x)], 1u);
  return b;
}
DI void xcd_barrier_complete(unsigned* bar, unsigned x, unsigned& nloc, unsigned& nx) {
  const unsigned G = gridDim.x * gridDim.y * gridDim.z;
  unsigned sum, cnt, mine, sp = 0u;
  for (;;) {
    sum = 0u; cnt = 0u; mine = 0u;
#pragma unroll
    for (unsigned j = 0; j < 16; ++j) { const unsigned c = xb_ld(&bar[XB_XCNT(j)]); sum += c; cnt += (c > 0u) ? 1u : 0u; mine = (j == x) ? c : mine; }
    if (sum == G) break;
    __builtin_amdgcn_s_sleep(1);
    if ((++sp & 255u) == 0u) { if (xb_ld(&bar[XB_TMO])) break; if (sp > XB_SPIN_CAP) { atomicAdd(&bar[XB_TMO], 1u); break; } }
  }
  nloc = mine > 0u ? mine : 1u; nx = cnt > 0u ? cnt : 1u;
}
DI void xcd_barrier(const XcdBarrier& b) {
  asm volatile("s_waitcnt vmcnt(0)" ::: "memory");
  __syncthreads();
  if (threadIdx.x == 0) {
    unsigned* bar = b.bar;
    __builtin_amdgcn_s_waitcnt(0);
    unsigned nloc = b.st[0], nx = b.st[1];
    if (nloc == 0u) { xcd_barrier_complete(bar, b.x, nloc, nx); b.st[0] = nloc; b.st[1] = nx; }
    const unsigned old = xb_add(&bar[XB_XSUB(b.x)], 1u);
    const unsigned gen = old / nloc;
    if (old + 1u == (gen + 1u) * nloc) {
      __builtin_amdgcn_fence(__ATOMIC_RELEASE, "agent");
      asm volatile("s_waitcnt vmcnt(0)" ::: "memory");
      const unsigned og = xb_add(&bar[XB_TOP], 1u);
      const unsigned tg = og / nx;
      if (og + 1u == (tg + 1u) * nx) xb_add(&bar[XB_TOPGEN], 1u);
      else XB_SPIN(xb_ld(&bar[XB_TOPGEN]) == tg, bar);
      __builtin_amdgcn_fence(__ATOMIC_ACQUIRE, "agent");
      xb_add(&bar[XB_XGEN(b.x)], 1u);
      asm volatile("s_waitcnt vmcnt(0)" ::: "memory");
    } else {
      XB_SPIN(xb_ld(&bar[XB_XGEN(b.x)]) == gen, bar);
      __builtin_amdgcn_fence(__ATOMIC_ACQUIRE, "agent");
      asm volatile("s_waitcnt vmcnt(0)" ::: "memory");
    }
  }
  __syncthreads();
}

DI int swz(int row, int kc) { return row * 128 + ((kc ^ ((row >> 1) & 7)) << 4); }

constexpr int G_BM = 192, G_BN = 256, G_MI = 6, G_NJ = 4, G_ABYTES = G_BM * 128, G_STAGE = G_ABYTES + G_BN * 128;
template <class Epi>
DI void gemm_tile(const bf16_t* __restrict__ A, int lda, const bf16_t* __restrict__ Bt, int ldb, int K, int row0, int col0, char* smem, const Epi& epi) {
  const int tid = threadIdx.x, lane = tid & 63, wid = tid >> 6, wr = wid >> 2, wc = wid & 3;
  const int fr = lane & 15, fq = lane >> 4;
  f32x4 acc[G_MI][G_NJ];
#pragma unroll
  for (int i = 0; i < G_MI; ++i)
#pragma unroll
    for (int j = 0; j < G_NJ; ++j) acc[i][j] = (f32x4){0.f, 0.f, 0.f, 0.f};
  const int srow = tid >> 3, skc = tid & 7;
  const bf16_t* ga = A + (size_t)(row0 + srow) * lda + skc * 8;
  const bf16_t* gb = Bt + (size_t)(col0 + srow) * ldb + skc * 8;
  const int soff = swz(srow, skc);
  u32x4 ra[3], rb[4];
  const int nk = K >> 6;
#pragma unroll
  for (int i = 0; i < 3; ++i) ra[i] = *(const u32x4*)(ga + (size_t)(64 * i) * lda);
#pragma unroll
  for (int i = 0; i < 4; ++i) rb[i] = *(const u32x4*)(gb + (size_t)(64 * i) * ldb);
#pragma unroll
  for (int i = 0; i < 3; ++i) *(u32x4*)(smem + soff + i * 8192) = ra[i];
#pragma unroll
  for (int i = 0; i < 4; ++i) *(u32x4*)(smem + G_ABYTES + soff + i * 8192) = rb[i];
  __syncthreads();
  for (int kt = 0; kt < nk; ++kt) {
    char* cur = smem + (kt & 1) * G_STAGE;
    const bool more = (kt + 1 < nk);
    if (more) {
      const int k0 = (kt + 1) << 6;
#pragma unroll
      for (int i = 0; i < 3; ++i) ra[i] = *(const u32x4*)(ga + (size_t)(64 * i) * lda + k0);
#pragma unroll
      for (int i = 0; i < 4; ++i) rb[i] = *(const u32x4*)(gb + (size_t)(64 * i) * ldb + k0);
    }
#pragma unroll
    for (int s = 0; s < 2; ++s) {
      bf16x8 af[G_MI], bfr[G_NJ];
#pragma unroll
      for (int i = 0; i < G_MI; ++i) af[i] = *(const bf16x8*)(cur + swz(wr * 96 + i * 16 + fr, s * 4 + fq));
#pragma unroll
      for (int j = 0; j < G_NJ; ++j) bfr[j] = *(const bf16x8*)(cur + G_ABYTES + swz(wc * 64 + j * 16 + fr, s * 4 + fq));
#pragma unroll
      for (int i = 0; i < G_MI; ++i)
#pragma unroll
        for (int j = 0; j < G_NJ; ++j) acc[i][j] = __builtin_amdgcn_mfma_f32_16x16x32_bf16(bfr[j], af[i], acc[i][j], 0, 0, 0);
    }
    if (more) {
      char* nxt = smem + ((kt + 1) & 1) * G_STAGE;
#pragma unroll
      for (int i = 0; i < 3; ++i) *(u32x4*)(nxt + soff + i * 8192) = ra[i];
#pragma unroll
      for (int i = 0; i < 4; ++i) *(u32x4*)(nxt + G_ABYTES + soff + i * 8192) = rb[i];
    }
    __syncthreads();
  }
  epi(acc, row0 + wr * 96, col0 + wc * 64, lane);
}


struct EpiRaw {
  bf16_t* R;
  DI void operator()(f32x4 (&acc)[G_MI][G_NJ], int rbase, int cbase, int lane) const {
    const int fr = lane & 15, fq = lane >> 4;
#pragma unroll
    for (int i = 0; i < G_MI; ++i)
#pragma unroll
      for (int j = 0; j < G_NJ; ++j) {
        const int row = rbase + i * 16 + fr, col = cbase + j * 16 + fq * 4;
        if (col < RLD) { u32x2 w = {pack2(acc[i][j][0], acc[i][j][1]), pack2(acc[i][j][2], acc[i][j][3])}; *(u32x2*)(R + (size_t)row * RLD + col) = w; }
      }
  }
};

struct EpiUq {
  bf16_t *Qa, *Qb; const float *c8, *s8;
  DI void operator()(f32x4 (&acc)[G_MI][G_NJ], int rbase, int cbase, int lane) const {
    const int fr = lane & 15, fq = lane >> 4;
#pragma unroll
    for (int i = 0; i < G_MI; ++i) {
      const bool lat = (rbase + i * 16) >= NCTX;
      const int row = rbase + i * 16 + fr;
      const int t = (row - NCTX) & (TLAT - 1);
#pragma unroll
      for (int j = 0; j < G_NJ; ++j) {
        const int cf = cbase + j * 16, col = cf + fq * 4;
        f32x4 v = acc[i][j];
        u32x2 w = {pack2(v[0], v[1]), pack2(v[2], v[3])};
        *(u32x2*)(Qa + (size_t)row * 768 + col) = w;
        if (lat) {
          const int w96 = cf % 96;
          if (w96 >= 64) {
            const int pos = (w96 == 64) ? (t >> 6) : (t & 63);
            f32x4 o;
#pragma unroll
            for (int e = 0; e < 4; ++e) {
              const float pv = __shfl_xor(v[e], 32);
              const int f = (fq & 1) * 4 + e;
              const float cs = c8[pos * 8 + f], sn = s8[pos * 8 + f];
              o[e] = (fq < 2) ? (v[e] * cs - pv * sn) : (pv * sn + v[e] * cs);
            }
            w = (u32x2){pack2(o[0], o[1]), pack2(o[2], o[3])};
          }
          *(u32x2*)(Qb + (size_t)(row - NCTX) * 768 + col) = w;
        }
      }
    }
  }
};

struct EpiUkv {
  bf16_t *Km, *Vm;
  DI void operator()(f32x4 (&acc)[G_MI][G_NJ], int rbase, int cbase, int lane) const {
    const int fr = lane & 15, fq = lane >> 4;
    const int h = cbase >> 7, part = (cbase >> 6) & 1;
#pragma unroll
    for (int i = 0; i < G_MI; ++i) {
      if (rbase + i * 16 >= NKEY) continue;
#pragma unroll
      for (int j = 0; j < G_NJ; ++j) {
        const int row = rbase + i * 16 + fr, c = j * 16 + fq * 4;
        u32x2 w = {pack2(acc[i][j][0], acc[i][j][1]), pack2(acc[i][j][2], acc[i][j][3])};
        if (part == 0) *(u32x2*)(Km + (size_t)row * 768 + h * 96 + c) = w;
        else *(u32x2*)(Vm + (size_t)row * 512 + h * 64 + c) = w;
      }
    }
  }
};

struct EpiRes {
  const float *xin_ctx, *xin_lat, *gate  ; float* X;
  DI void operator()(f32x4 (&acc)[G_MI][G_NJ], int rbase, int cbase, int lane) const {
    const int fr = lane & 15, fq = lane >> 4;
#pragma unroll
    for (int i = 0; i < G_MI; ++i) {
      const int row = rbase + i * 16 + fr;
      const float* g = gate + cond_idx(rbase + i * 16) * 6144;
      const float* xin = row < NCTX ? xin_ctx + (size_t)row * 1024 : xin_lat + (size_t)(row - NCTX) * 1024;
#pragma unroll
      for (int j = 0; j < G_NJ; ++j) {
        const int col = cbase + j * 16 + fq * 4;
        const f32x4 xv = *(const f32x4*)(xin + col), gv = *(const f32x4*)(g + col);
        f32x4 z;
#pragma unroll
        for (int e = 0; e < 4; ++e) z[e] = ALPHA * xv[e] + gv[e] * acc[i][j][e];
        *(f32x4*)(X + (size_t)row * 1024 + col) = z;
      }
    }
  }
};

struct EpiRelu2 {
  bf16_t* U;
  DI void operator()(f32x4 (&acc)[G_MI][G_NJ], int rbase, int cbase, int lane) const {
    const int fr = lane & 15, fq = lane >> 4;
#pragma unroll
    for (int i = 0; i < G_MI; ++i)
#pragma unroll
      for (int j = 0; j < G_NJ; ++j) {
        const int row = rbase + i * 16 + fr, col = cbase + j * 16 + fq * 4;
        f32x4 v = acc[i][j];
#pragma unroll
        for (int e = 0; e < 4; ++e) { const float r = fmaxf(v[e], 0.f); v[e] = r * r; }
        u32x2 w = {pack2(v[0], v[1]), pack2(v[2], v[3])};
        *(u32x2*)(U + (size_t)row * 4096 + col) = w;
      }
  }
};

struct EpiConv {
  bf16_t *Ug, *Pz;
  DI void operator()(f32x4 (&acc)[G_MI][G_NJ], int rbase, int cbase, int lane) const {
    const int fr = lane & 15, fq = lane >> 4;
#pragma unroll
    for (int i = 0; i < G_MI; ++i) {
      const int row = rbase + i * 16 + fr;
      if (cbase < 1024) {
#pragma unroll
        for (int jp = 0; jp < 2; ++jp) {
          const f32x4 a = acc[i][2 * jp], gt = acc[i][2 * jp + 1];
          f32x4 u;
#pragma unroll
          for (int e = 0; e < 4; ++e) u[e] = a[e] / (1.f + __expf(-gt[e]));
          const int ch = ((cbase + 32 * jp) >> 5) * 16 + fq * 4;
          u32x2 w = {pack2(u[0], u[1]), pack2(u[2], u[3])};
          *(u32x2*)(Ug + (size_t)row * 512 + ch) = w;
        }
      } else {
#pragma unroll
        for (int j = 0; j < G_NJ; ++j) {
          const int col = cbase - 1024 + j * 16 + fq * 4;
          u32x2 w = {pack2(acc[i][j][0], acc[i][j][1]), pack2(acc[i][j][2], acc[i][j][3])};
          *(u32x2*)(Pz + (size_t)row * 512 + col) = w;
        }
      }
    }
  }
};

template <class Epi>
DI void gemm_phase(const bf16_t* A, int lda, const bf16_t* Bt, int ldb, int K, int mt, int nt, const Epi& epi, char* smem, int tstart = 0, int ttotal = -1) {
  const int n = mt * nt;
  if (ttotal < 0) ttotal = n;
  for (int t = blockIdx.x; t < ttotal; t += gridDim.x) {
    const int u = t - tstart;
    if (u < 0 || u >= n) continue;
    const int pm = u / nt, pn = u - pm * nt;
    gemm_tile(A, lda, Bt, ldb, K, pm * G_BM, pn * G_BN, smem, epi);
  }
}

DI void rows_phase(const float* src_ctx, const float* src_lat, bool do_ln, const float* lg, const float* lb, float* Xdst,
                   const float* modsL, int sh_off, int sc_off, bf16_t* Hb) {
  const int lane = threadIdx.x & 63, gw = blockIdx.x * NWAVE + (threadIdx.x >> 6), nw = gridDim.x * NWAVE;
  for (int row = gw; row < NTOK; row += nw) {
    const float* src = row < NCTX ? src_ctx + (size_t)row * 1024 : src_lat + (size_t)(row - NCTX) * 1024;
    f32x4 v[4];
#pragma unroll
    for (int i = 0; i < 4; ++i) v[i] = *(const f32x4*)(src + i * 256 + lane * 4);
    if (do_ln) {
      float s = 0.f;
#pragma unroll
      for (int i = 0; i < 4; ++i) s += (v[i][0] + v[i][1]) + (v[i][2] + v[i][3]);
      const float mean = wave_sum(s) * (1.f / 1024.f);
      float q = 0.f;
#pragma unroll
      for (int i = 0; i < 4; ++i)
#pragma unroll
        for (int e = 0; e < 4; ++e) { const float d = v[i][e] - mean; q += d * d; }
      const float rstd = rsqrtf(wave_sum(q) * (1.f / 1024.f) + EPS);
#pragma unroll
      for (int i = 0; i < 4; ++i) {
        const f32x4 g = *(const f32x4*)(lg + i * 256 + lane * 4), b = *(const f32x4*)(lb + i * 256 + lane * 4);
#pragma unroll
        for (int e = 0; e < 4; ++e) v[i][e] = (v[i][e] - mean) * rstd * g[e] + b[e];
        if (Xdst) *(f32x4*)(Xdst + (size_t)row * 1024 + i * 256 + lane * 4) = v[i];
      }
    }
    if (Hb) {
      const float* m = modsL + cond_idx(row) * 6144;
#pragma unroll
      for (int i = 0; i < 4; ++i) {
        const int col = i * 256 + lane * 4;
        const f32x4 sh = *(const f32x4*)(m + sh_off + col), sc = *(const f32x4*)(m + sc_off + col);
        f32x4 h;
#pragma unroll
        for (int e = 0; e < 4; ++e) h[e] = v[i][e] * (1.f + sc[e]) + sh[e];
        u32x2 w = {pack2(h[0], h[1]), pack2(h[2], h[3])};
        *(u32x2*)(Hb + (size_t)row * 1024 + col) = w;
      }
    }
  }
}

DI double sin_red(double r) {
  const double r2 = r * r; double t = -1.0 / 51090942171709440000.0;
  t = t * r2 + 1.0 / 121645100408832000.0; t = t * r2 - 1.0 / 355687428096000.0; t = t * r2 + 1.0 / 1307674368000.0; t = t * r2 - 1.0 / 6227020800.0;
  t = t * r2 + 1.0 / 39916800.0; t = t * r2 - 1.0 / 362880.0; t = t * r2 + 1.0 / 5040.0; t = t * r2 - 1.0 / 120.0; t = t * r2 + 1.0 / 6.0;
  return r * (1.0 - r2 * t);
}
DI double cos_red(double r) {
  const double r2 = r * r; double t = 1.0 / 1124000727777607680000.0;
  t = t * r2 - 1.0 / 2432902008176640000.0; t = t * r2 + 1.0 / 6402373705728000.0; t = t * r2 - 1.0 / 20922789888000.0; t = t * r2 + 1.0 / 87178291200.0;
  t = t * r2 - 1.0 / 479001600.0; t = t * r2 + 1.0 / 3628800.0; t = t * r2 - 1.0 / 40320.0; t = t * r2 + 1.0 / 720.0; t = t * r2 - 1.0 / 24.0; t = t * r2 + 0.5; t = t * r2 * -1.0 + 1.0;
  return t;
}

constexpr int J_MODS = 192, J_WEFF = 64, J_CACHE = 64, J_ROPE = 1, J_SLOW = J_MODS + J_WEFF + J_CACHE + J_ROPE;
constexpr int T_ATTIN = 16 * 16, T_UQ = 4 * 6, T_UKV = 2 * 8, T_ATTOUT = 16 * 8, T_MLPIN = 16 * 32, T_MLPOUT = 64 * 8, T_CONVIN = 16 * 12, T_CONVOUT = 8 * 8;
constexpr int J_TR = T_ATTIN + T_UQ + T_UKV + T_ATTOUT + 2 * T_MLPIN + 2 * T_MLPOUT + T_CONVIN + T_CONVOUT;

struct TJ { const float* src; bf16_t* dst; int N, nvalid, lddst, perm, kt, nt; };
DI TJ tr_decode(const Params& p, int j) {
  char* ws = p.ws;
  TJ t; t.perm = 0;
  if (j < T_ATTIN) { t.src = p.w_att_in; t.N = 1952; t.nvalid = 1952; t.dst = (bf16_t*)(ws + O_WATTIN); t.lddst = 1024; t.kt = j / 16; t.nt = j % 16; return t; }
  j -= T_ATTIN;
  if (j < T_UQ) { t.src = p.w_uq; t.N = 768; t.nvalid = 768; t.dst = (bf16_t*)(ws + O_WUQ); t.lddst = 256; t.kt = j / 6; t.nt = j % 6; return t; }
  j -= T_UQ;
  if (j < T_UKV) { t.src = p.w_ukv; t.N = 1024; t.nvalid = 1024; t.dst = (bf16_t*)(ws + O_WUKV); t.lddst = 128; t.kt = j / 8; t.nt = j % 8; return t; }
  j -= T_UKV;
  if (j < T_ATTOUT) { t.src = p.w_att_out; t.N = 1024; t.nvalid = 1024; t.dst = (bf16_t*)(ws + O_WATTOUT); t.lddst = 1024; t.kt = j / 8; t.nt = j % 8; return t; }
  j -= T_ATTOUT;
  if (j < 2 * T_MLPIN) { const int l = j / T_MLPIN, u = j % T_MLPIN; t.src = p.w_mlp_in + (size_t)l * 1024 * 4096; t.N = 4096; t.nvalid = 4096; t.dst = (bf16_t*)(ws + O_WMLPIN) + (size_t)l * 4096 * 1024; t.lddst = 1024; t.kt = u / 32; t.nt = u % 32; return t; }
  j -= 2 * T_MLPIN;
  if (j < 2 * T_MLPOUT) { const int l = j / T_MLPOUT, u = j % T_MLPOUT; t.src = p.w_mlp_out + (size_t)l * 4096 * 1024; t.N = 1024; t.nvalid = 1024; t.dst = (bf16_t*)(ws + O_WMLPOUT) + (size_t)l * 4096 * 1024; t.lddst = 4096; t.kt = u / 8; t.nt = u % 8; return t; }
  j -= 2 * T_MLPOUT;
  if (j < T_CONVIN) { t.src = p.w_conv_in; t.N = 1536; t.nvalid = 1536; t.dst = (bf16_t*)(ws + O_WCONVIN); t.lddst = 1024; t.perm = 1; t.kt = j / 12; t.nt = j % 12; return t; }
  j -= T_CONVIN;
  t.src = p.w_conv_out; t.N = 1024; t.nvalid = 1024; t.dst = (bf16_t*)(ws + O_WCONVOUT); t.lddst = 1024; t.kt = j / 8; t.nt = j % 8; return t;
}
DI void tr_load(const TJ& t, float (&v)[16]) {
  const int tid = threadIdx.x, n = tid & 127, kb = tid >> 7;
  const int gn = t.nt * 128 + n;
  const float* s = t.src + (size_t)(t.kt * 64 + kb) * t.N + gn;
#pragma unroll
  for (int i = 0; i < 16; ++i) v[i] = (gn < t.nvalid) ? s[(size_t)(4 * i) * t.N] : 0.f;
}

DI void phase0(const Params& p, char* smem) {
  const int tid = threadIdx.x, lane = tid & 63, wid = tid >> 6;
  char* ws = p.ws;
  for (int job = blockIdx.x; job < J_SLOW; job += gridDim.x) {
    int j = job;
    if (j < J_MODS) {
      const int l = j / 96, cc = j % 96;
      float* sc = (float*)smem;
      for (int i = tid; i < 3072; i += NT) { const int ci = i >> 10, k = i & 1023; const float x = ci == 0 ? p.c_ctx[k] : p.c[(ci - 1) * 1024 + k]; sc[i] = x / (1.f + __expf(-x)); }
      __syncthreads();
      const int kg = tid >> 6, cl = tid & 63;
      const float* w = p.w_ada + (size_t)l * 1024 * 6144 + cc * 64 + cl;
      float s0 = 0.f, s1 = 0.f, s2 = 0.f;
#pragma unroll 16
      for (int k = kg * 128; k < kg * 128 + 128; ++k) { const float wv = w[(size_t)k * 6144]; s0 += sc[k] * wv; s1 += sc[1024 + k] * wv; s2 += sc[2048 + k] * wv; }
      float* r = (float*)(smem + 12288);
      r[(kg * 3 + 0) * 64 + cl] = s0; r[(kg * 3 + 1) * 64 + cl] = s1; r[(kg * 3 + 2) * 64 + cl] = s2;
      __syncthreads();
      if (tid < 192) {
        const int ci = tid >> 6, c2 = tid & 63;
        float s = 0.f;
#pragma unroll
        for (int g = 0; g < 8; ++g) s += r[(g * 3 + ci) * 64 + c2];
        ((float*)(ws + O_MODS))[(size_t)(l * 3 + ci) * 6144 + cc * 64 + c2] = s + p.b_ada[l * 6144 + cc * 64 + c2];
      }
      __syncthreads();
      continue;
    }
    j -= J_MODS;
    if (j < J_WEFF) {
      const int g = j >> 4, cch = (j >> 1) & 7, nch = j & 1;
      float* wp = (float*)smem;
      for (int i = tid; i < 2048; i += NT) wp[i] = p.w_pool[(size_t)(g * 128 + cch * 16 + (i >> 7)) * 128 + (i & 127)];
      __syncthreads();
      const int n = nch * 512 + tid;
      float a[16];
#pragma unroll
      for (int c = 0; c < 16; ++c) a[c] = 0.f;
#pragma unroll 4
      for (int e = 0; e < 128; ++e) {
        const float wo = p.w_conv_out[(size_t)(512 + g * 128 + e) * 1024 + n] * p.pool_scale[g * 128 + e];
#pragma unroll
        for (int c = 0; c < 16; ++c) a[c] += wp[c * 128 + e] * wo;
      }
      bf16_t* d = (bf16_t*)(ws + O_WCONVOUT) + (size_t)n * 1024 + 512 + g * 128 + cch * 16;
      *(u32x4*)d = (u32x4){pack2(a[0], a[1]), pack2(a[2], a[3]), pack2(a[4], a[5]), pack2(a[6], a[7])};
      *(u32x4*)(d + 8) = (u32x4){pack2(a[8], a[9]), pack2(a[10], a[11]), pack2(a[12], a[13]), pack2(a[14], a[15])};
      __syncthreads();
      continue;
    }
    j -= J_WEFF;
    if (j < J_CACHE) {
      const int rr = j * 8 + wid, b = rr >> 8, t = rr & 255;
      const size_t kr = NCTX + (size_t)b * TKL + t;
      const f32x4 a0 = *(const f32x4*)(p.cache_k + (size_t)rr * 512 + lane * 8), a1 = *(const f32x4*)(p.cache_k + (size_t)rr * 512 + lane * 8 + 4);
      *(u32x4*)((bf16_t*)(ws + O_KD) + kr * 512 + lane * 8) = (u32x4){pack2(a0[0], a0[1]), pack2(a0[2], a0[3]), pack2(a1[0], a1[1]), pack2(a1[2], a1[3])};
      const f32x4 b0 = *(const f32x4*)(p.cache_v + (size_t)rr * 512 + lane * 8), b1 = *(const f32x4*)(p.cache_v + (size_t)rr * 512 + lane * 8 + 4);
      *(u32x4*)((bf16_t*)(ws + O_VD) + kr * 512 + lane * 8) = (u32x4){pack2(b0[0], b0[1]), pack2(b0[2], b0[3]), pack2(b1[0], b1[1]), pack2(b1[2], b1[3])};
      const f32x2 cv = *(const f32x2*)(p.cache_ckv + (size_t)rr * 128 + lane * 2);
      *(unsigned*)((bf16_t*)(ws + O_CKVN) + kr * 128 + lane * 2) = pack2(cv[0], cv[1]);
      const int idx = lane & 31;
      const float x = p.cache_krope[(size_t)rr * 32 + idx];
      const unsigned pk = pack2(x, x);
#pragma unroll
      for (int k = 0; k < 4; ++k) { const int hh = (lane >> 5) + 2 * k; ((bf16_t*)(ws + O_KMLA))[kr * 768 + hh * 96 + 64 + idx] = (bf16_t)(pk & 0xffff); }
      continue;
    }
    j -= J_CACHE;
    {
      float* c16 = (float*)(ws + O_C16); float* s16 = (float*)(ws + O_S16); float* c8 = (float*)(ws + O_C8); float* s8 = (float*)(ws + O_S8);
      for (int i = tid; i < 1024 + 512; i += NT) {
        int pos, f, half;
        if (i < 1024) { pos = i >> 4; f = i & 15; half = 16; } else { const int q = i - 1024; pos = q >> 3; f = q & 7; half = 8; }
        const float inv = (float)exp(-9.210340371976184 * (double)f / (double)half);
        const float angf = (float)pos * inv;
        const double ang = (double)angf;
        const double r = ang - 6.283185307179586 * rint(ang * 0.15915494309189535);
        const float cs = (float)cos_red(r), sn = (float)sin_red(r);
        if (i < 1024) { c16[i] = cs; s16[i] = sn; } else { c8[i - 1024] = cs; s8[i - 1024] = sn; }
      }
      if (wid == 0) {
        const float d1 = wave_sum(p.lam_q1[lane] * p.lam_k1[lane]), d2 = wave_sum(p.lam_q2[lane] * p.lam_k2[lane]);
        if (lane == 0) ((float*)(ws + O_SCAL))[0] = expf(d1) - expf(d2) + 0.2f;
      }
    }
  }
  {
    float* tile = (float*)smem;
    int j = (blockIdx.x + gridDim.x - (J_SLOW % gridDim.x)) % gridDim.x;
    float v[16];
    TJ cur;
    if (j < J_TR) { cur = tr_decode(p, j); tr_load(cur, v); }
    while (j < J_TR) {
      {
        const int n = tid & 127, kb = tid >> 7;
#pragma unroll
        for (int i = 0; i < 16; ++i) tile[(kb + 4 * i) * 129 + n] = v[i];
      }
      __syncthreads();
      const int jn = j + gridDim.x;
      TJ nxt = cur;
      if (jn < J_TR) { nxt = tr_decode(p, jn); tr_load(nxt, v); }
      {
        const int n = tid >> 2, ks = (tid & 3) * 16;
        int gn = cur.nt * 128 + n;
        if (cur.perm) { if (gn < 512) gn = 32 * (gn >> 4) + (gn & 15); else if (gn < 1024) { const int c = gn - 512; gn = 32 * (c >> 4) + 16 + (c & 15); } }
        unsigned w[8];
#pragma unroll
        for (int e = 0; e < 8; ++e) w[e] = pack2(tile[(ks + 2 * e) * 129 + n], tile[(ks + 2 * e + 1) * 129 + n]);
        bf16_t* d = cur.dst + (size_t)gn * cur.lddst + cur.kt * 64 + ks;
        *(u32x4*)d = (u32x4){w[0], w[1], w[2], w[3]};
        *(u32x4*)(d + 8) = (u32x4){w[4], w[5], w[6], w[7]};
      }
      __syncthreads();
      cur = nxt; j = jn;
    }
  }
}

DI void rope8(const float (&x)[8], float (&o)[8], int lane, const float* c16, const float* s16, int prow, int pcol) {
  const int L = lane & 7;
  const int pos = (L & 4) ? pcol : prow;
  const bool second = (L & 2) != 0;
  const int fb = (L & 1) * 8;
#pragma unroll
  for (int e = 0; e < 8; ++e) {
    const float y = __shfl_xor(x[e], 2);
    const float cs = c16[pos * 16 + fb + e], sn = s16[pos * 16 + fb + e];
    o[e] = second ? (y * sn + x[e] * cs) : (x[e] * cs - y * sn);
  }
}
DI void unpack8(const u32x4 w, float (&x)[8]) {
#pragma unroll
  for (int e = 0; e < 4; ++e) { x[2 * e] = bflo(w[e]); x[2 * e + 1] = bfhi(w[e]); }
}
DI u32x4 pack8(const float (&x)[8]) { return (u32x4){pack2(x[0], x[1]), pack2(x[2], x[3]), pack2(x[4], x[5]), pack2(x[6], x[7])}; }

DI void phase3(const Params& p) {
  char* ws = p.ws;
  const bf16_t* R = (const bf16_t*)(ws + O_R);
  bf16_t* Qda = (bf16_t*)(ws + O_QDA); bf16_t* Qdb = (bf16_t*)(ws + O_QDB); bf16_t* Kd = (bf16_t*)(ws + O_KD); bf16_t* Vd = (bf16_t*)(ws + O_VD);
  bf16_t* cqn = (bf16_t*)(ws + O_CQN); bf16_t* ckvn = (bf16_t*)(ws + O_CKVN); bf16_t* Km = (bf16_t*)(ws + O_KMLA);
  const float* c16 = (const float*)(ws + O_C16); const float* s16 = (const float*)(ws + O_S16); const float* c8 = (const float*)(ws + O_C8); const float* s8 = (const float*)(ws + O_S8);
  float* o_k = p.out + (size_t)NTOK * 1024; float* o_v = o_k + (size_t)NCTX * 512; float* o_ckv = o_v + (size_t)NCTX * 512; float* o_kr = o_ckv + (size_t)NCTX * 128;
  const int lane = threadIdx.x & 63, gw = blockIdx.x * NWAVE + (threadIdx.x >> 6), nw = gridDim.x * NWAVE;
  for (int row = gw; row < NTOK; row += nw) {
    const bool lat = row >= NCTX;
    const int rl = row - NCTX, b = rl >> 12, t = rl & (TLAT - 1), prow = t >> 6, pcol = t & 63;
    const size_t kr = lat ? (size_t)NCTX + (size_t)b * TKL + 256 + t : (size_t)row;
    const bf16_t* r = R + (size_t)row * RLD;
    float x[8], o[8];
    const u32x4 wq = *(const u32x4*)(r + lane * 8);
    *(u32x4*)(Qda + (size_t)row * 512 + lane * 8) = wq;
    if (lat) { unpack8(wq, x); rope8(x, o, lane, c16, s16, prow, pcol); *(u32x4*)(Qdb + (size_t)rl * 512 + lane * 8) = pack8(o); }
    const u32x4 wk = *(const u32x4*)(r + 512 + lane * 8);
    if (lat) { unpack8(wk, x); rope8(x, o, lane, c16, s16, prow, pcol); *(u32x4*)(Kd + kr * 512 + lane * 8) = pack8(o); }
    else {
      unpack8(wk, x);
      *(f32x4*)(o_k + (size_t)row * 512 + lane * 8) = (f32x4){x[0], x[1], x[2], x[3]};
      *(f32x4*)(o_k + (size_t)row * 512 + lane * 8 + 4) = (f32x4){x[4], x[5], x[6], x[7]};
      *(u32x4*)(Kd + kr * 512 + lane * 8) = wk;
    }
    const u32x4 wv = *(const u32x4*)(r + 1024 + lane * 8);
    *(u32x4*)(Vd + kr * 512 + lane * 8) = wv;
    if (!lat) {
      unpack8(wv, x);
      *(f32x4*)(o_v + (size_t)row * 512 + lane * 8) = (f32x4){x[0], x[1], x[2], x[3]};
      *(f32x4*)(o_v + (size_t)row * 512 + lane * 8 + 4) = (f32x4){x[4], x[5], x[6], x[7]};
    }
    {
      const u32x2 w = *(const u32x2*)(r + 1536 + lane * 4);
      const float a0 = bflo(w[0]), a1 = bfhi(w[0]), a2 = bflo(w[1]), a3 = bfhi(w[1]);
      const float ss = wave_sum(a0 * a0 + a1 * a1 + a2 * a2 + a3 * a3);
      const float sc = rsqrtf(ss * (1.f / 256.f) + EPS);
      const f32x4 g = *(const f32x4*)(p.q_norm_g + lane * 4);
      *(u32x2*)(cqn + (size_t)row * 256 + lane * 4) = (u32x2){pack2(a0 * sc * g[0], a1 * sc * g[1]), pack2(a2 * sc * g[2], a3 * sc * g[3])};
    }
    {
      const unsigned w = *(const unsigned*)(r + 1792 + lane * 2);
      const float a0 = bflo(w), a1 = bfhi(w);
      const float ss = wave_sum(a0 * a0 + a1 * a1);
      const float sc = rsqrtf(ss * (1.f / 128.f) + EPS);
      const f32x2 g = *(const f32x2*)(p.kv_norm_g + lane * 2);
      const float y0 = a0 * sc * g[0], y1 = a1 * sc * g[1];
      if (!lat) *(f32x2*)(o_ckv + (size_t)row * 128 + lane * 2) = (f32x2){y0, y1};
      *(unsigned*)(ckvn + kr * 128 + lane * 2) = pack2(y0, y1);
    }
    {
      const int idx = lane & 31;
      const float xv = bf2f(r[1920 + idx]);
      float ov = xv;
      if (lat) {
        const int pos = (idx & 16) ? pcol : prow;
        const int f = idx & 7;
        const float y = __shfl_xor(xv, 8);
        const float cs = c8[pos * 8 + f], sn = s8[pos * 8 + f];
        ov = (idx & 8) ? (y * sn + xv * cs) : (xv * cs - y * sn);
      } else if (lane < 32) o_kr[(size_t)row * 32 + idx] = xv;
      const bf16_t ob = (bf16_t)(pack2(ov, ov) & 0xffff);
#pragma unroll
      for (int k = 0; k < 4; ++k) { const int hh = (lane >> 5) + 2 * k; Km[kr * 768 + hh * 96 + 64 + idx] = ob; }
    }
  }
}

template <int DQK, int DV>
DI void attn_core(const bf16_t* __restrict__ Qa, const bf16_t* __restrict__ Qb, int ldq, const bf16_t* __restrict__ Kp, int ldk, const bf16_t* __restrict__ Vp, int ldv,
                  int Tk, int n_a, float c  , char* smem, f32x16 (&o)[DV / 32]) {
  constexpr int KS = DQK * 2 + 16, VS = DV * 2 + 16, BUF = 64 * (KS + VS);
  constexpr int KCH = DQK / 8, VCH = DV / 8, NKCH = 64 * KCH, NVCH = 64 * VCH, NKC = (NKCH + NT - 1) / NT, NVC = (NVCH + NT - 1) / NT;
  constexpr bool KG = (NKCH % NT) != 0, VG = (NVCH % NT) != 0;
  constexpr int NS = DQK / 16, NDT = DV / 32;
  const int tid = threadIdx.x, lane = tid & 63, wid = tid >> 6, h = lane >> 5, ql = lane & 31;
  bf16x8 qf[NS];
  {
    const bf16_t* q = Qa + (size_t)(wid * 32 + ql) * ldq + h * 8;
#pragma unroll
    for (int s = 0; s < NS; ++s) qf[s] = *(const bf16x8*)(q + s * 16);
  }
#pragma unroll
  for (int dt = 0; dt < NDT; ++dt)
#pragma unroll
    for (int r = 0; r < 16; ++r) o[dt][r] = 0.f;
  float m_run = -INFINITY, l_run = 0.f;
  u32x4 rk[NKC], rv[NVC];
  const int nt = Tk >> 6, ta = n_a >> 6;
  unsigned koff[NKC], voff[NVC];
#pragma unroll
  for (int i = 0; i < NKC; ++i) { const int ch = tid + NT * i, row = ch / KCH, kc = ch % KCH; koff[i] = (unsigned)(row * ldk + kc * 8); }
#pragma unroll
  for (int i = 0; i < NVC; ++i) { const int ch = tid + NT * i, row = ch / VCH, vc = ch % VCH; voff[i] = (unsigned)(row * ldv + vc * 8); }
  auto gload = [&](int t) {
    const bf16_t* kb = Kp + (size_t)t * 64 * ldk;
    const bf16_t* vbp = Vp + (size_t)t * 64 * ldv;
#pragma unroll
    for (int i = 0; i < NKC; ++i) if (!KG || i + 1 < NKC || tid + NT * i < NKCH) rk[i] = *(const u32x4*)(kb + koff[i]);
#pragma unroll
    for (int i = 0; i < NVC; ++i) if (!VG || i + 1 < NVC || tid + NT * i < NVCH) rv[i] = *(const u32x4*)(vbp + voff[i]);
  };
  auto lstoreK = [&](char* buf) {
#pragma unroll
    for (int i = 0; i < NKC; ++i) { const int ch = tid + NT * i, row = ch / KCH, kc = ch % KCH; if (!KG || i + 1 < NKC || ch < NKCH) *(u32x4*)(buf + row * KS + kc * 16) = rk[i]; }
  };
  auto lstoreV = [&](char* buf) {
#pragma unroll
    for (int i = 0; i < NVC; ++i) { const int ch = tid + NT * i, row = ch / VCH, vc = ch % VCH; if (!VG || i + 1 < NVC || ch < NVCH) *(u32x4*)(buf + 64 * KS + row * VS + vc * 16) = rv[i]; }
  };
  gload(0); lstoreK(smem); lstoreV(smem); __syncthreads();
  const int i16 = lane & 15, tq = i16 >> 2, tp = i16 & 3, G = (lane >> 4) & 1;
  for (int t = 0; t < nt; ++t) {
    char* cur = smem + (t & 1) * BUF;
    const bool more = t + 1 < nt;
    if (more) gload(t + 1);
    if (t == ta) {
      const bf16_t* q = Qb + (size_t)(wid * 32 + ql) * ldq + h * 8;
#pragma unroll
      for (int s = 0; s < NS; ++s) qf[s] = *(const bf16x8*)(q + s * 16);
    }
    f32x16 st[2];
#pragma unroll
    for (int kt = 0; kt < 2; ++kt) {
#pragma unroll
      for (int r = 0; r < 16; ++r) st[kt][r] = 0.f;
#pragma unroll
      for (int s = 0; s < NS; ++s) {
        const bf16x8 kf = *(const bf16x8*)(cur + (kt * 32 + ql) * KS + s * 32 + h * 16);
        st[kt] = __builtin_amdgcn_mfma_f32_32x32x16_bf16(kf, qf[s], st[kt], 0, 0, 0);
      }
      __builtin_amdgcn_sched_barrier(0);
    }
    if (more) lstoreK(smem + ((t + 1) & 1) * BUF);
    float mx = st[0][0];
#pragma unroll
    for (int kt = 0; kt < 2; ++kt)
#pragma unroll
      for (int r = 0; r < 16; ++r) mx = fmaxf(mx, st[kt][r]);
    mx = fmaxf(mx, __shfl_xor(mx, 32));
    const float m_new = fmaxf(m_run, mx);
    const float alpha = __builtin_amdgcn_exp2f((m_run - m_new) * c);
    const float mc = m_new * c;
    m_run = m_new;
    float ls = 0.f;
#pragma unroll
    for (int kt = 0; kt < 2; ++kt)
#pragma unroll
      for (int r = 0; r < 16; ++r) { const float pv = __builtin_amdgcn_exp2f(st[kt][r] * c - mc); st[kt][r] = pv; ls += pv; }
    l_run = l_run * alpha + ls;
#pragma unroll
    for (int dt = 0; dt < NDT; ++dt)
#pragma unroll
      for (int r = 0; r < 16; ++r) o[dt][r] *= alpha;
    bf16x8 pf[2][2];
#pragma unroll
    for (int kt = 0; kt < 2; ++kt)
#pragma unroll
      for (int s2 = 0; s2 < 2; ++s2) {
        u32x4 w = {pack2(st[kt][8 * s2 + 0], st[kt][8 * s2 + 1]), pack2(st[kt][8 * s2 + 2], st[kt][8 * s2 + 3]), pack2(st[kt][8 * s2 + 4], st[kt][8 * s2 + 5]), pack2(st[kt][8 * s2 + 6], st[kt][8 * s2 + 7])};
        pf[kt][s2] = __builtin_bit_cast(bf16x8, w);
      }
    const char* vb = cur + 64 * KS + (4 * h + tq) * VS + 32 * G + 8 * tp;
#pragma unroll
    for (int kt = 0; kt < 2; ++kt)
#pragma unroll
      for (int s2 = 0; s2 < 2; ++s2) {
        bf16x8 vf[NDT];
#pragma unroll
        for (int dt = 0; dt < NDT; ++dt) {
          const char* a0 = vb + (kt * 32 + 16 * s2) * VS + dt * 64;
          const s16x4 lo = __builtin_amdgcn_ds_read_tr16_b64_v4i16((LDS_AS s16x4*)(a0));
          const s16x4 hi = __builtin_amdgcn_ds_read_tr16_b64_v4i16((LDS_AS s16x4*)(a0 + 8 * VS));
          vf[dt] = __builtin_shufflevector(lo, hi, 0, 1, 2, 3, 4, 5, 6, 7);
        }
#pragma unroll
        for (int dt = 0; dt < NDT; ++dt) o[dt] = __builtin_amdgcn_mfma_f32_32x32x16_bf16(vf[dt], pf[kt][s2], o[dt], 0, 0, 0);
        __builtin_amdgcn_sched_barrier(0);
      }
    if (more) lstoreV(smem + ((t + 1) & 1) * BUF);
    __syncthreads();
  }
  const float l = l_run + __shfl_xor(l_run, 32);
  const float inv = 1.f / l;
#pragma unroll
  for (int dt = 0; dt < NDT; ++dt)
#pragma unroll
    for (int r = 0; r < 16; ++r) o[dt][r] *= inv;
}

constexpr int U_DBIG = 128, U_MBIG = 256, U_DCTX = 64, U_MCTX = 128, U_TOTAL = U_DBIG + U_MBIG + U_DCTX + U_MCTX;

DI void phase_attn(const Params& p, char* smem, int cidx) {
  char* ws = p.ws;
  const bf16_t* Qda = (const bf16_t*)(ws + O_QDA); const bf16_t* Qdb = (const bf16_t*)(ws + O_QDB); const bf16_t* Kd = (const bf16_t*)(ws + O_KD); const bf16_t* Vd = (const bf16_t*)(ws + O_VD);
  const bf16_t* Qma = (const bf16_t*)(ws + O_QMA); const bf16_t* Qmb = (const bf16_t*)(ws + O_QMB); const bf16_t* Km = (const bf16_t*)(ws + O_KMLA); const bf16_t* Vm = (const bf16_t*)(ws + O_VMLA);
  bf16_t* cat = (bf16_t*)(ws + O_HB);
  float* otmp = (float*)(ws + O_OTMP) + (size_t)blockIdx.x * 32768;
  int* counter = (int*)(ws + O_CNT) + cidx;
  int* s_unit = (int*)(smem + 65532);
  const int tid = threadIdx.x, lane = tid & 63, wid = tid >> 6, h2 = lane >> 5, ql = lane & 31;
  const float lam = ((const float*)(ws + O_SCAL))[0];
  for (;;) {
    if (tid == 0) *s_unit = atomicAdd(counter, 1);
    __syncthreads();
    int u = __builtin_amdgcn_readfirstlane(*s_unit);
    __syncthreads();
    if (u >= U_TOTAL) break;
    bool diff; int qrow0, krow0, Tk, n_a, head; bool lat;
    if (u < U_DBIG) { diff = true; lat = true; const int b = u >> 6, hh = (u >> 4) & 3, qb = u & 15; head = hh; qrow0 = NCTX + b * TLAT + qb * 256; krow0 = NCTX + b * TKL; Tk = TKL; n_a = 256; }
    else if (u < U_DBIG + U_MBIG) { u -= U_DBIG; diff = false; lat = true; const int b = u >> 7, hh = (u >> 4) & 7, qb = u & 15; head = hh; qrow0 = NCTX + b * TLAT + qb * 256; krow0 = NCTX + b * TKL; Tk = TKL; n_a = 256; }
    else if (u < U_DBIG + U_MBIG + U_DCTX) { u -= U_DBIG + U_MBIG; diff = true; lat = false; const int sq = u >> 2, hh = u & 3; head = hh; qrow0 = sq * 256; krow0 = sq * 256; Tk = 256; n_a = 256; }
    else { u -= U_DBIG + U_MBIG + U_DCTX; diff = false; lat = false; const int sq = u >> 3, hh = u & 7; head = hh; qrow0 = sq * 256; krow0 = sq * 256; Tk = 256; n_a = 256; }
    const int qrowb = lat ? qrow0 - NCTX : 0;
    if (diff) {
      f32x16 o[4];
      const float c = 0.125f * 1.4426950408889634f;
#pragma unroll 1
      for (int m = 0; m < 2; ++m) {
        attn_core<64, 128>(Qda + (size_t)qrow0 * 512 + head * 128 + m * 64, Qdb + (size_t)qrowb * 512 + head * 128 + m * 64, 512,
                           Kd + (size_t)krow0 * 512 + head * 128 + m * 64, 512, Vd + (size_t)krow0 * 512 + head * 128, 512, Tk, n_a, c, smem, o);
        if (m == 0) {
#pragma unroll
          for (int dt = 0; dt < 4; ++dt)
#pragma unroll
            for (int rq = 0; rq < 4; ++rq) *(f32x4*)(otmp + tid * 64 + dt * 16 + rq * 4) = (f32x4){o[dt][4 * rq], o[dt][4 * rq + 1], o[dt][4 * rq + 2], o[dt][4 * rq + 3]};
        }
      }
      float ss = 0.f;
#pragma unroll
      for (int dt = 0; dt < 4; ++dt)
#pragma unroll
        for (int rq = 0; rq < 4; ++rq) {
          const f32x4 o0 = *(const f32x4*)(otmp + tid * 64 + dt * 16 + rq * 4);
#pragma unroll
          for (int e = 0; e < 4; ++e) { const float v = o0[e] - lam * o[dt][4 * rq + e]; o[dt][4 * rq + e] = v; ss += v * v; }
        }
      ss += __shfl_xor(ss, 32);
      const float sc = rsqrtf(ss * (1.f / 128.f) + EPS) * 0.8f;
      bf16_t* dst = cat + (size_t)(qrow0 + wid * 32 + ql) * 1024 + head * 128;
#pragma unroll
      for (int dt = 0; dt < 4; ++dt)
#pragma unroll
        for (int rq = 0; rq < 4; ++rq) {
          const int dv = dt * 32 + 8 * rq + 4 * h2;
          const f32x4 g = *(const f32x4*)(p.diff_norm_g + dv);
          u32x2 w = {pack2(o[dt][4 * rq] * sc * g[0], o[dt][4 * rq + 1] * sc * g[1]), pack2(o[dt][4 * rq + 2] * sc * g[2], o[dt][4 * rq + 3] * sc * g[3])};
          *(u32x2*)(dst + dv) = w;
        }
    } else {
      f32x16 o[2];
      const float c = 0.10206207261596575f * 1.4426950408889634f;
      attn_core<96, 64>(Qma + (size_t)qrow0 * 768 + head * 96, Qmb + (size_t)qrowb * 768 + head * 96, 768,
                        Km + (size_t)krow0 * 768 + head * 96, 768, Vm + (size_t)krow0 * 512 + head * 64, 512, Tk, n_a, c, smem, o);
      bf16_t* dst = cat + (size_t)(qrow0 + wid * 32 + ql) * 1024 + 512 + head * 64;
#pragma unroll
      for (int dt = 0; dt < 2; ++dt)
#pragma unroll
        for (int rq = 0; rq < 4; ++rq) {
          const int dv = dt * 32 + 8 * rq + 4 * h2;
          u32x2 w = {pack2(o[dt][4 * rq], o[dt][4 * rq + 1]), pack2(o[dt][4 * rq + 2], o[dt][4 * rq + 3])};
          *(u32x2*)(dst + dv) = w;
        }
    }
  }
}

DI void phase_conv(const Params& p, char* smem) {
  char* ws = p.ws;
  const bf16_t* Ug = (const bf16_t*)(ws + O_UG); const bf16_t* Pz = (const bf16_t*)(ws + O_PZ);
  bf16_t* cat = (bf16_t*)(ws + O_HB);
  const int tid = threadIdx.x, lane = tid & 63, half = tid >> 8, ht = tid & 255, hw4 = (tid >> 6) & 3;
  float* tile = (float*)smem + half * 8192;
  for (int up = blockIdx.x; up < NTOK / 32; up += gridDim.x) {
    const int t0 = (up * 2 + half) * 16;
    const int s0 = t0 < NCTX ? (t0 & ~255) : NCTX + ((t0 - NCTX) & ~(TLAT - 1));
    const int s1 = t0 < NCTX ? s0 + 256 : s0 + TLAT;
    {
      const int ch = ht * 2;
      float a0[16], a1[16];
#pragma unroll
      for (int o = 0; o < 16; ++o) { a0[o] = 0.f; a1[o] = 0.f; }
      f32x2 w[31];
#pragma unroll
      for (int j = 0; j < 31; ++j) w[j] = *(const f32x2*)(p.conv_w + j * 512 + ch);
#pragma unroll
      for (int i = 0; i < 46; ++i) {
        const int r = t0 - 15 + i;
        float u0 = 0.f, u1 = 0.f;
        if (r >= s0 && r < s1) { const unsigned v = *(const unsigned*)(Ug + (size_t)r * 512 + ch); u0 = bflo(v); u1 = bfhi(v); }
#pragma unroll
        for (int o = 0; o < 16; ++o) {
          const int j = i - o;
          if (j >= 0 && j <= 30) { a0[o] += u0 * w[j][0]; a1[o] += u1 * w[j][1]; }
        }
      }
      const f32x2 bias = *(const f32x2*)(p.conv_b + ch);
#pragma unroll
      for (int o = 0; o < 16; ++o) *(f32x2*)(tile + o * 512 + ch) = (f32x2){a0[o] + bias[0], a1[o] + bias[1]};
    }
    __syncthreads();
#pragma unroll 1
    for (int k = 0; k < 4; ++k) {
      const int o = hw4 * 4 + k, row = t0 + o;
      const f32x4 v0 = *(const f32x4*)(tile + o * 512 + lane * 4), v1 = *(const f32x4*)(tile + o * 512 + 256 + lane * 4);
      const float mean = wave_sum((v0[0] + v0[1]) + (v0[2] + v0[3]) + (v1[0] + v1[1]) + (v1[2] + v1[3])) * (1.f / 512.f);
      float q = 0.f;
#pragma unroll
      for (int e = 0; e < 4; ++e) { const float d0 = v0[e] - mean, d1 = v1[e] - mean; q += d0 * d0 + d1 * d1; }
      const float rstd = rsqrtf(wave_sum(q) * (1.f / 512.f) + EPS);
#pragma unroll
      for (int hlf = 0; hlf < 2; ++hlf) {
        const int col = hlf * 256 + lane * 4;
        const f32x4 v = hlf ? v1 : v0;
        const f32x4 g = *(const f32x4*)(p.conv_norm_g + col), bb = *(const f32x4*)(p.conv_norm_b + col);
        float y[4];
#pragma unroll
        for (int e = 0; e < 4; ++e) { const float z = (v[e] - mean) * rstd * g[e] + bb[e]; y[e] = z / (1.f + __expf(-z)); }
        *(u32x2*)(cat + (size_t)row * 1024 + col) = (u32x2){pack2(y[0], y[1]), pack2(y[2], y[3])};
      }
    }
    {
      const int ch = ht * 2, hw = 1 << hw4;
#pragma unroll 1
      for (int o = 0; o < 16; ++o) {
        const int r = t0 + o;
        const int lo = max(r - hw, s0), hi = min(r + hw - 1, s1 - 1);
        float a0 = 0.f, a1 = 0.f;
        for (int q = lo; q <= hi; ++q) { const unsigned v = *(const unsigned*)(Pz + (size_t)q * 512 + ch); a0 += bflo(v); a1 += bfhi(v); }
        const unsigned vc = *(const unsigned*)(Pz + (size_t)r * 512 + ch);
        const float ic = 1.f / (float)(hi - lo + 1);
        *(unsigned*)(cat + (size_t)r * 1024 + 512 + ch) = pack2(a0 * ic - bflo(vc), a1 * ic - bfhi(vc));
      }
    }
    __syncthreads();
  }
}

__global__ void __launch_bounds__(NT, 2) fwd_kernel(Params p, int ph_lo, int ph_hi) {
  __shared__ __attribute__((aligned(16))) char smem[2 * G_STAGE];
  __shared__ uint4 xb_words;
  cg::grid_group grid = cg::this_grid();
  char* ws = p.ws;
  if (threadIdx.x == 0) xb_words = make_uint4(0u, 0u, 0u, 0u);
  __syncthreads();
  const XcdBarrier xb = xcd_barrier_post((unsigned*)(ws + O_BAR), (volatile LDS_AS unsigned*)&xb_words);
  if (ph_lo > 1000) grid.sync();
  float* mods = (float*)(ws + O_MODS);
  bf16_t* Hb = (bf16_t*)(ws + O_HB);
  float* X = p.out;
#define GSYNC() xcd_barrier(xb)
#define PH_BEGIN(n) if (ph_lo <= n && n < ph_hi) { if (n > ph_lo) GSYNC();
#define PH_END }
#ifndef PROBE_DUP
#define PROBE_DUP 0
#endif
#ifndef PROBE_SYNCS
#define PROBE_SYNCS 0
#endif
#define DUP(n, ...) __VA_ARGS__; if ((PROBE_DUP >> n) & 1) { GSYNC(); __VA_ARGS__; }
  for (int i = 0; i < PROBE_SYNCS; ++i) GSYNC();
  PH_BEGIN(0) { DUP(0, phase0(p, smem)); } PH_END
  PH_BEGIN(1) { DUP(1, rows_phase(p.x_prompt, p.x_sample, false, nullptr, nullptr, nullptr, mods, 0, 1024, Hb)); } PH_END
  PH_BEGIN(2) { DUP(2, gemm_phase(Hb, 1024, (const bf16_t*)(ws + O_WATTIN), 1024, 1024, 64, 8, EpiRaw{(bf16_t*)(ws + O_R)}, smem)); } PH_END
  PH_BEGIN(3) { DUP(3, phase3(p)); } PH_END
  PH_BEGIN(4) {
        const int n1 = 64 * 3, n2 = 67 * 4;
        gemm_phase((const bf16_t*)(ws + O_CQN), 256, (const bf16_t*)(ws + O_WUQ), 256, 256, 64, 3,
                   EpiUq{(bf16_t*)(ws + O_QMA), (bf16_t*)(ws + O_QMB), (const float*)(ws + O_C8), (const float*)(ws + O_S8)}, smem, 0, n1 + n2);
        gemm_phase((const bf16_t*)(ws + O_CKVN), 128, (const bf16_t*)(ws + O_WUKV), 128, 128, 67, 4,
                   EpiUkv{(bf16_t*)(ws + O_KMLA), (bf16_t*)(ws + O_VMLA)}, smem, n1, n1 + n2);
  } PH_END
  PH_BEGIN(5) { phase_attn(p, smem, 0); if ((PROBE_DUP >> 5) & 1) { GSYNC(); phase_attn(p, smem, 1); } } PH_END
  PH_BEGIN(6) { DUP(6, gemm_phase(Hb, 1024, (const bf16_t*)(ws + O_WATTOUT), 1024, 1024, 64, 4, EpiRes{p.x_prompt, p.x_sample, mods + 2048, X}, smem)); } PH_END
  PH_BEGIN(7) { rows_phase(X, X + (size_t)NCTX * 1024, true, p.ln_mix_g, p.ln_mix_b, X, mods, 3072, 4096, Hb); } PH_END
  PH_BEGIN(8) { DUP(8, gemm_phase(Hb, 1024, (const bf16_t*)(ws + O_WMLPIN), 1024, 1024, 64, 16, EpiRelu2{(bf16_t*)(ws + O_U)}, smem)); } PH_END
  PH_BEGIN(9) { gemm_phase((const bf16_t*)(ws + O_U), 4096, (const bf16_t*)(ws + O_WMLPOUT), 4096, 4096, 64, 4, EpiRes{X, X + (size_t)NCTX * 1024, mods + 5120, X}, smem); } PH_END
  PH_BEGIN(10) { rows_phase(X, X + (size_t)NCTX * 1024, true, p.ln_mlp_g, p.ln_mlp_b, X, mods + 3 * 6144, 0, 1024, Hb); } PH_END
  PH_BEGIN(11) { DUP(11, gemm_phase(Hb, 1024, (const bf16_t*)(ws + O_WCONVIN), 1024, 1024, 64, 6, EpiConv{(bf16_t*)(ws + O_UG), (bf16_t*)(ws + O_PZ)}, smem)); } PH_END
  PH_BEGIN(12) { DUP(12, phase_conv(p, smem)); } PH_END
  PH_BEGIN(13) { gemm_phase(Hb, 1024, (const bf16_t*)(ws + O_WCONVOUT), 1024, 1024, 64, 4, EpiRes{X, X + (size_t)NCTX * 1024, mods + 3 * 6144 + 2048, X}, smem); } PH_END
  PH_BEGIN(14) { rows_phase(X, X + (size_t)NCTX * 1024, true, p.ln_mix_g + 1024, p.ln_mix_b + 1024, X, mods + 3 * 6144, 3072, 4096, Hb); } PH_END
  PH_BEGIN(15) { DUP(15, gemm_phase(Hb, 1024, (const bf16_t*)(ws + O_WMLPIN) + (size_t)4096 * 1024, 1024, 1024, 64, 16, EpiRelu2{(bf16_t*)(ws + O_U)}, smem)); } PH_END
  PH_BEGIN(16) { gemm_phase((const bf16_t*)(ws + O_U), 4096, (const bf16_t*)(ws + O_WMLPOUT) + (size_t)4096 * 1024, 4096, 4096, 64, 4, EpiRes{X, X + (size_t)NCTX * 1024, mods + 3 * 6144 + 5120, X}, smem); } PH_END
  PH_BEGIN(17) { rows_phase(X, X + (size_t)NCTX * 1024, true, p.ln_mlp_g + 1024, p.ln_mlp_b + 1024, X, nullptr, 0, 0, nullptr); } PH_END

}

extern "C" void kernel_launch(void* const* d_in, const int* in_sizes, int n_in, void* d_out, int out_size, void* d_ws, size_t ws_size, hipStream_t stream) {
  static int grid_blocks = 0;
  if (!grid_blocks) {
    int dev = 0, cus = 0, per_cu = 0;
    hipGetDevice(&dev);
    hipDeviceGetAttribute(&cus, hipDeviceAttributeMultiprocessorCount, dev);
    hipOccupancyMaxActiveBlocksPerMultiprocessor(&per_cu, fwd_kernel, NT, 0);
    if (per_cu > 1) per_cu = 1;
    if (per_cu < 1) per_cu = 1;
    grid_blocks = cus * per_cu;
    if (grid_blocks > 256) grid_blocks = 256;
  }
  if (ws_size < WS_NEED) { fprintf(stderr, "workspace too small: %zu < %zu\n", ws_size, (size_t)WS_NEED); return; }
  Params p{};
  const float** f = (const float**)&p;
  for (int i = 0; i < 35; ++i) f[i] = (const float*)d_in[i];
  p.out = (float*)d_out;
  p.ws = (char*)d_ws;
  hipMemsetAsync(d_ws, 0, 16384, stream);
  int lo = 0, hi = NPHASE;
  void* args[] = {&p, &lo, &hi};
  hipError_t e = hipLaunchCooperativeKernel((void*)fwd_kernel, dim3(grid_blocks), dim3(NT), args, 0, stream);
  if (e != hipSuccess) fprintf(stderr, "cooperative launch failed: %s (grid %d)\n", hipGetErrorString(e), grid_blocks);
}
```

```cpp
#include <hip/hip_runtime.h>
#include <hip/hip_cooperative_groups.h>
#include <cstdio>
#include <cstdint>
namespace cg = cooperative_groups;

typedef unsigned short bf16_t;
typedef short bf16x8 __attribute__((ext_vector_type(8)));
typedef short s16x4 __attribute__((ext_vector_type(4)));
typedef float f32x4 __attribute__((ext_vector_type(4)));
typedef float f32x2 __attribute__((ext_vector_type(2)));
typedef float f32x16 __attribute__((ext_vector_type(16)));
typedef unsigned u32x4 __attribute__((ext_vector_type(4)));
typedef unsigned u32x2 __attribute__((ext_vector_type(2)));
typedef __bf16 bf16v2 __attribute__((ext_vector_type(2)));
#define DI __device__ __forceinline__
#define LDS_AS __attribute__((address_space(3)))

constexpr int NTOK = 12288, NCTX = 4096, NKEY = 12800, TLAT = 4096, TKL = 4352;
constexpr int RLD = 1952;
constexpr float ALPHA = 1.41421356237f, EPS = 1e-5f;
constexpr int NPHASE = 18;
constexpr int NT = 512, NWAVE = 8;

constexpr size_t al(size_t x) { return (x + 255) & ~(size_t)255; }
constexpr size_t O_CNT = 0;
constexpr size_t O_BAR = 256;
constexpr size_t O_MODS = 16384;
constexpr size_t O_SCAL = O_MODS + al(2 * 3 * 6144 * 4);
constexpr size_t O_C16 = O_SCAL + 256;
constexpr size_t O_S16 = O_C16 + 4096;
constexpr size_t O_C8 = O_S16 + 4096;
constexpr size_t O_S8 = O_C8 + 2048;
constexpr size_t O_WATTIN = O_S8 + 2048;
constexpr size_t O_WUQ = O_WATTIN + (size_t)2048 * 1024 * 2;
constexpr size_t O_WUKV = O_WUQ + (size_t)768 * 256 * 2;
constexpr size_t O_WATTOUT = O_WUKV + (size_t)1024 * 128 * 2;
constexpr size_t O_WMLPIN = O_WATTOUT + (size_t)1024 * 1024 * 2;
constexpr size_t O_WMLPOUT = O_WMLPIN + (size_t)2 * 4096 * 1024 * 2;
constexpr size_t O_WCONVIN = O_WMLPOUT + (size_t)2 * 4096 * 1024 * 2;
constexpr size_t O_WCONVOUT = O_WCONVIN + (size_t)1536 * 1024 * 2;
constexpr size_t O_HB = O_WCONVOUT + (size_t)1024 * 1024 * 2;
constexpr size_t O_BIG = O_HB + (size_t)NTOK * 1024 * 2;
constexpr size_t O_R = O_BIG;
constexpr size_t O_QMA = O_R;
constexpr size_t O_QMB = O_QMA + (size_t)NTOK * 768 * 2;
constexpr size_t O_QDA = O_R + al((size_t)NTOK * RLD * 2);
constexpr size_t O_QDB = O_QDA + (size_t)NTOK * 512 * 2;
constexpr size_t O_KD = O_QDB + (size_t)8192 * 512 * 2;
constexpr size_t O_VD = O_KD + (size_t)NKEY * 512 * 2;
constexpr size_t O_CQN = O_VD + (size_t)NKEY * 512 * 2;
constexpr size_t O_CKVN = O_CQN + (size_t)NTOK * 256 * 2;
constexpr size_t O_KMLA = O_CKVN + (size_t)NKEY * 128 * 2;
constexpr size_t O_VMLA = O_KMLA + (size_t)NKEY * 768 * 2;
constexpr size_t O_OTMP = O_VMLA + (size_t)NKEY * 512 * 2;
constexpr size_t O_ATT_END = O_OTMP + (size_t)512 * 16384 * 4;
constexpr size_t O_U = O_BIG;
constexpr size_t O_U_END = O_U + (size_t)NTOK * 4096 * 2;
constexpr size_t O_UG = O_BIG;
constexpr size_t O_PZ = O_UG + (size_t)NTOK * 512 * 2;
constexpr size_t WS_NEED = (O_ATT_END > O_U_END ? O_ATT_END : O_U_END);
static_assert(O_QMB + (size_t)8192 * 768 * 2 <= O_QDA, "Qm overlay must fit in R");
static_assert(WS_NEED <= (size_t)256 * 1024 * 1024, "workspace too large");

struct Params {
  const float *x_prompt, *x_sample, *cache_k, *cache_v, *cache_ckv, *cache_krope, *c, *c_ctx;
  const float *w_ada, *b_ada, *ln_mix_g, *ln_mix_b, *ln_mlp_g, *ln_mlp_b, *w_mlp_in, *w_mlp_out;
  const float *w_att_in, *w_uq, *w_ukv, *q_norm_g, *kv_norm_g, *lam_q1, *lam_k1, *lam_q2, *lam_k2, *diff_norm_g, *w_att_out;
  const float *w_conv_in, *conv_w, *conv_b, *conv_norm_g, *conv_norm_b, *w_pool, *pool_scale, *w_conv_out;
  float* out;
  char* ws;
};

DI unsigned pack2(float lo, float hi) { f32x2 v = {lo, hi}; bf16v2 b = __builtin_convertvector(v, bf16v2); return __builtin_bit_cast(unsigned, b); }
DI float bf2f(unsigned short u) { return __uint_as_float((unsigned)u << 16); }
DI float bflo(unsigned u) { return __uint_as_float(u << 16); }
DI float bfhi(unsigned u) { return __uint_as_float(u & 0xffff0000u); }
DI float wave_sum(float v) {
#pragma unroll
  for (int o = 32; o >= 1; o >>= 1) v += __shfl_xor(v, o);
  return v;
}
DI void lds_barrier() { asm volatile("s_waitcnt lgkmcnt(0)\n\ts_barrier" ::: "memory"); }
DI int cond_idx(int row) { return row < NCTX ? 0 : 1 + ((row - NCTX) >> 12); }


#define XB_TMO      128
#define XB_XCNT(j)  (256  + 64 * (j))
#define XB_XSUB(j)  (1280 + 64 * (j))
#define XB_XGEN(j)  (2304 + 64 * (j))
#define XB_TOP      3328
#define XB_TOPGEN   3392
#define XCD_BAR_WORDS 3456
#define XB_SPIN_CAP (1u << 18)
DI unsigned xb_ld(unsigned* p)              { return __hip_atomic_load(p, __ATOMIC_RELAXED, __HIP_MEMORY_SCOPE_AGENT); }
DI unsigned xb_add(unsigned* p, unsigned v) { return __hip_atomic_fetch_add(p, v, __ATOMIC_RELAXED, __HIP_MEMORY_SCOPE_AGENT); }
DI unsigned xb_xcc_id() { return (unsigned)__builtin_amdgcn_s_getreg((3 << 11) | 20) & 0xFu; }
#define XB_SPIN(cond, bar) do { unsigned _sp = 0; while (cond) { __builtin_amdgcn_s_sleep(1); \
    if ((++_sp & 255u) == 0u) { if (xb_ld(&(bar)[XB_TMO])) break; if (_sp > XB_SPIN_CAP) { atomicAdd(&(bar)[XB_TMO], 1u); break; } } } } while (0)
struct XcdBarrier { unsigned* bar; unsigned x; volatile LDS_AS unsigned* st; };
DI XcdBarrier xcd_barrier_post(unsigned* bar, volatile LDS_AS unsigned* st) {
  XcdBarrier b; b.bar = bar; b.x = xb_xcc_id(); b.st = st;
  if (threadIdx.x == 0) (void)xb_add(&bar[XB_XCNT(b.x)], 1u);
  return b;
}
DI void xcd_barrier_complete(unsigned* bar, unsigned x, unsigned& nloc, unsigned& nx) {
  const unsigned G = gridDim.x * gridDim.y * gridDim.z;
  unsigned sum, cnt, mine, sp = 0u;
  for (;;) {
    sum = 0u; cnt = 0u; mine = 0u;
#pragma unroll
    for (unsigned j = 0; j < 16; ++j) { const unsigned c = xb_ld(&bar[XB_XCNT(j)]); sum += c; cnt += (c > 0u) ? 1u : 0u; mine = (j == x) ? c : mine; }
    if (sum == G) break;
    __builtin_amdgcn_s_sleep(1);
    if ((++sp & 255u) == 0u) { if (xb_ld(&bar[XB_TMO])) break; if (sp > XB_SPIN_CAP) { atomicAdd(&bar[XB_TMO], 1u); break; } }
  }
  nloc = mine > 0u ? mine : 1u; nx = cnt > 0u ? cnt : 1u;
}
DI void xcd_barrier(const XcdBarrier& b) {
  asm volatile("s_waitcnt vmcnt(0)" ::: "memory");
  __syncthreads();
  if (threadIdx.x == 0) {
    unsigned* bar = b.bar;
    __builtin_amdgcn_s_waitcnt(0);
    unsigned nloc = b.st[0], nx = b.st[1];
    if (nloc == 0u) { xcd_barrier_complete(bar, b.x, nloc, nx); b.st[0] = nloc; b.st[1] = nx; }
    const unsigned old = xb_add(&bar[XB_XSUB(b.x)], 1u);
    const unsigned gen = old / nloc;
    if (old + 1u == (gen + 1u) * nloc) {
      __builtin_amdgcn_fence(__ATOMIC_RELEASE, "agent");
      asm volatile("s_waitcnt vmcnt(0)" ::: "memory");
      const unsigned og = xb_add(&bar[XB_TOP], 1u);
      const unsigned tg = og / nx;
      if (og + 1u == (tg + 1u) * nx) xb_add(&bar[XB_TOPGEN], 1u);
      else XB_SPIN(xb_ld(&bar[XB_TOPGEN]) == tg, bar);
      __builtin_amdgcn_fence(__ATOMIC_ACQUIRE, "agent");
      xb_add(&bar[XB_XGEN(b.x)], 1u);
      asm volatile("s_waitcnt vmcnt(0)" ::: "memory");
    } else {
      XB_SPIN(xb_ld(&bar[XB_XGEN(b.x)]) == gen, bar);
      __builtin_amdgcn_fence(__ATOMIC_ACQUIRE, "agent");
      asm volatile("s_waitcnt vmcnt(0)" ::: "memory");
    }
  }
  __syncthreads();
}

DI int swz(int row, int kc) { return row * 128 + ((kc ^ ((row >> 1) & 7)) << 4); }

constexpr int G_BM = 192, G_BN = 256, G_MI = 6, G_NJ = 4, G_ABYTES = G_BM * 128, G_STAGE = G_ABYTES + G_BN * 128;
template <class Epi>
DI void gemm_tile(const bf16_t* __restrict__ A, int lda, const bf16_t* __restrict__ Bt, int ldb, int K, int row0, int col0, char* smem, const Epi& epi) {
  const int tid = threadIdx.x, lane = tid & 63, wid = tid >> 6, wr = wid >> 2, wc = wid & 3;
  const int fr = lane & 15, fq = lane >> 4;
  f32x4 acc[G_MI][G_NJ];
#pragma unroll
  for (int i = 0; i < G_MI; ++i)
#pragma unroll
    for (int j = 0; j < G_NJ; ++j) acc[i][j] = (f32x4){0.f, 0.f, 0.f, 0.f};
  const int srow = tid >> 3, skc = tid & 7;
  const bf16_t* ga = A + (size_t)(row0 + srow) * lda + skc * 8;
  const bf16_t* gb = Bt + (size_t)(col0 + srow) * ldb + skc * 8;
  const int soff = swz(srow, skc);
  u32x4 ra0[3], rb0[4], ra1[3], rb1[4];
  const int nk = K >> 6;
#define G_LOAD(RA, RB, kt_) do { const int k0_ = (kt_) << 6; \
    _Pragma("unroll") for (int i = 0; i < 3; ++i) RA[i] = *(const u32x4*)(ga + (size_t)(64 * i) * lda + k0_); \
    _Pragma("unroll") for (int i = 0; i < 4; ++i) RB[i] = *(const u32x4*)(gb + (size_t)(64 * i) * ldb + k0_); } while (0)
#define G_STORE(RA, RB, buf_) do { char* nb_ = (buf_); \
    _Pragma("unroll") for (int i = 0; i < 3; ++i) *(u32x4*)(nb_ + soff + i * 8192) = RA[i]; \
    _Pragma("unroll") for (int i = 0; i < 4; ++i) *(u32x4*)(nb_ + G_ABYTES + soff + i * 8192) = RB[i]; } while (0)
#define G_COMPUTE(buf_) do { const char* cur = (buf_); \
    _Pragma("unroll") for (int s = 0; s < 2; ++s) { \
      bf16x8 af[G_MI], bfr[G_NJ]; \
      _Pragma("unroll") for (int i = 0; i < G_MI; ++i) af[i] = *(const bf16x8*)(cur + swz(wr * 96 + i * 16 + fr, s * 4 + fq)); \
      _Pragma("unroll") for (int j = 0; j < G_NJ; ++j) bfr[j] = *(const bf16x8*)(cur + G_ABYTES + swz(wc * 64 + j * 16 + fr, s * 4 + fq)); \
      _Pragma("unroll") for (int i = 0; i < G_MI; ++i) \
        _Pragma("unroll") for (int j = 0; j < G_NJ; ++j) acc[i][j] = __builtin_amdgcn_mfma_f32_16x16x32_bf16(bfr[j], af[i], acc[i][j], 0, 0, 0); \
    } } while (0)
  G_LOAD(ra0, rb0, 0);
  G_STORE(ra0, rb0, smem);
  lds_barrier();
  G_LOAD(ra0, rb0, 1);
  for (int kt = 0; kt < nk; kt += 2) {
    G_LOAD(ra1, rb1, min(kt + 2, nk - 1));
    G_COMPUTE(smem);
    G_STORE(ra0, rb0, smem + G_STAGE);
    lds_barrier();
    G_LOAD(ra0, rb0, min(kt + 3, nk - 1));
    G_COMPUTE(smem + G_STAGE);
    G_STORE(ra1, rb1, smem);
    lds_barrier();
  }
#undef G_LOAD
#undef G_STORE
#undef G_COMPUTE
  epi(acc, row0 + wr * 96, col0 + wc * 64, lane);
}


struct EpiRaw {
  bf16_t* R;
  DI void operator()(f32x4 (&acc)[G_MI][G_NJ], int rbase, int cbase, int lane) const {
    const int fr = lane & 15, fq = lane >> 4;
#pragma unroll
    for (int i = 0; i < G_MI; ++i)
#pragma unroll
      for (int j = 0; j < G_NJ; ++j) {
        const int row = rbase + i * 16 + fr, col = cbase + j * 16 + fq * 4;
        if (col < RLD) { u32x2 w = {pack2(acc[i][j][0], acc[i][j][1]), pack2(acc[i][j][2], acc[i][j][3])}; *(u32x2*)(R + (size_t)row * RLD + col) = w; }
      }
  }
};

struct EpiUq {
  bf16_t *Qa, *Qb; const float *c8, *s8;
  DI void operator()(f32x4 (&acc)[G_MI][G_NJ], int rbase, int cbase, int lane) const {
    const int fr = lane & 15, fq = lane >> 4;
#pragma unroll
    for (int i = 0; i < G_MI; ++i) {
      const bool lat = (rbase + i * 16) >= NCTX;
      const int row = rbase + i * 16 + fr;
      const int t = (row - NCTX) & (TLAT - 1);
#pragma unroll
      for (int j = 0; j < G_NJ; ++j) {
        const int cf = cbase + j * 16, col = cf + fq * 4;
        f32x4 v = acc[i][j];
        u32x2 w = {pack2(v[0], v[1]), pack2(v[2], v[3])};
        *(u32x2*)(Qa + (size_t)row * 768 + col) = w;
        if (lat) {
          const int w96 = cf % 96;
          if (w96 >= 64) {
            const int pos = (w96 == 64) ? (t >> 6) : (t & 63);
            f32x4 o;
#pragma unroll
            for (int e = 0; e < 4; ++e) {
              const float pv = __shfl_xor(v[e], 32);
              const int f = (fq & 1) * 4 + e;
              const float cs = c8[pos * 8 + f], sn = s8[pos * 8 + f];
              o[e] = (fq < 2) ? (v[e] * cs - pv * sn) : (pv * sn + v[e] * cs);
            }
            w = (u32x2){pack2(o[0], o[1]), pack2(o[2], o[3])};
          }
          *(u32x2*)(Qb + (size_t)(row - NCTX) * 768 + col) = w;
        }
      }
    }
  }
};

struct EpiUkv {
  bf16_t *Km, *Vm;
  DI void operator()(f32x4 (&acc)[G_MI][G_NJ], int rbase, int cbase, int lane) const {
    const int fr = lane & 15, fq = lane >> 4;
    const int h = cbase >> 7, part = (cbase >> 6) & 1;
#pragma unroll
    for (int i = 0; i < G_MI; ++i) {
      if (rbase + i * 16 >= NKEY) continue;
#pragma unroll
      for (int j = 0; j < G_NJ; ++j) {
        const int row = rbase + i * 16 + fr, c = j * 16 + fq * 4;
        u32x2 w = {pack2(acc[i][j][0], acc[i][j][1]), pack2(acc[i][j][2], acc[i][j][3])};
        if (part == 0) *(u32x2*)(Km + (size_t)row * 768 + h * 96 + c) = w;
        else *(u32x2*)(Vm + (size_t)row * 512 + h * 64 + c) = w;
      }
    }
  }
};

struct EpiRes {
  const float *xin_ctx, *xin_lat, *gate  ; float* X;
  DI void operator()(f32x4 (&acc)[G_MI][G_NJ], int rbase, int cbase, int lane) const {
    const int fr = lane & 15, fq = lane >> 4;
#pragma unroll
    for (int i = 0; i < G_MI; ++i) {
      const int row = rbase + i * 16 + fr;
      const float* g = gate + cond_idx(rbase + i * 16) * 6144;
      const float* xin = row < NCTX ? xin_ctx + (size_t)row * 1024 : xin_lat + (size_t)(row - NCTX) * 1024;
#pragma unroll
      for (int j = 0; j < G_NJ; ++j) {
        const int col = cbase + j * 16 + fq * 4;
        const f32x4 xv = *(const f32x4*)(xin + col), gv = *(const f32x4*)(g + col);
        f32x4 z;
#pragma unroll
        for (int e = 0; e < 4; ++e) z[e] = ALPHA * xv[e] + gv[e] * acc[i][j][e];
        *(f32x4*)(X + (size_t)row * 1024 + col) = z;
      }
    }
  }
};

struct EpiRelu2 {
  bf16_t* U;
  DI void operator()(f32x4 (&acc)[G_MI][G_NJ], int rbase, int cbase, int lane) const {
    const int fr = lane & 15, fq = lane >> 4;
#pragma unroll
    for (int i = 0; i < G_MI; ++i)
#pragma unroll
      for (int j = 0; j < G_NJ; ++j) {
        const int row = rbase + i * 16 + fr, col = cbase + j * 16 + fq * 4;
        f32x4 v = acc[i][j];
#pragma unroll
        for (int e = 0; e < 4; ++e) { const float r = fmaxf(v[e], 0.f); v[e] = r * r; }
        u32x2 w = {pack2(v[0], v[1]), pack2(v[2], v[3])};
        *(u32x2*)(U + (size_t)row * 4096 + col) = w;
      }
  }
};

struct EpiConv {
  bf16_t *Ug, *Pz;
  DI void operator()(f32x4 (&acc)[G_MI][G_NJ], int rbase, int cbase, int lane) const {
    const int fr = lane & 15, fq = lane >> 4;
#pragma unroll
    for (int i = 0; i < G_MI; ++i) {
      const int row = rbase + i * 16 + fr;
      if (cbase < 1024) {
#pragma unroll
        for (int jp = 0; jp < 2; ++jp) {
          const f32x4 a = acc[i][2 * jp], gt = acc[i][2 * jp + 1];
          f32x4 u;
#pragma unroll
          for (int e = 0; e < 4; ++e) u[e] = a[e] / (1.f + __expf(-gt[e]));
          const int ch = ((cbase + 32 * jp) >> 5) * 16 + fq * 4;
          u32x2 w = {pack2(u[0], u[1]), pack2(u[2], u[3])};
          *(u32x2*)(Ug + (size_t)row * 512 + ch) = w;
        }
      } else {
#pragma unroll
        for (int j = 0; j < G_NJ; ++j) {
          const int col = cbase - 1024 + j * 16 + fq * 4;
          u32x2 w = {pack2(acc[i][j][0], acc[i][j][1]), pack2(acc[i][j][2], acc[i][j][3])};
          *(u32x2*)(Pz + (size_t)row * 512 + col) = w;
        }
      }
    }
  }
};

template <class Epi>
DI void gemm_phase(const bf16_t* A, int lda, const bf16_t* Bt, int ldb, int K, int mt, int nt, const Epi& epi, char* smem, int tstart = 0, int ttotal = -1) {
  const int n = mt * nt;
  if (ttotal < 0) ttotal = n;
  for (int t = blockIdx.x; t < ttotal; t += gridDim.x) {
    const int u = t - tstart;
    if (u < 0 || u >= n) continue;
    const int pm = u / nt, pn = u - pm * nt;
    gemm_tile(A, lda, Bt, ldb, K, pm * G_BM, pn * G_BN, smem, epi);
  }
}

DI void rows_phase(const float* src_ctx, const float* src_lat, bool do_ln, const float* lg, const float* lb, float* Xdst,
                   const float* modsL, int sh_off, int sc_off, bf16_t* Hb) {
  const int lane = threadIdx.x & 63, gw = blockIdx.x * NWAVE + (threadIdx.x >> 6), nw = gridDim.x * NWAVE;
  for (int row = gw; row < NTOK; row += nw) {
    const float* src = row < NCTX ? src_ctx + (size_t)row * 1024 : src_lat + (size_t)(row - NCTX) * 1024;
    f32x4 v[4];
#pragma unroll
    for (int i = 0; i < 4; ++i) v[i] = *(const f32x4*)(src + i * 256 + lane * 4);
    if (do_ln) {
      float s = 0.f;
#pragma unroll
      for (int i = 0; i < 4; ++i) s += (v[i][0] + v[i][1]) + (v[i][2] + v[i][3]);
      const float mean = wave_sum(s) * (1.f / 1024.f);
      float q = 0.f;
#pragma unroll
      for (int i = 0; i < 4; ++i)
#pragma unroll
        for (int e = 0; e < 4; ++e) { const float d = v[i][e] - mean; q += d * d; }
      const float rstd = rsqrtf(wave_sum(q) * (1.f / 1024.f) + EPS);
#pragma unroll
      for (int i = 0; i < 4; ++i) {
        const f32x4 g = *(const f32x4*)(lg + i * 256 + lane * 4), b = *(const f32x4*)(lb + i * 256 + lane * 4);
#pragma unroll
        for (int e = 0; e < 4; ++e) v[i][e] = (v[i][e] - mean) * rstd * g[e] + b[e];
        if (Xdst) *(f32x4*)(Xdst + (size_t)row * 1024 + i * 256 + lane * 4) = v[i];
      }
    }
    if (Hb) {
      const float* m = modsL + cond_idx(row) * 6144;
#pragma unroll
      for (int i = 0; i < 4; ++i) {
        const int col = i * 256 + lane * 4;
        const f32x4 sh = *(const f32x4*)(m + sh_off + col), sc = *(const f32x4*)(m + sc_off + col);
        f32x4 h;
#pragma unroll
        for (int e = 0; e < 4; ++e) h[e] = v[i][e] * (1.f + sc[e]) + sh[e];
        u32x2 w = {pack2(h[0], h[1]), pack2(h[2], h[3])};
        *(u32x2*)(Hb + (size_t)row * 1024 + col) = w;
      }
    }
  }
}

DI double sin_red(double r) {
  const double r2 = r * r; double t = -1.0 / 51090942171709440000.0;
  t = t * r2 + 1.0 / 121645100408832000.0; t = t * r2 - 1.0 / 355687428096000.0; t = t * r2 + 1.0 / 1307674368000.0; t = t * r2 - 1.0 / 6227020800.0;
  t = t * r2 + 1.0 / 39916800.0; t = t * r2 - 1.0 / 362880.0; t = t * r2 + 1.0 / 5040.0; t = t * r2 - 1.0 / 120.0; t = t * r2 + 1.0 / 6.0;
  return r * (1.0 - r2 * t);
}
DI double cos_red(double r) {
  const double r2 = r * r; double t = 1.0 / 1124000727777607680000.0;
  t = t * r2 - 1.0 / 2432902008176640000.0; t = t * r2 + 1.0 / 6402373705728000.0; t = t * r2 - 1.0 / 20922789888000.0; t = t * r2 + 1.0 / 87178291200.0;
  t = t * r2 - 1.0 / 479001600.0; t = t * r2 + 1.0 / 3628800.0; t = t * r2 - 1.0 / 40320.0; t = t * r2 + 1.0 / 720.0; t = t * r2 - 1.0 / 24.0; t = t * r2 + 0.5; t = t * r2 * -1.0 + 1.0;
  return t;
}

constexpr int J_MODS = 192, J_WEFF = 64, J_CACHE = 64, J_ROPE = 1, J_SLOW = J_MODS + J_WEFF + J_CACHE + J_ROPE;
constexpr int T_ATTIN = 16 * 16, T_UQ = 4 * 6, T_UKV = 2 * 8, T_ATTOUT = 16 * 8, T_MLPIN = 16 * 32, T_MLPOUT = 64 * 8, T_CONVIN = 16 * 12, T_CONVOUT = 8 * 8;
constexpr int J_TR = T_ATTIN + T_UQ + T_UKV + T_ATTOUT + 2 * T_MLPIN + 2 * T_MLPOUT + T_CONVIN + T_CONVOUT;

struct TJ { const float* src; bf16_t* dst; int N, nvalid, lddst, perm, kt, nt; };
DI TJ tr_decode(const Params& p, int j) {
  char* ws = p.ws;
  TJ t; t.perm = 0;
  if (j < T_ATTIN) { t.src = p.w_att_in; t.N = 1952; t.nvalid = 1952; t.dst = (bf16_t*)(ws + O_WATTIN); t.lddst = 1024; t.kt = j / 16; t.nt = j % 16; return t; }
  j -= T_ATTIN;
  if (j < T_UQ) { t.src = p.w_uq; t.N = 768; t.nvalid = 768; t.dst = (bf16_t*)(ws + O_WUQ); t.lddst = 256; t.kt = j / 6; t.nt = j % 6; return t; }
  j -= T_UQ;
  if (j < T_UKV) { t.src = p.w_ukv; t.N = 1024; t.nvalid = 1024; t.dst = (bf16_t*)(ws + O_WUKV); t.lddst = 128; t.kt = j / 8; t.nt = j % 8; return t; }
  j -= T_UKV;
  if (j < T_ATTOUT) { t.src = p.w_att_out; t.N = 1024; t.nvalid = 1024; t.dst = (bf16_t*)(ws + O_WATTOUT); t.lddst = 1024; t.kt = j / 8; t.nt = j % 8; return t; }
  j -= T_ATTOUT;
  if (j < 2 * T_MLPIN) { const int l = j / T_MLPIN, u = j % T_MLPIN; t.src = p.w_mlp_in + (size_t)l * 1024 * 4096; t.N = 4096; t.nvalid = 4096; t.dst = (bf16_t*)(ws + O_WMLPIN) + (size_t)l * 4096 * 1024; t.lddst = 1024; t.kt = u / 32; t.nt = u % 32; return t; }
  j -= 2 * T_MLPIN;
  if (j < 2 * T_MLPOUT) { const int l = j / T_MLPOUT, u = j % T_MLPOUT; t.src = p.w_mlp_out + (size_t)l * 4096 * 1024; t.N = 1024; t.nvalid = 1024; t.dst = (bf16_t*)(ws + O_WMLPOUT) + (size_t)l * 4096 * 1024; t.lddst = 4096; t.kt = u / 8; t.nt = u % 8; return t; }
  j -= 2 * T_MLPOUT;
  if (j < T_CONVIN) { t.src = p.w_conv_in; t.N = 1536; t.nvalid = 1536; t.dst = (bf16_t*)(ws + O_WCONVIN); t.lddst = 1024; t.perm = 1; t.kt = j / 12; t.nt = j % 12; return t; }
  j -= T_CONVIN;
  t.src = p.w_conv_out; t.N = 1024; t.nvalid = 1024; t.dst = (bf16_t*)(ws + O_WCONVOUT); t.lddst = 1024; t.kt = j / 8; t.nt = j % 8; return t;
}
DI void tr_load(const TJ& t, float (&v)[16]) {
  const int tid = threadIdx.x, n = tid & 127, kb = tid >> 7;
  const int gn = t.nt * 128 + n;
  const float* s = t.src + (size_t)(t.kt * 64 + kb) * t.N + gn;
#pragma unroll
  for (int i = 0; i < 16; ++i) v[i] = (gn < t.nvalid) ? s[(size_t)(4 * i) * t.N] : 0.f;
}

DI void phase0(const Params& p, char* smem) {
  const int tid = threadIdx.x, lane = tid & 63, wid = tid >> 6;
  char* ws = p.ws;
  for (int job = blockIdx.x; job < J_SLOW; job += gridDim.x) {
    int j = job;
    if (j < J_MODS) {
      const int l = j / 96, cc = j % 96;
      float* sc = (float*)smem;
      for (int i = tid; i < 3072; i += NT) { const int ci = i >> 10, k = i & 1023; const float x = ci == 0 ? p.c_ctx[k] : p.c[(ci - 1) * 1024 + k]; sc[i] = x / (1.f + __expf(-x)); }
      __syncthreads();
      const int kg = tid >> 6, cl = tid & 63;
      const float* w = p.w_ada + (size_t)l * 1024 * 6144 + cc * 64 + cl;
      float s0 = 0.f, s1 = 0.f, s2 = 0.f;
#pragma unroll 16
      for (int k = kg * 128; k < kg * 128 + 128; ++k) { const float wv = w[(size_t)k * 6144]; s0 += sc[k] * wv; s1 += sc[1024 + k] * wv; s2 += sc[2048 + k] * wv; }
      float* r = (float*)(smem + 12288);
      r[(kg * 3 + 0) * 64 + cl] = s0; r[(kg * 3 + 1) * 64 + cl] = s1; r[(kg * 3 + 2) * 64 + cl] = s2;
      __syncthreads();
      if (tid < 192) {
        const int ci = tid >> 6, c2 = tid & 63;
        float s = 0.f;
#pragma unroll
        for (int g = 0; g < 8; ++g) s += r[(g * 3 + ci) * 64 + c2];
        ((float*)(ws + O_MODS))[(size_t)(l * 3 + ci) * 6144 + cc * 64 + c2] = s + p.b_ada[l * 6144 + cc * 64 + c2];
      }
      __syncthreads();
      continue;
    }
    j -= J_MODS;
    if (j < J_WEFF) {
      const int g = j >> 4, cch = (j >> 1) & 7, nch = j & 1;
      float* wp = (float*)smem;
      for (int i = tid; i < 2048; i += NT) wp[i] = p.w_pool[(size_t)(g * 128 + cch * 16 + (i >> 7)) * 128 + (i & 127)];
      __syncthreads();
      const int n = nch * 512 + tid;
      float a[16];
#pragma unroll
      for (int c = 0; c < 16; ++c) a[c] = 0.f;
#pragma unroll 4
      for (int e = 0; e < 128; ++e) {
        const float wo = p.w_conv_out[(size_t)(512 + g * 128 + e) * 1024 + n] * p.pool_scale[g * 128 + e];
#pragma unroll
        for (int c = 0; c < 16; ++c) a[c] += wp[c * 128 + e] * wo;
      }
      bf16_t* d = (bf16_t*)(ws + O_WCONVOUT) + (size_t)n * 1024 + 512 + g * 128 + cch * 16;
      *(u32x4*)d = (u32x4){pack2(a[0], a[1]), pack2(a[2], a[3]), pack2(a[4], a[5]), pack2(a[6], a[7])};
      *(u32x4*)(d + 8) = (u32x4){pack2(a[8], a[9]), pack2(a[10], a[11]), pack2(a[12], a[13]), pack2(a[14], a[15])};
      __syncthreads();
      continue;
    }
    j -= J_WEFF;
    if (j < J_CACHE) {
      const int rr = j * 8 + wid, b = rr >> 8, t = rr & 255;
      const size_t kr = NCTX + (size_t)b * TKL + t;
      const f32x4 a0 = *(const f32x4*)(p.cache_k + (size_t)rr * 512 + lane * 8), a1 = *(const f32x4*)(p.cache_k + (size_t)rr * 512 + lane * 8 + 4);
      *(u32x4*)((bf16_t*)(ws + O_KD) + kr * 512 + lane * 8) = (u32x4){pack2(a0[0], a0[1]), pack2(a0[2], a0[3]), pack2(a1[0], a1[1]), pack2(a1[2], a1[3])};
      const f32x4 b0 = *(const f32x4*)(p.cache_v + (size_t)rr * 512 + lane * 8), b1 = *(const f32x4*)(p.cache_v + (size_t)rr * 512 + lane * 8 + 4);
      *(u32x4*)((bf16_t*)(ws + O_VD) + kr * 512 + lane * 8) = (u32x4){pack2(b0[0], b0[1]), pack2(b0[2], b0[3]), pack2(b1[0], b1[1]), pack2(b1[2], b1[3])};
      const f32x2 cv = *(const f32x2*)(p.cache_ckv + (size_t)rr * 128 + lane * 2);
      *(unsigned*)((bf16_t*)(ws + O_CKVN) + kr * 128 + lane * 2) = pack2(cv[0], cv[1]);
      const int idx = lane & 31;
      const float x = p.cache_krope[(size_t)rr * 32 + idx];
      const unsigned pk = pack2(x, x);
#pragma unroll
      for (int k = 0; k < 4; ++k) { const int hh = (lane >> 5) + 2 * k; ((bf16_t*)(ws + O_KMLA))[kr * 768 + hh * 96 + 64 + idx] = (bf16_t)(pk & 0xffff); }
      continue;
    }
    j -= J_CACHE;
    {
      float* c16 = (float*)(ws + O_C16); float* s16 = (float*)(ws + O_S16); float* c8 = (float*)(ws + O_C8); float* s8 = (float*)(ws + O_S8);
      for (int i = tid; i < 1024 + 512; i += NT) {
        int pos, f, half;
        if (i < 1024) { pos = i >> 4; f = i & 15; half = 16; } else { const int q = i - 1024; pos = q >> 3; f = q & 7; half = 8; }
        const float inv = (float)exp(-9.210340371976184 * (double)f / (double)half);
        const float angf = (float)pos * inv;
        const double ang = (double)angf;
        const double r = ang - 6.283185307179586 * rint(ang * 0.15915494309189535);
        const float cs = (float)cos_red(r), sn = (float)sin_red(r);
        if (i < 1024) { c16[i] = cs; s16[i] = sn; } else { c8[i - 1024] = cs; s8[i - 1024] = sn; }
      }
      if (wid == 0) {
        const float d1 = wave_sum(p.lam_q1[lane] * p.lam_k1[lane]), d2 = wave_sum(p.lam_q2[lane] * p.lam_k2[lane]);
        if (lane == 0) ((float*)(ws + O_SCAL))[0] = expf(d1) - expf(d2) + 0.2f;
      }
    }
  }
  {
    float* tile = (float*)smem;
    int j = (blockIdx.x + gridDim.x - (J_SLOW % gridDim.x)) % gridDim.x;
    float v[16];
    TJ cur;
    if (j < J_TR) { cur = tr_decode(p, j); tr_load(cur, v); }
    while (j < J_TR) {
      {
        const int n = tid & 127, kb = tid >> 7;
#pragma unroll
        for (int i = 0; i < 16; ++i) tile[(kb + 4 * i) * 129 + n] = v[i];
      }
      __syncthreads();
      const int jn = j + gridDim.x;
      TJ nxt = cur;
      if (jn < J_TR) { nxt = tr_decode(p, jn); tr_load(nxt, v); }
      {
        const int n = tid >> 2, ks = (tid & 3) * 16;
        int gn = cur.nt * 128 + n;
        if (cur.perm) { if (gn < 512) gn = 32 * (gn >> 4) + (gn & 15); else if (gn < 1024) { const int c = gn - 512; gn = 32 * (c >> 4) + 16 + (c & 15); } }
        unsigned w[8];
#pragma unroll
        for (int e = 0; e < 8; ++e) w[e] = pack2(tile[(ks + 2 * e) * 129 + n], tile[(ks + 2 * e + 1) * 129 + n]);
        bf16_t* d = cur.dst + (size_t)gn * cur.lddst + cur.kt * 64 + ks;
        *(u32x4*)d = (u32x4){w[0], w[1], w[2], w[3]};
        *(u32x4*)(d + 8) = (u32x4){w[4], w[5], w[6], w[7]};
      }
      __syncthreads();
      cur = nxt; j = jn;
    }
  }
}

DI void rope8(const float (&x)[8], float (&o)[8], int lane, const float* c16, const float* s16, int prow, int pcol) {
  const int L = lane & 7;
  const int pos = (L & 4) ? pcol : prow;
  const bool second = (L & 2) != 0;
  const int fb = (L & 1) * 8;
#pragma unroll
  for (int e = 0; e < 8; ++e) {
    const float y = __shfl_xor(x[e], 2);
    const float cs = c16[pos * 16 + fb + e], sn = s16[pos * 16 + fb + e];
    o[e] = second ? (y * sn + x[e] * cs) : (x[e] * cs - y * sn);
  }
}
DI void unpack8(const u32x4 w, float (&x)[8]) {
#pragma unroll
  for (int e = 0; e < 4; ++e) { x[2 * e] = bflo(w[e]); x[2 * e + 1] = bfhi(w[e]); }
}
DI u32x4 pack8(const float (&x)[8]) { return (u32x4){pack2(x[0], x[1]), pack2(x[2], x[3]), pack2(x[4], x[5]), pack2(x[6], x[7])}; }

DI void phase3(const Params& p) {
  char* ws = p.ws;
  const bf16_t* R = (const bf16_t*)(ws + O_R);
  bf16_t* Qda = (bf16_t*)(ws + O_QDA); bf16_t* Qdb = (bf16_t*)(ws + O_QDB); bf16_t* Kd = (bf16_t*)(ws + O_KD); bf16_t* Vd = (bf16_t*)(ws + O_VD);
  bf16_t* cqn = (bf16_t*)(ws + O_CQN); bf16_t* ckvn = (bf16_t*)(ws + O_CKVN); bf16_t* Km = (bf16_t*)(ws + O_KMLA);
  const float* c16 = (const float*)(ws + O_C16); const float* s16 = (const float*)(ws + O_S16); const float* c8 = (const float*)(ws + O_C8); const float* s8 = (const float*)(ws + O_S8);
  float* o_k = p.out + (size_t)NTOK * 1024; float* o_v = o_k + (size_t)NCTX * 512; float* o_ckv = o_v + (size_t)NCTX * 512; float* o_kr = o_ckv + (size_t)NCTX * 128;
  const int lane = threadIdx.x & 63, gw = blockIdx.x * NWAVE + (threadIdx.x >> 6), nw = gridDim.x * NWAVE;
  for (int row = gw; row < NTOK; row += nw) {
    const bool lat = row >= NCTX;
    const int rl = row - NCTX, b = rl >> 12, t = rl & (TLAT - 1), prow = t >> 6, pcol = t & 63;
    const size_t kr = lat ? (size_t)NCTX + (size_t)b * TKL + 256 + t : (size_t)row;
    const bf16_t* r = R + (size_t)row * RLD;
    float x[8], o[8];
    const u32x4 wq = *(const u32x4*)(r + lane * 8);
    *(u32x4*)(Qda + (size_t)row * 512 + lane * 8) = wq;
    if (lat) { unpack8(wq, x); rope8(x, o, lane, c16, s16, prow, pcol); *(u32x4*)(Qdb + (size_t)rl * 512 + lane * 8) = pack8(o); }
    const u32x4 wk = *(const u32x4*)(r + 512 + lane * 8);
    if (lat) { unpack8(wk, x); rope8(x, o, lane, c16, s16, prow, pcol); *(u32x4*)(Kd + kr * 512 + lane * 8) = pack8(o); }
    else {
      unpack8(wk, x);
      *(f32x4*)(o_k + (size_t)row * 512 + lane * 8) = (f32x4){x[0], x[1], x[2], x[3]};
      *(f32x4*)(o_k + (size_t)row * 512 + lane * 8 + 4) = (f32x4){x[4], x[5], x[6], x[7]};
      *(u32x4*)(Kd + kr * 512 + lane * 8) = wk;
    }
    const u32x4 wv = *(const u32x4*)(r + 1024 + lane * 8);
    *(u32x4*)(Vd + kr * 512 + lane * 8) = wv;
    if (!lat) {
      unpack8(wv, x);
      *(f32x4*)(o_v + (size_t)row * 512 + lane * 8) = (f32x4){x[0], x[1], x[2], x[3]};
      *(f32x4*)(o_v + (size_t)row * 512 + lane * 8 + 4) = (f32x4){x[4], x[5], x[6], x[7]};
    }
    {
      const u32x2 w = *(const u32x2*)(r + 1536 + lane * 4);
      const float a0 = bflo(w[0]), a1 = bfhi(w[0]), a2 = bflo(w[1]), a3 = bfhi(w[1]);
      const float ss = wave_sum(a0 * a0 + a1 * a1 + a2 * a2 + a3 * a3);
      const float sc = rsqrtf(ss * (1.f / 256.f) + EPS);
      const f32x4 g = *(const f32x4*)(p.q_norm_g + lane * 4);
      *(u32x2*)(cqn + (size_t)row * 256 + lane * 4) = (u32x2){pack2(a0 * sc * g[0], a1 * sc * g[1]), pack2(a2 * sc * g[2], a3 * sc * g[3])};
    }
    {
      const unsigned w = *(const unsigned*)(r + 1792 + lane * 2);
      const float a0 = bflo(w), a1 = bfhi(w);
      const float ss = wave_sum(a0 * a0 + a1 * a1);
      const float sc = rsqrtf(ss * (1.f / 128.f) + EPS);
      const f32x2 g = *(const f32x2*)(p.kv_norm_g + lane * 2);
      const float y0 = a0 * sc * g[0], y1 = a1 * sc * g[1];
      if (!lat) *(f32x2*)(o_ckv + (size_t)row * 128 + lane * 2) = (f32x2){y0, y1};
      *(unsigned*)(ckvn + kr * 128 + lane * 2) = pack2(y0, y1);
    }
    {
      const int idx = lane & 31;
      const float xv = bf2f(r[1920 + idx]);
      float ov = xv;
      if (lat) {
        const int pos = (idx & 16) ? pcol : prow;
        const int f = idx & 7;
        const float y = __shfl_xor(xv, 8);
        const float cs = c8[pos * 8 + f], sn = s8[pos * 8 + f];
        ov = (idx & 8) ? (y * sn + xv * cs) : (xv * cs - y * sn);
      } else if (lane < 32) o_kr[(size_t)row * 32 + idx] = xv;
      const bf16_t ob = (bf16_t)(pack2(ov, ov) & 0xffff);
#pragma unroll
      for (int k = 0; k < 4; ++k) { const int hh = (lane >> 5) + 2 * k; Km[kr * 768 + hh * 96 + 64 + idx] = ob; }
    }
  }
}

template <int DQK, int DV>
DI void attn_core(const bf16_t* __restrict__ Qa, const bf16_t* __restrict__ Qb, int ldq, const bf16_t* __restrict__ Kp, int ldk, const bf16_t* __restrict__ Vp, int ldv,
                  int Tk, int n_a, float c  , char* smem, f32x16 (&o)[DV / 32]) {
  constexpr int KS = DQK * 2 + 16, VS = DV * 2 + 64, BUF = 64 * (KS + VS);
  constexpr int KCH = DQK / 8, VCH = DV / 8, NKCH = 64 * KCH, NVCH = 64 * VCH, NKC = (NKCH + NT - 1) / NT, NVC = (NVCH + NT - 1) / NT;
  constexpr bool KG = (NKCH % NT) != 0, VG = (NVCH % NT) != 0;
  constexpr int NS = DQK / 16, NDT = DV / 32;
  const int tid = threadIdx.x, lane = tid & 63, wid = tid >> 6, h = lane >> 5, ql = lane & 31;
  bf16x8 qf[NS];
  {
    const bf16_t* q = Qa + (size_t)(wid * 32 + ql) * ldq + h * 8;
#pragma unroll
    for (int s = 0; s < NS; ++s) qf[s] = *(const bf16x8*)(q + s * 16);
  }
#pragma unroll
  for (int dt = 0; dt < NDT; ++dt)
#pragma unroll
    for (int r = 0; r < 16; ++r) o[dt][r] = 0.f;
  float m_run = -INFINITY, l_run = 0.f;
  u32x4 rk[NKC], rv[NVC];
  const int nt = Tk >> 6, ta = n_a >> 6;
  unsigned koff[NKC], voff[NVC];
#pragma unroll
  for (int i = 0; i < NKC; ++i) { const int ch = tid + NT * i, row = ch / KCH, kc = ch % KCH; koff[i] = (unsigned)(row * ldk + kc * 8); }
#pragma unroll
  for (int i = 0; i < NVC; ++i) { const int ch = tid + NT * i, row = ch / VCH, vc = ch % VCH; voff[i] = (unsigned)(row * ldv + vc * 8); }
  auto gload = [&](int t) {
    const bf16_t* kb = Kp + (size_t)t * 64 * ldk;
    const bf16_t* vbp = Vp + (size_t)t * 64 * ldv;
#pragma unroll
    for (int i = 0; i < NKC; ++i) if (!KG || i + 1 < NKC || tid + NT * i < NKCH) rk[i] = *(const u32x4*)(kb + koff[i]);
#pragma unroll
    for (int i = 0; i < NVC; ++i) if (!VG || i + 1 < NVC || tid + NT * i < NVCH) rv[i] = *(const u32x4*)(vbp + voff[i]);
  };
  auto lstoreK = [&](char* buf) {
#pragma unroll
    for (int i = 0; i < NKC; ++i) { const int ch = tid + NT * i, row = ch / KCH, kc = ch % KCH; if (!KG || i + 1 < NKC || ch < NKCH) *(u32x4*)(buf + row * KS + kc * 16) = rk[i]; }
  };
  auto lstoreV = [&](char* buf) {
#pragma unroll
    for (int i = 0; i < NVC; ++i) { const int ch = tid + NT * i, row = ch / VCH, vc = ch % VCH; if (!VG || i + 1 < NVC || ch < NVCH) *(u32x4*)(buf + 64 * KS + row * VS + vc * 16) = rv[i]; }
  };
  gload(0); lstoreK(smem); lstoreV(smem); lds_barrier();
  const int i16 = lane & 15, tq = i16 >> 2, tp = i16 & 3, G = (lane >> 4) & 1;
  auto run_tiles = [&](int t_begin, int t_end) {
  for (int t = t_begin; t < t_end; ++t) {
    char* cur = smem + (t & 1) * BUF;
    gload(min(t + 1, nt - 1));
    f32x16 st[2];
#pragma unroll
    for (int kt = 0; kt < 2; ++kt) {
#pragma unroll
      for (int r = 0; r < 16; ++r) st[kt][r] = 0.f;
#pragma unroll
      for (int s = 0; s < NS; ++s) {
        const bf16x8 kf = *(const bf16x8*)(cur + (kt * 32 + ql) * KS + s * 32 + h * 16);
        st[kt] = __builtin_amdgcn_mfma_f32_32x32x16_bf16(kf, qf[s], st[kt], 0, 0, 0);
      }
      __builtin_amdgcn_sched_barrier(0);
    }
    float mx = st[0][0];
#pragma unroll
    for (int kt = 0; kt < 2; ++kt)
#pragma unroll
      for (int r = 0; r < 16; ++r) mx = fmaxf(mx, st[kt][r]);
    mx = fmaxf(mx, __shfl_xor(mx, 32));
    const float m_new = fmaxf(m_run, mx);
    const float alpha = __builtin_amdgcn_exp2f((m_run - m_new) * c);
    const float mc = m_new * c;
    m_run = m_new;
    float ls = 0.f;
#pragma unroll
    for (int kt = 0; kt < 2; ++kt)
#pragma unroll
      for (int r = 0; r < 16; ++r) { const float pv = __builtin_amdgcn_exp2f(st[kt][r] * c - mc); st[kt][r] = pv; ls += pv; }
    l_run = l_run * alpha + ls;
    if (__any(alpha != 1.f)) {
#pragma unroll
      for (int dt = 0; dt < NDT; ++dt)
#pragma unroll
        for (int r = 0; r < 16; ++r) o[dt][r] *= alpha;
    }
    bf16x8 pf[2][2];
#pragma unroll
    for (int kt = 0; kt < 2; ++kt)
#pragma unroll
      for (int s2 = 0; s2 < 2; ++s2) {
        u32x4 w = {pack2(st[kt][8 * s2 + 0], st[kt][8 * s2 + 1]), pack2(st[kt][8 * s2 + 2], st[kt][8 * s2 + 3]), pack2(st[kt][8 * s2 + 4], st[kt][8 * s2 + 5]), pack2(st[kt][8 * s2 + 6], st[kt][8 * s2 + 7])};
        pf[kt][s2] = __builtin_bit_cast(bf16x8, w);
      }
    const char* vb = cur + 64 * KS + (4 * h + tq) * VS + 32 * G + 8 * tp;
#pragma unroll
    for (int kt = 0; kt < 2; ++kt)
#pragma unroll
      for (int s2 = 0; s2 < 2; ++s2) {
        bf16x8 vf[NDT];
#pragma unroll
        for (int dt = 0; dt < NDT; ++dt) {
          const char* a0 = vb + (kt * 32 + 16 * s2) * VS + dt * 64;
          const s16x4 lo = __builtin_amdgcn_ds_read_tr16_b64_v4i16((LDS_AS s16x4*)(a0));
          const s16x4 hi = __builtin_amdgcn_ds_read_tr16_b64_v4i16((LDS_AS s16x4*)(a0 + 8 * VS));
          vf[dt] = __builtin_shufflevector(lo, hi, 0, 1, 2, 3, 4, 5, 6, 7);
        }
#pragma unroll
        for (int dt = 0; dt < NDT; ++dt) o[dt] = __builtin_amdgcn_mfma_f32_32x32x16_bf16(vf[dt], pf[kt][s2], o[dt], 0, 0, 0);
        __builtin_amdgcn_sched_barrier(0);
      }
    lstoreK(smem + ((t + 1) & 1) * BUF); lstoreV(smem + ((t + 1) & 1) * BUF);
    lds_barrier();
  }
  };
  run_tiles(0, min(ta, nt));
  if (ta < nt) {
    const bf16_t* q = Qb + (size_t)(wid * 32 + ql) * ldq + h * 8;
#pragma unroll
    for (int s = 0; s < NS; ++s) qf[s] = *(const bf16x8*)(q + s * 16);
    run_tiles(ta, nt);
  }
  const float l = l_run + __shfl_xor(l_run, 32);
  const float inv = 1.f / l;
#pragma unroll
  for (int dt = 0; dt < NDT; ++dt)
#pragma unroll
    for (int r = 0; r < 16; ++r) o[dt][r] *= inv;
}

constexpr int U_DBIG = 128, U_MBIG = 256, U_DCTX = 64, U_MCTX = 128, U_TOTAL = U_DBIG + U_MBIG + U_DCTX + U_MCTX;

DI void phase_attn(const Params& p, char* smem, int cidx) {
  char* ws = p.ws;
  const bf16_t* Qda = (const bf16_t*)(ws + O_QDA); const bf16_t* Qdb = (const bf16_t*)(ws + O_QDB); const bf16_t* Kd = (const bf16_t*)(ws + O_KD); const bf16_t* Vd = (const bf16_t*)(ws + O_VD);
  const bf16_t* Qma = (const bf16_t*)(ws + O_QMA); const bf16_t* Qmb = (const bf16_t*)(ws + O_QMB); const bf16_t* Km = (const bf16_t*)(ws + O_KMLA); const bf16_t* Vm = (const bf16_t*)(ws + O_VMLA);
  bf16_t* cat = (bf16_t*)(ws + O_HB);
  float* otmp = (float*)(ws + O_OTMP) + (size_t)blockIdx.x * 32768;
  int* counter = (int*)(ws + O_CNT) + cidx;
  int* s_unit = (int*)(smem + 65532);
  const int tid = threadIdx.x, lane = tid & 63, wid = tid >> 6, h2 = lane >> 5, ql = lane & 31;
  const float lam = ((const float*)(ws + O_SCAL))[0];
  for (;;) {
    if (tid == 0) *s_unit = atomicAdd(counter, 1);
    __syncthreads();
    int u = __builtin_amdgcn_readfirstlane(*s_unit);
    __syncthreads();
    if (u >= U_TOTAL) break;
    bool diff; int qrow0, krow0, Tk, n_a, head; bool lat;
    if (u < U_DBIG) { diff = true; lat = true; const int b = u >> 6, hh = (u >> 4) & 3, qb = u & 15; head = hh; qrow0 = NCTX + b * TLAT + qb * 256; krow0 = NCTX + b * TKL; Tk = TKL; n_a = 256; }
    else if (u < U_DBIG + U_MBIG) { u -= U_DBIG; diff = false; lat = true; const int b = u >> 7, hh = (u >> 4) & 7, qb = u & 15; head = hh; qrow0 = NCTX + b * TLAT + qb * 256; krow0 = NCTX + b * TKL; Tk = TKL; n_a = 256; }
    else if (u < U_DBIG + U_MBIG + U_DCTX) { u -= U_DBIG + U_MBIG; diff = true; lat = false; const int sq = u >> 2, hh = u & 3; head = hh; qrow0 = sq * 256; krow0 = sq * 256; Tk = 256; n_a = 256; }
    else { u -= U_DBIG + U_MBIG + U_DCTX; diff = false; lat = false; const int sq = u >> 3, hh = u & 7; head = hh; qrow0 = sq * 256; krow0 = sq * 256; Tk = 256; n_a = 256; }
    const int qrowb = lat ? qrow0 - NCTX : 0;
    if (diff) {
      f32x16 o[4];
      const float c = 0.125f * 1.4426950408889634f;
#pragma unroll 1
      for (int m = 0; m < 2; ++m) {
        attn_core<64, 128>(Qda + (size_t)qrow0 * 512 + head * 128 + m * 64, Qdb + (size_t)qrowb * 512 + head * 128 + m * 64, 512,
                           Kd + (size_t)krow0 * 512 + head * 128 + m * 64, 512, Vd + (size_t)krow0 * 512 + head * 128, 512, Tk, n_a, c, smem, o);
        if (m == 0) {
#pragma unroll
          for (int dt = 0; dt < 4; ++dt)
#pragma unroll
            for (int rq = 0; rq < 4; ++rq) *(f32x4*)(otmp + tid * 64 + dt * 16 + rq * 4) = (f32x4){o[dt][4 * rq], o[dt][4 * rq + 1], o[dt][4 * rq + 2], o[dt][4 * rq + 3]};
        }
      }
      float ss = 0.f;
#pragma unroll
      for (int dt = 0; dt < 4; ++dt)
#pragma unroll
        for (int rq = 0; rq < 4; ++rq) {
          const f32x4 o0 = *(const f32x4*)(otmp + tid * 64 + dt * 16 + rq * 4);
#pragma unroll
          for (int e = 0; e < 4; ++e) { const float v = o0[e] - lam * o[dt][4 * rq + e]; o[dt][4 * rq + e] = v; ss += v * v; }
        }
      ss += __shfl_xor(ss, 32);
      const float sc = rsqrtf(ss * (1.f / 128.f) + EPS) * 0.8f;
      bf16_t* dst = cat + (size_t)(qrow0 + wid * 32 + ql) * 1024 + head * 128;
#pragma unroll
      for (int dt = 0; dt < 4; ++dt)
#pragma unroll
        for (int rq = 0; rq < 4; ++rq) {
          const int dv = dt * 32 + 8 * rq + 4 * h2;
          const f32x4 g = *(const f32x4*)(p.diff_norm_g + dv);
          u32x2 w = {pack2(o[dt][4 * rq] * sc * g[0], o[dt][4 * rq + 1] * sc * g[1]), pack2(o[dt][4 * rq + 2] * sc * g[2], o[dt][4 * rq + 3] * sc * g[3])};
          *(u32x2*)(dst + dv) = w;
        }
    } else {
      f32x16 o[2];
      const float c = 0.10206207261596575f * 1.4426950408889634f;
      attn_core<96, 64>(Qma + (size_t)qrow0 * 768 + head * 96, Qmb + (size_t)qrowb * 768 + head * 96, 768,
                        Km + (size_t)krow0 * 768 + head * 96, 768, Vm + (size_t)krow0 * 512 + head * 64, 512, Tk, n_a, c, smem, o);
      bf16_t* dst = cat + (size_t)(qrow0 + wid * 32 + ql) * 1024 + 512 + head * 64;
#pragma unroll
      for (int dt = 0; dt < 2; ++dt)
#pragma unroll
        for (int rq = 0; rq < 4; ++rq) {
          const int dv = dt * 32 + 8 * rq + 4 * h2;
          u32x2 w = {pack2(o[dt][4 * rq], o[dt][4 * rq + 1]), pack2(o[dt][4 * rq + 2], o[dt][4 * rq + 3])};
          *(u32x2*)(dst + dv) = w;
        }
    }
  }
}

DI void phase_conv(const Params& p, char* smem) {
  char* ws = p.ws;
  const bf16_t* Ug = (const bf16_t*)(ws + O_UG); const bf16_t* Pz = (const bf16_t*)(ws + O_PZ);
  bf16_t* cat = (bf16_t*)(ws + O_HB);
  const int tid = threadIdx.x, lane = tid & 63, half = tid >> 8, ht = tid & 255, hw4 = (tid >> 6) & 3;
  float* tile = (float*)smem + half * 8192;
  for (int up = blockIdx.x; up < NTOK / 32; up += gridDim.x) {
    const int t0 = (up * 2 + half) * 16;
    const int s0 = t0 < NCTX ? (t0 & ~255) : NCTX + ((t0 - NCTX) & ~(TLAT - 1));
    const int s1 = t0 < NCTX ? s0 + 256 : s0 + TLAT;
    {
      const int ch = ht * 2;
      float a0[16], a1[16];
#pragma unroll
      for (int o = 0; o < 16; ++o) { a0[o] = 0.f; a1[o] = 0.f; }
      f32x2 w[31];
#pragma unroll
      for (int j = 0; j < 31; ++j) w[j] = *(const f32x2*)(p.conv_w + j * 512 + ch);
#pragma unroll
      for (int i = 0; i < 46; ++i) {
        const int r = t0 - 15 + i;
        float u0 = 0.f, u1 = 0.f;
        if (r >= s0 && r < s1) { const unsigned v = *(const unsigned*)(Ug + (size_t)r * 512 + ch); u0 = bflo(v); u1 = bfhi(v); }
#pragma unroll
        for (int o = 0; o < 16; ++o) {
          const int j = i - o;
          if (j >= 0 && j <= 30) { a0[o] += u0 * w[j][0]; a1[o] += u1 * w[j][1]; }
        }
      }
      const f32x2 bias = *(const f32x2*)(p.conv_b + ch);
#pragma unroll
      for (int o = 0; o < 16; ++o) *(f32x2*)(tile + o * 512 + ch) = (f32x2){a0[o] + bias[0], a1[o] + bias[1]};
    }
    __syncthreads();
#pragma unroll 1
    for (int k = 0; k < 4; ++k) {
      const int o = hw4 * 4 + k, row = t0 + o;
      const f32x4 v0 = *(const f32x4*)(tile + o * 512 + lane * 4), v1 = *(const f32x4*)(tile + o * 512 + 256 + lane * 4);
      const float mean = wave_sum((v0[0] + v0[1]) + (v0[2] + v0[3]) + (v1[0] + v1[1]) + (v1[2] + v1[3])) * (1.f / 512.f);
      float q = 0.f;
#pragma unroll
      for (int e = 0; e < 4; ++e) { const float d0 = v0[e] - mean, d1 = v1[e] - mean; q += d0 * d0 + d1 * d1; }
      const float rstd = rsqrtf(wave_sum(q) * (1.f / 512.f) + EPS);
#pragma unroll
      for (int hlf = 0; hlf < 2; ++hlf) {
        const int col = hlf * 256 + lane * 4;
        const f32x4 v = hlf ? v1 : v0;
        const f32x4 g = *(const f32x4*)(p.conv_norm_g + col), bb = *(const f32x4*)(p.conv_norm_b + col);
        float y[4];
#pragma unroll
        for (int e = 0; e < 4; ++e) { const float z = (v[e] - mean) * rstd * g[e] + bb[e]; y[e] = z / (1.f + __expf(-z)); }
        *(u32x2*)(cat + (size_t)row * 1024 + col) = (u32x2){pack2(y[0], y[1]), pack2(y[2], y[3])};
      }
    }
    {
      const int ch = ht * 2, hw = 1 << hw4;
#pragma unroll 1
      for (int o = 0; o < 16; ++o) {
        const int r = t0 + o;
        const int lo = max(r - hw, s0), hi = min(r + hw - 1, s1 - 1);
        float a0 = 0.f, a1 = 0.f;
        for (int q = lo; q <= hi; ++q) { const unsigned v = *(const unsigned*)(Pz + (size_t)q * 512 + ch); a0 += bflo(v); a1 += bfhi(v); }
        const unsigned vc = *(const unsigned*)(Pz + (size_t)r * 512 + ch);
        const float ic = 1.f / (float)(hi - lo + 1);
        *(unsigned*)(cat + (size_t)r * 1024 + 512 + ch) = pack2(a0 * ic - bflo(vc), a1 * ic - bfhi(vc));
      }
    }
    __syncthreads();
  }
}

__global__ void __launch_bounds__(NT, 2) fwd_kernel(Params p, int ph_lo, int ph_hi) {
  __shared__ __attribute__((aligned(16))) char smem[2 * G_STAGE];
  __shared__ uint4 xb_words;
  cg::grid_group grid = cg::this_grid();
  char* ws = p.ws;
  if (threadIdx.x == 0) xb_words = make_uint4(0u, 0u, 0u, 0u);
  __syncthreads();
  const XcdBarrier xb = xcd_barrier_post((unsigned*)(ws + O_BAR), (volatile LDS_AS unsigned*)&xb_words);
  if (ph_lo > 1000) grid.sync();
  float* mods = (float*)(ws + O_MODS);
  bf16_t* Hb = (bf16_t*)(ws + O_HB);
  float* X = p.out;
#define GSYNC() xcd_barrier(xb)
#define PH_BEGIN(n) if (ph_lo <= n && n < ph_hi) { if (n > ph_lo) GSYNC();
#define PH_END }
#ifndef PROBE_DUP
#define PROBE_DUP 0
#endif
#ifndef PROBE_SYNCS
#define PROBE_SYNCS 0
#endif
#define DUP(n, ...) __VA_ARGS__; if ((PROBE_DUP >> n) & 1) { GSYNC(); __VA_ARGS__; }
  for (int i = 0; i < PROBE_SYNCS; ++i) GSYNC();
  PH_BEGIN(0) { DUP(0, phase0(p, smem)); } PH_END
  PH_BEGIN(1) { DUP(1, rows_phase(p.x_prompt, p.x_sample, false, nullptr, nullptr, nullptr, mods, 0, 1024, Hb)); } PH_END
  PH_BEGIN(2) { DUP(2, gemm_phase(Hb, 1024, (const bf16_t*)(ws + O_WATTIN), 1024, 1024, 64, 8, EpiRaw{(bf16_t*)(ws + O_R)}, smem)); } PH_END
  PH_BEGIN(3) { DUP(3, phase3(p)); } PH_END
  PH_BEGIN(4) {
        const int n1 = 64 * 3, n2 = 67 * 4;
        gemm_phase((const bf16_t*)(ws + O_CQN), 256, (const bf16_t*)(ws + O_WUQ), 256, 256, 64, 3,
                   EpiUq{(bf16_t*)(ws + O_QMA), (bf16_t*)(ws + O_QMB), (const float*)(ws + O_C8), (const float*)(ws + O_S8)}, smem, 0, n1 + n2);
        gemm_phase((const bf16_t*)(ws + O_CKVN), 128, (const bf16_t*)(ws + O_WUKV), 128, 128, 67, 4,
                   EpiUkv{(bf16_t*)(ws + O_KMLA), (bf16_t*)(ws + O_VMLA)}, smem, n1, n1 + n2);
  } PH_END
  PH_BEGIN(5) { phase_attn(p, smem, 0); if ((PROBE_DUP >> 5) & 1) { GSYNC(); phase_attn(p, smem, 1); } } PH_END
  PH_BEGIN(6) { DUP(6, gemm_phase(Hb, 1024, (const bf16_t*)(ws + O_WATTOUT), 1024, 1024, 64, 4, EpiRes{p.x_prompt, p.x_sample, mods + 2048, X}, smem)); } PH_END
  PH_BEGIN(7) { rows_phase(X, X + (size_t)NCTX * 1024, true, p.ln_mix_g, p.ln_mix_b, X, mods, 3072, 4096, Hb); } PH_END
  PH_BEGIN(8) { DUP(8, gemm_phase(Hb, 1024, (const bf16_t*)(ws + O_WMLPIN), 1024, 1024, 64, 16, EpiRelu2{(bf16_t*)(ws + O_U)}, smem)); } PH_END
  PH_BEGIN(9) { gemm_phase((const bf16_t*)(ws + O_U), 4096, (const bf16_t*)(ws + O_WMLPOUT), 4096, 4096, 64, 4, EpiRes{X, X + (size_t)NCTX * 1024, mods + 5120, X}, smem); } PH_END
  PH_BEGIN(10) { rows_phase(X, X + (size_t)NCTX * 1024, true, p.ln_mlp_g, p.ln_mlp_b, X, mods + 3 * 6144, 0, 1024, Hb); } PH_END
  PH_BEGIN(11) { DUP(11, gemm_phase(Hb, 1024, (const bf16_t*)(ws + O_WCONVIN), 1024, 1024, 64, 6, EpiConv{(bf16_t*)(ws + O_UG), (bf16_t*)(ws + O_PZ)}, smem)); } PH_END
  PH_BEGIN(12) { DUP(12, phase_conv(p, smem)); } PH_END
  PH_BEGIN(13) { gemm_phase(Hb, 1024, (const bf16_t*)(ws + O_WCONVOUT), 1024, 1024, 64, 4, EpiRes{X, X + (size_t)NCTX * 1024, mods + 3 * 6144 + 2048, X}, smem); } PH_END
  PH_BEGIN(14) { rows_phase(X, X + (size_t)NCTX * 1024, true, p.ln_mix_g + 1024, p.ln_mix_b + 1024, X, mods + 3 * 6144, 3072, 4096, Hb); } PH_END
  PH_BEGIN(15) { DUP(15, gemm_phase(Hb, 1024, (const bf16_t*)(ws + O_WMLPIN) + (size_t)4096 * 1024, 1024, 1024, 64, 16, EpiRelu2{(bf16_t*)(ws + O_U)}, smem)); } PH_END
  PH_BEGIN(16) { gemm_phase((const bf16_t*)(ws + O_U), 4096, (const bf16_t*)(ws + O_WMLPOUT) + (size_t)4096 * 1024, 4096, 4096, 64, 4, EpiRes{X, X + (size_t)NCTX * 1024, mods + 3 * 6144 + 5120, X}, smem); } PH_END
  PH_BEGIN(17) { rows_phase(X, X + (size_t)NCTX * 1024, true, p.ln_mlp_g + 1024, p.ln_mlp_b + 1024, X, nullptr, 0, 0, nullptr); } PH_END

}

extern "C" void kernel_launch(void* const* d_in, const int* in_sizes, int n_in, void* d_out, int out_size, void* d_ws, size_t ws_size, hipStream_t stream) {
  static int grid_blocks = 0;
  if (!grid_blocks) {
    int dev = 0, cus = 0, per_cu = 0;
    hipGetDevice(&dev);
    hipDeviceGetAttribute(&cus, hipDeviceAttributeMultiprocessorCount, dev);
    hipOccupancyMaxActiveBlocksPerMultiprocessor(&per_cu, fwd_kernel, NT, 0);
    if (per_cu > 1) per_cu = 1;
    if (per_cu < 1) per_cu = 1;
    grid_blocks = cus * per_cu;
    if (grid_blocks > 256) grid_blocks = 256;
  }
  if (ws_size < WS_NEED) { fprintf(stderr, "workspace too small: %zu < %zu\n", ws_size, (size_t)WS_NEED); return; }
  Params p{};
  const float** f = (const float**)&p;
  for (int i = 0; i < 35; ++i) f[i] = (const float*)d_in[i];
  p.out = (float*)d_out;
  p.ws = (char*)d_ws;
  hipMemsetAsync(d_ws, 0, 16384, stream);
  int lo = 0, hi = NPHASE;
  void* args[] = {&p, &lo, &hi};
  hipError_t e = hipLaunchCooperativeKernel((void*)fwd_kernel, dim3(grid_blocks), dim3(NT), args, 0, stream);
  if (e != hipSuccess) fprintf(stderr, "cooperative launch failed: %s (grid %d)\n", hipGetErrorString(e), grid_blocks);
}
```

```cpp
#include <hip/hip_runtime.h>
#include <hip/hip_cooperative_groups.h>
#include <cstdio>
#include <cstdint>
namespace cg = cooperative_groups;

typedef unsigned short bf16_t;
typedef short bf16x8 __attribute__((ext_vector_type(8)));
typedef short s16x4 __attribute__((ext_vector_type(4)));
typedef float f32x4 __attribute__((ext_vector_type(4)));
typedef float f32x2 __attribute__((ext_vector_type(2)));
typedef float f32x16 __attribute__((ext_vector_type(16)));
typedef unsigned u32x4 __attribute__((ext_vector_type(4)));
typedef unsigned u32x2 __attribute__((ext_vector_type(2)));
typedef __bf16 bf16v2 __attribute__((ext_vector_type(2)));
#define DI __device__ __forceinline__
#define LDS_AS __attribute__((address_space(3)))

constexpr int NTOK = 12288, NCTX = 4096, NKEY = 12800, TLAT = 4096, TKL = 4352;
constexpr int RLD = 1952;
constexpr float ALPHA = 1.41421356237f, EPS = 1e-5f;
constexpr int NPHASE = 18;
constexpr int NT = 512, NWAVE = 8;

constexpr size_t al(size_t x) { return (x + 255) & ~(size_t)255; }
constexpr size_t O_CNT = 0;
constexpr size_t O_BAR = 256;
constexpr size_t O_LNCNT = 14336;
constexpr size_t O_MODS = 16384;
constexpr size_t O_SCAL = O_MODS + al(2 * 3 * 6144 * 4);
constexpr size_t O_C16 = O_SCAL + 256;
constexpr size_t O_S16 = O_C16 + 4096;
constexpr size_t O_C8 = O_S16 + 4096;
constexpr size_t O_S8 = O_C8 + 2048;
constexpr size_t O_XBUF = O_S8 + 2048;
constexpr size_t O_WATTIN = O_XBUF + (size_t)4 * 256 * 192 * 2 * 4;
constexpr size_t O_WUQ = O_WATTIN + (size_t)2048 * 1024 * 2;
constexpr size_t O_WUKV = O_WUQ + (size_t)768 * 256 * 2;
constexpr size_t O_WATTOUT = O_WUKV + (size_t)1024 * 128 * 2;
constexpr size_t O_WMLPIN = O_WATTOUT + (size_t)1024 * 1024 * 2;
constexpr size_t O_WMLPOUT = O_WMLPIN + (size_t)2 * 4096 * 1024 * 2;
constexpr size_t O_WCONVIN = O_WMLPOUT + (size_t)2 * 4096 * 1024 * 2;
constexpr size_t O_WCONVOUT = O_WCONVIN + (size_t)1536 * 1024 * 2;
constexpr size_t O_HB = O_WCONVOUT + (size_t)1024 * 1024 * 2;
constexpr size_t O_BIG = O_HB + (size_t)NTOK * 1024 * 2;
constexpr size_t O_R = O_BIG;
constexpr size_t O_QMA = O_R;
constexpr size_t O_QMB = O_QMA + (size_t)NTOK * 768 * 2;
constexpr size_t O_QDA = O_R + al((size_t)NTOK * RLD * 2);
constexpr size_t O_QDB = O_QDA + (size_t)NTOK * 512 * 2;
constexpr size_t O_KD = O_QDB + (size_t)8192 * 512 * 2;
constexpr size_t O_VD = O_KD + (size_t)NKEY * 512 * 2;
constexpr size_t O_CQN = O_VD + (size_t)NKEY * 512 * 2;
constexpr size_t O_CKVN = O_CQN + (size_t)NTOK * 256 * 2;
constexpr size_t O_KMLA = O_CKVN + (size_t)NKEY * 128 * 2;
constexpr size_t O_VMLA = O_KMLA + (size_t)NKEY * 768 * 2;
constexpr size_t O_OTMP = O_VMLA + (size_t)NKEY * 512 * 2;
constexpr size_t O_ATT_END = O_OTMP + (size_t)512 * 16384 * 4;
constexpr size_t O_U = O_BIG;
constexpr size_t O_U_END = O_U + (size_t)NTOK * 4096 * 2;
constexpr size_t O_UG = O_BIG;
constexpr size_t O_PZ = O_UG + (size_t)NTOK * 512 * 2;
constexpr size_t WS_NEED = (O_ATT_END > O_U_END ? O_ATT_END : O_U_END);
static_assert(O_QMB + (size_t)8192 * 768 * 2 <= O_QDA, "Qm overlay must fit in R");
static_assert(WS_NEED <= (size_t)256 * 1024 * 1024, "workspace too large");

struct Params {
  const float *x_prompt, *x_sample, *cache_k, *cache_v, *cache_ckv, *cache_krope, *c, *c_ctx;
  const float *w_ada, *b_ada, *ln_mix_g, *ln_mix_b, *ln_mlp_g, *ln_mlp_b, *w_mlp_in, *w_mlp_out;
  const float *w_att_in, *w_uq, *w_ukv, *q_norm_g, *kv_norm_g, *lam_q1, *lam_k1, *lam_q2, *lam_k2, *diff_norm_g, *w_att_out;
  const float *w_conv_in, *conv_w, *conv_b, *conv_norm_g, *conv_norm_b, *w_pool, *pool_scale, *w_conv_out;
  float* out;
  char* ws;
};

DI unsigned pack2(float lo, float hi) { f32x2 v = {lo, hi}; bf16v2 b = __builtin_convertvector(v, bf16v2); return __builtin_bit_cast(unsigned, b); }
DI float bf2f(unsigned short u) { return __uint_as_float((unsigned)u << 16); }
DI float bflo(unsigned u) { return __uint_as_float(u << 16); }
DI float bfhi(unsigned u) { return __uint_as_float(u & 0xffff0000u); }
DI float wave_sum(float v) {
#pragma unroll
  for (int o = 32; o >= 1; o >>= 1) v += __shfl_xor(v, o);
  return v;
}
DI void lds_barrier() { asm volatile("s_waitcnt lgkmcnt(0)\n\ts_barrier" ::: "memory"); }
DI void dma16(const void* gsrc, unsigned lds_dst) {
  unsigned keep;
  asm volatile("s_mov_b32 %0, m0\n\ts_mov_b32 m0, %2\n\ts_nop 0\n\tglobal_load_lds_dwordx4 %1, off\n\ts_mov_b32 m0, %0" : "=&s"(keep) : "v"(gsrc), "s"(lds_dst) : "memory");
}
DI int cond_idx(int row) { return row < NCTX ? 0 : 1 + ((row - NCTX) >> 12); }


#define XB_TMO      128
#define XB_XCNT(j)  (256  + 64 * (j))
#define XB_XSUB(j)  (1280 + 64 * (j))
#define XB_XGEN(j)  (2304 + 64 * (j))
#define XB_TOP      3328
#define XB_TOPGEN   3392
#define XCD_BAR_WORDS 3456
#define XB_SPIN_CAP (1u << 18)
DI unsigned xb_ld(unsigned* p)              { return __hip_atomic_load(p, __ATOMIC_RELAXED, __HIP_MEMORY_SCOPE_AGENT); }
DI unsigned xb_add(unsigned* p, unsigned v) { return __hip_atomic_fetch_add(p, v, __ATOMIC_RELAXED, __HIP_MEMORY_SCOPE_AGENT); }
DI unsigned xb_xcc_id() { return (unsigned)__builtin_amdgcn_s_getreg((3 << 11) | 20) & 0xFu; }
#define XB_SPIN(cond, bar) do { unsigned _sp = 0; while (cond) { __builtin_amdgcn_s_sleep(1); \
    if ((++_sp & 255u) == 0u) { if (xb_ld(&(bar)[XB_TMO])) break; if (_sp > XB_SPIN_CAP) { atomicAdd(&(bar)[XB_TMO], 1u); break; } } } } while (0)
struct XcdBarrier { unsigned* bar; unsigned x; volatile LDS_AS unsigned* st; };
DI XcdBarrier xcd_barrier_post(unsigned* bar, volatile LDS_AS unsigned* st) {
  XcdBarrier b; b.bar = bar; b.x = xb_xcc_id(); b.st = st;
  if (threadIdx.x == 0) (void)xb_add(&bar[XB_XCNT(b.x)], 1u);
  return b;
}
DI void xcd_barrier_complete(unsigned* bar, unsigned x, unsigned& nloc, unsigned& nx) {
  const unsigned G = gridDim.x * gridDim.y * gridDim.z;
  unsigned sum, cnt, mine, sp = 0u;
  for (;;) {
    sum = 0u; cnt = 0u; mine = 0u;
#pragma unroll
    for (unsigned j = 0; j < 16; ++j) { const unsigned c = xb_ld(&bar[XB_XCNT(j)]); sum += c; cnt += (c > 0u) ? 1u : 0u; mine = (j == x) ? c : mine; }
    if (sum == G) break;
    __builtin_amdgcn_s_sleep(1);
    if ((++sp & 255u) == 0u) { if (xb_ld(&bar[XB_TMO])) break; if (sp > XB_SPIN_CAP) { atomicAdd(&bar[XB_TMO], 1u); break; } }
  }
  nloc = mine > 0u ? mine : 1u; nx = cnt > 0u ? cnt : 1u;
}
DI void xcd_barrier(const XcdBarrier& b) {
  asm volatile("s_waitcnt vmcnt(0)" ::: "memory");
  __syncthreads();
  if (threadIdx.x == 0) {
    unsigned* bar = b.bar;
    __builtin_amdgcn_s_waitcnt(0);
    unsigned nloc = b.st[0], nx = b.st[1];
    if (nloc == 0u) { xcd_barrier_complete(bar, b.x, nloc, nx); b.st[0] = nloc; b.st[1] = nx; }
    const unsigned old = xb_add(&bar[XB_XSUB(b.x)], 1u);
    const unsigned gen = old / nloc;
    if (old + 1u == (gen + 1u) * nloc) {
      __builtin_amdgcn_fence(__ATOMIC_RELEASE, "agent");
      asm volatile("s_waitcnt vmcnt(0)" ::: "memory");
      const unsigned og = xb_add(&bar[XB_TOP], 1u);
      const unsigned tg = og / nx;
      if (og + 1u == (tg + 1u) * nx) xb_add(&bar[XB_TOPGEN], 1u);
      else XB_SPIN(xb_ld(&bar[XB_TOPGEN]) == tg, bar);
      __builtin_amdgcn_fence(__ATOMIC_ACQUIRE, "agent");
      xb_add(&bar[XB_XGEN(b.x)], 1u);
      asm volatile("s_waitcnt vmcnt(0)" ::: "memory");
    } else {
      XB_SPIN(xb_ld(&bar[XB_XGEN(b.x)]) == gen, bar);
      __builtin_amdgcn_fence(__ATOMIC_ACQUIRE, "agent");
      asm volatile("s_waitcnt vmcnt(0)" ::: "memory");
    }
  }
  __syncthreads();
}

DI int swz(int row, int kc) { return row * 128 + ((kc ^ ((row >> 1) & 7)) << 4); }

constexpr int G_BM = 192, G_BN = 256, G_MI = 6, G_NJ = 4, G_ABYTES = G_BM * 128, G_STAGE = G_ABYTES + G_BN * 128;
template <class Epi>
DI void gemm_tile(const bf16_t* __restrict__ A, int lda, const bf16_t* __restrict__ Bt, int ldb, int K, int row0, int col0, char* smem, const Epi& epi) {
  const int tid = threadIdx.x, lane = tid & 63, wid = tid >> 6, wr = wid >> 2, wc = wid & 3;
  const int fr = lane & 15, fq = lane >> 4;
  f32x4 acc[G_MI][G_NJ];
#pragma unroll
  for (int i = 0; i < G_MI; ++i)
#pragma unroll
    for (int j = 0; j < G_NJ; ++j) acc[i][j] = (f32x4){0.f, 0.f, 0.f, 0.f};
  const int srow = tid >> 3, skc = tid & 7;
  const int schunk = skc ^ ((srow >> 1) & 7);
  const bf16_t* ga = A + (size_t)(row0 + srow) * lda + schunk * 8;
  const bf16_t* gb = Bt + (size_t)(col0 + srow) * ldb + schunk * 8;
  const int nk = K >> 6;
  const unsigned lds0 = __builtin_amdgcn_readfirstlane((unsigned)(size_t)(LDS_AS char*)smem + (unsigned)(tid & ~63) * 16u);
#define G_DMA(stage_off_, kt_) do { const int k0_ = (kt_) << 6; const unsigned sb_ = lds0 + (unsigned)(stage_off_); \
    _Pragma("unroll") for (int i = 0; i < 3; ++i) dma16(ga + (size_t)(64 * i) * lda + k0_, sb_ + i * 8192); \
    _Pragma("unroll") for (int i = 0; i < 4; ++i) dma16(gb + (size_t)(64 * i) * ldb + k0_, sb_ + G_ABYTES + i * 8192); } while (0)
#define G_COMPUTE(buf_) do { const char* cur = (buf_); \
    _Pragma("unroll") for (int s = 0; s < 2; ++s) { \
      bf16x8 af[G_MI], bfr[G_NJ]; \
      _Pragma("unroll") for (int i = 0; i < G_MI; ++i) af[i] = *(const bf16x8*)(cur + swz(wr * 96 + i * 16 + fr, s * 4 + fq)); \
      _Pragma("unroll") for (int j = 0; j < G_NJ; ++j) bfr[j] = *(const bf16x8*)(cur + G_ABYTES + swz(wc * 64 + j * 16 + fr, s * 4 + fq)); \
      _Pragma("unroll") for (int i = 0; i < G_MI; ++i) \
        _Pragma("unroll") for (int j = 0; j < G_NJ; ++j) acc[i][j] = __builtin_amdgcn_mfma_f32_16x16x32_bf16(bfr[j], af[i], acc[i][j], 0, 0, 0); \
    } } while (0)
  G_DMA(0, 0);
  asm volatile("s_waitcnt vmcnt(0)" ::: "memory");
  lds_barrier();
  for (int kt = 0; kt < nk; kt += 2) {
    G_DMA(G_STAGE, kt + 1);
    G_COMPUTE(smem);
    asm volatile("s_waitcnt vmcnt(0)" ::: "memory");
    lds_barrier();
    G_DMA(0, min(kt + 2, nk - 1));
    G_COMPUTE(smem + G_STAGE);
    asm volatile("s_waitcnt vmcnt(0)" ::: "memory");
    lds_barrier();
  }
#undef G_DMA
#undef G_COMPUTE
  epi(acc, row0 + wr * 96, col0 + wc * 64, lane);
}


struct EpiRaw {
  bf16_t* R;
  DI void operator()(f32x4 (&acc)[G_MI][G_NJ], int rbase, int cbase, int lane) const {
    const int fr = lane & 15, fq = lane >> 4;
#pragma unroll
    for (int i = 0; i < G_MI; ++i)
#pragma unroll
      for (int j = 0; j < G_NJ; ++j) {
        const int row = rbase + i * 16 + fr, col = cbase + j * 16 + fq * 4;
        if (col < RLD) { u32x2 w = {pack2(acc[i][j][0], acc[i][j][1]), pack2(acc[i][j][2], acc[i][j][3])}; *(u32x2*)(R + (size_t)row * RLD + col) = w; }
      }
  }
};

struct EpiUq {
  bf16_t *Qa, *Qb; const float *c8, *s8;
  DI void operator()(f32x4 (&acc)[G_MI][G_NJ], int rbase, int cbase, int lane) const {
    const int fr = lane & 15, fq = lane >> 4;
#pragma unroll
    for (int i = 0; i < G_MI; ++i) {
      const bool lat = (rbase + i * 16) >= NCTX;
      const int row = rbase + i * 16 + fr;
      const int t = (row - NCTX) & (TLAT - 1);
#pragma unroll
      for (int j = 0; j < G_NJ; ++j) {
        const int cf = cbase + j * 16, col = cf + fq * 4;
        f32x4 v = acc[i][j];
        u32x2 w = {pack2(v[0], v[1]), pack2(v[2], v[3])};
        *(u32x2*)(Qa + (size_t)row * 768 + col) = w;
        if (lat) {
          const int w96 = cf % 96;
          if (w96 >= 64) {
            const int pos = (w96 == 64) ? (t >> 6) : (t & 63);
            f32x4 o;
#pragma unroll
            for (int e = 0; e < 4; ++e) {
              const float pv = __shfl_xor(v[e], 32);
              const int f = (fq & 1) * 4 + e;
              const float cs = c8[pos * 8 + f], sn = s8[pos * 8 + f];
              o[e] = (fq < 2) ? (v[e] * cs - pv * sn) : (pv * sn + v[e] * cs);
            }
            w = (u32x2){pack2(o[0], o[1]), pack2(o[2], o[3])};
          }
          *(u32x2*)(Qb + (size_t)(row - NCTX) * 768 + col) = w;
        }
      }
    }
  }
};

struct EpiUkv {
  bf16_t *Km, *Vm;
  DI void operator()(f32x4 (&acc)[G_MI][G_NJ], int rbase, int cbase, int lane) const {
    const int fr = lane & 15, fq = lane >> 4;
    const int h = cbase >> 7, part = (cbase >> 6) & 1;
#pragma unroll
    for (int i = 0; i < G_MI; ++i) {
      if (rbase + i * 16 >= NKEY) continue;
#pragma unroll
      for (int j = 0; j < G_NJ; ++j) {
        const int row = rbase + i * 16 + fr, c = j * 16 + fq * 4;
        u32x2 w = {pack2(acc[i][j][0], acc[i][j][1]), pack2(acc[i][j][2], acc[i][j][3])};
        if (part == 0) *(u32x2*)(Km + (size_t)row * 768 + h * 96 + c) = w;
        else *(u32x2*)(Vm + (size_t)row * 512 + h * 64 + c) = w;
      }
    }
  }
};

struct EpiRes {
  const float *xin_ctx, *xin_lat, *gate  ; float* X;
  DI void operator()(f32x4 (&acc)[G_MI][G_NJ], int rbase, int cbase, int lane) const {
    const int fr = lane & 15, fq = lane >> 4;
#pragma unroll
    for (int i = 0; i < G_MI; ++i) {
      const int row = rbase + i * 16 + fr;
      const float* g = gate + cond_idx(rbase + i * 16) * 6144;
      const float* xin = row < NCTX ? xin_ctx + (size_t)row * 1024 : xin_lat + (size_t)(row - NCTX) * 1024;
#pragma unroll
      for (int j = 0; j < G_NJ; ++j) {
        const int col = cbase + j * 16 + fq * 4;
        const f32x4 xv = *(const f32x4*)(xin + col), gv = *(const f32x4*)(g + col);
        f32x4 z;
#pragma unroll
        for (int e = 0; e < 4; ++e) z[e] = ALPHA * xv[e] + gv[e] * acc[i][j][e];
        *(f32x4*)(X + (size_t)row * 1024 + col) = z;
      }
    }
  }
};


struct EpiResLN {
  const float *xin_ctx, *xin_lat, *gate; float* X;
  const float *lg, *lb, *modsL; int sh_off, sc_off; bf16_t* Hb;
  float* xbuf; unsigned* cnt; char* smem; bool fused;
  DI void operator()(f32x4 (&acc)[G_MI][G_NJ], int rbase, int cbase, int lane) const {
    const int tid = threadIdx.x, wid = tid >> 6, wr = wid >> 2, wc = wid & 3, fr = lane & 15, fq = lane >> 4;
#pragma unroll
    for (int i = 0; i < G_MI; ++i) {
      const int row = rbase + i * 16 + fr;
      const float* g = gate + cond_idx(rbase + i * 16) * 6144;
      const float* xin = row < NCTX ? xin_ctx + (size_t)row * 1024 : xin_lat + (size_t)(row - NCTX) * 1024;
#pragma unroll
      for (int j = 0; j < G_NJ; ++j) {
        const int col = cbase + j * 16 + fq * 4;
        const f32x4 xv = *(const f32x4*)(xin + col), gv = *(const f32x4*)(g + col);
#pragma unroll
        for (int e = 0; e < 4; ++e) acc[i][j][e] = ALPHA * xv[e] + gv[e] * acc[i][j][e];
        if (!fused) *(f32x4*)(X + (size_t)row * 1024 + col) = acc[i][j];
      }
    }
    if (!fused) return;
    const int row0 = rbase - wr * 96, pm = row0 / G_BM, pn = (cbase - wc * 64) / G_BN;
    f32x2* part = (f32x2*)smem;
    f32x2* stat = (f32x2*)(smem + 8192);
#pragma unroll
    for (int i = 0; i < G_MI; ++i) {
      float s1 = 0.f, s2 = 0.f;
#pragma unroll
      for (int j = 0; j < G_NJ; ++j)
#pragma unroll
        for (int e = 0; e < 4; ++e) { const float v = acc[i][j][e]; s1 += v; s2 += v * v; }
      s1 += __shfl_xor(s1, 16); s2 += __shfl_xor(s2, 16);
      s1 += __shfl_xor(s1, 32); s2 += __shfl_xor(s2, 32);
      if (fq == 0) part[(wr * 96 + i * 16 + fr) * 4 + wc] = (f32x2){s1, s2};
    }
    __syncthreads();
    if (tid < G_BM) {
      const f32x2 a = part[tid * 4 + 0], b = part[tid * 4 + 1], c = part[tid * 4 + 2], d = part[tid * 4 + 3];
      const float s1 = (a[0] + b[0]) + (c[0] + d[0]), s2 = (a[1] + b[1]) + (c[1] + d[1]);
      const unsigned long long pk = ((unsigned long long)__float_as_uint(s2) << 32) | (unsigned long long)__float_as_uint(s1);
      __hip_atomic_store((unsigned long long*)(xbuf + ((size_t)(pm * 4 + pn) * G_BM + tid) * 2), pk, __ATOMIC_RELAXED, __HIP_MEMORY_SCOPE_AGENT);
    }
    asm volatile("s_waitcnt vmcnt(0)" ::: "memory");
    __syncthreads();
    if (tid == 0) {
      __hip_atomic_fetch_add(cnt + pm, 1u, __ATOMIC_RELAXED, __HIP_MEMORY_SCOPE_AGENT);
      unsigned sp = 0;
      while (__hip_atomic_load(cnt + pm, __ATOMIC_RELAXED, __HIP_MEMORY_SCOPE_AGENT) < 4u) { __builtin_amdgcn_s_sleep(1); if (++sp > (1u << 22)) break; }
    }
    __syncthreads();
    if (tid < G_BM) {
      float s1 = 0.f, s2 = 0.f;
#pragma unroll
      for (int q = 0; q < 4; ++q) {
        const unsigned long long pk = __hip_atomic_load((unsigned long long*)(xbuf + ((size_t)(pm * 4 + q) * G_BM + tid) * 2), __ATOMIC_RELAXED, __HIP_MEMORY_SCOPE_AGENT);
        s1 += __uint_as_float((unsigned)pk); s2 += __uint_as_float((unsigned)(pk >> 32));
      }
      const float mean = s1 * (1.f / 1024.f);
      const float var = fmaxf(s2 * (1.f / 1024.f) - mean * mean, 0.f);
      stat[tid] = (f32x2){mean, rsqrtf(var + EPS)};
    }
    __syncthreads();
#pragma unroll
    for (int i = 0; i < G_MI; ++i) {
      const int row = rbase + i * 16 + fr;
      const f32x2 ms = stat[wr * 96 + i * 16 + fr];
      const float* m = modsL + cond_idx(rbase + i * 16) * 6144;
#pragma unroll
      for (int j = 0; j < G_NJ; ++j) {
        const int col = cbase + j * 16 + fq * 4;
        const f32x4 gv = *(const f32x4*)(lg + col), bv = *(const f32x4*)(lb + col);
        f32x4 x;
#pragma unroll
        for (int e = 0; e < 4; ++e) x[e] = (acc[i][j][e] - ms[0]) * ms[1] * gv[e] + bv[e];
        *(f32x4*)(X + (size_t)row * 1024 + col) = x;
        if (Hb) {
          const f32x4 sh = *(const f32x4*)(m + sh_off + col), sc = *(const f32x4*)(m + sc_off + col);
          u32x2 w = {pack2(x[0] * (1.f + sc[0]) + sh[0], x[1] * (1.f + sc[1]) + sh[1]), pack2(x[2] * (1.f + sc[2]) + sh[2], x[3] * (1.f + sc[3]) + sh[3])};
          *(u32x2*)(Hb + (size_t)row * 1024 + col) = w;
        }
      }
    }
    __syncthreads();
  }
};

struct EpiRelu2 {
  bf16_t* U;
  DI void operator()(f32x4 (&acc)[G_MI][G_NJ], int rbase, int cbase, int lane) const {
    const int fr = lane & 15, fq = lane >> 4;
#pragma unroll
    for (int i = 0; i < G_MI; ++i)
#pragma unroll
      for (int j = 0; j < G_NJ; ++j) {
        const int row = rbase + i * 16 + fr, col = cbase + j * 16 + fq * 4;
        f32x4 v = acc[i][j];
#pragma unroll
        for (int e = 0; e < 4; ++e) { const float r = fmaxf(v[e], 0.f); v[e] = r * r; }
        u32x2 w = {pack2(v[0], v[1]), pack2(v[2], v[3])};
        *(u32x2*)(U + (size_t)row * 4096 + col) = w;
      }
  }
};

struct EpiConv {
  bf16_t *Ug, *Pz;
  DI void operator()(f32x4 (&acc)[G_MI][G_NJ], int rbase, int cbase, int lane) const {
    const int fr = lane & 15, fq = lane >> 4;
#pragma unroll
    for (int i = 0; i < G_MI; ++i) {
      const int row = rbase + i * 16 + fr;
      if (cbase < 1024) {
#pragma unroll
        for (int jp = 0; jp < 2; ++jp) {
          const f32x4 a = acc[i][2 * jp], gt = acc[i][2 * jp + 1];
          f32x4 u;
#pragma unroll
          for (int e = 0; e < 4; ++e) u[e] = a[e] / (1.f + __expf(-gt[e]));
          const int ch = ((cbase + 32 * jp) >> 5) * 16 + fq * 4;
          u32x2 w = {pack2(u[0], u[1]), pack2(u[2], u[3])};
          *(u32x2*)(Ug + (size_t)row * 512 + ch) = w;
        }
      } else {
#pragma unroll
        for (int j = 0; j < G_NJ; ++j) {
          const int col = cbase - 1024 + j * 16 + fq * 4;
          u32x2 w = {pack2(acc[i][j][0], acc[i][j][1]), pack2(acc[i][j][2], acc[i][j][3])};
          *(u32x2*)(Pz + (size_t)row * 512 + col) = w;
        }
      }
    }
  }
};

template <class Epi>
DI void gemm_phase(const bf16_t* A, int lda, const bf16_t* Bt, int ldb, int K, int mt, int nt, const Epi& epi, char* smem, int tstart = 0, int ttotal = -1) {
  const int n = mt * nt;
  if (ttotal < 0) ttotal = n;
  for (int t = blockIdx.x; t < ttotal; t += gridDim.x) {
    const int u = t - tstart;
    if (u < 0 || u >= n) continue;
    const int pm = u / nt, pn = u - pm * nt;
    gemm_tile(A, lda, Bt, ldb, K, pm * G_BM, pn * G_BN, smem, epi);
  }
}

DI void rows_phase(const float* src_ctx, const float* src_lat, bool do_ln, const float* lg, const float* lb, float* Xdst,
                   const float* modsL, int sh_off, int sc_off, bf16_t* Hb) {
  const int lane = threadIdx.x & 63, gw = blockIdx.x * NWAVE + (threadIdx.x >> 6), nw = gridDim.x * NWAVE;
  for (int row = gw; row < NTOK; row += nw) {
    const float* src = row < NCTX ? src_ctx + (size_t)row * 1024 : src_lat + (size_t)(row - NCTX) * 1024;
    f32x4 v[4];
#pragma unroll
    for (int i = 0; i < 4; ++i) v[i] = *(const f32x4*)(src + i * 256 + lane * 4);
    if (do_ln) {
      float s = 0.f;
#pragma unroll
      for (int i = 0; i < 4; ++i) s += (v[i][0] + v[i][1]) + (v[i][2] + v[i][3]);
      const float mean = wave_sum(s) * (1.f / 1024.f);
      float q = 0.f;
#pragma unroll
      for (int i = 0; i < 4; ++i)
#pragma unroll
        for (int e = 0; e < 4; ++e) { const float d = v[i][e] - mean; q += d * d; }
      const float rstd = rsqrtf(wave_sum(q) * (1.f / 1024.f) + EPS);
#pragma unroll
      for (int i = 0; i < 4; ++i) {
        const f32x4 g = *(const f32x4*)(lg + i * 256 + lane * 4), b = *(const f32x4*)(lb + i * 256 + lane * 4);
#pragma unroll
        for (int e = 0; e < 4; ++e) v[i][e] = (v[i][e] - mean) * rstd * g[e] + b[e];
        if (Xdst) *(f32x4*)(Xdst + (size_t)row * 1024 + i * 256 + lane * 4) = v[i];
      }
    }
    if (Hb) {
      const float* m = modsL + cond_idx(row) * 6144;
#pragma unroll
      for (int i = 0; i < 4; ++i) {
        const int col = i * 256 + lane * 4;
        const f32x4 sh = *(const f32x4*)(m + sh_off + col), sc = *(const f32x4*)(m + sc_off + col);
        f32x4 h;
#pragma unroll
        for (int e = 0; e < 4; ++e) h[e] = v[i][e] * (1.f + sc[e]) + sh[e];
        u32x2 w = {pack2(h[0], h[1]), pack2(h[2], h[3])};
        *(u32x2*)(Hb + (size_t)row * 1024 + col) = w;
      }
    }
  }
}

DI double sin_red(double r) {
  const double r2 = r * r; double t = -1.0 / 51090942171709440000.0;
  t = t * r2 + 1.0 / 121645100408832000.0; t = t * r2 - 1.0 / 355687428096000.0; t = t * r2 + 1.0 / 1307674368000.0; t = t * r2 - 1.0 / 6227020800.0;
  t = t * r2 + 1.0 / 39916800.0; t = t * r2 - 1.0 / 362880.0; t = t * r2 + 1.0 / 5040.0; t = t * r2 - 1.0 / 120.0; t = t * r2 + 1.0 / 6.0;
  return r * (1.0 - r2 * t);
}
DI double cos_red(double r) {
  const double r2 = r * r; double t = 1.0 / 1124000727777607680000.0;
  t = t * r2 - 1.0 / 2432902008176640000.0; t = t * r2 + 1.0 / 6402373705728000.0; t = t * r2 - 1.0 / 20922789888000.0; t = t * r2 + 1.0 / 87178291200.0;
  t = t * r2 - 1.0 / 479001600.0; t = t * r2 + 1.0 / 3628800.0; t = t * r2 - 1.0 / 40320.0; t = t * r2 + 1.0 / 720.0; t = t * r2 - 1.0 / 24.0; t = t * r2 + 0.5; t = t * r2 * -1.0 + 1.0;
  return t;
}

constexpr int J_MODS = 192, J_WEFF = 64, J_CACHE = 64, J_ROPE = 1, J_SLOW = J_MODS + J_WEFF + J_CACHE + J_ROPE;
constexpr int T_ATTIN = 16 * 16, T_UQ = 4 * 6, T_UKV = 2 * 8, T_ATTOUT = 16 * 8, T_MLPIN = 16 * 32, T_MLPOUT = 64 * 8, T_CONVIN = 16 * 12, T_CONVOUT = 8 * 8;
constexpr int J_TR = T_ATTIN + T_UQ + T_UKV + T_ATTOUT + 2 * T_MLPIN + 2 * T_MLPOUT + T_CONVIN + T_CONVOUT;

struct TJ { const float* src; bf16_t* dst; int N, nvalid, lddst, perm, kt, nt; };
DI TJ tr_decode(const Params& p, int j) {
  char* ws = p.ws;
  TJ t; t.perm = 0;
  if (j < T_ATTIN) { t.src = p.w_att_in; t.N = 1952; t.nvalid = 1952; t.dst = (bf16_t*)(ws + O_WATTIN); t.lddst = 1024; t.kt = j / 16; t.nt = j % 16; return t; }
  j -= T_ATTIN;
  if (j < T_UQ) { t.src = p.w_uq; t.N = 768; t.nvalid = 768; t.dst = (bf16_t*)(ws + O_WUQ); t.lddst = 256; t.kt = j / 6; t.nt = j % 6; return t; }
  j -= T_UQ;
  if (j < T_UKV) { t.src = p.w_ukv; t.N = 1024; t.nvalid = 1024; t.dst = (bf16_t*)(ws + O_WUKV); t.lddst = 128; t.kt = j / 8; t.nt = j % 8; return t; }
  j -= T_UKV;
  if (j < T_ATTOUT) { t.src = p.w_att_out; t.N = 1024; t.nvalid = 1024; t.dst = (bf16_t*)(ws + O_WATTOUT); t.lddst = 1024; t.kt = j / 8; t.nt = j % 8; return t; }
  j -= T_ATTOUT;
  if (j < 2 * T_MLPIN) { const int l = j / T_MLPIN, u = j % T_MLPIN; t.src = p.w_mlp_in + (size_t)l * 1024 * 4096; t.N = 4096; t.nvalid = 4096; t.dst = (bf16_t*)(ws + O_WMLPIN) + (size_t)l * 4096 * 1024; t.lddst = 1024; t.kt = u / 32; t.nt = u % 32; return t; }
  j -= 2 * T_MLPIN;
  if (j < 2 * T_MLPOUT) { const int l = j / T_MLPOUT, u = j % T_MLPOUT; t.src = p.w_mlp_out + (size_t)l * 4096 * 1024; t.N = 1024; t.nvalid = 1024; t.dst = (bf16_t*)(ws + O_WMLPOUT) + (size_t)l * 4096 * 1024; t.lddst = 4096; t.kt = u / 8; t.nt = u % 8; return t; }
  j -= 2 * T_MLPOUT;
  if (j < T_CONVIN) { t.src = p.w_conv_in; t.N = 1536; t.nvalid = 1536; t.dst = (bf16_t*)(ws + O_WCONVIN); t.lddst = 1024; t.perm = 1; t.kt = j / 12; t.nt = j % 12; return t; }
  j -= T_CONVIN;
  t.src = p.w_conv_out; t.N = 1024; t.nvalid = 1024; t.dst = (bf16_t*)(ws + O_WCONVOUT); t.lddst = 1024; t.kt = j / 8; t.nt = j % 8; return t;
}
DI void tr_load(const TJ& t, float (&v)[16]) {
  const int tid = threadIdx.x, n = tid & 127, kb = tid >> 7;
  const int gn = t.nt * 128 + n;
  const float* s = t.src + (size_t)(t.kt * 64 + kb) * t.N + gn;
#pragma unroll
  for (int i = 0; i < 16; ++i) v[i] = (gn < t.nvalid) ? s[(size_t)(4 * i) * t.N] : 0.f;
}

DI void phase0(const Params& p, char* smem) {
  const int tid = threadIdx.x, lane = tid & 63, wid = tid >> 6;
  char* ws = p.ws;
  for (int job = blockIdx.x; job < J_SLOW; job += gridDim.x) {
    int j = job;
    if (j < J_MODS) {
      const int l = j / 96, cc = j % 96;
      float* sc = (float*)smem;
      for (int i = tid; i < 3072; i += NT) { const int ci = i >> 10, k = i & 1023; const float x = ci == 0 ? p.c_ctx[k] : p.c[(ci - 1) * 1024 + k]; sc[i] = x / (1.f + __expf(-x)); }
      __syncthreads();
      const int kg = tid >> 6, cl = tid & 63;
      const float* w = p.w_ada + (size_t)l * 1024 * 6144 + cc * 64 + cl;
      float s0 = 0.f, s1 = 0.f, s2 = 0.f;
#pragma unroll 16
      for (int k = kg * 128; k < kg * 128 + 128; ++k) { const float wv = w[(size_t)k * 6144]; s0 += sc[k] * wv; s1 += sc[1024 + k] * wv; s2 += sc[2048 + k] * wv; }
      float* r = (float*)(smem + 12288);
      r[(kg * 3 + 0) * 64 + cl] = s0; r[(kg * 3 + 1) * 64 + cl] = s1; r[(kg * 3 + 2) * 64 + cl] = s2;
      __syncthreads();
      if (tid < 192) {
        const int ci = tid >> 6, c2 = tid & 63;
        float s = 0.f;
#pragma unroll
        for (int g = 0; g < 8; ++g) s += r[(g * 3 + ci) * 64 + c2];
        ((float*)(ws + O_MODS))[(size_t)(l * 3 + ci) * 6144 + cc * 64 + c2] = s + p.b_ada[l * 6144 + cc * 64 + c2];
      }
      __syncthreads();
      continue;
    }
    j -= J_MODS;
    if (j < J_WEFF) {
      const int g = j >> 4, cch = (j >> 1) & 7, nch = j & 1;
      float* wp = (float*)smem;
      for (int i = tid; i < 2048; i += NT) wp[i] = p.w_pool[(size_t)(g * 128 + cch * 16 + (i >> 7)) * 128 + (i & 127)];
      __syncthreads();
      const int n = nch * 512 + tid;
      float a[16];
#pragma unroll
      for (int c = 0; c < 16; ++c) a[c] = 0.f;
#pragma unroll 4
      for (int e = 0; e < 128; ++e) {
        const float wo = p.w_conv_out[(size_t)(512 + g * 128 + e) * 1024 + n] * p.pool_scale[g * 128 + e];
#pragma unroll
        for (int c = 0; c < 16; ++c) a[c] += wp[c * 128 + e] * wo;
      }
      bf16_t* d = (bf16_t*)(ws + O_WCONVOUT) + (size_t)n * 1024 + 512 + g * 128 + cch * 16;
      *(u32x4*)d = (u32x4){pack2(a[0], a[1]), pack2(a[2], a[3]), pack2(a[4], a[5]), pack2(a[6], a[7])};
      *(u32x4*)(d + 8) = (u32x4){pack2(a[8], a[9]), pack2(a[10], a[11]), pack2(a[12], a[13]), pack2(a[14], a[15])};
      __syncthreads();
      continue;
    }
    j -= J_WEFF;
    if (j < J_CACHE) {
      const int rr = j * 8 + wid, b = rr >> 8, t = rr & 255;
      const size_t kr = NCTX + (size_t)b * TKL + t;
      const f32x4 a0 = *(const f32x4*)(p.cache_k + (size_t)rr * 512 + lane * 8), a1 = *(const f32x4*)(p.cache_k + (size_t)rr * 512 + lane * 8 + 4);
      *(u32x4*)((bf16_t*)(ws + O_KD) + kr * 512 + lane * 8) = (u32x4){pack2(a0[0], a0[1]), pack2(a0[2], a0[3]), pack2(a1[0], a1[1]), pack2(a1[2], a1[3])};
      const f32x4 b0 = *(const f32x4*)(p.cache_v + (size_t)rr * 512 + lane * 8), b1 = *(const f32x4*)(p.cache_v + (size_t)rr * 512 + lane * 8 + 4);
      *(u32x4*)((bf16_t*)(ws + O_VD) + kr * 512 + lane * 8) = (u32x4){pack2(b0[0], b0[1]), pack2(b0[2], b0[3]), pack2(b1[0], b1[1]), pack2(b1[2], b1[3])};
      const f32x2 cv = *(const f32x2*)(p.cache_ckv + (size_t)rr * 128 + lane * 2);
      *(unsigned*)((bf16_t*)(ws + O_CKVN) + kr * 128 + lane * 2) = pack2(cv[0], cv[1]);
      const int idx = lane & 31;
      const float x = p.cache_krope[(size_t)rr * 32 + idx];
      const unsigned pk = pack2(x, x);
#pragma unroll
      for (int k = 0; k < 4; ++k) { const int hh = (lane >> 5) + 2 * k; ((bf16_t*)(ws + O_KMLA))[kr * 768 + hh * 96 + 64 + idx] = (bf16_t)(pk & 0xffff); }
      continue;
    }
    j -= J_CACHE;
    {
      float* c16 = (float*)(ws + O_C16); float* s16 = (float*)(ws + O_S16); float* c8 = (float*)(ws + O_C8); float* s8 = (float*)(ws + O_S8);
      for (int i = tid; i < 1024 + 512; i += NT) {
        int pos, f, half;
        if (i < 1024) { pos = i >> 4; f = i & 15; half = 16; } else { const int q = i - 1024; pos = q >> 3; f = q & 7; half = 8; }
        const float inv = (float)exp(-9.210340371976184 * (double)f / (double)half);
        const float angf = (float)pos * inv;
        const double ang = (double)angf;
        const double r = ang - 6.283185307179586 * rint(ang * 0.15915494309189535);
        const float cs = (float)cos_red(r), sn = (float)sin_red(r);
        if (i < 1024) { c16[i] = cs; s16[i] = sn; } else { c8[i - 1024] = cs; s8[i - 1024] = sn; }
      }
      if (wid == 0) {
        const float d1 = wave_sum(p.lam_q1[lane] * p.lam_k1[lane]), d2 = wave_sum(p.lam_q2[lane] * p.lam_k2[lane]);
        if (lane == 0) ((float*)(ws + O_SCAL))[0] = expf(d1) - expf(d2) + 0.2f;
      }
    }
  }
  {
    float* tile = (float*)smem;
    int j = (blockIdx.x + gridDim.x - (J_SLOW % gridDim.x)) % gridDim.x;
    float v[16];
    TJ cur;
    if (j < J_TR) { cur = tr_decode(p, j); tr_load(cur, v); }
    while (j < J_TR) {
      {
        const int n = tid & 127, kb = tid >> 7;
#pragma unroll
        for (int i = 0; i < 16; ++i) tile[(kb + 4 * i) * 129 + n] = v[i];
      }
      __syncthreads();
      const int jn = j + gridDim.x;
      TJ nxt = cur;
      if (jn < J_TR) { nxt = tr_decode(p, jn); tr_load(nxt, v); }
      {
        const int n = tid >> 2, ks = (tid & 3) * 16;
        int gn = cur.nt * 128 + n;
        if (cur.perm) { if (gn < 512) gn = 32 * (gn >> 4) + (gn & 15); else if (gn < 1024) { const int c = gn - 512; gn = 32 * (c >> 4) + 16 + (c & 15); } }
        unsigned w[8];
#pragma unroll
        for (int e = 0; e < 8; ++e) w[e] = pack2(tile[(ks + 2 * e) * 129 + n], tile[(ks + 2 * e + 1) * 129 + n]);
        bf16_t* d = cur.dst + (size_t)gn * cur.lddst + cur.kt * 64 + ks;
        *(u32x4*)d = (u32x4){w[0], w[1], w[2], w[3]};
        *(u32x4*)(d + 8) = (u32x4){w[4], w[5], w[6], w[7]};
      }
      __syncthreads();
      cur = nxt; j = jn;
    }
  }
}

DI void rope8(const float (&x)[8], float (&o)[8], int lane, const float* c16, const float* s16, int prow, int pcol) {
  const int L = lane & 7;
  const int pos = (L & 4) ? pcol : prow;
  const bool second = (L & 2) != 0;
  const int fb = (L & 1) * 8;
#pragma unroll
  for (int e = 0; e < 8; ++e) {
    const float y = __shfl_xor(x[e], 2);
    const float cs = c16[pos * 16 + fb + e], sn = s16[pos * 16 + fb + e];
    o[e] = second ? (y * sn + x[e] * cs) : (x[e] * cs - y * sn);
  }
}
DI void unpack8(const u32x4 w, float (&x)[8]) {
#pragma unroll
  for (int e = 0; e < 4; ++e) { x[2 * e] = bflo(w[e]); x[2 * e + 1] = bfhi(w[e]); }
}
DI u32x4 pack8(const float (&x)[8]) { return (u32x4){pack2(x[0], x[1]), pack2(x[2], x[3]), pack2(x[4], x[5]), pack2(x[6], x[7])}; }

DI void phase3(const Params& p) {
  char* ws = p.ws;
  const bf16_t* R = (const bf16_t*)(ws + O_R);
  bf16_t* Qda = (bf16_t*)(ws + O_QDA); bf16_t* Qdb = (bf16_t*)(ws + O_QDB); bf16_t* Kd = (bf16_t*)(ws + O_KD); bf16_t* Vd = (bf16_t*)(ws + O_VD);
  bf16_t* cqn = (bf16_t*)(ws + O_CQN); bf16_t* ckvn = (bf16_t*)(ws + O_CKVN); bf16_t* Km = (bf16_t*)(ws + O_KMLA);
  const float* c16 = (const float*)(ws + O_C16); const float* s16 = (const float*)(ws + O_S16); const float* c8 = (const float*)(ws + O_C8); const float* s8 = (const float*)(ws + O_S8);
  float* o_k = p.out + (size_t)NTOK * 1024; float* o_v = o_k + (size_t)NCTX * 512; float* o_ckv = o_v + (size_t)NCTX * 512; float* o_kr = o_ckv + (size_t)NCTX * 128;
  const int lane = threadIdx.x & 63, gw = blockIdx.x * NWAVE + (threadIdx.x >> 6), nw = gridDim.x * NWAVE;
  for (int row = gw; row < NTOK; row += nw) {
    const bool lat = row >= NCTX;
    const int rl = row - NCTX, b = rl >> 12, t = rl & (TLAT - 1), prow = t >> 6, pcol = t & 63;
    const size_t kr = lat ? (size_t)NCTX + (size_t)b * TKL + 256 + t : (size_t)row;
    const bf16_t* r = R + (size_t)row * RLD;
    float x[8], o[8];
    const u32x4 wq = *(const u32x4*)(r + lane * 8);
    *(u32x4*)(Qda + (size_t)row * 512 + lane * 8) = wq;
    if (lat) { unpack8(wq, x); rope8(x, o, lane, c16, s16, prow, pcol); *(u32x4*)(Qdb + (size_t)rl * 512 + lane * 8) = pack8(o); }
    const u32x4 wk = *(const u32x4*)(r + 512 + lane * 8);
    if (lat) { unpack8(wk, x); rope8(x, o, lane, c16, s16, prow, pcol); *(u32x4*)(Kd + kr * 512 + lane * 8) = pack8(o); }
    else {
      unpack8(wk, x);
      *(f32x4*)(o_k + (size_t)row * 512 + lane * 8) = (f32x4){x[0], x[1], x[2], x[3]};
      *(f32x4*)(o_k + (size_t)row * 512 + lane * 8 + 4) = (f32x4){x[4], x[5], x[6], x[7]};
      *(u32x4*)(Kd + kr * 512 + lane * 8) = wk;
    }
    const u32x4 wv = *(const u32x4*)(r + 1024 + lane * 8);
    *(u32x4*)(Vd + kr * 512 + lane * 8) = wv;
    if (!lat) {
      unpack8(wv, x);
      *(f32x4*)(o_v + (size_t)row * 512 + lane * 8) = (f32x4){x[0], x[1], x[2], x[3]};
      *(f32x4*)(o_v + (size_t)row * 512 + lane * 8 + 4) = (f32x4){x[4], x[5], x[6], x[7]};
    }
    {
      const u32x2 w = *(const u32x2*)(r + 1536 + lane * 4);
      const float a0 = bflo(w[0]), a1 = bfhi(w[0]), a2 = bflo(w[1]), a3 = bfhi(w[1]);
      const float ss = wave_sum(a0 * a0 + a1 * a1 + a2 * a2 + a3 * a3);
      const float sc = rsqrtf(ss * (1.f / 256.f) + EPS);
      const f32x4 g = *(const f32x4*)(p.q_norm_g + lane * 4);
      *(u32x2*)(cqn + (size_t)row * 256 + lane * 4) = (u32x2){pack2(a0 * sc * g[0], a1 * sc * g[1]), pack2(a2 * sc * g[2], a3 * sc * g[3])};
    }
    {
      const unsigned w = *(const unsigned*)(r + 1792 + lane * 2);
      const float a0 = bflo(w), a1 = bfhi(w);
      const float ss = wave_sum(a0 * a0 + a1 * a1);
      const float sc = rsqrtf(ss * (1.f / 128.f) + EPS);
      const f32x2 g = *(const f32x2*)(p.kv_norm_g + lane * 2);
      const float y0 = a0 * sc * g[0], y1 = a1 * sc * g[1];
      if (!lat) *(f32x2*)(o_ckv + (size_t)row * 128 + lane * 2) = (f32x2){y0, y1};
      *(unsigned*)(ckvn + kr * 128 + lane * 2) = pack2(y0, y1);
    }
    {
      const int idx = lane & 31;
      const float xv = bf2f(r[1920 + idx]);
      float ov = xv;
      if (lat) {
        const int pos = (idx & 16) ? pcol : prow;
        const int f = idx & 7;
        const float y = __shfl_xor(xv, 8);
        const float cs = c8[pos * 8 + f], sn = s8[pos * 8 + f];
        ov = (idx & 8) ? (y * sn + xv * cs) : (xv * cs - y * sn);
      } else if (lane < 32) o_kr[(size_t)row * 32 + idx] = xv;
      const bf16_t ob = (bf16_t)(pack2(ov, ov) & 0xffff);
#pragma unroll
      for (int k = 0; k < 4; ++k) { const int hh = (lane >> 5) + 2 * k; Km[kr * 768 + hh * 96 + 64 + idx] = ob; }
    }
  }
}

template <int DQK, int DV>
DI void attn_core(const bf16_t* __restrict__ Qa, const bf16_t* __restrict__ Qb, int ldq, const bf16_t* __restrict__ Kp, int ldk, const bf16_t* __restrict__ Vp, int ldv,
                  int Tk, int n_a, float c  , char* smem, f32x16 (&o)[DV / 32]) {
  constexpr int KS = DQK * 2 + 16, VS = DV * 2 + 64, BUF = 64 * (KS + VS);
  constexpr int KCH = DQK / 8, VCH = DV / 8, NKCH = 64 * KCH, NVCH = 64 * VCH, NKC = (NKCH + NT - 1) / NT, NVC = (NVCH + NT - 1) / NT;
  constexpr bool KG = (NKCH % NT) != 0, VG = (NVCH % NT) != 0;
  constexpr int NS = DQK / 16, NDT = DV / 32;
  const int tid = threadIdx.x, lane = tid & 63, wid = tid >> 6, h = lane >> 5, ql = lane & 31;
  bf16x8 qf[NS];
  {
    const bf16_t* q = Qa + (size_t)(wid * 32 + ql) * ldq + h * 8;
#pragma unroll
    for (int s = 0; s < NS; ++s) qf[s] = *(const bf16x8*)(q + s * 16);
  }
#pragma unroll
  for (int dt = 0; dt < NDT; ++dt)
#pragma unroll
    for (int r = 0; r < 16; ++r) o[dt][r] = 0.f;
  float m_run = -INFINITY, l_run = 0.f;
  u32x4 rk[NKC], rv[NVC];
  const int nt = Tk >> 6, ta = n_a >> 6;
  unsigned koff[NKC], voff[NVC];
#pragma unroll
  for (int i = 0; i < NKC; ++i) { const int ch = tid + NT * i, row = ch / KCH, kc = ch % KCH; koff[i] = (unsigned)(row * ldk + kc * 8); }
#pragma unroll
  for (int i = 0; i < NVC; ++i) { const int ch = tid + NT * i, row = ch / VCH, vc = ch % VCH; voff[i] = (unsigned)(row * ldv + vc * 8); }
  auto gload = [&](int t) {
    const bf16_t* kb = Kp + (size_t)t * 64 * ldk;
    const bf16_t* vbp = Vp + (size_t)t * 64 * ldv;
#pragma unroll
    for (int i = 0; i < NKC; ++i) if (!KG || i + 1 < NKC || tid + NT * i < NKCH) rk[i] = *(const u32x4*)(kb + koff[i]);
#pragma unroll
    for (int i = 0; i < NVC; ++i) if (!VG || i + 1 < NVC || tid + NT * i < NVCH) rv[i] = *(const u32x4*)(vbp + voff[i]);
  };
  auto lstoreK = [&](char* buf) {
#pragma unroll
    for (int i = 0; i < NKC; ++i) { const int ch = tid + NT * i, row = ch / KCH, kc = ch % KCH; if (!KG || i + 1 < NKC || ch < NKCH) *(u32x4*)(buf + row * KS + kc * 16) = rk[i]; }
  };
  auto lstoreV = [&](char* buf) {
#pragma unroll
    for (int i = 0; i < NVC; ++i) { const int ch = tid + NT * i, row = ch / VCH, vc = ch % VCH; if (!VG || i + 1 < NVC || ch < NVCH) *(u32x4*)(buf + 64 * KS + row * VS + vc * 16) = rv[i]; }
  };
  gload(0); lstoreK(smem); lstoreV(smem); lds_barrier();
  const int i16 = lane & 15, tq = i16 >> 2, tp = i16 & 3, G = (lane >> 4) & 1;
  auto run_tiles = [&](int t_begin, int t_end) {
  for (int t = t_begin; t < t_end; ++t) {
    char* cur = smem + (t & 1) * BUF;
    gload(min(t + 1, nt - 1));
    f32x16 st[2];
#pragma unroll
    for (int kt = 0; kt < 2; ++kt) {
#pragma unroll
      for (int r = 0; r < 16; ++r) st[kt][r] = 0.f;
#pragma unroll
      for (int s = 0; s < NS; ++s) {
        const bf16x8 kf = *(const bf16x8*)(cur + (kt * 32 + ql) * KS + s * 32 + h * 16);
        st[kt] = __builtin_amdgcn_mfma_f32_32x32x16_bf16(kf, qf[s], st[kt], 0, 0, 0);
      }
      __builtin_amdgcn_sched_barrier(0);
    }
    float mx = st[0][0];
#pragma unroll
    for (int kt = 0; kt < 2; ++kt)
#pragma unroll
      for (int r = 0; r < 16; ++r) mx = fmaxf(mx, st[kt][r]);
    mx = fmaxf(mx, __shfl_xor(mx, 32));
    const float m_new = fmaxf(m_run, mx);
    const float alpha = __builtin_amdgcn_exp2f((m_run - m_new) * c);
    const float mc = m_new * c;
    m_run = m_new;
    float ls = 0.f;
#pragma unroll
    for (int kt = 0; kt < 2; ++kt)
#pragma unroll
      for (int r = 0; r < 16; ++r) { const float pv = __builtin_amdgcn_exp2f(st[kt][r] * c - mc); st[kt][r] = pv; ls += pv; }
    l_run = l_run * alpha + ls;
    if (__any(alpha != 1.f)) {
#pragma unroll
      for (int dt = 0; dt < NDT; ++dt)
#pragma unroll
        for (int r = 0; r < 16; ++r) o[dt][r] *= alpha;
    }
    bf16x8 pf[2][2];
#pragma unroll
    for (int kt = 0; kt < 2; ++kt)
#pragma unroll
      for (int s2 = 0; s2 < 2; ++s2) {
        u32x4 w = {pack2(st[kt][8 * s2 + 0], st[kt][8 * s2 + 1]), pack2(st[kt][8 * s2 + 2], st[kt][8 * s2 + 3]), pack2(st[kt][8 * s2 + 4], st[kt][8 * s2 + 5]), pack2(st[kt][8 * s2 + 6], st[kt][8 * s2 + 7])};
        pf[kt][s2] = __builtin_bit_cast(bf16x8, w);
      }
    const char* vb = cur + 64 * KS + (4 * h + tq) * VS + 32 * G + 8 * tp;
#pragma unroll
    for (int kt = 0; kt < 2; ++kt)
#pragma unroll
      for (int s2 = 0; s2 < 2; ++s2) {
        bf16x8 vf[NDT];
#pragma unroll
        for (int dt = 0; dt < NDT; ++dt) {
          const char* a0 = vb + (kt * 32 + 16 * s2) * VS + dt * 64;
          const s16x4 lo = __builtin_amdgcn_ds_read_tr16_b64_v4i16((LDS_AS s16x4*)(a0));
          const s16x4 hi = __builtin_amdgcn_ds_read_tr16_b64_v4i16((LDS_AS s16x4*)(a0 + 8 * VS));
          vf[dt] = __builtin_shufflevector(lo, hi, 0, 1, 2, 3, 4, 5, 6, 7);
        }
#pragma unroll
        for (int dt = 0; dt < NDT; ++dt) o[dt] = __builtin_amdgcn_mfma_f32_32x32x16_bf16(vf[dt], pf[kt][s2], o[dt], 0, 0, 0);
        __builtin_amdgcn_sched_barrier(0);
      }
    lstoreK(smem + ((t + 1) & 1) * BUF); lstoreV(smem + ((t + 1) & 1) * BUF);
    lds_barrier();
  }
  };
  run_tiles(0, min(ta, nt));
  if (ta < nt) {
    const bf16_t* q = Qb + (size_t)(wid * 32 + ql) * ldq + h * 8;
#pragma unroll
    for (int s = 0; s < NS; ++s) qf[s] = *(const bf16x8*)(q + s * 16);
    run_tiles(ta, nt);
  }
  const float l = l_run + __shfl_xor(l_run, 32);
  const float inv = 1.f / l;
#pragma unroll
  for (int dt = 0; dt < NDT; ++dt)
#pragma unroll
    for (int r = 0; r < 16; ++r) o[dt][r] *= inv;
}

constexpr int U_DBIG = 128, U_MBIG = 256, U_DCTX = 64, U_MCTX = 128, U_TOTAL = U_DBIG + U_MBIG + U_DCTX + U_MCTX;

DI void phase_attn(const Params& p, char* smem, int cidx) {
  char* ws = p.ws;
  const bf16_t* Qda = (const bf16_t*)(ws + O_QDA); const bf16_t* Qdb = (const bf16_t*)(ws + O_QDB); const bf16_t* Kd = (const bf16_t*)(ws + O_KD); const bf16_t* Vd = (const bf16_t*)(ws + O_VD);
  const bf16_t* Qma = (const bf16_t*)(ws + O_QMA); const bf16_t* Qmb = (const bf16_t*)(ws + O_QMB); const bf16_t* Km = (const bf16_t*)(ws + O_KMLA); const bf16_t* Vm = (const bf16_t*)(ws + O_VMLA);
  bf16_t* cat = (bf16_t*)(ws + O_HB);
  float* otmp = (float*)(ws + O_OTMP) + (size_t)blockIdx.x * 32768;
  int* counter = (int*)(ws + O_CNT) + cidx;
  int* s_unit = (int*)(smem + 65532);
  const int tid = threadIdx.x, lane = tid & 63, wid = tid >> 6, h2 = lane >> 5, ql = lane & 31;
  const float lam = ((const float*)(ws + O_SCAL))[0];
  for (;;) {
    if (tid == 0) *s_unit = atomicAdd(counter, 1);
    __syncthreads();
    int u = __builtin_amdgcn_readfirstlane(*s_unit);
    __syncthreads();
    if (u >= U_TOTAL) break;
    bool diff; int qrow0, krow0, Tk, n_a, head; bool lat;
    if (u < U_DBIG) { diff = true; lat = true; const int b = u >> 6, hh = (u >> 4) & 3, qb = u & 15; head = hh; qrow0 = NCTX + b * TLAT + qb * 256; krow0 = NCTX + b * TKL; Tk = TKL; n_a = 256; }
    else if (u < U_DBIG + U_MBIG) { u -= U_DBIG; diff = false; lat = true; const int b = u >> 7, hh = (u >> 4) & 7, qb = u & 15; head = hh; qrow0 = NCTX + b * TLAT + qb * 256; krow0 = NCTX + b * TKL; Tk = TKL; n_a = 256; }
    else if (u < U_DBIG + U_MBIG + U_DCTX) { u -= U_DBIG + U_MBIG; diff = true; lat = false; const int sq = u >> 2, hh = u & 3; head = hh; qrow0 = sq * 256; krow0 = sq * 256; Tk = 256; n_a = 256; }
    else { u -= U_DBIG + U_MBIG + U_DCTX; diff = false; lat = false; const int sq = u >> 3, hh = u & 7; head = hh; qrow0 = sq * 256; krow0 = sq * 256; Tk = 256; n_a = 256; }
    const int qrowb = lat ? qrow0 - NCTX : 0;
    if (diff) {
      f32x16 o[4];
      const float c = 0.125f * 1.4426950408889634f;
#pragma unroll 1
      for (int m = 0; m < 2; ++m) {
        attn_core<64, 128>(Qda + (size_t)qrow0 * 512 + head * 128 + m * 64, Qdb + (size_t)qrowb * 512 + head * 128 + m * 64, 512,
                           Kd + (size_t)krow0 * 512 + head * 128 + m * 64, 512, Vd + (size_t)krow0 * 512 + head * 128, 512, Tk, n_a, c, smem, o);
        if (m == 0) {
#pragma unroll
          for (int dt = 0; dt < 4; ++dt)
#pragma unroll
            for (int rq = 0; rq < 4; ++rq) *(f32x4*)(otmp + tid * 64 + dt * 16 + rq * 4) = (f32x4){o[dt][4 * rq], o[dt][4 * rq + 1], o[dt][4 * rq + 2], o[dt][4 * rq + 3]};
        }
      }
      float ss = 0.f;
#pragma unroll
      for (int dt = 0; dt < 4; ++dt)
#pragma unroll
        for (int rq = 0; rq < 4; ++rq) {
          const f32x4 o0 = *(const f32x4*)(otmp + tid * 64 + dt * 16 + rq * 4);
#pragma unroll
          for (int e = 0; e < 4; ++e) { const float v = o0[e] - lam * o[dt][4 * rq + e]; o[dt][4 * rq + e] = v; ss += v * v; }
        }
      ss += __shfl_xor(ss, 32);
      const float sc = rsqrtf(ss * (1.f / 128.f) + EPS) * 0.8f;
      bf16_t* dst = cat + (size_t)(qrow0 + wid * 32 + ql) * 1024 + head * 128;
#pragma unroll
      for (int dt = 0; dt < 4; ++dt)
#pragma unroll
        for (int rq = 0; rq < 4; ++rq) {
          const int dv = dt * 32 + 8 * rq + 4 * h2;
          const f32x4 g = *(const f32x4*)(p.diff_norm_g + dv);
          u32x2 w = {pack2(o[dt][4 * rq] * sc * g[0], o[dt][4 * rq + 1] * sc * g[1]), pack2(o[dt][4 * rq + 2] * sc * g[2], o[dt][4 * rq + 3] * sc * g[3])};
          *(u32x2*)(dst + dv) = w;
        }
    } else {
      f32x16 o[2];
      const float c = 0.10206207261596575f * 1.4426950408889634f;
      attn_core<96, 64>(Qma + (size_t)qrow0 * 768 + head * 96, Qmb + (size_t)qrowb * 768 + head * 96, 768,
                        Km + (size_t)krow0 * 768 + head * 96, 768, Vm + (size_t)krow0 * 512 + head * 64, 512, Tk, n_a, c, smem, o);
      bf16_t* dst = cat + (size_t)(qrow0 + wid * 32 + ql) * 1024 + 512 + head * 64;
#pragma unroll
      for (int dt = 0; dt < 2; ++dt)
#pragma unroll
        for (int rq = 0; rq < 4; ++rq) {
          const int dv = dt * 32 + 8 * rq + 4 * h2;
          u32x2 w = {pack2(o[dt][4 * rq], o[dt][4 * rq + 1]), pack2(o[dt][4 * rq + 2], o[dt][4 * rq + 3])};
          *(u32x2*)(dst + dv) = w;
        }
    }
  }
}

DI void phase_conv(const Params& p, char* smem) {
  char* ws = p.ws;
  const bf16_t* Ug = (const bf16_t*)(ws + O_UG); const bf16_t* Pz = (const bf16_t*)(ws + O_PZ);
  bf16_t* cat = (bf16_t*)(ws + O_HB);
  const int tid = threadIdx.x, lane = tid & 63, half = tid >> 8, ht = tid & 255, hw4 = (tid >> 6) & 3;
  float* tile = (float*)smem + half * 8192;
  for (int up = blockIdx.x; up < NTOK / 32; up += gridDim.x) {
    const int t0 = (up * 2 + half) * 16;
    const int s0 = t0 < NCTX ? (t0 & ~255) : NCTX + ((t0 - NCTX) & ~(TLAT - 1));
    const int s1 = t0 < NCTX ? s0 + 256 : s0 + TLAT;
    {
      const int ch = ht * 2;
      float a0[16], a1[16];
#pragma unroll
      for (int o = 0; o < 16; ++o) { a0[o] = 0.f; a1[o] = 0.f; }
      f32x2 w[31];
#pragma unroll
      for (int j = 0; j < 31; ++j) w[j] = *(const f32x2*)(p.conv_w + j * 512 + ch);
#pragma unroll
      for (int i = 0; i < 46; ++i) {
        const int r = t0 - 15 + i;
        float u0 = 0.f, u1 = 0.f;
        if (r >= s0 && r < s1) { const unsigned v = *(const unsigned*)(Ug + (size_t)r * 512 + ch); u0 = bflo(v); u1 = bfhi(v); }
#pragma unroll
        for (int o = 0; o < 16; ++o) {
          const int j = i - o;
          if (j >= 0 && j <= 30) { a0[o] += u0 * w[j][0]; a1[o] += u1 * w[j][1]; }
        }
      }
      const f32x2 bias = *(const f32x2*)(p.conv_b + ch);
#pragma unroll
      for (int o = 0; o < 16; ++o) *(f32x2*)(tile + o * 512 + ch) = (f32x2){a0[o] + bias[0], a1[o] + bias[1]};
    }
    __syncthreads();
#pragma unroll 1
    for (int k = 0; k < 4; ++k) {
      const int o = hw4 * 4 + k, row = t0 + o;
      const f32x4 v0 = *(const f32x4*)(tile + o * 512 + lane * 4), v1 = *(const f32x4*)(tile + o * 512 + 256 + lane * 4);
      const float mean = wave_sum((v0[0] + v0[1]) + (v0[2] + v0[3]) + (v1[0] + v1[1]) + (v1[2] + v1[3])) * (1.f / 512.f);
      float q = 0.f;
#pragma unroll
      for (int e = 0; e < 4; ++e) { const float d0 = v0[e] - mean, d1 = v1[e] - mean; q += d0 * d0 + d1 * d1; }
      const float rstd = rsqrtf(wave_sum(q) * (1.f / 512.f) + EPS);
#pragma unroll
      for (int hlf = 0; hlf < 2; ++hlf) {
        const int col = hlf * 256 + lane * 4;
        const f32x4 v = hlf ? v1 : v0;
        const f32x4 g = *(const f32x4*)(p.conv_norm_g + col), bb = *(const f32x4*)(p.conv_norm_b + col);
        float y[4];
#pragma unroll
        for (int e = 0; e < 4; ++e) { const float z = (v[e] - mean) * rstd * g[e] + bb[e]; y[e] = z / (1.f + __expf(-z)); }
        *(u32x2*)(cat + (size_t)row * 1024 + col) = (u32x2){pack2(y[0], y[1]), pack2(y[2], y[3])};
      }
    }
    {
      const int ch = ht * 2, hw = 1 << hw4;
#pragma unroll 1
      for (int o = 0; o < 16; ++o) {
        const int r = t0 + o;
        const int lo = max(r - hw, s0), hi = min(r + hw - 1, s1 - 1);
        float a0 = 0.f, a1 = 0.f;
        for (int q = lo; q <= hi; ++q) { const unsigned v = *(const unsigned*)(Pz + (size_t)q * 512 + ch); a0 += bflo(v); a1 += bfhi(v); }
        const unsigned vc = *(const unsigned*)(Pz + (size_t)r * 512 + ch);
        const float ic = 1.f / (float)(hi - lo + 1);
        *(unsigned*)(cat + (size_t)r * 1024 + 512 + ch) = pack2(a0 * ic - bflo(vc), a1 * ic - bfhi(vc));
      }
    }
    __syncthreads();
  }
}

__global__ void __launch_bounds__(NT, 2) fwd_kernel(Params p, int ph_lo, int ph_hi) {
  __shared__ __attribute__((aligned(16))) char smem[2 * G_STAGE];
  __shared__ uint4 xb_words;
  cg::grid_group grid = cg::this_grid();
  char* ws = p.ws;
  if (threadIdx.x == 0) xb_words = make_uint4(0u, 0u, 0u, 0u);
  __syncthreads();
  const XcdBarrier xb = xcd_barrier_post((unsigned*)(ws + O_BAR), (volatile LDS_AS unsigned*)&xb_words);
  if (ph_lo > 1000) grid.sync();
  float* mods = (float*)(ws + O_MODS);
  bf16_t* Hb = (bf16_t*)(ws + O_HB);
  float* X = p.out;
  float* xbuf = (float*)(ws + O_XBUF);
  unsigned* lncnt = (unsigned*)(ws + O_LNCNT);
  const bool fused = (gridDim.x == 256);
#define GSYNC() xcd_barrier(xb)
#define PH_BEGIN(n) if (ph_lo <= n && n < ph_hi) { if (n > ph_lo) GSYNC();
#define PH_BEGIN_IF(n, c) if (ph_lo <= n && n < ph_hi && (c)) { if (n > ph_lo) GSYNC();
#define PH_END }
#ifndef PROBE_DUP
#define PROBE_DUP 0
#endif
#ifndef PROBE_SYNCS
#define PROBE_SYNCS 0
#endif
#define DUP(n, ...) __VA_ARGS__; if ((PROBE_DUP >> n) & 1) { GSYNC(); __VA_ARGS__; }
  for (int i = 0; i < PROBE_SYNCS; ++i) GSYNC();
  PH_BEGIN(0) { DUP(0, phase0(p, smem)); } PH_END
  PH_BEGIN(1) { DUP(1, rows_phase(p.x_prompt, p.x_sample, false, nullptr, nullptr, nullptr, mods, 0, 1024, Hb)); } PH_END
  PH_BEGIN(2) { DUP(2, gemm_phase(Hb, 1024, (const bf16_t*)(ws + O_WATTIN), 1024, 1024, 64, 8, EpiRaw{(bf16_t*)(ws + O_R)}, smem)); } PH_END
  PH_BEGIN(3) { DUP(3, phase3(p)); } PH_END
  PH_BEGIN(4) {
        const int n1 = 64 * 3, n2 = 67 * 4;
        gemm_phase((const bf16_t*)(ws + O_CQN), 256, (const bf16_t*)(ws + O_WUQ), 256, 256, 64, 3,
                   EpiUq{(bf16_t*)(ws + O_QMA), (bf16_t*)(ws + O_QMB), (const float*)(ws + O_C8), (const float*)(ws + O_S8)}, smem, 0, n1 + n2);
        gemm_phase((const bf16_t*)(ws + O_CKVN), 128, (const bf16_t*)(ws + O_WUKV), 128, 128, 67, 4,
                   EpiUkv{(bf16_t*)(ws + O_KMLA), (bf16_t*)(ws + O_VMLA)}, smem, n1, n1 + n2);
  } PH_END
  PH_BEGIN(5) { phase_attn(p, smem, 0); if ((PROBE_DUP >> 5) & 1) { GSYNC(); phase_attn(p, smem, 1); } } PH_END
  PH_BEGIN(6) { gemm_phase(Hb, 1024, (const bf16_t*)(ws + O_WATTOUT), 1024, 1024, 64, 4, EpiResLN{p.x_prompt, p.x_sample, mods + 2048, X, p.ln_mix_g, p.ln_mix_b, mods, 3072, 4096, Hb, xbuf, lncnt, smem, fused}, smem); } PH_END
  PH_BEGIN_IF(7, !fused) { rows_phase(X, X + (size_t)NCTX * 1024, true, p.ln_mix_g, p.ln_mix_b, X, mods, 3072, 4096, Hb); } PH_END
  PH_BEGIN(8) { DUP(8, gemm_phase(Hb, 1024, (const bf16_t*)(ws + O_WMLPIN), 1024, 1024, 64, 16, EpiRelu2{(bf16_t*)(ws + O_U)}, smem)); } PH_END
  PH_BEGIN(9) { gemm_phase((const bf16_t*)(ws + O_U), 4096, (const bf16_t*)(ws + O_WMLPOUT), 4096, 4096, 64, 4, EpiResLN{X, X + (size_t)NCTX * 1024, mods + 5120, X, p.ln_mlp_g, p.ln_mlp_b, mods + 3 * 6144, 0, 1024, Hb, xbuf + 98304, lncnt + 64, smem, fused}, smem); } PH_END
  PH_BEGIN_IF(10, !fused) { rows_phase(X, X + (size_t)NCTX * 1024, true, p.ln_mlp_g, p.ln_mlp_b, X, mods + 3 * 6144, 0, 1024, Hb); } PH_END
  PH_BEGIN(11) { DUP(11, gemm_phase(Hb, 1024, (const bf16_t*)(ws + O_WCONVIN), 1024, 1024, 64, 6, EpiConv{(bf16_t*)(ws + O_UG), (bf16_t*)(ws + O_PZ)}, smem)); } PH_END
  PH_BEGIN(12) { DUP(12, phase_conv(p, smem)); } PH_END
  PH_BEGIN(13) { gemm_phase(Hb, 1024, (const bf16_t*)(ws + O_WCONVOUT), 1024, 1024, 64, 4, EpiResLN{X, X + (size_t)NCTX * 1024, mods + 3 * 6144 + 2048, X, p.ln_mix_g + 1024, p.ln_mix_b + 1024, mods + 3 * 6144, 3072, 4096, Hb, xbuf + 2 * 98304, lncnt + 128, smem, fused}, smem); } PH_END
  PH_BEGIN_IF(14, !fused) { rows_phase(X, X + (size_t)NCTX * 1024, true, p.ln_mix_g + 1024, p.ln_mix_b + 1024, X, mods + 3 * 6144, 3072, 4096, Hb); } PH_END
  PH_BEGIN(15) { DUP(15, gemm_phase(Hb, 1024, (const bf16_t*)(ws + O_WMLPIN) + (size_t)4096 * 1024, 1024, 1024, 64, 16, EpiRelu2{(bf16_t*)(ws + O_U)}, smem)); } PH_END
  PH_BEGIN(16) { gemm_phase((const bf16_t*)(ws + O_U), 4096, (const bf16_t*)(ws + O_WMLPOUT) + (size_t)4096 * 1024, 4096, 4096, 64, 4, EpiResLN{X, X + (size_t)NCTX * 1024, mods + 3 * 6144 + 5120, X, p.ln_mlp_g + 1024, p.ln_mlp_b + 1024, mods, 0, 0, nullptr, xbuf + 3 * 98304, lncnt + 192, smem, fused}, smem); } PH_END
  PH_BEGIN_IF(17, !fused) { rows_phase(X, X + (size_t)NCTX * 1024, true, p.ln_mlp_g + 1024, p.ln_mlp_b + 1024, X, nullptr, 0, 0, nullptr); } PH_END
}

extern "C" void kernel_launch(void* const* d_in, const int* in_sizes, int n_in, void* d_out, int out_size, void* d_ws, size_t ws_size, hipStream_t stream) {
  static int grid_blocks = 0;
  if (!grid_blocks) {
    int dev = 0, cus = 0, per_cu = 0;
    hipGetDevice(&dev);
    hipDeviceGetAttribute(&cus, hipDeviceAttributeMultiprocessorCount, dev);
    hipOccupancyMaxActiveBlocksPerMultiprocessor(&per_cu, fwd_kernel, NT, 0);
    if (per_cu > 1) per_cu = 1;
    if (per_cu < 1) per_cu = 1;
    grid_blocks = cus * per_cu;
    if (grid_blocks > 256) grid_blocks = 256;
  }
  if (ws_size < WS_NEED) { fprintf(stderr, "workspace too small: %zu < %zu\n", ws_size, (size_t)WS_NEED); return; }
  Params p{};
  const float** f = (const float**)&p;
  for (int i = 0; i < 35; ++i) f[i] = (const float*)d_in[i];
  p.out = (float*)d_out;
  p.ws = (char*)d_ws;
  hipMemsetAsync(d_ws, 0, 16384, stream);
  int lo = 0, hi = NPHASE;
  void* args[] = {&p, &lo, &hi};
  hipError_t e = hipLaunchCooperativeKernel((void*)fwd_kernel, dim3(grid_blocks), dim3(NT), args, 0, stream);
  if (e != hipSuccess) fprintf(stderr, "cooperative launch failed: %s (grid %d)\n", hipGetErrorString(e), grid_blocks);
}
```

```cpp
#include <hip/hip_runtime.h>
#include <hip/hip_cooperative_groups.h>
#include <cstdio>
#include <cstdint>
namespace cg = cooperative_groups;

typedef unsigned short bf16_t;
typedef short bf16x8 __attribute__((ext_vector_type(8)));
typedef short s16x4 __attribute__((ext_vector_type(4)));
typedef float f32x4 __attribute__((ext_vector_type(4)));
typedef float f32x2 __attribute__((ext_vector_type(2)));
typedef float f32x16 __attribute__((ext_vector_type(16)));
typedef unsigned u32x4 __attribute__((ext_vector_type(4)));
typedef unsigned u32x2 __attribute__((ext_vector_type(2)));
typedef __bf16 bf16v2 __attribute__((ext_vector_type(2)));
#define DI __device__ __forceinline__
#define LDS_AS __attribute__((address_space(3)))

constexpr int NTOK = 12288, NCTX = 4096, NKEY = 12800, TLAT = 4096, TKL = 4352;
constexpr int RLD = 1952;
constexpr float ALPHA = 1.41421356237f, EPS = 1e-5f;
constexpr int NPHASE = 18;
constexpr int NT = 512, NWAVE = 8;

constexpr size_t al(size_t x) { return (x + 255) & ~(size_t)255; }
constexpr size_t O_CNT = 0;
constexpr size_t O_BAR = 256;
constexpr size_t O_LNCNT = 14336;
constexpr size_t O_MODS = 16384;
constexpr size_t O_SCAL = O_MODS + al(2 * 3 * 6144 * 4);
constexpr size_t O_C16 = O_SCAL + 256;
constexpr size_t O_S16 = O_C16 + 4096;
constexpr size_t O_C8 = O_S16 + 4096;
constexpr size_t O_S8 = O_C8 + 2048;
constexpr size_t O_XBUF = O_S8 + 2048;
constexpr size_t O_WATTIN = O_XBUF + (size_t)4 * 256 * 192 * 2 * 4;
constexpr size_t O_WUQ = O_WATTIN + (size_t)2048 * 1024 * 2;
constexpr size_t O_WUKV = O_WUQ + (size_t)768 * 256 * 2;
constexpr size_t O_WATTOUT = O_WUKV + (size_t)1024 * 128 * 2;
constexpr size_t O_WMLPIN = O_WATTOUT + (size_t)1024 * 1024 * 2;
constexpr size_t O_WMLPOUT = O_WMLPIN + (size_t)2 * 4096 * 1024 * 2;
constexpr size_t O_WCONVIN = O_WMLPOUT + (size_t)2 * 4096 * 1024 * 2;
constexpr size_t O_WCONVOUT = O_WCONVIN + (size_t)1536 * 1024 * 2;
constexpr size_t O_HB = O_WCONVOUT + (size_t)1024 * 1024 * 2;
constexpr size_t O_BIG = O_HB + (size_t)NTOK * 1024 * 2;
constexpr size_t O_R = O_BIG;
constexpr size_t O_QMA = O_R;
constexpr size_t O_QMB = O_QMA + (size_t)NTOK * 768 * 2;
constexpr size_t O_QDA = O_R + al((size_t)NTOK * RLD * 2);
constexpr size_t O_QDB = O_QDA + (size_t)NTOK * 512 * 2;
constexpr size_t O_KD = O_QDB + (size_t)8192 * 512 * 2;
constexpr size_t O_VD = O_KD + (size_t)NKEY * 512 * 2;
constexpr size_t O_CQN = O_VD + (size_t)NKEY * 512 * 2;
constexpr size_t O_CKVN = O_CQN + (size_t)NTOK * 256 * 2;
constexpr size_t O_KMLA = O_CKVN + (size_t)NKEY * 128 * 2;
constexpr size_t O_VMLA = O_KMLA + (size_t)NKEY * 768 * 2;
constexpr size_t O_OTMP = O_VMLA + (size_t)NKEY * 512 * 2;
constexpr size_t O_ATT_END = O_OTMP + (size_t)512 * 16384 * 4;
constexpr size_t O_U = O_BIG;
constexpr size_t O_U_END = O_U + (size_t)NTOK * 4096 * 2;
constexpr size_t O_UG = O_BIG;
constexpr size_t O_PZ = O_UG + (size_t)NTOK * 512 * 2;
constexpr size_t WS_NEED = (O_ATT_END > O_U_END ? O_ATT_END : O_U_END);
static_assert(O_QMB + (size_t)8192 * 768 * 2 <= O_QDA, "Qm overlay must fit in R");
static_assert(WS_NEED <= (size_t)256 * 1024 * 1024, "workspace too large");

struct Params {
  const float *x_prompt, *x_sample, *cache_k, *cache_v, *cache_ckv, *cache_krope, *c, *c_ctx;
  const float *w_ada, *b_ada, *ln_mix_g, *ln_mix_b, *ln_mlp_g, *ln_mlp_b, *w_mlp_in, *w_mlp_out;
  const float *w_att_in, *w_uq, *w_ukv, *q_norm_g, *kv_norm_g, *lam_q1, *lam_k1, *lam_q2, *lam_k2, *diff_norm_g, *w_att_out;
  const float *w_conv_in, *conv_w, *conv_b, *conv_norm_g, *conv_norm_b, *w_pool, *pool_scale, *w_conv_out;
  float* out;
  char* ws;
};

DI unsigned pack2(float lo, float hi) { f32x2 v = {lo, hi}; bf16v2 b = __builtin_convertvector(v, bf16v2); return __builtin_bit_cast(unsigned, b); }
DI float bf2f(unsigned short u) { return __uint_as_float((unsigned)u << 16); }
DI float bflo(unsigned u) { return __uint_as_float(u << 16); }
DI float bfhi(unsigned u) { return __uint_as_float(u & 0xffff0000u); }
DI float wave_sum(float v) {
#pragma unroll
  for (int o = 32; o >= 1; o >>= 1) v += __shfl_xor(v, o);
  return v;
}
DI void lds_barrier() { asm volatile("s_waitcnt lgkmcnt(0)\n\ts_barrier" ::: "memory"); }
DI void dma16(const void* gsrc, unsigned lds_dst) {
  unsigned keep;
  asm volatile("s_mov_b32 %0, m0\n\ts_mov_b32 m0, %2\n\ts_nop 0\n\tglobal_load_lds_dwordx4 %1, off\n\ts_mov_b32 m0, %0" : "=&s"(keep) : "v"(gsrc), "s"(lds_dst) : "memory");
}
DI int cond_idx(int row) { return row < NCTX ? 0 : 1 + ((row - NCTX) >> 12); }


#define XB_TMO      128
#define XB_XCNT(j)  (256  + 64 * (j))
#define XB_XSUB(j)  (1280 + 64 * (j))
#define XB_XGEN(j)  (2304 + 64 * (j))
#define XB_TOP      3328
#define XB_TOPGEN   3392
#define XCD_BAR_WORDS 3456
#define XB_SPIN_CAP (1u << 18)
DI unsigned xb_ld(unsigned* p)              { return __hip_atomic_load(p, __ATOMIC_RELAXED, __HIP_MEMORY_SCOPE_AGENT); }
DI unsigned xb_add(unsigned* p, unsigned v) { return __hip_atomic_fetch_add(p, v, __ATOMIC_RELAXED, __HIP_MEMORY_SCOPE_AGENT); }
DI unsigned xb_xcc_id() { return (unsigned)__builtin_amdgcn_s_getreg((3 << 11) | 20) & 0xFu; }
#define XB_SPIN(cond, bar) do { unsigned _sp = 0; while (cond) { __builtin_amdgcn_s_sleep(1); \
    if ((++_sp & 255u) == 0u) { if (xb_ld(&(bar)[XB_TMO])) break; if (_sp > XB_SPIN_CAP) { atomicAdd(&(bar)[XB_TMO], 1u); break; } } } } while (0)
struct XcdBarrier { unsigned* bar; unsigned x; volatile LDS_AS unsigned* st; };
DI XcdBarrier xcd_barrier_post(unsigned* bar, volatile LDS_AS unsigned* st) {
  XcdBarrier b; b.bar = bar; b.x = xb_xcc_id(); b.st = st;
  if (threadIdx.x == 0) (void)xb_add(&bar[XB_XCNT(b.x)], 1u);
  return b;
}
DI void xcd_barrier_complete(unsigned* bar, unsigned x, unsigned& nloc, unsigned& nx) {
  const unsigned G = gridDim.x * gridDim.y * gridDim.z;
  unsigned sum, cnt, mine, sp = 0u;
  for (;;) {
    sum = 0u; cnt = 0u; mine = 0u;
#pragma unroll
    for (unsigned j = 0; j < 16; ++j) { const unsigned c = xb_ld(&bar[XB_XCNT(j)]); sum += c; cnt += (c > 0u) ? 1u : 0u; mine = (j == x) ? c : mine; }
    if (sum == G) break;
    __builtin_amdgcn_s_sleep(1);
    if ((++sp & 255u) == 0u) { if (xb_ld(&bar[XB_TMO])) break; if (sp > XB_SPIN_CAP) { atomicAdd(&bar[XB_TMO], 1u); break; } }
  }
  nloc = mine > 0u ? mine : 1u; nx = cnt > 0u ? cnt : 1u;
}
DI void xcd_barrier(const XcdBarrier& b) {
  asm volatile("s_waitcnt vmcnt(0)" ::: "memory");
  __syncthreads();
  if (threadIdx.x == 0) {
    unsigned* bar = b.bar;
    __builtin_amdgcn_s_waitcnt(0);
    unsigned nloc = b.st[0], nx = b.st[1];
    if (nloc == 0u) { xcd_barrier_complete(bar, b.x, nloc, nx); b.st[0] = nloc; b.st[1] = nx; }
    const unsigned old = xb_add(&bar[XB_XSUB(b.x)], 1u);
    const unsigned gen = old / nloc;
    if (old + 1u == (gen + 1u) * nloc) {
      __builtin_amdgcn_fence(__ATOMIC_RELEASE, "agent");
      asm volatile("s_waitcnt vmcnt(0)" ::: "memory");
      const unsigned og = xb_add(&bar[XB_TOP], 1u);
      const unsigned tg = og / nx;
      if (og + 1u == (tg + 1u) * nx) xb_add(&bar[XB_TOPGEN], 1u);
      else XB_SPIN(xb_ld(&bar[XB_TOPGEN]) == tg, bar);
      __builtin_amdgcn_fence(__ATOMIC_ACQUIRE, "agent");
      xb_add(&bar[XB_XGEN(b.x)], 1u);
      asm volatile("s_waitcnt vmcnt(0)" ::: "memory");
    } else {
      XB_SPIN(xb_ld(&bar[XB_XGEN(b.x)]) == gen, bar);
      __builtin_amdgcn_fence(__ATOMIC_ACQUIRE, "agent");
      asm volatile("s_waitcnt vmcnt(0)" ::: "memory");
    }
  }
  __syncthreads();
}

DI int swz(int row, int kc) { return row * 128 + ((kc ^ ((row >> 1) & 7)) << 4); }

constexpr int G_BM = 192, G_BN = 256, G_MI = 6, G_NJ = 4, G_ABYTES = G_BM * 128, G_STAGE = G_ABYTES + G_BN * 128;
template <class Epi>
DI void gemm_tile(const bf16_t* __restrict__ A, int lda, const bf16_t* __restrict__ Bt, int ldb, int K, int row0, int col0, char* smem, const Epi& epi) {
  const int tid = threadIdx.x, lane = tid & 63, wid = tid >> 6, wr = wid >> 2, wc = wid & 3;
  const int fr = lane & 15, fq = lane >> 4;
  f32x4 acc[G_MI][G_NJ];
#pragma unroll
  for (int i = 0; i < G_MI; ++i)
#pragma unroll
    for (int j = 0; j < G_NJ; ++j) acc[i][j] = (f32x4){0.f, 0.f, 0.f, 0.f};
  const int srow = tid >> 3, skc = tid & 7;
  const int schunk = skc ^ ((srow >> 1) & 7);
  const bf16_t* ga = A + (size_t)(row0 + srow) * lda + schunk * 8;
  const bf16_t* gb = Bt + (size_t)(col0 + srow) * ldb + schunk * 8;
  const int nk = K >> 6;
  const unsigned lds0 = __builtin_amdgcn_readfirstlane((unsigned)(size_t)(LDS_AS char*)smem + (unsigned)(tid & ~63) * 16u);
#define G_DMA(stage_off_, kt_) do { const int k0_ = (kt_) << 6; const unsigned sb_ = lds0 + (unsigned)(stage_off_); \
    _Pragma("unroll") for (int i = 0; i < 3; ++i) dma16(ga + (size_t)(64 * i) * lda + k0_, sb_ + i * 8192); \
    _Pragma("unroll") for (int i = 0; i < 4; ++i) dma16(gb + (size_t)(64 * i) * ldb + k0_, sb_ + G_ABYTES + i * 8192); } while (0)
#define G_COMPUTE(buf_) do { const char* cur = (buf_); \
    _Pragma("unroll") for (int s = 0; s < 2; ++s) { \
      bf16x8 af[G_MI], bfr[G_NJ]; \
      _Pragma("unroll") for (int i = 0; i < G_MI; ++i) af[i] = *(const bf16x8*)(cur + swz(wr * 96 + i * 16 + fr, s * 4 + fq)); \
      _Pragma("unroll") for (int j = 0; j < G_NJ; ++j) bfr[j] = *(const bf16x8*)(cur + G_ABYTES + swz(wc * 64 + j * 16 + fr, s * 4 + fq)); \
      __builtin_amdgcn_s_setprio(1); \
      _Pragma("unroll") for (int i = 0; i < G_MI; ++i) \
        _Pragma("unroll") for (int j = 0; j < G_NJ; ++j) acc[i][j] = __builtin_amdgcn_mfma_f32_16x16x32_bf16(bfr[j], af[i], acc[i][j], 0, 0, 0); \
      __builtin_amdgcn_s_setprio(0); \
    } } while (0)
  G_DMA(0, 0);
  asm volatile("s_waitcnt vmcnt(0)" ::: "memory");
  lds_barrier();
  for (int kt = 0; kt < nk; kt += 2) {
    G_DMA(G_STAGE, kt + 1);
    G_COMPUTE(smem);
    asm volatile("s_waitcnt vmcnt(0)" ::: "memory");
    lds_barrier();
    G_DMA(0, min(kt + 2, nk - 1));
    G_COMPUTE(smem + G_STAGE);
    asm volatile("s_waitcnt vmcnt(0)" ::: "memory");
    lds_barrier();
  }
#undef G_DMA
#undef G_COMPUTE
  epi(acc, row0 + wr * 96, col0 + wc * 64, lane);
}


struct EpiRaw {
  bf16_t* R;
  DI void operator()(f32x4 (&acc)[G_MI][G_NJ], int rbase, int cbase, int lane) const {
    const int fr = lane & 15, fq = lane >> 4;
#pragma unroll
    for (int i = 0; i < G_MI; ++i)
#pragma unroll
      for (int j = 0; j < G_NJ; ++j) {
        const int row = rbase + i * 16 + fr, col = cbase + j * 16 + fq * 4;
        if (col < RLD) { u32x2 w = {pack2(acc[i][j][0], acc[i][j][1]), pack2(acc[i][j][2], acc[i][j][3])}; *(u32x2*)(R + (size_t)row * RLD + col) = w; }
      }
  }
};


struct EpiAttIn {
  bf16_t *Qda, *Qdb, *Kd, *Vd, *cqn, *ckvn, *Km; float *o_k, *o_v, *o_ckv, *o_kr;
  const float *c16, *s16, *c8, *s8, *qg, *kvg; char* smem;
  DI void operator()(f32x4 (&acc)[G_MI][G_NJ], int rbase, int cbase, int lane) const {
    const int tid = threadIdx.x, wid = tid >> 6, wr = wid >> 2, wc = wid & 3, fr = lane & 15, fq = lane >> 4;
    const int tile = (cbase - wc * 64) >> 8;
    float* part = (float*)smem;
    if (tile < 6) {
      const int which = tile >> 1, c0 = cbase & 511;
#pragma unroll
      for (int i = 0; i < G_MI; ++i) {
        const int rowf = rbase + i * 16, row = rowf + fr;
        const bool lat = rowf >= NCTX;
        const int rl = row - NCTX, b = rl >> 12, t = rl & (TLAT - 1), prow = t >> 6, pcol = t & 63;
        const size_t kr = lat ? (size_t)NCTX + (size_t)b * TKL + 256 + t : (size_t)row;
        u32x2 raw[G_NJ], rot[G_NJ];
#pragma unroll
        for (int j = 0; j < G_NJ; ++j) raw[j] = (u32x2){pack2(acc[i][j][0], acc[i][j][1]), pack2(acc[i][j][2], acc[i][j][3])};
        if (lat && which < 2) {
#pragma unroll
          for (int jp = 0; jp < 2; ++jp) {
            const int pos = jp == 0 ? prow : pcol;
            const f32x4 cs = *(const f32x4*)(c16 + pos * 16 + fq * 4), sn = *(const f32x4*)(s16 + pos * 16 + fq * 4);
            const f32x4 x1 = acc[i][2 * jp], x2 = acc[i][2 * jp + 1];
            f32x4 o1, o2;
#pragma unroll
            for (int e = 0; e < 4; ++e) { o1[e] = x1[e] * cs[e] - x2[e] * sn[e]; o2[e] = x1[e] * sn[e] + x2[e] * cs[e]; }
            rot[2 * jp] = (u32x2){pack2(o1[0], o1[1]), pack2(o1[2], o1[3])};
            rot[2 * jp + 1] = (u32x2){pack2(o2[0], o2[1]), pack2(o2[2], o2[3])};
          }
        }
#pragma unroll
        for (int j = 0; j < G_NJ; ++j) {
          const int c = c0 + j * 16 + fq * 4;
          if (which == 0) {
            *(u32x2*)(Qda + (size_t)row * 512 + c) = raw[j];
            if (lat) *(u32x2*)(Qdb + (size_t)rl * 512 + c) = rot[j];
          } else if (which == 1) {
            if (lat) *(u32x2*)(Kd + kr * 512 + c) = rot[j];
            else { *(u32x2*)(Kd + kr * 512 + c) = raw[j]; *(f32x4*)(o_k + (size_t)row * 512 + c) = acc[i][j]; }
          } else {
            *(u32x2*)(Vd + kr * 512 + c) = raw[j];
            if (!lat) *(f32x4*)(o_v + (size_t)row * 512 + c) = acc[i][j];
          }
        }
      }
      return;
    }
    const bool norm_wave = (tile == 6) || (wc < 2);
#pragma unroll
    for (int i = 0; i < G_MI; ++i) {
      float ss = 0.f;
#pragma unroll
      for (int j = 0; j < G_NJ; ++j)
#pragma unroll
        for (int e = 0; e < 4; ++e) ss += acc[i][j][e] * acc[i][j][e];
      ss += __shfl_xor(ss, 16); ss += __shfl_xor(ss, 32);
      if (fq == 0) part[(wr * 96 + i * 16 + fr) * 4 + wc] = ss;
    }
    __syncthreads();
#pragma unroll
    for (int i = 0; i < G_MI; ++i) {
      const int rowf = rbase + i * 16, row = rowf + fr;
      const bool lat = rowf >= NCTX;
      const int rl = row - NCTX, b = rl >> 12, t = rl & (TLAT - 1), prow = t >> 6, pcol = t & 63;
      const size_t kr = lat ? (size_t)NCTX + (size_t)b * TKL + 256 + t : (size_t)row;
      const f32x4 pr = *(const f32x4*)(part + (wr * 96 + i * 16 + fr) * 4);
      if (tile == 6) {
        const float sc = rsqrtf(((pr[0] + pr[1]) + (pr[2] + pr[3])) * (1.f / 256.f) + EPS);
#pragma unroll
        for (int j = 0; j < G_NJ; ++j) {
          const int c = wc * 64 + j * 16 + fq * 4;
          const f32x4 g = *(const f32x4*)(qg + c);
          *(u32x2*)(cqn + (size_t)row * 256 + c) = (u32x2){pack2(acc[i][j][0] * sc * g[0], acc[i][j][1] * sc * g[1]), pack2(acc[i][j][2] * sc * g[2], acc[i][j][3] * sc * g[3])};
        }
      } else if (norm_wave) {
        const float sc = rsqrtf((pr[0] + pr[1]) * (1.f / 128.f) + EPS);
#pragma unroll
        for (int j = 0; j < G_NJ; ++j) {
          const int c = wc * 64 + j * 16 + fq * 4;
          const f32x4 g = *(const f32x4*)(kvg + c);
          f32x4 y;
#pragma unroll
          for (int e = 0; e < 4; ++e) y[e] = acc[i][j][e] * sc * g[e];
          if (!lat) *(f32x4*)(o_ckv + (size_t)row * 128 + c) = y;
          *(u32x2*)(ckvn + kr * 128 + c) = (u32x2){pack2(y[0], y[1]), pack2(y[2], y[3])};
        }
      } else if (wc == 2) {
#pragma unroll
        for (int j = 0; j < 2; ++j) {
          f32x4 v = acc[i][j];
          if (lat) {
            const int pos = j == 0 ? prow : pcol;
            f32x4 o;
#pragma unroll
            for (int e = 0; e < 4; ++e) {
              const float pv = __shfl_xor(v[e], 32);
              const int f = (fq & 1) * 4 + e;
              const float cs = c8[pos * 8 + f], sn = s8[pos * 8 + f];
              o[e] = (fq < 2) ? (v[e] * cs - pv * sn) : (pv * sn + v[e] * cs);
            }
            v = o;
          } else *(f32x4*)(o_kr + (size_t)row * 32 + j * 16 + fq * 4) = v;
          const u32x2 w = {pack2(v[0], v[1]), pack2(v[2], v[3])};
#pragma unroll
          for (int hh = 0; hh < 8; ++hh) *(u32x2*)(Km + kr * 768 + hh * 96 + 64 + j * 16 + fq * 4) = w;
        }
      }
    }
    __syncthreads();
  }
};

struct EpiUq {
  bf16_t *Qa, *Qb; const float *c8, *s8;
  DI void operator()(f32x4 (&acc)[G_MI][G_NJ], int rbase, int cbase, int lane) const {
    const int fr = lane & 15, fq = lane >> 4;
#pragma unroll
    for (int i = 0; i < G_MI; ++i) {
      const bool lat = (rbase + i * 16) >= NCTX;
      const int row = rbase + i * 16 + fr;
      const int t = (row - NCTX) & (TLAT - 1);
#pragma unroll
      for (int j = 0; j < G_NJ; ++j) {
        const int cf = cbase + j * 16, col = cf + fq * 4;
        f32x4 v = acc[i][j];
        u32x2 w = {pack2(v[0], v[1]), pack2(v[2], v[3])};
        *(u32x2*)(Qa + (size_t)row * 768 + col) = w;
        if (lat) {
          const int w96 = cf % 96;
          if (w96 >= 64) {
            const int pos = (w96 == 64) ? (t >> 6) : (t & 63);
            f32x4 o;
#pragma unroll
            for (int e = 0; e < 4; ++e) {
              const float pv = __shfl_xor(v[e], 32);
              const int f = (fq & 1) * 4 + e;
              const float cs = c8[pos * 8 + f], sn = s8[pos * 8 + f];
              o[e] = (fq < 2) ? (v[e] * cs - pv * sn) : (pv * sn + v[e] * cs);
            }
            w = (u32x2){pack2(o[0], o[1]), pack2(o[2], o[3])};
          }
          *(u32x2*)(Qb + (size_t)(row - NCTX) * 768 + col) = w;
        }
      }
    }
  }
};

struct EpiUkv {
  bf16_t *Km, *Vm;
  DI void operator()(f32x4 (&acc)[G_MI][G_NJ], int rbase, int cbase, int lane) const {
    const int fr = lane & 15, fq = lane >> 4;
    const int h = cbase >> 7, part = (cbase >> 6) & 1;
#pragma unroll
    for (int i = 0; i < G_MI; ++i) {
      if (rbase + i * 16 >= NKEY) continue;
#pragma unroll
      for (int j = 0; j < G_NJ; ++j) {
        const int row = rbase + i * 16 + fr, c = j * 16 + fq * 4;
        u32x2 w = {pack2(acc[i][j][0], acc[i][j][1]), pack2(acc[i][j][2], acc[i][j][3])};
        if (part == 0) *(u32x2*)(Km + (size_t)row * 768 + h * 96 + c) = w;
        else *(u32x2*)(Vm + (size_t)row * 512 + h * 64 + c) = w;
      }
    }
  }
};

struct EpiRes {
  const float *xin_ctx, *xin_lat, *gate  ; float* X;
  DI void operator()(f32x4 (&acc)[G_MI][G_NJ], int rbase, int cbase, int lane) const {
    const int fr = lane & 15, fq = lane >> 4;
#pragma unroll
    for (int i = 0; i < G_MI; ++i) {
      const int row = rbase + i * 16 + fr;
      const float* g = gate + cond_idx(rbase + i * 16) * 6144;
      const float* xin = row < NCTX ? xin_ctx + (size_t)row * 1024 : xin_lat + (size_t)(row - NCTX) * 1024;
#pragma unroll
      for (int j = 0; j < G_NJ; ++j) {
        const int col = cbase + j * 16 + fq * 4;
        const f32x4 xv = *(const f32x4*)(xin + col), gv = *(const f32x4*)(g + col);
        f32x4 z;
#pragma unroll
        for (int e = 0; e < 4; ++e) z[e] = ALPHA * xv[e] + gv[e] * acc[i][j][e];
        *(f32x4*)(X + (size_t)row * 1024 + col) = z;
      }
    }
  }
};


struct EpiResLN {
  const float *xin_ctx, *xin_lat, *gate; float* X;
  const float *lg, *lb, *modsL; int sh_off, sc_off; bf16_t* Hb;
  float* xbuf; unsigned* cnt; char* smem; bool fused;
  DI void operator()(f32x4 (&acc)[G_MI][G_NJ], int rbase, int cbase, int lane) const {
    const int tid = threadIdx.x, wid = tid >> 6, wr = wid >> 2, wc = wid & 3, fr = lane & 15, fq = lane >> 4;
#pragma unroll
    for (int i = 0; i < G_MI; ++i) {
      const int row = rbase + i * 16 + fr;
      const float* g = gate + cond_idx(rbase + i * 16) * 6144;
      const float* xin = row < NCTX ? xin_ctx + (size_t)row * 1024 : xin_lat + (size_t)(row - NCTX) * 1024;
#pragma unroll
      for (int j = 0; j < G_NJ; ++j) {
        const int col = cbase + j * 16 + fq * 4;
        const f32x4 xv = *(const f32x4*)(xin + col), gv = *(const f32x4*)(g + col);
#pragma unroll
        for (int e = 0; e < 4; ++e) acc[i][j][e] = ALPHA * xv[e] + gv[e] * acc[i][j][e];
        if (!fused) *(f32x4*)(X + (size_t)row * 1024 + col) = acc[i][j];
      }
    }
    if (!fused) return;
    const int row0 = rbase - wr * 96, pm = row0 / G_BM, pn = (cbase - wc * 64) / G_BN;
    f32x2* part = (f32x2*)smem;
    f32x2* stat = (f32x2*)(smem + 8192);
#pragma unroll
    for (int i = 0; i < G_MI; ++i) {
      float s1 = 0.f, s2 = 0.f;
#pragma unroll
      for (int j = 0; j < G_NJ; ++j)
#pragma unroll
        for (int e = 0; e < 4; ++e) { const float v = acc[i][j][e]; s1 += v; s2 += v * v; }
      s1 += __shfl_xor(s1, 16); s2 += __shfl_xor(s2, 16);
      s1 += __shfl_xor(s1, 32); s2 += __shfl_xor(s2, 32);
      if (fq == 0) part[(wr * 96 + i * 16 + fr) * 4 + wc] = (f32x2){s1, s2};
    }
    __syncthreads();
    if (tid < G_BM) {
      const f32x2 a = part[tid * 4 + 0], b = part[tid * 4 + 1], c = part[tid * 4 + 2], d = part[tid * 4 + 3];
      const float s1 = (a[0] + b[0]) + (c[0] + d[0]), s2 = (a[1] + b[1]) + (c[1] + d[1]);
      const unsigned long long pk = ((unsigned long long)__float_as_uint(s2) << 32) | (unsigned long long)__float_as_uint(s1);
      __hip_atomic_store((unsigned long long*)(xbuf + ((size_t)(pm * 4 + pn) * G_BM + tid) * 2), pk, __ATOMIC_RELAXED, __HIP_MEMORY_SCOPE_AGENT);
    }
    asm volatile("s_waitcnt vmcnt(0)" ::: "memory");
    __syncthreads();
    if (tid == 0) {
      __hip_atomic_fetch_add(cnt + pm, 1u, __ATOMIC_RELAXED, __HIP_MEMORY_SCOPE_AGENT);
      unsigned sp = 0;
      while (__hip_atomic_load(cnt + pm, __ATOMIC_RELAXED, __HIP_MEMORY_SCOPE_AGENT) < 4u) { __builtin_amdgcn_s_sleep(1); if (++sp > (1u << 22)) break; }
    }
    __syncthreads();
    if (tid < G_BM) {
      float s1 = 0.f, s2 = 0.f;
#pragma unroll
      for (int q = 0; q < 4; ++q) {
        const unsigned long long pk = __hip_atomic_load((unsigned long long*)(xbuf + ((size_t)(pm * 4 + q) * G_BM + tid) * 2), __ATOMIC_RELAXED, __HIP_MEMORY_SCOPE_AGENT);
        s1 += __uint_as_float((unsigned)pk); s2 += __uint_as_float((unsigned)(pk >> 32));
      }
      const float mean = s1 * (1.f / 1024.f);
      const float var = fmaxf(s2 * (1.f / 1024.f) - mean * mean, 0.f);
      stat[tid] = (f32x2){mean, rsqrtf(var + EPS)};
    }
    __syncthreads();
#pragma unroll
    for (int i = 0; i < G_MI; ++i) {
      const int row = rbase + i * 16 + fr;
      const f32x2 ms = stat[wr * 96 + i * 16 + fr];
      const float* m = modsL + cond_idx(rbase + i * 16) * 6144;
#pragma unroll
      for (int j = 0; j < G_NJ; ++j) {
        const int col = cbase + j * 16 + fq * 4;
        const f32x4 gv = *(const f32x4*)(lg + col), bv = *(const f32x4*)(lb + col);
        f32x4 x;
#pragma unroll
        for (int e = 0; e < 4; ++e) x[e] = (acc[i][j][e] - ms[0]) * ms[1] * gv[e] + bv[e];
        *(f32x4*)(X + (size_t)row * 1024 + col) = x;
        if (Hb) {
          const f32x4 sh = *(const f32x4*)(m + sh_off + col), sc = *(const f32x4*)(m + sc_off + col);
          u32x2 w = {pack2(x[0] * (1.f + sc[0]) + sh[0], x[1] * (1.f + sc[1]) + sh[1]), pack2(x[2] * (1.f + sc[2]) + sh[2], x[3] * (1.f + sc[3]) + sh[3])};
          *(u32x2*)(Hb + (size_t)row * 1024 + col) = w;
        }
      }
    }
    __syncthreads();
  }
};

struct EpiRelu2 {
  bf16_t* U;
  DI void operator()(f32x4 (&acc)[G_MI][G_NJ], int rbase, int cbase, int lane) const {
    const int fr = lane & 15, fq = lane >> 4;
#pragma unroll
    for (int i = 0; i < G_MI; ++i)
#pragma unroll
      for (int j = 0; j < G_NJ; ++j) {
        const int row = rbase + i * 16 + fr, col = cbase + j * 16 + fq * 4;
        f32x4 v = acc[i][j];
#pragma unroll
        for (int e = 0; e < 4; ++e) { const float r = fmaxf(v[e], 0.f); v[e] = r * r; }
        u32x2 w = {pack2(v[0], v[1]), pack2(v[2], v[3])};
        *(u32x2*)(U + (size_t)row * 4096 + col) = w;
      }
  }
};

struct EpiConv {
  bf16_t *Ug, *Pz;
  DI void operator()(f32x4 (&acc)[G_MI][G_NJ], int rbase, int cbase, int lane) const {
    const int fr = lane & 15, fq = lane >> 4;
#pragma unroll
    for (int i = 0; i < G_MI; ++i) {
      const int row = rbase + i * 16 + fr;
      if (cbase < 1024) {
#pragma unroll
        for (int jp = 0; jp < 2; ++jp) {
          const f32x4 a = acc[i][2 * jp], gt = acc[i][2 * jp + 1];
          f32x4 u;
#pragma unroll
          for (int e = 0; e < 4; ++e) u[e] = a[e] / (1.f + __expf(-gt[e]));
          const int ch = ((cbase + 32 * jp) >> 5) * 16 + fq * 4;
          u32x2 w = {pack2(u[0], u[1]), pack2(u[2], u[3])};
          *(u32x2*)(Ug + (size_t)row * 512 + ch) = w;
        }
      } else {
#pragma unroll
        for (int j = 0; j < G_NJ; ++j) {
          const int col = cbase - 1024 + j * 16 + fq * 4;
          u32x2 w = {pack2(acc[i][j][0], acc[i][j][1]), pack2(acc[i][j][2], acc[i][j][3])};
          *(u32x2*)(Pz + (size_t)row * 512 + col) = w;
        }
      }
    }
  }
};

#ifndef XCD_ORDER
#define XCD_ORDER 1
#endif
template <class Epi>
DI void gemm_phase(const bf16_t* A, int lda, const bf16_t* Bt, int ldb, int K, int mt, int nt, const Epi& epi, char* smem, int tstart = 0, int ttotal = -1) {
  const int n = mt * nt;
  if (ttotal < 0) ttotal = n;
  for (int t = blockIdx.x; t < ttotal; t += gridDim.x) {
    const int u = t - tstart;
    if (u < 0 || u >= n) continue;
    int pm = u / nt, pn = u - pm * nt;
    if (XCD_ORDER && gridDim.x == 256 && (nt & 3) == 0 && (mt & 3) == 0 && n % 256 == 0) {
      const int r = u >> 8, w = u & 255, x = w & 7, idx = w >> 3;
      const int rows_r = 256 / nt;
      const int pw = nt < 8 ? nt : 8, ph = 32 / pw;
      const int npx = nt / pw;
      const int px = x % npx, py = x / npx;
      pm = r * rows_r + py * ph + idx / pw; pn = px * pw + idx % pw;
    }
    gemm_tile(A, lda, Bt, ldb, K, pm * G_BM, pn * G_BN, smem, epi);
  }
}

DI void rows_phase(const float* src_ctx, const float* src_lat, bool do_ln, const float* lg, const float* lb, float* Xdst,
                   const float* modsL, int sh_off, int sc_off, bf16_t* Hb) {
  const int lane = threadIdx.x & 63, gw = blockIdx.x * NWAVE + (threadIdx.x >> 6), nw = gridDim.x * NWAVE;
  for (int row = gw; row < NTOK; row += nw) {
    const float* src = row < NCTX ? src_ctx + (size_t)row * 1024 : src_lat + (size_t)(row - NCTX) * 1024;
    f32x4 v[4];
#pragma unroll
    for (int i = 0; i < 4; ++i) v[i] = *(const f32x4*)(src + i * 256 + lane * 4);
    if (do_ln) {
      float s = 0.f;
#pragma unroll
      for (int i = 0; i < 4; ++i) s += (v[i][0] + v[i][1]) + (v[i][2] + v[i][3]);
      const float mean = wave_sum(s) * (1.f / 1024.f);
      float q = 0.f;
#pragma unroll
      for (int i = 0; i < 4; ++i)
#pragma unroll
        for (int e = 0; e < 4; ++e) { const float d = v[i][e] - mean; q += d * d; }
      const float rstd = rsqrtf(wave_sum(q) * (1.f / 1024.f) + EPS);
#pragma unroll
      for (int i = 0; i < 4; ++i) {
        const f32x4 g = *(const f32x4*)(lg + i * 256 + lane * 4), b = *(const f32x4*)(lb + i * 256 + lane * 4);
#pragma unroll
        for (int e = 0; e < 4; ++e) v[i][e] = (v[i][e] - mean) * rstd * g[e] + b[e];
        if (Xdst) *(f32x4*)(Xdst + (size_t)row * 1024 + i * 256 + lane * 4) = v[i];
      }
    }
    if (Hb) {
      const float* m = modsL + cond_idx(row) * 6144;
#pragma unroll
      for (int i = 0; i < 4; ++i) {
        const int col = i * 256 + lane * 4;
        const f32x4 sh = *(const f32x4*)(m + sh_off + col), sc = *(const f32x4*)(m + sc_off + col);
        f32x4 h;
#pragma unroll
        for (int e = 0; e < 4; ++e) h[e] = v[i][e] * (1.f + sc[e]) + sh[e];
        u32x2 w = {pack2(h[0], h[1]), pack2(h[2], h[3])};
        *(u32x2*)(Hb + (size_t)row * 1024 + col) = w;
      }
    }
  }
}

DI double sin_red(double r) {
  const double r2 = r * r; double t = -1.0 / 51090942171709440000.0;
  t = t * r2 + 1.0 / 121645100408832000.0; t = t * r2 - 1.0 / 355687428096000.0; t = t * r2 + 1.0 / 1307674368000.0; t = t * r2 - 1.0 / 6227020800.0;
  t = t * r2 + 1.0 / 39916800.0; t = t * r2 - 1.0 / 362880.0; t = t * r2 + 1.0 / 5040.0; t = t * r2 - 1.0 / 120.0; t = t * r2 + 1.0 / 6.0;
  return r * (1.0 - r2 * t);
}
DI double cos_red(double r) {
  const double r2 = r * r; double t = 1.0 / 1124000727777607680000.0;
  t = t * r2 - 1.0 / 2432902008176640000.0; t = t * r2 + 1.0 / 6402373705728000.0; t = t * r2 - 1.0 / 20922789888000.0; t = t * r2 + 1.0 / 87178291200.0;
  t = t * r2 - 1.0 / 479001600.0; t = t * r2 + 1.0 / 3628800.0; t = t * r2 - 1.0 / 40320.0; t = t * r2 + 1.0 / 720.0; t = t * r2 - 1.0 / 24.0; t = t * r2 + 0.5; t = t * r2 * -1.0 + 1.0;
  return t;
}

constexpr int J_MODS = 192, J_WEFF = 64, J_CACHE = 64, J_ROPE = 1, J_SLOW = J_MODS + J_WEFF + J_CACHE + J_ROPE;
constexpr int T_ATTIN = 16 * 16, T_UQ = 4 * 6, T_UKV = 2 * 8, T_ATTOUT = 16 * 8, T_MLPIN = 16 * 32, T_MLPOUT = 64 * 8, T_CONVIN = 16 * 12, T_CONVOUT = 8 * 8;
constexpr int J_TR = T_ATTIN + T_UQ + T_UKV + T_ATTOUT + 2 * T_MLPIN + 2 * T_MLPOUT + T_CONVIN + T_CONVOUT;

struct TJ { const float* src; bf16_t* dst; int N, nvalid, lddst, perm, kt, nt; };
DI TJ tr_decode(const Params& p, int j) {
  char* ws = p.ws;
  TJ t; t.perm = 0;
  if (j < T_ATTIN) { t.src = p.w_att_in; t.N = 1952; t.nvalid = 1952; t.dst = (bf16_t*)(ws + O_WATTIN); t.lddst = 1024; t.kt = j / 16; t.nt = j % 16; return t; }
  j -= T_ATTIN;
  if (j < T_UQ) { t.src = p.w_uq; t.N = 768; t.nvalid = 768; t.dst = (bf16_t*)(ws + O_WUQ); t.lddst = 256; t.kt = j / 6; t.nt = j % 6; return t; }
  j -= T_UQ;
  if (j < T_UKV) { t.src = p.w_ukv; t.N = 1024; t.nvalid = 1024; t.dst = (bf16_t*)(ws + O_WUKV); t.lddst = 128; t.kt = j / 8; t.nt = j % 8; return t; }
  j -= T_UKV;
  if (j < T_ATTOUT) { t.src = p.w_att_out; t.N = 1024; t.nvalid = 1024; t.dst = (bf16_t*)(ws + O_WATTOUT); t.lddst = 1024; t.kt = j / 8; t.nt = j % 8; return t; }
  j -= T_ATTOUT;
  if (j < 2 * T_MLPIN) { const int l = j / T_MLPIN, u = j % T_MLPIN; t.src = p.w_mlp_in + (size_t)l * 1024 * 4096; t.N = 4096; t.nvalid = 4096; t.dst = (bf16_t*)(ws + O_WMLPIN) + (size_t)l * 4096 * 1024; t.lddst = 1024; t.kt = u / 32; t.nt = u % 32; return t; }
  j -= 2 * T_MLPIN;
  if (j < 2 * T_MLPOUT) { const int l = j / T_MLPOUT, u = j % T_MLPOUT; t.src = p.w_mlp_out + (size_t)l * 4096 * 1024; t.N = 1024; t.nvalid = 1024; t.dst = (bf16_t*)(ws + O_WMLPOUT) + (size_t)l * 4096 * 1024; t.lddst = 4096; t.kt = u / 8; t.nt = u % 8; return t; }
  j -= 2 * T_MLPOUT;
  if (j < T_CONVIN) { t.src = p.w_conv_in; t.N = 1536; t.nvalid = 1536; t.dst = (bf16_t*)(ws + O_WCONVIN); t.lddst = 1024; t.perm = 1; t.kt = j / 12; t.nt = j % 12; return t; }
  j -= T_CONVIN;
  t.src = p.w_conv_out; t.N = 1024; t.nvalid = 1024; t.dst = (bf16_t*)(ws + O_WCONVOUT); t.lddst = 1024; t.kt = j / 8; t.nt = j % 8; return t;
}
DI void tr_load(const TJ& t, float (&v)[16]) {
  const int tid = threadIdx.x, n = tid & 127, kb = tid >> 7;
  const int gn = t.nt * 128 + n;
  const float* s = t.src + (size_t)(t.kt * 64 + kb) * t.N + gn;
#pragma unroll
  for (int i = 0; i < 16; ++i) v[i] = (gn < t.nvalid) ? s[(size_t)(4 * i) * t.N] : 0.f;
}

DI void phase0(const Params& p, char* smem) {
  const int tid = threadIdx.x, lane = tid & 63, wid = tid >> 6;
  char* ws = p.ws;
  for (int job = blockIdx.x; job < J_SLOW; job += gridDim.x) {
    int j = job;
    if (j < J_MODS) {
      const int l = j / 96, cc = j % 96;
      float* sc = (float*)smem;
      for (int i = tid; i < 3072; i += NT) { const int ci = i >> 10, k = i & 1023; const float x = ci == 0 ? p.c_ctx[k] : p.c[(ci - 1) * 1024 + k]; sc[i] = x / (1.f + __expf(-x)); }
      __syncthreads();
      const int kg = tid >> 6, cl = tid & 63;
      const float* w = p.w_ada + (size_t)l * 1024 * 6144 + cc * 64 + cl;
      float s0 = 0.f, s1 = 0.f, s2 = 0.f;
#pragma unroll 16
      for (int k = kg * 128; k < kg * 128 + 128; ++k) { const float wv = w[(size_t)k * 6144]; s0 += sc[k] * wv; s1 += sc[1024 + k] * wv; s2 += sc[2048 + k] * wv; }
      float* r = (float*)(smem + 12288);
      r[(kg * 3 + 0) * 64 + cl] = s0; r[(kg * 3 + 1) * 64 + cl] = s1; r[(kg * 3 + 2) * 64 + cl] = s2;
      __syncthreads();
      if (tid < 192) {
        const int ci = tid >> 6, c2 = tid & 63;
        float s = 0.f;
#pragma unroll
        for (int g = 0; g < 8; ++g) s += r[(g * 3 + ci) * 64 + c2];
        ((float*)(ws + O_MODS))[(size_t)(l * 3 + ci) * 6144 + cc * 64 + c2] = s + p.b_ada[l * 6144 + cc * 64 + c2];
      }
      __syncthreads();
      continue;
    }
    j -= J_MODS;
    if (j < J_WEFF) {
      const int g = j >> 4, cch = (j >> 1) & 7, nch = j & 1;
      float* wp = (float*)smem;
      for (int i = tid; i < 2048; i += NT) wp[i] = p.w_pool[(size_t)(g * 128 + cch * 16 + (i >> 7)) * 128 + (i & 127)];
      __syncthreads();
      const int n = nch * 512 + tid;
      float a[16];
#pragma unroll
      for (int c = 0; c < 16; ++c) a[c] = 0.f;
#pragma unroll 4
      for (int e = 0; e < 128; ++e) {
        const float wo = p.w_conv_out[(size_t)(512 + g * 128 + e) * 1024 + n] * p.pool_scale[g * 128 + e];
#pragma unroll
        for (int c = 0; c < 16; ++c) a[c] += wp[c * 128 + e] * wo;
      }
      bf16_t* d = (bf16_t*)(ws + O_WCONVOUT) + (size_t)n * 1024 + 512 + g * 128 + cch * 16;
      *(u32x4*)d = (u32x4){pack2(a[0], a[1]), pack2(a[2], a[3]), pack2(a[4], a[5]), pack2(a[6], a[7])};
      *(u32x4*)(d + 8) = (u32x4){pack2(a[8], a[9]), pack2(a[10], a[11]), pack2(a[12], a[13]), pack2(a[14], a[15])};
      __syncthreads();
      continue;
    }
    j -= J_WEFF;
    if (j < J_CACHE) {
      const int rr = j * 8 + wid, b = rr >> 8, t = rr & 255;
      const size_t kr = NCTX + (size_t)b * TKL + t;
      const f32x4 a0 = *(const f32x4*)(p.cache_k + (size_t)rr * 512 + lane * 8), a1 = *(const f32x4*)(p.cache_k + (size_t)rr * 512 + lane * 8 + 4);
      *(u32x4*)((bf16_t*)(ws + O_KD) + kr * 512 + lane * 8) = (u32x4){pack2(a0[0], a0[1]), pack2(a0[2], a0[3]), pack2(a1[0], a1[1]), pack2(a1[2], a1[3])};
      const f32x4 b0 = *(const f32x4*)(p.cache_v + (size_t)rr * 512 + lane * 8), b1 = *(const f32x4*)(p.cache_v + (size_t)rr * 512 + lane * 8 + 4);
      *(u32x4*)((bf16_t*)(ws + O_VD) + kr * 512 + lane * 8) = (u32x4){pack2(b0[0], b0[1]), pack2(b0[2], b0[3]), pack2(b1[0], b1[1]), pack2(b1[2], b1[3])};
      const f32x2 cv = *(const f32x2*)(p.cache_ckv + (size_t)rr * 128 + lane * 2);
      *(unsigned*)((bf16_t*)(ws + O_CKVN) + kr * 128 + lane * 2) = pack2(cv[0], cv[1]);
      const int idx = lane & 31;
      const float x = p.cache_krope[(size_t)rr * 32 + idx];
      const unsigned pk = pack2(x, x);
#pragma unroll
      for (int k = 0; k < 4; ++k) { const int hh = (lane >> 5) + 2 * k; ((bf16_t*)(ws + O_KMLA))[kr * 768 + hh * 96 + 64 + idx] = (bf16_t)(pk & 0xffff); }
      continue;
    }
    j -= J_CACHE;
    {
      float* c16 = (float*)(ws + O_C16); float* s16 = (float*)(ws + O_S16); float* c8 = (float*)(ws + O_C8); float* s8 = (float*)(ws + O_S8);
      for (int i = tid; i < 1024 + 512; i += NT) {
        int pos, f, half;
        if (i < 1024) { pos = i >> 4; f = i & 15; half = 16; } else { const int q = i - 1024; pos = q >> 3; f = q & 7; half = 8; }
        const float inv = (float)exp(-9.210340371976184 * (double)f / (double)half);
        const float angf = (float)pos * inv;
        const double ang = (double)angf;
        const double r = ang - 6.283185307179586 * rint(ang * 0.15915494309189535);
        const float cs = (float)cos_red(r), sn = (float)sin_red(r);
        if (i < 1024) { c16[i] = cs; s16[i] = sn; } else { c8[i - 1024] = cs; s8[i - 1024] = sn; }
      }
      if (wid == 0) {
        const float d1 = wave_sum(p.lam_q1[lane] * p.lam_k1[lane]), d2 = wave_sum(p.lam_q2[lane] * p.lam_k2[lane]);
        if (lane == 0) ((float*)(ws + O_SCAL))[0] = expf(d1) - expf(d2) + 0.2f;
      }
    }
  }
  {
    float* tile = (float*)smem;
    int j = (blockIdx.x + gridDim.x - (J_SLOW % gridDim.x)) % gridDim.x;
    float v[16];
    TJ cur;
    if (j < J_TR) { cur = tr_decode(p, j); tr_load(cur, v); }
    while (j < J_TR) {
      {
        const int n = tid & 127, kb = tid >> 7;
#pragma unroll
        for (int i = 0; i < 16; ++i) tile[(kb + 4 * i) * 129 + n] = v[i];
      }
      __syncthreads();
      const int jn = j + gridDim.x;
      TJ nxt = cur;
      if (jn < J_TR) { nxt = tr_decode(p, jn); tr_load(nxt, v); }
      {
        const int n = tid >> 2, ks = (tid & 3) * 16;
        int gn = cur.nt * 128 + n;
        if (cur.perm) { if (gn < 512) gn = 32 * (gn >> 4) + (gn & 15); else if (gn < 1024) { const int c = gn - 512; gn = 32 * (c >> 4) + 16 + (c & 15); } }
        unsigned w[8];
#pragma unroll
        for (int e = 0; e < 8; ++e) w[e] = pack2(tile[(ks + 2 * e) * 129 + n], tile[(ks + 2 * e + 1) * 129 + n]);
        bf16_t* d = cur.dst + (size_t)gn * cur.lddst + cur.kt * 64 + ks;
        *(u32x4*)d = (u32x4){w[0], w[1], w[2], w[3]};
        *(u32x4*)(d + 8) = (u32x4){w[4], w[5], w[6], w[7]};
      }
      __syncthreads();
      cur = nxt; j = jn;
    }
  }
}

DI void rope8(const float (&x)[8], float (&o)[8], int lane, const float* c16, const float* s16, int prow, int pcol) {
  const int L = lane & 7;
  const int pos = (L & 4) ? pcol : prow;
  const bool second = (L & 2) != 0;
  const int fb = (L & 1) * 8;
#pragma unroll
  for (int e = 0; e < 8; ++e) {
    const float y = __shfl_xor(x[e], 2);
    const float cs = c16[pos * 16 + fb + e], sn = s16[pos * 16 + fb + e];
    o[e] = second ? (y * sn + x[e] * cs) : (x[e] * cs - y * sn);
  }
}
DI void unpack8(const u32x4 w, float (&x)[8]) {
#pragma unroll
  for (int e = 0; e < 4; ++e) { x[2 * e] = bflo(w[e]); x[2 * e + 1] = bfhi(w[e]); }
}
DI u32x4 pack8(const float (&x)[8]) { return (u32x4){pack2(x[0], x[1]), pack2(x[2], x[3]), pack2(x[4], x[5]), pack2(x[6], x[7])}; }

DI void phase3(const Params& p) {
  char* ws = p.ws;
  const bf16_t* R = (const bf16_t*)(ws + O_R);
  bf16_t* Qda = (bf16_t*)(ws + O_QDA); bf16_t* Qdb = (bf16_t*)(ws + O_QDB); bf16_t* Kd = (bf16_t*)(ws + O_KD); bf16_t* Vd = (bf16_t*)(ws + O_VD);
  bf16_t* cqn = (bf16_t*)(ws + O_CQN); bf16_t* ckvn = (bf16_t*)(ws + O_CKVN); bf16_t* Km = (bf16_t*)(ws + O_KMLA);
  const float* c16 = (const float*)(ws + O_C16); const float* s16 = (const float*)(ws + O_S16); const float* c8 = (const float*)(ws + O_C8); const float* s8 = (const float*)(ws + O_S8);
  float* o_k = p.out + (size_t)NTOK * 1024; float* o_v = o_k + (size_t)NCTX * 512; float* o_ckv = o_v + (size_t)NCTX * 512; float* o_kr = o_ckv + (size_t)NCTX * 128;
  const int lane = threadIdx.x & 63, gw = blockIdx.x * NWAVE + (threadIdx.x >> 6), nw = gridDim.x * NWAVE;
  for (int row = gw; row < NTOK; row += nw) {
    const bool lat = row >= NCTX;
    const int rl = row - NCTX, b = rl >> 12, t = rl & (TLAT - 1), prow = t >> 6, pcol = t & 63;
    const size_t kr = lat ? (size_t)NCTX + (size_t)b * TKL + 256 + t : (size_t)row;
    const bf16_t* r = R + (size_t)row * RLD;
    float x[8], o[8];
    const u32x4 wq = *(const u32x4*)(r + lane * 8);
    *(u32x4*)(Qda + (size_t)row * 512 + lane * 8) = wq;
    if (lat) { unpack8(wq, x); rope8(x, o, lane, c16, s16, prow, pcol); *(u32x4*)(Qdb + (size_t)rl * 512 + lane * 8) = pack8(o); }
    const u32x4 wk = *(const u32x4*)(r + 512 + lane * 8);
    if (lat) { unpack8(wk, x); rope8(x, o, lane, c16, s16, prow, pcol); *(u32x4*)(Kd + kr * 512 + lane * 8) = pack8(o); }
    else {
      unpack8(wk, x);
      *(f32x4*)(o_k + (size_t)row * 512 + lane * 8) = (f32x4){x[0], x[1], x[2], x[3]};
      *(f32x4*)(o_k + (size_t)row * 512 + lane * 8 + 4) = (f32x4){x[4], x[5], x[6], x[7]};
      *(u32x4*)(Kd + kr * 512 + lane * 8) = wk;
    }
    const u32x4 wv = *(const u32x4*)(r + 1024 + lane * 8);
    *(u32x4*)(Vd + kr * 512 + lane * 8) = wv;
    if (!lat) {
      unpack8(wv, x);
      *(f32x4*)(o_v + (size_t)row * 512 + lane * 8) = (f32x4){x[0], x[1], x[2], x[3]};
      *(f32x4*)(o_v + (size_t)row * 512 + lane * 8 + 4) = (f32x4){x[4], x[5], x[6], x[7]};
    }
    {
      const u32x2 w = *(const u32x2*)(r + 1536 + lane * 4);
      const float a0 = bflo(w[0]), a1 = bfhi(w[0]), a2 = bflo(w[1]), a3 = bfhi(w[1]);
      const float ss = wave_sum(a0 * a0 + a1 * a1 + a2 * a2 + a3 * a3);
      const float sc = rsqrtf(ss * (1.f / 256.f) + EPS);
      const f32x4 g = *(const f32x4*)(p.q_norm_g + lane * 4);
      *(u32x2*)(cqn + (size_t)row * 256 + lane * 4) = (u32x2){pack2(a0 * sc * g[0], a1 * sc * g[1]), pack2(a2 * sc * g[2], a3 * sc * g[3])};
    }
    {
      const unsigned w = *(const unsigned*)(r + 1792 + lane * 2);
      const float a0 = bflo(w), a1 = bfhi(w);
      const float ss = wave_sum(a0 * a0 + a1 * a1);
      const float sc = rsqrtf(ss * (1.f / 128.f) + EPS);
      const f32x2 g = *(const f32x2*)(p.kv_norm_g + lane * 2);
      const float y0 = a0 * sc * g[0], y1 = a1 * sc * g[1];
      if (!lat) *(f32x2*)(o_ckv + (size_t)row * 128 + lane * 2) = (f32x2){y0, y1};
      *(unsigned*)(ckvn + kr * 128 + lane * 2) = pack2(y0, y1);
    }
    {
      const int idx = lane & 31;
      const float xv = bf2f(r[1920 + idx]);
      float ov = xv;
      if (lat) {
        const int pos = (idx & 16) ? pcol : prow;
        const int f = idx & 7;
        const float y = __shfl_xor(xv, 8);
        const float cs = c8[pos * 8 + f], sn = s8[pos * 8 + f];
        ov = (idx & 8) ? (y * sn + xv * cs) : (xv * cs - y * sn);
      } else if (lane < 32) o_kr[(size_t)row * 32 + idx] = xv;
      const bf16_t ob = (bf16_t)(pack2(ov, ov) & 0xffff);
#pragma unroll
      for (int k = 0; k < 4; ++k) { const int hh = (lane >> 5) + 2 * k; Km[kr * 768 + hh * 96 + 64 + idx] = ob; }
    }
  }
}

template <int DQK, int DV>
DI void attn_core(const bf16_t* __restrict__ Qa, const bf16_t* __restrict__ Qb, int ldq, const bf16_t* __restrict__ Kp, int ldk, const bf16_t* __restrict__ Vp, int ldv,
                  int Tk, int n_a, float c  , char* smem, f32x16 (&o)[DV / 32]) {
  constexpr int KS = DQK * 2 + 16, VS = DV * 2 + 64, BUF = 64 * (KS + VS);
  constexpr int KCH = DQK / 8, VCH = DV / 8, NKCH = 64 * KCH, NVCH = 64 * VCH, NKC = (NKCH + NT - 1) / NT, NVC = (NVCH + NT - 1) / NT;
  constexpr bool KG = (NKCH % NT) != 0, VG = (NVCH % NT) != 0;
  constexpr int NS = DQK / 16, NDT = DV / 32;
  const int tid = threadIdx.x, lane = tid & 63, wid = tid >> 6, h = lane >> 5, ql = lane & 31;
  bf16x8 qf[NS];
  {
    const bf16_t* q = Qa + (size_t)(wid * 32 + ql) * ldq + h * 8;
#pragma unroll
    for (int s = 0; s < NS; ++s) qf[s] = *(const bf16x8*)(q + s * 16);
  }
#pragma unroll
  for (int dt = 0; dt < NDT; ++dt)
#pragma unroll
    for (int r = 0; r < 16; ++r) o[dt][r] = 0.f;
  float m_run = -INFINITY, l_run = 0.f;
  u32x4 rk[NKC], rv[NVC];
  const int nt = Tk >> 6, ta = n_a >> 6;
  unsigned koff[NKC], voff[NVC];
#pragma unroll
  for (int i = 0; i < NKC; ++i) { const int ch = tid + NT * i, row = ch / KCH, kc = ch % KCH; koff[i] = (unsigned)(row * ldk + kc * 8); }
#pragma unroll
  for (int i = 0; i < NVC; ++i) { const int ch = tid + NT * i, row = ch / VCH, vc = ch % VCH; voff[i] = (unsigned)(row * ldv + vc * 8); }
  auto gload = [&](int t) {
    const bf16_t* kb = Kp + (size_t)t * 64 * ldk;
    const bf16_t* vbp = Vp + (size_t)t * 64 * ldv;
#pragma unroll
    for (int i = 0; i < NKC; ++i) if (!KG || i + 1 < NKC || tid + NT * i < NKCH) rk[i] = *(const u32x4*)(kb + koff[i]);
#pragma unroll
    for (int i = 0; i < NVC; ++i) if (!VG || i + 1 < NVC || tid + NT * i < NVCH) rv[i] = *(const u32x4*)(vbp + voff[i]);
  };
  auto lstoreK = [&](char* buf) {
#pragma unroll
    for (int i = 0; i < NKC; ++i) { const int ch = tid + NT * i, row = ch / KCH, kc = ch % KCH; if (!KG || i + 1 < NKC || ch < NKCH) *(u32x4*)(buf + row * KS + kc * 16) = rk[i]; }
  };
  auto lstoreV = [&](char* buf) {
#pragma unroll
    for (int i = 0; i < NVC; ++i) { const int ch = tid + NT * i, row = ch / VCH, vc = ch % VCH; if (!VG || i + 1 < NVC || ch < NVCH) *(u32x4*)(buf + 64 * KS + row * VS + vc * 16) = rv[i]; }
  };
  gload(0); lstoreK(smem); lstoreV(smem); lds_barrier();
  const int i16 = lane & 15, tq = i16 >> 2, tp = i16 & 3, G = (lane >> 4) & 1;
  auto run_tiles = [&](int t_begin, int t_end) {
  for (int t = t_begin; t < t_end; ++t) {
    char* cur = smem + (t & 1) * BUF;
    gload(min(t + 1, nt - 1));
    f32x16 st[2];
#pragma unroll
    for (int kt = 0; kt < 2; ++kt) {
#pragma unroll
      for (int r = 0; r < 16; ++r) st[kt][r] = 0.f;
#pragma unroll
      for (int s = 0; s < NS; ++s) {
        const bf16x8 kf = *(const bf16x8*)(cur + (kt * 32 + ql) * KS + s * 32 + h * 16);
        st[kt] = __builtin_amdgcn_mfma_f32_32x32x16_bf16(kf, qf[s], st[kt], 0, 0, 0);
      }
      __builtin_amdgcn_sched_barrier(0);
    }
    float mx = st[0][0];
#pragma unroll
    for (int kt = 0; kt < 2; ++kt)
#pragma unroll
      for (int r = 0; r < 16; ++r) mx = fmaxf(mx, st[kt][r]);
    mx = fmaxf(mx, __shfl_xor(mx, 32));
    const float m_new = fmaxf(m_run, mx);
    const float alpha = __builtin_amdgcn_exp2f((m_run - m_new) * c);
    const float mc = m_new * c;
    m_run = m_new;
    float ls = 0.f;
#pragma unroll
    for (int kt = 0; kt < 2; ++kt)
#pragma unroll
      for (int r = 0; r < 16; ++r) { const float pv = __builtin_amdgcn_exp2f(st[kt][r] * c - mc); st[kt][r] = pv; ls += pv; }
    l_run = l_run * alpha + ls;
    if (__any(alpha != 1.f)) {
#pragma unroll
      for (int dt = 0; dt < NDT; ++dt)
#pragma unroll
        for (int r = 0; r < 16; ++r) o[dt][r] *= alpha;
    }
    bf16x8 pf[2][2];
#pragma unroll
    for (int kt = 0; kt < 2; ++kt)
#pragma unroll
      for (int s2 = 0; s2 < 2; ++s2) {
        u32x4 w = {pack2(st[kt][8 * s2 + 0], st[kt][8 * s2 + 1]), pack2(st[kt][8 * s2 + 2], st[kt][8 * s2 + 3]), pack2(st[kt][8 * s2 + 4], st[kt][8 * s2 + 5]), pack2(st[kt][8 * s2 + 6], st[kt][8 * s2 + 7])};
        pf[kt][s2] = __builtin_bit_cast(bf16x8, w);
      }
    const char* vb = cur + 64 * KS + (4 * h + tq) * VS + 32 * G + 8 * tp;
#pragma unroll
    for (int kt = 0; kt < 2; ++kt)
#pragma unroll
      for (int s2 = 0; s2 < 2; ++s2) {
        bf16x8 vf[NDT];
#pragma unroll
        for (int dt = 0; dt < NDT; ++dt) {
          const char* a0 = vb + (kt * 32 + 16 * s2) * VS + dt * 64;
          const s16x4 lo = __builtin_amdgcn_ds_read_tr16_b64_v4i16((LDS_AS s16x4*)(a0));
          const s16x4 hi = __builtin_amdgcn_ds_read_tr16_b64_v4i16((LDS_AS s16x4*)(a0 + 8 * VS));
          vf[dt] = __builtin_shufflevector(lo, hi, 0, 1, 2, 3, 4, 5, 6, 7);
        }
#pragma unroll
        for (int dt = 0; dt < NDT; ++dt) o[dt] = __builtin_amdgcn_mfma_f32_32x32x16_bf16(vf[dt], pf[kt][s2], o[dt], 0, 0, 0);
        __builtin_amdgcn_sched_barrier(0);
      }
    lstoreK(smem + ((t + 1) & 1) * BUF); lstoreV(smem + ((t + 1) & 1) * BUF);
    lds_barrier();
  }
  };
  run_tiles(0, min(ta, nt));
  if (ta < nt) {
    const bf16_t* q = Qb + (size_t)(wid * 32 + ql) * ldq + h * 8;
#pragma unroll
    for (int s = 0; s < NS; ++s) qf[s] = *(const bf16x8*)(q + s * 16);
    run_tiles(ta, nt);
  }
  const float l = l_run + __shfl_xor(l_run, 32);
  const float inv = 1.f / l;
#pragma unroll
  for (int dt = 0; dt < NDT; ++dt)
#pragma unroll
    for (int r = 0; r < 16; ++r) o[dt][r] *= inv;
}

constexpr int U_DBIG = 128, U_MBIG = 256, U_DCTX = 64, U_MCTX = 128, U_TOTAL = U_DBIG + U_MBIG + U_DCTX + U_MCTX;

DI void phase_attn(const Params& p, char* smem, int cidx) {
  char* ws = p.ws;
  const bf16_t* Qda = (const bf16_t*)(ws + O_QDA); const bf16_t* Qdb = (const bf16_t*)(ws + O_QDB); const bf16_t* Kd = (const bf16_t*)(ws + O_KD); const bf16_t* Vd = (const bf16_t*)(ws + O_VD);
  const bf16_t* Qma = (const bf16_t*)(ws + O_QMA); const bf16_t* Qmb = (const bf16_t*)(ws + O_QMB); const bf16_t* Km = (const bf16_t*)(ws + O_KMLA); const bf16_t* Vm = (const bf16_t*)(ws + O_VMLA);
  bf16_t* cat = (bf16_t*)(ws + O_HB);
  float* otmp = (float*)(ws + O_OTMP) + (size_t)blockIdx.x * 32768;
  int* counter = (int*)(ws + O_CNT) + cidx;
  int* s_unit = (int*)(smem + 65532);
  const int tid = threadIdx.x, lane = tid & 63, wid = tid >> 6, h2 = lane >> 5, ql = lane & 31;
  const float lam = ((const float*)(ws + O_SCAL))[0];
  for (;;) {
    if (tid == 0) *s_unit = atomicAdd(counter, 1);
    __syncthreads();
    int u = __builtin_amdgcn_readfirstlane(*s_unit);
    __syncthreads();
    if (u >= U_TOTAL) break;
    bool diff; int qrow0, krow0, Tk, n_a, head; bool lat;
    if (u < U_DBIG) { diff = true; lat = true; const int b = u >> 6, hh = (u >> 4) & 3, qb = u & 15; head = hh; qrow0 = NCTX + b * TLAT + qb * 256; krow0 = NCTX + b * TKL; Tk = TKL; n_a = 256; }
    else if (u < U_DBIG + U_MBIG) { u -= U_DBIG; diff = false; lat = true; const int b = u >> 7, hh = (u >> 4) & 7, qb = u & 15; head = hh; qrow0 = NCTX + b * TLAT + qb * 256; krow0 = NCTX + b * TKL; Tk = TKL; n_a = 256; }
    else if (u < U_DBIG + U_MBIG + U_DCTX) { u -= U_DBIG + U_MBIG; diff = true; lat = false; const int sq = u >> 2, hh = u & 3; head = hh; qrow0 = sq * 256; krow0 = sq * 256; Tk = 256; n_a = 256; }
    else { u -= U_DBIG + U_MBIG + U_DCTX; diff = false; lat = false; const int sq = u >> 3, hh = u & 7; head = hh; qrow0 = sq * 256; krow0 = sq * 256; Tk = 256; n_a = 256; }
    const int qrowb = lat ? qrow0 - NCTX : 0;
    if (diff) {
      f32x16 o[4];
      const float c = 0.125f * 1.4426950408889634f;
#pragma unroll 1
      for (int m = 0; m < 2; ++m) {
        attn_core<64, 128>(Qda + (size_t)qrow0 * 512 + head * 128 + m * 64, Qdb + (size_t)qrowb * 512 + head * 128 + m * 64, 512,
                           Kd + (size_t)krow0 * 512 + head * 128 + m * 64, 512, Vd + (size_t)krow0 * 512 + head * 128, 512, Tk, n_a, c, smem, o);
        if (m == 0) {
#pragma unroll
          for (int dt = 0; dt < 4; ++dt)
#pragma unroll
            for (int rq = 0; rq < 4; ++rq) *(f32x4*)(otmp + tid * 64 + dt * 16 + rq * 4) = (f32x4){o[dt][4 * rq], o[dt][4 * rq + 1], o[dt][4 * rq + 2], o[dt][4 * rq + 3]};
        }
      }
      float ss = 0.f;
#pragma unroll
      for (int dt = 0; dt < 4; ++dt)
#pragma unroll
        for (int rq = 0; rq < 4; ++rq) {
          const f32x4 o0 = *(const f32x4*)(otmp + tid * 64 + dt * 16 + rq * 4);
#pragma unroll
          for (int e = 0; e < 4; ++e) { const float v = o0[e] - lam * o[dt][4 * rq + e]; o[dt][4 * rq + e] = v; ss += v * v; }
        }
      ss += __shfl_xor(ss, 32);
      const float sc = rsqrtf(ss * (1.f / 128.f) + EPS) * 0.8f;
      bf16_t* dst = cat + (size_t)(qrow0 + wid * 32 + ql) * 1024 + head * 128;
#pragma unroll
      for (int dt = 0; dt < 4; ++dt)
#pragma unroll
        for (int rq = 0; rq < 4; ++rq) {
          const int dv = dt * 32 + 8 * rq + 4 * h2;
          const f32x4 g = *(const f32x4*)(p.diff_norm_g + dv);
          u32x2 w = {pack2(o[dt][4 * rq] * sc * g[0], o[dt][4 * rq + 1] * sc * g[1]), pack2(o[dt][4 * rq + 2] * sc * g[2], o[dt][4 * rq + 3] * sc * g[3])};
          *(u32x2*)(dst + dv) = w;
        }
    } else {
      f32x16 o[2];
      const float c = 0.10206207261596575f * 1.4426950408889634f;
      attn_core<96, 64>(Qma + (size_t)qrow0 * 768 + head * 96, Qmb + (size_t)qrowb * 768 + head * 96, 768,
                        Km + (size_t)krow0 * 768 + head * 96, 768, Vm + (size_t)krow0 * 512 + head * 64, 512, Tk, n_a, c, smem, o);
      bf16_t* dst = cat + (size_t)(qrow0 + wid * 32 + ql) * 1024 + 512 + head * 64;
#pragma unroll
      for (int dt = 0; dt < 2; ++dt)
#pragma unroll
        for (int rq = 0; rq < 4; ++rq) {
          const int dv = dt * 32 + 8 * rq + 4 * h2;
          u32x2 w = {pack2(o[dt][4 * rq], o[dt][4 * rq + 1]), pack2(o[dt][4 * rq + 2], o[dt][4 * rq + 3])};
          *(u32x2*)(dst + dv) = w;
        }
    }
  }
}

DI void phase_conv(const Params& p, char* smem) {
  char* ws = p.ws;
  const bf16_t* Ug = (const bf16_t*)(ws + O_UG); const bf16_t* Pz = (const bf16_t*)(ws + O_PZ);
  bf16_t* cat = (bf16_t*)(ws + O_HB);
  const int tid = threadIdx.x, lane = tid & 63, half = tid >> 8, ht = tid & 255, hw4 = (tid >> 6) & 3;
  float* tile = (float*)smem + half * 8192;
  for (int up = blockIdx.x; up < NTOK / 32; up += gridDim.x) {
    const int t0 = (up * 2 + half) * 16;
    const int s0 = t0 < NCTX ? (t0 & ~255) : NCTX + ((t0 - NCTX) & ~(TLAT - 1));
    const int s1 = t0 < NCTX ? s0 + 256 : s0 + TLAT;
    {
      const int ch = ht * 2;
      float a0[16], a1[16];
#pragma unroll
      for (int o = 0; o < 16; ++o) { a0[o] = 0.f; a1[o] = 0.f; }
      f32x2 w[31];
#pragma unroll
      for (int j = 0; j < 31; ++j) w[j] = *(const f32x2*)(p.conv_w + j * 512 + ch);
#pragma unroll
      for (int i = 0; i < 46; ++i) {
        const int r = t0 - 15 + i;
        float u0 = 0.f, u1 = 0.f;
        if (r >= s0 && r < s1) { const unsigned v = *(const unsigned*)(Ug + (size_t)r * 512 + ch); u0 = bflo(v); u1 = bfhi(v); }
#pragma unroll
        for (int o = 0; o < 16; ++o) {
          const int j = i - o;
          if (j >= 0 && j <= 30) { a0[o] += u0 * w[j][0]; a1[o] += u1 * w[j][1]; }
        }
      }
      const f32x2 bias = *(const f32x2*)(p.conv_b + ch);
#pragma unroll
      for (int o = 0; o < 16; ++o) *(f32x2*)(tile + o * 512 + ch) = (f32x2){a0[o] + bias[0], a1[o] + bias[1]};
    }
    __syncthreads();
#pragma unroll 1
    for (int k = 0; k < 4; ++k) {
      const int o = hw4 * 4 + k, row = t0 + o;
      const f32x4 v0 = *(const f32x4*)(tile + o * 512 + lane * 4), v1 = *(const f32x4*)(tile + o * 512 + 256 + lane * 4);
      const float mean = wave_sum((v0[0] + v0[1]) + (v0[2] + v0[3]) + (v1[0] + v1[1]) + (v1[2] + v1[3])) * (1.f / 512.f);
      float q = 0.f;
#pragma unroll
      for (int e = 0; e < 4; ++e) { const float d0 = v0[e] - mean, d1 = v1[e] - mean; q += d0 * d0 + d1 * d1; }
      const float rstd = rsqrtf(wave_sum(q) * (1.f / 512.f) + EPS);
#pragma unroll
      for (int hlf = 0; hlf < 2; ++hlf) {
        const int col = hlf * 256 + lane * 4;
        const f32x4 v = hlf ? v1 : v0;
        const f32x4 g = *(const f32x4*)(p.conv_norm_g + col), bb = *(const f32x4*)(p.conv_norm_b + col);
        float y[4];
#pragma unroll
        for (int e = 0; e < 4; ++e) { const float z = (v[e] - mean) * rstd * g[e] + bb[e]; y[e] = z / (1.f + __expf(-z)); }
        *(u32x2*)(cat + (size_t)row * 1024 + col) = (u32x2){pack2(y[0], y[1]), pack2(y[2], y[3])};
      }
    }
    {
      const int ch = ht * 2, hw = 1 << hw4;
#pragma unroll 1
      for (int o = 0; o < 16; ++o) {
        const int r = t0 + o;
        const int lo = max(r - hw, s0), hi = min(r + hw - 1, s1 - 1);
        float a0 = 0.f, a1 = 0.f;
        for (int q = lo; q <= hi; ++q) { const unsigned v = *(const unsigned*)(Pz + (size_t)q * 512 + ch); a0 += bflo(v); a1 += bfhi(v); }
        const unsigned vc = *(const unsigned*)(Pz + (size_t)r * 512 + ch);
        const float ic = 1.f / (float)(hi - lo + 1);
        *(unsigned*)(cat + (size_t)r * 1024 + 512 + ch) = pack2(a0 * ic - bflo(vc), a1 * ic - bfhi(vc));
      }
    }
    __syncthreads();
  }
}

__global__ void __launch_bounds__(NT, 2) fwd_kernel(Params p, int ph_lo, int ph_hi) {
  __shared__ __attribute__((aligned(16))) char smem[2 * G_STAGE];
  __shared__ uint4 xb_words;
  cg::grid_group grid = cg::this_grid();
  char* ws = p.ws;
  if (threadIdx.x == 0) xb_words = make_uint4(0u, 0u, 0u, 0u);
  __syncthreads();
  const XcdBarrier xb = xcd_barrier_post((unsigned*)(ws + O_BAR), (volatile LDS_AS unsigned*)&xb_words);
  if (ph_lo > 1000) grid.sync();
  float* mods = (float*)(ws + O_MODS);
  bf16_t* Hb = (bf16_t*)(ws + O_HB);
  float* X = p.out;
  float* xbuf = (float*)(ws + O_XBUF);
  unsigned* lncnt = (unsigned*)(ws + O_LNCNT);
  const bool fused = (gridDim.x == 256);
#define GSYNC() xcd_barrier(xb)
#define PH_BEGIN(n) if (ph_lo <= n && n < ph_hi) { if (n > ph_lo) GSYNC();
#define PH_BEGIN_IF(n, c) if (ph_lo <= n && n < ph_hi && (c)) { if (n > ph_lo) GSYNC();
#define PH_END }
#ifndef PROBE_DUP
#define PROBE_DUP 0
#endif
#ifndef PROBE_SYNCS
#define PROBE_SYNCS 0
#endif
#define DUP(n, ...) __VA_ARGS__; if ((PROBE_DUP >> n) & 1) { GSYNC(); __VA_ARGS__; }
  for (int i = 0; i < PROBE_SYNCS; ++i) GSYNC();
  PH_BEGIN(0) { DUP(0, phase0(p, smem)); } PH_END
  PH_BEGIN(1) { DUP(1, rows_phase(p.x_prompt, p.x_sample, false, nullptr, nullptr, nullptr, mods, 0, 1024, Hb)); } PH_END
  PH_BEGIN(2) {
    float* o_k = p.out + (size_t)NTOK * 1024; float* o_v = o_k + (size_t)NCTX * 512; float* o_ckv = o_v + (size_t)NCTX * 512; float* o_kr = o_ckv + (size_t)NCTX * 128;
    DUP(2, gemm_phase(Hb, 1024, (const bf16_t*)(ws + O_WATTIN), 1024, 1024, 64, 8,
                      EpiAttIn{(bf16_t*)(ws + O_QDA), (bf16_t*)(ws + O_QDB), (bf16_t*)(ws + O_KD), (bf16_t*)(ws + O_VD), (bf16_t*)(ws + O_CQN), (bf16_t*)(ws + O_CKVN), (bf16_t*)(ws + O_KMLA),
                               o_k, o_v, o_ckv, o_kr, (const float*)(ws + O_C16), (const float*)(ws + O_S16), (const float*)(ws + O_C8), (const float*)(ws + O_S8), p.q_norm_g, p.kv_norm_g, smem}, smem));
  } PH_END
  PH_BEGIN(4) {
        const int n1 = 64 * 3, n2 = 67 * 4;
        gemm_phase((const bf16_t*)(ws + O_CQN), 256, (const bf16_t*)(ws + O_WUQ), 256, 256, 64, 3,
                   EpiUq{(bf16_t*)(ws + O_QMA), (bf16_t*)(ws + O_QMB), (const float*)(ws + O_C8), (const float*)(ws + O_S8)}, smem, 0, n1 + n2);
        gemm_phase((const bf16_t*)(ws + O_CKVN), 128, (const bf16_t*)(ws + O_WUKV), 128, 128, 67, 4,
                   EpiUkv{(bf16_t*)(ws + O_KMLA), (bf16_t*)(ws + O_VMLA)}, smem, n1, n1 + n2);
  } PH_END
  PH_BEGIN(5) { phase_attn(p, smem, 0); if ((PROBE_DUP >> 5) & 1) { GSYNC(); phase_attn(p, smem, 1); } } PH_END
  PH_BEGIN(6) { gemm_phase(Hb, 1024, (const bf16_t*)(ws + O_WATTOUT), 1024, 1024, 64, 4, EpiResLN{p.x_prompt, p.x_sample, mods + 2048, X, p.ln_mix_g, p.ln_mix_b, mods, 3072, 4096, Hb, xbuf, lncnt, smem, fused}, smem); } PH_END
  PH_BEGIN_IF(7, !fused) { rows_phase(X, X + (size_t)NCTX * 1024, true, p.ln_mix_g, p.ln_mix_b, X, mods, 3072, 4096, Hb); } PH_END
  PH_BEGIN(8) { DUP(8, gemm_phase(Hb, 1024, (const bf16_t*)(ws + O_WMLPIN), 1024, 1024, 64, 16, EpiRelu2{(bf16_t*)(ws + O_U)}, smem)); } PH_END
  PH_BEGIN(9) { gemm_phase((const bf16_t*)(ws + O_U), 4096, (const bf16_t*)(ws + O_WMLPOUT), 4096, 4096, 64, 4, EpiResLN{X, X + (size_t)NCTX * 1024, mods + 5120, X, p.ln_mlp_g, p.ln_mlp_b, mods + 3 * 6144, 0, 1024, Hb, xbuf + 98304, lncnt + 64, smem, fused}, smem); } PH_END
  PH_BEGIN_IF(10, !fused) { rows_phase(X, X + (size_t)NCTX * 1024, true, p.ln_mlp_g, p.ln_mlp_b, X, mods + 3 * 6144, 0, 1024, Hb); } PH_END
  PH_BEGIN(11) { DUP(11, gemm_phase(Hb, 1024, (const bf16_t*)(ws + O_WCONVIN), 1024, 1024, 64, 6, EpiConv{(bf16_t*)(ws + O_UG), (bf16_t*)(ws + O_PZ)}, smem)); } PH_END
  PH_BEGIN(12) { DUP(12, phase_conv(p, smem)); } PH_END
  PH_BEGIN(13) { gemm_phase(Hb, 1024, (const bf16_t*)(ws + O_WCONVOUT), 1024, 1024, 64, 4, EpiResLN{X, X + (size_t)NCTX * 1024, mods + 3 * 6144 + 2048, X, p.ln_mix_g + 1024, p.ln_mix_b + 1024, mods + 3 * 6144, 3072, 4096, Hb, xbuf + 2 * 98304, lncnt + 128, smem, fused}, smem); } PH_END
  PH_BEGIN_IF(14, !fused) { rows_phase(X, X + (size_t)NCTX * 1024, true, p.ln_mix_g + 1024, p.ln_mix_b + 1024, X, mods + 3 * 6144, 3072, 4096, Hb); } PH_END
  PH_BEGIN(15) { DUP(15, gemm_phase(Hb, 1024, (const bf16_t*)(ws + O_WMLPIN) + (size_t)4096 * 1024, 1024, 1024, 64, 16, EpiRelu2{(bf16_t*)(ws + O_U)}, smem)); } PH_END
  PH_BEGIN(16) { gemm_phase((const bf16_t*)(ws + O_U), 4096, (const bf16_t*)(ws + O_WMLPOUT) + (size_t)4096 * 1024, 4096, 4096, 64, 4, EpiResLN{X, X + (size_t)NCTX * 1024, mods + 3 * 6144 + 5120, X, p.ln_mlp_g + 1024, p.ln_mlp_b + 1024, mods, 0, 0, nullptr, xbuf + 3 * 98304, lncnt + 192, smem, fused}, smem); } PH_END
  PH_BEGIN_IF(17, !fused) { rows_phase(X, X + (size_t)NCTX * 1024, true, p.ln_mlp_g + 1024, p.ln_mlp_b + 1024, X, nullptr, 0, 0, nullptr); } PH_END
}

extern "C" void kernel_launch(void* const* d_in, const int* in_sizes, int n_in, void* d_out, int out_size, void* d_ws, size_t ws_size, hipStream_t stream) {
  static int grid_blocks = 0;
  if (!grid_blocks) {
    int dev = 0, cus = 0, per_cu = 0;
    hipGetDevice(&dev);
    hipDeviceGetAttribute(&cus, hipDeviceAttributeMultiprocessorCount, dev);
    hipOccupancyMaxActiveBlocksPerMultiprocessor(&per_cu, fwd_kernel, NT, 0);
    if (per_cu > 1) per_cu = 1;
    if (per_cu < 1) per_cu = 1;
    grid_blocks = cus * per_cu;
    if (grid_blocks > 256) grid_blocks = 256;
  }
  if (ws_size < WS_NEED) { fprintf(stderr, "workspace too small: %zu < %zu\n", ws_size, (size_t)WS_NEED); return; }
  Params p{};
  const float** f = (const float**)&p;
  for (int i = 0; i < 35; ++i) f[i] = (const float*)d_in[i];
  p.out = (float*)d_out;
  p.ws = (char*)d_ws;
  hipMemsetAsync(d_ws, 0, 16384, stream);
  int lo = 0, hi = NPHASE;
  void* args[] = {&p, &lo, &hi};
  hipError_t e = hipLaunchCooperativeKernel((void*)fwd_kernel, dim3(grid_blocks), dim3(NT), args, 0, stream);
  if (e != hipSuccess) fprintf(stderr, "cooperative launch failed: %s (grid %d)\n", hipGetErrorString(e), grid_blocks);
}
```

```cpp
#include <hip/hip_runtime.h>
#include <hip/hip_cooperative_groups.h>
#include <cstdio>
#include <cstdint>
namespace cg = cooperative_groups;

typedef unsigned short bf16_t;
typedef short bf16x8 __attribute__((ext_vector_type(8)));
typedef short s16x4 __attribute__((ext_vector_type(4)));
typedef float f32x4 __attribute__((ext_vector_type(4)));
typedef float f32x2 __attribute__((ext_vector_type(2)));
typedef float f32x16 __attribute__((ext_vector_type(16)));
typedef unsigned u32x4 __attribute__((ext_vector_type(4)));
typedef unsigned u32x2 __attribute__((ext_vector_type(2)));
typedef __bf16 bf16v2 __attribute__((ext_vector_type(2)));
#define DI __device__ __forceinline__
#define LDS_AS __attribute__((address_space(3)))

constexpr int NTOK = 12288, NCTX = 4096, NKEY = 12800, TLAT = 4096, TKL = 4352;
constexpr int RLD = 1952;
constexpr float ALPHA = 1.41421356237f, EPS = 1e-5f;
constexpr int NPHASE = 18;
constexpr int NT = 512, NWAVE = 8;

constexpr size_t al(size_t x) { return (x + 255) & ~(size_t)255; }
constexpr size_t O_CNT = 0;
constexpr size_t O_BAR = 256;
constexpr size_t O_LNCNT = 14336;
constexpr size_t O_MODS = 16384;
constexpr size_t O_SCAL = O_MODS + al(2 * 3 * 6144 * 4);
constexpr size_t O_C16 = O_SCAL + 256;
constexpr size_t O_S16 = O_C16 + 4096;
constexpr size_t O_C8 = O_S16 + 4096;
constexpr size_t O_S8 = O_C8 + 2048;
constexpr size_t O_XBUF = O_S8 + 2048;
constexpr size_t O_WATTIN = O_XBUF + (size_t)4 * 256 * 192 * 2 * 4;
constexpr size_t O_WUQ = O_WATTIN + (size_t)2048 * 1024 * 2;
constexpr size_t O_WUKV = O_WUQ + (size_t)768 * 256 * 2;
constexpr size_t O_WATTOUT = O_WUKV + (size_t)1024 * 128 * 2;
constexpr size_t O_WMLPIN = O_WATTOUT + (size_t)1024 * 1024 * 2;
constexpr size_t O_WMLPOUT = O_WMLPIN + (size_t)2 * 4096 * 1024 * 2;
constexpr size_t O_WCONVIN = O_WMLPOUT + (size_t)2 * 4096 * 1024 * 2;
constexpr size_t O_WCONVOUT = O_WCONVIN + (size_t)1536 * 1024 * 2;
constexpr size_t O_HB = O_WCONVOUT + (size_t)1024 * 1024 * 2;
constexpr size_t O_BIG = O_HB + (size_t)NTOK * 1024 * 2;
constexpr size_t O_R = O_BIG;
constexpr size_t O_QMA = O_R;
constexpr size_t O_QMB = O_QMA + (size_t)NTOK * 768 * 2;
constexpr size_t O_QDA = O_R + al((size_t)NTOK * RLD * 2);
constexpr size_t O_QDB = O_QDA + (size_t)NTOK * 512 * 2;
constexpr size_t O_KD = O_QDB + (size_t)8192 * 512 * 2;
constexpr size_t O_VD = O_KD + (size_t)NKEY * 512 * 2;
constexpr size_t O_CQN = O_VD + (size_t)NKEY * 512 * 2;
constexpr size_t O_CKVN = O_CQN + (size_t)NTOK * 256 * 2;
constexpr size_t O_KMLA = O_CKVN + (size_t)NKEY * 128 * 2;
constexpr size_t O_VMLA = O_KMLA + (size_t)NKEY * 768 * 2;
constexpr size_t O_OTMP = O_VMLA + (size_t)NKEY * 512 * 2;
constexpr size_t O_ATT_END = O_OTMP + (size_t)512 * 16384 * 4;
constexpr size_t O_U = O_BIG;
constexpr size_t O_U_END = O_U + (size_t)NTOK * 4096 * 2;
constexpr size_t O_UG = O_BIG;
constexpr size_t O_PZ = O_UG + (size_t)NTOK * 512 * 2;
constexpr size_t WS_NEED = (O_ATT_END > O_U_END ? O_ATT_END : O_U_END);
static_assert(O_QMB + (size_t)8192 * 768 * 2 <= O_QDA, "Qm overlay must fit in R");
static_assert(WS_NEED <= (size_t)256 * 1024 * 1024, "workspace too large");

struct Params {
  const float *x_prompt, *x_sample, *cache_k, *cache_v, *cache_ckv, *cache_krope, *c, *c_ctx;
  const float *w_ada, *b_ada, *ln_mix_g, *ln_mix_b, *ln_mlp_g, *ln_mlp_b, *w_mlp_in, *w_mlp_out;
  const float *w_att_in, *w_uq, *w_ukv, *q_norm_g, *kv_norm_g, *lam_q1, *lam_k1, *lam_q2, *lam_k2, *diff_norm_g, *w_att_out;
  const float *w_conv_in, *conv_w, *conv_b, *conv_norm_g, *conv_norm_b, *w_pool, *pool_scale, *w_conv_out;
  float* out;
  char* ws;
};

DI unsigned pack2(float lo, float hi) { f32x2 v = {lo, hi}; bf16v2 b = __builtin_convertvector(v, bf16v2); return __builtin_bit_cast(unsigned, b); }
DI float bf2f(unsigned short u) { return __uint_as_float((unsigned)u << 16); }
DI float bflo(unsigned u) { return __uint_as_float(u << 16); }
DI float bfhi(unsigned u) { return __uint_as_float(u & 0xffff0000u); }
DI float wave_sum(float v) {
#pragma unroll
  for (int o = 32; o >= 1; o >>= 1) v += __shfl_xor(v, o);
  return v;
}
DI void lds_barrier() { asm volatile("s_waitcnt lgkmcnt(0)\n\ts_barrier" ::: "memory"); }
DI void dma16(const void* gsrc, unsigned lds_dst) {
  unsigned keep;
  asm volatile("s_mov_b32 %0, m0\n\ts_mov_b32 m0, %2\n\ts_nop 0\n\tglobal_load_lds_dwordx4 %1, off\n\ts_mov_b32 m0, %0" : "=&s"(keep) : "v"(gsrc), "s"(lds_dst) : "memory");
}
DI int cond_idx(int row) { return row < NCTX ? 0 : 1 + ((row - NCTX) >> 12); }


#define XB_TMO      128
#define XB_XCNT(j)  (256  + 64 * (j))
#define XB_XSUB(j)  (1280 + 64 * (j))
#define XB_XGEN(j)  (2304 + 64 * (j))
#define XB_TOP      3328
#define XB_TOPGEN   3392
#define XCD_BAR_WORDS 3456
#define XB_SPIN_CAP (1u << 18)
DI unsigned xb_ld(unsigned* p)              { return __hip_atomic_load(p, __ATOMIC_RELAXED, __HIP_MEMORY_SCOPE_AGENT); }
DI unsigned xb_add(unsigned* p, unsigned v) { return __hip_atomic_fetch_add(p, v, __ATOMIC_RELAXED, __HIP_MEMORY_SCOPE_AGENT); }
DI unsigned xb_xcc_id() { return (unsigned)__builtin_amdgcn_s_getreg((3 << 11) | 20) & 0xFu; }
#define XB_SPIN(cond, bar) do { unsigned _sp = 0; while (cond) { __builtin_amdgcn_s_sleep(1); \
    if ((++_sp & 255u) == 0u) { if (xb_ld(&(bar)[XB_TMO])) break; if (_sp > XB_SPIN_CAP) { atomicAdd(&(bar)[XB_TMO], 1u); break; } } } } while (0)
struct XcdBarrier { unsigned* bar; unsigned x; volatile LDS_AS unsigned* st; };
DI XcdBarrier xcd_barrier_post(unsigned* bar, volatile LDS_AS unsigned* st) {
  XcdBarrier b; b.bar = bar; b.x = xb_xcc_id(); b.st = st;
  if (threadIdx.x == 0) (void)xb_add(&bar[XB_XCNT(b.x)], 1u);
  return b;
}
DI void xcd_barrier_complete(unsigned* bar, unsigned x, unsigned& nloc, unsigned& nx) {
  const unsigned G = gridDim.x * gridDim.y * gridDim.z;
  unsigned sum, cnt, mine, sp = 0u;
  for (;;) {
    sum = 0u; cnt = 0u; mine = 0u;
#pragma unroll
    for (unsigned j = 0; j < 16; ++j) { const unsigned c = xb_ld(&bar[XB_XCNT(j)]); sum += c; cnt += (c > 0u) ? 1u : 0u; mine = (j == x) ? c : mine; }
    if (sum == G) break;
    __builtin_amdgcn_s_sleep(1);
    if ((++sp & 255u) == 0u) { if (xb_ld(&bar[XB_TMO])) break; if (sp > XB_SPIN_CAP) { atomicAdd(&bar[XB_TMO], 1u); break; } }
  }
  nloc = mine > 0u ? mine : 1u; nx = cnt > 0u ? cnt : 1u;
}
DI void xcd_barrier(const XcdBarrier& b) {
  asm volatile("s_waitcnt vmcnt(0)" ::: "memory");
  __syncthreads();
  if (threadIdx.x == 0) {
    unsigned* bar = b.bar;
    __builtin_amdgcn_s_waitcnt(0);
    unsigned nloc = b.st[0], nx = b.st[1];
    if (nloc == 0u) { xcd_barrier_complete(bar, b.x, nloc, nx); b.st[0] = nloc; b.st[1] = nx; }
    const unsigned old = xb_add(&bar[XB_XSUB(b.x)], 1u);
    const unsigned gen = old / nloc;
    if (old + 1u == (gen + 1u) * nloc) {
      __builtin_amdgcn_fence(__ATOMIC_RELEASE, "agent");
      asm volatile("s_waitcnt vmcnt(0)" ::: "memory");
      const unsigned og = xb_add(&bar[XB_TOP], 1u);
      const unsigned tg = og / nx;
      if (og + 1u == (tg + 1u) * nx) xb_add(&bar[XB_TOPGEN], 1u);
      else XB_SPIN(xb_ld(&bar[XB_TOPGEN]) == tg, bar);
      __builtin_amdgcn_fence(__ATOMIC_ACQUIRE, "agent");
      xb_add(&bar[XB_XGEN(b.x)], 1u);
      asm volatile("s_waitcnt vmcnt(0)" ::: "memory");
    } else {
      XB_SPIN(xb_ld(&bar[XB_XGEN(b.x)]) == gen, bar);
      __builtin_amdgcn_fence(__ATOMIC_ACQUIRE, "agent");
      asm volatile("s_waitcnt vmcnt(0)" ::: "memory");
    }
  }
  __syncthreads();
}

DI int swz(int row, int kc) { return row * 128 + ((kc ^ ((row >> 1) & 7)) << 4); }

constexpr int G_BM = 192, G_BN = 256, G_MI = 6, G_NJ = 4, G_ABYTES = G_BM * 128, G_STAGE = G_ABYTES + G_BN * 128;
template <class Epi>
DI void gemm_tile(const bf16_t* __restrict__ A, int lda, const bf16_t* __restrict__ Bt, int ldb, int K, int row0, int col0, char* smem, const Epi& epi) {
  const int tid = threadIdx.x, lane = tid & 63, wid = tid >> 6, wr = wid >> 2, wc = wid & 3;
  const int fr = lane & 15, fq = lane >> 4;
  f32x4 acc[G_MI][G_NJ];
#pragma unroll
  for (int i = 0; i < G_MI; ++i)
#pragma unroll
    for (int j = 0; j < G_NJ; ++j) acc[i][j] = (f32x4){0.f, 0.f, 0.f, 0.f};
  const int srow = tid >> 3, skc = tid & 7;
  const int schunk = skc ^ ((srow >> 1) & 7);
  const bf16_t* ga = A + (size_t)(row0 + srow) * lda + schunk * 8;
  const bf16_t* gb = Bt + (size_t)(col0 + srow) * ldb + schunk * 8;
  const int nk = K >> 6;
  const unsigned lds0 = __builtin_amdgcn_readfirstlane((unsigned)(size_t)(LDS_AS char*)smem + (unsigned)(tid & ~63) * 16u);
#define G_DMA(stage_off_, kt_) do { const int k0_ = (kt_) << 6; const unsigned sb_ = lds0 + (unsigned)(stage_off_); \
    _Pragma("unroll") for (int i = 0; i < 3; ++i) dma16(ga + (size_t)(64 * i) * lda + k0_, sb_ + i * 8192); \
    _Pragma("unroll") for (int i = 0; i < 4; ++i) dma16(gb + (size_t)(64 * i) * ldb + k0_, sb_ + G_ABYTES + i * 8192); } while (0)
#define G_COMPUTE(buf_) do { const char* cur = (buf_); \
    _Pragma("unroll") for (int s = 0; s < 2; ++s) { \
      bf16x8 af[G_MI], bfr[G_NJ]; \
      _Pragma("unroll") for (int i = 0; i < G_MI; ++i) af[i] = *(const bf16x8*)(cur + swz(wr * 96 + i * 16 + fr, s * 4 + fq)); \
      _Pragma("unroll") for (int j = 0; j < G_NJ; ++j) bfr[j] = *(const bf16x8*)(cur + G_ABYTES + swz(wc * 64 + j * 16 + fr, s * 4 + fq)); \
      __builtin_amdgcn_s_setprio(1); \
      _Pragma("unroll") for (int i = 0; i < G_MI; ++i) \
        _Pragma("unroll") for (int j = 0; j < G_NJ; ++j) acc[i][j] = __builtin_amdgcn_mfma_f32_16x16x32_bf16(bfr[j], af[i], acc[i][j], 0, 0, 0); \
      __builtin_amdgcn_s_setprio(0); \
    } } while (0)
  G_DMA(0, 0);
  asm volatile("s_waitcnt vmcnt(0)" ::: "memory");
  lds_barrier();
  for (int kt = 0; kt < nk; kt += 2) {
    G_DMA(G_STAGE, kt + 1);
    G_COMPUTE(smem);
    asm volatile("s_waitcnt vmcnt(0)" ::: "memory");
    lds_barrier();
    G_DMA(0, min(kt + 2, nk - 1));
    G_COMPUTE(smem + G_STAGE);
    asm volatile("s_waitcnt vmcnt(0)" ::: "memory");
    lds_barrier();
  }
#undef G_DMA
#undef G_COMPUTE
  epi(acc, row0 + wr * 96, col0 + wc * 64, lane);
}


struct EpiRaw {
  bf16_t* R;
  DI void operator()(f32x4 (&acc)[G_MI][G_NJ], int rbase, int cbase, int lane) const {
    const int fr = lane & 15, fq = lane >> 4;
#pragma unroll
    for (int i = 0; i < G_MI; ++i)
#pragma unroll
      for (int j = 0; j < G_NJ; ++j) {
        const int row = rbase + i * 16 + fr, col = cbase + j * 16 + fq * 4;
        if (col < RLD) { u32x2 w = {pack2(acc[i][j][0], acc[i][j][1]), pack2(acc[i][j][2], acc[i][j][3])}; *(u32x2*)(R + (size_t)row * RLD + col) = w; }
      }
  }
};


struct EpiAttIn {
  bf16_t *Qda, *Qdb, *Kd, *Vd, *cqn, *ckvn, *Km; float *o_k, *o_v, *o_ckv, *o_kr;
  const float *c16, *s16, *c8, *s8, *qg, *kvg; char* smem;
  DI void operator()(f32x4 (&acc)[G_MI][G_NJ], int rbase, int cbase, int lane) const {
    const int tid = threadIdx.x, wid = tid >> 6, wr = wid >> 2, wc = wid & 3, fr = lane & 15, fq = lane >> 4;
    const int tile = (cbase - wc * 64) >> 8;
    float* part = (float*)smem;
    if (tile < 6) {
      const int which = tile >> 1, c0 = cbase & 511;
#pragma unroll
      for (int i = 0; i < G_MI; ++i) {
        const int rowf = rbase + i * 16, row = rowf + fr;
        const bool lat = rowf >= NCTX;
        const int rl = row - NCTX, b = rl >> 12, t = rl & (TLAT - 1), prow = t >> 6, pcol = t & 63;
        const size_t kr = lat ? (size_t)NCTX + (size_t)b * TKL + 256 + t : (size_t)row;
        u32x2 raw[G_NJ], rot[G_NJ];
#pragma unroll
        for (int j = 0; j < G_NJ; ++j) raw[j] = (u32x2){pack2(acc[i][j][0], acc[i][j][1]), pack2(acc[i][j][2], acc[i][j][3])};
        if (lat && which < 2) {
#pragma unroll
          for (int jp = 0; jp < 2; ++jp) {
            const int pos = jp == 0 ? prow : pcol;
            const f32x4 cs = *(const f32x4*)(c16 + pos * 16 + fq * 4), sn = *(const f32x4*)(s16 + pos * 16 + fq * 4);
            const f32x4 x1 = acc[i][2 * jp], x2 = acc[i][2 * jp + 1];
            f32x4 o1, o2;
#pragma unroll
            for (int e = 0; e < 4; ++e) { o1[e] = x1[e] * cs[e] - x2[e] * sn[e]; o2[e] = x1[e] * sn[e] + x2[e] * cs[e]; }
            rot[2 * jp] = (u32x2){pack2(o1[0], o1[1]), pack2(o1[2], o1[3])};
            rot[2 * jp + 1] = (u32x2){pack2(o2[0], o2[1]), pack2(o2[2], o2[3])};
          }
        }
#pragma unroll
        for (int j = 0; j < G_NJ; ++j) {
          const int c = c0 + j * 16 + fq * 4;
          if (which == 0) {
            *(u32x2*)(Qda + (size_t)row * 512 + c) = raw[j];
            if (lat) *(u32x2*)(Qdb + (size_t)rl * 512 + c) = rot[j];
          } else if (which == 1) {
            if (lat) *(u32x2*)(Kd + kr * 512 + c) = rot[j];
            else { *(u32x2*)(Kd + kr * 512 + c) = raw[j]; *(f32x4*)(o_k + (size_t)row * 512 + c) = acc[i][j]; }
          } else {
            *(u32x2*)(Vd + kr * 512 + c) = raw[j];
            if (!lat) *(f32x4*)(o_v + (size_t)row * 512 + c) = acc[i][j];
          }
        }
      }
      return;
    }
    const bool norm_wave = (tile == 6) || (wc < 2);
#pragma unroll
    for (int i = 0; i < G_MI; ++i) {
      float ss = 0.f;
#pragma unroll
      for (int j = 0; j < G_NJ; ++j)
#pragma unroll
        for (int e = 0; e < 4; ++e) ss += acc[i][j][e] * acc[i][j][e];
      ss += __shfl_xor(ss, 16); ss += __shfl_xor(ss, 32);
      if (fq == 0) part[(wr * 96 + i * 16 + fr) * 4 + wc] = ss;
    }
    __syncthreads();
#pragma unroll
    for (int i = 0; i < G_MI; ++i) {
      const int rowf = rbase + i * 16, row = rowf + fr;
      const bool lat = rowf >= NCTX;
      const int rl = row - NCTX, b = rl >> 12, t = rl & (TLAT - 1), prow = t >> 6, pcol = t & 63;
      const size_t kr = lat ? (size_t)NCTX + (size_t)b * TKL + 256 + t : (size_t)row;
      const f32x4 pr = *(const f32x4*)(part + (wr * 96 + i * 16 + fr) * 4);
      if (tile == 6) {
        const float sc = rsqrtf(((pr[0] + pr[1]) + (pr[2] + pr[3])) * (1.f / 256.f) + EPS);
#pragma unroll
        for (int j = 0; j < G_NJ; ++j) {
          const int c = wc * 64 + j * 16 + fq * 4;
          const f32x4 g = *(const f32x4*)(qg + c);
          *(u32x2*)(cqn + (size_t)row * 256 + c) = (u32x2){pack2(acc[i][j][0] * sc * g[0], acc[i][j][1] * sc * g[1]), pack2(acc[i][j][2] * sc * g[2], acc[i][j][3] * sc * g[3])};
        }
      } else if (norm_wave) {
        const float sc = rsqrtf((pr[0] + pr[1]) * (1.f / 128.f) + EPS);
#pragma unroll
        for (int j = 0; j < G_NJ; ++j) {
          const int c = wc * 64 + j * 16 + fq * 4;
          const f32x4 g = *(const f32x4*)(kvg + c);
          f32x4 y;
#pragma unroll
          for (int e = 0; e < 4; ++e) y[e] = acc[i][j][e] * sc * g[e];
          if (!lat) *(f32x4*)(o_ckv + (size_t)row * 128 + c) = y;
          *(u32x2*)(ckvn + kr * 128 + c) = (u32x2){pack2(y[0], y[1]), pack2(y[2], y[3])};
        }
      } else if (wc == 2) {
#pragma unroll
        for (int j = 0; j < 2; ++j) {
          f32x4 v = acc[i][j];
          if (lat) {
            const int pos = j == 0 ? prow : pcol;
            f32x4 o;
#pragma unroll
            for (int e = 0; e < 4; ++e) {
              const float pv = __shfl_xor(v[e], 32);
              const int f = (fq & 1) * 4 + e;
              const float cs = c8[pos * 8 + f], sn = s8[pos * 8 + f];
              o[e] = (fq < 2) ? (v[e] * cs - pv * sn) : (pv * sn + v[e] * cs);
            }
            v = o;
          } else *(f32x4*)(o_kr + (size_t)row * 32 + j * 16 + fq * 4) = v;
          const u32x2 w = {pack2(v[0], v[1]), pack2(v[2], v[3])};
#pragma unroll
          for (int hh = 0; hh < 8; ++hh) *(u32x2*)(Km + kr * 768 + hh * 96 + 64 + j * 16 + fq * 4) = w;
        }
      }
    }
    __syncthreads();
  }
};

struct EpiUq {
  bf16_t *Qa, *Qb; const float *c8, *s8;
  DI void operator()(f32x4 (&acc)[G_MI][G_NJ], int rbase, int cbase, int lane) const {
    const int fr = lane & 15, fq = lane >> 4;
#pragma unroll
    for (int i = 0; i < G_MI; ++i) {
      const bool lat = (rbase + i * 16) >= NCTX;
      const int row = rbase + i * 16 + fr;
      const int t = (row - NCTX) & (TLAT - 1);
#pragma unroll
      for (int j = 0; j < G_NJ; ++j) {
        const int cf = cbase + j * 16, col = cf + fq * 4;
        f32x4 v = acc[i][j];
        u32x2 w = {pack2(v[0], v[1]), pack2(v[2], v[3])};
        *(u32x2*)(Qa + (size_t)row * 768 + col) = w;
        if (lat) {
          const int w96 = cf % 96;
          if (w96 >= 64) {
            const int pos = (w96 == 64) ? (t >> 6) : (t & 63);
            f32x4 o;
#pragma unroll
            for (int e = 0; e < 4; ++e) {
              const float pv = __shfl_xor(v[e], 32);
              const int f = (fq & 1) * 4 + e;
              const float cs = c8[pos * 8 + f], sn = s8[pos * 8 + f];
              o[e] = (fq < 2) ? (v[e] * cs - pv * sn) : (pv * sn + v[e] * cs);
            }
            w = (u32x2){pack2(o[0], o[1]), pack2(o[2], o[3])};
          }
          *(u32x2*)(Qb + (size_t)(row - NCTX) * 768 + col) = w;
        }
      }
    }
  }
};

struct EpiUkv {
  bf16_t *Km, *Vm;
  DI void operator()(f32x4 (&acc)[G_MI][G_NJ], int rbase, int cbase, int lane) const {
    const int fr = lane & 15, fq = lane >> 4;
    const int h = cbase >> 7, part = (cbase >> 6) & 1;
#pragma unroll
    for (int i = 0; i < G_MI; ++i) {
      if (rbase + i * 16 >= NKEY) continue;
#pragma unroll
      for (int j = 0; j < G_NJ; ++j) {
        const int row = rbase + i * 16 + fr, c = j * 16 + fq * 4;
        u32x2 w = {pack2(acc[i][j][0], acc[i][j][1]), pack2(acc[i][j][2], acc[i][j][3])};
        if (part == 0) *(u32x2*)(Km + (size_t)row * 768 + h * 96 + c) = w;
        else *(u32x2*)(Vm + (size_t)row * 512 + h * 64 + c) = w;
      }
    }
  }
};

struct EpiRes {
  const float *xin_ctx, *xin_lat, *gate  ; float* X;
  DI void operator()(f32x4 (&acc)[G_MI][G_NJ], int rbase, int cbase, int lane) const {
    const int fr = lane & 15, fq = lane >> 4;
#pragma unroll
    for (int i = 0; i < G_MI; ++i) {
      const int row = rbase + i * 16 + fr;
      const float* g = gate + cond_idx(rbase + i * 16) * 6144;
      const float* xin = row < NCTX ? xin_ctx + (size_t)row * 1024 : xin_lat + (size_t)(row - NCTX) * 1024;
#pragma unroll
      for (int j = 0; j < G_NJ; ++j) {
        const int col = cbase + j * 16 + fq * 4;
        const f32x4 xv = *(const f32x4*)(xin + col), gv = *(const f32x4*)(g + col);
        f32x4 z;
#pragma unroll
        for (int e = 0; e < 4; ++e) z[e] = ALPHA * xv[e] + gv[e] * acc[i][j][e];
        *(f32x4*)(X + (size_t)row * 1024 + col) = z;
      }
    }
  }
};


struct EpiResLN {
  const float *xin_ctx, *xin_lat, *gate; float* X;
  const float *lg, *lb, *modsL; int sh_off, sc_off; bf16_t* Hb;
  float* xbuf; unsigned* cnt; char* smem; bool fused;
  DI void operator()(f32x4 (&acc)[G_MI][G_NJ], int rbase, int cbase, int lane) const {
    const int tid = threadIdx.x, wid = tid >> 6, wr = wid >> 2, wc = wid & 3, fr = lane & 15, fq = lane >> 4;
#pragma unroll
    for (int i = 0; i < G_MI; ++i) {
      const int row = rbase + i * 16 + fr;
      const float* g = gate + cond_idx(rbase + i * 16) * 6144;
      const float* xin = row < NCTX ? xin_ctx + (size_t)row * 1024 : xin_lat + (size_t)(row - NCTX) * 1024;
#pragma unroll
      for (int j = 0; j < G_NJ; ++j) {
        const int col = cbase + j * 16 + fq * 4;
        const f32x4 xv = *(const f32x4*)(xin + col), gv = *(const f32x4*)(g + col);
#pragma unroll
        for (int e = 0; e < 4; ++e) acc[i][j][e] = ALPHA * xv[e] + gv[e] * acc[i][j][e];
        if (!fused) *(f32x4*)(X + (size_t)row * 1024 + col) = acc[i][j];
      }
    }
    if (!fused) return;
    const int row0 = rbase - wr * 96, pm = row0 / G_BM, pn = (cbase - wc * 64) / G_BN;
    f32x2* part = (f32x2*)smem;
    f32x2* stat = (f32x2*)(smem + 8192);
#pragma unroll
    for (int i = 0; i < G_MI; ++i) {
      float s1 = 0.f, s2 = 0.f;
#pragma unroll
      for (int j = 0; j < G_NJ; ++j)
#pragma unroll
        for (int e = 0; e < 4; ++e) { const float v = acc[i][j][e]; s1 += v; s2 += v * v; }
      s1 += __shfl_xor(s1, 16); s2 += __shfl_xor(s2, 16);
      s1 += __shfl_xor(s1, 32); s2 += __shfl_xor(s2, 32);
      if (fq == 0) part[(wr * 96 + i * 16 + fr) * 4 + wc] = (f32x2){s1, s2};
    }
    __syncthreads();
    if (tid < G_BM) {
      const f32x2 a = part[tid * 4 + 0], b = part[tid * 4 + 1], c = part[tid * 4 + 2], d = part[tid * 4 + 3];
      const float s1 = (a[0] + b[0]) + (c[0] + d[0]), s2 = (a[1] + b[1]) + (c[1] + d[1]);
      const unsigned long long pk = ((unsigned long long)__float_as_uint(s2) << 32) | (unsigned long long)__float_as_uint(s1);
      __hip_atomic_store((unsigned long long*)(xbuf + ((size_t)(pm * 4 + pn) * G_BM + tid) * 2), pk, __ATOMIC_RELAXED, __HIP_MEMORY_SCOPE_AGENT);
    }
    asm volatile("s_waitcnt vmcnt(0)" ::: "memory");
    __syncthreads();
    if (tid == 0) {
      __hip_atomic_fetch_add(cnt + pm, 1u, __ATOMIC_RELAXED, __HIP_MEMORY_SCOPE_AGENT);
      unsigned sp = 0;
      while (__hip_atomic_load(cnt + pm, __ATOMIC_RELAXED, __HIP_MEMORY_SCOPE_AGENT) < 4u) { __builtin_amdgcn_s_sleep(1); if (++sp > (1u << 22)) break; }
    }
    __syncthreads();
    if (tid < G_BM) {
      float s1 = 0.f, s2 = 0.f;
#pragma unroll
      for (int q = 0; q < 4; ++q) {
        const unsigned long long pk = __hip_atomic_load((unsigned long long*)(xbuf + ((size_t)(pm * 4 + q) * G_BM + tid) * 2), __ATOMIC_RELAXED, __HIP_MEMORY_SCOPE_AGENT);
        s1 += __uint_as_float((unsigned)pk); s2 += __uint_as_float((unsigned)(pk >> 32));
      }
      const float mean = s1 * (1.f / 1024.f);
      const float var = fmaxf(s2 * (1.f / 1024.f) - mean * mean, 0.f);
      stat[tid] = (f32x2){mean, rsqrtf(var + EPS)};
    }
    __syncthreads();
#pragma unroll
    for (int i = 0; i < G_MI; ++i) {
      const int row = rbase + i * 16 + fr;
      const f32x2 ms = stat[wr * 96 + i * 16 + fr];
      const float* m = modsL + cond_idx(rbase + i * 16) * 6144;
#pragma unroll
      for (int j = 0; j < G_NJ; ++j) {
        const int col = cbase + j * 16 + fq * 4;
        const f32x4 gv = *(const f32x4*)(lg + col), bv = *(const f32x4*)(lb + col);
        f32x4 x;
#pragma unroll
        for (int e = 0; e < 4; ++e) x[e] = (acc[i][j][e] - ms[0]) * ms[1] * gv[e] + bv[e];
        *(f32x4*)(X + (size_t)row * 1024 + col) = x;
        if (Hb) {
          const f32x4 sh = *(const f32x4*)(m + sh_off + col), sc = *(const f32x4*)(m + sc_off + col);
          u32x2 w = {pack2(x[0] * (1.f + sc[0]) + sh[0], x[1] * (1.f + sc[1]) + sh[1]), pack2(x[2] * (1.f + sc[2]) + sh[2], x[3] * (1.f + sc[3]) + sh[3])};
          *(u32x2*)(Hb + (size_t)row * 1024 + col) = w;
        }
      }
    }
    __syncthreads();
  }
};

struct EpiRelu2 {
  bf16_t* U;
  DI void operator()(f32x4 (&acc)[G_MI][G_NJ], int rbase, int cbase, int lane) const {
    const int fr = lane & 15, fq = lane >> 4;
#pragma unroll
    for (int i = 0; i < G_MI; ++i)
#pragma unroll
      for (int j = 0; j < G_NJ; ++j) {
        const int row = rbase + i * 16 + fr, col = cbase + j * 16 + fq * 4;
        f32x4 v = acc[i][j];
#pragma unroll
        for (int e = 0; e < 4; ++e) { const float r = fmaxf(v[e], 0.f); v[e] = r * r; }
        u32x2 w = {pack2(v[0], v[1]), pack2(v[2], v[3])};
        *(u32x2*)(U + (size_t)row * 4096 + col) = w;
      }
  }
};

struct EpiConv {
  bf16_t *Ug, *Pz;
  DI void operator()(f32x4 (&acc)[G_MI][G_NJ], int rbase, int cbase, int lane) const {
    const int fr = lane & 15, fq = lane >> 4;
#pragma unroll
    for (int i = 0; i < G_MI; ++i) {
      const int row = rbase + i * 16 + fr;
      if (cbase < 1024) {
#pragma unroll
        for (int jp = 0; jp < 2; ++jp) {
          const f32x4 a = acc[i][2 * jp], gt = acc[i][2 * jp + 1];
          f32x4 u;
#pragma unroll
          for (int e = 0; e < 4; ++e) u[e] = a[e] / (1.f + __expf(-gt[e]));
          const int ch = ((cbase + 32 * jp) >> 5) * 16 + fq * 4;
          u32x2 w = {pack2(u[0], u[1]), pack2(u[2], u[3])};
          *(u32x2*)(Ug + (size_t)row * 512 + ch) = w;
        }
      } else {
#pragma unroll
        for (int j = 0; j < G_NJ; ++j) {
          const int col = cbase - 1024 + j * 16 + fq * 4;
          u32x2 w = {pack2(acc[i][j][0], acc[i][j][1]), pack2(acc[i][j][2], acc[i][j][3])};
          *(u32x2*)(Pz + (size_t)row * 512 + col) = w;
        }
      }
    }
  }
};

#ifndef XCD_ORDER
#define XCD_ORDER 1
#endif
template <class Epi>
DI void gemm_phase(const bf16_t* A, int lda, const bf16_t* Bt, int ldb, int K, int mt, int nt, const Epi& epi, char* smem, int tstart = 0, int ttotal = -1) {
  const int n = mt * nt;
  if (ttotal < 0) ttotal = n;
  for (int t = blockIdx.x; t < ttotal; t += gridDim.x) {
    const int u = t - tstart;
    if (u < 0 || u >= n) continue;
    int pm = u / nt, pn = u - pm * nt;
    if (XCD_ORDER && gridDim.x == 256 && (nt & 3) == 0 && (mt & 3) == 0 && n % 256 == 0) {
      const int r = u >> 8, w = u & 255, x = w & 7, idx = w >> 3;
      const int rows_r = 256 / nt;
      const int pw = nt < 8 ? nt : 8, ph = 32 / pw;
      const int npx = nt / pw;
      const int px = x % npx, py = x / npx;
      pm = r * rows_r + py * ph + idx / pw; pn = px * pw + idx % pw;
    }
    gemm_tile(A, lda, Bt, ldb, K, pm * G_BM, pn * G_BN, smem, epi);
  }
}

DI void rows_phase(const float* src_ctx, const float* src_lat, bool do_ln, const float* lg, const float* lb, float* Xdst,
                   const float* modsL, int sh_off, int sc_off, bf16_t* Hb) {
  const int lane = threadIdx.x & 63, gw = blockIdx.x * NWAVE + (threadIdx.x >> 6), nw = gridDim.x * NWAVE;
  for (int row = gw; row < NTOK; row += nw) {
    const float* src = row < NCTX ? src_ctx + (size_t)row * 1024 : src_lat + (size_t)(row - NCTX) * 1024;
    f32x4 v[4];
#pragma unroll
    for (int i = 0; i < 4; ++i) v[i] = *(const f32x4*)(src + i * 256 + lane * 4);
    if (do_ln) {
      float s = 0.f;
#pragma unroll
      for (int i = 0; i < 4; ++i) s += (v[i][0] + v[i][1]) + (v[i][2] + v[i][3]);
      const float mean = wave_sum(s) * (1.f / 1024.f);
      float q = 0.f;
#pragma unroll
      for (int i = 0; i < 4; ++i)
#pragma unroll
        for (int e = 0; e < 4; ++e) { const float d = v[i][e] - mean; q += d * d; }
      const float rstd = rsqrtf(wave_sum(q) * (1.f / 1024.f) + EPS);
#pragma unroll
      for (int i = 0; i < 4; ++i) {
        const f32x4 g = *(const f32x4*)(lg + i * 256 + lane * 4), b = *(const f32x4*)(lb + i * 256 + lane * 4);
#pragma unroll
        for (int e = 0; e < 4; ++e) v[i][e] = (v[i][e] - mean) * rstd * g[e] + b[e];
        if (Xdst) *(f32x4*)(Xdst + (size_t)row * 1024 + i * 256 + lane * 4) = v[i];
      }
    }
    if (Hb) {
      const float* m = modsL + cond_idx(row) * 6144;
#pragma unroll
      for (int i = 0; i < 4; ++i) {
        const int col = i * 256 + lane * 4;
        const f32x4 sh = *(const f32x4*)(m + sh_off + col), sc = *(const f32x4*)(m + sc_off + col);
        f32x4 h;
#pragma unroll
        for (int e = 0; e < 4; ++e) h[e] = v[i][e] * (1.f + sc[e]) + sh[e];
        u32x2 w = {pack2(h[0], h[1]), pack2(h[2], h[3])};
        *(u32x2*)(Hb + (size_t)row * 1024 + col) = w;
      }
    }
  }
}

DI double sin_red(double r) {
  const double r2 = r * r; double t = -1.0 / 51090942171709440000.0;
  t = t * r2 + 1.0 / 121645100408832000.0; t = t * r2 - 1.0 / 355687428096000.0; t = t * r2 + 1.0 / 1307674368000.0; t = t * r2 - 1.0 / 6227020800.0;
  t = t * r2 + 1.0 / 39916800.0; t = t * r2 - 1.0 / 362880.0; t = t * r2 + 1.0 / 5040.0; t = t * r2 - 1.0 / 120.0; t = t * r2 + 1.0 / 6.0;
  return r * (1.0 - r2 * t);
}
DI double cos_red(double r) {
  const double r2 = r * r; double t = 1.0 / 1124000727777607680000.0;
  t = t * r2 - 1.0 / 2432902008176640000.0; t = t * r2 + 1.0 / 6402373705728000.0; t = t * r2 - 1.0 / 20922789888000.0; t = t * r2 + 1.0 / 87178291200.0;
  t = t * r2 - 1.0 / 479001600.0; t = t * r2 + 1.0 / 3628800.0; t = t * r2 - 1.0 / 40320.0; t = t * r2 + 1.0 / 720.0; t = t * r2 - 1.0 / 24.0; t = t * r2 + 0.5; t = t * r2 * -1.0 + 1.0;
  return t;
}

constexpr int J_MODS = 192, J_WEFF = 64, J_CACHE = 64, J_ROPE = 1, J_SLOW = J_MODS + J_WEFF + J_CACHE + J_ROPE;
constexpr int T_ATTIN = 16 * 16, T_UQ = 4 * 6, T_UKV = 2 * 8, T_ATTOUT = 16 * 8, T_MLPIN = 16 * 32, T_MLPOUT = 64 * 8, T_CONVIN = 16 * 12, T_CONVOUT = 8 * 8;
constexpr int J_TR = T_ATTIN + T_UQ + T_UKV + T_ATTOUT + 2 * T_MLPIN + 2 * T_MLPOUT + T_CONVIN + T_CONVOUT;

struct TJ { const float* src; bf16_t* dst; int N, nvalid, lddst, perm, kt, nt; };
DI TJ tr_decode(const Params& p, int j) {
  char* ws = p.ws;
  TJ t; t.perm = 0;
  if (j < T_ATTIN) { t.src = p.w_att_in; t.N = 1952; t.nvalid = 1952; t.dst = (bf16_t*)(ws + O_WATTIN); t.lddst = 1024; t.kt = j / 16; t.nt = j % 16; return t; }
  j -= T_ATTIN;
  if (j < T_UQ) { t.src = p.w_uq; t.N = 768; t.nvalid = 768; t.dst = (bf16_t*)(ws + O_WUQ); t.lddst = 256; t.kt = j / 6; t.nt = j % 6; return t; }
  j -= T_UQ;
  if (j < T_UKV) { t.src = p.w_ukv; t.N = 1024; t.nvalid = 1024; t.dst = (bf16_t*)(ws + O_WUKV); t.lddst = 128; t.kt = j / 8; t.nt = j % 8; return t; }
  j -= T_UKV;
  if (j < T_ATTOUT) { t.src = p.w_att_out; t.N = 1024; t.nvalid = 1024; t.dst = (bf16_t*)(ws + O_WATTOUT); t.lddst = 1024; t.kt = j / 8; t.nt = j % 8; return t; }
  j -= T_ATTOUT;
  if (j < 2 * T_MLPIN) { const int l = j / T_MLPIN, u = j % T_MLPIN; t.src = p.w_mlp_in + (size_t)l * 1024 * 4096; t.N = 4096; t.nvalid = 4096; t.dst = (bf16_t*)(ws + O_WMLPIN) + (size_t)l * 4096 * 1024; t.lddst = 1024; t.kt = u / 32; t.nt = u % 32; return t; }
  j -= 2 * T_MLPIN;
  if (j < 2 * T_MLPOUT) { const int l = j / T_MLPOUT, u = j % T_MLPOUT; t.src = p.w_mlp_out + (size_t)l * 4096 * 1024; t.N = 1024; t.nvalid = 1024; t.dst = (bf16_t*)(ws + O_WMLPOUT) + (size_t)l * 4096 * 1024; t.lddst = 4096; t.kt = u / 8; t.nt = u % 8; return t; }
  j -= 2 * T_MLPOUT;
  if (j < T_CONVIN) { t.src = p.w_conv_in; t.N = 1536; t.nvalid = 1536; t.dst = (bf16_t*)(ws + O_WCONVIN); t.lddst = 1024; t.perm = 1; t.kt = j / 12; t.nt = j % 12; return t; }
  j -= T_CONVIN;
  t.src = p.w_conv_out; t.N = 1024; t.nvalid = 1024; t.dst = (bf16_t*)(ws + O_WCONVOUT); t.lddst = 1024; t.kt = j / 8; t.nt = j % 8; return t;
}
DI void tr_load(const TJ& t, float (&v)[16]) {
  const int tid = threadIdx.x, n = tid & 127, kb = tid >> 7;
  const int gn = t.nt * 128 + n;
  const float* s = t.src + (size_t)(t.kt * 64 + kb) * t.N + gn;
#pragma unroll
  for (int i = 0; i < 16; ++i) v[i] = (gn < t.nvalid) ? s[(size_t)(4 * i) * t.N] : 0.f;
}

DI void phase0(const Params& p, char* smem) {
  const int tid = threadIdx.x, lane = tid & 63, wid = tid >> 6;
  char* ws = p.ws;
  for (int job = blockIdx.x; job < J_SLOW; job += gridDim.x) {
    int j = job;
    if (j < J_MODS) {
      const int l = j / 96, cc = j % 96;
      float* sc = (float*)smem;
      for (int i = tid; i < 3072; i += NT) { const int ci = i >> 10, k = i & 1023; const float x = ci == 0 ? p.c_ctx[k] : p.c[(ci - 1) * 1024 + k]; sc[i] = x / (1.f + __expf(-x)); }
      __syncthreads();
      const int kg = tid >> 6, cl = tid & 63;
      const float* w = p.w_ada + (size_t)l * 1024 * 6144 + cc * 64 + cl;
      float s0 = 0.f, s1 = 0.f, s2 = 0.f;
#pragma unroll 16
      for (int k = kg * 128; k < kg * 128 + 128; ++k) { const float wv = w[(size_t)k * 6144]; s0 += sc[k] * wv; s1 += sc[1024 + k] * wv; s2 += sc[2048 + k] * wv; }
      float* r = (float*)(smem + 12288);
      r[(kg * 3 + 0) * 64 + cl] = s0; r[(kg * 3 + 1) * 64 + cl] = s1; r[(kg * 3 + 2) * 64 + cl] = s2;
      __syncthreads();
      if (tid < 192) {
        const int ci = tid >> 6, c2 = tid & 63;
        float s = 0.f;
#pragma unroll
        for (int g = 0; g < 8; ++g) s += r[(g * 3 + ci) * 64 + c2];
        ((float*)(ws + O_MODS))[(size_t)(l * 3 + ci) * 6144 + cc * 64 + c2] = s + p.b_ada[l * 6144 + cc * 64 + c2];
      }
      __syncthreads();
      continue;
    }
    j -= J_MODS;
    if (j < J_WEFF) {
      const int g = j >> 4, cch = (j >> 1) & 7, nch = j & 1;
      float* wp = (float*)smem;
      for (int i = tid; i < 2048; i += NT) wp[i] = p.w_pool[(size_t)(g * 128 + cch * 16 + (i >> 7)) * 128 + (i & 127)];
      __syncthreads();
      const int n = nch * 512 + tid;
      float a[16];
#pragma unroll
      for (int c = 0; c < 16; ++c) a[c] = 0.f;
#pragma unroll 4
      for (int e = 0; e < 128; ++e) {
        const float wo = p.w_conv_out[(size_t)(512 + g * 128 + e) * 1024 + n] * p.pool_scale[g * 128 + e];
#pragma unroll
        for (int c = 0; c < 16; ++c) a[c] += wp[c * 128 + e] * wo;
      }
      bf16_t* d = (bf16_t*)(ws + O_WCONVOUT) + (size_t)n * 1024 + 512 + g * 128 + cch * 16;
      *(u32x4*)d = (u32x4){pack2(a[0], a[1]), pack2(a[2], a[3]), pack2(a[4], a[5]), pack2(a[6], a[7])};
      *(u32x4*)(d + 8) = (u32x4){pack2(a[8], a[9]), pack2(a[10], a[11]), pack2(a[12], a[13]), pack2(a[14], a[15])};
      __syncthreads();
      continue;
    }
    j -= J_WEFF;
    if (j < J_CACHE) {
      const int rr = j * 8 + wid, b = rr >> 8, t = rr & 255;
      const size_t kr = NCTX + (size_t)b * TKL + t;
      const f32x4 a0 = *(const f32x4*)(p.cache_k + (size_t)rr * 512 + lane * 8), a1 = *(const f32x4*)(p.cache_k + (size_t)rr * 512 + lane * 8 + 4);
      *(u32x4*)((bf16_t*)(ws + O_KD) + kr * 512 + lane * 8) = (u32x4){pack2(a0[0], a0[1]), pack2(a0[2], a0[3]), pack2(a1[0], a1[1]), pack2(a1[2], a1[3])};
      const f32x4 b0 = *(const f32x4*)(p.cache_v + (size_t)rr * 512 + lane * 8), b1 = *(const f32x4*)(p.cache_v + (size_t)rr * 512 + lane * 8 + 4);
      *(u32x4*)((bf16_t*)(ws + O_VD) + kr * 512 + lane * 8) = (u32x4){pack2(b0[0], b0[1]), pack2(b0[2], b0[3]), pack2(b1[0], b1[1]), pack2(b1[2], b1[3])};
      const f32x2 cv = *(const f32x2*)(p.cache_ckv + (size_t)rr * 128 + lane * 2);
      *(unsigned*)((bf16_t*)(ws + O_CKVN) + kr * 128 + lane * 2) = pack2(cv[0], cv[1]);
      const int idx = lane & 31;
      const float x = p.cache_krope[(size_t)rr * 32 + idx];
      const unsigned pk = pack2(x, x);
#pragma unroll
      for (int k = 0; k < 4; ++k) { const int hh = (lane >> 5) + 2 * k; ((bf16_t*)(ws + O_KMLA))[kr * 768 + hh * 96 + 64 + idx] = (bf16_t)(pk & 0xffff); }
      continue;
    }
    j -= J_CACHE;
    {
      float* c16 = (float*)(ws + O_C16); float* s16 = (float*)(ws + O_S16); float* c8 = (float*)(ws + O_C8); float* s8 = (float*)(ws + O_S8);
      for (int i = tid; i < 1024 + 512; i += NT) {
        int pos, f, half;
        if (i < 1024) { pos = i >> 4; f = i & 15; half = 16; } else { const int q = i - 1024; pos = q >> 3; f = q & 7; half = 8; }
        const float inv = (float)exp(-9.210340371976184 * (double)f / (double)half);
        const float angf = (float)pos * inv;
        const double ang = (double)angf;
        const double r = ang - 6.283185307179586 * rint(ang * 0.15915494309189535);
        const float cs = (float)cos_red(r), sn = (float)sin_red(r);
        if (i < 1024) { c16[i] = cs; s16[i] = sn; } else { c8[i - 1024] = cs; s8[i - 1024] = sn; }
      }
      if (wid == 0) {
        const float d1 = wave_sum(p.lam_q1[lane] * p.lam_k1[lane]), d2 = wave_sum(p.lam_q2[lane] * p.lam_k2[lane]);
        if (lane == 0) ((float*)(ws + O_SCAL))[0] = expf(d1) - expf(d2) + 0.2f;
      }
    }
  }
  {
    float* tile = (float*)smem;
    int j = (blockIdx.x + gridDim.x - (J_SLOW % gridDim.x)) % gridDim.x;
    float v[16];
    TJ cur;
    if (j < J_TR) { cur = tr_decode(p, j); tr_load(cur, v); }
    while (j < J_TR) {
      {
        const int n = tid & 127, kb = tid >> 7;
#pragma unroll
        for (int i = 0; i < 16; ++i) tile[(kb + 4 * i) * 129 + n] = v[i];
      }
      __syncthreads();
      const int jn = j + gridDim.x;
      TJ nxt = cur;
      if (jn < J_TR) { nxt = tr_decode(p, jn); tr_load(nxt, v); }
      {
        const int n = tid >> 2, ks = (tid & 3) * 16;
        int gn = cur.nt * 128 + n;
        if (cur.perm) { if (gn < 512) gn = 32 * (gn >> 4) + (gn & 15); else if (gn < 1024) { const int c = gn - 512; gn = 32 * (c >> 4) + 16 + (c & 15); } }
        unsigned w[8];
#pragma unroll
        for (int e = 0; e < 8; ++e) w[e] = pack2(tile[(ks + 2 * e) * 129 + n], tile[(ks + 2 * e + 1) * 129 + n]);
        bf16_t* d = cur.dst + (size_t)gn * cur.lddst + cur.kt * 64 + ks;
        *(u32x4*)d = (u32x4){w[0], w[1], w[2], w[3]};
        *(u32x4*)(d + 8) = (u32x4){w[4], w[5], w[6], w[7]};
      }
      __syncthreads();
      cur = nxt; j = jn;
    }
  }
}

DI void rope8(const float (&x)[8], float (&o)[8], int lane, const float* c16, const float* s16, int prow, int pcol) {
  const int L = lane & 7;
  const int pos = (L & 4) ? pcol : prow;
  const bool second = (L & 2) != 0;
  const int fb = (L & 1) * 8;
#pragma unroll
  for (int e = 0; e < 8; ++e) {
    const float y = __shfl_xor(x[e], 2);
    const float cs = c16[pos * 16 + fb + e], sn = s16[pos * 16 + fb + e];
    o[e] = second ? (y * sn + x[e] * cs) : (x[e] * cs - y * sn);
  }
}
DI void unpack8(const u32x4 w, float (&x)[8]) {
#pragma unroll
  for (int e = 0; e < 4; ++e) { x[2 * e] = bflo(w[e]); x[2 * e + 1] = bfhi(w[e]); }
}
DI u32x4 pack8(const float (&x)[8]) { return (u32x4){pack2(x[0], x[1]), pack2(x[2], x[3]), pack2(x[4], x[5]), pack2(x[6], x[7])}; }

DI void phase3(const Params& p) {
  char* ws = p.ws;
  const bf16_t* R = (const bf16_t*)(ws + O_R);
  bf16_t* Qda = (bf16_t*)(ws + O_QDA); bf16_t* Qdb = (bf16_t*)(ws + O_QDB); bf16_t* Kd = (bf16_t*)(ws + O_KD); bf16_t* Vd = (bf16_t*)(ws + O_VD);
  bf16_t* cqn = (bf16_t*)(ws + O_CQN); bf16_t* ckvn = (bf16_t*)(ws + O_CKVN); bf16_t* Km = (bf16_t*)(ws + O_KMLA);
  const float* c16 = (const float*)(ws + O_C16); const float* s16 = (const float*)(ws + O_S16); const float* c8 = (const float*)(ws + O_C8); const float* s8 = (const float*)(ws + O_S8);
  float* o_k = p.out + (size_t)NTOK * 1024; float* o_v = o_k + (size_t)NCTX * 512; float* o_ckv = o_v + (size_t)NCTX * 512; float* o_kr = o_ckv + (size_t)NCTX * 128;
  const int lane = threadIdx.x & 63, gw = blockIdx.x * NWAVE + (threadIdx.x >> 6), nw = gridDim.x * NWAVE;
  for (int row = gw; row < NTOK; row += nw) {
    const bool lat = row >= NCTX;
    const int rl = row - NCTX, b = rl >> 12, t = rl & (TLAT - 1), prow = t >> 6, pcol = t & 63;
    const size_t kr = lat ? (size_t)NCTX + (size_t)b * TKL + 256 + t : (size_t)row;
    const bf16_t* r = R + (size_t)row * RLD;
    float x[8], o[8];
    const u32x4 wq = *(const u32x4*)(r + lane * 8);
    *(u32x4*)(Qda + (size_t)row * 512 + lane * 8) = wq;
    if (lat) { unpack8(wq, x); rope8(x, o, lane, c16, s16, prow, pcol); *(u32x4*)(Qdb + (size_t)rl * 512 + lane * 8) = pack8(o); }
    const u32x4 wk = *(const u32x4*)(r + 512 + lane * 8);
    if (lat) { unpack8(wk, x); rope8(x, o, lane, c16, s16, prow, pcol); *(u32x4*)(Kd + kr * 512 + lane * 8) = pack8(o); }
    else {
      unpack8(wk, x);
      *(f32x4*)(o_k + (size_t)row * 512 + lane * 8) = (f32x4){x[0], x[1], x[2], x[3]};
      *(f32x4*)(o_k + (size_t)row * 512 + lane * 8 + 4) = (f32x4){x[4], x[5], x[6], x[7]};
      *(u32x4*)(Kd + kr * 512 + lane * 8) = wk;
    }
    const u32x4 wv = *(const u32x4*)(r + 1024 + lane * 8);
    *(u32x4*)(Vd + kr * 512 + lane * 8) = wv;
    if (!lat) {
      unpack8(wv, x);
      *(f32x4*)(o_v + (size_t)row * 512 + lane * 8) = (f32x4){x[0], x[1], x[2], x[3]};
      *(f32x4*)(o_v + (size_t)row * 512 + lane * 8 + 4) = (f32x4){x[4], x[5], x[6], x[7]};
    }
    {
      const u32x2 w = *(const u32x2*)(r + 1536 + lane * 4);
      const float a0 = bflo(w[0]), a1 = bfhi(w[0]), a2 = bflo(w[1]), a3 = bfhi(w[1]);
      const float ss = wave_sum(a0 * a0 + a1 * a1 + a2 * a2 + a3 * a3);
      const float sc = rsqrtf(ss * (1.f / 256.f) + EPS);
      const f32x4 g = *(const f32x4*)(p.q_norm_g + lane * 4);
      *(u32x2*)(cqn + (size_t)row * 256 + lane * 4) = (u32x2){pack2(a0 * sc * g[0], a1 * sc * g[1]), pack2(a2 * sc * g[2], a3 * sc * g[3])};
    }
    {
      const unsigned w = *(const unsigned*)(r + 1792 + lane * 2);
      const float a0 = bflo(w), a1 = bfhi(w);
      const float ss = wave_sum(a0 * a0 + a1 * a1);
      const float sc = rsqrtf(ss * (1.f / 128.f) + EPS);
      const f32x2 g = *(const f32x2*)(p.kv_norm_g + lane * 2);
      const float y0 = a0 * sc * g[0], y1 = a1 * sc * g[1];
      if (!lat) *(f32x2*)(o_ckv + (size_t)row * 128 + lane * 2) = (f32x2){y0, y1};
      *(unsigned*)(ckvn + kr * 128 + lane * 2) = pack2(y0, y1);
    }
    {
      const int idx = lane & 31;
      const float xv = bf2f(r[1920 + idx]);
      float ov = xv;
      if (lat) {
        const int pos = (idx & 16) ? pcol : prow;
        const int f = idx & 7;
        const float y = __shfl_xor(xv, 8);
        const float cs = c8[pos * 8 + f], sn = s8[pos * 8 + f];
        ov = (idx & 8) ? (y * sn + xv * cs) : (xv * cs - y * sn);
      } else if (lane < 32) o_kr[(size_t)row * 32 + idx] = xv;
      const bf16_t ob = (bf16_t)(pack2(ov, ov) & 0xffff);
#pragma unroll
      for (int k = 0; k < 4; ++k) { const int hh = (lane >> 5) + 2 * k; Km[kr * 768 + hh * 96 + 64 + idx] = ob; }
    }
  }
}

template <int DQK, int DV>
DI void attn_core(const bf16_t* __restrict__ Qa, const bf16_t* __restrict__ Qb, int ldq, const bf16_t* __restrict__ Kp, int ldk, const bf16_t* __restrict__ Vp, int ldv,
                  int Tk, int n_a, float c  , char* smem, f32x16 (&o)[DV / 32]) {
  constexpr int KS = DQK * 2 + 16, VS = DV * 2 + 64, BUF = 64 * (KS + VS);
  constexpr int KCH = DQK / 8, VCH = DV / 8, NKCH = 64 * KCH, NVCH = 64 * VCH, NKC = (NKCH + NT - 1) / NT, NVC = (NVCH + NT - 1) / NT;
  constexpr bool KG = (NKCH % NT) != 0, VG = (NVCH % NT) != 0;
  constexpr int NS = DQK / 16, NDT = DV / 32;
  const int tid = threadIdx.x, lane = tid & 63, wid = tid >> 6, h = lane >> 5, ql = lane & 31;
  bf16x8 qf[NS];
  {
    const bf16_t* q = Qa + (size_t)(wid * 32 + ql) * ldq + h * 8;
#pragma unroll
    for (int s = 0; s < NS; ++s) qf[s] = *(const bf16x8*)(q + s * 16);
  }
#pragma unroll
  for (int dt = 0; dt < NDT; ++dt)
#pragma unroll
    for (int r = 0; r < 16; ++r) o[dt][r] = 0.f;
  float m_run = -INFINITY, l_run = 0.f;
  u32x4 rk[NKC], rv[NVC];
  const int nt = Tk >> 6, ta = n_a >> 6;
  unsigned koff[NKC], voff[NVC];
#pragma unroll
  for (int i = 0; i < NKC; ++i) { const int ch = tid + NT * i, row = ch / KCH, kc = ch % KCH; koff[i] = (unsigned)(row * ldk + kc * 8); }
#pragma unroll
  for (int i = 0; i < NVC; ++i) { const int ch = tid + NT * i, row = ch / VCH, vc = ch % VCH; voff[i] = (unsigned)(row * ldv + vc * 8); }
  auto gload = [&](int t) {
    const bf16_t* kb = Kp + (size_t)t * 64 * ldk;
    const bf16_t* vbp = Vp + (size_t)t * 64 * ldv;
#pragma unroll
    for (int i = 0; i < NKC; ++i) if (!KG || i + 1 < NKC || tid + NT * i < NKCH) rk[i] = *(const u32x4*)(kb + koff[i]);
#pragma unroll
    for (int i = 0; i < NVC; ++i) if (!VG || i + 1 < NVC || tid + NT * i < NVCH) rv[i] = *(const u32x4*)(vbp + voff[i]);
  };
  auto lstoreK = [&](char* buf) {
#pragma unroll
    for (int i = 0; i < NKC; ++i) { const int ch = tid + NT * i, row = ch / KCH, kc = ch % KCH; if (!KG || i + 1 < NKC || ch < NKCH) *(u32x4*)(buf + row * KS + kc * 16) = rk[i]; }
  };
  auto lstoreV = [&](char* buf) {
#pragma unroll
    for (int i = 0; i < NVC; ++i) { const int ch = tid + NT * i, row = ch / VCH, vc = ch % VCH; if (!VG || i + 1 < NVC || ch < NVCH) *(u32x4*)(buf + 64 * KS + row * VS + vc * 16) = rv[i]; }
  };
  gload(0); lstoreK(smem); lstoreV(smem); lds_barrier();
  const int i16 = lane & 15, tq = i16 >> 2, tp = i16 & 3, G = (lane >> 4) & 1;
  auto run_tiles = [&](int t_begin, int t_end) {
  for (int t = t_begin; t < t_end; ++t) {
    char* cur = smem + (t & 1) * BUF;
    gload(min(t + 1, nt - 1));
    f32x16 st[2];
#pragma unroll
    for (int kt = 0; kt < 2; ++kt) {
#pragma unroll
      for (int r = 0; r < 16; ++r) st[kt][r] = 0.f;
#pragma unroll
      for (int s = 0; s < NS; ++s) {
        const bf16x8 kf = *(const bf16x8*)(cur + (kt * 32 + ql) * KS + s * 32 + h * 16);
        st[kt] = __builtin_amdgcn_mfma_f32_32x32x16_bf16(kf, qf[s], st[kt], 0, 0, 0);
      }
      __builtin_amdgcn_sched_barrier(0);
    }
    float mx = st[0][0];
#pragma unroll
    for (int kt = 0; kt < 2; ++kt)
#pragma unroll
      for (int r = 0; r < 16; ++r) mx = fmaxf(mx, st[kt][r]);
    mx = fmaxf(mx, __shfl_xor(mx, 32));
    const float m_new = fmaxf(m_run, mx);
    const float alpha = __builtin_amdgcn_exp2f((m_run - m_new) * c);
    const float mc = m_new * c;
    m_run = m_new;
    float ls = 0.f;
#pragma unroll
    for (int kt = 0; kt < 2; ++kt)
#pragma unroll
      for (int r = 0; r < 16; ++r) { const float pv = __builtin_amdgcn_exp2f(st[kt][r] * c - mc); st[kt][r] = pv; ls += pv; }
    l_run = l_run * alpha + ls;
    if (__any(alpha != 1.f)) {
#pragma unroll
      for (int dt = 0; dt < NDT; ++dt)
#pragma unroll
        for (int r = 0; r < 16; ++r) o[dt][r] *= alpha;
    }
    bf16x8 pf[2][2];
#pragma unroll
    for (int kt = 0; kt < 2; ++kt)
#pragma unroll
      for (int s2 = 0; s2 < 2; ++s2) {
        u32x4 w = {pack2(st[kt][8 * s2 + 0], st[kt][8 * s2 + 1]), pack2(st[kt][8 * s2 + 2], st[kt][8 * s2 + 3]), pack2(st[kt][8 * s2 + 4], st[kt][8 * s2 + 5]), pack2(st[kt][8 * s2 + 6], st[kt][8 * s2 + 7])};
        pf[kt][s2] = __builtin_bit_cast(bf16x8, w);
      }
    const char* vb = cur + 64 * KS + (4 * h + tq) * VS + 32 * G + 8 * tp;
#pragma unroll
    for (int kt = 0; kt < 2; ++kt)
#pragma unroll
      for (int s2 = 0; s2 < 2; ++s2) {
        bf16x8 vf[NDT];
#pragma unroll
        for (int dt = 0; dt < NDT; ++dt) {
          const char* a0 = vb + (kt * 32 + 16 * s2) * VS + dt * 64;
          const s16x4 lo = __builtin_amdgcn_ds_read_tr16_b64_v4i16((LDS_AS s16x4*)(a0));
          const s16x4 hi = __builtin_amdgcn_ds_read_tr16_b64_v4i16((LDS_AS s16x4*)(a0 + 8 * VS));
          vf[dt] = __builtin_shufflevector(lo, hi, 0, 1, 2, 3, 4, 5, 6, 7);
        }
#pragma unroll
        for (int dt = 0; dt < NDT; ++dt) o[dt] = __builtin_amdgcn_mfma_f32_32x32x16_bf16(vf[dt], pf[kt][s2], o[dt], 0, 0, 0);
        __builtin_amdgcn_sched_barrier(0);
      }
    lstoreK(smem + ((t + 1) & 1) * BUF); lstoreV(smem + ((t + 1) & 1) * BUF);
    lds_barrier();
  }
  };
  run_tiles(0, min(ta, nt));
  if (ta < nt) {
    const bf16_t* q = Qb + (size_t)(wid * 32 + ql) * ldq + h * 8;
#pragma unroll
    for (int s = 0; s < NS; ++s) qf[s] = *(const bf16x8*)(q + s * 16);
    run_tiles(ta, nt);
  }
  const float l = l_run + __shfl_xor(l_run, 32);
  const float inv = 1.f / l;
#pragma unroll
  for (int dt = 0; dt < NDT; ++dt)
#pragma unroll
    for (int r = 0; r < 16; ++r) o[dt][r] *= inv;
}

constexpr int U_DBIG = 128, U_MBIG = 256, U_DCTX = 64, U_MCTX = 128, U_TOTAL = U_DBIG + U_MBIG + U_DCTX + U_MCTX;

DI void phase_attn(const Params& p, char* smem, int cidx) {
  char* ws = p.ws;
  const bf16_t* Qda = (const bf16_t*)(ws + O_QDA); const bf16_t* Qdb = (const bf16_t*)(ws + O_QDB); const bf16_t* Kd = (const bf16_t*)(ws + O_KD); const bf16_t* Vd = (const bf16_t*)(ws + O_VD);
  const bf16_t* Qma = (const bf16_t*)(ws + O_QMA); const bf16_t* Qmb = (const bf16_t*)(ws + O_QMB); const bf16_t* Km = (const bf16_t*)(ws + O_KMLA); const bf16_t* Vm = (const bf16_t*)(ws + O_VMLA);
  bf16_t* cat = (bf16_t*)(ws + O_HB);
  float* otmp = (float*)(ws + O_OTMP) + (size_t)blockIdx.x * 32768;
  int* counter = (int*)(ws + O_CNT) + cidx;
  int* s_unit = (int*)(smem + 65532);
  const int tid = threadIdx.x, lane = tid & 63, wid = tid >> 6, h2 = lane >> 5, ql = lane & 31;
  const float lam = ((const float*)(ws + O_SCAL))[0];
  for (;;) {
    if (tid == 0) *s_unit = atomicAdd(counter, 1);
    __syncthreads();
    int u = __builtin_amdgcn_readfirstlane(*s_unit);
    __syncthreads();
    if (u >= U_TOTAL) break;
    bool diff; int qrow0, krow0, Tk, n_a, head; bool lat;
    if (u < U_DBIG) { diff = true; lat = true; const int b = u >> 6, hh = (u >> 4) & 3, qb = u & 15; head = hh; qrow0 = NCTX + b * TLAT + qb * 256; krow0 = NCTX + b * TKL; Tk = TKL; n_a = 256; }
    else if (u < U_DBIG + U_MBIG) { u -= U_DBIG; diff = false; lat = true; const int b = u >> 7, hh = (u >> 4) & 7, qb = u & 15; head = hh; qrow0 = NCTX + b * TLAT + qb * 256; krow0 = NCTX + b * TKL; Tk = TKL; n_a = 256; }
    else if (u < U_DBIG + U_MBIG + U_DCTX) { u -= U_DBIG + U_MBIG; diff = true; lat = false; const int sq = u >> 2, hh = u & 3; head = hh; qrow0 = sq * 256; krow0 = sq * 256; Tk = 256; n_a = 256; }
    else { u -= U_DBIG + U_MBIG + U_DCTX; diff = false; lat = false; const int sq = u >> 3, hh = u & 7; head = hh; qrow0 = sq * 256; krow0 = sq * 256; Tk = 256; n_a = 256; }
    const int qrowb = lat ? qrow0 - NCTX : 0;
    if (diff) {
      f32x16 o[4];
      const float c = 0.125f * 1.4426950408889634f;
#pragma unroll 1
      for (int m = 0; m < 2; ++m) {
        attn_core<64, 128>(Qda + (size_t)qrow0 * 512 + head * 128 + m * 64, Qdb + (size_t)qrowb * 512 + head * 128 + m * 64, 512,
                           Kd + (size_t)krow0 * 512 + head * 128 + m * 64, 512, Vd + (size_t)krow0 * 512 + head * 128, 512, Tk, n_a, c, smem, o);
        if (m == 0) {
#pragma unroll
          for (int dt = 0; dt < 4; ++dt)
#pragma unroll
            for (int rq = 0; rq < 4; ++rq) *(f32x4*)(otmp + tid * 64 + dt * 16 + rq * 4) = (f32x4){o[dt][4 * rq], o[dt][4 * rq + 1], o[dt][4 * rq + 2], o[dt][4 * rq + 3]};
        }
      }
      float ss = 0.f;
#pragma unroll
      for (int dt = 0; dt < 4; ++dt)
#pragma unroll
        for (int rq = 0; rq < 4; ++rq) {
          const f32x4 o0 = *(const f32x4*)(otmp + tid * 64 + dt * 16 + rq * 4);
#pragma unroll
          for (int e = 0; e < 4; ++e) { const float v = o0[e] - lam * o[dt][4 * rq + e]; o[dt][4 * rq + e] = v; ss += v * v; }
        }
      ss += __shfl_xor(ss, 32);
      const float sc = rsqrtf(ss * (1.f / 128.f) + EPS) * 0.8f;
      bf16_t* dst = cat + (size_t)(qrow0 + wid * 32 + ql) * 1024 + head * 128;
#pragma unroll
      for (int dt = 0; dt < 4; ++dt)
#pragma unroll
        for (int rq = 0; rq < 4; ++rq) {
          const int dv = dt * 32 + 8 * rq + 4 * h2;
          const f32x4 g = *(const f32x4*)(p.diff_norm_g + dv);
          u32x2 w = {pack2(o[dt][4 * rq] * sc * g[0], o[dt][4 * rq + 1] * sc * g[1]), pack2(o[dt][4 * rq + 2] * sc * g[2], o[dt][4 * rq + 3] * sc * g[3])};
          *(u32x2*)(dst + dv) = w;
        }
    } else {
      f32x16 o[2];
      const float c = 0.10206207261596575f * 1.4426950408889634f;
      attn_core<96, 64>(Qma + (size_t)qrow0 * 768 + head * 96, Qmb + (size_t)qrowb * 768 + head * 96, 768,
                        Km + (size_t)krow0 * 768 + head * 96, 768, Vm + (size_t)krow0 * 512 + head * 64, 512, Tk, n_a, c, smem, o);
      bf16_t* dst = cat + (size_t)(qrow0 + wid * 32 + ql) * 1024 + 512 + head * 64;
#pragma unroll
      for (int dt = 0; dt < 2; ++dt)
#pragma unroll
        for (int rq = 0; rq < 4; ++rq) {
          const int dv = dt * 32 + 8 * rq + 4 * h2;
          u32x2 w = {pack2(o[dt][4 * rq], o[dt][4 * rq + 1]), pack2(o[dt][4 * rq + 2], o[dt][4 * rq + 3])};
          *(u32x2*)(dst + dv) = w;
        }
    }
  }
}

template <int HW>
DI void pool_unit(const bf16_t* __restrict__ Pz, bf16_t* __restrict__ cat, int t0, int s0, int s1, int ch) {
  float v0[16 + 2 * HW], v1[16 + 2 * HW];
#pragma unroll
  for (int i = 0; i < 16 + 2 * HW; ++i) {
    const int r = t0 - HW + i;
    unsigned w = 0u;
    if (r >= s0 && r < s1) w = *(const unsigned*)(Pz + (size_t)r * 512 + ch);
    v0[i] = bflo(w); v1[i] = bfhi(w);
  }
#pragma unroll
  for (int o = 0; o < 16; ++o) {
    const int r = t0 + o;
    float a0 = 0.f, a1 = 0.f;
#pragma unroll
    for (int d = 0; d < 2 * HW; ++d) { a0 += v0[o + d]; a1 += v1[o + d]; }
    const int lo = max(r - HW, s0), hi = min(r + HW - 1, s1 - 1);
    const float ic = 1.f / (float)(hi - lo + 1);
    *(unsigned*)(cat + (size_t)r * 1024 + 512 + ch) = pack2(a0 * ic - v0[o + HW], a1 * ic - v1[o + HW]);
  }
}

DI void phase_conv(const Params& p, char* smem) {
  char* ws = p.ws;
  const bf16_t* Ug = (const bf16_t*)(ws + O_UG); const bf16_t* Pz = (const bf16_t*)(ws + O_PZ);
  bf16_t* cat = (bf16_t*)(ws + O_HB);
  const int tid = threadIdx.x, lane = tid & 63, half = tid >> 8, ht = tid & 255, hw4 = (tid >> 6) & 3;
  float* tile = (float*)smem + half * 8192;
  for (int up = blockIdx.x; up < NTOK / 32; up += gridDim.x) {
    const int t0 = (up * 2 + half) * 16;
    const int s0 = t0 < NCTX ? (t0 & ~255) : NCTX + ((t0 - NCTX) & ~(TLAT - 1));
    const int s1 = t0 < NCTX ? s0 + 256 : s0 + TLAT;
    {
      const int ch = ht * 2;
      f32x2 w[31];
#pragma unroll
      for (int j = 0; j < 31; ++j) w[j] = *(const f32x2*)(p.conv_w + j * 512 + ch);
      const f32x2 bias = *(const f32x2*)(p.conv_b + ch);
#pragma unroll 1
      for (int hf = 0; hf < 2; ++hf) {
        float a0[8], a1[8];
#pragma unroll
        for (int o = 0; o < 8; ++o) { a0[o] = 0.f; a1[o] = 0.f; }
#pragma unroll
        for (int i = 0; i < 38; ++i) {
          const int r = t0 + hf * 8 - 15 + i;
          float u0 = 0.f, u1 = 0.f;
          if (r >= s0 && r < s1) { const unsigned v = *(const unsigned*)(Ug + (size_t)r * 512 + ch); u0 = bflo(v); u1 = bfhi(v); }
#pragma unroll
          for (int o = 0; o < 8; ++o) {
            const int j = i - o;
            if (j >= 0 && j <= 30) { a0[o] += u0 * w[j][0]; a1[o] += u1 * w[j][1]; }
          }
        }
#pragma unroll
        for (int o = 0; o < 8; ++o) *(f32x2*)(tile + (hf * 8 + o) * 512 + ch) = (f32x2){a0[o] + bias[0], a1[o] + bias[1]};
      }
    }
    __syncthreads();
#pragma unroll 1
    for (int k = 0; k < 4; ++k) {
      const int o = hw4 * 4 + k, row = t0 + o;
      const f32x4 v0 = *(const f32x4*)(tile + o * 512 + lane * 4), v1 = *(const f32x4*)(tile + o * 512 + 256 + lane * 4);
      const float mean = wave_sum((v0[0] + v0[1]) + (v0[2] + v0[3]) + (v1[0] + v1[1]) + (v1[2] + v1[3])) * (1.f / 512.f);
      float q = 0.f;
#pragma unroll
      for (int e = 0; e < 4; ++e) { const float d0 = v0[e] - mean, d1 = v1[e] - mean; q += d0 * d0 + d1 * d1; }
      const float rstd = rsqrtf(wave_sum(q) * (1.f / 512.f) + EPS);
#pragma unroll
      for (int hlf = 0; hlf < 2; ++hlf) {
        const int col = hlf * 256 + lane * 4;
        const f32x4 v = hlf ? v1 : v0;
        const f32x4 g = *(const f32x4*)(p.conv_norm_g + col), bb = *(const f32x4*)(p.conv_norm_b + col);
        float y[4];
#pragma unroll
        for (int e = 0; e < 4; ++e) { const float z = (v[e] - mean) * rstd * g[e] + bb[e]; y[e] = z / (1.f + __expf(-z)); }
        *(u32x2*)(cat + (size_t)row * 1024 + col) = (u32x2){pack2(y[0], y[1]), pack2(y[2], y[3])};
      }
    }
    __builtin_amdgcn_sched_barrier(0);
    switch (hw4) {
      case 0: pool_unit<1>(Pz, cat, t0, s0, s1, ht * 2); break;
      case 1: pool_unit<2>(Pz, cat, t0, s0, s1, ht * 2); break;
      case 2: pool_unit<4>(Pz, cat, t0, s0, s1, ht * 2); break;
      default: pool_unit<8>(Pz, cat, t0, s0, s1, ht * 2); break;
    }
    __syncthreads();
  }
}

__global__ void __launch_bounds__(NT, 2) fwd_kernel(Params p, int ph_lo, int ph_hi) {
  __shared__ __attribute__((aligned(16))) char smem[2 * G_STAGE];
  __shared__ uint4 xb_words;
  cg::grid_group grid = cg::this_grid();
  char* ws = p.ws;
  if (threadIdx.x == 0) xb_words = make_uint4(0u, 0u, 0u, 0u);
  __syncthreads();
  const XcdBarrier xb = xcd_barrier_post((unsigned*)(ws + O_BAR), (volatile LDS_AS unsigned*)&xb_words);
  if (ph_lo > 1000) grid.sync();
  float* mods = (float*)(ws + O_MODS);
  bf16_t* Hb = (bf16_t*)(ws + O_HB);
  float* X = p.out;
  float* xbuf = (float*)(ws + O_XBUF);
  unsigned* lncnt = (unsigned*)(ws + O_LNCNT);
  const bool fused = (gridDim.x == 256);
#define GSYNC() xcd_barrier(xb)
#define PH_BEGIN(n) if (ph_lo <= n && n < ph_hi) { if (n > ph_lo) GSYNC();
#define PH_BEGIN_IF(n, c) if (ph_lo <= n && n < ph_hi && (c)) { if (n > ph_lo) GSYNC();
#define PH_END }
#ifndef PROBE_DUP
#define PROBE_DUP 0
#endif
#ifndef PROBE_SYNCS
#define PROBE_SYNCS 0
#endif
#define DUP(n, ...) __VA_ARGS__; if ((PROBE_DUP >> n) & 1) { GSYNC(); __VA_ARGS__; }
  for (int i = 0; i < PROBE_SYNCS; ++i) GSYNC();
  PH_BEGIN(0) { DUP(0, phase0(p, smem)); } PH_END
  PH_BEGIN(1) { DUP(1, rows_phase(p.x_prompt, p.x_sample, false, nullptr, nullptr, nullptr, mods, 0, 1024, Hb)); } PH_END
  PH_BEGIN(2) {
    float* o_k = p.out + (size_t)NTOK * 1024; float* o_v = o_k + (size_t)NCTX * 512; float* o_ckv = o_v + (size_t)NCTX * 512; float* o_kr = o_ckv + (size_t)NCTX * 128;
    DUP(2, gemm_phase(Hb, 1024, (const bf16_t*)(ws + O_WATTIN), 1024, 1024, 64, 8,
                      EpiAttIn{(bf16_t*)(ws + O_QDA), (bf16_t*)(ws + O_QDB), (bf16_t*)(ws + O_KD), (bf16_t*)(ws + O_VD), (bf16_t*)(ws + O_CQN), (bf16_t*)(ws + O_CKVN), (bf16_t*)(ws + O_KMLA),
                               o_k, o_v, o_ckv, o_kr, (const float*)(ws + O_C16), (const float*)(ws + O_S16), (const float*)(ws + O_C8), (const float*)(ws + O_S8), p.q_norm_g, p.kv_norm_g, smem}, smem));
  } PH_END
  PH_BEGIN(4) {
        const int n1 = 64 * 3, n2 = 67 * 4;
        gemm_phase((const bf16_t*)(ws + O_CQN), 256, (const bf16_t*)(ws + O_WUQ), 256, 256, 64, 3,
                   EpiUq{(bf16_t*)(ws + O_QMA), (bf16_t*)(ws + O_QMB), (const float*)(ws + O_C8), (const float*)(ws + O_S8)}, smem, 0, n1 + n2);
        gemm_phase((const bf16_t*)(ws + O_CKVN), 128, (const bf16_t*)(ws + O_WUKV), 128, 128, 67, 4,
                   EpiUkv{(bf16_t*)(ws + O_KMLA), (bf16_t*)(ws + O_VMLA)}, smem, n1, n1 + n2);
  } PH_END
  PH_BEGIN(5) { phase_attn(p, smem, 0); if ((PROBE_DUP >> 5) & 1) { GSYNC(); phase_attn(p, smem, 1); } } PH_END
  PH_BEGIN(6) { gemm_phase(Hb, 1024, (const bf16_t*)(ws + O_WATTOUT), 1024, 1024, 64, 4, EpiResLN{p.x_prompt, p.x_sample, mods + 2048, X, p.ln_mix_g, p.ln_mix_b, mods, 3072, 4096, Hb, xbuf, lncnt, smem, fused}, smem); } PH_END
  PH_BEGIN_IF(7, !fused) { rows_phase(X, X + (size_t)NCTX * 1024, true, p.ln_mix_g, p.ln_mix_b, X, mods, 3072, 4096, Hb); } PH_END
  PH_BEGIN(8) { DUP(8, gemm_phase(Hb, 1024, (const bf16_t*)(ws + O_WMLPIN), 1024, 1024, 64, 16, EpiRelu2{(bf16_t*)(ws + O_U)}, smem)); } PH_END
  PH_BEGIN(9) { gemm_phase((const bf16_t*)(ws + O_U), 4096, (const bf16_t*)(ws + O_WMLPOUT), 4096, 4096, 64, 4, EpiResLN{X, X + (size_t)NCTX * 1024, mods + 5120, X, p.ln_mlp_g, p.ln_mlp_b, mods + 3 * 6144, 0, 1024, Hb, xbuf + 98304, lncnt + 64, smem, fused}, smem); } PH_END
  PH_BEGIN_IF(10, !fused) { rows_phase(X, X + (size_t)NCTX * 1024, true, p.ln_mlp_g, p.ln_mlp_b, X, mods + 3 * 6144, 0, 1024, Hb); } PH_END
  PH_BEGIN(11) { DUP(11, gemm_phase(Hb, 1024, (const bf16_t*)(ws + O_WCONVIN), 1024, 1024, 64, 6, EpiConv{(bf16_t*)(ws + O_UG), (bf16_t*)(ws + O_PZ)}, smem)); } PH_END
  PH_BEGIN(12) { DUP(12, phase_conv(p, smem)); } PH_END
  PH_BEGIN(13) { gemm_phase(Hb, 1024, (const bf16_t*)(ws + O_WCONVOUT), 1024, 1024, 64, 4, EpiResLN{X, X + (size_t)NCTX * 1024, mods + 3 * 6144 + 2048, X, p.ln_mix_g + 1024, p.ln_mix_b + 1024, mods + 3 * 6144, 3072, 4096, Hb, xbuf + 2 * 98304, lncnt + 128, smem, fused}, smem); } PH_END
  PH_BEGIN_IF(14, !fused) { rows_phase(X, X + (size_t)NCTX * 1024, true, p.ln_mix_g + 1024, p.ln_mix_b + 1024, X, mods + 3 * 6144, 3072, 4096, Hb); } PH_END
  PH_BEGIN(15) { DUP(15, gemm_phase(Hb, 1024, (const bf16_t*)(ws + O_WMLPIN) + (size_t)4096 * 1024, 1024, 1024, 64, 16, EpiRelu2{(bf16_t*)(ws + O_U)}, smem)); } PH_END
  PH_BEGIN(16) { gemm_phase((const bf16_t*)(ws + O_U), 4096, (const bf16_t*)(ws + O_WMLPOUT) + (size_t)4096 * 1024, 4096, 4096, 64, 4, EpiResLN{X, X + (size_t)NCTX * 1024, mods + 3 * 6144 + 5120, X, p.ln_mlp_g + 1024, p.ln_mlp_b + 1024, mods, 0, 0, nullptr, xbuf + 3 * 98304, lncnt + 192, smem, fused}, smem); } PH_END
  PH_BEGIN_IF(17, !fused) { rows_phase(X, X + (size_t)NCTX * 1024, true, p.ln_mlp_g + 1024, p.ln_mlp_b + 1024, X, nullptr, 0, 0, nullptr); } PH_END
}

extern "C" void kernel_launch(void* const* d_in, const int* in_sizes, int n_in, void* d_out, int out_size, void* d_ws, size_t ws_size, hipStream_t stream) {
  static int grid_blocks = 0;
  if (!grid_blocks) {
    int dev = 0, cus = 0, per_cu = 0;
    hipGetDevice(&dev);
    hipDeviceGetAttribute(&cus, hipDeviceAttributeMultiprocessorCount, dev);
    hipOccupancyMaxActiveBlocksPerMultiprocessor(&per_cu, fwd_kernel, NT, 0);
    if (per_cu > 1) per_cu = 1;
    if (per_cu < 1) per_cu = 1;
    grid_blocks = cus * per_cu;
    if (grid_blocks > 256) grid_blocks = 256;
  }
  if (ws_size < WS_NEED) { fprintf(stderr, "workspace too small: %zu < %zu\n", ws_size, (size_t)WS_NEED); return; }
  Params p{};
  const float** f = (const float**)&p;
  for (int i = 0; i < 35; ++i) f[i] = (const float*)d_in[i];
  p.out = (float*)d_out;
  p.ws = (char*)d_ws;
  hipMemsetAsync(d_ws, 0, 16384, stream);
  int lo = 0, hi = NPHASE;
  void* args[] = {&p, &lo, &hi};
  hipError_t e = hipLaunchCooperativeKernel((void*)fwd_kernel, dim3(grid_blocks), dim3(NT), args, 0, stream);
  if (e != hipSuccess) fprintf(stderr, "cooperative launch failed: %s (grid %d)\n", hipGetErrorString(e), grid_blocks);
}
```

```cpp
#include <hip/hip_runtime.h>
#include <hip/hip_cooperative_groups.h>
#include <cstdio>
#include <cstdint>
namespace cg = cooperative_groups;

typedef unsigned short bf16_t;
typedef short bf16x8 __attribute__((ext_vector_type(8)));
typedef short s16x4 __attribute__((ext_vector_type(4)));
typedef float f32x4 __attribute__((ext_vector_type(4)));
typedef float f32x2 __attribute__((ext_vector_type(2)));
typedef float f32x16 __attribute__((ext_vector_type(16)));
typedef unsigned u32x4 __attribute__((ext_vector_type(4)));
typedef unsigned u32x2 __attribute__((ext_vector_type(2)));
typedef __bf16 bf16v2 __attribute__((ext_vector_type(2)));
#define DI __device__ __forceinline__
#define LDS_AS __attribute__((address_space(3)))

constexpr int NTOK = 12288, NCTX = 4096, NKEY = 12800, TLAT = 4096, TKL = 4352;
constexpr int RLD = 1952;
constexpr float ALPHA = 1.41421356237f, EPS = 1e-5f;
constexpr int NPHASE = 18;
constexpr int NT = 512, NWAVE = 8;

constexpr size_t al(size_t x) { return (x + 255) & ~(size_t)255; }
constexpr size_t O_CNT = 0;
constexpr size_t O_BAR = 256;
constexpr size_t O_LNCNT = 14336;
constexpr size_t O_MODS = 16384;
constexpr size_t O_SCAL = O_MODS + al(2 * 3 * 6144 * 4);
constexpr size_t O_C16 = O_SCAL + 256;
constexpr size_t O_S16 = O_C16 + 4096;
constexpr size_t O_C8 = O_S16 + 4096;
constexpr size_t O_S8 = O_C8 + 2048;
constexpr size_t O_XBUF = O_S8 + 2048;
constexpr size_t O_WATTIN = O_XBUF + (size_t)4 * 256 * 192 * 2 * 4;
constexpr size_t O_WUQ = O_WATTIN + (size_t)2048 * 1024 * 2;
constexpr size_t O_WUKV = O_WUQ + (size_t)768 * 256 * 2;
constexpr size_t O_WATTOUT = O_WUKV + (size_t)1024 * 128 * 2;
constexpr size_t O_WMLPIN = O_WATTOUT + (size_t)1024 * 1024 * 2;
constexpr size_t O_WMLPOUT = O_WMLPIN + (size_t)2 * 4096 * 1024 * 2;
constexpr size_t O_WCONVIN = O_WMLPOUT + (size_t)2 * 4096 * 1024 * 2;
constexpr size_t O_WCONVOUT = O_WCONVIN + (size_t)1536 * 1024 * 2;
constexpr size_t O_HB = O_WCONVOUT + (size_t)1024 * 1024 * 2;
constexpr size_t O_BIG = O_HB + (size_t)NTOK * 1024 * 2;
constexpr size_t O_R = O_BIG;
constexpr size_t O_QMA = O_R;
constexpr size_t O_QMB = O_QMA + (size_t)NTOK * 768 * 2;
constexpr size_t O_QDA = O_R + al((size_t)NTOK * RLD * 2);
constexpr size_t O_QDB = O_QDA + (size_t)NTOK * 512 * 2;
constexpr size_t O_KD = O_QDB + (size_t)8192 * 512 * 2;
constexpr size_t O_VD = O_KD + (size_t)NKEY * 512 * 2;
constexpr size_t O_CQN = O_VD + (size_t)NKEY * 512 * 2;
constexpr size_t O_CKVN = O_CQN + (size_t)NTOK * 256 * 2;
constexpr size_t O_KMLA = O_CKVN + (size_t)NKEY * 128 * 2;
constexpr size_t O_VMLA = O_KMLA + (size_t)NKEY * 768 * 2;
constexpr size_t O_OTMP = O_VMLA + (size_t)NKEY * 512 * 2;
constexpr size_t O_ATT_END = O_OTMP + (size_t)512 * 16384 * 4;
constexpr size_t O_U = O_BIG;
constexpr size_t O_U_END = O_U + (size_t)NTOK * 4096 * 2;
constexpr size_t O_UG = O_BIG;
constexpr size_t O_PZ = O_UG + (size_t)NTOK * 512 * 2;
constexpr size_t WS_NEED = (O_ATT_END > O_U_END ? O_ATT_END : O_U_END);
static_assert(O_QMB + (size_t)8192 * 768 * 2 <= O_QDA, "Qm overlay must fit in R");
static_assert(WS_NEED <= (size_t)256 * 1024 * 1024, "workspace too large");

struct Params {
  const float *x_prompt, *x_sample, *cache_k, *cache_v, *cache_ckv, *cache_krope, *c, *c_ctx;
  const float *w_ada, *b_ada, *ln_mix_g, *ln_mix_b, *ln_mlp_g, *ln_mlp_b, *w_mlp_in, *w_mlp_out;
  const float *w_att_in, *w_uq, *w_ukv, *q_norm_g, *kv_norm_g, *lam_q1, *lam_k1, *lam_q2, *lam_k2, *diff_norm_g, *w_att_out;
  const float *w_conv_in, *conv_w, *conv_b, *conv_norm_g, *conv_norm_b, *w_pool, *pool_scale, *w_conv_out;
  float* out;
  char* ws;
};

DI unsigned pack2(float lo, float hi) { f32x2 v = {lo, hi}; bf16v2 b = __builtin_convertvector(v, bf16v2); return __builtin_bit_cast(unsigned, b); }
DI float bf2f(unsigned short u) { return __uint_as_float((unsigned)u << 16); }
DI float bflo(unsigned u) { return __uint_as_float(u << 16); }
DI float bfhi(unsigned u) { return __uint_as_float(u & 0xffff0000u); }
DI float wave_sum(float v) {
#pragma unroll
  for (int o = 32; o >= 1; o >>= 1) v += __shfl_xor(v, o);
  return v;
}
DI void lds_barrier() { asm volatile("s_waitcnt lgkmcnt(0)\n\ts_barrier" ::: "memory"); }
DI void dma16(const void* gsrc, unsigned lds_dst) {
  unsigned keep;
  asm volatile("s_mov_b32 %0, m0\n\ts_mov_b32 m0, %2\n\ts_nop 0\n\tglobal_load_lds_dwordx4 %1, off\n\ts_mov_b32 m0, %0" : "=&s"(keep) : "v"(gsrc), "s"(lds_dst) : "memory");
}
DI int cond_idx(int row) { return row < NCTX ? 0 : 1 + ((row - NCTX) >> 12); }


#define XB_TMO      128
#define XB_XCNT(j)  (256  + 64 * (j))
#define XB_XSUB(j)  (1280 + 64 * (j))
#define XB_XGEN(j)  (2304 + 64 * (j))
#define XB_TOP      3328
#define XB_TOPGEN   3392
#define XCD_BAR_WORDS 3456
#define XB_SPIN_CAP (1u << 18)
DI unsigned xb_ld(unsigned* p)              { return __hip_atomic_load(p, __ATOMIC_RELAXED, __HIP_MEMORY_SCOPE_AGENT); }
DI unsigned xb_add(unsigned* p, unsigned v) { return __hip_atomic_fetch_add(p, v, __ATOMIC_RELAXED, __HIP_MEMORY_SCOPE_AGENT); }
DI unsigned xb_xcc_id() { return (unsigned)__builtin_amdgcn_s_getreg((3 << 11) | 20) & 0xFu; }
#define XB_SPIN(cond, bar) do { unsigned _sp = 0; while (cond) { __builtin_amdgcn_s_sleep(1); \
    if ((++_sp & 255u) == 0u) { if (xb_ld(&(bar)[XB_TMO])) break; if (_sp > XB_SPIN_CAP) { atomicAdd(&(bar)[XB_TMO], 1u); break; } } } } while (0)
struct XcdBarrier { unsigned* bar; unsigned x; volatile LDS_AS unsigned* st; };
DI XcdBarrier xcd_barrier_post(unsigned* bar, volatile LDS_AS unsigned* st) {
  XcdBarrier b; b.bar = bar; b.x = xb_xcc_id(); b.st = st;
  if (threadIdx.x == 0) (void)xb_add(&bar[XB_XCNT(b.x)], 1u);
  return b;
}
DI void xcd_barrier_complete(unsigned* bar, unsigned x, unsigned& nloc, unsigned& nx) {
  const unsigned G = gridDim.x * gridDim.y * gridDim.z;
  unsigned sum, cnt, mine, sp = 0u;
  for (;;) {
    sum = 0u; cnt = 0u; mine = 0u;
#pragma unroll
    for (unsigned j = 0; j < 16; ++j) { const unsigned c = xb_ld(&bar[XB_XCNT(j)]); sum += c; cnt += (c > 0u) ? 1u : 0u; mine = (j == x) ? c : mine; }
    if (sum == G) break;
    __builtin_amdgcn_s_sleep(1);
    if ((++sp & 255u) == 0u) { if (xb_ld(&bar[XB_TMO])) break; if (sp > XB_SPIN_CAP) { atomicAdd(&bar[XB_TMO], 1u); break; } }
  }
  nloc = mine > 0u ? mine : 1u; nx = cnt > 0u ? cnt : 1u;
}
DI void xcd_barrier(const XcdBarrier& b) {
  asm volatile("s_waitcnt vmcnt(0)" ::: "memory");
  __syncthreads();
  if (threadIdx.x == 0) {
    unsigned* bar = b.bar;
    __builtin_amdgcn_s_waitcnt(0);
    unsigned nloc = b.st[0], nx = b.st[1];
    if (nloc == 0u) { xcd_barrier_complete(bar, b.x, nloc, nx); b.st[0] = nloc; b.st[1] = nx; }
    const unsigned old = xb_add(&bar[XB_XSUB(b.x)], 1u);
    const unsigned gen = old / nloc;
    if (old + 1u == (gen + 1u) * nloc) {
      __builtin_amdgcn_fence(__ATOMIC_RELEASE, "agent");
      asm volatile("s_waitcnt vmcnt(0)" ::: "memory");
      const unsigned og = xb_add(&bar[XB_TOP], 1u);
      const unsigned tg = og / nx;
      if (og + 1u == (tg + 1u) * nx) xb_add(&bar[XB_TOPGEN], 1u);
      else XB_SPIN(xb_ld(&bar[XB_TOPGEN]) == tg, bar);
      __builtin_amdgcn_fence(__ATOMIC_ACQUIRE, "agent");
      xb_add(&bar[XB_XGEN(b.x)], 1u);
      asm volatile("s_waitcnt vmcnt(0)" ::: "memory");
    } else {
      XB_SPIN(xb_ld(&bar[XB_XGEN(b.x)]) == gen, bar);
      __builtin_amdgcn_fence(__ATOMIC_ACQUIRE, "agent");
      asm volatile("s_waitcnt vmcnt(0)" ::: "memory");
    }
  }
  __syncthreads();
}

DI int swz(int row, int kc) { return row * 128 + ((kc ^ ((row >> 1) & 7)) << 4); }

constexpr int G_BM = 192, G_BN = 256, G_MI = 6, G_NJ = 4, G_ABYTES = G_BM * 128, G_STAGE = G_ABYTES + G_BN * 128;
template <class Epi>
DI void gemm_tile(const bf16_t* __restrict__ A, int lda, const bf16_t* __restrict__ Bt, int ldb, int K, int row0, int col0, char* smem, const Epi& epi,
                  bool prefetched, bool has_next, int nrow0, int ncol0) {
  const int tid = threadIdx.x, lane = tid & 63, wid = tid >> 6, wr = wid >> 2, wc = wid & 3;
  const int fr = lane & 15, fq = lane >> 4;
  f32x4 acc[G_MI][G_NJ];
#pragma unroll
  for (int i = 0; i < G_MI; ++i)
#pragma unroll
    for (int j = 0; j < G_NJ; ++j) acc[i][j] = (f32x4){0.f, 0.f, 0.f, 0.f};
  const int srow = tid >> 3, skc = tid & 7;
  const int schunk = skc ^ ((srow >> 1) & 7);
  const bf16_t* ga = A + (size_t)(row0 + srow) * lda + schunk * 8;
  const bf16_t* gb = Bt + (size_t)(col0 + srow) * ldb + schunk * 8;
  const int nk = K >> 6;
  const unsigned lds0 = __builtin_amdgcn_readfirstlane((unsigned)(size_t)(LDS_AS char*)smem + (unsigned)(tid & ~63) * 16u);
#define G_DMA_P(ga_, gb_, stage_off_, kt_) do { const int k0_ = (kt_) << 6; const unsigned sb_ = lds0 + (unsigned)(stage_off_); \
    _Pragma("unroll") for (int i = 0; i < 3; ++i) dma16((ga_) + (size_t)(64 * i) * lda + k0_, sb_ + i * 8192); \
    _Pragma("unroll") for (int i = 0; i < 4; ++i) dma16((gb_) + (size_t)(64 * i) * ldb + k0_, sb_ + G_ABYTES + i * 8192); } while (0)
#define G_DMA(stage_off_, kt_) G_DMA_P(ga, gb, stage_off_, kt_)
#define G_COMPUTE(buf_) do { const char* cur = (buf_); \
    _Pragma("unroll") for (int s = 0; s < 2; ++s) { \
      bf16x8 af[G_MI], bfr[G_NJ]; \
      _Pragma("unroll") for (int i = 0; i < G_MI; ++i) af[i] = *(const bf16x8*)(cur + swz(wr * 96 + i * 16 + fr, s * 4 + fq)); \
      _Pragma("unroll") for (int j = 0; j < G_NJ; ++j) bfr[j] = *(const bf16x8*)(cur + G_ABYTES + swz(wc * 64 + j * 16 + fr, s * 4 + fq)); \
      __builtin_amdgcn_s_setprio(1); \
      _Pragma("unroll") for (int i = 0; i < G_MI; ++i) \
        _Pragma("unroll") for (int j = 0; j < G_NJ; ++j) acc[i][j] = __builtin_amdgcn_mfma_f32_16x16x32_bf16(bfr[j], af[i], acc[i][j], 0, 0, 0); \
      __builtin_amdgcn_s_setprio(0); \
    } } while (0)
  if (!prefetched) { G_DMA(0, 0); asm volatile("s_waitcnt vmcnt(0)" ::: "memory"); }
  else asm volatile("s_waitcnt vmcnt(%0)" :: "n"(Epi::kMinStores) : "memory");
  lds_barrier();
  for (int kt = 0; kt < nk; kt += 2) {
    G_DMA(G_STAGE, kt + 1);
    G_COMPUTE(smem);
    asm volatile("s_waitcnt vmcnt(0)" ::: "memory");
    lds_barrier();
    G_DMA(0, min(kt + 2, nk - 1));
    G_COMPUTE(smem + G_STAGE);
    asm volatile("s_waitcnt vmcnt(0)" ::: "memory");
    lds_barrier();
  }
  if (has_next) {
    const bf16_t* gan = A + (size_t)(nrow0 + srow) * lda + schunk * 8;
    const bf16_t* gbn = Bt + (size_t)(ncol0 + srow) * ldb + schunk * 8;
    G_DMA_P(gan, gbn, 0, 0);
  }
#undef G_DMA
#undef G_DMA_P
#undef G_COMPUTE
  epi(acc, row0 + wr * 96, col0 + wc * 64, lane);
}


struct EpiRaw {
  static constexpr int kMinStores = 0;
  static constexpr bool kPrefetchNext = true;
  bf16_t* R;
  DI void operator()(f32x4 (&acc)[G_MI][G_NJ], int rbase, int cbase, int lane) const {
    const int fr = lane & 15, fq = lane >> 4;
#pragma unroll
    for (int i = 0; i < G_MI; ++i)
#pragma unroll
      for (int j = 0; j < G_NJ; ++j) {
        const int row = rbase + i * 16 + fr, col = cbase + j * 16 + fq * 4;
        if (col < RLD) { u32x2 w = {pack2(acc[i][j][0], acc[i][j][1]), pack2(acc[i][j][2], acc[i][j][3])}; *(u32x2*)(R + (size_t)row * RLD + col) = w; }
      }
  }
};


struct EpiAttIn {
  static constexpr int kMinStores = 0;
  static constexpr bool kPrefetchNext = true;
  bf16_t *Qda, *Qdb, *Kd, *Vd, *cqn, *ckvn, *Km; float *o_k, *o_v, *o_ckv, *o_kr;
  const float *c16, *s16, *c8, *s8, *qg, *kvg; char* smem;
  DI void operator()(f32x4 (&acc)[G_MI][G_NJ], int rbase, int cbase, int lane) const {
    const int tid = threadIdx.x, wid = tid >> 6, wr = wid >> 2, wc = wid & 3, fr = lane & 15, fq = lane >> 4;
    const int tile = (cbase - wc * 64) >> 8;
    float* part = (float*)smem;
    if (tile < 6) {
      const int which = tile >> 1, c0 = cbase & 511;
#pragma unroll
      for (int i = 0; i < G_MI; ++i) {
        const int rowf = rbase + i * 16, row = rowf + fr;
        const bool lat = rowf >= NCTX;
        const int rl = row - NCTX, b = rl >> 12, t = rl & (TLAT - 1), prow = t >> 6, pcol = t & 63;
        const size_t kr = lat ? (size_t)NCTX + (size_t)b * TKL + 256 + t : (size_t)row;
        u32x2 raw[G_NJ], rot[G_NJ];
#pragma unroll
        for (int j = 0; j < G_NJ; ++j) raw[j] = (u32x2){pack2(acc[i][j][0], acc[i][j][1]), pack2(acc[i][j][2], acc[i][j][3])};
        if (lat && which < 2) {
#pragma unroll
          for (int jp = 0; jp < 2; ++jp) {
            const int pos = jp == 0 ? prow : pcol;
            const f32x4 cs = *(const f32x4*)(c16 + pos * 16 + fq * 4), sn = *(const f32x4*)(s16 + pos * 16 + fq * 4);
            const f32x4 x1 = acc[i][2 * jp], x2 = acc[i][2 * jp + 1];
            f32x4 o1, o2;
#pragma unroll
            for (int e = 0; e < 4; ++e) { o1[e] = x1[e] * cs[e] - x2[e] * sn[e]; o2[e] = x1[e] * sn[e] + x2[e] * cs[e]; }
            rot[2 * jp] = (u32x2){pack2(o1[0], o1[1]), pack2(o1[2], o1[3])};
            rot[2 * jp + 1] = (u32x2){pack2(o2[0], o2[1]), pack2(o2[2], o2[3])};
          }
        }
#pragma unroll
        for (int j = 0; j < G_NJ; ++j) {
          const int c = c0 + j * 16 + fq * 4;
          if (which == 0) {
            *(u32x2*)(Qda + (size_t)row * 512 + c) = raw[j];
            if (lat) *(u32x2*)(Qdb + (size_t)rl * 512 + c) = rot[j];
          } else if (which == 1) {
            if (lat) *(u32x2*)(Kd + kr * 512 + c) = rot[j];
            else { *(u32x2*)(Kd + kr * 512 + c) = raw[j]; *(f32x4*)(o_k + (size_t)row * 512 + c) = acc[i][j]; }
          } else {
            *(u32x2*)(Vd + kr * 512 + c) = raw[j];
            if (!lat) *(f32x4*)(o_v + (size_t)row * 512 + c) = acc[i][j];
          }
        }
      }
      return;
    }
    const bool norm_wave = (tile == 6) || (wc < 2);
#pragma unroll
    for (int i = 0; i < G_MI; ++i) {
      float ss = 0.f;
#pragma unroll
      for (int j = 0; j < G_NJ; ++j)
#pragma unroll
        for (int e = 0; e < 4; ++e) ss += acc[i][j][e] * acc[i][j][e];
      ss += __shfl_xor(ss, 16); ss += __shfl_xor(ss, 32);
      if (fq == 0) part[(wr * 96 + i * 16 + fr) * 4 + wc] = ss;
    }
    __syncthreads();
#pragma unroll
    for (int i = 0; i < G_MI; ++i) {
      const int rowf = rbase + i * 16, row = rowf + fr;
      const bool lat = rowf >= NCTX;
      const int rl = row - NCTX, b = rl >> 12, t = rl & (TLAT - 1), prow = t >> 6, pcol = t & 63;
      const size_t kr = lat ? (size_t)NCTX + (size_t)b * TKL + 256 + t : (size_t)row;
      const f32x4 pr = *(const f32x4*)(part + (wr * 96 + i * 16 + fr) * 4);
      if (tile == 6) {
        const float sc = rsqrtf(((pr[0] + pr[1]) + (pr[2] + pr[3])) * (1.f / 256.f) + EPS);
#pragma unroll
        for (int j = 0; j < G_NJ; ++j) {
          const int c = wc * 64 + j * 16 + fq * 4;
          const f32x4 g = *(const f32x4*)(qg + c);
          *(u32x2*)(cqn + (size_t)row * 256 + c) = (u32x2){pack2(acc[i][j][0] * sc * g[0], acc[i][j][1] * sc * g[1]), pack2(acc[i][j][2] * sc * g[2], acc[i][j][3] * sc * g[3])};
        }
      } else if (norm_wave) {
        const float sc = rsqrtf((pr[0] + pr[1]) * (1.f / 128.f) + EPS);
#pragma unroll
        for (int j = 0; j < G_NJ; ++j) {
          const int c = wc * 64 + j * 16 + fq * 4;
          const f32x4 g = *(const f32x4*)(kvg + c);
          f32x4 y;
#pragma unroll
          for (int e = 0; e < 4; ++e) y[e] = acc[i][j][e] * sc * g[e];
          if (!lat) *(f32x4*)(o_ckv + (size_t)row * 128 + c) = y;
          *(u32x2*)(ckvn + kr * 128 + c) = (u32x2){pack2(y[0], y[1]), pack2(y[2], y[3])};
        }
      } else if (wc == 2) {
#pragma unroll
        for (int j = 0; j < 2; ++j) {
          f32x4 v = acc[i][j];
          if (lat) {
            const int pos = j == 0 ? prow : pcol;
            f32x4 o;
#pragma unroll
            for (int e = 0; e < 4; ++e) {
              const float pv = __shfl_xor(v[e], 32);
              const int f = (fq & 1) * 4 + e;
              const float cs = c8[pos * 8 + f], sn = s8[pos * 8 + f];
              o[e] = (fq < 2) ? (v[e] * cs - pv * sn) : (pv * sn + v[e] * cs);
            }
            v = o;
          } else *(f32x4*)(o_kr + (size_t)row * 32 + j * 16 + fq * 4) = v;
          const u32x2 w = {pack2(v[0], v[1]), pack2(v[2], v[3])};
#pragma unroll
          for (int hh = 0; hh < 8; ++hh) *(u32x2*)(Km + kr * 768 + hh * 96 + 64 + j * 16 + fq * 4) = w;
        }
      }
    }
    __syncthreads();
  }
};

struct EpiUq {
  static constexpr int kMinStores = 24;
  static constexpr bool kPrefetchNext = true;
  bf16_t *Qa, *Qb; const float *c8, *s8;
  DI void operator()(f32x4 (&acc)[G_MI][G_NJ], int rbase, int cbase, int lane) const {
    const int fr = lane & 15, fq = lane >> 4;
#pragma unroll
    for (int i = 0; i < G_MI; ++i) {
      const bool lat = (rbase + i * 16) >= NCTX;
      const int row = rbase + i * 16 + fr;
      const int t = (row - NCTX) & (TLAT - 1);
#pragma unroll
      for (int j = 0; j < G_NJ; ++j) {
        const int cf = cbase + j * 16, col = cf + fq * 4;
        f32x4 v = acc[i][j];
        u32x2 w = {pack2(v[0], v[1]), pack2(v[2], v[3])};
        *(u32x2*)(Qa + (size_t)row * 768 + col) = w;
        if (lat) {
          const int w96 = cf % 96;
          if (w96 >= 64) {
            const int pos = (w96 == 64) ? (t >> 6) : (t & 63);
            f32x4 o;
#pragma unroll
            for (int e = 0; e < 4; ++e) {
              const float pv = __shfl_xor(v[e], 32);
              const int f = (fq & 1) * 4 + e;
              const float cs = c8[pos * 8 + f], sn = s8[pos * 8 + f];
              o[e] = (fq < 2) ? (v[e] * cs - pv * sn) : (pv * sn + v[e] * cs);
            }
            w = (u32x2){pack2(o[0], o[1]), pack2(o[2], o[3])};
          }
          *(u32x2*)(Qb + (size_t)(row - NCTX) * 768 + col) = w;
        }
      }
    }
  }
};

struct EpiUkv {
  static constexpr int kMinStores = 0;
  static constexpr bool kPrefetchNext = true;
  bf16_t *Km, *Vm;
  DI void operator()(f32x4 (&acc)[G_MI][G_NJ], int rbase, int cbase, int lane) const {
    const int fr = lane & 15, fq = lane >> 4;
    const int h = cbase >> 7, part = (cbase >> 6) & 1;
#pragma unroll
    for (int i = 0; i < G_MI; ++i) {
      if (rbase + i * 16 >= NKEY) continue;
#pragma unroll
      for (int j = 0; j < G_NJ; ++j) {
        const int row = rbase + i * 16 + fr, c = j * 16 + fq * 4;
        u32x2 w = {pack2(acc[i][j][0], acc[i][j][1]), pack2(acc[i][j][2], acc[i][j][3])};
        if (part == 0) *(u32x2*)(Km + (size_t)row * 768 + h * 96 + c) = w;
        else *(u32x2*)(Vm + (size_t)row * 512 + h * 64 + c) = w;
      }
    }
  }
};

struct EpiRes {
  static constexpr int kMinStores = 0;
  static constexpr bool kPrefetchNext = true;
  const float *xin_ctx, *xin_lat, *gate  ; float* X;
  DI void operator()(f32x4 (&acc)[G_MI][G_NJ], int rbase, int cbase, int lane) const {
    const int fr = lane & 15, fq = lane >> 4;
#pragma unroll
    for (int i = 0; i < G_MI; ++i) {
      const int row = rbase + i * 16 + fr;
      const float* g = gate + cond_idx(rbase + i * 16) * 6144;
      const float* xin = row < NCTX ? xin_ctx + (size_t)row * 1024 : xin_lat + (size_t)(row - NCTX) * 1024;
#pragma unroll
      for (int j = 0; j < G_NJ; ++j) {
        const int col = cbase + j * 16 + fq * 4;
        const f32x4 xv = *(const f32x4*)(xin + col), gv = *(const f32x4*)(g + col);
        f32x4 z;
#pragma unroll
        for (int e = 0; e < 4; ++e) z[e] = ALPHA * xv[e] + gv[e] * acc[i][j][e];
        *(f32x4*)(X + (size_t)row * 1024 + col) = z;
      }
    }
  }
};


struct EpiResLN {
  static constexpr int kMinStores = 0;
  static constexpr bool kPrefetchNext = true;
  const float *xin_ctx, *xin_lat, *gate; float* X;
  const float *lg, *lb, *modsL; int sh_off, sc_off; bf16_t* Hb;
  float* xbuf; unsigned* cnt; char* smem; bool fused;
  DI void operator()(f32x4 (&acc)[G_MI][G_NJ], int rbase, int cbase, int lane) const {
    const int tid = threadIdx.x, wid = tid >> 6, wr = wid >> 2, wc = wid & 3, fr = lane & 15, fq = lane >> 4;
#pragma unroll
    for (int i = 0; i < G_MI; ++i) {
      const int row = rbase + i * 16 + fr;
      const float* g = gate + cond_idx(rbase + i * 16) * 6144;
      const float* xin = row < NCTX ? xin_ctx + (size_t)row * 1024 : xin_lat + (size_t)(row - NCTX) * 1024;
#pragma unroll
      for (int j = 0; j < G_NJ; ++j) {
        const int col = cbase + j * 16 + fq * 4;
        const f32x4 xv = *(const f32x4*)(xin + col), gv = *(const f32x4*)(g + col);
#pragma unroll
        for (int e = 0; e < 4; ++e) acc[i][j][e] = ALPHA * xv[e] + gv[e] * acc[i][j][e];
        if (!fused) *(f32x4*)(X + (size_t)row * 1024 + col) = acc[i][j];
      }
    }
    if (!fused) return;
    const int row0 = rbase - wr * 96, pm = row0 / G_BM, pn = (cbase - wc * 64) / G_BN;
    f32x2* part = (f32x2*)smem;
    f32x2* stat = (f32x2*)(smem + 8192);
#pragma unroll
    for (int i = 0; i < G_MI; ++i) {
      float s1 = 0.f, s2 = 0.f;
#pragma unroll
      for (int j = 0; j < G_NJ; ++j)
#pragma unroll
        for (int e = 0; e < 4; ++e) { const float v = acc[i][j][e]; s1 += v; s2 += v * v; }
      s1 += __shfl_xor(s1, 16); s2 += __shfl_xor(s2, 16);
      s1 += __shfl_xor(s1, 32); s2 += __shfl_xor(s2, 32);
      if (fq == 0) part[(wr * 96 + i * 16 + fr) * 4 + wc] = (f32x2){s1, s2};
    }
    __syncthreads();
    if (tid < G_BM) {
      const f32x2 a = part[tid * 4 + 0], b = part[tid * 4 + 1], c = part[tid * 4 + 2], d = part[tid * 4 + 3];
      const float s1 = (a[0] + b[0]) + (c[0] + d[0]), s2 = (a[1] + b[1]) + (c[1] + d[1]);
      const unsigned long long pk = ((unsigned long long)__float_as_uint(s2) << 32) | (unsigned long long)__float_as_uint(s1);
      __hip_atomic_store((unsigned long long*)(xbuf + ((size_t)(pm * 4 + pn) * G_BM + tid) * 2), pk, __ATOMIC_RELAXED, __HIP_MEMORY_SCOPE_AGENT);
    }
    asm volatile("s_waitcnt vmcnt(0)" ::: "memory");
    __syncthreads();
    if (tid == 0) {
      __hip_atomic_fetch_add(cnt + pm, 1u, __ATOMIC_RELAXED, __HIP_MEMORY_SCOPE_AGENT);
      unsigned sp = 0;
      while (__hip_atomic_load(cnt + pm, __ATOMIC_RELAXED, __HIP_MEMORY_SCOPE_AGENT) < 4u) { __builtin_amdgcn_s_sleep(1); if (++sp > (1u << 22)) break; }
    }
    __syncthreads();
    if (tid < G_BM) {
      float s1 = 0.f, s2 = 0.f;
#pragma unroll
      for (int q = 0; q < 4; ++q) {
        const unsigned long long pk = __hip_atomic_load((unsigned long long*)(xbuf + ((size_t)(pm * 4 + q) * G_BM + tid) * 2), __ATOMIC_RELAXED, __HIP_MEMORY_SCOPE_AGENT);
        s1 += __uint_as_float((unsigned)pk); s2 += __uint_as_float((unsigned)(pk >> 32));
      }
      const float mean = s1 * (1.f / 1024.f);
      const float var = fmaxf(s2 * (1.f / 1024.f) - mean * mean, 0.f);
      stat[tid] = (f32x2){mean, rsqrtf(var + EPS)};
    }
    __syncthreads();
#pragma unroll
    for (int i = 0; i < G_MI; ++i) {
      const int row = rbase + i * 16 + fr;
      const f32x2 ms = stat[wr * 96 + i * 16 + fr];
      const float* m = modsL + cond_idx(rbase + i * 16) * 6144;
#pragma unroll
      for (int j = 0; j < G_NJ; ++j) {
        const int col = cbase + j * 16 + fq * 4;
        const f32x4 gv = *(const f32x4*)(lg + col), bv = *(const f32x4*)(lb + col);
        f32x4 x;
#pragma unroll
        for (int e = 0; e < 4; ++e) x[e] = (acc[i][j][e] - ms[0]) * ms[1] * gv[e] + bv[e];
        *(f32x4*)(X + (size_t)row * 1024 + col) = x;
        if (Hb) {
          const f32x4 sh = *(const f32x4*)(m + sh_off + col), sc = *(const f32x4*)(m + sc_off + col);
          u32x2 w = {pack2(x[0] * (1.f + sc[0]) + sh[0], x[1] * (1.f + sc[1]) + sh[1]), pack2(x[2] * (1.f + sc[2]) + sh[2], x[3] * (1.f + sc[3]) + sh[3])};
          *(u32x2*)(Hb + (size_t)row * 1024 + col) = w;
        }
      }
    }
    __syncthreads();
  }
};

struct EpiRelu2 {
  static constexpr int kMinStores = 0;
  static constexpr bool kPrefetchNext = false;
  bf16_t* U; char* lds;
  DI void operator()(f32x4 (&acc)[G_MI][G_NJ], int rbase, int cbase, int lane) const {
    const int fr = lane & 15, fq = lane >> 4, wid = threadIdx.x >> 6;
    char* w = lds + wid * (96 * 144);
#pragma unroll
    for (int i = 0; i < G_MI; ++i)
#pragma unroll
      for (int j = 0; j < G_NJ; ++j) {
        f32x4 v = acc[i][j];
#pragma unroll
        for (int e = 0; e < 4; ++e) { const float r = fmaxf(v[e], 0.f); v[e] = r * r; }
        *(u32x2*)(w + (i * 16 + fr) * 144 + (j * 16 + fq * 4) * 2) = (u32x2){pack2(v[0], v[1]), pack2(v[2], v[3])};
      }
    const int rr = lane >> 3, ch = lane & 7;
#pragma unroll
    for (int it = 0; it < 12; ++it) {
      const int r = it * 8 + rr;
      const u32x4 v = *(const u32x4*)(w + r * 144 + ch * 16);
      *(u32x4*)(U + (size_t)(rbase + r) * 4096 + cbase + ch * 8) = v;
    }
    lds_barrier();
  }
};

struct EpiConv {
  static constexpr int kMinStores = 12;
  static constexpr bool kPrefetchNext = true;
  bf16_t *Ug, *Pz;
  DI void operator()(f32x4 (&acc)[G_MI][G_NJ], int rbase, int cbase, int lane) const {
    const int fr = lane & 15, fq = lane >> 4;
#pragma unroll
    for (int i = 0; i < G_MI; ++i) {
      const int row = rbase + i * 16 + fr;
      if (cbase < 1024) {
#pragma unroll
        for (int jp = 0; jp < 2; ++jp) {
          const f32x4 a = acc[i][2 * jp], gt = acc[i][2 * jp + 1];
          f32x4 u;
#pragma unroll
          for (int e = 0; e < 4; ++e) u[e] = a[e] / (1.f + __expf(-gt[e]));
          const int ch = ((cbase + 32 * jp) >> 5) * 16 + fq * 4;
          u32x2 w = {pack2(u[0], u[1]), pack2(u[2], u[3])};
          *(u32x2*)(Ug + (size_t)row * 512 + ch) = w;
        }
      } else {
#pragma unroll
        for (int j = 0; j < G_NJ; ++j) {
          const int col = cbase - 1024 + j * 16 + fq * 4;
          u32x2 w = {pack2(acc[i][j][0], acc[i][j][1]), pack2(acc[i][j][2], acc[i][j][3])};
          *(u32x2*)(Pz + (size_t)row * 512 + col) = w;
        }
      }
    }
  }
};

#ifndef XCD_ORDER
#define XCD_ORDER 1
#endif
template <class Epi>
DI void gemm_phase(const bf16_t* A, int lda, const bf16_t* Bt, int ldb, int K, int mt, int nt, const Epi& epi, char* smem, int tstart = 0, int ttotal = -1) {
  const int n = mt * nt;
  if (ttotal < 0) ttotal = n;
  const bool xo = XCD_ORDER && gridDim.x == 256 && (nt & 3) == 0 && (mt & 3) == 0 && n % 256 == 0;
  auto coords = [&](int u, int& r0, int& c0) {
    int pm = u / nt, pn = u - pm * nt;
    if (xo) {
      const int r = u >> 8, w = u & 255, x = w & 7, idx = w >> 3;
      const int rows_r = 256 / nt, pw = nt < 8 ? nt : 8, ph = 32 / pw, npx = nt / pw, px = x % npx, py = x / npx;
      pm = r * rows_r + py * ph + idx / pw; pn = px * pw + idx % pw;
    }
    r0 = pm * G_BM; c0 = pn * G_BN;
  };
  int t = blockIdx.x;
  while (t < tstart) t += gridDim.x;
  bool prefetched = false;
  while (t < tstart + n && t < ttotal) {
    const int tn = t + gridDim.x;
    const bool has_next = Epi::kPrefetchNext && tn < tstart + n && tn < ttotal;
    int r0, c0, nr0 = 0, nc0 = 0;
    coords(t - tstart, r0, c0);
    if (has_next) coords(tn - tstart, nr0, nc0);
    gemm_tile(A, lda, Bt, ldb, K, r0, c0, smem, epi, prefetched, has_next, nr0, nc0);
    prefetched = has_next;
    t = tn;
  }
}

DI void rows_phase(const float* src_ctx, const float* src_lat, bool do_ln, const float* lg, const float* lb, float* Xdst,
                   const float* modsL, int sh_off, int sc_off, bf16_t* Hb) {
  const int lane = threadIdx.x & 63, gw = blockIdx.x * NWAVE + (threadIdx.x >> 6), nw = gridDim.x * NWAVE;
  for (int row = gw; row < NTOK; row += nw) {
    const float* src = row < NCTX ? src_ctx + (size_t)row * 1024 : src_lat + (size_t)(row - NCTX) * 1024;
    f32x4 v[4];
#pragma unroll
    for (int i = 0; i < 4; ++i) v[i] = *(const f32x4*)(src + i * 256 + lane * 4);
    if (do_ln) {
      float s = 0.f;
#pragma unroll
      for (int i = 0; i < 4; ++i) s += (v[i][0] + v[i][1]) + (v[i][2] + v[i][3]);
      const float mean = wave_sum(s) * (1.f / 1024.f);
      float q = 0.f;
#pragma unroll
      for (int i = 0; i < 4; ++i)
#pragma unroll
        for (int e = 0; e < 4; ++e) { const float d = v[i][e] - mean; q += d * d; }
      const float rstd = rsqrtf(wave_sum(q) * (1.f / 1024.f) + EPS);
#pragma unroll
      for (int i = 0; i < 4; ++i) {
        const f32x4 g = *(const f32x4*)(lg + i * 256 + lane * 4), b = *(const f32x4*)(lb + i * 256 + lane * 4);
#pragma unroll
        for (int e = 0; e < 4; ++e) v[i][e] = (v[i][e] - mean) * rstd * g[e] + b[e];
        if (Xdst) *(f32x4*)(Xdst + (size_t)row * 1024 + i * 256 + lane * 4) = v[i];
      }
    }
    if (Hb) {
      const float* m = modsL + cond_idx(row) * 6144;
#pragma unroll
      for (int i = 0; i < 4; ++i) {
        const int col = i * 256 + lane * 4;
        const f32x4 sh = *(const f32x4*)(m + sh_off + col), sc = *(const f32x4*)(m + sc_off + col);
        f32x4 h;
#pragma unroll
        for (int e = 0; e < 4; ++e) h[e] = v[i][e] * (1.f + sc[e]) + sh[e];
        u32x2 w = {pack2(h[0], h[1]), pack2(h[2], h[3])};
        *(u32x2*)(Hb + (size_t)row * 1024 + col) = w;
      }
    }
  }
}

DI void modulate_phase(const float* __restrict__ src_ctx, const float* __restrict__ src_lat, const float* __restrict__ modsL, bf16_t* __restrict__ Hb) {
  const int lane = threadIdx.x & 63, gw = blockIdx.x * NWAVE + (threadIdx.x >> 6), nw = gridDim.x * NWAVE;
  for (int r0 = gw * 2; r0 < NTOK; r0 += nw * 2) {
    f32x4 v[2][4];
#pragma unroll
    for (int k = 0; k < 2; ++k) {
      const int row = r0 + k;
      const float* src = row < NCTX ? src_ctx + (size_t)row * 1024 : src_lat + (size_t)(row - NCTX) * 1024;
#pragma unroll
      for (int i = 0; i < 4; ++i) v[k][i] = __builtin_nontemporal_load((const f32x4*)(src + i * 256 + lane * 4));
    }
#pragma unroll
    for (int k = 0; k < 2; ++k) {
      const int row = r0 + k;
      const float* m = modsL + cond_idx(row) * 6144;
#pragma unroll
      for (int i = 0; i < 4; ++i) {
        const int col = i * 256 + lane * 4;
        const f32x4 sh = *(const f32x4*)(m + col), sc = *(const f32x4*)(m + 1024 + col);
        u32x2 w = {pack2(v[k][i][0] * (1.f + sc[0]) + sh[0], v[k][i][1] * (1.f + sc[1]) + sh[1]), pack2(v[k][i][2] * (1.f + sc[2]) + sh[2], v[k][i][3] * (1.f + sc[3]) + sh[3])};
        *(u32x2*)(Hb + (size_t)row * 1024 + col) = w;
      }
    }
  }
}

DI double sin_red(double r) {
  const double r2 = r * r; double t = -1.0 / 51090942171709440000.0;
  t = t * r2 + 1.0 / 121645100408832000.0; t = t * r2 - 1.0 / 355687428096000.0; t = t * r2 + 1.0 / 1307674368000.0; t = t * r2 - 1.0 / 6227020800.0;
  t = t * r2 + 1.0 / 39916800.0; t = t * r2 - 1.0 / 362880.0; t = t * r2 + 1.0 / 5040.0; t = t * r2 - 1.0 / 120.0; t = t * r2 + 1.0 / 6.0;
  return r * (1.0 - r2 * t);
}
DI double cos_red(double r) {
  const double r2 = r * r; double t = 1.0 / 1124000727777607680000.0;
  t = t * r2 - 1.0 / 2432902008176640000.0; t = t * r2 + 1.0 / 6402373705728000.0; t = t * r2 - 1.0 / 20922789888000.0; t = t * r2 + 1.0 / 87178291200.0;
  t = t * r2 - 1.0 / 479001600.0; t = t * r2 + 1.0 / 3628800.0; t = t * r2 - 1.0 / 40320.0; t = t * r2 + 1.0 / 720.0; t = t * r2 - 1.0 / 24.0; t = t * r2 + 0.5; t = t * r2 * -1.0 + 1.0;
  return t;
}

constexpr int J_MODS = 192, J_WEFF = 64, J_CACHE = 64, J_ROPE = 1, J_SLOW = J_MODS + J_WEFF + J_CACHE + J_ROPE;
constexpr int T_ATTIN = 16 * 16, T_UQ = 4 * 6, T_UKV = 2 * 8, T_ATTOUT = 16 * 8, T_MLPIN = 16 * 32, T_MLPOUT = 64 * 8, T_CONVIN = 16 * 12, T_CONVOUT = 8 * 8;
constexpr int J_TR = T_ATTIN + T_UQ + T_UKV + T_ATTOUT + 2 * T_MLPIN + 2 * T_MLPOUT + T_CONVIN + T_CONVOUT;

struct TJ { const float* src; bf16_t* dst; int N, nvalid, lddst, perm, kt, nt; };
DI TJ tr_decode(const Params& p, int j) {
  char* ws = p.ws;
  TJ t; t.perm = 0;
  if (j < T_ATTIN) { t.src = p.w_att_in; t.N = 1952; t.nvalid = 1952; t.dst = (bf16_t*)(ws + O_WATTIN); t.lddst = 1024; t.kt = j / 16; t.nt = j % 16; return t; }
  j -= T_ATTIN;
  if (j < T_UQ) { t.src = p.w_uq; t.N = 768; t.nvalid = 768; t.dst = (bf16_t*)(ws + O_WUQ); t.lddst = 256; t.kt = j / 6; t.nt = j % 6; return t; }
  j -= T_UQ;
  if (j < T_UKV) { t.src = p.w_ukv; t.N = 1024; t.nvalid = 1024; t.dst = (bf16_t*)(ws + O_WUKV); t.lddst = 128; t.kt = j / 8; t.nt = j % 8; return t; }
  j -= T_UKV;
  if (j < T_ATTOUT) { t.src = p.w_att_out; t.N = 1024; t.nvalid = 1024; t.dst = (bf16_t*)(ws + O_WATTOUT); t.lddst = 1024; t.kt = j / 8; t.nt = j % 8; return t; }
  j -= T_ATTOUT;
  if (j < 2 * T_MLPIN) { const int l = j / T_MLPIN, u = j % T_MLPIN; t.src = p.w_mlp_in + (size_t)l * 1024 * 4096; t.N = 4096; t.nvalid = 4096; t.dst = (bf16_t*)(ws + O_WMLPIN) + (size_t)l * 4096 * 1024; t.lddst = 1024; t.kt = u / 32; t.nt = u % 32; return t; }
  j -= 2 * T_MLPIN;
  if (j < 2 * T_MLPOUT) { const int l = j / T_MLPOUT, u = j % T_MLPOUT; t.src = p.w_mlp_out + (size_t)l * 4096 * 1024; t.N = 1024; t.nvalid = 1024; t.dst = (bf16_t*)(ws + O_WMLPOUT) + (size_t)l * 4096 * 1024; t.lddst = 4096; t.kt = u / 8; t.nt = u % 8; return t; }
  j -= 2 * T_MLPOUT;
  if (j < T_CONVIN) { t.src = p.w_conv_in; t.N = 1536; t.nvalid = 1536; t.dst = (bf16_t*)(ws + O_WCONVIN); t.lddst = 1024; t.perm = 1; t.kt = j / 12; t.nt = j % 12; return t; }
  j -= T_CONVIN;
  t.src = p.w_conv_out; t.N = 1024; t.nvalid = 1024; t.dst = (bf16_t*)(ws + O_WCONVOUT); t.lddst = 1024; t.kt = j / 8; t.nt = j % 8; return t;
}
DI void tr_load(const TJ& t, float (&v)[16]) {
  const int tid = threadIdx.x, n = tid & 127, kb = tid >> 7;
  const int gn = t.nt * 128 + n;
  const float* s = t.src + (size_t)(t.kt * 64 + kb) * t.N + gn;
#pragma unroll
  for (int i = 0; i < 16; ++i) v[i] = (gn < t.nvalid) ? s[(size_t)(4 * i) * t.N] : 0.f;
}

DI void phase0(const Params& p, char* smem) {
  const int tid = threadIdx.x, lane = tid & 63, wid = tid >> 6;
  char* ws = p.ws;
  for (int job = blockIdx.x; job < J_SLOW; job += gridDim.x) {
    int j = job;
    if (j < J_MODS) {
      const int l = j / 96, cc = j % 96;
      float* sc = (float*)smem;
      for (int i = tid; i < 3072; i += NT) { const int ci = i >> 10, k = i & 1023; const float x = ci == 0 ? p.c_ctx[k] : p.c[(ci - 1) * 1024 + k]; sc[i] = x / (1.f + __expf(-x)); }
      __syncthreads();
      const int kg = tid >> 6, cl = tid & 63;
      const float* w = p.w_ada + (size_t)l * 1024 * 6144 + cc * 64 + cl;
      float s0 = 0.f, s1 = 0.f, s2 = 0.f;
#pragma unroll 16
      for (int k = kg * 128; k < kg * 128 + 128; ++k) { const float wv = w[(size_t)k * 6144]; s0 += sc[k] * wv; s1 += sc[1024 + k] * wv; s2 += sc[2048 + k] * wv; }
      float* r = (float*)(smem + 12288);
      r[(kg * 3 + 0) * 64 + cl] = s0; r[(kg * 3 + 1) * 64 + cl] = s1; r[(kg * 3 + 2) * 64 + cl] = s2;
      __syncthreads();
      if (tid < 192) {
        const int ci = tid >> 6, c2 = tid & 63;
        float s = 0.f;
#pragma unroll
        for (int g = 0; g < 8; ++g) s += r[(g * 3 + ci) * 64 + c2];
        ((float*)(ws + O_MODS))[(size_t)(l * 3 + ci) * 6144 + cc * 64 + c2] = s + p.b_ada[l * 6144 + cc * 64 + c2];
      }
      __syncthreads();
      continue;
    }
    j -= J_MODS;
    if (j < J_WEFF) {
      const int g = j >> 4, cch = (j >> 1) & 7, nch = j & 1;
      float* wp = (float*)smem;
      for (int i = tid; i < 2048; i += NT) wp[i] = p.w_pool[(size_t)(g * 128 + cch * 16 + (i >> 7)) * 128 + (i & 127)];
      __syncthreads();
      const int n = nch * 512 + tid;
      float a[16];
#pragma unroll
      for (int c = 0; c < 16; ++c) a[c] = 0.f;
#pragma unroll 16
      for (int e = 0; e < 128; ++e) {
        const float wo = p.w_conv_out[(size_t)(512 + g * 128 + e) * 1024 + n] * p.pool_scale[g * 128 + e];
#pragma unroll
        for (int c = 0; c < 16; ++c) a[c] += wp[c * 128 + e] * wo;
      }
      bf16_t* d = (bf16_t*)(ws + O_WCONVOUT) + (size_t)n * 1024 + 512 + g * 128 + cch * 16;
      *(u32x4*)d = (u32x4){pack2(a[0], a[1]), pack2(a[2], a[3]), pack2(a[4], a[5]), pack2(a[6], a[7])};
      *(u32x4*)(d + 8) = (u32x4){pack2(a[8], a[9]), pack2(a[10], a[11]), pack2(a[12], a[13]), pack2(a[14], a[15])};
      __syncthreads();
      continue;
    }
    j -= J_WEFF;
    if (j < J_CACHE) {
      const int rr = j * 8 + wid, b = rr >> 8, t = rr & 255;
      const size_t kr = NCTX + (size_t)b * TKL + t;
      const f32x4 a0 = *(const f32x4*)(p.cache_k + (size_t)rr * 512 + lane * 8), a1 = *(const f32x4*)(p.cache_k + (size_t)rr * 512 + lane * 8 + 4);
      *(u32x4*)((bf16_t*)(ws + O_KD) + kr * 512 + lane * 8) = (u32x4){pack2(a0[0], a0[1]), pack2(a0[2], a0[3]), pack2(a1[0], a1[1]), pack2(a1[2], a1[3])};
      const f32x4 b0 = *(const f32x4*)(p.cache_v + (size_t)rr * 512 + lane * 8), b1 = *(const f32x4*)(p.cache_v + (size_t)rr * 512 + lane * 8 + 4);
      *(u32x4*)((bf16_t*)(ws + O_VD) + kr * 512 + lane * 8) = (u32x4){pack2(b0[0], b0[1]), pack2(b0[2], b0[3]), pack2(b1[0], b1[1]), pack2(b1[2], b1[3])};
      const f32x2 cv = *(const f32x2*)(p.cache_ckv + (size_t)rr * 128 + lane * 2);
      *(unsigned*)((bf16_t*)(ws + O_CKVN) + kr * 128 + lane * 2) = pack2(cv[0], cv[1]);
      const int idx = lane & 31;
      const float x = p.cache_krope[(size_t)rr * 32 + idx];
      const unsigned pk = pack2(x, x);
#pragma unroll
      for (int k = 0; k < 4; ++k) { const int hh = (lane >> 5) + 2 * k; ((bf16_t*)(ws + O_KMLA))[kr * 768 + hh * 96 + 64 + idx] = (bf16_t)(pk & 0xffff); }
      continue;
    }
    j -= J_CACHE;
    {
      float* c16 = (float*)(ws + O_C16); float* s16 = (float*)(ws + O_S16); float* c8 = (float*)(ws + O_C8); float* s8 = (float*)(ws + O_S8);
      for (int i = tid; i < 1024 + 512; i += NT) {
        int pos, f, half;
        if (i < 1024) { pos = i >> 4; f = i & 15; half = 16; } else { const int q = i - 1024; pos = q >> 3; f = q & 7; half = 8; }
        const float inv = (float)exp(-9.210340371976184 * (double)f / (double)half);
        const float angf = (float)pos * inv;
        const double ang = (double)angf;
        const double r = ang - 6.283185307179586 * rint(ang * 0.15915494309189535);
        const float cs = (float)cos_red(r), sn = (float)sin_red(r);
        if (i < 1024) { c16[i] = cs; s16[i] = sn; } else { c8[i - 1024] = cs; s8[i - 1024] = sn; }
      }
      if (wid == 0) {
        const float d1 = wave_sum(p.lam_q1[lane] * p.lam_k1[lane]), d2 = wave_sum(p.lam_q2[lane] * p.lam_k2[lane]);
        if (lane == 0) ((float*)(ws + O_SCAL))[0] = expf(d1) - expf(d2) + 0.2f;
      }
    }
  }
  {
    float* tile = (float*)smem;
    const int G = gridDim.x;
    int j = (blockIdx.x + G - (J_SLOW % G)) % G;
    float va[16], vb[16];
    TJ ta, tb;
    if (j < J_TR) { ta = tr_decode(p, j); tr_load(ta, va); } else ta = TJ{};
    if (j + G < J_TR) { tb = tr_decode(p, j + G); tr_load(tb, vb); } else tb = ta;
#define TR_STEP(V, T, jj_) do { \
      { const int n = tid & 127, kb = tid >> 7; \
        _Pragma("unroll") for (int i = 0; i < 16; ++i) tile[(kb + 4 * i) * 129 + n] = V[i]; } \
      __syncthreads(); \
      const TJ cur = T; \
      if ((jj_) + 2 * G < J_TR) { T = tr_decode(p, (jj_) + 2 * G); tr_load(T, V); }     \
      { const int n = tid >> 2, ks = (tid & 3) * 16; \
        int gn = cur.nt * 128 + n; \
        if (cur.perm) { if (gn < 512) gn = 32 * (gn >> 4) + (gn & 15); else if (gn < 1024) { const int c = gn - 512; gn = 32 * (c >> 4) + 16 + (c & 15); } } \
        unsigned w[8]; \
        _Pragma("unroll") for (int e = 0; e < 8; ++e) w[e] = pack2(tile[(ks + 2 * e) * 129 + n], tile[(ks + 2 * e + 1) * 129 + n]); \
        bf16_t* d = cur.dst + (size_t)gn * cur.lddst + cur.kt * 64 + ks; \
        *(u32x4*)d = (u32x4){w[0], w[1], w[2], w[3]}; \
        *(u32x4*)(d + 8) = (u32x4){w[4], w[5], w[6], w[7]}; } \
      __syncthreads(); } while (0)
    while (j < J_TR) {
      TR_STEP(va, ta, j);
      j += G;
      if (j >= J_TR) break;
      TR_STEP(vb, tb, j);
      j += G;
    }
#undef TR_STEP
  }
}

DI void rope8(const float (&x)[8], float (&o)[8], int lane, const float* c16, const float* s16, int prow, int pcol) {
  const int L = lane & 7;
  const int pos = (L & 4) ? pcol : prow;
  const bool second = (L & 2) != 0;
  const int fb = (L & 1) * 8;
#pragma unroll
  for (int e = 0; e < 8; ++e) {
    const float y = __shfl_xor(x[e], 2);
    const float cs = c16[pos * 16 + fb + e], sn = s16[pos * 16 + fb + e];
    o[e] = second ? (y * sn + x[e] * cs) : (x[e] * cs - y * sn);
  }
}
DI void unpack8(const u32x4 w, float (&x)[8]) {
#pragma unroll
  for (int e = 0; e < 4; ++e) { x[2 * e] = bflo(w[e]); x[2 * e + 1] = bfhi(w[e]); }
}
DI u32x4 pack8(const float (&x)[8]) { return (u32x4){pack2(x[0], x[1]), pack2(x[2], x[3]), pack2(x[4], x[5]), pack2(x[6], x[7])}; }

DI void phase3(const Params& p) {
  char* ws = p.ws;
  const bf16_t* R = (const bf16_t*)(ws + O_R);
  bf16_t* Qda = (bf16_t*)(ws + O_QDA); bf16_t* Qdb = (bf16_t*)(ws + O_QDB); bf16_t* Kd = (bf16_t*)(ws + O_KD); bf16_t* Vd = (bf16_t*)(ws + O_VD);
  bf16_t* cqn = (bf16_t*)(ws + O_CQN); bf16_t* ckvn = (bf16_t*)(ws + O_CKVN); bf16_t* Km = (bf16_t*)(ws + O_KMLA);
  const float* c16 = (const float*)(ws + O_C16); const float* s16 = (const float*)(ws + O_S16); const float* c8 = (const float*)(ws + O_C8); const float* s8 = (const float*)(ws + O_S8);
  float* o_k = p.out + (size_t)NTOK * 1024; float* o_v = o_k + (size_t)NCTX * 512; float* o_ckv = o_v + (size_t)NCTX * 512; float* o_kr = o_ckv + (size_t)NCTX * 128;
  const int lane = threadIdx.x & 63, gw = blockIdx.x * NWAVE + (threadIdx.x >> 6), nw = gridDim.x * NWAVE;
  for (int row = gw; row < NTOK; row += nw) {
    const bool lat = row >= NCTX;
    const int rl = row - NCTX, b = rl >> 12, t = rl & (TLAT - 1), prow = t >> 6, pcol = t & 63;
    const size_t kr = lat ? (size_t)NCTX + (size_t)b * TKL + 256 + t : (size_t)row;
    const bf16_t* r = R + (size_t)row * RLD;
    float x[8], o[8];
    const u32x4 wq = *(const u32x4*)(r + lane * 8);
    *(u32x4*)(Qda + (size_t)row * 512 + lane * 8) = wq;
    if (lat) { unpack8(wq, x); rope8(x, o, lane, c16, s16, prow, pcol); *(u32x4*)(Qdb + (size_t)rl * 512 + lane * 8) = pack8(o); }
    const u32x4 wk = *(const u32x4*)(r + 512 + lane * 8);
    if (lat) { unpack8(wk, x); rope8(x, o, lane, c16, s16, prow, pcol); *(u32x4*)(Kd + kr * 512 + lane * 8) = pack8(o); }
    else {
      unpack8(wk, x);
      *(f32x4*)(o_k + (size_t)row * 512 + lane * 8) = (f32x4){x[0], x[1], x[2], x[3]};
      *(f32x4*)(o_k + (size_t)row * 512 + lane * 8 + 4) = (f32x4){x[4], x[5], x[6], x[7]};
      *(u32x4*)(Kd + kr * 512 + lane * 8) = wk;
    }
    const u32x4 wv = *(const u32x4*)(r + 1024 + lane * 8);
    *(u32x4*)(Vd + kr * 512 + lane * 8) = wv;
    if (!lat) {
      unpack8(wv, x);
      *(f32x4*)(o_v + (size_t)row * 512 + lane * 8) = (f32x4){x[0], x[1], x[2], x[3]};
      *(f32x4*)(o_v + (size_t)row * 512 + lane * 8 + 4) = (f32x4){x[4], x[5], x[6], x[7]};
    }
    {
      const u32x2 w = *(const u32x2*)(r + 1536 + lane * 4);
      const float a0 = bflo(w[0]), a1 = bfhi(w[0]), a2 = bflo(w[1]), a3 = bfhi(w[1]);
      const float ss = wave_sum(a0 * a0 + a1 * a1 + a2 * a2 + a3 * a3);
      const float sc = rsqrtf(ss * (1.f / 256.f) + EPS);
      const f32x4 g = *(const f32x4*)(p.q_norm_g + lane * 4);
      *(u32x2*)(cqn + (size_t)row * 256 + lane * 4) = (u32x2){pack2(a0 * sc * g[0], a1 * sc * g[1]), pack2(a2 * sc * g[2], a3 * sc * g[3])};
    }
    {
      const unsigned w = *(const unsigned*)(r + 1792 + lane * 2);
      const float a0 = bflo(w), a1 = bfhi(w);
      const float ss = wave_sum(a0 * a0 + a1 * a1);
      const float sc = rsqrtf(ss * (1.f / 128.f) + EPS);
      const f32x2 g = *(const f32x2*)(p.kv_norm_g + lane * 2);
      const float y0 = a0 * sc * g[0], y1 = a1 * sc * g[1];
      if (!lat) *(f32x2*)(o_ckv + (size_t)row * 128 + lane * 2) = (f32x2){y0, y1};
      *(unsigned*)(ckvn + kr * 128 + lane * 2) = pack2(y0, y1);
    }
    {
      const int idx = lane & 31;
      const float xv = bf2f(r[1920 + idx]);
      float ov = xv;
      if (lat) {
        const int pos = (idx & 16) ? pcol : prow;
        const int f = idx & 7;
        const float y = __shfl_xor(xv, 8);
        const float cs = c8[pos * 8 + f], sn = s8[pos * 8 + f];
        ov = (idx & 8) ? (y * sn + xv * cs) : (xv * cs - y * sn);
      } else if (lane < 32) o_kr[(size_t)row * 32 + idx] = xv;
      const bf16_t ob = (bf16_t)(pack2(ov, ov) & 0xffff);
#pragma unroll
      for (int k = 0; k < 4; ++k) { const int hh = (lane >> 5) + 2 * k; Km[kr * 768 + hh * 96 + 64 + idx] = ob; }
    }
  }
}

template <int DQK, int DV>
DI void attn_core(const bf16_t* __restrict__ Qa, const bf16_t* __restrict__ Qb, int ldq, const bf16_t* __restrict__ Kp, int ldk, const bf16_t* __restrict__ Vp, int ldv,
                  int Tk, int n_a, float c  , char* smem, f32x16 (&o)[DV / 32]) {
  constexpr int KS = DQK * 2 + 16, VS = DV * 2 + 64, BUF = 64 * (KS + VS);
  constexpr int KCH = DQK / 8, VCH = DV / 8, NKCH = 64 * KCH, NVCH = 64 * VCH, NKC = (NKCH + NT - 1) / NT, NVC = (NVCH + NT - 1) / NT;
  constexpr bool KG = (NKCH % NT) != 0, VG = (NVCH % NT) != 0;
  constexpr int NS = DQK / 16, NDT = DV / 32;
  const int tid = threadIdx.x, lane = tid & 63, wid = tid >> 6, h = lane >> 5, ql = lane & 31;
  bf16x8 qf[NS];
  {
    const bf16_t* q = Qa + (size_t)(wid * 32 + ql) * ldq + h * 8;
#pragma unroll
    for (int s = 0; s < NS; ++s) qf[s] = *(const bf16x8*)(q + s * 16);
  }
#pragma unroll
  for (int dt = 0; dt < NDT; ++dt)
#pragma unroll
    for (int r = 0; r < 16; ++r) o[dt][r] = 0.f;
  float m_run = -INFINITY, l_run = 0.f;
  u32x4 rkA[NKC], rvA[NVC], rkB[NKC], rvB[NVC];
  const int nt = Tk >> 6, ta = n_a >> 6;
  unsigned koff[NKC], voff[NVC];
#pragma unroll
  for (int i = 0; i < NKC; ++i) { const int ch = (tid + NT * i) % NKCH, row = ch / KCH, kc = ch % KCH; koff[i] = (unsigned)(row * ldk + kc * 8); }
#pragma unroll
  for (int i = 0; i < NVC; ++i) { const int ch = (tid + NT * i) % NVCH, row = ch / VCH, vc = ch % VCH; voff[i] = (unsigned)(row * ldv + vc * 8); }
  auto gload = [&](u32x4 (&rk)[NKC], u32x4 (&rv)[NVC], int t) {
    const bf16_t* kb = Kp + (size_t)t * 64 * ldk;
    const bf16_t* vbp = Vp + (size_t)t * 64 * ldv;
#pragma unroll
    for (int i = 0; i < NKC; ++i) rk[i] = *(const u32x4*)(kb + koff[i]);
#pragma unroll
    for (int i = 0; i < NVC; ++i) rv[i] = *(const u32x4*)(vbp + voff[i]);
  };
  auto lstore = [&](u32x4 (&rk)[NKC], u32x4 (&rv)[NVC], char* buf) {
#pragma unroll
    for (int i = 0; i < NKC; ++i) { const int ch = tid + NT * i, row = ch / KCH, kc = ch % KCH; if (!KG || i + 1 < NKC || ch < NKCH) *(u32x4*)(buf + row * KS + kc * 16) = rk[i]; }
#pragma unroll
    for (int i = 0; i < NVC; ++i) { const int ch = tid + NT * i, row = ch / VCH, vc = ch % VCH; if (!VG || i + 1 < NVC || ch < NVCH) *(u32x4*)(buf + 64 * KS + row * VS + vc * 16) = rv[i]; }
  };
  gload(rkA, rvA, 0); lstore(rkA, rvA, smem); lds_barrier();
  gload(rkA, rvA, min(1, nt - 1));
  const int i16 = lane & 15, tq = i16 >> 2, tp = i16 & 3, G = (lane >> 4) & 1;
  auto compute = [&](const char* cur) {
    f32x16 st[2];
    bf16x8 kf[2][NS];
#pragma unroll
    for (int kt = 0; kt < 2; ++kt)
#pragma unroll
      for (int s = 0; s < NS; ++s) kf[kt][s] = *(const bf16x8*)(cur + (kt * 32 + ql) * KS + s * 32 + h * 16);
#pragma unroll
    for (int kt = 0; kt < 2; ++kt) {
#pragma unroll
      for (int r = 0; r < 16; ++r) st[kt][r] = 0.f;
#pragma unroll
      for (int s = 0; s < NS; ++s) st[kt] = __builtin_amdgcn_mfma_f32_32x32x16_bf16(kf[kt][s], qf[s], st[kt], 0, 0, 0);
    }
    __builtin_amdgcn_sched_barrier(0);
    float mx = st[0][0];
#pragma unroll
    for (int kt = 0; kt < 2; ++kt)
#pragma unroll
      for (int r = 0; r < 16; ++r) mx = fmaxf(mx, st[kt][r]);
    mx = fmaxf(mx, __shfl_xor(mx, 32));
    const float m_new = fmaxf(m_run, mx);
    const float alpha = __builtin_amdgcn_exp2f((m_run - m_new) * c);
    const float mc = m_new * c;
    m_run = m_new;
    float ls = 0.f;
#pragma unroll
    for (int kt = 0; kt < 2; ++kt)
#pragma unroll
      for (int r = 0; r < 16; ++r) { const float pv = __builtin_amdgcn_exp2f(st[kt][r] * c - mc); st[kt][r] = pv; ls += pv; }
    l_run = l_run * alpha + ls;
    if (__any(alpha != 1.f)) {
#pragma unroll
      for (int dt = 0; dt < NDT; ++dt)
#pragma unroll
        for (int r = 0; r < 16; ++r) o[dt][r] *= alpha;
    }
    bf16x8 pf[2][2];
#pragma unroll
    for (int kt = 0; kt < 2; ++kt)
#pragma unroll
      for (int s2 = 0; s2 < 2; ++s2) {
        u32x4 w = {pack2(st[kt][8 * s2 + 0], st[kt][8 * s2 + 1]), pack2(st[kt][8 * s2 + 2], st[kt][8 * s2 + 3]), pack2(st[kt][8 * s2 + 4], st[kt][8 * s2 + 5]), pack2(st[kt][8 * s2 + 6], st[kt][8 * s2 + 7])};
        pf[kt][s2] = __builtin_bit_cast(bf16x8, w);
      }
    const char* vb = cur + 64 * KS + (4 * h + tq) * VS + 32 * G + 8 * tp;
    bf16x8 vfa[NDT], vfb[NDT];
#define A_VLOAD(VF, g_) do { \
      _Pragma("unroll") for (int dt = 0; dt < NDT; ++dt) { \
        const char* a0 = vb + (((g_) >> 1) * 32 + 16 * ((g_) & 1)) * VS + dt * 64; \
        const s16x4 lo = __builtin_amdgcn_ds_read_tr16_b64_v4i16((LDS_AS s16x4*)(a0)); \
        const s16x4 hi = __builtin_amdgcn_ds_read_tr16_b64_v4i16((LDS_AS s16x4*)(a0 + 8 * VS)); \
        VF[dt] = __builtin_shufflevector(lo, hi, 0, 1, 2, 3, 4, 5, 6, 7); } } while (0)
#define A_VMMA(VF, g_) do { \
      _Pragma("unroll") for (int dt = 0; dt < NDT; ++dt) o[dt] = __builtin_amdgcn_mfma_f32_32x32x16_bf16(VF[dt], pf[(g_) >> 1][(g_) & 1], o[dt], 0, 0, 0); } while (0)
    A_VLOAD(vfa, 0);
    A_VLOAD(vfb, 1);
    __builtin_amdgcn_sched_barrier(0);
    A_VMMA(vfa, 0);
    __builtin_amdgcn_sched_barrier(0);
    A_VLOAD(vfa, 2);
    __builtin_amdgcn_sched_barrier(0);
    A_VMMA(vfb, 1);
    __builtin_amdgcn_sched_barrier(0);
    A_VLOAD(vfb, 3);
    __builtin_amdgcn_sched_barrier(0);
    A_VMMA(vfa, 2);
    __builtin_amdgcn_sched_barrier(0);
    A_VMMA(vfb, 3);
#undef A_VLOAD
#undef A_VMMA
  };
  auto run_tiles = [&](int t_begin, int t_end) {
    for (int t = t_begin; t < t_end; t += 2) {
      gload(rkB, rvB, min(t + 2, nt - 1));
      compute(smem);
      lstore(rkA, rvA, smem + BUF);
      lds_barrier();
      gload(rkA, rvA, min(t + 3, nt - 1));
      compute(smem + BUF);
      lstore(rkB, rvB, smem);
      lds_barrier();
    }
  };
  run_tiles(0, min(ta, nt));
  if (ta < nt) {
    const bf16_t* q = Qb + (size_t)(wid * 32 + ql) * ldq + h * 8;
#pragma unroll
    for (int s = 0; s < NS; ++s) qf[s] = *(const bf16x8*)(q + s * 16);
    run_tiles(ta, nt);
  }
  const float l = l_run + __shfl_xor(l_run, 32);
  const float inv = 1.f / l;
#pragma unroll
  for (int dt = 0; dt < NDT; ++dt)
#pragma unroll
    for (int r = 0; r < 16; ++r) o[dt][r] *= inv;
}

constexpr int U_DBIG = 128, U_MBIG = 256, U_DCTX = 64, U_MCTX = 128, U_TOTAL = U_DBIG + U_MBIG + U_DCTX + U_MCTX;

DI void phase_attn(const Params& p, char* smem, int cidx) {
  char* ws = p.ws;
  const bf16_t* Qda = (const bf16_t*)(ws + O_QDA); const bf16_t* Qdb = (const bf16_t*)(ws + O_QDB); const bf16_t* Kd = (const bf16_t*)(ws + O_KD); const bf16_t* Vd = (const bf16_t*)(ws + O_VD);
  const bf16_t* Qma = (const bf16_t*)(ws + O_QMA); const bf16_t* Qmb = (const bf16_t*)(ws + O_QMB); const bf16_t* Km = (const bf16_t*)(ws + O_KMLA); const bf16_t* Vm = (const bf16_t*)(ws + O_VMLA);
  bf16_t* cat = (bf16_t*)(ws + O_HB);
  float* otmp = (float*)(ws + O_OTMP) + (size_t)blockIdx.x * 32768;
  int* counter = (int*)(ws + O_CNT) + cidx;
  int* s_unit = (int*)(smem + 65532);
  const int tid = threadIdx.x, lane = tid & 63, wid = tid >> 6, h2 = lane >> 5, ql = lane & 31;
  const float lam = ((const float*)(ws + O_SCAL))[0];
  for (;;) {
    if (tid == 0) *s_unit = atomicAdd(counter, 1);
    __syncthreads();
    int u = __builtin_amdgcn_readfirstlane(*s_unit);
    __syncthreads();
    if (u >= U_TOTAL) break;
    bool diff; int qrow0, krow0, Tk, n_a, head; bool lat;
    if (u < U_DBIG) { diff = true; lat = true; const int b = u >> 6, hh = (u >> 4) & 3, qb = u & 15; head = hh; qrow0 = NCTX + b * TLAT + qb * 256; krow0 = NCTX + b * TKL; Tk = TKL; n_a = 256; }
    else if (u < U_DBIG + U_MBIG) { u -= U_DBIG; diff = false; lat = true; const int b = u >> 7, hh = (u >> 4) & 7, qb = u & 15; head = hh; qrow0 = NCTX + b * TLAT + qb * 256; krow0 = NCTX + b * TKL; Tk = TKL; n_a = 256; }
    else if (u < U_DBIG + U_MBIG + U_DCTX) { u -= U_DBIG + U_MBIG; diff = true; lat = false; const int sq = u >> 2, hh = u & 3; head = hh; qrow0 = sq * 256; krow0 = sq * 256; Tk = 256; n_a = 256; }
    else { u -= U_DBIG + U_MBIG + U_DCTX; diff = false; lat = false; const int sq = u >> 3, hh = u & 7; head = hh; qrow0 = sq * 256; krow0 = sq * 256; Tk = 256; n_a = 256; }
    const int qrowb = lat ? qrow0 - NCTX : 0;
    if (diff) {
      f32x16 o[4];
      const float c = 0.125f * 1.4426950408889634f;
#pragma unroll 1
      for (int m = 0; m < 2; ++m) {
        attn_core<64, 128>(Qda + (size_t)qrow0 * 512 + head * 128 + m * 64, Qdb + (size_t)qrowb * 512 + head * 128 + m * 64, 512,
                           Kd + (size_t)krow0 * 512 + head * 128 + m * 64, 512, Vd + (size_t)krow0 * 512 + head * 128, 512, Tk, n_a, c, smem, o);
        if (m == 0) {
#pragma unroll
          for (int dt = 0; dt < 4; ++dt)
#pragma unroll
            for (int rq = 0; rq < 4; ++rq) *(f32x4*)(otmp + tid * 64 + dt * 16 + rq * 4) = (f32x4){o[dt][4 * rq], o[dt][4 * rq + 1], o[dt][4 * rq + 2], o[dt][4 * rq + 3]};
        }
      }
      float ss = 0.f;
#pragma unroll
      for (int dt = 0; dt < 4; ++dt)
#pragma unroll
        for (int rq = 0; rq < 4; ++rq) {
          const f32x4 o0 = *(const f32x4*)(otmp + tid * 64 + dt * 16 + rq * 4);
#pragma unroll
          for (int e = 0; e < 4; ++e) { const float v = o0[e] - lam * o[dt][4 * rq + e]; o[dt][4 * rq + e] = v; ss += v * v; }
        }
      ss += __shfl_xor(ss, 32);
      const float sc = rsqrtf(ss * (1.f / 128.f) + EPS) * 0.8f;
      bf16_t* dst = cat + (size_t)(qrow0 + wid * 32 + ql) * 1024 + head * 128;
#pragma unroll
      for (int dt = 0; dt < 4; ++dt)
#pragma unroll
        for (int rq = 0; rq < 4; ++rq) {
          const int dv = dt * 32 + 8 * rq + 4 * h2;
          const f32x4 g = *(const f32x4*)(p.diff_norm_g + dv);
          u32x2 w = {pack2(o[dt][4 * rq] * sc * g[0], o[dt][4 * rq + 1] * sc * g[1]), pack2(o[dt][4 * rq + 2] * sc * g[2], o[dt][4 * rq + 3] * sc * g[3])};
          *(u32x2*)(dst + dv) = w;
        }
    } else {
      f32x16 o[2];
      const float c = 0.10206207261596575f * 1.4426950408889634f;
      attn_core<96, 64>(Qma + (size_t)qrow0 * 768 + head * 96, Qmb + (size_t)qrowb * 768 + head * 96, 768,
                        Km + (size_t)krow0 * 768 + head * 96, 768, Vm + (size_t)krow0 * 512 + head * 64, 512, Tk, n_a, c, smem, o);
      bf16_t* dst = cat + (size_t)(qrow0 + wid * 32 + ql) * 1024 + 512 + head * 64;
#pragma unroll
      for (int dt = 0; dt < 2; ++dt)
#pragma unroll
        for (int rq = 0; rq < 4; ++rq) {
          const int dv = dt * 32 + 8 * rq + 4 * h2;
          u32x2 w = {pack2(o[dt][4 * rq], o[dt][4 * rq + 1]), pack2(o[dt][4 * rq + 2], o[dt][4 * rq + 3])};
          *(u32x2*)(dst + dv) = w;
        }
    }
  }
}

template <int HW>
DI void pool_unit(const bf16_t* __restrict__ Pz, bf16_t* __restrict__ cat, int t0, int s0, int s1, int ch) {
  float v0[16 + 2 * HW], v1[16 + 2 * HW];
#pragma unroll
  for (int i = 0; i < 16 + 2 * HW; ++i) {
    const int r = t0 - HW + i;
    unsigned w = 0u;
    if (r >= s0 && r < s1) w = *(const unsigned*)(Pz + (size_t)r * 512 + ch);
    v0[i] = bflo(w); v1[i] = bfhi(w);
  }
#pragma unroll
  for (int o = 0; o < 16; ++o) {
    const int r = t0 + o;
    float a0 = 0.f, a1 = 0.f;
#pragma unroll
    for (int d = 0; d < 2 * HW; ++d) { a0 += v0[o + d]; a1 += v1[o + d]; }
    const int lo = max(r - HW, s0), hi = min(r + HW - 1, s1 - 1);
    const float ic = 1.f / (float)(hi - lo + 1);
    *(unsigned*)(cat + (size_t)r * 1024 + 512 + ch) = pack2(a0 * ic - v0[o + HW], a1 * ic - v1[o + HW]);
  }
}

DI void phase_conv(const Params& p, char* smem) {
  char* ws = p.ws;
  const bf16_t* Ug = (const bf16_t*)(ws + O_UG); const bf16_t* Pz = (const bf16_t*)(ws + O_PZ);
  bf16_t* cat = (bf16_t*)(ws + O_HB);
  const int tid = threadIdx.x, lane = tid & 63, half = tid >> 8, ht = tid & 255, hw4 = (tid >> 6) & 3;
  float* tile = (float*)smem + half * 8192;
  for (int up = blockIdx.x; up < NTOK / 32; up += gridDim.x) {
    const int t0 = (up * 2 + half) * 16;
    const int s0 = t0 < NCTX ? (t0 & ~255) : NCTX + ((t0 - NCTX) & ~(TLAT - 1));
    const int s1 = t0 < NCTX ? s0 + 256 : s0 + TLAT;
    {
      const int ch = ht * 2;
      f32x2 w[31];
#pragma unroll
      for (int j = 0; j < 31; ++j) w[j] = *(const f32x2*)(p.conv_w + j * 512 + ch);
      const f32x2 bias = *(const f32x2*)(p.conv_b + ch);
#pragma unroll 1
      for (int hf = 0; hf < 2; ++hf) {
        float a0[8], a1[8];
#pragma unroll
        for (int o = 0; o < 8; ++o) { a0[o] = 0.f; a1[o] = 0.f; }
#pragma unroll
        for (int i = 0; i < 38; ++i) {
          const int r = t0 + hf * 8 - 15 + i;
          float u0 = 0.f, u1 = 0.f;
          if (r >= s0 && r < s1) { const unsigned v = *(const unsigned*)(Ug + (size_t)r * 512 + ch); u0 = bflo(v); u1 = bfhi(v); }
#pragma unroll
          for (int o = 0; o < 8; ++o) {
            const int j = i - o;
            if (j >= 0 && j <= 30) { a0[o] += u0 * w[j][0]; a1[o] += u1 * w[j][1]; }
          }
        }
#pragma unroll
        for (int o = 0; o < 8; ++o) *(f32x2*)(tile + (hf * 8 + o) * 512 + ch) = (f32x2){a0[o] + bias[0], a1[o] + bias[1]};
      }
    }
    __syncthreads();
#pragma unroll 1
    for (int k = 0; k < 4; ++k) {
      const int o = hw4 * 4 + k, row = t0 + o;
      const f32x4 v0 = *(const f32x4*)(tile + o * 512 + lane * 4), v1 = *(const f32x4*)(tile + o * 512 + 256 + lane * 4);
      const float mean = wave_sum((v0[0] + v0[1]) + (v0[2] + v0[3]) + (v1[0] + v1[1]) + (v1[2] + v1[3])) * (1.f / 512.f);
      float q = 0.f;
#pragma unroll
      for (int e = 0; e < 4; ++e) { const float d0 = v0[e] - mean, d1 = v1[e] - mean; q += d0 * d0 + d1 * d1; }
      const float rstd = rsqrtf(wave_sum(q) * (1.f / 512.f) + EPS);
#pragma unroll
      for (int hlf = 0; hlf < 2; ++hlf) {
        const int col = hlf * 256 + lane * 4;
        const f32x4 v = hlf ? v1 : v0;
        const f32x4 g = *(const f32x4*)(p.conv_norm_g + col), bb = *(const f32x4*)(p.conv_norm_b + col);
        float y[4];
#pragma unroll
        for (int e = 0; e < 4; ++e) { const float z = (v[e] - mean) * rstd * g[e] + bb[e]; y[e] = z / (1.f + __expf(-z)); }
        *(u32x2*)(cat + (size_t)row * 1024 + col) = (u32x2){pack2(y[0], y[1]), pack2(y[2], y[3])};
      }
    }
    __builtin_amdgcn_sched_barrier(0);
    switch (hw4) {
      case 0: pool_unit<1>(Pz, cat, t0, s0, s1, ht * 2); break;
      case 1: pool_unit<2>(Pz, cat, t0, s0, s1, ht * 2); break;
      case 2: pool_unit<4>(Pz, cat, t0, s0, s1, ht * 2); break;
      default: pool_unit<8>(Pz, cat, t0, s0, s1, ht * 2); break;
    }
    __syncthreads();
  }
}

__global__ void __launch_bounds__(NT, 2) fwd_kernel(Params p, int ph_lo, int ph_hi) {
  __shared__ __attribute__((aligned(16))) char smem[2 * G_STAGE + 12288];
  __shared__ uint4 xb_words;
  cg::grid_group grid = cg::this_grid();
  char* ws = p.ws;
  if (threadIdx.x == 0) xb_words = make_uint4(0u, 0u, 0u, 0u);
  __syncthreads();
  const XcdBarrier xb = xcd_barrier_post((unsigned*)(ws + O_BAR), (volatile LDS_AS unsigned*)&xb_words);
  if (ph_lo > 1000) grid.sync();
  float* mods = (float*)(ws + O_MODS);
  bf16_t* Hb = (bf16_t*)(ws + O_HB);
  float* X = p.out;
  float* xbuf = (float*)(ws + O_XBUF);
  unsigned* lncnt = (unsigned*)(ws + O_LNCNT);
  const bool fused = (gridDim.x == 256);
#define GSYNC() xcd_barrier(xb)
#define PH_BEGIN(n) if (ph_lo <= n && n < ph_hi) { if (n > ph_lo) GSYNC();
#define PH_BEGIN_IF(n, c) if (ph_lo <= n && n < ph_hi && (c)) { if (n > ph_lo) GSYNC();
#define PH_END }
#ifndef PROBE_DUP
#define PROBE_DUP 0
#endif
#ifndef PROBE_SYNCS
#define PROBE_SYNCS 0
#endif
#define DUP(n, ...) __VA_ARGS__; if ((PROBE_DUP >> n) & 1) { GSYNC(); __VA_ARGS__; }
  for (int i = 0; i < PROBE_SYNCS; ++i) GSYNC();
  PH_BEGIN(0) { DUP(0, phase0(p, smem)); } PH_END
  PH_BEGIN(1) { DUP(1, modulate_phase(p.x_prompt, p.x_sample, mods, Hb)); } PH_END
  PH_BEGIN(2) {
    float* o_k = p.out + (size_t)NTOK * 1024; float* o_v = o_k + (size_t)NCTX * 512; float* o_ckv = o_v + (size_t)NCTX * 512; float* o_kr = o_ckv + (size_t)NCTX * 128;
    DUP(2, gemm_phase(Hb, 1024, (const bf16_t*)(ws + O_WATTIN), 1024, 1024, 64, 8,
                      EpiAttIn{(bf16_t*)(ws + O_QDA), (bf16_t*)(ws + O_QDB), (bf16_t*)(ws + O_KD), (bf16_t*)(ws + O_VD), (bf16_t*)(ws + O_CQN), (bf16_t*)(ws + O_CKVN), (bf16_t*)(ws + O_KMLA),
                               o_k, o_v, o_ckv, o_kr, (const float*)(ws + O_C16), (const float*)(ws + O_S16), (const float*)(ws + O_C8), (const float*)(ws + O_S8), p.q_norm_g, p.kv_norm_g, smem + 2 * G_STAGE}, smem));
  } PH_END
  PH_BEGIN(4) {
        const int n1 = 64 * 3, n2 = 67 * 4;
        gemm_phase((const bf16_t*)(ws + O_CQN), 256, (const bf16_t*)(ws + O_WUQ), 256, 256, 64, 3,
                   EpiUq{(bf16_t*)(ws + O_QMA), (bf16_t*)(ws + O_QMB), (const float*)(ws + O_C8), (const float*)(ws + O_S8)}, smem, 0, n1 + n2);
        gemm_phase((const bf16_t*)(ws + O_CKVN), 128, (const bf16_t*)(ws + O_WUKV), 128, 128, 67, 4,
                   EpiUkv{(bf16_t*)(ws + O_KMLA), (bf16_t*)(ws + O_VMLA)}, smem, n1, n1 + n2);
  } PH_END
  PH_BEGIN(5) { phase_attn(p, smem, 0); if ((PROBE_DUP >> 5) & 1) { GSYNC(); phase_attn(p, smem, 1); } } PH_END
  PH_BEGIN(6) { gemm_phase(Hb, 1024, (const bf16_t*)(ws + O_WATTOUT), 1024, 1024, 64, 4, EpiResLN{p.x_prompt, p.x_sample, mods + 2048, X, p.ln_mix_g, p.ln_mix_b, mods, 3072, 4096, Hb, xbuf, lncnt, smem + 2 * G_STAGE, fused}, smem); } PH_END
  PH_BEGIN_IF(7, !fused) { rows_phase(X, X + (size_t)NCTX * 1024, true, p.ln_mix_g, p.ln_mix_b, X, mods, 3072, 4096, Hb); } PH_END
  PH_BEGIN(8) { DUP(8, gemm_phase(Hb, 1024, (const bf16_t*)(ws + O_WMLPIN), 1024, 1024, 64, 16, EpiRelu2{(bf16_t*)(ws + O_U), smem}, smem)); } PH_END
  PH_BEGIN(9) { gemm_phase((const bf16_t*)(ws + O_U), 4096, (const bf16_t*)(ws + O_WMLPOUT), 4096, 4096, 64, 4, EpiResLN{X, X + (size_t)NCTX * 1024, mods + 5120, X, p.ln_mlp_g, p.ln_mlp_b, mods + 3 * 6144, 0, 1024, Hb, xbuf + 98304, lncnt + 64, smem + 2 * G_STAGE, fused}, smem); } PH_END
  PH_BEGIN_IF(10, !fused) { rows_phase(X, X + (size_t)NCTX * 1024, true, p.ln_mlp_g, p.ln_mlp_b, X, mods + 3 * 6144, 0, 1024, Hb); } PH_END
  PH_BEGIN(11) { DUP(11, gemm_phase(Hb, 1024, (const bf16_t*)(ws + O_WCONVIN), 1024, 1024, 64, 6, EpiConv{(bf16_t*)(ws + O_UG), (bf16_t*)(ws + O_PZ)}, smem)); } PH_END
  PH_BEGIN(12) { DUP(12, phase_conv(p, smem)); } PH_END
  PH_BEGIN(13) { gemm_phase(Hb, 1024, (const bf16_t*)(ws + O_WCONVOUT), 1024, 1024, 64, 4, EpiResLN{X, X + (size_t)NCTX * 1024, mods + 3 * 6144 + 2048, X, p.ln_mix_g + 1024, p.ln_mix_b + 1024, mods + 3 * 6144, 3072, 4096, Hb, xbuf + 2 * 98304, lncnt + 128, smem + 2 * G_STAGE, fused}, smem); } PH_END
  PH_BEGIN_IF(14, !fused) { rows_phase(X, X + (size_t)NCTX * 1024, true, p.ln_mix_g + 1024, p.ln_mix_b + 1024, X, mods + 3 * 6144, 3072, 4096, Hb); } PH_END
  PH_BEGIN(15) { DUP(15, gemm_phase(Hb, 1024, (const bf16_t*)(ws + O_WMLPIN) + (size_t)4096 * 1024, 1024, 1024, 64, 16, EpiRelu2{(bf16_t*)(ws + O_U), smem}, smem)); } PH_END
  PH_BEGIN(16) { gemm_phase((const bf16_t*)(ws + O_U), 4096, (const bf16_t*)(ws + O_WMLPOUT) + (size_t)4096 * 1024, 4096, 4096, 64, 4, EpiResLN{X, X + (size_t)NCTX * 1024, mods + 3 * 6144 + 5120, X, p.ln_mlp_g + 1024, p.ln_mlp_b + 1024, mods, 0, 0, nullptr, xbuf + 3 * 98304, lncnt + 192, smem + 2 * G_STAGE, fused}, smem); } PH_END
  PH_BEGIN_IF(17, !fused) { rows_phase(X, X + (size_t)NCTX * 1024, true, p.ln_mlp_g + 1024, p.ln_mlp_b + 1024, X, nullptr, 0, 0, nullptr); } PH_END
}

extern "C" void kernel_launch(void* const* d_in, const int* in_sizes, int n_in, void* d_out, int out_size, void* d_ws, size_t ws_size, hipStream_t stream) {
  static int grid_blocks = 0;
  if (!grid_blocks) {
    int dev = 0, cus = 0, per_cu = 0;
    hipGetDevice(&dev);
    hipDeviceGetAttribute(&cus, hipDeviceAttributeMultiprocessorCount, dev);
    hipOccupancyMaxActiveBlocksPerMultiprocessor(&per_cu, fwd_kernel, NT, 0);
    if (per_cu > 1) per_cu = 1;
    if (per_cu < 1) per_cu = 1;
    grid_blocks = cus * per_cu;
    if (grid_blocks > 256) grid_blocks = 256;
  }
  if (ws_size < WS_NEED) { fprintf(stderr, "workspace too small: %zu < %zu\n", ws_size, (size_t)WS_NEED); return; }
  Params p{};
  const float** f = (const float**)&p;
  for (int i = 0; i < 35; ++i) f[i] = (const float*)d_in[i];
  p.out = (float*)d_out;
  p.ws = (char*)d_ws;
  hipMemsetAsync(d_ws, 0, 16384, stream);
  int lo = 0, hi = NPHASE;
  void* args[] = {&p, &lo, &hi};
  hipError_t e = hipLaunchCooperativeKernel((void*)fwd_kernel, dim3(grid_blocks), dim3(NT), args, 0, stream);
  if (e != hipSuccess) fprintf(stderr, "cooperative launch failed: %s (grid %d)\n", hipGetErrorString(e), grid_blocks);
}
```

```cpp
#include <hip/hip_runtime.h>
#include <hip/hip_cooperative_groups.h>
#include <cstdio>
#include <cstdint>
namespace cg = cooperative_groups;

typedef unsigned short bf16_t;
typedef short bf16x8 __attribute__((ext_vector_type(8)));
typedef short s16x4 __attribute__((ext_vector_type(4)));
typedef float f32x4 __attribute__((ext_vector_type(4)));
typedef float f32x2 __attribute__((ext_vector_type(2)));
typedef float f32x16 __attribute__((ext_vector_type(16)));
typedef unsigned u32x4 __attribute__((ext_vector_type(4)));
typedef unsigned u32x2 __attribute__((ext_vector_type(2)));
typedef __bf16 bf16v2 __attribute__((ext_vector_type(2)));
#define DI __device__ __forceinline__
#define LDS_AS __attribute__((address_space(3)))

constexpr int NTOK = 12288, NCTX = 4096, NKEY = 12800, TLAT = 4096, TKL = 4352;
constexpr int RLD = 1952;
constexpr float ALPHA = 1.41421356237f, EPS = 1e-5f;
constexpr int NPHASE = 18;
constexpr int NT = 512, NWAVE = 8;

constexpr size_t al(size_t x) { return (x + 255) & ~(size_t)255; }
constexpr size_t O_CNT = 0;
constexpr size_t O_BAR = 256;
constexpr size_t O_LNCNT = 14336;
constexpr size_t O_MODS = 16384;
constexpr size_t O_SCAL = O_MODS + al(2 * 3 * 6144 * 4);
constexpr size_t O_C16 = O_SCAL + 256;
constexpr size_t O_S16 = O_C16 + 4096;
constexpr size_t O_C8 = O_S16 + 4096;
constexpr size_t O_S8 = O_C8 + 2048;
constexpr size_t O_XBUF = O_S8 + 2048;
constexpr size_t O_WATTIN = O_XBUF + (size_t)4 * 256 * 192 * 2 * 4;
constexpr size_t O_WUQ = O_WATTIN + (size_t)2048 * 1024 * 2;
constexpr size_t O_WUKV = O_WUQ + (size_t)768 * 256 * 2;
constexpr size_t O_WATTOUT = O_WUKV + (size_t)1024 * 128 * 2;
constexpr size_t O_WMLPIN = O_WATTOUT + (size_t)1024 * 1024 * 2;
constexpr size_t O_WMLPOUT = O_WMLPIN + (size_t)2 * 4096 * 1024 * 2;
constexpr size_t O_WCONVIN = O_WMLPOUT + (size_t)2 * 4096 * 1024 * 2;
constexpr size_t O_WCONVOUT = O_WCONVIN + (size_t)1536 * 1024 * 2;
constexpr size_t O_HB = O_WCONVOUT + (size_t)1024 * 1024 * 2;
constexpr size_t O_BIG = O_HB + (size_t)NTOK * 1024 * 2;
constexpr size_t O_R = O_BIG;
constexpr size_t O_QMA = O_R;
constexpr size_t O_QMB = O_QMA + (size_t)NTOK * 768 * 2;
constexpr size_t O_QDA = O_R + al((size_t)NTOK * RLD * 2);
constexpr size_t O_QDB = O_QDA + (size_t)NTOK * 512 * 2;
constexpr size_t O_KD = O_QDB + (size_t)8192 * 512 * 2;
constexpr size_t O_VD = O_KD + (size_t)NKEY * 512 * 2;
constexpr size_t O_CQN = O_VD + (size_t)NKEY * 512 * 2;
constexpr size_t O_CKVN = O_CQN + (size_t)NTOK * 256 * 2;
constexpr size_t O_KMLA = O_CKVN + (size_t)NKEY * 128 * 2;
constexpr size_t O_VMLA = O_KMLA + (size_t)NKEY * 768 * 2;
constexpr size_t O_OTMP = O_VMLA + (size_t)NKEY * 512 * 2;
constexpr size_t O_ATT_END = O_OTMP + (size_t)512 * 16384 * 4;
constexpr size_t O_U = O_BIG;
constexpr size_t O_U_END = O_U + (size_t)NTOK * 4096 * 2;
constexpr size_t O_UG = O_BIG;
constexpr size_t O_PZ = O_UG + (size_t)NTOK * 512 * 2;
constexpr size_t WS_NEED = (O_ATT_END > O_U_END ? O_ATT_END : O_U_END);
static_assert(O_QMB + (size_t)8192 * 768 * 2 <= O_QDA, "Qm overlay must fit in R");
static_assert(WS_NEED <= (size_t)256 * 1024 * 1024, "workspace too large");

struct Params {
  const float *x_prompt, *x_sample, *cache_k, *cache_v, *cache_ckv, *cache_krope, *c, *c_ctx;
  const float *w_ada, *b_ada, *ln_mix_g, *ln_mix_b, *ln_mlp_g, *ln_mlp_b, *w_mlp_in, *w_mlp_out;
  const float *w_att_in, *w_uq, *w_ukv, *q_norm_g, *kv_norm_g, *lam_q1, *lam_k1, *lam_q2, *lam_k2, *diff_norm_g, *w_att_out;
  const float *w_conv_in, *conv_w, *conv_b, *conv_norm_g, *conv_norm_b, *w_pool, *pool_scale, *w_conv_out;
  float* out;
  char* ws;
};

DI unsigned pack2(float lo, float hi) { f32x2 v = {lo, hi}; bf16v2 b = __builtin_convertvector(v, bf16v2); return __builtin_bit_cast(unsigned, b); }
DI float bf2f(unsigned short u) { return __uint_as_float((unsigned)u << 16); }
DI float bflo(unsigned u) { return __uint_as_float(u << 16); }
DI float bfhi(unsigned u) { return __uint_as_float(u & 0xffff0000u); }
DI float wave_sum(float v) {
#pragma unroll
  for (int o = 32; o >= 1; o >>= 1) v += __shfl_xor(v, o);
  return v;
}
DI void lds_barrier() { asm volatile("s_waitcnt lgkmcnt(0)\n\ts_barrier" ::: "memory"); }
DI void dma16(const void* gsrc, unsigned lds_dst) {
  unsigned keep;
  asm volatile("s_mov_b32 %0, m0\n\ts_mov_b32 m0, %2\n\ts_nop 0\n\tglobal_load_lds_dwordx4 %1, off\n\ts_mov_b32 m0, %0" : "=&s"(keep) : "v"(gsrc), "s"(lds_dst) : "memory");
}
DI int cond_idx(int row) { return row < NCTX ? 0 : 1 + ((row - NCTX) >> 12); }


#define XB_TMO      128
#define XB_XCNT(j)  (256  + 64 * (j))
#define XB_XSUB(j)  (1280 + 64 * (j))
#define XB_XGEN(j)  (2304 + 64 * (j))
#define XB_TOP      3328
#define XB_TOPGEN   3392
#define XCD_BAR_WORDS 3456
#define XB_SPIN_CAP (1u << 18)
DI unsigned xb_ld(unsigned* p)              { return __hip_atomic_load(p, __ATOMIC_RELAXED, __HIP_MEMORY_SCOPE_AGENT); }
DI unsigned xb_add(unsigned* p, unsigned v) { return __hip_atomic_fetch_add(p, v, __ATOMIC_RELAXED, __HIP_MEMORY_SCOPE_AGENT); }
DI unsigned xb_xcc_id() { return (unsigned)__builtin_amdgcn_s_getreg((3 << 11) | 20) & 0xFu; }
#define XB_SPIN(cond, bar) do { unsigned _sp = 0; while (cond) { __builtin_amdgcn_s_sleep(1); \
    if ((++_sp & 255u) == 0u) { if (xb_ld(&(bar)[XB_TMO])) break; if (_sp > XB_SPIN_CAP) { atomicAdd(&(bar)[XB_TMO], 1u); break; } } } } while (0)
struct XcdBarrier { unsigned* bar; unsigned x; volatile LDS_AS unsigned* st; };
DI XcdBarrier xcd_barrier_post(unsigned* bar, volatile LDS_AS unsigned* st) {
  XcdBarrier b; b.bar = bar; b.x = xb_xcc_id(); b.st = st;
  if (threadIdx.x == 0) (void)xb_add(&bar[XB_XCNT(b.x)], 1u);
  return b;
}
DI void xcd_barrier_complete(unsigned* bar, unsigned x, unsigned& nloc, unsigned& nx) {
  const unsigned G = gridDim.x * gridDim.y * gridDim.z;
  unsigned sum, cnt, mine, sp = 0u;
  for (;;) {
    sum = 0u; cnt = 0u; mine = 0u;
#pragma unroll
    for (unsigned j = 0; j < 16; ++j) { const unsigned c = xb_ld(&bar[XB_XCNT(j)]); sum += c; cnt += (c > 0u) ? 1u : 0u; mine = (j == x) ? c : mine; }
    if (sum == G) break;
    __builtin_amdgcn_s_sleep(1);
    if ((++sp & 255u) == 0u) { if (xb_ld(&bar[XB_TMO])) break; if (sp > XB_SPIN_CAP) { atomicAdd(&bar[XB_TMO], 1u); break; } }
  }
  nloc = mine > 0u ? mine : 1u; nx = cnt > 0u ? cnt : 1u;
}
DI void xcd_barrier(const XcdBarrier& b) {
  asm volatile("s_waitcnt vmcnt(0)" ::: "memory");
  __syncthreads();
  if (threadIdx.x == 0) {
    unsigned* bar = b.bar;
    __builtin_amdgcn_s_waitcnt(0);
    unsigned nloc = b.st[0], nx = b.st[1];
    if (nloc == 0u) { xcd_barrier_complete(bar, b.x, nloc, nx); b.st[0] = nloc; b.st[1] = nx; }
    const unsigned old = xb_add(&bar[XB_XSUB(b.x)], 1u);
    const unsigned gen = old / nloc;
    if (old + 1u == (gen + 1u) * nloc) {
      __builtin_amdgcn_fence(__ATOMIC_RELEASE, "agent");
      asm volatile("s_waitcnt vmcnt(0)" ::: "memory");
      const unsigned og = xb_add(&bar[XB_TOP], 1u);
      const unsigned tg = og / nx;
      if (og + 1u == (tg + 1u) * nx) xb_add(&bar[XB_TOPGEN], 1u);
      else XB_SPIN(xb_ld(&bar[XB_TOPGEN]) == tg, bar);
      __builtin_amdgcn_fence(__ATOMIC_ACQUIRE, "agent");
      xb_add(&bar[XB_XGEN(b.x)], 1u);
      asm volatile("s_waitcnt vmcnt(0)" ::: "memory");
    } else {
      XB_SPIN(xb_ld(&bar[XB_XGEN(b.x)]) == gen, bar);
      __builtin_amdgcn_fence(__ATOMIC_ACQUIRE, "agent");
      asm volatile("s_waitcnt vmcnt(0)" ::: "memory");
    }
  }
  __syncthreads();
}

DI int swz(int row, int kc) { return row * 128 + ((kc ^ ((row >> 1) & 7)) << 4); }

constexpr int G_BM = 192, G_BN = 256, G_MI = 6, G_NJ = 4, G_ABYTES = G_BM * 128, G_STAGE = G_ABYTES + G_BN * 128;
template <class Epi>
DI void gemm_tile(const bf16_t* __restrict__ A, int lda, const bf16_t* __restrict__ Bt, int ldb, int K, int row0, int col0, char* smem, const Epi& epi,
                  bool prefetched, bool has_next, int nrow0, int ncol0) {
  const int tid = threadIdx.x, lane = tid & 63, wid = tid >> 6, wr = wid >> 2, wc = wid & 3;
  const int fr = lane & 15, fq = lane >> 4;
  f32x4 acc[G_MI][G_NJ];
#pragma unroll
  for (int i = 0; i < G_MI; ++i)
#pragma unroll
    for (int j = 0; j < G_NJ; ++j) acc[i][j] = (f32x4){0.f, 0.f, 0.f, 0.f};
  const int srow = tid >> 3, skc = tid & 7;
  const int schunk = skc ^ ((srow >> 1) & 7);
  const bf16_t* ga = A + (size_t)(row0 + srow) * lda + schunk * 8;
  const bf16_t* gb = Bt + (size_t)(col0 + srow) * ldb + schunk * 8;
  const int nk = K >> 6;
  const unsigned lds0 = __builtin_amdgcn_readfirstlane((unsigned)(size_t)(LDS_AS char*)smem + (unsigned)(tid & ~63) * 16u);
#define G_DMA_P(ga_, gb_, stage_off_, kt_) do { const int k0_ = (kt_) << 6; const unsigned sb_ = lds0 + (unsigned)(stage_off_); \
    _Pragma("unroll") for (int i = 0; i < 3; ++i) dma16((ga_) + (size_t)(64 * i) * lda + k0_, sb_ + i * 8192); \
    _Pragma("unroll") for (int i = 0; i < 4; ++i) dma16((gb_) + (size_t)(64 * i) * ldb + k0_, sb_ + G_ABYTES + i * 8192); } while (0)
#define G_DMA(stage_off_, kt_) G_DMA_P(ga, gb, stage_off_, kt_)
#define G_COMPUTE(buf_) do { const char* cur = (buf_); \
    _Pragma("unroll") for (int s = 0; s < 2; ++s) { \
      bf16x8 af[G_MI], bfr[G_NJ]; \
      _Pragma("unroll") for (int i = 0; i < G_MI; ++i) af[i] = *(const bf16x8*)(cur + swz(wr * 96 + i * 16 + fr, s * 4 + fq)); \
      _Pragma("unroll") for (int j = 0; j < G_NJ; ++j) bfr[j] = *(const bf16x8*)(cur + G_ABYTES + swz(wc * 64 + j * 16 + fr, s * 4 + fq)); \
      __builtin_amdgcn_s_setprio(1); \
      _Pragma("unroll") for (int i = 0; i < G_MI; ++i) \
        _Pragma("unroll") for (int j = 0; j < G_NJ; ++j) acc[i][j] = __builtin_amdgcn_mfma_f32_16x16x32_bf16(bfr[j], af[i], acc[i][j], 0, 0, 0); \
      __builtin_amdgcn_s_setprio(0); \
    } } while (0)
  if (!prefetched) { G_DMA(0, 0); asm volatile("s_waitcnt vmcnt(0)" ::: "memory"); }
  else asm volatile("s_waitcnt vmcnt(%0)" :: "n"(Epi::kMinStores) : "memory");
  lds_barrier();
  for (int kt = 0; kt < nk; kt += 2) {
    G_DMA(G_STAGE, kt + 1);
    G_COMPUTE(smem);
    asm volatile("s_waitcnt vmcnt(0)" ::: "memory");
    lds_barrier();
    G_DMA(0, min(kt + 2, nk - 1));
    G_COMPUTE(smem + G_STAGE);
    asm volatile("s_waitcnt vmcnt(0)" ::: "memory");
    lds_barrier();
  }
  if (has_next) {
    const bf16_t* gan = A + (size_t)(nrow0 + srow) * lda + schunk * 8;
    const bf16_t* gbn = Bt + (size_t)(ncol0 + srow) * ldb + schunk * 8;
    G_DMA_P(gan, gbn, 0, 0);
  }
#undef G_DMA
#undef G_DMA_P
#undef G_COMPUTE
  epi(acc, row0 + wr * 96, col0 + wc * 64, lane);
}


template <class F>
DI void wave_rows_store(char* w, const u32x2 (&pk)[G_MI][G_NJ], int lane, F rowptr) {
  const int fr = lane & 15, fq = lane >> 4;
#pragma unroll
  for (int i = 0; i < G_MI; ++i)
#pragma unroll
    for (int j = 0; j < G_NJ; ++j) *(u32x2*)(w + (i * 16 + fr) * 144 + (j * 16 + fq * 4) * 2) = pk[i][j];
  const int rr = lane >> 3, ch = lane & 7;
#pragma unroll
  for (int it = 0; it < 12; ++it) {
    const int r = it * 8 + rr;
    const u32x4 v = *(const u32x4*)(w + r * 144 + ch * 16);
    bf16_t* d = rowptr(r);
    if (d) *(u32x4*)(d + ch * 8) = v;
  }
}
DI u32x2 pk4(const f32x4 v) { return (u32x2){pack2(v[0], v[1]), pack2(v[2], v[3])}; }

struct EpiRaw {
  static constexpr int kMinStores = 0;
  static constexpr bool kPrefetchNext = true;
  bf16_t* R;
  DI void operator()(f32x4 (&acc)[G_MI][G_NJ], int rbase, int cbase, int lane) const {
    const int fr = lane & 15, fq = lane >> 4;
#pragma unroll
    for (int i = 0; i < G_MI; ++i)
#pragma unroll
      for (int j = 0; j < G_NJ; ++j) {
        const int row = rbase + i * 16 + fr, col = cbase + j * 16 + fq * 4;
        if (col < RLD) { u32x2 w = {pack2(acc[i][j][0], acc[i][j][1]), pack2(acc[i][j][2], acc[i][j][3])}; *(u32x2*)(R + (size_t)row * RLD + col) = w; }
      }
  }
};


struct EpiAttIn {
  static constexpr int kMinStores = 0;
  static constexpr bool kPrefetchNext = true;
  bf16_t *Qda, *Qdb, *Kd, *Vd, *cqn, *ckvn, *Km; float *o_k, *o_v, *o_ckv, *o_kr;
  const float *c16, *s16, *c8, *s8, *qg, *kvg; char* smem;
  DI void operator()(f32x4 (&acc)[G_MI][G_NJ], int rbase, int cbase, int lane) const {
    const int tid = threadIdx.x, wid = tid >> 6, wr = wid >> 2, wc = wid & 3, fr = lane & 15, fq = lane >> 4;
    const int tile = (cbase - wc * 64) >> 8;
    float* part = (float*)smem;
    if (tile < 6) {
      const int which = tile >> 1, c0 = cbase & 511;
#pragma unroll
      for (int i = 0; i < G_MI; ++i) {
        const int rowf = rbase + i * 16, row = rowf + fr;
        const bool lat = rowf >= NCTX;
        const int rl = row - NCTX, b = rl >> 12, t = rl & (TLAT - 1), prow = t >> 6, pcol = t & 63;
        const size_t kr = lat ? (size_t)NCTX + (size_t)b * TKL + 256 + t : (size_t)row;
        u32x2 raw[G_NJ], rot[G_NJ];
#pragma unroll
        for (int j = 0; j < G_NJ; ++j) raw[j] = (u32x2){pack2(acc[i][j][0], acc[i][j][1]), pack2(acc[i][j][2], acc[i][j][3])};
        if (lat && which < 2) {
#pragma unroll
          for (int jp = 0; jp < 2; ++jp) {
            const int pos = jp == 0 ? prow : pcol;
            const f32x4 cs = *(const f32x4*)(c16 + pos * 16 + fq * 4), sn = *(const f32x4*)(s16 + pos * 16 + fq * 4);
            const f32x4 x1 = acc[i][2 * jp], x2 = acc[i][2 * jp + 1];
            f32x4 o1, o2;
#pragma unroll
            for (int e = 0; e < 4; ++e) { o1[e] = x1[e] * cs[e] - x2[e] * sn[e]; o2[e] = x1[e] * sn[e] + x2[e] * cs[e]; }
            rot[2 * jp] = (u32x2){pack2(o1[0], o1[1]), pack2(o1[2], o1[3])};
            rot[2 * jp + 1] = (u32x2){pack2(o2[0], o2[1]), pack2(o2[2], o2[3])};
          }
        }
#pragma unroll
        for (int j = 0; j < G_NJ; ++j) {
          const int c = c0 + j * 16 + fq * 4;
          if (which == 0) {
            *(u32x2*)(Qda + (size_t)row * 512 + c) = raw[j];
            if (lat) *(u32x2*)(Qdb + (size_t)rl * 512 + c) = rot[j];
          } else if (which == 1) {
            if (lat) *(u32x2*)(Kd + kr * 512 + c) = rot[j];
            else { *(u32x2*)(Kd + kr * 512 + c) = raw[j]; *(f32x4*)(o_k + (size_t)row * 512 + c) = acc[i][j]; }
          } else {
            *(u32x2*)(Vd + kr * 512 + c) = raw[j];
            if (!lat) *(f32x4*)(o_v + (size_t)row * 512 + c) = acc[i][j];
          }
        }
      }
      return;
    }
    const bool norm_wave = (tile == 6) || (wc < 2);
#pragma unroll
    for (int i = 0; i < G_MI; ++i) {
      float ss = 0.f;
#pragma unroll
      for (int j = 0; j < G_NJ; ++j)
#pragma unroll
        for (int e = 0; e < 4; ++e) ss += acc[i][j][e] * acc[i][j][e];
      ss += __shfl_xor(ss, 16); ss += __shfl_xor(ss, 32);
      if (fq == 0) part[(wr * 96 + i * 16 + fr) * 4 + wc] = ss;
    }
    __syncthreads();
#pragma unroll
    for (int i = 0; i < G_MI; ++i) {
      const int rowf = rbase + i * 16, row = rowf + fr;
      const bool lat = rowf >= NCTX;
      const int rl = row - NCTX, b = rl >> 12, t = rl & (TLAT - 1), prow = t >> 6, pcol = t & 63;
      const size_t kr = lat ? (size_t)NCTX + (size_t)b * TKL + 256 + t : (size_t)row;
      const f32x4 pr = *(const f32x4*)(part + (wr * 96 + i * 16 + fr) * 4);
      if (tile == 6) {
        const float sc = rsqrtf(((pr[0] + pr[1]) + (pr[2] + pr[3])) * (1.f / 256.f) + EPS);
#pragma unroll
        for (int j = 0; j < G_NJ; ++j) {
          const int c = wc * 64 + j * 16 + fq * 4;
          const f32x4 g = *(const f32x4*)(qg + c);
          *(u32x2*)(cqn + (size_t)row * 256 + c) = (u32x2){pack2(acc[i][j][0] * sc * g[0], acc[i][j][1] * sc * g[1]), pack2(acc[i][j][2] * sc * g[2], acc[i][j][3] * sc * g[3])};
        }
      } else if (norm_wave) {
        const float sc = rsqrtf((pr[0] + pr[1]) * (1.f / 128.f) + EPS);
#pragma unroll
        for (int j = 0; j < G_NJ; ++j) {
          const int c = wc * 64 + j * 16 + fq * 4;
          const f32x4 g = *(const f32x4*)(kvg + c);
          f32x4 y;
#pragma unroll
          for (int e = 0; e < 4; ++e) y[e] = acc[i][j][e] * sc * g[e];
          if (!lat) *(f32x4*)(o_ckv + (size_t)row * 128 + c) = y;
          *(u32x2*)(ckvn + kr * 128 + c) = (u32x2){pack2(y[0], y[1]), pack2(y[2], y[3])};
        }
      } else if (wc == 2) {
#pragma unroll
        for (int j = 0; j < 2; ++j) {
          f32x4 v = acc[i][j];
          if (lat) {
            const int pos = j == 0 ? prow : pcol;
            f32x4 o;
#pragma unroll
            for (int e = 0; e < 4; ++e) {
              const float pv = __shfl_xor(v[e], 32);
              const int f = (fq & 1) * 4 + e;
              const float cs = c8[pos * 8 + f], sn = s8[pos * 8 + f];
              o[e] = (fq < 2) ? (v[e] * cs - pv * sn) : (pv * sn + v[e] * cs);
            }
            v = o;
          } else *(f32x4*)(o_kr + (size_t)row * 32 + j * 16 + fq * 4) = v;
          const u32x2 w = {pack2(v[0], v[1]), pack2(v[2], v[3])};
#pragma unroll
          for (int hh = 0; hh < 8; ++hh) *(u32x2*)(Km + kr * 768 + hh * 96 + 64 + j * 16 + fq * 4) = w;
        }
      }
    }
    __syncthreads();
  }
};

struct EpiUq {
  static constexpr int kMinStores = 24;
  static constexpr bool kPrefetchNext = true;
  bf16_t *Qa, *Qb; const float *c8, *s8;
  DI void operator()(f32x4 (&acc)[G_MI][G_NJ], int rbase, int cbase, int lane) const {
    const int fr = lane & 15, fq = lane >> 4;
#pragma unroll
    for (int i = 0; i < G_MI; ++i) {
      const bool lat = (rbase + i * 16) >= NCTX;
      const int row = rbase + i * 16 + fr;
      const int t = (row - NCTX) & (TLAT - 1);
#pragma unroll
      for (int j = 0; j < G_NJ; ++j) {
        const int cf = cbase + j * 16, col = cf + fq * 4;
        f32x4 v = acc[i][j];
        u32x2 w = {pack2(v[0], v[1]), pack2(v[2], v[3])};
        *(u32x2*)(Qa + (size_t)row * 768 + col) = w;
        if (lat) {
          const int w96 = cf % 96;
          if (w96 >= 64) {
            const int pos = (w96 == 64) ? (t >> 6) : (t & 63);
            f32x4 o;
#pragma unroll
            for (int e = 0; e < 4; ++e) {
              const float pv = __shfl_xor(v[e], 32);
              const int f = (fq & 1) * 4 + e;
              const float cs = c8[pos * 8 + f], sn = s8[pos * 8 + f];
              o[e] = (fq < 2) ? (v[e] * cs - pv * sn) : (pv * sn + v[e] * cs);
            }
            w = (u32x2){pack2(o[0], o[1]), pack2(o[2], o[3])};
          }
          *(u32x2*)(Qb + (size_t)(row - NCTX) * 768 + col) = w;
        }
      }
    }
  }
};

struct EpiUkv {
  static constexpr int kMinStores = 0;
  static constexpr bool kPrefetchNext = false;
  bf16_t *Km, *Vm; char* lds;
  DI void operator()(f32x4 (&acc)[G_MI][G_NJ], int rbase, int cbase, int lane) const {
    const int h = cbase >> 7, part = (cbase >> 6) & 1;
    u32x2 pk[G_MI][G_NJ];
#pragma unroll
    for (int i = 0; i < G_MI; ++i)
#pragma unroll
      for (int j = 0; j < G_NJ; ++j) pk[i][j] = pk4(acc[i][j]);
    bf16_t* base = part == 0 ? Km + h * 96 : Vm + h * 64;
    const int ld = part == 0 ? 768 : 512;
    wave_rows_store(lds + (threadIdx.x >> 6) * (96 * 144), pk, lane, [&](int r) -> bf16_t* { const int row = rbase + r; return row < NKEY ? base + (size_t)row * ld : nullptr; });
    lds_barrier();
  }
};

struct EpiRes {
  static constexpr int kMinStores = 0;
  static constexpr bool kPrefetchNext = true;
  const float *xin_ctx, *xin_lat, *gate  ; float* X;
  DI void operator()(f32x4 (&acc)[G_MI][G_NJ], int rbase, int cbase, int lane) const {
    const int fr = lane & 15, fq = lane >> 4;
#pragma unroll
    for (int i = 0; i < G_MI; ++i) {
      const int row = rbase + i * 16 + fr;
      const float* g = gate + cond_idx(rbase + i * 16) * 6144;
      const float* xin = row < NCTX ? xin_ctx + (size_t)row * 1024 : xin_lat + (size_t)(row - NCTX) * 1024;
#pragma unroll
      for (int j = 0; j < G_NJ; ++j) {
        const int col = cbase + j * 16 + fq * 4;
        const f32x4 xv = *(const f32x4*)(xin + col), gv = *(const f32x4*)(g + col);
        f32x4 z;
#pragma unroll
        for (int e = 0; e < 4; ++e) z[e] = ALPHA * xv[e] + gv[e] * acc[i][j][e];
        *(f32x4*)(X + (size_t)row * 1024 + col) = z;
      }
    }
  }
};


struct EpiResLN {
  static constexpr int kMinStores = 0;
  static constexpr bool kPrefetchNext = true;
  const float *xin_ctx, *xin_lat, *gate; float* X;
  const float *lg, *lb, *modsL; int sh_off, sc_off; bf16_t* Hb;
  float* xbuf; unsigned* cnt; char* smem; bool fused;
  DI void operator()(f32x4 (&acc)[G_MI][G_NJ], int rbase, int cbase, int lane) const {
    const int tid = threadIdx.x, wid = tid >> 6, wr = wid >> 2, wc = wid & 3, fr = lane & 15, fq = lane >> 4;
#pragma unroll
    for (int i = 0; i < G_MI; ++i) {
      const int row = rbase + i * 16 + fr;
      const float* g = gate + cond_idx(rbase + i * 16) * 6144;
      const float* xin = row < NCTX ? xin_ctx + (size_t)row * 1024 : xin_lat + (size_t)(row - NCTX) * 1024;
#pragma unroll
      for (int j = 0; j < G_NJ; ++j) {
        const int col = cbase + j * 16 + fq * 4;
        const f32x4 xv = *(const f32x4*)(xin + col), gv = *(const f32x4*)(g + col);
#pragma unroll
        for (int e = 0; e < 4; ++e) acc[i][j][e] = ALPHA * xv[e] + gv[e] * acc[i][j][e];
        if (!fused) *(f32x4*)(X + (size_t)row * 1024 + col) = acc[i][j];
      }
    }
    if (!fused) return;
    const int row0 = rbase - wr * 96, pm = row0 / G_BM, pn = (cbase - wc * 64) / G_BN;
    f32x2* part = (f32x2*)smem;
    f32x2* stat = (f32x2*)(smem + 8192);
#pragma unroll
    for (int i = 0; i < G_MI; ++i) {
      float s1 = 0.f, s2 = 0.f;
#pragma unroll
      for (int j = 0; j < G_NJ; ++j)
#pragma unroll
        for (int e = 0; e < 4; ++e) { const float v = acc[i][j][e]; s1 += v; s2 += v * v; }
      s1 += __shfl_xor(s1, 16); s2 += __shfl_xor(s2, 16);
      s1 += __shfl_xor(s1, 32); s2 += __shfl_xor(s2, 32);
      if (fq == 0) part[(wr * 96 + i * 16 + fr) * 4 + wc] = (f32x2){s1, s2};
    }
    __syncthreads();
    if (tid < G_BM) {
      const f32x2 a = part[tid * 4 + 0], b = part[tid * 4 + 1], c = part[tid * 4 + 2], d = part[tid * 4 + 3];
      const float s1 = (a[0] + b[0]) + (c[0] + d[0]), s2 = (a[1] + b[1]) + (c[1] + d[1]);
      const unsigned long long pk = ((unsigned long long)__float_as_uint(s2) << 32) | (unsigned long long)__float_as_uint(s1);
      __hip_atomic_store((unsigned long long*)(xbuf + ((size_t)(pm * 4 + pn) * G_BM + tid) * 2), pk, __ATOMIC_RELAXED, __HIP_MEMORY_SCOPE_AGENT);
    }
    asm volatile("s_waitcnt vmcnt(0)" ::: "memory");
    __syncthreads();
    if (tid == 0) {
      __hip_atomic_fetch_add(cnt + pm, 1u, __ATOMIC_RELAXED, __HIP_MEMORY_SCOPE_AGENT);
      unsigned sp = 0;
      while (__hip_atomic_load(cnt + pm, __ATOMIC_RELAXED, __HIP_MEMORY_SCOPE_AGENT) < 4u) { __builtin_amdgcn_s_sleep(1); if (++sp > (1u << 22)) break; }
    }
    __syncthreads();
    if (tid < G_BM) {
      float s1 = 0.f, s2 = 0.f;
#pragma unroll
      for (int q = 0; q < 4; ++q) {
        const unsigned long long pk = __hip_atomic_load((unsigned long long*)(xbuf + ((size_t)(pm * 4 + q) * G_BM + tid) * 2), __ATOMIC_RELAXED, __HIP_MEMORY_SCOPE_AGENT);
        s1 += __uint_as_float((unsigned)pk); s2 += __uint_as_float((unsigned)(pk >> 32));
      }
      const float mean = s1 * (1.f / 1024.f);
      const float var = fmaxf(s2 * (1.f / 1024.f) - mean * mean, 0.f);
      stat[tid] = (f32x2){mean, rsqrtf(var + EPS)};
    }
    __syncthreads();
#pragma unroll
    for (int i = 0; i < G_MI; ++i) {
      const int row = rbase + i * 16 + fr;
      const f32x2 ms = stat[wr * 96 + i * 16 + fr];
      const float* m = modsL + cond_idx(rbase + i * 16) * 6144;
#pragma unroll
      for (int j = 0; j < G_NJ; ++j) {
        const int col = cbase + j * 16 + fq * 4;
        const f32x4 gv = *(const f32x4*)(lg + col), bv = *(const f32x4*)(lb + col);
        f32x4 x;
#pragma unroll
        for (int e = 0; e < 4; ++e) x[e] = (acc[i][j][e] - ms[0]) * ms[1] * gv[e] + bv[e];
        *(f32x4*)(X + (size_t)row * 1024 + col) = x;
        if (Hb) {
          const f32x4 sh = *(const f32x4*)(m + sh_off + col), sc = *(const f32x4*)(m + sc_off + col);
          u32x2 w = {pack2(x[0] * (1.f + sc[0]) + sh[0], x[1] * (1.f + sc[1]) + sh[1]), pack2(x[2] * (1.f + sc[2]) + sh[2], x[3] * (1.f + sc[3]) + sh[3])};
          *(u32x2*)(Hb + (size_t)row * 1024 + col) = w;
        }
      }
    }
    __syncthreads();
  }
};

struct EpiRelu2 {
  static constexpr int kMinStores = 0;
  static constexpr bool kPrefetchNext = false;
  bf16_t* U; char* lds;
  DI void operator()(f32x4 (&acc)[G_MI][G_NJ], int rbase, int cbase, int lane) const {
    const int fr = lane & 15, fq = lane >> 4, wid = threadIdx.x >> 6;
    char* w = lds + wid * (96 * 144);
#pragma unroll
    for (int i = 0; i < G_MI; ++i)
#pragma unroll
      for (int j = 0; j < G_NJ; ++j) {
        f32x4 v = acc[i][j];
#pragma unroll
        for (int e = 0; e < 4; ++e) { const float r = fmaxf(v[e], 0.f); v[e] = r * r; }
        *(u32x2*)(w + (i * 16 + fr) * 144 + (j * 16 + fq * 4) * 2) = (u32x2){pack2(v[0], v[1]), pack2(v[2], v[3])};
      }
    const int rr = lane >> 3, ch = lane & 7;
#pragma unroll
    for (int it = 0; it < 12; ++it) {
      const int r = it * 8 + rr;
      const u32x4 v = *(const u32x4*)(w + r * 144 + ch * 16);
      *(u32x4*)(U + (size_t)(rbase + r) * 4096 + cbase + ch * 8) = v;
    }
    lds_barrier();
  }
};

struct EpiConv {
  static constexpr int kMinStores = 0;
  static constexpr bool kPrefetchNext = false;
  bf16_t *Ug, *Pz; char* lds;
  DI void operator()(f32x4 (&acc)[G_MI][G_NJ], int rbase, int cbase, int lane) const {
    const int fr = lane & 15, fq = lane >> 4;
    char* w = lds + (threadIdx.x >> 6) * (96 * 144);
    if (cbase < 1024) {
#pragma unroll
      for (int i = 0; i < G_MI; ++i)
#pragma unroll
        for (int jp = 0; jp < 2; ++jp) {
          const f32x4 a = acc[i][2 * jp], gt = acc[i][2 * jp + 1];
          f32x4 u;
#pragma unroll
          for (int e = 0; e < 4; ++e) u[e] = a[e] / (1.f + __expf(-gt[e]));
          *(u32x2*)(w + (i * 16 + fr) * 80 + (jp * 16 + fq * 4) * 2) = pk4(u);
        }
      const int rr = lane >> 2, ch = lane & 3, c0 = (cbase >> 5) * 16;
#pragma unroll
      for (int it = 0; it < 6; ++it) {
        const int r = it * 16 + rr;
        const u32x4 v = *(const u32x4*)(w + r * 80 + ch * 16);
        *(u32x4*)(Ug + (size_t)(rbase + r) * 512 + c0 + ch * 8) = v;
      }
    } else {
      u32x2 pk[G_MI][G_NJ];
#pragma unroll
      for (int i = 0; i < G_MI; ++i)
#pragma unroll
        for (int j = 0; j < G_NJ; ++j) pk[i][j] = pk4(acc[i][j]);
      wave_rows_store(w, pk, lane, [&](int r) -> bf16_t* { return Pz + (size_t)(rbase + r) * 512 + (cbase - 1024); });
    }
    lds_barrier();
  }
};

#ifndef XCD_ORDER
#define XCD_ORDER 1
#endif
template <class Epi>
DI void gemm_phase(const bf16_t* A, int lda, const bf16_t* Bt, int ldb, int K, int mt, int nt, const Epi& epi, char* smem, int tstart = 0, int ttotal = -1) {
  const int n = mt * nt;
  if (ttotal < 0) ttotal = n;
  const bool xo = XCD_ORDER && gridDim.x == 256 && (nt & 3) == 0 && (mt & 3) == 0 && n % 256 == 0;
  auto coords = [&](int u, int& r0, int& c0) {
    int pm = u / nt, pn = u - pm * nt;
    if (xo) {
      const int r = u >> 8, w = u & 255, x = w & 7, idx = w >> 3;
      const int rows_r = 256 / nt, pw = nt < 8 ? nt : 8, ph = 32 / pw, npx = nt / pw, px = x % npx, py = x / npx;
      pm = r * rows_r + py * ph + idx / pw; pn = px * pw + idx % pw;
    }
    r0 = pm * G_BM; c0 = pn * G_BN;
  };
  int t = blockIdx.x;
  while (t < tstart) t += gridDim.x;
  bool prefetched = false;
  while (t < tstart + n && t < ttotal) {
    const int tn = t + gridDim.x;
    const bool has_next = Epi::kPrefetchNext && tn < tstart + n && tn < ttotal;
    int r0, c0, nr0 = 0, nc0 = 0;
    coords(t - tstart, r0, c0);
    if (has_next) coords(tn - tstart, nr0, nc0);
    gemm_tile(A, lda, Bt, ldb, K, r0, c0, smem, epi, prefetched, has_next, nr0, nc0);
    prefetched = has_next;
    t = tn;
  }
}

DI void rows_phase(const float* src_ctx, const float* src_lat, bool do_ln, const float* lg, const float* lb, float* Xdst,
                   const float* modsL, int sh_off, int sc_off, bf16_t* Hb) {
  const int lane = threadIdx.x & 63, gw = blockIdx.x * NWAVE + (threadIdx.x >> 6), nw = gridDim.x * NWAVE;
  for (int row = gw; row < NTOK; row += nw) {
    const float* src = row < NCTX ? src_ctx + (size_t)row * 1024 : src_lat + (size_t)(row - NCTX) * 1024;
    f32x4 v[4];
#pragma unroll
    for (int i = 0; i < 4; ++i) v[i] = *(const f32x4*)(src + i * 256 + lane * 4);
    if (do_ln) {
      float s = 0.f;
#pragma unroll
      for (int i = 0; i < 4; ++i) s += (v[i][0] + v[i][1]) + (v[i][2] + v[i][3]);
      const float mean = wave_sum(s) * (1.f / 1024.f);
      float q = 0.f;
#pragma unroll
      for (int i = 0; i < 4; ++i)
#pragma unroll
        for (int e = 0; e < 4; ++e) { const float d = v[i][e] - mean; q += d * d; }
      const float rstd = rsqrtf(wave_sum(q) * (1.f / 1024.f) + EPS);
#pragma unroll
      for (int i = 0; i < 4; ++i) {
        const f32x4 g = *(const f32x4*)(lg + i * 256 + lane * 4), b = *(const f32x4*)(lb + i * 256 + lane * 4);
#pragma unroll
        for (int e = 0; e < 4; ++e) v[i][e] = (v[i][e] - mean) * rstd * g[e] + b[e];
        if (Xdst) *(f32x4*)(Xdst + (size_t)row * 1024 + i * 256 + lane * 4) = v[i];
      }
    }
    if (Hb) {
      const float* m = modsL + cond_idx(row) * 6144;
#pragma unroll
      for (int i = 0; i < 4; ++i) {
        const int col = i * 256 + lane * 4;
        const f32x4 sh = *(const f32x4*)(m + sh_off + col), sc = *(const f32x4*)(m + sc_off + col);
        f32x4 h;
#pragma unroll
        for (int e = 0; e < 4; ++e) h[e] = v[i][e] * (1.f + sc[e]) + sh[e];
        u32x2 w = {pack2(h[0], h[1]), pack2(h[2], h[3])};
        *(u32x2*)(Hb + (size_t)row * 1024 + col) = w;
      }
    }
  }
}

DI void modulate_phase(const float* __restrict__ src_ctx, const float* __restrict__ src_lat, const float* __restrict__ modsL, bf16_t* __restrict__ Hb) {
  const int lane = threadIdx.x & 63, gw = blockIdx.x * NWAVE + (threadIdx.x >> 6), nw = gridDim.x * NWAVE;
  for (int r0 = gw * 2; r0 < NTOK; r0 += nw * 2) {
    f32x4 v[2][4];
#pragma unroll
    for (int k = 0; k < 2; ++k) {
      const int row = r0 + k;
      const float* src = row < NCTX ? src_ctx + (size_t)row * 1024 : src_lat + (size_t)(row - NCTX) * 1024;
#pragma unroll
      for (int i = 0; i < 4; ++i) v[k][i] = __builtin_nontemporal_load((const f32x4*)(src + i * 256 + lane * 4));
    }
#pragma unroll
    for (int k = 0; k < 2; ++k) {
      const int row = r0 + k;
      const float* m = modsL + cond_idx(row) * 6144;
#pragma unroll
      for (int i = 0; i < 4; ++i) {
        const int col = i * 256 + lane * 4;
        const f32x4 sh = *(const f32x4*)(m + col), sc = *(const f32x4*)(m + 1024 + col);
        u32x2 w = {pack2(v[k][i][0] * (1.f + sc[0]) + sh[0], v[k][i][1] * (1.f + sc[1]) + sh[1]), pack2(v[k][i][2] * (1.f + sc[2]) + sh[2], v[k][i][3] * (1.f + sc[3]) + sh[3])};
        *(u32x2*)(Hb + (size_t)row * 1024 + col) = w;
      }
    }
  }
}

DI double sin_red(double r) {
  const double r2 = r * r; double t = -1.0 / 51090942171709440000.0;
  t = t * r2 + 1.0 / 121645100408832000.0; t = t * r2 - 1.0 / 355687428096000.0; t = t * r2 + 1.0 / 1307674368000.0; t = t * r2 - 1.0 / 6227020800.0;
  t = t * r2 + 1.0 / 39916800.0; t = t * r2 - 1.0 / 362880.0; t = t * r2 + 1.0 / 5040.0; t = t * r2 - 1.0 / 120.0; t = t * r2 + 1.0 / 6.0;
  return r * (1.0 - r2 * t);
}
DI double cos_red(double r) {
  const double r2 = r * r; double t = 1.0 / 1124000727777607680000.0;
  t = t * r2 - 1.0 / 2432902008176640000.0; t = t * r2 + 1.0 / 6402373705728000.0; t = t * r2 - 1.0 / 20922789888000.0; t = t * r2 + 1.0 / 87178291200.0;
  t = t * r2 - 1.0 / 479001600.0; t = t * r2 + 1.0 / 3628800.0; t = t * r2 - 1.0 / 40320.0; t = t * r2 + 1.0 / 720.0; t = t * r2 - 1.0 / 24.0; t = t * r2 + 0.5; t = t * r2 * -1.0 + 1.0;
  return t;
}

constexpr int J_MODS = 96, J_WEFF = 64, J_CACHE = 64, J_ROPE = 1, J_SLOW = J_MODS + J_WEFF + J_CACHE + J_ROPE;
constexpr int T_ATTIN = 16 * 16, T_UQ = 4 * 6, T_UKV = 2 * 8, T_ATTOUT = 16 * 8, T_MLPIN = 16 * 32, T_MLPOUT = 64 * 8, T_CONVIN = 16 * 12, T_CONVOUT = 8 * 8;
constexpr int J_TR = T_ATTIN + T_UQ + T_UKV + T_ATTOUT + 2 * T_MLPIN + 2 * T_MLPOUT + T_CONVIN + T_CONVOUT;

struct TJ { const float* src; bf16_t* dst; int N, nvalid, lddst, perm, kt, nt; };
DI TJ tr_decode(const Params& p, int j) {
  char* ws = p.ws;
  TJ t; t.perm = 0;
  if (j < T_ATTIN) { t.src = p.w_att_in; t.N = 1952; t.nvalid = 1952; t.dst = (bf16_t*)(ws + O_WATTIN); t.lddst = 1024; t.kt = j / 16; t.nt = j % 16; return t; }
  j -= T_ATTIN;
  if (j < T_UQ) { t.src = p.w_uq; t.N = 768; t.nvalid = 768; t.dst = (bf16_t*)(ws + O_WUQ); t.lddst = 256; t.kt = j / 6; t.nt = j % 6; return t; }
  j -= T_UQ;
  if (j < T_UKV) { t.src = p.w_ukv; t.N = 1024; t.nvalid = 1024; t.dst = (bf16_t*)(ws + O_WUKV); t.lddst = 128; t.kt = j / 8; t.nt = j % 8; return t; }
  j -= T_UKV;
  if (j < T_ATTOUT) { t.src = p.w_att_out; t.N = 1024; t.nvalid = 1024; t.dst = (bf16_t*)(ws + O_WATTOUT); t.lddst = 1024; t.kt = j / 8; t.nt = j % 8; return t; }
  j -= T_ATTOUT;
  if (j < 2 * T_MLPIN) { const int l = j / T_MLPIN, u = j % T_MLPIN; t.src = p.w_mlp_in + (size_t)l * 1024 * 4096; t.N = 4096; t.nvalid = 4096; t.dst = (bf16_t*)(ws + O_WMLPIN) + (size_t)l * 4096 * 1024; t.lddst = 1024; t.kt = u / 32; t.nt = u % 32; return t; }
  j -= 2 * T_MLPIN;
  if (j < 2 * T_MLPOUT) { const int l = j / T_MLPOUT, u = j % T_MLPOUT; t.src = p.w_mlp_out + (size_t)l * 4096 * 1024; t.N = 1024; t.nvalid = 1024; t.dst = (bf16_t*)(ws + O_WMLPOUT) + (size_t)l * 4096 * 1024; t.lddst = 4096; t.kt = u / 8; t.nt = u % 8; return t; }
  j -= 2 * T_MLPOUT;
  if (j < T_CONVIN) { t.src = p.w_conv_in; t.N = 1536; t.nvalid = 1536; t.dst = (bf16_t*)(ws + O_WCONVIN); t.lddst = 1024; t.perm = 1; t.kt = j / 12; t.nt = j % 12; return t; }
  j -= T_CONVIN;
  t.src = p.w_conv_out; t.N = 1024; t.nvalid = 1024; t.dst = (bf16_t*)(ws + O_WCONVOUT); t.lddst = 1024; t.kt = j / 8; t.nt = j % 8; return t;
}
DI void tr_load(const TJ& t, float (&v)[16]) {
  const int tid = threadIdx.x, n4 = (tid & 31) * 4, kb = tid >> 5;
  const int gn = t.nt * 128 + n4;
  const float* s = t.src + (size_t)(t.kt * 64 + kb) * t.N + gn;
#pragma unroll
  for (int i = 0; i < 4; ++i) {
    f32x4 x = {0.f, 0.f, 0.f, 0.f};
    if (gn < t.nvalid) x = *(const f32x4*)(s + (size_t)(16 * i) * t.N);
    v[4 * i] = x[0]; v[4 * i + 1] = x[1]; v[4 * i + 2] = x[2]; v[4 * i + 3] = x[3];
  }
}

DI void phase0(const Params& p, char* smem) {
  const int tid = threadIdx.x, lane = tid & 63, wid = tid >> 6;
  char* ws = p.ws;
  for (int job = blockIdx.x; job < J_SLOW; job += gridDim.x) {
    int j = job;
    if (j < J_MODS) {
      const int l = j / 48, cc = j % 48;
      float* sc = (float*)smem;
      for (int i = tid; i < 3072; i += NT) { const int ci = i >> 10, k = i & 1023; const float x = ci == 0 ? p.c_ctx[k] : p.c[(ci - 1) * 1024 + k]; sc[i] = x / (1.f + __expf(-x)); }
      __syncthreads();
      const int kg = tid >> 5, c4 = (tid & 31) * 4;
      const float* w = p.w_ada + (size_t)l * 1024 * 6144 + cc * 128 + c4;
      f32x4 s0 = {0.f, 0.f, 0.f, 0.f}, s1 = s0, s2 = s0;
#pragma unroll 16
      for (int k = kg * 64; k < kg * 64 + 64; ++k) {
        const f32x4 wv = __builtin_nontemporal_load((const f32x4*)(w + (size_t)k * 6144));
        const float a = sc[k], b = sc[1024 + k], c = sc[2048 + k];
#pragma unroll
        for (int e = 0; e < 4; ++e) { s0[e] += a * wv[e]; s1[e] += b * wv[e]; s2[e] += c * wv[e]; }
      }
      f32x4* r = (f32x4*)(smem + 12288);
      r[(kg * 3 + 0) * 32 + (tid & 31)] = s0; r[(kg * 3 + 1) * 32 + (tid & 31)] = s1; r[(kg * 3 + 2) * 32 + (tid & 31)] = s2;
      __syncthreads();
      if (tid < 96) {
        const int ci = tid >> 5, q = tid & 31;
        f32x4 s = {0.f, 0.f, 0.f, 0.f};
#pragma unroll
        for (int g = 0; g < 16; ++g) { const f32x4 t4 = r[(g * 3 + ci) * 32 + q]; s[0] += t4[0]; s[1] += t4[1]; s[2] += t4[2]; s[3] += t4[3]; }
        const f32x4 bb = *(const f32x4*)(p.b_ada + l * 6144 + cc * 128 + q * 4);
        *(f32x4*)((float*)(ws + O_MODS) + (size_t)(l * 3 + ci) * 6144 + cc * 128 + q * 4) = (f32x4){s[0] + bb[0], s[1] + bb[1], s[2] + bb[2], s[3] + bb[3]};
      }
      __syncthreads();
      continue;
    }
    j -= J_MODS;
    if (j < J_WEFF) {
      const int g = j >> 4, cch = (j >> 1) & 7, nch = j & 1;
      float* wp = (float*)smem;
      for (int i = tid; i < 2048; i += NT) wp[i] = p.w_pool[(size_t)(g * 128 + cch * 16 + (i >> 7)) * 128 + (i & 127)];
      __syncthreads();
      const int n = nch * 512 + tid;
      float a[16];
#pragma unroll
      for (int c = 0; c < 16; ++c) a[c] = 0.f;
#pragma unroll 16
      for (int e = 0; e < 128; ++e) {
        const float wo = p.w_conv_out[(size_t)(512 + g * 128 + e) * 1024 + n] * p.pool_scale[g * 128 + e];
#pragma unroll
        for (int c = 0; c < 16; ++c) a[c] += wp[c * 128 + e] * wo;
      }
      bf16_t* d = (bf16_t*)(ws + O_WCONVOUT) + (size_t)n * 1024 + 512 + g * 128 + cch * 16;
      *(u32x4*)d = (u32x4){pack2(a[0], a[1]), pack2(a[2], a[3]), pack2(a[4], a[5]), pack2(a[6], a[7])};
      *(u32x4*)(d + 8) = (u32x4){pack2(a[8], a[9]), pack2(a[10], a[11]), pack2(a[12], a[13]), pack2(a[14], a[15])};
      __syncthreads();
      continue;
    }
    j -= J_WEFF;
    if (j < J_CACHE) {
      const int rr = j * 8 + wid, b = rr >> 8, t = rr & 255;
      const size_t kr = NCTX + (size_t)b * TKL + t;
      const f32x4 a0 = *(const f32x4*)(p.cache_k + (size_t)rr * 512 + lane * 8), a1 = *(const f32x4*)(p.cache_k + (size_t)rr * 512 + lane * 8 + 4);
      *(u32x4*)((bf16_t*)(ws + O_KD) + kr * 512 + lane * 8) = (u32x4){pack2(a0[0], a0[1]), pack2(a0[2], a0[3]), pack2(a1[0], a1[1]), pack2(a1[2], a1[3])};
      const f32x4 b0 = *(const f32x4*)(p.cache_v + (size_t)rr * 512 + lane * 8), b1 = *(const f32x4*)(p.cache_v + (size_t)rr * 512 + lane * 8 + 4);
      *(u32x4*)((bf16_t*)(ws + O_VD) + kr * 512 + lane * 8) = (u32x4){pack2(b0[0], b0[1]), pack2(b0[2], b0[3]), pack2(b1[0], b1[1]), pack2(b1[2], b1[3])};
      const f32x2 cv = *(const f32x2*)(p.cache_ckv + (size_t)rr * 128 + lane * 2);
      *(unsigned*)((bf16_t*)(ws + O_CKVN) + kr * 128 + lane * 2) = pack2(cv[0], cv[1]);
      const int idx = lane & 31;
      const float x = p.cache_krope[(size_t)rr * 32 + idx];
      const unsigned pk = pack2(x, x);
#pragma unroll
      for (int k = 0; k < 4; ++k) { const int hh = (lane >> 5) + 2 * k; ((bf16_t*)(ws + O_KMLA))[kr * 768 + hh * 96 + 64 + idx] = (bf16_t)(pk & 0xffff); }
      continue;
    }
    j -= J_CACHE;
    {
      float* c16 = (float*)(ws + O_C16); float* s16 = (float*)(ws + O_S16); float* c8 = (float*)(ws + O_C8); float* s8 = (float*)(ws + O_S8);
      for (int i = tid; i < 1024 + 512; i += NT) {
        int pos, f, half;
        if (i < 1024) { pos = i >> 4; f = i & 15; half = 16; } else { const int q = i - 1024; pos = q >> 3; f = q & 7; half = 8; }
        const float inv = (float)exp(-9.210340371976184 * (double)f / (double)half);
        const float angf = (float)pos * inv;
        const double ang = (double)angf;
        const double r = ang - 6.283185307179586 * rint(ang * 0.15915494309189535);
        const float cs = (float)cos_red(r), sn = (float)sin_red(r);
        if (i < 1024) { c16[i] = cs; s16[i] = sn; } else { c8[i - 1024] = cs; s8[i - 1024] = sn; }
      }
      if (wid == 0) {
        const float d1 = wave_sum(p.lam_q1[lane] * p.lam_k1[lane]), d2 = wave_sum(p.lam_q2[lane] * p.lam_k2[lane]);
        if (lane == 0) ((float*)(ws + O_SCAL))[0] = expf(d1) - expf(d2) + 0.2f;
      }
    }
  }
  {
    float* tile = (float*)smem;
    const int G = gridDim.x;
    int j = (blockIdx.x + G - (J_SLOW % G)) % G;
    float va[16], vb[16];
    TJ ta, tb;
    if (j < J_TR) { ta = tr_decode(p, j); tr_load(ta, va); } else ta = TJ{};
    if (j + G < J_TR) { tb = tr_decode(p, j + G); tr_load(tb, vb); } else tb = ta;
#define TR_STEP(V, T, jj_) do { \
      { const int n4 = (tid & 31) * 4, kb = tid >> 5; \
        _Pragma("unroll") for (int i = 0; i < 4; ++i) \
          _Pragma("unroll") for (int e = 0; e < 4; ++e) tile[(kb + 16 * i) * 129 + n4 + e] = V[4 * i + e]; } \
      __syncthreads(); \
      const TJ cur = T; \
      if ((jj_) + 2 * G < J_TR) { T = tr_decode(p, (jj_) + 2 * G); tr_load(T, V); }     \
      _Pragma("unroll") for (int ps = 0; ps < 2; ++ps) {     \
        const int n = ps * 64 + (tid >> 3), ks = (tid & 7) * 8; \
        int gn = cur.nt * 128 + n; \
        if (cur.perm) { if (gn < 512) gn = 32 * (gn >> 4) + (gn & 15); else if (gn < 1024) { const int c = gn - 512; gn = 32 * (c >> 4) + 16 + (c & 15); } } \
        unsigned w[4]; \
        _Pragma("unroll") for (int e = 0; e < 4; ++e) w[e] = pack2(tile[(ks + 2 * e) * 129 + n], tile[(ks + 2 * e + 1) * 129 + n]); \
        *(u32x4*)(cur.dst + (size_t)gn * cur.lddst + cur.kt * 64 + ks) = (u32x4){w[0], w[1], w[2], w[3]}; } \
      __syncthreads(); } while (0)
    while (j < J_TR) {
      TR_STEP(va, ta, j);
      j += G;
      if (j >= J_TR) break;
      TR_STEP(vb, tb, j);
      j += G;
    }
#undef TR_STEP
  }
}

DI void rope8(const float (&x)[8], float (&o)[8], int lane, const float* c16, const float* s16, int prow, int pcol) {
  const int L = lane & 7;
  const int pos = (L & 4) ? pcol : prow;
  const bool second = (L & 2) != 0;
  const int fb = (L & 1) * 8;
#pragma unroll
  for (int e = 0; e < 8; ++e) {
    const float y = __shfl_xor(x[e], 2);
    const float cs = c16[pos * 16 + fb + e], sn = s16[pos * 16 + fb + e];
    o[e] = second ? (y * sn + x[e] * cs) : (x[e] * cs - y * sn);
  }
}
DI void unpack8(const u32x4 w, float (&x)[8]) {
#pragma unroll
  for (int e = 0; e < 4; ++e) { x[2 * e] = bflo(w[e]); x[2 * e + 1] = bfhi(w[e]); }
}
DI u32x4 pack8(const float (&x)[8]) { return (u32x4){pack2(x[0], x[1]), pack2(x[2], x[3]), pack2(x[4], x[5]), pack2(x[6], x[7])}; }

DI void phase3(const Params& p) {
  char* ws = p.ws;
  const bf16_t* R = (const bf16_t*)(ws + O_R);
  bf16_t* Qda = (bf16_t*)(ws + O_QDA); bf16_t* Qdb = (bf16_t*)(ws + O_QDB); bf16_t* Kd = (bf16_t*)(ws + O_KD); bf16_t* Vd = (bf16_t*)(ws + O_VD);
  bf16_t* cqn = (bf16_t*)(ws + O_CQN); bf16_t* ckvn = (bf16_t*)(ws + O_CKVN); bf16_t* Km = (bf16_t*)(ws + O_KMLA);
  const float* c16 = (const float*)(ws + O_C16); const float* s16 = (const float*)(ws + O_S16); const float* c8 = (const float*)(ws + O_C8); const float* s8 = (const float*)(ws + O_S8);
  float* o_k = p.out + (size_t)NTOK * 1024; float* o_v = o_k + (size_t)NCTX * 512; float* o_ckv = o_v + (size_t)NCTX * 512; float* o_kr = o_ckv + (size_t)NCTX * 128;
  const int lane = threadIdx.x & 63, gw = blockIdx.x * NWAVE + (threadIdx.x >> 6), nw = gridDim.x * NWAVE;
  for (int row = gw; row < NTOK; row += nw) {
    const bool lat = row >= NCTX;
    const int rl = row - NCTX, b = rl >> 12, t = rl & (TLAT - 1), prow = t >> 6, pcol = t & 63;
    const size_t kr = lat ? (size_t)NCTX + (size_t)b * TKL + 256 + t : (size_t)row;
    const bf16_t* r = R + (size_t)row * RLD;
    float x[8], o[8];
    const u32x4 wq = *(const u32x4*)(r + lane * 8);
    *(u32x4*)(Qda + (size_t)row * 512 + lane * 8) = wq;
    if (lat) { unpack8(wq, x); rope8(x, o, lane, c16, s16, prow, pcol); *(u32x4*)(Qdb + (size_t)rl * 512 + lane * 8) = pack8(o); }
    const u32x4 wk = *(const u32x4*)(r + 512 + lane * 8);
    if (lat) { unpack8(wk, x); rope8(x, o, lane, c16, s16, prow, pcol); *(u32x4*)(Kd + kr * 512 + lane * 8) = pack8(o); }
    else {
      unpack8(wk, x);
      *(f32x4*)(o_k + (size_t)row * 512 + lane * 8) = (f32x4){x[0], x[1], x[2], x[3]};
      *(f32x4*)(o_k + (size_t)row * 512 + lane * 8 + 4) = (f32x4){x[4], x[5], x[6], x[7]};
      *(u32x4*)(Kd + kr * 512 + lane * 8) = wk;
    }
    const u32x4 wv = *(const u32x4*)(r + 1024 + lane * 8);
    *(u32x4*)(Vd + kr * 512 + lane * 8) = wv;
    if (!lat) {
      unpack8(wv, x);
      *(f32x4*)(o_v + (size_t)row * 512 + lane * 8) = (f32x4){x[0], x[1], x[2], x[3]};
      *(f32x4*)(o_v + (size_t)row * 512 + lane * 8 + 4) = (f32x4){x[4], x[5], x[6], x[7]};
    }
    {
      const u32x2 w = *(const u32x2*)(r + 1536 + lane * 4);
      const float a0 = bflo(w[0]), a1 = bfhi(w[0]), a2 = bflo(w[1]), a3 = bfhi(w[1]);
      const float ss = wave_sum(a0 * a0 + a1 * a1 + a2 * a2 + a3 * a3);
      const float sc = rsqrtf(ss * (1.f / 256.f) + EPS);
      const f32x4 g = *(const f32x4*)(p.q_norm_g + lane * 4);
      *(u32x2*)(cqn + (size_t)row * 256 + lane * 4) = (u32x2){pack2(a0 * sc * g[0], a1 * sc * g[1]), pack2(a2 * sc * g[2], a3 * sc * g[3])};
    }
    {
      const unsigned w = *(const unsigned*)(r + 1792 + lane * 2);
      const float a0 = bflo(w), a1 = bfhi(w);
      const float ss = wave_sum(a0 * a0 + a1 * a1);
      const float sc = rsqrtf(ss * (1.f / 128.f) + EPS);
      const f32x2 g = *(const f32x2*)(p.kv_norm_g + lane * 2);
      const float y0 = a0 * sc * g[0], y1 = a1 * sc * g[1];
      if (!lat) *(f32x2*)(o_ckv + (size_t)row * 128 + lane * 2) = (f32x2){y0, y1};
      *(unsigned*)(ckvn + kr * 128 + lane * 2) = pack2(y0, y1);
    }
    {
      const int idx = lane & 31;
      const float xv = bf2f(r[1920 + idx]);
      float ov = xv;
      if (lat) {
        const int pos = (idx & 16) ? pcol : prow;
        const int f = idx & 7;
        const float y = __shfl_xor(xv, 8);
        const float cs = c8[pos * 8 + f], sn = s8[pos * 8 + f];
        ov = (idx & 8) ? (y * sn + xv * cs) : (xv * cs - y * sn);
      } else if (lane < 32) o_kr[(size_t)row * 32 + idx] = xv;
      const bf16_t ob = (bf16_t)(pack2(ov, ov) & 0xffff);
#pragma unroll
      for (int k = 0; k < 4; ++k) { const int hh = (lane >> 5) + 2 * k; Km[kr * 768 + hh * 96 + 64 + idx] = ob; }
    }
  }
}

template <int DQK, int DV>
DI void attn_core(const bf16_t* __restrict__ Qa, const bf16_t* __restrict__ Qb, int ldq, const bf16_t* __restrict__ Kp, int ldk, const bf16_t* __restrict__ Vp, int ldv,
                  int Tk, int n_a, float c  , char* smem, f32x16 (&o)[DV / 32]) {
  constexpr int KS = DQK * 2 + 16, VS = DV * 2 + 64, BUF = 64 * (KS + VS);
  constexpr int KCH = DQK / 8, VCH = DV / 8, NKCH = 64 * KCH, NVCH = 64 * VCH, NKC = (NKCH + NT - 1) / NT, NVC = (NVCH + NT - 1) / NT;
  constexpr bool KG = (NKCH % NT) != 0, VG = (NVCH % NT) != 0;
  constexpr int NS = DQK / 16, NDT = DV / 32;
  const int tid = threadIdx.x, lane = tid & 63, wid = tid >> 6, h = lane >> 5, ql = lane & 31;
  bf16x8 qf[NS];
  {
    const bf16_t* q = Qa + (size_t)(wid * 32 + ql) * ldq + h * 8;
#pragma unroll
    for (int s = 0; s < NS; ++s) qf[s] = *(const bf16x8*)(q + s * 16);
  }
#pragma unroll
  for (int dt = 0; dt < NDT; ++dt)
#pragma unroll
    for (int r = 0; r < 16; ++r) o[dt][r] = 0.f;
  float m_run = -INFINITY, l_run = 0.f;
  u32x4 rkA[NKC], rvA[NVC], rkB[NKC], rvB[NVC];
  const int nt = Tk >> 6, ta = n_a >> 6;
  unsigned koff[NKC], voff[NVC];
#pragma unroll
  for (int i = 0; i < NKC; ++i) { const int ch = (tid + NT * i) % NKCH, row = ch / KCH, kc = ch % KCH; koff[i] = (unsigned)(row * ldk + kc * 8); }
#pragma unroll
  for (int i = 0; i < NVC; ++i) { const int ch = (tid + NT * i) % NVCH, row = ch / VCH, vc = ch % VCH; voff[i] = (unsigned)(row * ldv + vc * 8); }
  auto gload = [&](u32x4 (&rk)[NKC], u32x4 (&rv)[NVC], int t) {
    const bf16_t* kb = Kp + (size_t)t * 64 * ldk;
    const bf16_t* vbp = Vp + (size_t)t * 64 * ldv;
#pragma unroll
    for (int i = 0; i < NKC; ++i) rk[i] = *(const u32x4*)(kb + koff[i]);
#pragma unroll
    for (int i = 0; i < NVC; ++i) rv[i] = *(const u32x4*)(vbp + voff[i]);
  };
  auto lstore = [&](u32x4 (&rk)[NKC], u32x4 (&rv)[NVC], char* buf) {
#pragma unroll
    for (int i = 0; i < NKC; ++i) { const int ch = tid + NT * i, row = ch / KCH, kc = ch % KCH; if (!KG || i + 1 < NKC || ch < NKCH) *(u32x4*)(buf + row * KS + kc * 16) = rk[i]; }
#pragma unroll
    for (int i = 0; i < NVC; ++i) { const int ch = tid + NT * i, row = ch / VCH, vc = ch % VCH; if (!VG || i + 1 < NVC || ch < NVCH) *(u32x4*)(buf + 64 * KS + row * VS + vc * 16) = rv[i]; }
  };
  gload(rkA, rvA, 0); lstore(rkA, rvA, smem); lds_barrier();
  gload(rkA, rvA, min(1, nt - 1));
  const int i16 = lane & 15, tq = i16 >> 2, tp = i16 & 3, G = (lane >> 4) & 1;
  auto compute = [&](const char* cur) {
    f32x16 st[2];
    bf16x8 kf[2][NS];
#pragma unroll
    for (int kt = 0; kt < 2; ++kt)
#pragma unroll
      for (int s = 0; s < NS; ++s) kf[kt][s] = *(const bf16x8*)(cur + (kt * 32 + ql) * KS + s * 32 + h * 16);
#pragma unroll
    for (int kt = 0; kt < 2; ++kt) {
#pragma unroll
      for (int r = 0; r < 16; ++r) st[kt][r] = 0.f;
#pragma unroll
      for (int s = 0; s < NS; ++s) st[kt] = __builtin_amdgcn_mfma_f32_32x32x16_bf16(kf[kt][s], qf[s], st[kt], 0, 0, 0);
    }
    __builtin_amdgcn_sched_barrier(0);
    float mx = st[0][0];
#pragma unroll
    for (int kt = 0; kt < 2; ++kt)
#pragma unroll
      for (int r = 0; r < 16; ++r) mx = fmaxf(mx, st[kt][r]);
    mx = fmaxf(mx, __shfl_xor(mx, 32));
    const float m_new = fmaxf(m_run, mx);
    const float alpha = __builtin_amdgcn_exp2f((m_run - m_new) * c);
    const float mc = m_new * c;
    m_run = m_new;
    float ls = 0.f;
#pragma unroll
    for (int kt = 0; kt < 2; ++kt)
#pragma unroll
      for (int r = 0; r < 16; ++r) { const float pv = __builtin_amdgcn_exp2f(st[kt][r] * c - mc); st[kt][r] = pv; ls += pv; }
    l_run = l_run * alpha + ls;
    if (__any(alpha != 1.f)) {
#pragma unroll
      for (int dt = 0; dt < NDT; ++dt)
#pragma unroll
        for (int r = 0; r < 16; ++r) o[dt][r] *= alpha;
    }
    bf16x8 pf[2][2];
#pragma unroll
    for (int kt = 0; kt < 2; ++kt)
#pragma unroll
      for (int s2 = 0; s2 < 2; ++s2) {
        u32x4 w = {pack2(st[kt][8 * s2 + 0], st[kt][8 * s2 + 1]), pack2(st[kt][8 * s2 + 2], st[kt][8 * s2 + 3]), pack2(st[kt][8 * s2 + 4], st[kt][8 * s2 + 5]), pack2(st[kt][8 * s2 + 6], st[kt][8 * s2 + 7])};
        pf[kt][s2] = __builtin_bit_cast(bf16x8, w);
      }
    const char* vb = cur + 64 * KS + (4 * h + tq) * VS + 32 * G + 8 * tp;
    bf16x8 vfa[NDT], vfb[NDT];
#define A_VLOAD(VF, g_) do { \
      _Pragma("unroll") for (int dt = 0; dt < NDT; ++dt) { \
        const char* a0 = vb + (((g_) >> 1) * 32 + 16 * ((g_) & 1)) * VS + dt * 64; \
        const s16x4 lo = __builtin_amdgcn_ds_read_tr16_b64_v4i16((LDS_AS s16x4*)(a0)); \
        const s16x4 hi = __builtin_amdgcn_ds_read_tr16_b64_v4i16((LDS_AS s16x4*)(a0 + 8 * VS)); \
        VF[dt] = __builtin_shufflevector(lo, hi, 0, 1, 2, 3, 4, 5, 6, 7); } } while (0)
#define A_VMMA(VF, g_) do { \
      _Pragma("unroll") for (int dt = 0; dt < NDT; ++dt) o[dt] = __builtin_amdgcn_mfma_f32_32x32x16_bf16(VF[dt], pf[(g_) >> 1][(g_) & 1], o[dt], 0, 0, 0); } while (0)
    A_VLOAD(vfa, 0);
    A_VLOAD(vfb, 1);
    __builtin_amdgcn_sched_barrier(0);
    A_VMMA(vfa, 0);
    __builtin_amdgcn_sched_barrier(0);
    A_VLOAD(vfa, 2);
    __builtin_amdgcn_sched_barrier(0);
    A_VMMA(vfb, 1);
    __builtin_amdgcn_sched_barrier(0);
    A_VLOAD(vfb, 3);
    __builtin_amdgcn_sched_barrier(0);
    A_VMMA(vfa, 2);
    __builtin_amdgcn_sched_barrier(0);
    A_VMMA(vfb, 3);
#undef A_VLOAD
#undef A_VMMA
  };
  auto run_tiles = [&](int t_begin, int t_end) {
    for (int t = t_begin; t < t_end; t += 2) {
      gload(rkB, rvB, min(t + 2, nt - 1));
      compute(smem);
      lstore(rkA, rvA, smem + BUF);
      lds_barrier();
      gload(rkA, rvA, min(t + 3, nt - 1));
      compute(smem + BUF);
      lstore(rkB, rvB, smem);
      lds_barrier();
    }
  };
  run_tiles(0, min(ta, nt));
  if (ta < nt) {
    const bf16_t* q = Qb + (size_t)(wid * 32 + ql) * ldq + h * 8;
#pragma unroll
    for (int s = 0; s < NS; ++s) qf[s] = *(const bf16x8*)(q + s * 16);
    run_tiles(ta, nt);
  }
  const float l = l_run + __shfl_xor(l_run, 32);
  const float inv = 1.f / l;
#pragma unroll
  for (int dt = 0; dt < NDT; ++dt)
#pragma unroll
    for (int r = 0; r < 16; ++r) o[dt][r] *= inv;
}

constexpr int U_DBIG = 128, U_MBIG = 256, U_DCTX = 64, U_MCTX = 128, U_TOTAL = U_DBIG + U_MBIG + U_DCTX + U_MCTX;

DI void phase_attn(const Params& p, char* smem, int cidx) {
  char* ws = p.ws;
  const bf16_t* Qda = (const bf16_t*)(ws + O_QDA); const bf16_t* Qdb = (const bf16_t*)(ws + O_QDB); const bf16_t* Kd = (const bf16_t*)(ws + O_KD); const bf16_t* Vd = (const bf16_t*)(ws + O_VD);
  const bf16_t* Qma = (const bf16_t*)(ws + O_QMA); const bf16_t* Qmb = (const bf16_t*)(ws + O_QMB); const bf16_t* Km = (const bf16_t*)(ws + O_KMLA); const bf16_t* Vm = (const bf16_t*)(ws + O_VMLA);
  bf16_t* cat = (bf16_t*)(ws + O_HB);
  float* otmp = (float*)(ws + O_OTMP) + (size_t)blockIdx.x * 32768;
  int* counter = (int*)(ws + O_CNT) + cidx;
  int* s_unit = (int*)(smem + 65532);
  const int tid = threadIdx.x, lane = tid & 63, wid = tid >> 6, h2 = lane >> 5, ql = lane & 31;
  const float lam = ((const float*)(ws + O_SCAL))[0];
  for (;;) {
    if (tid == 0) *s_unit = atomicAdd(counter, 1);
    __syncthreads();
    int u = __builtin_amdgcn_readfirstlane(*s_unit);
    __syncthreads();
    if (u >= U_TOTAL) break;
    bool diff; int qrow0, krow0, Tk, n_a, head; bool lat;
    if (u < U_DBIG) { diff = true; lat = true; const int b = u >> 6, hh = (u >> 4) & 3, qb = u & 15; head = hh; qrow0 = NCTX + b * TLAT + qb * 256; krow0 = NCTX + b * TKL; Tk = TKL; n_a = 256; }
    else if (u < U_DBIG + U_MBIG) { u -= U_DBIG; diff = false; lat = true; const int b = u >> 7, hh = (u >> 4) & 7, qb = u & 15; head = hh; qrow0 = NCTX + b * TLAT + qb * 256; krow0 = NCTX + b * TKL; Tk = TKL; n_a = 256; }
    else if (u < U_DBIG + U_MBIG + U_DCTX) { u -= U_DBIG + U_MBIG; diff = true; lat = false; const int sq = u >> 2, hh = u & 3; head = hh; qrow0 = sq * 256; krow0 = sq * 256; Tk = 256; n_a = 256; }
    else { u -= U_DBIG + U_MBIG + U_DCTX; diff = false; lat = false; const int sq = u >> 3, hh = u & 7; head = hh; qrow0 = sq * 256; krow0 = sq * 256; Tk = 256; n_a = 256; }
    const int qrowb = lat ? qrow0 - NCTX : 0;
    if (diff) {
      f32x16 o[4];
      const float c = 0.125f * 1.4426950408889634f;
#pragma unroll 1
      for (int m = 0; m < 2; ++m) {
        attn_core<64, 128>(Qda + (size_t)qrow0 * 512 + head * 128 + m * 64, Qdb + (size_t)qrowb * 512 + head * 128 + m * 64, 512,
                           Kd + (size_t)krow0 * 512 + head * 128 + m * 64, 512, Vd + (size_t)krow0 * 512 + head * 128, 512, Tk, n_a, c, smem, o);
        if (m == 0) {
#pragma unroll
          for (int dt = 0; dt < 4; ++dt)
#pragma unroll
            for (int rq = 0; rq < 4; ++rq) *(f32x4*)(otmp + tid * 64 + dt * 16 + rq * 4) = (f32x4){o[dt][4 * rq], o[dt][4 * rq + 1], o[dt][4 * rq + 2], o[dt][4 * rq + 3]};
        }
      }
      float ss = 0.f;
#pragma unroll
      for (int dt = 0; dt < 4; ++dt)
#pragma unroll
        for (int rq = 0; rq < 4; ++rq) {
          const f32x4 o0 = *(const f32x4*)(otmp + tid * 64 + dt * 16 + rq * 4);
#pragma unroll
          for (int e = 0; e < 4; ++e) { const float v = o0[e] - lam * o[dt][4 * rq + e]; o[dt][4 * rq + e] = v; ss += v * v; }
        }
      ss += __shfl_xor(ss, 32);
      const float sc = rsqrtf(ss * (1.f / 128.f) + EPS) * 0.8f;
      bf16_t* dst = cat + (size_t)(qrow0 + wid * 32 + ql) * 1024 + head * 128;
#pragma unroll
      for (int dt = 0; dt < 4; ++dt)
#pragma unroll
        for (int rq = 0; rq < 4; ++rq) {
          const int dv = dt * 32 + 8 * rq + 4 * h2;
          const f32x4 g = *(const f32x4*)(p.diff_norm_g + dv);
          u32x2 w = {pack2(o[dt][4 * rq] * sc * g[0], o[dt][4 * rq + 1] * sc * g[1]), pack2(o[dt][4 * rq + 2] * sc * g[2], o[dt][4 * rq + 3] * sc * g[3])};
          *(u32x2*)(dst + dv) = w;
        }
    } else {
      f32x16 o[2];
      const float c = 0.10206207261596575f * 1.4426950408889634f;
      attn_core<96, 64>(Qma + (size_t)qrow0 * 768 + head * 96, Qmb + (size_t)qrowb * 768 + head * 96, 768,
                        Km + (size_t)krow0 * 768 + head * 96, 768, Vm + (size_t)krow0 * 512 + head * 64, 512, Tk, n_a, c, smem, o);
      bf16_t* dst = cat + (size_t)(qrow0 + wid * 32 + ql) * 1024 + 512 + head * 64;
#pragma unroll
      for (int dt = 0; dt < 2; ++dt)
#pragma unroll
        for (int rq = 0; rq < 4; ++rq) {
          const int dv = dt * 32 + 8 * rq + 4 * h2;
          u32x2 w = {pack2(o[dt][4 * rq], o[dt][4 * rq + 1]), pack2(o[dt][4 * rq + 2], o[dt][4 * rq + 3])};
          *(u32x2*)(dst + dv) = w;
        }
    }
  }
}

template <int HW>
DI void pool_unit(const bf16_t* __restrict__ Pz, bf16_t* __restrict__ cat, int t0, int s0, int s1, int ch) {
  float v0[16 + 2 * HW], v1[16 + 2 * HW];
#pragma unroll
  for (int i = 0; i < 16 + 2 * HW; ++i) {
    const int r = t0 - HW + i;
    unsigned w = 0u;
    if (r >= s0 && r < s1) w = *(const unsigned*)(Pz + (size_t)r * 512 + ch);
    v0[i] = bflo(w); v1[i] = bfhi(w);
  }
#pragma unroll
  for (int o = 0; o < 16; ++o) {
    const int r = t0 + o;
    float a0 = 0.f, a1 = 0.f;
#pragma unroll
    for (int d = 0; d < 2 * HW; ++d) { a0 += v0[o + d]; a1 += v1[o + d]; }
    const int lo = max(r - HW, s0), hi = min(r + HW - 1, s1 - 1);
    const float ic = 1.f / (float)(hi - lo + 1);
    *(unsigned*)(cat + (size_t)r * 1024 + 512 + ch) = pack2(a0 * ic - v0[o + HW], a1 * ic - v1[o + HW]);
  }
}

DI void phase_conv(const Params& p, char* smem) {
  char* ws = p.ws;
  const bf16_t* Ug = (const bf16_t*)(ws + O_UG); const bf16_t* Pz = (const bf16_t*)(ws + O_PZ);
  bf16_t* cat = (bf16_t*)(ws + O_HB);
  const int tid = threadIdx.x, lane = tid & 63, half = tid >> 8, ht = tid & 255, hw4 = (tid >> 6) & 3;
  float* tile = (float*)smem + half * 8192;
  for (int up = blockIdx.x; up < NTOK / 32; up += gridDim.x) {
    const int t0 = (up * 2 + half) * 16;
    const int s0 = t0 < NCTX ? (t0 & ~255) : NCTX + ((t0 - NCTX) & ~(TLAT - 1));
    const int s1 = t0 < NCTX ? s0 + 256 : s0 + TLAT;
    {
      const int ch = ht * 2;
      f32x2 w[31];
#pragma unroll
      for (int j = 0; j < 31; ++j) w[j] = *(const f32x2*)(p.conv_w + j * 512 + ch);
      const f32x2 bias = *(const f32x2*)(p.conv_b + ch);
#pragma unroll 1
      for (int hf = 0; hf < 2; ++hf) {
        float a0[8], a1[8];
#pragma unroll
        for (int o = 0; o < 8; ++o) { a0[o] = 0.f; a1[o] = 0.f; }
#pragma unroll
        for (int i = 0; i < 38; ++i) {
          const int r = t0 + hf * 8 - 15 + i;
          float u0 = 0.f, u1 = 0.f;
          if (r >= s0 && r < s1) { const unsigned v = *(const unsigned*)(Ug + (size_t)r * 512 + ch); u0 = bflo(v); u1 = bfhi(v); }
#pragma unroll
          for (int o = 0; o < 8; ++o) {
            const int j = i - o;
            if (j >= 0 && j <= 30) { a0[o] += u0 * w[j][0]; a1[o] += u1 * w[j][1]; }
          }
        }
#pragma unroll
        for (int o = 0; o < 8; ++o) *(f32x2*)(tile + (hf * 8 + o) * 512 + ch) = (f32x2){a0[o] + bias[0], a1[o] + bias[1]};
      }
    }
    __syncthreads();
#pragma unroll 1
    for (int k = 0; k < 4; ++k) {
      const int o = hw4 * 4 + k, row = t0 + o;
      const f32x4 v0 = *(const f32x4*)(tile + o * 512 + lane * 4), v1 = *(const f32x4*)(tile + o * 512 + 256 + lane * 4);
      const float mean = wave_sum((v0[0] + v0[1]) + (v0[2] + v0[3]) + (v1[0] + v1[1]) + (v1[2] + v1[3])) * (1.f / 512.f);
      float q = 0.f;
#pragma unroll
      for (int e = 0; e < 4; ++e) { const float d0 = v0[e] - mean, d1 = v1[e] - mean; q += d0 * d0 + d1 * d1; }
      const float rstd = rsqrtf(wave_sum(q) * (1.f / 512.f) + EPS);
#pragma unroll
      for (int hlf = 0; hlf < 2; ++hlf) {
        const int col = hlf * 256 + lane * 4;
        const f32x4 v = hlf ? v1 : v0;
        const f32x4 g = *(const f32x4*)(p.conv_norm_g + col), bb = *(const f32x4*)(p.conv_norm_b + col);
        float y[4];
#pragma unroll
        for (int e = 0; e < 4; ++e) { const float z = (v[e] - mean) * rstd * g[e] + bb[e]; y[e] = z / (1.f + __expf(-z)); }
        *(u32x2*)(cat + (size_t)row * 1024 + col) = (u32x2){pack2(y[0], y[1]), pack2(y[2], y[3])};
      }
    }
    __builtin_amdgcn_sched_barrier(0);
    switch (hw4) {
      case 0: pool_unit<1>(Pz, cat, t0, s0, s1, ht * 2); break;
      case 1: pool_unit<2>(Pz, cat, t0, s0, s1, ht * 2); break;
      case 2: pool_unit<4>(Pz, cat, t0, s0, s1, ht * 2); break;
      default: pool_unit<8>(Pz, cat, t0, s0, s1, ht * 2); break;
    }
    __syncthreads();
  }
}

__global__ void __launch_bounds__(NT, 2) fwd_kernel(Params p, int ph_lo, int ph_hi) {
  __shared__ __attribute__((aligned(16))) char smem[2 * G_STAGE + 12288];
  __shared__ uint4 xb_words;
  cg::grid_group grid = cg::this_grid();
  char* ws = p.ws;
  if (threadIdx.x == 0) xb_words = make_uint4(0u, 0u, 0u, 0u);
  __syncthreads();
  const XcdBarrier xb = xcd_barrier_post((unsigned*)(ws + O_BAR), (volatile LDS_AS unsigned*)&xb_words);
  if (ph_lo > 1000) grid.sync();
  float* mods = (float*)(ws + O_MODS);
  bf16_t* Hb = (bf16_t*)(ws + O_HB);
  float* X = p.out;
  float* xbuf = (float*)(ws + O_XBUF);
  unsigned* lncnt = (unsigned*)(ws + O_LNCNT);
  const bool fused = (gridDim.x == 256);
#define GSYNC() xcd_barrier(xb)
#define PH_BEGIN(n) if (ph_lo <= n && n < ph_hi) { if (n > ph_lo) GSYNC();
#define PH_BEGIN_IF(n, c) if (ph_lo <= n && n < ph_hi && (c)) { if (n > ph_lo) GSYNC();
#define PH_END }
#ifndef PROBE_DUP
#define PROBE_DUP 0
#endif
#ifndef PROBE_SYNCS
#define PROBE_SYNCS 0
#endif
#define DUP(n, ...) __VA_ARGS__; if ((PROBE_DUP >> n) & 1) { GSYNC(); __VA_ARGS__; }
  for (int i = 0; i < PROBE_SYNCS; ++i) GSYNC();
  PH_BEGIN(0) { DUP(0, phase0(p, smem)); } PH_END
  PH_BEGIN(1) { DUP(1, modulate_phase(p.x_prompt, p.x_sample, mods, Hb)); } PH_END
  PH_BEGIN(2) {
    float* o_k = p.out + (size_t)NTOK * 1024; float* o_v = o_k + (size_t)NCTX * 512; float* o_ckv = o_v + (size_t)NCTX * 512; float* o_kr = o_ckv + (size_t)NCTX * 128;
    DUP(2, gemm_phase(Hb, 1024, (const bf16_t*)(ws + O_WATTIN), 1024, 1024, 64, 8,
                      EpiAttIn{(bf16_t*)(ws + O_QDA), (bf16_t*)(ws + O_QDB), (bf16_t*)(ws + O_KD), (bf16_t*)(ws + O_VD), (bf16_t*)(ws + O_CQN), (bf16_t*)(ws + O_CKVN), (bf16_t*)(ws + O_KMLA),
                               o_k, o_v, o_ckv, o_kr, (const float*)(ws + O_C16), (const float*)(ws + O_S16), (const float*)(ws + O_C8), (const float*)(ws + O_S8), p.q_norm_g, p.kv_norm_g, smem + 2 * G_STAGE}, smem));
  } PH_END
  PH_BEGIN(4) {
        const int n1 = 64 * 3, n2 = 67 * 4;
        gemm_phase((const bf16_t*)(ws + O_CQN), 256, (const bf16_t*)(ws + O_WUQ), 256, 256, 64, 3,
                   EpiUq{(bf16_t*)(ws + O_QMA), (bf16_t*)(ws + O_QMB), (const float*)(ws + O_C8), (const float*)(ws + O_S8)}, smem, 0, n1 + n2);
        gemm_phase((const bf16_t*)(ws + O_CKVN), 128, (const bf16_t*)(ws + O_WUKV), 128, 128, 67, 4,
                   EpiUkv{(bf16_t*)(ws + O_KMLA), (bf16_t*)(ws + O_VMLA), smem}, smem, n1, n1 + n2);
  } PH_END
  PH_BEGIN(5) { phase_attn(p, smem, 0); if ((PROBE_DUP >> 5) & 1) { GSYNC(); phase_attn(p, smem, 1); } } PH_END
  PH_BEGIN(6) { gemm_phase(Hb, 1024, (const bf16_t*)(ws + O_WATTOUT), 1024, 1024, 64, 4, EpiResLN{p.x_prompt, p.x_sample, mods + 2048, X, p.ln_mix_g, p.ln_mix_b, mods, 3072, 4096, Hb, xbuf, lncnt, smem + 2 * G_STAGE, fused}, smem); } PH_END
  PH_BEGIN_IF(7, !fused) { rows_phase(X, X + (size_t)NCTX * 1024, true, p.ln_mix_g, p.ln_mix_b, X, mods, 3072, 4096, Hb); } PH_END
  PH_BEGIN(8) { DUP(8, gemm_phase(Hb, 1024, (const bf16_t*)(ws + O_WMLPIN), 1024, 1024, 64, 16, EpiRelu2{(bf16_t*)(ws + O_U), smem}, smem)); } PH_END
  PH_BEGIN(9) { gemm_phase((const bf16_t*)(ws + O_U), 4096, (const bf16_t*)(ws + O_WMLPOUT), 4096, 4096, 64, 4, EpiResLN{X, X + (size_t)NCTX * 1024, mods + 5120, X, p.ln_mlp_g, p.ln_mlp_b, mods + 3 * 6144, 0, 1024, Hb, xbuf + 98304, lncnt + 64, smem + 2 * G_STAGE, fused}, smem); } PH_END
  PH_BEGIN_IF(10, !fused) { rows_phase(X, X + (size_t)NCTX * 1024, true, p.ln_mlp_g, p.ln_mlp_b, X, mods + 3 * 6144, 0, 1024, Hb); } PH_END
  PH_BEGIN(11) { DUP(11, gemm_phase(Hb, 1024, (const bf16_t*)(ws + O_WCONVIN), 1024, 1024, 64, 6, EpiConv{(bf16_t*)(ws + O_UG), (bf16_t*)(ws + O_PZ), smem}, smem)); } PH_END
  PH_BEGIN(12) { DUP(12, phase_conv(p, smem)); } PH_END
  PH_BEGIN(13) { gemm_phase(Hb, 1024, (const bf16_t*)(ws + O_WCONVOUT), 1024, 1024, 64, 4, EpiResLN{X, X + (size_t)NCTX * 1024, mods + 3 * 6144 + 2048, X, p.ln_mix_g + 1024, p.ln_mix_b + 1024, mods + 3 * 6144, 3072, 4096, Hb, xbuf + 2 * 98304, lncnt + 128, smem + 2 * G_STAGE, fused}, smem); } PH_END
  PH_BEGIN_IF(14, !fused) { rows_phase(X, X + (size_t)NCTX * 1024, true, p.ln_mix_g + 1024, p.ln_mix_b + 1024, X, mods + 3 * 6144, 3072, 4096, Hb); } PH_END
  PH_BEGIN(15) { DUP(15, gemm_phase(Hb, 1024, (const bf16_t*)(ws + O_WMLPIN) + (size_t)4096 * 1024, 1024, 1024, 64, 16, EpiRelu2{(bf16_t*)(ws + O_U), smem}, smem)); } PH_END
  PH_BEGIN(16) { gemm_phase((const bf16_t*)(ws + O_U), 4096, (const bf16_t*)(ws + O_WMLPOUT) + (size_t)4096 * 1024, 4096, 4096, 64, 4, EpiResLN{X, X + (size_t)NCTX * 1024, mods + 3 * 6144 + 5120, X, p.ln_mlp_g + 1024, p.ln_mlp_b + 1024, mods, 0, 0, nullptr, xbuf + 3 * 98304, lncnt + 192, smem + 2 * G_STAGE, fused}, smem); } PH_END
  PH_BEGIN_IF(17, !fused) { rows_phase(X, X + (size_t)NCTX * 1024, true, p.ln_mlp_g + 1024, p.ln_mlp_b + 1024, X, nullptr, 0, 0, nullptr); } PH_END
}

extern "C" void kernel_launch(void* const* d_in, const int* in_sizes, int n_in, void* d_out, int out_size, void* d_ws, size_t ws_size, hipStream_t stream) {
  static int grid_blocks = 0;
  if (!grid_blocks) {
    int dev = 0, cus = 0, per_cu = 0;
    hipGetDevice(&dev);
    hipDeviceGetAttribute(&cus, hipDeviceAttributeMultiprocessorCount, dev);
    hipOccupancyMaxActiveBlocksPerMultiprocessor(&per_cu, fwd_kernel, NT, 0);
    if (per_cu > 1) per_cu = 1;
    if (per_cu < 1) per_cu = 1;
    grid_blocks = cus * per_cu;
    if (grid_blocks > 256) grid_blocks = 256;
  }
  if (ws_size < WS_NEED) { fprintf(stderr, "workspace too small: %zu < %zu\n", ws_size, (size_t)WS_NEED); return; }
  Params p{};
  const float** f = (const float**)&p;
  for (int i = 0; i < 35; ++i) f[i] = (const float*)d_in[i];
  p.out = (float*)d_out;
  p.ws = (char*)d_ws;
  hipMemsetAsync(d_ws, 0, 16384, stream);
  int lo = 0, hi = NPHASE;
  void* args[] = {&p, &lo, &hi};
  hipError_t e = hipLaunchCooperativeKernel((void*)fwd_kernel, dim3(grid_blocks), dim3(NT), args, 0, stream);
  if (e != hipSuccess) fprintf(stderr, "cooperative launch failed: %s (grid %d)\n", hipGetErrorString(e), grid_blocks);
}
```

```cpp
#include <hip/hip_runtime.h>
#include <hip/hip_cooperative_groups.h>
#include <cstdio>
#include <cstdint>
namespace cg = cooperative_groups;

typedef unsigned short bf16_t;
typedef short bf16x8 __attribute__((ext_vector_type(8)));
typedef short s16x4 __attribute__((ext_vector_type(4)));
typedef float f32x4 __attribute__((ext_vector_type(4)));
typedef float f32x2 __attribute__((ext_vector_type(2)));
typedef float f32x16 __attribute__((ext_vector_type(16)));
typedef unsigned u32x4 __attribute__((ext_vector_type(4)));
typedef unsigned u32x2 __attribute__((ext_vector_type(2)));
typedef __bf16 bf16v2 __attribute__((ext_vector_type(2)));
#define DI __device__ __forceinline__
#define LDS_AS __attribute__((address_space(3)))

constexpr int NTOK = 12288, NCTX = 4096, NKEY = 12800, TLAT = 4096, TKL = 4352;
constexpr int RLD = 1952;
constexpr float ALPHA = 1.41421356237f, EPS = 1e-5f;
constexpr int NPHASE = 18;
constexpr int NT = 512, NWAVE = 8;

constexpr size_t al(size_t x) { return (x + 255) & ~(size_t)255; }
constexpr size_t O_CNT = 0;
constexpr size_t O_BAR = 256;
constexpr size_t O_LNCNT = 14336;
constexpr size_t O_MODS = 16384;
constexpr size_t O_SCAL = O_MODS + al(2 * 3 * 6144 * 4);
constexpr size_t O_C16 = O_SCAL + 256;
constexpr size_t O_S16 = O_C16 + 4096;
constexpr size_t O_C8 = O_S16 + 4096;
constexpr size_t O_S8 = O_C8 + 2048;
constexpr size_t O_XBUF = O_S8 + 2048;
constexpr size_t O_WATTIN = O_XBUF + (size_t)4 * 256 * 192 * 2 * 4;
constexpr size_t O_WUQ = O_WATTIN + (size_t)2048 * 1024 * 2;
constexpr size_t O_WUKV = O_WUQ + (size_t)768 * 256 * 2;
constexpr size_t O_WATTOUT = O_WUKV + (size_t)1024 * 128 * 2;
constexpr size_t O_WMLPIN = O_WATTOUT + (size_t)1024 * 1024 * 2;
constexpr size_t O_WMLPOUT = O_WMLPIN + (size_t)2 * 4096 * 1024 * 2;
constexpr size_t O_WCONVIN = O_WMLPOUT + (size_t)2 * 4096 * 1024 * 2;
constexpr size_t O_WCONVOUT = O_WCONVIN + (size_t)1536 * 1024 * 2;
constexpr size_t O_HB = O_WCONVOUT + (size_t)1024 * 1024 * 2;
constexpr size_t O_BIG = O_HB + (size_t)NTOK * 1024 * 2;
constexpr size_t O_R = O_BIG;
constexpr size_t O_QMA = O_R;
constexpr size_t O_QMB = O_QMA + (size_t)NTOK * 768 * 2;
constexpr size_t O_QDA = O_R + al((size_t)NTOK * RLD * 2);
constexpr size_t O_QDB = O_QDA + (size_t)NTOK * 512 * 2;
constexpr size_t O_KD = O_QDB + (size_t)8192 * 512 * 2;
constexpr size_t O_VD = O_KD + (size_t)NKEY * 512 * 2;
constexpr size_t O_CQN = O_VD + (size_t)NKEY * 512 * 2;
constexpr size_t O_CKVN = O_CQN + (size_t)NTOK * 256 * 2;
constexpr size_t O_KMLA = O_CKVN + (size_t)NKEY * 128 * 2;
constexpr size_t O_VMLA = O_KMLA + (size_t)NKEY * 768 * 2;
constexpr size_t O_OTMP = O_VMLA + (size_t)NKEY * 512 * 2;
constexpr size_t O_ATT_END = O_OTMP + (size_t)512 * 16384 * 4;
constexpr size_t O_U = O_BIG;
constexpr size_t O_U_END = O_U + (size_t)NTOK * 4096 * 2;
constexpr size_t O_UG = O_BIG;
constexpr size_t O_PZ = O_UG + (size_t)NTOK * 512 * 2;
constexpr size_t WS_NEED = (O_ATT_END > O_U_END ? O_ATT_END : O_U_END);
static_assert(O_QMB + (size_t)8192 * 768 * 2 <= O_QDA, "Qm overlay must fit in R");
static_assert(WS_NEED <= (size_t)256 * 1024 * 1024, "workspace too large");

struct Params {
  const float *x_prompt, *x_sample, *cache_k, *cache_v, *cache_ckv, *cache_krope, *c, *c_ctx;
  const float *w_ada, *b_ada, *ln_mix_g, *ln_mix_b, *ln_mlp_g, *ln_mlp_b, *w_mlp_in, *w_mlp_out;
  const float *w_att_in, *w_uq, *w_ukv, *q_norm_g, *kv_norm_g, *lam_q1, *lam_k1, *lam_q2, *lam_k2, *diff_norm_g, *w_att_out;
  const float *w_conv_in, *conv_w, *conv_b, *conv_norm_g, *conv_norm_b, *w_pool, *pool_scale, *w_conv_out;
  float* out;
  char* ws;
};

DI unsigned pack2(float lo, float hi) { f32x2 v = {lo, hi}; bf16v2 b = __builtin_convertvector(v, bf16v2); return __builtin_bit_cast(unsigned, b); }
DI float bf2f(unsigned short u) { return __uint_as_float((unsigned)u << 16); }
DI float bflo(unsigned u) { return __uint_as_float(u << 16); }
DI float bfhi(unsigned u) { return __uint_as_float(u & 0xffff0000u); }
DI float wave_sum(float v) {
#pragma unroll
  for (int o = 32; o >= 1; o >>= 1) v += __shfl_xor(v, o);
  return v;
}
DI void lds_barrier() { asm volatile("s_waitcnt lgkmcnt(0)\n\ts_barrier" ::: "memory"); }
DI void dma16(const void* gsrc, unsigned lds_dst) {
  unsigned keep;
  asm volatile("s_mov_b32 %0, m0\n\ts_mov_b32 m0, %2\n\ts_nop 0\n\tglobal_load_lds_dwordx4 %1, off\n\ts_mov_b32 m0, %0" : "=&s"(keep) : "v"(gsrc), "s"(lds_dst) : "memory");
}
DI int cond_idx(int row) { return row < NCTX ? 0 : 1 + ((row - NCTX) >> 12); }


#define XB_TMO      128
#define XB_XCNT(j)  (256  + 64 * (j))
#define XB_XSUB(j)  (1280 + 64 * (j))
#define XB_XGEN(j)  (2304 + 64 * (j))
#define XB_TOP      3328
#define XB_TOPGEN   3392
#define XCD_BAR_WORDS 3456
#define XB_SPIN_CAP (1u << 18)
DI unsigned xb_ld(unsigned* p)              { return __hip_atomic_load(p, __ATOMIC_RELAXED, __HIP_MEMORY_SCOPE_AGENT); }
DI unsigned xb_add(unsigned* p, unsigned v) { return __hip_atomic_fetch_add(p, v, __ATOMIC_RELAXED, __HIP_MEMORY_SCOPE_AGENT); }
DI unsigned xb_xcc_id() { return (unsigned)__builtin_amdgcn_s_getreg((3 << 11) | 20) & 0xFu; }
#define XB_SPIN(cond, bar) do { unsigned _sp = 0; while (cond) { __builtin_amdgcn_s_sleep(1); \
    if ((++_sp & 255u) == 0u) { if (xb_ld(&(bar)[XB_TMO])) break; if (_sp > XB_SPIN_CAP) { atomicAdd(&(bar)[XB_TMO], 1u); break; } } } } while (0)
struct XcdBarrier { unsigned* bar; unsigned x; volatile LDS_AS unsigned* st; };
DI XcdBarrier xcd_barrier_post(unsigned* bar, volatile LDS_AS unsigned* st) {
  XcdBarrier b; b.bar = bar; b.x = xb_xcc_id(); b.st = st;
  if (threadIdx.x == 0) (void)xb_add(&bar[XB_XCNT(b.x)], 1u);
  return b;
}
DI void xcd_barrier_complete(unsigned* bar, unsigned x, unsigned& nloc, unsigned& nx) {
  const unsigned G = gridDim.x * gridDim.y * gridDim.z;
  unsigned sum, cnt, mine, sp = 0u;
  for (;;) {
    sum = 0u; cnt = 0u; mine = 0u;
#pragma unroll
    for (unsigned j = 0; j < 16; ++j) { const unsigned c = xb_ld(&bar[XB_XCNT(j)]); sum += c; cnt += (c > 0u) ? 1u : 0u; mine = (j == x) ? c : mine; }
    if (sum == G) break;
    __builtin_amdgcn_s_sleep(1);
    if ((++sp & 255u) == 0u) { if (xb_ld(&bar[XB_TMO])) break; if (sp > XB_SPIN_CAP) { atomicAdd(&bar[XB_TMO], 1u); break; } }
  }
  nloc = mine > 0u ? mine : 1u; nx = cnt > 0u ? cnt : 1u;
}
DI void xcd_barrier(const XcdBarrier& b) {
  asm volatile("s_waitcnt vmcnt(0)" ::: "memory");
  __syncthreads();
  if (threadIdx.x == 0) {
    unsigned* bar = b.bar;
    __builtin_amdgcn_s_waitcnt(0);
    unsigned nloc = b.st[0], nx = b.st[1];
    if (nloc == 0u) { xcd_barrier_complete(bar, b.x, nloc, nx); b.st[0] = nloc; b.st[1] = nx; }
    const unsigned old = xb_add(&bar[XB_XSUB(b.x)], 1u);
    const unsigned gen = old / nloc;
    if (old + 1u == (gen + 1u) * nloc) {
      __builtin_amdgcn_fence(__ATOMIC_RELEASE, "agent");
      asm volatile("s_waitcnt vmcnt(0)" ::: "memory");
      const unsigned og = xb_add(&bar[XB_TOP], 1u);
      const unsigned tg = og / nx;
      if (og + 1u == (tg + 1u) * nx) xb_add(&bar[XB_TOPGEN], 1u);
      else XB_SPIN(xb_ld(&bar[XB_TOPGEN]) == tg, bar);
      __builtin_amdgcn_fence(__ATOMIC_ACQUIRE, "agent");
      xb_add(&bar[XB_XGEN(b.x)], 1u);
      asm volatile("s_waitcnt vmcnt(0)" ::: "memory");
    } else {
      XB_SPIN(xb_ld(&bar[XB_XGEN(b.x)]) == gen, bar);
      __builtin_amdgcn_fence(__ATOMIC_ACQUIRE, "agent");
      asm volatile("s_waitcnt vmcnt(0)" ::: "memory");
    }
  }
  __syncthreads();
}

DI int swz(int row, int kc) { return row * 128 + ((kc ^ ((row >> 1) & 7)) << 4); }

constexpr int G_BM = 192, G_BN = 256, G_MI = 6, G_NJ = 4, G_ABYTES = G_BM * 128, G_STAGE = G_ABYTES + G_BN * 128;
template <class Epi>
DI void gemm_tile(const bf16_t* __restrict__ A, int lda, const bf16_t* __restrict__ Bt, int ldb, int K, int row0, int col0, char* smem, const Epi& epi,
                  bool prefetched, bool has_next, int nrow0, int ncol0) {
  const int tid = threadIdx.x, lane = tid & 63, wid = tid >> 6, wr = wid >> 2, wc = wid & 3;
  const int fr = lane & 15, fq = lane >> 4;
  f32x4 acc[G_MI][G_NJ];
#pragma unroll
  for (int i = 0; i < G_MI; ++i)
#pragma unroll
    for (int j = 0; j < G_NJ; ++j) acc[i][j] = (f32x4){0.f, 0.f, 0.f, 0.f};
  const int srow = tid >> 3, skc = tid & 7;
  const int schunk = skc ^ ((srow >> 1) & 7);
  const bf16_t* ga = A + (size_t)(row0 + srow) * lda + schunk * 8;
  const bf16_t* gb = Bt + (size_t)(col0 + srow) * ldb + schunk * 8;
  const int nk = K >> 6;
  const unsigned lds0 = __builtin_amdgcn_readfirstlane((unsigned)(size_t)(LDS_AS char*)smem + (unsigned)(tid & ~63) * 16u);
#define G_DMA_P(ga_, gb_, stage_off_, kt_) do { const int k0_ = (kt_) << 6; const unsigned sb_ = lds0 + (unsigned)(stage_off_); \
    _Pragma("unroll") for (int i = 0; i < 3; ++i) dma16((ga_) + (size_t)(64 * i) * lda + k0_, sb_ + i * 8192); \
    _Pragma("unroll") for (int i = 0; i < 4; ++i) dma16((gb_) + (size_t)(64 * i) * ldb + k0_, sb_ + G_ABYTES + i * 8192); } while (0)
#define G_DMA(stage_off_, kt_) G_DMA_P(ga, gb, stage_off_, kt_)
#define G_COMPUTE(buf_) do { const char* cur = (buf_); \
    _Pragma("unroll") for (int s = 0; s < 2; ++s) { \
      bf16x8 af[G_MI], bfr[G_NJ]; \
      _Pragma("unroll") for (int i = 0; i < G_MI; ++i) af[i] = *(const bf16x8*)(cur + swz(wr * 96 + i * 16 + fr, s * 4 + fq)); \
      _Pragma("unroll") for (int j = 0; j < G_NJ; ++j) bfr[j] = *(const bf16x8*)(cur + G_ABYTES + swz(wc * 64 + j * 16 + fr, s * 4 + fq)); \
      __builtin_amdgcn_s_setprio(1); \
      _Pragma("unroll") for (int i = 0; i < G_MI; ++i) \
        _Pragma("unroll") for (int j = 0; j < G_NJ; ++j) acc[i][j] = __builtin_amdgcn_mfma_f32_16x16x32_bf16(bfr[j], af[i], acc[i][j], 0, 0, 0); \
      __builtin_amdgcn_s_setprio(0); \
    } } while (0)
  if (!prefetched) { G_DMA(0, 0); asm volatile("s_waitcnt vmcnt(0)" ::: "memory"); }
  else asm volatile("s_waitcnt vmcnt(%0)" :: "n"(Epi::kMinStores) : "memory");
  lds_barrier();
  for (int kt = 0; kt < nk; kt += 2) {
    G_DMA(G_STAGE, kt + 1);
    G_COMPUTE(smem);
    asm volatile("s_waitcnt vmcnt(0)" ::: "memory");
    lds_barrier();
    G_DMA(0, min(kt + 2, nk - 1));
    G_COMPUTE(smem + G_STAGE);
    asm volatile("s_waitcnt vmcnt(0)" ::: "memory");
    lds_barrier();
  }
  if (has_next) {
    const bf16_t* gan = A + (size_t)(nrow0 + srow) * lda + schunk * 8;
    const bf16_t* gbn = Bt + (size_t)(ncol0 + srow) * ldb + schunk * 8;
    G_DMA_P(gan, gbn, 0, 0);
  }
#undef G_DMA
#undef G_DMA_P
#undef G_COMPUTE
  epi(acc, row0 + wr * 96, col0 + wc * 64, lane);
}


template <class F>
DI void wave_rows_store(char* w, const u32x2 (&pk)[G_MI][G_NJ], int lane, F rowptr) {
  const int fr = lane & 15, fq = lane >> 4;
#pragma unroll
  for (int i = 0; i < G_MI; ++i)
#pragma unroll
    for (int j = 0; j < G_NJ; ++j) *(u32x2*)(w + (i * 16 + fr) * 144 + (j * 16 + fq * 4) * 2) = pk[i][j];
  const int rr = lane >> 3, ch = lane & 7;
#pragma unroll
  for (int it = 0; it < 12; ++it) {
    const int r = it * 8 + rr;
    const u32x4 v = *(const u32x4*)(w + r * 144 + ch * 16);
    bf16_t* d = rowptr(r);
    if (d) *(u32x4*)(d + ch * 8) = v;
  }
}
DI u32x2 pk4(const f32x4 v) { return (u32x2){pack2(v[0], v[1]), pack2(v[2], v[3])}; }

struct EpiRaw {
  static constexpr int kMinStores = 0;
  static constexpr bool kPrefetchNext = true;
  bf16_t* R;
  DI void operator()(f32x4 (&acc)[G_MI][G_NJ], int rbase, int cbase, int lane) const {
    const int fr = lane & 15, fq = lane >> 4;
#pragma unroll
    for (int i = 0; i < G_MI; ++i)
#pragma unroll
      for (int j = 0; j < G_NJ; ++j) {
        const int row = rbase + i * 16 + fr, col = cbase + j * 16 + fq * 4;
        if (col < RLD) { u32x2 w = {pack2(acc[i][j][0], acc[i][j][1]), pack2(acc[i][j][2], acc[i][j][3])}; *(u32x2*)(R + (size_t)row * RLD + col) = w; }
      }
  }
};


struct EpiAttIn {
  static constexpr int kMinStores = 0;
  static constexpr bool kPrefetchNext = true;
  bf16_t *Qda, *Qdb, *Kd, *Vd, *cqn, *ckvn, *Km; float *o_k, *o_v, *o_ckv, *o_kr;
  const float *c16, *s16, *c8, *s8, *qg, *kvg; char* smem;
  DI void operator()(f32x4 (&acc)[G_MI][G_NJ], int rbase, int cbase, int lane) const {
    const int tid = threadIdx.x, wid = tid >> 6, wr = wid >> 2, wc = wid & 3, fr = lane & 15, fq = lane >> 4;
    const int tile = (cbase - wc * 64) >> 8;
    float* part = (float*)smem;
    if (tile < 6) {
      const int which = tile >> 1, c0 = cbase & 511;
#pragma unroll
      for (int i = 0; i < G_MI; ++i) {
        const int rowf = rbase + i * 16, row = rowf + fr;
        const bool lat = rowf >= NCTX;
        const int rl = row - NCTX, b = rl >> 12, t = rl & (TLAT - 1), prow = t >> 6, pcol = t & 63;
        const size_t kr = lat ? (size_t)NCTX + (size_t)b * TKL + 256 + t : (size_t)row;
        u32x2 raw[G_NJ], rot[G_NJ];
#pragma unroll
        for (int j = 0; j < G_NJ; ++j) raw[j] = (u32x2){pack2(acc[i][j][0], acc[i][j][1]), pack2(acc[i][j][2], acc[i][j][3])};
        if (lat && which < 2) {
#pragma unroll
          for (int jp = 0; jp < 2; ++jp) {
            const int pos = jp == 0 ? prow : pcol;
            const f32x4 cs = *(const f32x4*)(c16 + pos * 16 + fq * 4), sn = *(const f32x4*)(s16 + pos * 16 + fq * 4);
            const f32x4 x1 = acc[i][2 * jp], x2 = acc[i][2 * jp + 1];
            f32x4 o1, o2;
#pragma unroll
            for (int e = 0; e < 4; ++e) { o1[e] = x1[e] * cs[e] - x2[e] * sn[e]; o2[e] = x1[e] * sn[e] + x2[e] * cs[e]; }
            rot[2 * jp] = (u32x2){pack2(o1[0], o1[1]), pack2(o1[2], o1[3])};
            rot[2 * jp + 1] = (u32x2){pack2(o2[0], o2[1]), pack2(o2[2], o2[3])};
          }
        }
#pragma unroll
        for (int j = 0; j < G_NJ; ++j) {
          const int c = c0 + j * 16 + fq * 4;
          if (which == 0) {
            *(u32x2*)(Qda + (size_t)row * 512 + c) = raw[j];
            if (lat) *(u32x2*)(Qdb + (size_t)rl * 512 + c) = rot[j];
          } else if (which == 1) {
            if (lat) *(u32x2*)(Kd + kr * 512 + c) = rot[j];
            else { *(u32x2*)(Kd + kr * 512 + c) = raw[j]; *(f32x4*)(o_k + (size_t)row * 512 + c) = acc[i][j]; }
          } else {
            *(u32x2*)(Vd + kr * 512 + c) = raw[j];
            if (!lat) *(f32x4*)(o_v + (size_t)row * 512 + c) = acc[i][j];
          }
        }
      }
      return;
    }
    const bool norm_wave = (tile == 6) || (wc < 2);
#pragma unroll
    for (int i = 0; i < G_MI; ++i) {
      float ss = 0.f;
#pragma unroll
      for (int j = 0; j < G_NJ; ++j)
#pragma unroll
        for (int e = 0; e < 4; ++e) ss += acc[i][j][e] * acc[i][j][e];
      ss += __shfl_xor(ss, 16); ss += __shfl_xor(ss, 32);
      if (fq == 0) part[(wr * 96 + i * 16 + fr) * 4 + wc] = ss;
    }
    __syncthreads();
#pragma unroll
    for (int i = 0; i < G_MI; ++i) {
      const int rowf = rbase + i * 16, row = rowf + fr;
      const bool lat = rowf >= NCTX;
      const int rl = row - NCTX, b = rl >> 12, t = rl & (TLAT - 1), prow = t >> 6, pcol = t & 63;
      const size_t kr = lat ? (size_t)NCTX + (size_t)b * TKL + 256 + t : (size_t)row;
      const f32x4 pr = *(const f32x4*)(part + (wr * 96 + i * 16 + fr) * 4);
      if (tile == 6) {
        const float sc = rsqrtf(((pr[0] + pr[1]) + (pr[2] + pr[3])) * (1.f / 256.f) + EPS);
#pragma unroll
        for (int j = 0; j < G_NJ; ++j) {
          const int c = wc * 64 + j * 16 + fq * 4;
          const f32x4 g = *(const f32x4*)(qg + c);
          *(u32x2*)(cqn + (size_t)row * 256 + c) = (u32x2){pack2(acc[i][j][0] * sc * g[0], acc[i][j][1] * sc * g[1]), pack2(acc[i][j][2] * sc * g[2], acc[i][j][3] * sc * g[3])};
        }
      } else if (norm_wave) {
        const float sc = rsqrtf((pr[0] + pr[1]) * (1.f / 128.f) + EPS);
#pragma unroll
        for (int j = 0; j < G_NJ; ++j) {
          const int c = wc * 64 + j * 16 + fq * 4;
          const f32x4 g = *(const f32x4*)(kvg + c);
          f32x4 y;
#pragma unroll
          for (int e = 0; e < 4; ++e) y[e] = acc[i][j][e] * sc * g[e];
          if (!lat) *(f32x4*)(o_ckv + (size_t)row * 128 + c) = y;
          *(u32x2*)(ckvn + kr * 128 + c) = (u32x2){pack2(y[0], y[1]), pack2(y[2], y[3])};
        }
      } else if (wc == 2) {
#pragma unroll
        for (int j = 0; j < 2; ++j) {
          f32x4 v = acc[i][j];
          if (lat) {
            const int pos = j == 0 ? prow : pcol;
            f32x4 o;
#pragma unroll
            for (int e = 0; e < 4; ++e) {
              const float pv = __shfl_xor(v[e], 32);
              const int f = (fq & 1) * 4 + e;
              const float cs = c8[pos * 8 + f], sn = s8[pos * 8 + f];
              o[e] = (fq < 2) ? (v[e] * cs - pv * sn) : (pv * sn + v[e] * cs);
            }
            v = o;
          } else *(f32x4*)(o_kr + (size_t)row * 32 + j * 16 + fq * 4) = v;
          const u32x2 w = {pack2(v[0], v[1]), pack2(v[2], v[3])};
#pragma unroll
          for (int hh = 0; hh < 8; ++hh) *(u32x2*)(Km + kr * 768 + hh * 96 + 64 + j * 16 + fq * 4) = w;
        }
      }
    }
    __syncthreads();
  }
};

struct EpiUq {
  static constexpr int kMinStores = 24;
  static constexpr bool kPrefetchNext = true;
  bf16_t *Qa, *Qb; const float *c8, *s8;
  DI void operator()(f32x4 (&acc)[G_MI][G_NJ], int rbase, int cbase, int lane) const {
    const int fr = lane & 15, fq = lane >> 4;
#pragma unroll
    for (int i = 0; i < G_MI; ++i) {
      const bool lat = (rbase + i * 16) >= NCTX;
      const int row = rbase + i * 16 + fr;
      const int t = (row - NCTX) & (TLAT - 1);
#pragma unroll
      for (int j = 0; j < G_NJ; ++j) {
        const int cf = cbase + j * 16, col = cf + fq * 4;
        f32x4 v = acc[i][j];
        u32x2 w = {pack2(v[0], v[1]), pack2(v[2], v[3])};
        *(u32x2*)(Qa + (size_t)row * 768 + col) = w;
        if (lat) {
          const int w96 = cf % 96;
          if (w96 >= 64) {
            const int pos = (w96 == 64) ? (t >> 6) : (t & 63);
            f32x4 o;
#pragma unroll
            for (int e = 0; e < 4; ++e) {
              const float pv = __shfl_xor(v[e], 32);
              const int f = (fq & 1) * 4 + e;
              const float cs = c8[pos * 8 + f], sn = s8[pos * 8 + f];
              o[e] = (fq < 2) ? (v[e] * cs - pv * sn) : (pv * sn + v[e] * cs);
            }
            w = (u32x2){pack2(o[0], o[1]), pack2(o[2], o[3])};
          }
          *(u32x2*)(Qb + (size_t)(row - NCTX) * 768 + col) = w;
        }
      }
    }
  }
};

struct EpiUkv {
  static constexpr int kMinStores = 0;
  static constexpr bool kPrefetchNext = false;
  bf16_t *Km, *Vm; char* lds;
  DI void operator()(f32x4 (&acc)[G_MI][G_NJ], int rbase, int cbase, int lane) const {
    const int h = cbase >> 7, part = (cbase >> 6) & 1;
    u32x2 pk[G_MI][G_NJ];
#pragma unroll
    for (int i = 0; i < G_MI; ++i)
#pragma unroll
      for (int j = 0; j < G_NJ; ++j) pk[i][j] = pk4(acc[i][j]);
    bf16_t* base = part == 0 ? Km + h * 96 : Vm + h * 64;
    const int ld = part == 0 ? 768 : 512;
    wave_rows_store(lds + (threadIdx.x >> 6) * (96 * 144), pk, lane, [&](int r) -> bf16_t* { const int row = rbase + r; return row < NKEY ? base + (size_t)row * ld : nullptr; });
    lds_barrier();
  }
};

struct EpiRes {
  static constexpr int kMinStores = 0;
  static constexpr bool kPrefetchNext = true;
  const float *xin_ctx, *xin_lat, *gate  ; float* X;
  DI void operator()(f32x4 (&acc)[G_MI][G_NJ], int rbase, int cbase, int lane) const {
    const int fr = lane & 15, fq = lane >> 4;
#pragma unroll
    for (int i = 0; i < G_MI; ++i) {
      const int row = rbase + i * 16 + fr;
      const float* g = gate + cond_idx(rbase + i * 16) * 6144;
      const float* xin = row < NCTX ? xin_ctx + (size_t)row * 1024 : xin_lat + (size_t)(row - NCTX) * 1024;
#pragma unroll
      for (int j = 0; j < G_NJ; ++j) {
        const int col = cbase + j * 16 + fq * 4;
        const f32x4 xv = *(const f32x4*)(xin + col), gv = *(const f32x4*)(g + col);
        f32x4 z;
#pragma unroll
        for (int e = 0; e < 4; ++e) z[e] = ALPHA * xv[e] + gv[e] * acc[i][j][e];
        *(f32x4*)(X + (size_t)row * 1024 + col) = z;
      }
    }
  }
};


struct EpiResLN {
  static constexpr int kMinStores = 0;
  static constexpr bool kPrefetchNext = true;
  const float *xin_ctx, *xin_lat, *gate; float* X;
  const float *lg, *lb, *modsL; int sh_off, sc_off; bf16_t* Hb;
  float* xbuf; unsigned* cnt; char* smem; bool fused;
  DI void operator()(f32x4 (&acc)[G_MI][G_NJ], int rbase, int cbase, int lane) const {
    const int tid = threadIdx.x, wid = tid >> 6, wr = wid >> 2, wc = wid & 3, fr = lane & 15, fq = lane >> 4;
#pragma unroll
    for (int i = 0; i < G_MI; ++i) {
      const int row = rbase + i * 16 + fr;
      const float* g = gate + cond_idx(rbase + i * 16) * 6144;
      const float* xin = row < NCTX ? xin_ctx + (size_t)row * 1024 : xin_lat + (size_t)(row - NCTX) * 1024;
#pragma unroll
      for (int j = 0; j < G_NJ; ++j) {
        const int col = cbase + j * 16 + fq * 4;
        const f32x4 xv = *(const f32x4*)(xin + col), gv = *(const f32x4*)(g + col);
#pragma unroll
        for (int e = 0; e < 4; ++e) acc[i][j][e] = ALPHA * xv[e] + gv[e] * acc[i][j][e];
        if (!fused) *(f32x4*)(X + (size_t)row * 1024 + col) = acc[i][j];
      }
    }
    if (!fused) return;
    const int row0 = rbase - wr * 96, pm = row0 / G_BM, pn = (cbase - wc * 64) / G_BN;
    f32x2* part = (f32x2*)smem;
    f32x2* stat = (f32x2*)(smem + 8192);
#pragma unroll
    for (int i = 0; i < G_MI; ++i) {
      float s1 = 0.f, s2 = 0.f;
#pragma unroll
      for (int j = 0; j < G_NJ; ++j)
#pragma unroll
        for (int e = 0; e < 4; ++e) { const float v = acc[i][j][e]; s1 += v; s2 += v * v; }
      s1 += __shfl_xor(s1, 16); s2 += __shfl_xor(s2, 16);
      s1 += __shfl_xor(s1, 32); s2 += __shfl_xor(s2, 32);
      if (fq == 0) part[(wr * 96 + i * 16 + fr) * 4 + wc] = (f32x2){s1, s2};
    }
    __syncthreads();
    if (tid < G_BM) {
      const f32x2 a = part[tid * 4 + 0], b = part[tid * 4 + 1], c = part[tid * 4 + 2], d = part[tid * 4 + 3];
      const float s1 = (a[0] + b[0]) + (c[0] + d[0]), s2 = (a[1] + b[1]) + (c[1] + d[1]);
      const unsigned long long pk = ((unsigned long long)__float_as_uint(s2) << 32) | (unsigned long long)__float_as_uint(s1);
      __hip_atomic_store((unsigned long long*)(xbuf + ((size_t)(pm * 4 + pn) * G_BM + tid) * 2), pk, __ATOMIC_RELAXED, __HIP_MEMORY_SCOPE_AGENT);
    }
    asm volatile("s_waitcnt vmcnt(0)" ::: "memory");
    __syncthreads();
    if (tid == 0) {
      __hip_atomic_fetch_add(cnt + pm, 1u, __ATOMIC_RELAXED, __HIP_MEMORY_SCOPE_AGENT);
      unsigned sp = 0;
      while (__hip_atomic_load(cnt + pm, __ATOMIC_RELAXED, __HIP_MEMORY_SCOPE_AGENT) < 4u) { __builtin_amdgcn_s_sleep(1); if (++sp > (1u << 22)) break; }
    }
    __syncthreads();
    if (tid < G_BM) {
      float s1 = 0.f, s2 = 0.f;
#pragma unroll
      for (int q = 0; q < 4; ++q) {
        const unsigned long long pk = __hip_atomic_load((unsigned long long*)(xbuf + ((size_t)(pm * 4 + q) * G_BM + tid) * 2), __ATOMIC_RELAXED, __HIP_MEMORY_SCOPE_AGENT);
        s1 += __uint_as_float((unsigned)pk); s2 += __uint_as_float((unsigned)(pk >> 32));
      }
      const float mean = s1 * (1.f / 1024.f);
      const float var = fmaxf(s2 * (1.f / 1024.f) - mean * mean, 0.f);
      stat[tid] = (f32x2){mean, rsqrtf(var + EPS)};
    }
    __syncthreads();
#pragma unroll
    for (int i = 0; i < G_MI; ++i) {
      const int row = rbase + i * 16 + fr;
      const f32x2 ms = stat[wr * 96 + i * 16 + fr];
      const float* m = modsL + cond_idx(rbase + i * 16) * 6144;
#pragma unroll
      for (int j = 0; j < G_NJ; ++j) {
        const int col = cbase + j * 16 + fq * 4;
        const f32x4 gv = *(const f32x4*)(lg + col), bv = *(const f32x4*)(lb + col);
        f32x4 x;
#pragma unroll
        for (int e = 0; e < 4; ++e) x[e] = (acc[i][j][e] - ms[0]) * ms[1] * gv[e] + bv[e];
        *(f32x4*)(X + (size_t)row * 1024 + col) = x;
        if (Hb) {
          const f32x4 sh = *(const f32x4*)(m + sh_off + col), sc = *(const f32x4*)(m + sc_off + col);
          u32x2 w = {pack2(x[0] * (1.f + sc[0]) + sh[0], x[1] * (1.f + sc[1]) + sh[1]), pack2(x[2] * (1.f + sc[2]) + sh[2], x[3] * (1.f + sc[3]) + sh[3])};
          *(u32x2*)(Hb + (size_t)row * 1024 + col) = w;
        }
      }
    }
    __syncthreads();
  }
};

struct EpiRelu2 {
  static constexpr int kMinStores = 0;
  static constexpr bool kPrefetchNext = false;
  bf16_t* U; char* lds;
  DI void operator()(f32x4 (&acc)[G_MI][G_NJ], int rbase, int cbase, int lane) const {
    const int fr = lane & 15, fq = lane >> 4, wid = threadIdx.x >> 6;
    char* w = lds + wid * (96 * 144);
#pragma unroll
    for (int i = 0; i < G_MI; ++i)
#pragma unroll
      for (int j = 0; j < G_NJ; ++j) {
        f32x4 v = acc[i][j];
#pragma unroll
        for (int e = 0; e < 4; ++e) { const float r = fmaxf(v[e], 0.f); v[e] = r * r; }
        *(u32x2*)(w + (i * 16 + fr) * 144 + (j * 16 + fq * 4) * 2) = (u32x2){pack2(v[0], v[1]), pack2(v[2], v[3])};
      }
    const int rr = lane >> 3, ch = lane & 7;
#pragma unroll
    for (int it = 0; it < 12; ++it) {
      const int r = it * 8 + rr;
      const u32x4 v = *(const u32x4*)(w + r * 144 + ch * 16);
      *(u32x4*)(U + (size_t)(rbase + r) * 4096 + cbase + ch * 8) = v;
    }
    lds_barrier();
  }
};

struct EpiConv {
  static constexpr int kMinStores = 0;
  static constexpr bool kPrefetchNext = false;
  bf16_t *Ug, *Pz; char* lds;
  DI void operator()(f32x4 (&acc)[G_MI][G_NJ], int rbase, int cbase, int lane) const {
    const int fr = lane & 15, fq = lane >> 4;
    char* w = lds + (threadIdx.x >> 6) * (96 * 144);
    if (cbase < 1024) {
#pragma unroll
      for (int i = 0; i < G_MI; ++i)
#pragma unroll
        for (int jp = 0; jp < 2; ++jp) {
          const f32x4 a = acc[i][2 * jp], gt = acc[i][2 * jp + 1];
          f32x4 u;
#pragma unroll
          for (int e = 0; e < 4; ++e) u[e] = a[e] / (1.f + __expf(-gt[e]));
          *(u32x2*)(w + (i * 16 + fr) * 80 + (jp * 16 + fq * 4) * 2) = pk4(u);
        }
      const int rr = lane >> 2, ch = lane & 3, c0 = (cbase >> 5) * 16;
#pragma unroll
      for (int it = 0; it < 6; ++it) {
        const int r = it * 16 + rr;
        const u32x4 v = *(const u32x4*)(w + r * 80 + ch * 16);
        *(u32x4*)(Ug + (size_t)(rbase + r) * 512 + c0 + ch * 8) = v;
      }
    } else {
      u32x2 pk[G_MI][G_NJ];
#pragma unroll
      for (int i = 0; i < G_MI; ++i)
#pragma unroll
        for (int j = 0; j < G_NJ; ++j) pk[i][j] = pk4(acc[i][j]);
      wave_rows_store(w, pk, lane, [&](int r) -> bf16_t* { return Pz + (size_t)(rbase + r) * 512 + (cbase - 1024); });
    }
    lds_barrier();
  }
};

#ifndef XCD_ORDER
#define XCD_ORDER 1
#endif
template <class Epi>
DI void gemm_phase(const bf16_t* A, int lda, const bf16_t* Bt, int ldb, int K, int mt, int nt, const Epi& epi, char* smem, int tstart = 0, int ttotal = -1) {
  const int n = mt * nt;
  if (ttotal < 0) ttotal = n;
  const bool xo = XCD_ORDER && gridDim.x == 256 && (nt & 3) == 0 && (mt & 3) == 0 && n % 256 == 0;
  auto coords = [&](int u, int& r0, int& c0) {
    int pm = u / nt, pn = u - pm * nt;
    if (xo) {
      const int r = u >> 8, w = u & 255, x = w & 7, idx = w >> 3;
      const int rows_r = 256 / nt, pw = nt < 8 ? nt : 8, ph = 32 / pw, npx = nt / pw, px = x % npx, py = x / npx;
      pm = r * rows_r + py * ph + idx / pw; pn = px * pw + idx % pw;
    }
    r0 = pm * G_BM; c0 = pn * G_BN;
  };
  int t = blockIdx.x;
  while (t < tstart) t += gridDim.x;
  bool prefetched = false;
  while (t < tstart + n && t < ttotal) {
    const int tn = t + gridDim.x;
    const bool has_next = Epi::kPrefetchNext && tn < tstart + n && tn < ttotal;
    int r0, c0, nr0 = 0, nc0 = 0;
    coords(t - tstart, r0, c0);
    if (has_next) coords(tn - tstart, nr0, nc0);
    gemm_tile(A, lda, Bt, ldb, K, r0, c0, smem, epi, prefetched, has_next, nr0, nc0);
    prefetched = has_next;
    t = tn;
  }
}

DI void rows_phase(const float* src_ctx, const float* src_lat, bool do_ln, const float* lg, const float* lb, float* Xdst,
                   const float* modsL, int sh_off, int sc_off, bf16_t* Hb) {
  const int lane = threadIdx.x & 63, gw = blockIdx.x * NWAVE + (threadIdx.x >> 6), nw = gridDim.x * NWAVE;
  for (int row = gw; row < NTOK; row += nw) {
    const float* src = row < NCTX ? src_ctx + (size_t)row * 1024 : src_lat + (size_t)(row - NCTX) * 1024;
    f32x4 v[4];
#pragma unroll
    for (int i = 0; i < 4; ++i) v[i] = *(const f32x4*)(src + i * 256 + lane * 4);
    if (do_ln) {
      float s = 0.f;
#pragma unroll
      for (int i = 0; i < 4; ++i) s += (v[i][0] + v[i][1]) + (v[i][2] + v[i][3]);
      const float mean = wave_sum(s) * (1.f / 1024.f);
      float q = 0.f;
#pragma unroll
      for (int i = 0; i < 4; ++i)
#pragma unroll
        for (int e = 0; e < 4; ++e) { const float d = v[i][e] - mean; q += d * d; }
      const float rstd = rsqrtf(wave_sum(q) * (1.f / 1024.f) + EPS);
#pragma unroll
      for (int i = 0; i < 4; ++i) {
        const f32x4 g = *(const f32x4*)(lg + i * 256 + lane * 4), b = *(const f32x4*)(lb + i * 256 + lane * 4);
#pragma unroll
        for (int e = 0; e < 4; ++e) v[i][e] = (v[i][e] - mean) * rstd * g[e] + b[e];
        if (Xdst) *(f32x4*)(Xdst + (size_t)row * 1024 + i * 256 + lane * 4) = v[i];
      }
    }
    if (Hb) {
      const float* m = modsL + cond_idx(row) * 6144;
#pragma unroll
      for (int i = 0; i < 4; ++i) {
        const int col = i * 256 + lane * 4;
        const f32x4 sh = *(const f32x4*)(m + sh_off + col), sc = *(const f32x4*)(m + sc_off + col);
        f32x4 h;
#pragma unroll
        for (int e = 0; e < 4; ++e) h[e] = v[i][e] * (1.f + sc[e]) + sh[e];
        u32x2 w = {pack2(h[0], h[1]), pack2(h[2], h[3])};
        *(u32x2*)(Hb + (size_t)row * 1024 + col) = w;
      }
    }
  }
}

DI void modulate_phase(const float* __restrict__ src_ctx, const float* __restrict__ src_lat, const float* __restrict__ modsL, bf16_t* __restrict__ Hb) {
  const int lane = threadIdx.x & 63, gw = blockIdx.x * NWAVE + (threadIdx.x >> 6), nw = gridDim.x * NWAVE;
  for (int r0 = gw * 2; r0 < NTOK; r0 += nw * 2) {
    f32x4 v[2][4];
#pragma unroll
    for (int k = 0; k < 2; ++k) {
      const int row = r0 + k;
      const float* src = row < NCTX ? src_ctx + (size_t)row * 1024 : src_lat + (size_t)(row - NCTX) * 1024;
#pragma unroll
      for (int i = 0; i < 4; ++i) v[k][i] = __builtin_nontemporal_load((const f32x4*)(src + i * 256 + lane * 4));
    }
#pragma unroll
    for (int k = 0; k < 2; ++k) {
      const int row = r0 + k;
      const float* m = modsL + cond_idx(row) * 6144;
#pragma unroll
      for (int i = 0; i < 4; ++i) {
        const int col = i * 256 + lane * 4;
        const f32x4 sh = *(const f32x4*)(m + col), sc = *(const f32x4*)(m + 1024 + col);
        u32x2 w = {pack2(v[k][i][0] * (1.f + sc[0]) + sh[0], v[k][i][1] * (1.f + sc[1]) + sh[1]), pack2(v[k][i][2] * (1.f + sc[2]) + sh[2], v[k][i][3] * (1.f + sc[3]) + sh[3])};
        *(u32x2*)(Hb + (size_t)row * 1024 + col) = w;
      }
    }
  }
}

DI double sin_red(double r) {
  const double r2 = r * r; double t = -1.0 / 51090942171709440000.0;
  t = t * r2 + 1.0 / 121645100408832000.0; t = t * r2 - 1.0 / 355687428096000.0; t = t * r2 + 1.0 / 1307674368000.0; t = t * r2 - 1.0 / 6227020800.0;
  t = t * r2 + 1.0 / 39916800.0; t = t * r2 - 1.0 / 362880.0; t = t * r2 + 1.0 / 5040.0; t = t * r2 - 1.0 / 120.0; t = t * r2 + 1.0 / 6.0;
  return r * (1.0 - r2 * t);
}
DI double cos_red(double r) {
  const double r2 = r * r; double t = 1.0 / 1124000727777607680000.0;
  t = t * r2 - 1.0 / 2432902008176640000.0; t = t * r2 + 1.0 / 6402373705728000.0; t = t * r2 - 1.0 / 20922789888000.0; t = t * r2 + 1.0 / 87178291200.0;
  t = t * r2 - 1.0 / 479001600.0; t = t * r2 + 1.0 / 3628800.0; t = t * r2 - 1.0 / 40320.0; t = t * r2 + 1.0 / 720.0; t = t * r2 - 1.0 / 24.0; t = t * r2 + 0.5; t = t * r2 * -1.0 + 1.0;
  return t;
}

constexpr int J_MODS = 96, J_WEFF = 64, J_CACHE = 64, J_ROPE = 1, J_SLOW = J_MODS + J_WEFF + J_CACHE + J_ROPE;
constexpr int T_ATTIN = 16 * 16, T_UQ = 4 * 6, T_UKV = 2 * 8, T_ATTOUT = 16 * 8, T_MLPIN = 16 * 32, T_MLPOUT = 64 * 8, T_CONVIN = 16 * 12, T_CONVOUT = 8 * 8;
constexpr int J_TR = T_ATTIN + T_UQ + T_UKV + T_ATTOUT + 2 * T_MLPIN + 2 * T_MLPOUT + T_CONVIN + T_CONVOUT;

struct TJ { const float* src; bf16_t* dst; int N, nvalid, lddst, perm, kt, nt; };
DI TJ tr_decode(const Params& p, int j) {
  char* ws = p.ws;
  TJ t; t.perm = 0;
  if (j < T_ATTIN) { t.src = p.w_att_in; t.N = 1952; t.nvalid = 1952; t.dst = (bf16_t*)(ws + O_WATTIN); t.lddst = 1024; t.kt = j / 16; t.nt = j % 16; return t; }
  j -= T_ATTIN;
  if (j < T_UQ) { t.src = p.w_uq; t.N = 768; t.nvalid = 768; t.dst = (bf16_t*)(ws + O_WUQ); t.lddst = 256; t.kt = j / 6; t.nt = j % 6; return t; }
  j -= T_UQ;
  if (j < T_UKV) { t.src = p.w_ukv; t.N = 1024; t.nvalid = 1024; t.dst = (bf16_t*)(ws + O_WUKV); t.lddst = 128; t.kt = j / 8; t.nt = j % 8; return t; }
  j -= T_UKV;
  if (j < T_ATTOUT) { t.src = p.w_att_out; t.N = 1024; t.nvalid = 1024; t.dst = (bf16_t*)(ws + O_WATTOUT); t.lddst = 1024; t.kt = j / 8; t.nt = j % 8; return t; }
  j -= T_ATTOUT;
  if (j < 2 * T_MLPIN) { const int l = j / T_MLPIN, u = j % T_MLPIN; t.src = p.w_mlp_in + (size_t)l * 1024 * 4096; t.N = 4096; t.nvalid = 4096; t.dst = (bf16_t*)(ws + O_WMLPIN) + (size_t)l * 4096 * 1024; t.lddst = 1024; t.kt = u / 32; t.nt = u % 32; return t; }
  j -= 2 * T_MLPIN;
  if (j < 2 * T_MLPOUT) { const int l = j / T_MLPOUT, u = j % T_MLPOUT; t.src = p.w_mlp_out + (size_t)l * 4096 * 1024; t.N = 1024; t.nvalid = 1024; t.dst = (bf16_t*)(ws + O_WMLPOUT) + (size_t)l * 4096 * 1024; t.lddst = 4096; t.kt = u / 8; t.nt = u % 8; return t; }
  j -= 2 * T_MLPOUT;
  if (j < T_CONVIN) { t.src = p.w_conv_in; t.N = 1536; t.nvalid = 1536; t.dst = (bf16_t*)(ws + O_WCONVIN); t.lddst = 1024; t.perm = 1; t.kt = j / 12; t.nt = j % 12; return t; }
  j -= T_CONVIN;
  t.src = p.w_conv_out; t.N = 1024; t.nvalid = 1024; t.dst = (bf16_t*)(ws + O_WCONVOUT); t.lddst = 1024; t.kt = j / 8; t.nt = j % 8; return t;
}
DI void tr_load(const TJ& t, float (&v)[16]) {
  const int tid = threadIdx.x, n4 = (tid & 31) * 4, kb = tid >> 5;
  const int gn = t.nt * 128 + n4;
  const float* s = t.src + (size_t)(t.kt * 64 + kb) * t.N + gn;
#pragma unroll
  for (int i = 0; i < 4; ++i) {
    f32x4 x = {0.f, 0.f, 0.f, 0.f};
    if (gn < t.nvalid) x = *(const f32x4*)(s + (size_t)(16 * i) * t.N);
    v[4 * i] = x[0]; v[4 * i + 1] = x[1]; v[4 * i + 2] = x[2]; v[4 * i + 3] = x[3];
  }
}

DI void phase0(const Params& p, char* smem) {
  const int tid = threadIdx.x, lane = tid & 63, wid = tid >> 6;
  char* ws = p.ws;
  for (int job = blockIdx.x; job < J_SLOW; job += gridDim.x) {
    int j = job;
    if (j < J_MODS) {
      const int l = j / 48, cc = j % 48;
      float* sc = (float*)smem;
      for (int i = tid; i < 3072; i += NT) { const int ci = i >> 10, k = i & 1023; const float x = ci == 0 ? p.c_ctx[k] : p.c[(ci - 1) * 1024 + k]; sc[i] = x / (1.f + __expf(-x)); }
      __syncthreads();
      const int kg = tid >> 5, c4 = (tid & 31) * 4;
      const float* w = p.w_ada + (size_t)l * 1024 * 6144 + cc * 128 + c4;
      f32x4 s0 = {0.f, 0.f, 0.f, 0.f}, s1 = s0, s2 = s0;
#pragma unroll 16
      for (int k = kg * 64; k < kg * 64 + 64; ++k) {
        const f32x4 wv = __builtin_nontemporal_load((const f32x4*)(w + (size_t)k * 6144));
        const float a = sc[k], b = sc[1024 + k], c = sc[2048 + k];
#pragma unroll
        for (int e = 0; e < 4; ++e) { s0[e] += a * wv[e]; s1[e] += b * wv[e]; s2[e] += c * wv[e]; }
      }
      f32x4* r = (f32x4*)(smem + 12288);
      r[(kg * 3 + 0) * 32 + (tid & 31)] = s0; r[(kg * 3 + 1) * 32 + (tid & 31)] = s1; r[(kg * 3 + 2) * 32 + (tid & 31)] = s2;
      __syncthreads();
      if (tid < 96) {
        const int ci = tid >> 5, q = tid & 31;
        f32x4 s = {0.f, 0.f, 0.f, 0.f};
#pragma unroll
        for (int g = 0; g < 16; ++g) { const f32x4 t4 = r[(g * 3 + ci) * 32 + q]; s[0] += t4[0]; s[1] += t4[1]; s[2] += t4[2]; s[3] += t4[3]; }
        const f32x4 bb = *(const f32x4*)(p.b_ada + l * 6144 + cc * 128 + q * 4);
        float* md = (float*)(ws + O_MODS) + (size_t)(l * 3 + ci) * 6144 + cc * 128 + q * 4;
#pragma unroll
        for (int e = 0; e < 4; ++e) __hip_atomic_store(md + e, s[e] + bb[e], __ATOMIC_RELAXED, __HIP_MEMORY_SCOPE_AGENT);
      }
      asm volatile("s_waitcnt vmcnt(0)" ::: "memory");
      __syncthreads();
      if (tid == 0) __hip_atomic_fetch_add((unsigned*)(ws + O_CNT) + 2, 1u, __ATOMIC_RELAXED, __HIP_MEMORY_SCOPE_AGENT);
      continue;
    }
    j -= J_MODS;
    if (j < J_WEFF) {
      const int g = j >> 4, cch = (j >> 1) & 7, nch = j & 1;
      float* wp = (float*)smem;
      for (int i = tid; i < 2048; i += NT) wp[i] = p.w_pool[(size_t)(g * 128 + cch * 16 + (i >> 7)) * 128 + (i & 127)];
      __syncthreads();
      const int n = nch * 512 + tid;
      float a[16];
#pragma unroll
      for (int c = 0; c < 16; ++c) a[c] = 0.f;
#pragma unroll 16
      for (int e = 0; e < 128; ++e) {
        const float wo = p.w_conv_out[(size_t)(512 + g * 128 + e) * 1024 + n] * p.pool_scale[g * 128 + e];
#pragma unroll
        for (int c = 0; c < 16; ++c) a[c] += wp[c * 128 + e] * wo;
      }
      bf16_t* d = (bf16_t*)(ws + O_WCONVOUT) + (size_t)n * 1024 + 512 + g * 128 + cch * 16;
      *(u32x4*)d = (u32x4){pack2(a[0], a[1]), pack2(a[2], a[3]), pack2(a[4], a[5]), pack2(a[6], a[7])};
      *(u32x4*)(d + 8) = (u32x4){pack2(a[8], a[9]), pack2(a[10], a[11]), pack2(a[12], a[13]), pack2(a[14], a[15])};
      __syncthreads();
      continue;
    }
    j -= J_WEFF;
    if (j < J_CACHE) {
      const int rr = j * 8 + wid, b = rr >> 8, t = rr & 255;
      const size_t kr = NCTX + (size_t)b * TKL + t;
      const f32x4 a0 = *(const f32x4*)(p.cache_k + (size_t)rr * 512 + lane * 8), a1 = *(const f32x4*)(p.cache_k + (size_t)rr * 512 + lane * 8 + 4);
      *(u32x4*)((bf16_t*)(ws + O_KD) + kr * 512 + lane * 8) = (u32x4){pack2(a0[0], a0[1]), pack2(a0[2], a0[3]), pack2(a1[0], a1[1]), pack2(a1[2], a1[3])};
      const f32x4 b0 = *(const f32x4*)(p.cache_v + (size_t)rr * 512 + lane * 8), b1 = *(const f32x4*)(p.cache_v + (size_t)rr * 512 + lane * 8 + 4);
      *(u32x4*)((bf16_t*)(ws + O_VD) + kr * 512 + lane * 8) = (u32x4){pack2(b0[0], b0[1]), pack2(b0[2], b0[3]), pack2(b1[0], b1[1]), pack2(b1[2], b1[3])};
      const f32x2 cv = *(const f32x2*)(p.cache_ckv + (size_t)rr * 128 + lane * 2);
      *(unsigned*)((bf16_t*)(ws + O_CKVN) + kr * 128 + lane * 2) = pack2(cv[0], cv[1]);
      const int idx = lane & 31;
      const float x = p.cache_krope[(size_t)rr * 32 + idx];
      const unsigned pk = pack2(x, x);
#pragma unroll
      for (int k = 0; k < 4; ++k) { const int hh = (lane >> 5) + 2 * k; ((bf16_t*)(ws + O_KMLA))[kr * 768 + hh * 96 + 64 + idx] = (bf16_t)(pk & 0xffff); }
      continue;
    }
    j -= J_CACHE;
    {
      float* c16 = (float*)(ws + O_C16); float* s16 = (float*)(ws + O_S16); float* c8 = (float*)(ws + O_C8); float* s8 = (float*)(ws + O_S8);
      for (int i = tid; i < 1024 + 512; i += NT) {
        int pos, f, half;
        if (i < 1024) { pos = i >> 4; f = i & 15; half = 16; } else { const int q = i - 1024; pos = q >> 3; f = q & 7; half = 8; }
        const float inv = (float)exp(-9.210340371976184 * (double)f / (double)half);
        const float angf = (float)pos * inv;
        const double ang = (double)angf;
        const double r = ang - 6.283185307179586 * rint(ang * 0.15915494309189535);
        const float cs = (float)cos_red(r), sn = (float)sin_red(r);
        if (i < 1024) { c16[i] = cs; s16[i] = sn; } else { c8[i - 1024] = cs; s8[i - 1024] = sn; }
      }
      if (wid == 0) {
        const float d1 = wave_sum(p.lam_q1[lane] * p.lam_k1[lane]), d2 = wave_sum(p.lam_q2[lane] * p.lam_k2[lane]);
        if (lane == 0) ((float*)(ws + O_SCAL))[0] = expf(d1) - expf(d2) + 0.2f;
      }
    }
  }
  {
    float* tile = (float*)smem;
    const int G = gridDim.x;
    int j = (blockIdx.x + G - (J_SLOW % G)) % G;
    float va[16], vb[16];
    TJ ta, tb;
    if (j < J_TR) { ta = tr_decode(p, j); tr_load(ta, va); } else ta = TJ{};
    if (j + G < J_TR) { tb = tr_decode(p, j + G); tr_load(tb, vb); } else tb = ta;
#define TR_STEP(V, T, jj_) do { \
      { const int n4 = (tid & 31) * 4, kb = tid >> 5; \
        _Pragma("unroll") for (int i = 0; i < 4; ++i) \
          _Pragma("unroll") for (int e = 0; e < 4; ++e) tile[(kb + 16 * i) * 129 + n4 + e] = V[4 * i + e]; } \
      __syncthreads(); \
      const TJ cur = T; \
      if ((jj_) + 2 * G < J_TR) { T = tr_decode(p, (jj_) + 2 * G); tr_load(T, V); }     \
      _Pragma("unroll") for (int ps = 0; ps < 2; ++ps) {     \
        const int n = ps * 64 + (tid >> 3), ks = (tid & 7) * 8; \
        int gn = cur.nt * 128 + n; \
        if (cur.perm) { if (gn < 512) gn = 32 * (gn >> 4) + (gn & 15); else if (gn < 1024) { const int c = gn - 512; gn = 32 * (c >> 4) + 16 + (c & 15); } } \
        unsigned w[4]; \
        _Pragma("unroll") for (int e = 0; e < 4; ++e) w[e] = pack2(tile[(ks + 2 * e) * 129 + n], tile[(ks + 2 * e + 1) * 129 + n]); \
        *(u32x4*)(cur.dst + (size_t)gn * cur.lddst + cur.kt * 64 + ks) = (u32x4){w[0], w[1], w[2], w[3]}; } \
      __syncthreads(); } while (0)
    while (j < J_TR) {
      TR_STEP(va, ta, j);
      j += G;
      if (j >= J_TR) break;
      TR_STEP(vb, tb, j);
      j += G;
    }
#undef TR_STEP
  }
  if (tid == 0) {
    unsigned sp = 0;
    while (__hip_atomic_load((unsigned*)(ws + O_CNT) + 2, __ATOMIC_RELAXED, __HIP_MEMORY_SCOPE_AGENT) < (unsigned)J_MODS) { __builtin_amdgcn_s_sleep(2); if (++sp > (1u << 22)) break; }
  }
  __syncthreads();
  modulate_phase(p.x_prompt, p.x_sample, (const float*)(ws + O_MODS), (bf16_t*)(ws + O_HB));
}

DI void rope8(const float (&x)[8], float (&o)[8], int lane, const float* c16, const float* s16, int prow, int pcol) {
  const int L = lane & 7;
  const int pos = (L & 4) ? pcol : prow;
  const bool second = (L & 2) != 0;
  const int fb = (L & 1) * 8;
#pragma unroll
  for (int e = 0; e < 8; ++e) {
    const float y = __shfl_xor(x[e], 2);
    const float cs = c16[pos * 16 + fb + e], sn = s16[pos * 16 + fb + e];
    o[e] = second ? (y * sn + x[e] * cs) : (x[e] * cs - y * sn);
  }
}
DI void unpack8(const u32x4 w, float (&x)[8]) {
#pragma unroll
  for (int e = 0; e < 4; ++e) { x[2 * e] = bflo(w[e]); x[2 * e + 1] = bfhi(w[e]); }
}
DI u32x4 pack8(const float (&x)[8]) { return (u32x4){pack2(x[0], x[1]), pack2(x[2], x[3]), pack2(x[4], x[5]), pack2(x[6], x[7])}; }

DI void phase3(const Params& p) {
  char* ws = p.ws;
  const bf16_t* R = (const bf16_t*)(ws + O_R);
  bf16_t* Qda = (bf16_t*)(ws + O_QDA); bf16_t* Qdb = (bf16_t*)(ws + O_QDB); bf16_t* Kd = (bf16_t*)(ws + O_KD); bf16_t* Vd = (bf16_t*)(ws + O_VD);
  bf16_t* cqn = (bf16_t*)(ws + O_CQN); bf16_t* ckvn = (bf16_t*)(ws + O_CKVN); bf16_t* Km = (bf16_t*)(ws + O_KMLA);
  const float* c16 = (const float*)(ws + O_C16); const float* s16 = (const float*)(ws + O_S16); const float* c8 = (const float*)(ws + O_C8); const float* s8 = (const float*)(ws + O_S8);
  float* o_k = p.out + (size_t)NTOK * 1024; float* o_v = o_k + (size_t)NCTX * 512; float* o_ckv = o_v + (size_t)NCTX * 512; float* o_kr = o_ckv + (size_t)NCTX * 128;
  const int lane = threadIdx.x & 63, gw = blockIdx.x * NWAVE + (threadIdx.x >> 6), nw = gridDim.x * NWAVE;
  for (int row = gw; row < NTOK; row += nw) {
    const bool lat = row >= NCTX;
    const int rl = row - NCTX, b = rl >> 12, t = rl & (TLAT - 1), prow = t >> 6, pcol = t & 63;
    const size_t kr = lat ? (size_t)NCTX + (size_t)b * TKL + 256 + t : (size_t)row;
    const bf16_t* r = R + (size_t)row * RLD;
    float x[8], o[8];
    const u32x4 wq = *(const u32x4*)(r + lane * 8);
    *(u32x4*)(Qda + (size_t)row * 512 + lane * 8) = wq;
    if (lat) { unpack8(wq, x); rope8(x, o, lane, c16, s16, prow, pcol); *(u32x4*)(Qdb + (size_t)rl * 512 + lane * 8) = pack8(o); }
    const u32x4 wk = *(const u32x4*)(r + 512 + lane * 8);
    if (lat) { unpack8(wk, x); rope8(x, o, lane, c16, s16, prow, pcol); *(u32x4*)(Kd + kr * 512 + lane * 8) = pack8(o); }
    else {
      unpack8(wk, x);
      *(f32x4*)(o_k + (size_t)row * 512 + lane * 8) = (f32x4){x[0], x[1], x[2], x[3]};
      *(f32x4*)(o_k + (size_t)row * 512 + lane * 8 + 4) = (f32x4){x[4], x[5], x[6], x[7]};
      *(u32x4*)(Kd + kr * 512 + lane * 8) = wk;
    }
    const u32x4 wv = *(const u32x4*)(r + 1024 + lane * 8);
    *(u32x4*)(Vd + kr * 512 + lane * 8) = wv;
    if (!lat) {
      unpack8(wv, x);
      *(f32x4*)(o_v + (size_t)row * 512 + lane * 8) = (f32x4){x[0], x[1], x[2], x[3]};
      *(f32x4*)(o_v + (size_t)row * 512 + lane * 8 + 4) = (f32x4){x[4], x[5], x[6], x[7]};
    }
    {
      const u32x2 w = *(const u32x2*)(r + 1536 + lane * 4);
      const float a0 = bflo(w[0]), a1 = bfhi(w[0]), a2 = bflo(w[1]), a3 = bfhi(w[1]);
      const float ss = wave_sum(a0 * a0 + a1 * a1 + a2 * a2 + a3 * a3);
      const float sc = rsqrtf(ss * (1.f / 256.f) + EPS);
      const f32x4 g = *(const f32x4*)(p.q_norm_g + lane * 4);
      *(u32x2*)(cqn + (size_t)row * 256 + lane * 4) = (u32x2){pack2(a0 * sc * g[0], a1 * sc * g[1]), pack2(a2 * sc * g[2], a3 * sc * g[3])};
    }
    {
      const unsigned w = *(const unsigned*)(r + 1792 + lane * 2);
      const float a0 = bflo(w), a1 = bfhi(w);
      const float ss = wave_sum(a0 * a0 + a1 * a1);
      const float sc = rsqrtf(ss * (1.f / 128.f) + EPS);
      const f32x2 g = *(const f32x2*)(p.kv_norm_g + lane * 2);
      const float y0 = a0 * sc * g[0], y1 = a1 * sc * g[1];
      if (!lat) *(f32x2*)(o_ckv + (size_t)row * 128 + lane * 2) = (f32x2){y0, y1};
      *(unsigned*)(ckvn + kr * 128 + lane * 2) = pack2(y0, y1);
    }
    {
      const int idx = lane & 31;
      const float xv = bf2f(r[1920 + idx]);
      float ov = xv;
      if (lat) {
        const int pos = (idx & 16) ? pcol : prow;
        const int f = idx & 7;
        const float y = __shfl_xor(xv, 8);
        const float cs = c8[pos * 8 + f], sn = s8[pos * 8 + f];
        ov = (idx & 8) ? (y * sn + xv * cs) : (xv * cs - y * sn);
      } else if (lane < 32) o_kr[(size_t)row * 32 + idx] = xv;
      const bf16_t ob = (bf16_t)(pack2(ov, ov) & 0xffff);
#pragma unroll
      for (int k = 0; k < 4; ++k) { const int hh = (lane >> 5) + 2 * k; Km[kr * 768 + hh * 96 + 64 + idx] = ob; }
    }
  }
}

template <int DQK, int DV>
DI void attn_core(const bf16_t* __restrict__ Qa, const bf16_t* __restrict__ Qb, int ldq, const bf16_t* __restrict__ Kp, int ldk, const bf16_t* __restrict__ Vp, int ldv,
                  int Tk, int n_a, float c  , char* smem, f32x16 (&o)[DV / 32]) {
  constexpr int KS = DQK * 2 + 16, VS = DV * 2 + 64, BUF = 64 * (KS + VS);
  constexpr int KCH = DQK / 8, VCH = DV / 8, NKCH = 64 * KCH, NVCH = 64 * VCH, NKC = (NKCH + NT - 1) / NT, NVC = (NVCH + NT - 1) / NT;
  constexpr bool KG = (NKCH % NT) != 0, VG = (NVCH % NT) != 0;
  constexpr int NS = DQK / 16, NDT = DV / 32;
  const int tid = threadIdx.x, lane = tid & 63, wid = tid >> 6, h = lane >> 5, ql = lane & 31;
  bf16x8 qf[NS];
  {
    const bf16_t* q = Qa + (size_t)(wid * 32 + ql) * ldq + h * 8;
#pragma unroll
    for (int s = 0; s < NS; ++s) qf[s] = *(const bf16x8*)(q + s * 16);
  }
#pragma unroll
  for (int dt = 0; dt < NDT; ++dt)
#pragma unroll
    for (int r = 0; r < 16; ++r) o[dt][r] = 0.f;
  float m_run = -INFINITY, l_run = 0.f;
  u32x4 rkA[NKC], rvA[NVC], rkB[NKC], rvB[NVC];
  const int nt = Tk >> 6, ta = n_a >> 6;
  unsigned koff[NKC], voff[NVC];
#pragma unroll
  for (int i = 0; i < NKC; ++i) { const int ch = (tid + NT * i) % NKCH, row = ch / KCH, kc = ch % KCH; koff[i] = (unsigned)(row * ldk + kc * 8); }
#pragma unroll
  for (int i = 0; i < NVC; ++i) { const int ch = (tid + NT * i) % NVCH, row = ch / VCH, vc = ch % VCH; voff[i] = (unsigned)(row * ldv + vc * 8); }
  auto gload = [&](u32x4 (&rk)[NKC], u32x4 (&rv)[NVC], int t) {
    const bf16_t* kb = Kp + (size_t)t * 64 * ldk;
    const bf16_t* vbp = Vp + (size_t)t * 64 * ldv;
#pragma unroll
    for (int i = 0; i < NKC; ++i) rk[i] = *(const u32x4*)(kb + koff[i]);
#pragma unroll
    for (int i = 0; i < NVC; ++i) rv[i] = *(const u32x4*)(vbp + voff[i]);
  };
  auto lstore = [&](u32x4 (&rk)[NKC], u32x4 (&rv)[NVC], char* buf) {
#pragma unroll
    for (int i = 0; i < NKC; ++i) { const int ch = tid + NT * i, row = ch / KCH, kc = ch % KCH; if (!KG || i + 1 < NKC || ch < NKCH) *(u32x4*)(buf + row * KS + kc * 16) = rk[i]; }
#pragma unroll
    for (int i = 0; i < NVC; ++i) { const int ch = tid + NT * i, row = ch / VCH, vc = ch % VCH; if (!VG || i + 1 < NVC || ch < NVCH) *(u32x4*)(buf + 64 * KS + row * VS + vc * 16) = rv[i]; }
  };
  gload(rkA, rvA, 0); lstore(rkA, rvA, smem); lds_barrier();
  gload(rkA, rvA, min(1, nt - 1));
  const int i16 = lane & 15, tq = i16 >> 2, tp = i16 & 3, G = (lane >> 4) & 1;
  auto compute = [&](const char* cur) {
    f32x16 st[2];
    bf16x8 kf[2][NS];
#pragma unroll
    for (int kt = 0; kt < 2; ++kt)
#pragma unroll
      for (int s = 0; s < NS; ++s) kf[kt][s] = *(const bf16x8*)(cur + (kt * 32 + ql) * KS + s * 32 + h * 16);
#pragma unroll
    for (int kt = 0; kt < 2; ++kt) {
#pragma unroll
      for (int r = 0; r < 16; ++r) st[kt][r] = 0.f;
#pragma unroll
      for (int s = 0; s < NS; ++s) st[kt] = __builtin_amdgcn_mfma_f32_32x32x16_bf16(kf[kt][s], qf[s], st[kt], 0, 0, 0);
    }
    __builtin_amdgcn_sched_barrier(0);
    float mx = st[0][0];
#pragma unroll
    for (int kt = 0; kt < 2; ++kt)
#pragma unroll
      for (int r = 0; r < 16; ++r) mx = fmaxf(mx, st[kt][r]);
    mx = fmaxf(mx, __shfl_xor(mx, 32));
    const float m_new = fmaxf(m_run, mx);
    const float alpha = __builtin_amdgcn_exp2f((m_run - m_new) * c);
    const float mc = m_new * c;
    m_run = m_new;
    f32x2 ls2 = {0.f, 0.f};
#pragma unroll
    for (int kt = 0; kt < 2; ++kt) {
      const f32x16 tv = st[kt] * c - mc;
#pragma unroll
      for (int r = 0; r < 16; r += 2) {
        const f32x2 pv = {__builtin_amdgcn_exp2f(tv[r]), __builtin_amdgcn_exp2f(tv[r + 1])};
        st[kt][r] = pv[0]; st[kt][r + 1] = pv[1];
        ls2 += pv;
      }
    }
    l_run = l_run * alpha + (ls2[0] + ls2[1]);
    if (__any(alpha != 1.f)) {
#pragma unroll
      for (int dt = 0; dt < NDT; ++dt)
#pragma unroll
        for (int r = 0; r < 16; ++r) o[dt][r] *= alpha;
    }
    bf16x8 pf[2][2];
#pragma unroll
    for (int kt = 0; kt < 2; ++kt)
#pragma unroll
      for (int s2 = 0; s2 < 2; ++s2) {
        u32x4 w = {pack2(st[kt][8 * s2 + 0], st[kt][8 * s2 + 1]), pack2(st[kt][8 * s2 + 2], st[kt][8 * s2 + 3]), pack2(st[kt][8 * s2 + 4], st[kt][8 * s2 + 5]), pack2(st[kt][8 * s2 + 6], st[kt][8 * s2 + 7])};
        pf[kt][s2] = __builtin_bit_cast(bf16x8, w);
      }
    const char* vb = cur + 64 * KS + (4 * h + tq) * VS + 32 * G + 8 * tp;
    bf16x8 vfa[NDT], vfb[NDT];
#define A_VLOAD(VF, g_) do { \
      _Pragma("unroll") for (int dt = 0; dt < NDT; ++dt) { \
        const char* a0 = vb + (((g_) >> 1) * 32 + 16 * ((g_) & 1)) * VS + dt * 64; \
        const s16x4 lo = __builtin_amdgcn_ds_read_tr16_b64_v4i16((LDS_AS s16x4*)(a0)); \
        const s16x4 hi = __builtin_amdgcn_ds_read_tr16_b64_v4i16((LDS_AS s16x4*)(a0 + 8 * VS)); \
        VF[dt] = __builtin_shufflevector(lo, hi, 0, 1, 2, 3, 4, 5, 6, 7); } } while (0)
#define A_VMMA(VF, g_) do { \
      _Pragma("unroll") for (int dt = 0; dt < NDT; ++dt) o[dt] = __builtin_amdgcn_mfma_f32_32x32x16_bf16(VF[dt], pf[(g_) >> 1][(g_) & 1], o[dt], 0, 0, 0); } while (0)
    A_VLOAD(vfa, 0);
    A_VLOAD(vfb, 1);
    __builtin_amdgcn_sched_barrier(0);
    A_VMMA(vfa, 0);
    __builtin_amdgcn_sched_barrier(0);
    A_VLOAD(vfa, 2);
    __builtin_amdgcn_sched_barrier(0);
    A_VMMA(vfb, 1);
    __builtin_amdgcn_sched_barrier(0);
    A_VLOAD(vfb, 3);
    __builtin_amdgcn_sched_barrier(0);
    A_VMMA(vfa, 2);
    __builtin_amdgcn_sched_barrier(0);
    A_VMMA(vfb, 3);
#undef A_VLOAD
#undef A_VMMA
  };
  auto run_tiles = [&](int t_begin, int t_end) {
    for (int t = t_begin; t < t_end; t += 2) {
      gload(rkB, rvB, min(t + 2, nt - 1));
      compute(smem);
      lstore(rkA, rvA, smem + BUF);
      lds_barrier();
      gload(rkA, rvA, min(t + 3, nt - 1));
      compute(smem + BUF);
      lstore(rkB, rvB, smem);
      lds_barrier();
    }
  };
  if (wid >= 4) __builtin_amdgcn_s_setprio(1);
  run_tiles(0, min(ta, nt));
  if (ta < nt) {
    const bf16_t* q = Qb + (size_t)(wid * 32 + ql) * ldq + h * 8;
#pragma unroll
    for (int s = 0; s < NS; ++s) qf[s] = *(const bf16x8*)(q + s * 16);
    run_tiles(ta, nt);
  }
  __builtin_amdgcn_s_setprio(0);
  const float l = l_run + __shfl_xor(l_run, 32);
  const float inv = 1.f / l;
#pragma unroll
  for (int dt = 0; dt < NDT; ++dt)
#pragma unroll
    for (int r = 0; r < 16; ++r) o[dt][r] *= inv;
}

constexpr int U_DBIG = 128, U_MBIG = 256, U_DCTX = 64, U_MCTX = 128, U_TOTAL = U_DBIG + U_MBIG + U_DCTX + U_MCTX;

DI void phase_attn(const Params& p, char* smem, int cidx) {
  char* ws = p.ws;
  const bf16_t* Qda = (const bf16_t*)(ws + O_QDA); const bf16_t* Qdb = (const bf16_t*)(ws + O_QDB); const bf16_t* Kd = (const bf16_t*)(ws + O_KD); const bf16_t* Vd = (const bf16_t*)(ws + O_VD);
  const bf16_t* Qma = (const bf16_t*)(ws + O_QMA); const bf16_t* Qmb = (const bf16_t*)(ws + O_QMB); const bf16_t* Km = (const bf16_t*)(ws + O_KMLA); const bf16_t* Vm = (const bf16_t*)(ws + O_VMLA);
  bf16_t* cat = (bf16_t*)(ws + O_HB);
  float* otmp = (float*)(ws + O_OTMP) + (size_t)blockIdx.x * 32768;
  int* counter = (int*)(ws + O_CNT) + cidx;
  int* s_unit = (int*)(smem + 65532);
  const int tid = threadIdx.x, lane = tid & 63, wid = tid >> 6, h2 = lane >> 5, ql = lane & 31;
  const float lam = ((const float*)(ws + O_SCAL))[0];
  for (;;) {
    if (tid == 0) *s_unit = atomicAdd(counter, 1);
    __syncthreads();
    int u = __builtin_amdgcn_readfirstlane(*s_unit);
    __syncthreads();
    if (u >= U_TOTAL) break;
    bool diff; int qrow0, krow0, Tk, n_a, head; bool lat;
    if (u < U_DBIG) { diff = true; lat = true; const int b = u >> 6, hh = (u >> 4) & 3, qb = u & 15; head = hh; qrow0 = NCTX + b * TLAT + qb * 256; krow0 = NCTX + b * TKL; Tk = TKL; n_a = 256; }
    else if (u < U_DBIG + U_MBIG) { u -= U_DBIG; diff = false; lat = true; const int b = u >> 7, hh = (u >> 4) & 7, qb = u & 15; head = hh; qrow0 = NCTX + b * TLAT + qb * 256; krow0 = NCTX + b * TKL; Tk = TKL; n_a = 256; }
    else if (u < U_DBIG + U_MBIG + U_DCTX) { u -= U_DBIG + U_MBIG; diff = true; lat = false; const int sq = u >> 2, hh = u & 3; head = hh; qrow0 = sq * 256; krow0 = sq * 256; Tk = 256; n_a = 256; }
    else { u -= U_DBIG + U_MBIG + U_DCTX; diff = false; lat = false; const int sq = u >> 3, hh = u & 7; head = hh; qrow0 = sq * 256; krow0 = sq * 256; Tk = 256; n_a = 256; }
    const int qrowb = lat ? qrow0 - NCTX : 0;
    if (diff) {
      f32x16 o[4];
      const float c = 0.125f * 1.4426950408889634f;
#pragma unroll 1
      for (int m = 0; m < 2; ++m) {
        attn_core<64, 128>(Qda + (size_t)qrow0 * 512 + head * 128 + m * 64, Qdb + (size_t)qrowb * 512 + head * 128 + m * 64, 512,
                           Kd + (size_t)krow0 * 512 + head * 128 + m * 64, 512, Vd + (size_t)krow0 * 512 + head * 128, 512, Tk, n_a, c, smem, o);
        if (m == 0) {
#pragma unroll
          for (int dt = 0; dt < 4; ++dt)
#pragma unroll
            for (int rq = 0; rq < 4; ++rq) *(f32x4*)(otmp + tid * 64 + dt * 16 + rq * 4) = (f32x4){o[dt][4 * rq], o[dt][4 * rq + 1], o[dt][4 * rq + 2], o[dt][4 * rq + 3]};
        }
      }
      float ss = 0.f;
#pragma unroll
      for (int dt = 0; dt < 4; ++dt)
#pragma unroll
        for (int rq = 0; rq < 4; ++rq) {
          const f32x4 o0 = *(const f32x4*)(otmp + tid * 64 + dt * 16 + rq * 4);
#pragma unroll
          for (int e = 0; e < 4; ++e) { const float v = o0[e] - lam * o[dt][4 * rq + e]; o[dt][4 * rq + e] = v; ss += v * v; }
        }
      ss += __shfl_xor(ss, 32);
      const float sc = rsqrtf(ss * (1.f / 128.f) + EPS) * 0.8f;
      bf16_t* dst = cat + (size_t)(qrow0 + wid * 32 + ql) * 1024 + head * 128;
#pragma unroll
      for (int dt = 0; dt < 4; ++dt)
#pragma unroll
        for (int rq = 0; rq < 4; ++rq) {
          const int dv = dt * 32 + 8 * rq + 4 * h2;
          const f32x4 g = *(const f32x4*)(p.diff_norm_g + dv);
          u32x2 w = {pack2(o[dt][4 * rq] * sc * g[0], o[dt][4 * rq + 1] * sc * g[1]), pack2(o[dt][4 * rq + 2] * sc * g[2], o[dt][4 * rq + 3] * sc * g[3])};
          *(u32x2*)(dst + dv) = w;
        }
    } else {
      f32x16 o[2];
      const float c = 0.10206207261596575f * 1.4426950408889634f;
      attn_core<96, 64>(Qma + (size_t)qrow0 * 768 + head * 96, Qmb + (size_t)qrowb * 768 + head * 96, 768,
                        Km + (size_t)krow0 * 768 + head * 96, 768, Vm + (size_t)krow0 * 512 + head * 64, 512, Tk, n_a, c, smem, o);
      bf16_t* dst = cat + (size_t)(qrow0 + wid * 32 + ql) * 1024 + 512 + head * 64;
#pragma unroll
      for (int dt = 0; dt < 2; ++dt)
#pragma unroll
        for (int rq = 0; rq < 4; ++rq) {
          const int dv = dt * 32 + 8 * rq + 4 * h2;
          u32x2 w = {pack2(o[dt][4 * rq], o[dt][4 * rq + 1]), pack2(o[dt][4 * rq + 2], o[dt][4 * rq + 3])};
          *(u32x2*)(dst + dv) = w;
        }
    }
  }
}

DI void unpack8f(const u32x4 w, float (&x)[8]) {
#pragma unroll
  for (int e = 0; e < 4; ++e) { x[2 * e] = bflo(w[e]); x[2 * e + 1] = bfhi(w[e]); }
}
DI void phase_conv(const Params& p, char* smem) {
  constexpr int TT = 8;
  char* ws = p.ws;
  const bf16_t* Ug = (const bf16_t*)(ws + O_UG); const bf16_t* Pz = (const bf16_t*)(ws + O_PZ);
  bf16_t* cat = (bf16_t*)(ws + O_HB);
  const int tid = threadIdx.x, lane = tid & 63, wid = tid >> 6;
  float* wl = (float*)smem;
  {
    f32x4 wv[8];
#pragma unroll
    for (int k = 0; k < 8; ++k) { const int i4 = tid + NT * k; wv[k] = (f32x4){0.f, 0.f, 0.f, 0.f}; if (i4 < 31 * 128) wv[k] = *(const f32x4*)(p.conv_w + i4 * 4); }
#pragma unroll
    for (int k = 0; k < 8; ++k) {
      const int i4 = tid + NT * k, j = i4 >> 7, c = (i4 & 127) * 4, lc = c >> 3, hf = (c >> 2) & 1;
      if (i4 < 31 * 128) *(f32x4*)(wl + ((j * 2 + hf) * 64 + lc) * 4) = wv[k];
    }
  }
  __syncthreads();
  const int c0 = lane * 8;
  const int grp = lane >> 4, HW = 1 << grp;
  for (int u = blockIdx.x * NWAVE + wid; u < NTOK / TT; u += gridDim.x * NWAVE) {
    const int t0 = u * TT;
    const int s0 = t0 < NCTX ? (t0 & ~255) : NCTX + ((t0 - NCTX) & ~(TLAT - 1));
    const int s1 = t0 < NCTX ? s0 + 256 : s0 + TLAT;
    {
      u32x4 pr[TT + 16];
#pragma unroll
      for (int i = 0; i < TT + 16; ++i) {
        const int r = t0 - 8 + i;
        pr[i] = (u32x4){0u, 0u, 0u, 0u};
        if (r >= s0 && r < s1) pr[i] = *(const u32x4*)(Pz + (size_t)r * 512 + c0);
      }
#pragma unroll
      for (int o = 0; o < TT; ++o) {
        const int r = t0 + o, ci = o + 8;
        float s[8], x[8], ctr[8], s2[8], s4[8], s8[8];
        unpack8f(pr[ci], ctr);
        unpack8f(pr[ci - 1], x);
#pragma unroll
        for (int e = 0; e < 8; ++e) { s[e] = x[e] + ctr[e]; s2[e] = s[e]; }
#pragma unroll
        for (int d = 0; d < 2; ++d) { unpack8f(pr[d == 0 ? ci - 2 : ci + 1], x);
#pragma unroll
          for (int e = 0; e < 8; ++e) s[e] += x[e]; }
#pragma unroll
        for (int e = 0; e < 8; ++e) s4[e] = s[e];
#pragma unroll
        for (int d = 0; d < 4; ++d) { unpack8f(pr[d < 2 ? ci - 4 + d : ci + d], x);
#pragma unroll
          for (int e = 0; e < 8; ++e) s[e] += x[e]; }
#pragma unroll
        for (int e = 0; e < 8; ++e) s8[e] = s[e];
#pragma unroll
        for (int d = 0; d < 8; ++d) { unpack8f(pr[d < 4 ? ci - 8 + d : ci + d], x);
#pragma unroll
          for (int e = 0; e < 8; ++e) s[e] += x[e]; }
        const int lo = max(r - HW, s0), hi = min(r + HW - 1, s1 - 1);
        const float ic = 1.f / (float)(hi - lo + 1);
        float dv[8];
#pragma unroll
        for (int e = 0; e < 8; ++e) { const float sm = grp == 0 ? s2[e] : grp == 1 ? s4[e] : grp == 2 ? s8[e] : s[e]; dv[e] = sm * ic - ctr[e]; }
        *(u32x4*)(cat + (size_t)r * 1024 + 512 + c0) = (u32x4){pack2(dv[0], dv[1]), pack2(dv[2], dv[3]), pack2(dv[4], dv[5]), pack2(dv[6], dv[7])};
      }
    }
    f32x2 acc2[TT][4];
#pragma unroll
    for (int o = 0; o < TT; ++o)
#pragma unroll
      for (int e = 0; e < 4; ++e) acc2[o][e] = (f32x2){0.f, 0.f};
    u32x4 q0, q1, q2, q3;
#define CV_ROW(i_) ({ const int r_ = t0 - 15 + (i_); u32x4 v_ = {0u, 0u, 0u, 0u}; if ((i_) < TT + 30 && r_ >= s0 && r_ < s1) v_ = *(const u32x4*)(Ug + (size_t)r_ * 512 + c0); v_; })
    q0 = CV_ROW(0); q1 = CV_ROW(1); q2 = CV_ROW(2); q3 = CV_ROW(3);
#pragma unroll 1
    for (int i = 0; i < TT + 30; ++i) {
      const u32x4 w = q0;
      q0 = q1; q1 = q2; q2 = q3; q3 = CV_ROW(i + 4);
      f32x2 x2[4];
#pragma unroll
      for (int e = 0; e < 4; ++e) x2[e] = (f32x2){bflo(w[e]), bfhi(w[e])};
#pragma unroll
      for (int o = 0; o < TT; ++o) {
        const int j = i - o;
        if ((unsigned)j <= 30u) {
          const f32x4 w0 = *(const f32x4*)(wl + ((j * 2 + 0) * 64 + lane) * 4), w1 = *(const f32x4*)(wl + ((j * 2 + 1) * 64 + lane) * 4);
          acc2[o][0] += x2[0] * (f32x2){w0[0], w0[1]}; acc2[o][1] += x2[1] * (f32x2){w0[2], w0[3]};
          acc2[o][2] += x2[2] * (f32x2){w1[0], w1[1]}; acc2[o][3] += x2[3] * (f32x2){w1[2], w1[3]};
        }
      }
    }
#undef CV_ROW
    const f32x4 bias0 = *(const f32x4*)(p.conv_b + c0), bias1 = *(const f32x4*)(p.conv_b + c0 + 4);
    const f32x4 g0 = *(const f32x4*)(p.conv_norm_g + c0), g1 = *(const f32x4*)(p.conv_norm_g + c0 + 4);
    const f32x4 b0 = *(const f32x4*)(p.conv_norm_b + c0), b1 = *(const f32x4*)(p.conv_norm_b + c0 + 4);
#pragma unroll
    for (int o = 0; o < TT; ++o) {
      float v[8];
#pragma unroll
      for (int e = 0; e < 4; ++e) { v[e] = acc2[o][e >> 1][e & 1] + bias0[e]; v[4 + e] = acc2[o][2 + (e >> 1)][e & 1] + bias1[e]; }
      float sm = 0.f;
#pragma unroll
      for (int e = 0; e < 8; ++e) sm += v[e];
      const float mean = wave_sum(sm) * (1.f / 512.f);
      float q = 0.f;
#pragma unroll
      for (int e = 0; e < 8; ++e) { const float d = v[e] - mean; q += d * d; }
      const float rstd = rsqrtf(wave_sum(q) * (1.f / 512.f) + EPS);
      float y[8];
#pragma unroll
      for (int e = 0; e < 4; ++e) {
        const float z0 = (v[e] - mean) * rstd * g0[e] + b0[e], z1 = (v[4 + e] - mean) * rstd * g1[e] + b1[e];
        y[e] = z0 / (1.f + __expf(-z0)); y[4 + e] = z1 / (1.f + __expf(-z1));
      }
      *(u32x4*)(cat + (size_t)(t0 + o) * 1024 + c0) = (u32x4){pack2(y[0], y[1]), pack2(y[2], y[3]), pack2(y[4], y[5]), pack2(y[6], y[7])};
    }
  }
  __syncthreads();
}

__global__ void __launch_bounds__(NT, 2) fwd_kernel(Params p, int ph_lo, int ph_hi) {
  __shared__ __attribute__((aligned(16))) char smem[2 * G_STAGE + 12288];
  __shared__ uint4 xb_words;
  cg::grid_group grid = cg::this_grid();
  char* ws = p.ws;
  if (threadIdx.x == 0) xb_words = make_uint4(0u, 0u, 0u, 0u);
  __syncthreads();
  const XcdBarrier xb = xcd_barrier_post((unsigned*)(ws + O_BAR), (volatile LDS_AS unsigned*)&xb_words);
  if (ph_lo > 1000) grid.sync();
  float* mods = (float*)(ws + O_MODS);
  bf16_t* Hb = (bf16_t*)(ws + O_HB);
  float* X = p.out;
  float* xbuf = (float*)(ws + O_XBUF);
  unsigned* lncnt = (unsigned*)(ws + O_LNCNT);
  const bool fused = (gridDim.x == 256);
#define GSYNC() xcd_barrier(xb)
#define PH_BEGIN(n) if (ph_lo <= n && n < ph_hi) { if (n > ph_lo) GSYNC();
#define PH_BEGIN_IF(n, c) if (ph_lo <= n && n < ph_hi && (c)) { if (n > ph_lo) GSYNC();
#define PH_END }
#ifndef PROBE_DUP
#define PROBE_DUP 0
#endif
#ifndef PROBE_SYNCS
#define PROBE_SYNCS 0
#endif
#define DUP(n, ...) __VA_ARGS__; if ((PROBE_DUP >> n) & 1) { GSYNC(); __VA_ARGS__; }
  for (int i = 0; i < PROBE_SYNCS; ++i) GSYNC();
  PH_BEGIN(0) { DUP(0, phase0(p, smem)); } PH_END
  PH_BEGIN(2) {
    float* o_k = p.out + (size_t)NTOK * 1024; float* o_v = o_k + (size_t)NCTX * 512; float* o_ckv = o_v + (size_t)NCTX * 512; float* o_kr = o_ckv + (size_t)NCTX * 128;
    DUP(2, gemm_phase(Hb, 1024, (const bf16_t*)(ws + O_WATTIN), 1024, 1024, 64, 8,
                      EpiAttIn{(bf16_t*)(ws + O_QDA), (bf16_t*)(ws + O_QDB), (bf16_t*)(ws + O_KD), (bf16_t*)(ws + O_VD), (bf16_t*)(ws + O_CQN), (bf16_t*)(ws + O_CKVN), (bf16_t*)(ws + O_KMLA),
                               o_k, o_v, o_ckv, o_kr, (const float*)(ws + O_C16), (const float*)(ws + O_S16), (const float*)(ws + O_C8), (const float*)(ws + O_S8), p.q_norm_g, p.kv_norm_g, smem + 2 * G_STAGE}, smem));
  } PH_END
  PH_BEGIN(4) {
        const int n1 = 64 * 3, n2 = 67 * 4;
        gemm_phase((const bf16_t*)(ws + O_CQN), 256, (const bf16_t*)(ws + O_WUQ), 256, 256, 64, 3,
                   EpiUq{(bf16_t*)(ws + O_QMA), (bf16_t*)(ws + O_QMB), (const float*)(ws + O_C8), (const float*)(ws + O_S8)}, smem, 0, n1 + n2);
        gemm_phase((const bf16_t*)(ws + O_CKVN), 128, (const bf16_t*)(ws + O_WUKV), 128, 128, 67, 4,
                   EpiUkv{(bf16_t*)(ws + O_KMLA), (bf16_t*)(ws + O_VMLA), smem}, smem, n1, n1 + n2);
  } PH_END
  PH_BEGIN(5) { phase_attn(p, smem, 0); if ((PROBE_DUP >> 5) & 1) { GSYNC(); phase_attn(p, smem, 1); } } PH_END
  PH_BEGIN(6) { gemm_phase(Hb, 1024, (const bf16_t*)(ws + O_WATTOUT), 1024, 1024, 64, 4, EpiResLN{p.x_prompt, p.x_sample, mods + 2048, X, p.ln_mix_g, p.ln_mix_b, mods, 3072, 4096, Hb, xbuf, lncnt, smem + 2 * G_STAGE, fused}, smem); } PH_END
  PH_BEGIN_IF(7, !fused) { rows_phase(X, X + (size_t)NCTX * 1024, true, p.ln_mix_g, p.ln_mix_b, X, mods, 3072, 4096, Hb); } PH_END
  PH_BEGIN(8) { DUP(8, gemm_phase(Hb, 1024, (const bf16_t*)(ws + O_WMLPIN), 1024, 1024, 64, 16, EpiRelu2{(bf16_t*)(ws + O_U), smem}, smem)); } PH_END
  PH_BEGIN(9) { gemm_phase((const bf16_t*)(ws + O_U), 4096, (const bf16_t*)(ws + O_WMLPOUT), 4096, 4096, 64, 4, EpiResLN{X, X + (size_t)NCTX * 1024, mods + 5120, X, p.ln_mlp_g, p.ln_mlp_b, mods + 3 * 6144, 0, 1024, Hb, xbuf + 98304, lncnt + 64, smem + 2 * G_STAGE, fused}, smem); } PH_END
  PH_BEGIN_IF(10, !fused) { rows_phase(X, X + (size_t)NCTX * 1024, true, p.ln_mlp_g, p.ln_mlp_b, X, mods + 3 * 6144, 0, 1024, Hb); } PH_END
  PH_BEGIN(11) { DUP(11, gemm_phase(Hb, 1024, (const bf16_t*)(ws + O_WCONVIN), 1024, 1024, 64, 6, EpiConv{(bf16_t*)(ws + O_UG), (bf16_t*)(ws + O_PZ), smem}, smem)); } PH_END
  PH_BEGIN(12) { DUP(12, phase_conv(p, smem)); } PH_END
  PH_BEGIN(13) { gemm_phase(Hb, 1024, (const bf16_t*)(ws + O_WCONVOUT), 1024, 1024, 64, 4, EpiResLN{X, X + (size_t)NCTX * 1024, mods + 3 * 6144 + 2048, X, p.ln_mix_g + 1024, p.ln_mix_b + 1024, mods + 3 * 6144, 3072, 4096, Hb, xbuf + 2 * 98304, lncnt + 128, smem + 2 * G_STAGE, fused}, smem); } PH_END
  PH_BEGIN_IF(14, !fused) { rows_phase(X, X + (size_t)NCTX * 1024, true, p.ln_mix_g + 1024, p.ln_mix_b + 1024, X, mods + 3 * 6144, 3072, 4096, Hb); } PH_END
  PH_BEGIN(15) { DUP(15, gemm_phase(Hb, 1024, (const bf16_t*)(ws + O_WMLPIN) + (size_t)4096 * 1024, 1024, 1024, 64, 16, EpiRelu2{(bf16_t*)(ws + O_U), smem}, smem)); } PH_END
  PH_BEGIN(16) { gemm_phase((const bf16_t*)(ws + O_U), 4096, (const bf16_t*)(ws + O_WMLPOUT) + (size_t)4096 * 1024, 4096, 4096, 64, 4, EpiResLN{X, X + (size_t)NCTX * 1024, mods + 3 * 6144 + 5120, X, p.ln_mlp_g + 1024, p.ln_mlp_b + 1024, mods, 0, 0, nullptr, xbuf + 3 * 98304, lncnt + 192, smem + 2 * G_STAGE, fused}, smem); } PH_END
  PH_BEGIN_IF(17, !fused) { rows_phase(X, X + (size_t)NCTX * 1024, true, p.ln_mlp_g + 1024, p.ln_mlp_b + 1024, X, nullptr, 0, 0, nullptr); } PH_END
}

extern "C" void kernel_launch(void* const* d_in, const int* in_sizes, int n_in, void* d_out, int out_size, void* d_ws, size_t ws_size, hipStream_t stream) {
  static int grid_blocks = 0;
  if (!grid_blocks) {
    int dev = 0, cus = 0, per_cu = 0;
    hipGetDevice(&dev);
    hipDeviceGetAttribute(&cus, hipDeviceAttributeMultiprocessorCount, dev);
    hipOccupancyMaxActiveBlocksPerMultiprocessor(&per_cu, fwd_kernel, NT, 0);
    if (per_cu > 1) per_cu = 1;
    if (per_cu < 1) per_cu = 1;
    grid_blocks = cus * per_cu;
    if (grid_blocks > 256) grid_blocks = 256;
  }
  if (ws_size < WS_NEED) { fprintf(stderr, "workspace too small: %zu < %zu\n", ws_size, (size_t)WS_NEED); return; }
  Params p{};
  const float** f = (const float**)&p;
  for (int i = 0; i < 35; ++i) f[i] = (const float*)d_in[i];
  p.out = (float*)d_out;
  p.ws = (char*)d_ws;
  hipMemsetAsync(d_ws, 0, 16384, stream);
  int lo = 0, hi = NPHASE;
  void* args[] = {&p, &lo, &hi};
  hipError_t e = hipLaunchCooperativeKernel((void*)fwd_kernel, dim3(grid_blocks), dim3(NT), args, 0, stream);
  if (e != hipSuccess) fprintf(stderr, "cooperative launch failed: %s (grid %d)\n", hipGetErrorString(e), grid_blocks);
}
```

```cpp
#include <hip/hip_runtime.h>
#include <hip/hip_cooperative_groups.h>
#include <cstdio>
#include <cstdint>
namespace cg = cooperative_groups;

typedef unsigned short bf16_t;
typedef short bf16x8 __attribute__((ext_vector_type(8)));
typedef short s16x4 __attribute__((ext_vector_type(4)));
typedef float f32x4 __attribute__((ext_vector_type(4)));
typedef float f32x2 __attribute__((ext_vector_type(2)));
typedef float f32x16 __attribute__((ext_vector_type(16)));
typedef unsigned u32x4 __attribute__((ext_vector_type(4)));
typedef unsigned u32x2 __attribute__((ext_vector_type(2)));
typedef __bf16 bf16v2 __attribute__((ext_vector_type(2)));
#define DI __device__ __forceinline__
#define LDS_AS __attribute__((address_space(3)))

constexpr int NTOK = 12288, NCTX = 4096, NKEY = 12800, TLAT = 4096, TKL = 4352;
constexpr int RLD = 1952;
constexpr float ALPHA = 1.41421356237f, EPS = 1e-5f;
constexpr int NPHASE = 18;
constexpr int NT = 512, NWAVE = 8;

constexpr size_t al(size_t x) { return (x + 255) & ~(size_t)255; }
constexpr size_t O_CNT = 0;
constexpr size_t O_BAR = 256;
constexpr size_t O_LNCNT = 14336;
constexpr size_t O_MODS = 16384;
constexpr size_t O_SCAL = O_MODS + al(2 * 3 * 6144 * 4);
constexpr size_t O_C16 = O_SCAL + 256;
constexpr size_t O_S16 = O_C16 + 4096;
constexpr size_t O_C8 = O_S16 + 4096;
constexpr size_t O_S8 = O_C8 + 2048;
constexpr size_t O_XBUF = O_S8 + 2048;
constexpr size_t O_WATTIN = O_XBUF + (size_t)4 * 256 * 192 * 2 * 4;
constexpr size_t O_WUQ = O_WATTIN + (size_t)2048 * 1024 * 2;
constexpr size_t O_WUKV = O_WUQ + (size_t)768 * 256 * 2;
constexpr size_t O_WATTOUT = O_WUKV + (size_t)1024 * 128 * 2;
constexpr size_t O_WMLPIN = O_WATTOUT + (size_t)1024 * 1024 * 2;
constexpr size_t O_WMLPOUT = O_WMLPIN + (size_t)2 * 4096 * 1024 * 2;
constexpr size_t O_WCONVIN = O_WMLPOUT + (size_t)2 * 4096 * 1024 * 2;
constexpr size_t O_WCONVOUT = O_WCONVIN + (size_t)1536 * 1024 * 2;
constexpr size_t O_HB = O_WCONVOUT + (size_t)1024 * 1024 * 2;
constexpr size_t O_BIG = O_HB + (size_t)NTOK * 1024 * 2;
constexpr size_t O_R = O_BIG;
constexpr size_t O_QMA = O_R;
constexpr size_t O_QMB = O_QMA + (size_t)NTOK * 768 * 2;
constexpr size_t O_QDA = O_R + al((size_t)NTOK * RLD * 2);
constexpr size_t O_QDB = O_QDA + (size_t)NTOK * 512 * 2;
constexpr size_t O_KD = O_QDB + (size_t)8192 * 512 * 2;
constexpr size_t O_VD = O_KD + (size_t)NKEY * 512 * 2;
constexpr size_t O_CQN = O_VD + (size_t)NKEY * 512 * 2;
constexpr size_t O_CKVN = O_CQN + (size_t)NTOK * 256 * 2;
constexpr size_t O_KMLA = O_CKVN + (size_t)NKEY * 128 * 2;
constexpr size_t O_VMLA = O_KMLA + (size_t)NKEY * 768 * 2;
constexpr size_t O_OTMP = O_VMLA + (size_t)NKEY * 512 * 2;
constexpr size_t O_ATT_END = O_OTMP + (size_t)512 * 16384 * 4;
constexpr size_t O_U = O_BIG;
constexpr size_t O_U_END = O_U + (size_t)NTOK * 4096 * 2;
constexpr size_t O_UG = O_BIG;
constexpr size_t O_PZ = O_UG + (size_t)NTOK * 512 * 2;
constexpr size_t WS_NEED = (O_ATT_END > O_U_END ? O_ATT_END : O_U_END);
static_assert(O_QMB + (size_t)8192 * 768 * 2 <= O_QDA, "Qm overlay must fit in R");
static_assert(WS_NEED <= (size_t)256 * 1024 * 1024, "workspace too large");

struct Params {
  const float *x_prompt, *x_sample, *cache_k, *cache_v, *cache_ckv, *cache_krope, *c, *c_ctx;
  const float *w_ada, *b_ada, *ln_mix_g, *ln_mix_b, *ln_mlp_g, *ln_mlp_b, *w_mlp_in, *w_mlp_out;
  const float *w_att_in, *w_uq, *w_ukv, *q_norm_g, *kv_norm_g, *lam_q1, *lam_k1, *lam_q2, *lam_k2, *diff_norm_g, *w_att_out;
  const float *w_conv_in, *conv_w, *conv_b, *conv_norm_g, *conv_norm_b, *w_pool, *pool_scale, *w_conv_out;
  float* out;
  char* ws;
};

DI unsigned pack2(float lo, float hi) { f32x2 v = {lo, hi}; bf16v2 b = __builtin_convertvector(v, bf16v2); return __builtin_bit_cast(unsigned, b); }
DI float bf2f(unsigned short u) { return __uint_as_float((unsigned)u << 16); }
DI float bflo(unsigned u) { return __uint_as_float(u << 16); }
DI float bfhi(unsigned u) { return __uint_as_float(u & 0xffff0000u); }
DI float wave_sum(float v) {
#pragma unroll
  for (int o = 32; o >= 1; o >>= 1) v += __shfl_xor(v, o);
  return v;
}
DI void lds_barrier() { asm volatile("s_waitcnt lgkmcnt(0)\n\ts_barrier" ::: "memory"); }
DI void dma16(const void* gsrc, unsigned lds_dst) {
  unsigned keep;
  asm volatile("s_mov_b32 %0, m0\n\ts_mov_b32 m0, %2\n\ts_nop 0\n\tglobal_load_lds_dwordx4 %1, off\n\ts_mov_b32 m0, %0" : "=&s"(keep) : "v"(gsrc), "s"(lds_dst) : "memory");
}
DI int cond_idx(int row) { return row < NCTX ? 0 : 1 + ((row - NCTX) >> 12); }


#define XB_TMO      128
#define XB_XCNT(j)  (256  + 64 * (j))
#define XB_XSUB(j)  (1280 + 64 * (j))
#define XB_XGEN(j)  (2304 + 64 * (j))
#define XB_TOP      3328
#define XB_TOPGEN   3392
#define XCD_BAR_WORDS 3456
#define XB_SPIN_CAP (1u << 18)
DI unsigned xb_ld(unsigned* p)              { return __hip_atomic_load(p, __ATOMIC_RELAXED, __HIP_MEMORY_SCOPE_AGENT); }
DI unsigned xb_add(unsigned* p, unsigned v) { return __hip_atomic_fetch_add(p, v, __ATOMIC_RELAXED, __HIP_MEMORY_SCOPE_AGENT); }
DI unsigned xb_xcc_id() { return (unsigned)__builtin_amdgcn_s_getreg((3 << 11) | 20) & 0xFu; }
#define XB_SPIN(cond, bar) do { unsigned _sp = 0; while (cond) { __builtin_amdgcn_s_sleep(1); \
    if ((++_sp & 255u) == 0u) { if (xb_ld(&(bar)[XB_TMO])) break; if (_sp > XB_SPIN_CAP) { atomicAdd(&(bar)[XB_TMO], 1u); break; } } } } while (0)
struct XcdBarrier { unsigned* bar; unsigned x; volatile LDS_AS unsigned* st; };
DI XcdBarrier xcd_barrier_post(unsigned* bar, volatile LDS_AS unsigned* st) {
  XcdBarrier b; b.bar = bar; b.x = xb_xcc_id(); b.st = st;
  if (threadIdx.x == 0) (void)xb_add(&bar[XB_XCNT(b.x)], 1u);
  return b;
}
DI void xcd_barrier_complete(unsigned* bar, unsigned x, unsigned& nloc, unsigned& nx) {
  const unsigned G = gridDim.x * gridDim.y * gridDim.z;
  unsigned sum, cnt, mine, sp = 0u;
  for (;;) {
    sum = 0u; cnt = 0u; mine = 0u;
#pragma unroll
    for (unsigned j = 0; j < 16; ++j) { const unsigned c = xb_ld(&bar[XB_XCNT(j)]); sum += c; cnt += (c > 0u) ? 1u : 0u; mine = (j == x) ? c : mine; }
    if (sum == G) break;
    __builtin_amdgcn_s_sleep(1);
    if ((++sp & 255u) == 0u) { if (xb_ld(&bar[XB_TMO])) break; if (sp > XB_SPIN_CAP) { atomicAdd(&bar[XB_TMO], 1u); break; } }
  }
  nloc = mine > 0u ? mine : 1u; nx = cnt > 0u ? cnt : 1u;
}
DI void xcd_barrier(const XcdBarrier& b) {
  asm volatile("s_waitcnt vmcnt(0)" ::: "memory");
  __syncthreads();
  if (threadIdx.x == 0) {
    unsigned* bar = b.bar;
    __builtin_amdgcn_s_waitcnt(0);
    unsigned nloc = b.st[0], nx = b.st[1];
    if (nloc == 0u) { xcd_barrier_complete(bar, b.x, nloc, nx); b.st[0] = nloc; b.st[1] = nx; }
    const unsigned old = xb_add(&bar[XB_XSUB(b.x)], 1u);
    const unsigned gen = old / nloc;
    if (old + 1u == (gen + 1u) * nloc) {
      __builtin_amdgcn_fence(__ATOMIC_RELEASE, "agent");
      asm volatile("s_waitcnt vmcnt(0)" ::: "memory");
      const unsigned og = xb_add(&bar[XB_TOP], 1u);
      const unsigned tg = og / nx;
      if (og + 1u == (tg + 1u) * nx) xb_add(&bar[XB_TOPGEN], 1u);
      else XB_SPIN(xb_ld(&bar[XB_TOPGEN]) == tg, bar);
      __builtin_amdgcn_fence(__ATOMIC_ACQUIRE, "agent");
      xb_add(&bar[XB_XGEN(b.x)], 1u);
      asm volatile("s_waitcnt vmcnt(0)" ::: "memory");
    } else {
      XB_SPIN(xb_ld(&bar[XB_XGEN(b.x)]) == gen, bar);
      __builtin_amdgcn_fence(__ATOMIC_ACQUIRE, "agent");
      asm volatile("s_waitcnt vmcnt(0)" ::: "memory");
    }
  }
  __syncthreads();
}

DI int swz(int row, int kc) { return row * 128 + ((kc ^ ((row >> 1) & 7)) << 4); }

constexpr int G_BM = 192, G_BN = 256, G_MI = 6, G_NJ = 4, G_ABYTES = G_BM * 128, G_STAGE = G_ABYTES + G_BN * 128;
template <class Epi>
DI void gemm_tile(const bf16_t* __restrict__ A, int lda, const bf16_t* __restrict__ Bt, int ldb, int K, int row0, int col0, char* smem, const Epi& epi,
                  bool prefetched, bool has_next, int nrow0, int ncol0) {
  const int tid = threadIdx.x, lane = tid & 63, wid = tid >> 6, wr = wid >> 2, wc = wid & 3;
  const int fr = lane & 15, fq = lane >> 4;
  f32x4 acc[G_MI][G_NJ];
#pragma unroll
  for (int i = 0; i < G_MI; ++i)
#pragma unroll
    for (int j = 0; j < G_NJ; ++j) acc[i][j] = (f32x4){0.f, 0.f, 0.f, 0.f};
  const int srow = tid >> 3, skc = tid & 7;
  const int schunk = skc ^ ((srow >> 1) & 7);
  const bf16_t* ga = A + (size_t)(row0 + srow) * lda + schunk * 8;
  const bf16_t* gb = Bt + (size_t)(col0 + srow) * ldb + schunk * 8;
  const int nk = K >> 6;
  const unsigned lds0 = __builtin_amdgcn_readfirstlane((unsigned)(size_t)(LDS_AS char*)smem + (unsigned)(tid & ~63) * 16u);
#define G_DMA_P(ga_, gb_, stage_off_, kt_) do { const int k0_ = (kt_) << 6; const unsigned sb_ = lds0 + (unsigned)(stage_off_); \
    _Pragma("unroll") for (int i = 0; i < 3; ++i) dma16((ga_) + (size_t)(64 * i) * lda + k0_, sb_ + i * 8192); \
    _Pragma("unroll") for (int i = 0; i < 4; ++i) dma16((gb_) + (size_t)(64 * i) * ldb + k0_, sb_ + G_ABYTES + i * 8192); } while (0)
#define G_DMA(stage_off_, kt_) G_DMA_P(ga, gb, stage_off_, kt_)
#define G_COMPUTE(buf_) do { const char* cur = (buf_); \
    _Pragma("unroll") for (int s = 0; s < 2; ++s) { \
      bf16x8 af[G_MI], bfr[G_NJ]; \
      _Pragma("unroll") for (int i = 0; i < G_MI; ++i) af[i] = *(const bf16x8*)(cur + swz(wr * 96 + i * 16 + fr, s * 4 + fq)); \
      _Pragma("unroll") for (int j = 0; j < G_NJ; ++j) bfr[j] = *(const bf16x8*)(cur + G_ABYTES + swz(wc * 64 + j * 16 + fr, s * 4 + fq)); \
      __builtin_amdgcn_s_setprio(1); \
      _Pragma("unroll") for (int i = 0; i < G_MI; ++i) \
        _Pragma("unroll") for (int j = 0; j < G_NJ; ++j) acc[i][j] = __builtin_amdgcn_mfma_f32_16x16x32_bf16(bfr[j], af[i], acc[i][j], 0, 0, 0); \
      __builtin_amdgcn_s_setprio(0); \
    } } while (0)
  if (!prefetched) { G_DMA(0, 0); asm volatile("s_waitcnt vmcnt(0)" ::: "memory"); }
  else asm volatile("s_waitcnt vmcnt(%0)" :: "n"(Epi::kMinStores) : "memory");
  lds_barrier();
  for (int kt = 0; kt < nk; kt += 2) {
    G_DMA(G_STAGE, kt + 1);
    G_COMPUTE(smem);
    asm volatile("s_waitcnt vmcnt(0)" ::: "memory");
    lds_barrier();
    G_DMA(0, min(kt + 2, nk - 1));
    G_COMPUTE(smem + G_STAGE);
    asm volatile("s_waitcnt vmcnt(0)" ::: "memory");
    lds_barrier();
  }
  if (has_next) {
    const bf16_t* gan = A + (size_t)(nrow0 + srow) * lda + schunk * 8;
    const bf16_t* gbn = Bt + (size_t)(ncol0 + srow) * ldb + schunk * 8;
    G_DMA_P(gan, gbn, 0, 0);
  }
#undef G_DMA
#undef G_DMA_P
#undef G_COMPUTE
  epi(acc, row0 + wr * 96, col0 + wc * 64, lane);
}


template <class F>
DI void wave_rows_store(char* w, const u32x2 (&pk)[G_MI][G_NJ], int lane, F rowptr) {
  const int fr = lane & 15, fq = lane >> 4;
#pragma unroll
  for (int i = 0; i < G_MI; ++i)
#pragma unroll
    for (int j = 0; j < G_NJ; ++j) *(u32x2*)(w + (i * 16 + fr) * 144 + (j * 16 + fq * 4) * 2) = pk[i][j];
  const int rr = lane >> 3, ch = lane & 7;
#pragma unroll
  for (int it = 0; it < 12; ++it) {
    const int r = it * 8 + rr;
    const u32x4 v = *(const u32x4*)(w + r * 144 + ch * 16);
    bf16_t* d = rowptr(r);
    if (d) *(u32x4*)(d + ch * 8) = v;
  }
}
DI u32x2 pk4(const f32x4 v) { return (u32x2){pack2(v[0], v[1]), pack2(v[2], v[3])}; }

struct EpiRaw {
  static constexpr int kMinStores = 0;
  static constexpr bool kPrefetchNext = true;
  bf16_t* R;
  DI void operator()(f32x4 (&acc)[G_MI][G_NJ], int rbase, int cbase, int lane) const {
    const int fr = lane & 15, fq = lane >> 4;
#pragma unroll
    for (int i = 0; i < G_MI; ++i)
#pragma unroll
      for (int j = 0; j < G_NJ; ++j) {
        const int row = rbase + i * 16 + fr, col = cbase + j * 16 + fq * 4;
        if (col < RLD) { u32x2 w = {pack2(acc[i][j][0], acc[i][j][1]), pack2(acc[i][j][2], acc[i][j][3])}; *(u32x2*)(R + (size_t)row * RLD + col) = w; }
      }
  }
};


struct EpiAttIn {
  static constexpr int kMinStores = 0;
  static constexpr bool kPrefetchNext = true;
  bf16_t *Qda, *Qdb, *Kd, *Vd, *cqn, *ckvn, *Km; float *o_k, *o_v, *o_ckv, *o_kr;
  const float *c16, *s16, *c8, *s8, *qg, *kvg; char* smem;
  DI void operator()(f32x4 (&acc)[G_MI][G_NJ], int rbase, int cbase, int lane) const {
    const int tid = threadIdx.x, wid = tid >> 6, wr = wid >> 2, wc = wid & 3, fr = lane & 15, fq = lane >> 4;
    const int tile = (cbase - wc * 64) >> 8;
    float* part = (float*)smem;
    if (tile < 6) {
      const int which = tile >> 1, c0 = cbase & 511;
#pragma unroll
      for (int i = 0; i < G_MI; ++i) {
        const int rowf = rbase + i * 16, row = rowf + fr;
        const bool lat = rowf >= NCTX;
        const int rl = row - NCTX, b = rl >> 12, t = rl & (TLAT - 1), prow = t >> 6, pcol = t & 63;
        const size_t kr = lat ? (size_t)NCTX + (size_t)b * TKL + 256 + t : (size_t)row;
        u32x2 raw[G_NJ], rot[G_NJ];
#pragma unroll
        for (int j = 0; j < G_NJ; ++j) raw[j] = (u32x2){pack2(acc[i][j][0], acc[i][j][1]), pack2(acc[i][j][2], acc[i][j][3])};
        if (lat && which < 2) {
#pragma unroll
          for (int jp = 0; jp < 2; ++jp) {
            const int pos = jp == 0 ? prow : pcol;
            const f32x4 cs = *(const f32x4*)(c16 + pos * 16 + fq * 4), sn = *(const f32x4*)(s16 + pos * 16 + fq * 4);
            const f32x4 x1 = acc[i][2 * jp], x2 = acc[i][2 * jp + 1];
            f32x4 o1, o2;
#pragma unroll
            for (int e = 0; e < 4; ++e) { o1[e] = x1[e] * cs[e] - x2[e] * sn[e]; o2[e] = x1[e] * sn[e] + x2[e] * cs[e]; }
            rot[2 * jp] = (u32x2){pack2(o1[0], o1[1]), pack2(o1[2], o1[3])};
            rot[2 * jp + 1] = (u32x2){pack2(o2[0], o2[1]), pack2(o2[2], o2[3])};
          }
        }
#pragma unroll
        for (int j = 0; j < G_NJ; ++j) {
          const int c = c0 + j * 16 + fq * 4;
          if (which == 0) {
            *(u32x2*)(Qda + (size_t)row * 512 + c) = raw[j];
            if (lat) *(u32x2*)(Qdb + (size_t)rl * 512 + c) = rot[j];
          } else if (which == 1) {
            if (lat) *(u32x2*)(Kd + kr * 512 + c) = rot[j];
            else { *(u32x2*)(Kd + kr * 512 + c) = raw[j]; *(f32x4*)(o_k + (size_t)row * 512 + c) = acc[i][j]; }
          } else {
            *(u32x2*)(Vd + kr * 512 + c) = raw[j];
            if (!lat) *(f32x4*)(o_v + (size_t)row * 512 + c) = acc[i][j];
          }
        }
      }
      return;
    }
    const bool norm_wave = (tile == 6) || (wc < 2);
#pragma unroll
    for (int i = 0; i < G_MI; ++i) {
      float ss = 0.f;
#pragma unroll
      for (int j = 0; j < G_NJ; ++j)
#pragma unroll
        for (int e = 0; e < 4; ++e) ss += acc[i][j][e] * acc[i][j][e];
      ss += __shfl_xor(ss, 16); ss += __shfl_xor(ss, 32);
      if (fq == 0) part[(wr * 96 + i * 16 + fr) * 4 + wc] = ss;
    }
    __syncthreads();
#pragma unroll
    for (int i = 0; i < G_MI; ++i) {
      const int rowf = rbase + i * 16, row = rowf + fr;
      const bool lat = rowf >= NCTX;
      const int rl = row - NCTX, b = rl >> 12, t = rl & (TLAT - 1), prow = t >> 6, pcol = t & 63;
      const size_t kr = lat ? (size_t)NCTX + (size_t)b * TKL + 256 + t : (size_t)row;
      const f32x4 pr = *(const f32x4*)(part + (wr * 96 + i * 16 + fr) * 4);
      if (tile == 6) {
        const float sc = rsqrtf(((pr[0] + pr[1]) + (pr[2] + pr[3])) * (1.f / 256.f) + EPS);
#pragma unroll
        for (int j = 0; j < G_NJ; ++j) {
          const int c = wc * 64 + j * 16 + fq * 4;
          const f32x4 g = *(const f32x4*)(qg + c);
          *(u32x2*)(cqn + (size_t)row * 256 + c) = (u32x2){pack2(acc[i][j][0] * sc * g[0], acc[i][j][1] * sc * g[1]), pack2(acc[i][j][2] * sc * g[2], acc[i][j][3] * sc * g[3])};
        }
      } else if (norm_wave) {
        const float sc = rsqrtf((pr[0] + pr[1]) * (1.f / 128.f) + EPS);
#pragma unroll
        for (int j = 0; j < G_NJ; ++j) {
          const int c = wc * 64 + j * 16 + fq * 4;
          const f32x4 g = *(const f32x4*)(kvg + c);
          f32x4 y;
#pragma unroll
          for (int e = 0; e < 4; ++e) y[e] = acc[i][j][e] * sc * g[e];
          if (!lat) *(f32x4*)(o_ckv + (size_t)row * 128 + c) = y;
          *(u32x2*)(ckvn + kr * 128 + c) = (u32x2){pack2(y[0], y[1]), pack2(y[2], y[3])};
        }
      } else if (wc == 2) {
#pragma unroll
        for (int j = 0; j < 2; ++j) {
          f32x4 v = acc[i][j];
          if (lat) {
            const int pos = j == 0 ? prow : pcol;
            f32x4 o;
#pragma unroll
            for (int e = 0; e < 4; ++e) {
              const float pv = __shfl_xor(v[e], 32);
              const int f = (fq & 1) * 4 + e;
              const float cs = c8[pos * 8 + f], sn = s8[pos * 8 + f];
              o[e] = (fq < 2) ? (v[e] * cs - pv * sn) : (pv * sn + v[e] * cs);
            }
            v = o;
          } else *(f32x4*)(o_kr + (size_t)row * 32 + j * 16 + fq * 4) = v;
          const u32x2 w = {pack2(v[0], v[1]), pack2(v[2], v[3])};
#pragma unroll
          for (int hh = 0; hh < 8; ++hh) *(u32x2*)(Km + kr * 768 + hh * 96 + 64 + j * 16 + fq * 4) = w;
        }
      }
    }
    __syncthreads();
  }
};

struct EpiUq {
  static constexpr int kMinStores = 24;
  static constexpr bool kPrefetchNext = true;
  bf16_t *Qa, *Qb; const float *c8, *s8;
  DI void operator()(f32x4 (&acc)[G_MI][G_NJ], int rbase, int cbase, int lane) const {
    const int fr = lane & 15, fq = lane >> 4;
#pragma unroll
    for (int i = 0; i < G_MI; ++i) {
      const bool lat = (rbase + i * 16) >= NCTX;
      const int row = rbase + i * 16 + fr;
      const int t = (row - NCTX) & (TLAT - 1);
#pragma unroll
      for (int j = 0; j < G_NJ; ++j) {
        const int cf = cbase + j * 16, col = cf + fq * 4;
        f32x4 v = acc[i][j];
        u32x2 w = {pack2(v[0], v[1]), pack2(v[2], v[3])};
        *(u32x2*)(Qa + (size_t)row * 768 + col) = w;
        if (lat) {
          const int w96 = cf % 96;
          if (w96 >= 64) {
            const int pos = (w96 == 64) ? (t >> 6) : (t & 63);
            f32x4 o;
#pragma unroll
            for (int e = 0; e < 4; ++e) {
              const float pv = __shfl_xor(v[e], 32);
              const int f = (fq & 1) * 4 + e;
              const float cs = c8[pos * 8 + f], sn = s8[pos * 8 + f];
              o[e] = (fq < 2) ? (v[e] * cs - pv * sn) : (pv * sn + v[e] * cs);
            }
            w = (u32x2){pack2(o[0], o[1]), pack2(o[2], o[3])};
          }
          *(u32x2*)(Qb + (size_t)(row - NCTX) * 768 + col) = w;
        }
      }
    }
  }
};

struct EpiUkv {
  static constexpr int kMinStores = 0;
  static constexpr bool kPrefetchNext = false;
  bf16_t *Km, *Vm; char* lds;
  DI void operator()(f32x4 (&acc)[G_MI][G_NJ], int rbase, int cbase, int lane) const {
    const int h = cbase >> 7, part = (cbase >> 6) & 1;
    u32x2 pk[G_MI][G_NJ];
#pragma unroll
    for (int i = 0; i < G_MI; ++i)
#pragma unroll
      for (int j = 0; j < G_NJ; ++j) pk[i][j] = pk4(acc[i][j]);
    bf16_t* base = part == 0 ? Km + h * 96 : Vm + h * 64;
    const int ld = part == 0 ? 768 : 512;
    wave_rows_store(lds + (threadIdx.x >> 6) * (96 * 144), pk, lane, [&](int r) -> bf16_t* { const int row = rbase + r; return row < NKEY ? base + (size_t)row * ld : nullptr; });
    lds_barrier();
  }
};

struct EpiRes {
  static constexpr int kMinStores = 0;
  static constexpr bool kPrefetchNext = true;
  const float *xin_ctx, *xin_lat, *gate  ; float* X;
  DI void operator()(f32x4 (&acc)[G_MI][G_NJ], int rbase, int cbase, int lane) const {
    const int fr = lane & 15, fq = lane >> 4;
#pragma unroll
    for (int i = 0; i < G_MI; ++i) {
      const int row = rbase + i * 16 + fr;
      const float* g = gate + cond_idx(rbase + i * 16) * 6144;
      const float* xin = row < NCTX ? xin_ctx + (size_t)row * 1024 : xin_lat + (size_t)(row - NCTX) * 1024;
#pragma unroll
      for (int j = 0; j < G_NJ; ++j) {
        const int col = cbase + j * 16 + fq * 4;
        const f32x4 xv = *(const f32x4*)(xin + col), gv = *(const f32x4*)(g + col);
        f32x4 z;
#pragma unroll
        for (int e = 0; e < 4; ++e) z[e] = ALPHA * xv[e] + gv[e] * acc[i][j][e];
        *(f32x4*)(X + (size_t)row * 1024 + col) = z;
      }
    }
  }
};


struct EpiResLN {
  static constexpr int kMinStores = 0;
  static constexpr bool kPrefetchNext = true;
  const float *xin_ctx, *xin_lat, *gate; float* X;
  const float *lg, *lb, *modsL; int sh_off, sc_off; bf16_t* Hb;
  float* xbuf; unsigned* cnt; char* smem; bool fused;
  DI void operator()(f32x4 (&acc)[G_MI][G_NJ], int rbase, int cbase, int lane) const {
    const int tid = threadIdx.x, wid = tid >> 6, wr = wid >> 2, wc = wid & 3, fr = lane & 15, fq = lane >> 4;
#pragma unroll
    for (int i = 0; i < G_MI; ++i) {
      const int row = rbase + i * 16 + fr;
      const float* g = gate + cond_idx(rbase + i * 16) * 6144;
      const float* xin = row < NCTX ? xin_ctx + (size_t)row * 1024 : xin_lat + (size_t)(row - NCTX) * 1024;
#pragma unroll
      for (int j = 0; j < G_NJ; ++j) {
        const int col = cbase + j * 16 + fq * 4;
        const f32x4 xv = *(const f32x4*)(xin + col), gv = *(const f32x4*)(g + col);
#pragma unroll
        for (int e = 0; e < 4; ++e) acc[i][j][e] = ALPHA * xv[e] + gv[e] * acc[i][j][e];
        if (!fused) *(f32x4*)(X + (size_t)row * 1024 + col) = acc[i][j];
      }
    }
    if (!fused) return;
    const int row0 = rbase - wr * 96, pm = row0 / G_BM, pn = (cbase - wc * 64) / G_BN;
    f32x2* part = (f32x2*)smem;
    f32x2* stat = (f32x2*)(smem + 8192);
#pragma unroll
    for (int i = 0; i < G_MI; ++i) {
      float s1 = 0.f, s2 = 0.f;
#pragma unroll
      for (int j = 0; j < G_NJ; ++j)
#pragma unroll
        for (int e = 0; e < 4; ++e) { const float v = acc[i][j][e]; s1 += v; s2 += v * v; }
      s1 += __shfl_xor(s1, 16); s2 += __shfl_xor(s2, 16);
      s1 += __shfl_xor(s1, 32); s2 += __shfl_xor(s2, 32);
      if (fq == 0) part[(wr * 96 + i * 16 + fr) * 4 + wc] = (f32x2){s1, s2};
    }
    __syncthreads();
    if (tid < G_BM) {
      const f32x2 a = part[tid * 4 + 0], b = part[tid * 4 + 1], c = part[tid * 4 + 2], d = part[tid * 4 + 3];
      const float s1 = (a[0] + b[0]) + (c[0] + d[0]), s2 = (a[1] + b[1]) + (c[1] + d[1]);
      const unsigned long long pk = ((unsigned long long)__float_as_uint(s2) << 32) | (unsigned long long)__float_as_uint(s1);
      __hip_atomic_store((unsigned long long*)(xbuf + ((size_t)(pm * 4 + pn) * G_BM + tid) * 2), pk, __ATOMIC_RELAXED, __HIP_MEMORY_SCOPE_AGENT);
    }
    asm volatile("s_waitcnt vmcnt(0)" ::: "memory");
    __syncthreads();
    if (tid == 0) {
      __hip_atomic_fetch_add(cnt + pm, 1u, __ATOMIC_RELAXED, __HIP_MEMORY_SCOPE_AGENT);
      unsigned sp = 0;
      while (__hip_atomic_load(cnt + pm, __ATOMIC_RELAXED, __HIP_MEMORY_SCOPE_AGENT) < 4u) { __builtin_amdgcn_s_sleep(1); if (++sp > (1u << 22)) break; }
    }
    __syncthreads();
    if (tid < G_BM) {
      float s1 = 0.f, s2 = 0.f;
#pragma unroll
      for (int q = 0; q < 4; ++q) {
        const unsigned long long pk = __hip_atomic_load((unsigned long long*)(xbuf + ((size_t)(pm * 4 + q) * G_BM + tid) * 2), __ATOMIC_RELAXED, __HIP_MEMORY_SCOPE_AGENT);
        s1 += __uint_as_float((unsigned)pk); s2 += __uint_as_float((unsigned)(pk >> 32));
      }
      const float mean = s1 * (1.f / 1024.f);
      const float var = fmaxf(s2 * (1.f / 1024.f) - mean * mean, 0.f);
      stat[tid] = (f32x2){mean, rsqrtf(var + EPS)};
    }
    __syncthreads();
#pragma unroll
    for (int i = 0; i < G_MI; ++i) {
      const int row = rbase + i * 16 + fr;
      const f32x2 ms = stat[wr * 96 + i * 16 + fr];
      const float* m = modsL + cond_idx(rbase + i * 16) * 6144;
#pragma unroll
      for (int j = 0; j < G_NJ; ++j) {
        const int col = cbase + j * 16 + fq * 4;
        const f32x4 gv = *(const f32x4*)(lg + col), bv = *(const f32x4*)(lb + col);
        f32x4 x;
#pragma unroll
        for (int e = 0; e < 4; ++e) x[e] = (acc[i][j][e] - ms[0]) * ms[1] * gv[e] + bv[e];
        *(f32x4*)(X + (size_t)row * 1024 + col) = x;
        if (Hb) {
          const f32x4 sh = *(const f32x4*)(m + sh_off + col), sc = *(const f32x4*)(m + sc_off + col);
          u32x2 w = {pack2(x[0] * (1.f + sc[0]) + sh[0], x[1] * (1.f + sc[1]) + sh[1]), pack2(x[2] * (1.f + sc[2]) + sh[2], x[3] * (1.f + sc[3]) + sh[3])};
          *(u32x2*)(Hb + (size_t)row * 1024 + col) = w;
        }
      }
    }
    __syncthreads();
  }
};

struct EpiRelu2 {
  static constexpr int kMinStores = 12;
  static constexpr bool kPrefetchNext = true;
  bf16_t* U; char* lds;
  DI void operator()(f32x4 (&acc)[G_MI][G_NJ], int rbase, int cbase, int lane) const {
    const int fr = lane & 15, fq = lane >> 4, wid = threadIdx.x >> 6;
    char* w = lds + wid * (48 * 144);
    const int rr = lane >> 3, ch = lane & 7;
#pragma unroll
    for (int hf = 0; hf < 2; ++hf) {
#pragma unroll
      for (int i3 = 0; i3 < 3; ++i3)
#pragma unroll
        for (int j = 0; j < G_NJ; ++j) {
          f32x4 v = acc[hf * 3 + i3][j];
#pragma unroll
          for (int e = 0; e < 4; ++e) { const float r = fmaxf(v[e], 0.f); v[e] = r * r; }
          *(u32x2*)(w + (i3 * 16 + fr) * 144 + (j * 16 + fq * 4) * 2) = (u32x2){pack2(v[0], v[1]), pack2(v[2], v[3])};
        }
#pragma unroll
      for (int it = 0; it < 6; ++it) {
        const int r = it * 8 + rr;
        const u32x4 v = *(const u32x4*)(w + r * 144 + ch * 16);
        *(u32x4*)(U + (size_t)(rbase + hf * 48 + r) * 4096 + cbase + ch * 8) = v;
      }
    }
  }
};

struct EpiConv {
  static constexpr int kMinStores = 0;
  static constexpr bool kPrefetchNext = false;
  bf16_t *Ug, *Pz; char* lds;
  DI void operator()(f32x4 (&acc)[G_MI][G_NJ], int rbase, int cbase, int lane) const {
    const int fr = lane & 15, fq = lane >> 4;
    char* w = lds + (threadIdx.x >> 6) * (96 * 144);
    if (cbase < 1024) {
#pragma unroll
      for (int i = 0; i < G_MI; ++i)
#pragma unroll
        for (int jp = 0; jp < 2; ++jp) {
          const f32x4 a = acc[i][2 * jp], gt = acc[i][2 * jp + 1];
          f32x4 u;
#pragma unroll
          for (int e = 0; e < 4; ++e) u[e] = a[e] / (1.f + __expf(-gt[e]));
          *(u32x2*)(w + (i * 16 + fr) * 80 + (jp * 16 + fq * 4) * 2) = pk4(u);
        }
      const int rr = lane >> 2, ch = lane & 3, c0 = (cbase >> 5) * 16;
#pragma unroll
      for (int it = 0; it < 6; ++it) {
        const int r = it * 16 + rr;
        const u32x4 v = *(const u32x4*)(w + r * 80 + ch * 16);
        *(u32x4*)(Ug + (size_t)(rbase + r) * 512 + c0 + ch * 8) = v;
      }
    } else {
      u32x2 pk[G_MI][G_NJ];
#pragma unroll
      for (int i = 0; i < G_MI; ++i)
#pragma unroll
        for (int j = 0; j < G_NJ; ++j) pk[i][j] = pk4(acc[i][j]);
      wave_rows_store(w, pk, lane, [&](int r) -> bf16_t* { return Pz + (size_t)(rbase + r) * 512 + (cbase - 1024); });
    }
    lds_barrier();
  }
};

#ifndef XCD_ORDER
#define XCD_ORDER 1
#endif
template <class Epi>
DI void gemm_phase(const bf16_t* A, int lda, const bf16_t* Bt, int ldb, int K, int mt, int nt, const Epi& epi, char* smem, int tstart = 0, int ttotal = -1) {
  const int n = mt * nt;
  if (ttotal < 0) ttotal = n;
  const bool xo = XCD_ORDER && gridDim.x == 256 && (nt & 3) == 0 && (mt & 3) == 0 && n % 256 == 0;
  auto coords = [&](int u, int& r0, int& c0) {
    int pm = u / nt, pn = u - pm * nt;
    if (xo) {
      const int r = u >> 8, w = u & 255, x = w & 7, idx = w >> 3;
      const int rows_r = 256 / nt, pw = nt < 8 ? nt : 8, ph = 32 / pw, npx = nt / pw, px = x % npx, py = x / npx;
      pm = r * rows_r + py * ph + idx / pw; pn = px * pw + idx % pw;
    }
    r0 = pm * G_BM; c0 = pn * G_BN;
  };
  int t = blockIdx.x;
  while (t < tstart) t += gridDim.x;
  bool prefetched = false;
  while (t < tstart + n && t < ttotal) {
    const int tn = t + gridDim.x;
    const bool has_next = Epi::kPrefetchNext && tn < tstart + n && tn < ttotal;
    int r0, c0, nr0 = 0, nc0 = 0;
    coords(t - tstart, r0, c0);
    if (has_next) coords(tn - tstart, nr0, nc0);
    gemm_tile(A, lda, Bt, ldb, K, r0, c0, smem, epi, prefetched, has_next, nr0, nc0);
    prefetched = has_next;
    t = tn;
  }
}

DI void rows_phase(const float* src_ctx, const float* src_lat, bool do_ln, const float* lg, const float* lb, float* Xdst,
                   const float* modsL, int sh_off, int sc_off, bf16_t* Hb) {
  const int lane = threadIdx.x & 63, gw = blockIdx.x * NWAVE + (threadIdx.x >> 6), nw = gridDim.x * NWAVE;
  for (int row = gw; row < NTOK; row += nw) {
    const float* src = row < NCTX ? src_ctx + (size_t)row * 1024 : src_lat + (size_t)(row - NCTX) * 1024;
    f32x4 v[4];
#pragma unroll
    for (int i = 0; i < 4; ++i) v[i] = *(const f32x4*)(src + i * 256 + lane * 4);
    if (do_ln) {
      float s = 0.f;
#pragma unroll
      for (int i = 0; i < 4; ++i) s += (v[i][0] + v[i][1]) + (v[i][2] + v[i][3]);
      const float mean = wave_sum(s) * (1.f / 1024.f);
      float q = 0.f;
#pragma unroll
      for (int i = 0; i < 4; ++i)
#pragma unroll
        for (int e = 0; e < 4; ++e) { const float d = v[i][e] - mean; q += d * d; }
      const float rstd = rsqrtf(wave_sum(q) * (1.f / 1024.f) + EPS);
#pragma unroll
      for (int i = 0; i < 4; ++i) {
        const f32x4 g = *(const f32x4*)(lg + i * 256 + lane * 4), b = *(const f32x4*)(lb + i * 256 + lane * 4);
#pragma unroll
        for (int e = 0; e < 4; ++e) v[i][e] = (v[i][e] - mean) * rstd * g[e] + b[e];
        if (Xdst) *(f32x4*)(Xdst + (size_t)row * 1024 + i * 256 + lane * 4) = v[i];
      }
    }
    if (Hb) {
      const float* m = modsL + cond_idx(row) * 6144;
#pragma unroll
      for (int i = 0; i < 4; ++i) {
        const int col = i * 256 + lane * 4;
        const f32x4 sh = *(const f32x4*)(m + sh_off + col), sc = *(const f32x4*)(m + sc_off + col);
        f32x4 h;
#pragma unroll
        for (int e = 0; e < 4; ++e) h[e] = v[i][e] * (1.f + sc[e]) + sh[e];
        u32x2 w = {pack2(h[0], h[1]), pack2(h[2], h[3])};
        *(u32x2*)(Hb + (size_t)row * 1024 + col) = w;
      }
    }
  }
}

DI void modulate_phase(const float* __restrict__ src_ctx, const float* __restrict__ src_lat, const float* __restrict__ modsL, bf16_t* __restrict__ Hb) {
  const int lane = threadIdx.x & 63, gw = blockIdx.x * NWAVE + (threadIdx.x >> 6), nw = gridDim.x * NWAVE;
  for (int r0 = gw * 2; r0 < NTOK; r0 += nw * 2) {
    f32x4 v[2][4];
#pragma unroll
    for (int k = 0; k < 2; ++k) {
      const int row = r0 + k;
      const float* src = row < NCTX ? src_ctx + (size_t)row * 1024 : src_lat + (size_t)(row - NCTX) * 1024;
#pragma unroll
      for (int i = 0; i < 4; ++i) v[k][i] = __builtin_nontemporal_load((const f32x4*)(src + i * 256 + lane * 4));
    }
#pragma unroll
    for (int k = 0; k < 2; ++k) {
      const int row = r0 + k;
      const float* m = modsL + cond_idx(row) * 6144;
#pragma unroll
      for (int i = 0; i < 4; ++i) {
        const int col = i * 256 + lane * 4;
        const f32x4 sh = *(const f32x4*)(m + col), sc = *(const f32x4*)(m + 1024 + col);
        u32x2 w = {pack2(v[k][i][0] * (1.f + sc[0]) + sh[0], v[k][i][1] * (1.f + sc[1]) + sh[1]), pack2(v[k][i][2] * (1.f + sc[2]) + sh[2], v[k][i][3] * (1.f + sc[3]) + sh[3])};
        *(u32x2*)(Hb + (size_t)row * 1024 + col) = w;
      }
    }
  }
}

DI double sin_red(double r) {
  const double r2 = r * r; double t = -1.0 / 51090942171709440000.0;
  t = t * r2 + 1.0 / 121645100408832000.0; t = t * r2 - 1.0 / 355687428096000.0; t = t * r2 + 1.0 / 1307674368000.0; t = t * r2 - 1.0 / 6227020800.0;
  t = t * r2 + 1.0 / 39916800.0; t = t * r2 - 1.0 / 362880.0; t = t * r2 + 1.0 / 5040.0; t = t * r2 - 1.0 / 120.0; t = t * r2 + 1.0 / 6.0;
  return r * (1.0 - r2 * t);
}
DI double cos_red(double r) {
  const double r2 = r * r; double t = 1.0 / 1124000727777607680000.0;
  t = t * r2 - 1.0 / 2432902008176640000.0; t = t * r2 + 1.0 / 6402373705728000.0; t = t * r2 - 1.0 / 20922789888000.0; t = t * r2 + 1.0 / 87178291200.0;
  t = t * r2 - 1.0 / 479001600.0; t = t * r2 + 1.0 / 3628800.0; t = t * r2 - 1.0 / 40320.0; t = t * r2 + 1.0 / 720.0; t = t * r2 - 1.0 / 24.0; t = t * r2 + 0.5; t = t * r2 * -1.0 + 1.0;
  return t;
}

constexpr int J_MODS = 96, J_WEFF = 64, J_CACHE = 64, J_ROPE = 1, J_SLOW = J_MODS + J_WEFF + J_CACHE + J_ROPE;
constexpr int T_ATTIN = 16 * 16, T_UQ = 4 * 6, T_UKV = 2 * 8, T_ATTOUT = 16 * 8, T_MLPIN = 16 * 32, T_MLPOUT = 64 * 8, T_CONVIN = 16 * 12, T_CONVOUT = 8 * 8;
constexpr int J_TR = T_ATTIN + T_UQ + T_UKV + T_ATTOUT + 2 * T_MLPIN + 2 * T_MLPOUT + T_CONVIN + T_CONVOUT;

struct TJ { const float* src; bf16_t* dst; int N, nvalid, lddst, perm, kt, nt; };
DI TJ tr_decode(const Params& p, int j) {
  char* ws = p.ws;
  TJ t; t.perm = 0;
  if (j < T_ATTIN) { t.src = p.w_att_in; t.N = 1952; t.nvalid = 1952; t.dst = (bf16_t*)(ws + O_WATTIN); t.lddst = 1024; t.kt = j / 16; t.nt = j % 16; return t; }
  j -= T_ATTIN;
  if (j < T_UQ) { t.src = p.w_uq; t.N = 768; t.nvalid = 768; t.dst = (bf16_t*)(ws + O_WUQ); t.lddst = 256; t.kt = j / 6; t.nt = j % 6; return t; }
  j -= T_UQ;
  if (j < T_UKV) { t.src = p.w_ukv; t.N = 1024; t.nvalid = 1024; t.dst = (bf16_t*)(ws + O_WUKV); t.lddst = 128; t.kt = j / 8; t.nt = j % 8; return t; }
  j -= T_UKV;
  if (j < T_ATTOUT) { t.src = p.w_att_out; t.N = 1024; t.nvalid = 1024; t.dst = (bf16_t*)(ws + O_WATTOUT); t.lddst = 1024; t.kt = j / 8; t.nt = j % 8; return t; }
  j -= T_ATTOUT;
  if (j < 2 * T_MLPIN) { const int l = j / T_MLPIN, u = j % T_MLPIN; t.src = p.w_mlp_in + (size_t)l * 1024 * 4096; t.N = 4096; t.nvalid = 4096; t.dst = (bf16_t*)(ws + O_WMLPIN) + (size_t)l * 4096 * 1024; t.lddst = 1024; t.kt = u / 32; t.nt = u % 32; return t; }
  j -= 2 * T_MLPIN;
  if (j < 2 * T_MLPOUT) { const int l = j / T_MLPOUT, u = j % T_MLPOUT; t.src = p.w_mlp_out + (size_t)l * 4096 * 1024; t.N = 1024; t.nvalid = 1024; t.dst = (bf16_t*)(ws + O_WMLPOUT) + (size_t)l * 4096 * 1024; t.lddst = 4096; t.kt = u / 8; t.nt = u % 8; return t; }
  j -= 2 * T_MLPOUT;
  if (j < T_CONVIN) { t.src = p.w_conv_in; t.N = 1536; t.nvalid = 1536; t.dst = (bf16_t*)(ws + O_WCONVIN); t.lddst = 1024; t.perm = 1; t.kt = j / 12; t.nt = j % 12; return t; }
  j -= T_CONVIN;
  t.src = p.w_conv_out; t.N = 1024; t.nvalid = 1024; t.dst = (bf16_t*)(ws + O_WCONVOUT); t.lddst = 1024; t.kt = j / 8; t.nt = j % 8; return t;
}
DI void tr_load(const TJ& t, float (&v)[16]) {
  const int tid = threadIdx.x, n4 = (tid & 31) * 4, kb = tid >> 5;
  const int gn = t.nt * 128 + n4;
  const float* s = t.src + (size_t)(t.kt * 64 + kb) * t.N + gn;
#pragma unroll
  for (int i = 0; i < 4; ++i) {
    f32x4 x = {0.f, 0.f, 0.f, 0.f};
    if (gn < t.nvalid) x = *(const f32x4*)(s + (size_t)(16 * i) * t.N);
    v[4 * i] = x[0]; v[4 * i + 1] = x[1]; v[4 * i + 2] = x[2]; v[4 * i + 3] = x[3];
  }
}

DI void phase0(const Params& p, char* smem) {
  const int tid = threadIdx.x, lane = tid & 63, wid = tid >> 6;
  char* ws = p.ws;
  for (int job = blockIdx.x; job < J_SLOW; job += gridDim.x) {
    int j = job;
    if (j < J_MODS) {
      const int l = j / 48, cc = j % 48;
      float* sc = (float*)smem;
      for (int i = tid; i < 3072; i += NT) { const int ci = i >> 10, k = i & 1023; const float x = ci == 0 ? p.c_ctx[k] : p.c[(ci - 1) * 1024 + k]; sc[i] = x / (1.f + __expf(-x)); }
      __syncthreads();
      const int kg = tid >> 5, c4 = (tid & 31) * 4;
      const float* w = p.w_ada + (size_t)l * 1024 * 6144 + cc * 128 + c4;
      f32x4 s0 = {0.f, 0.f, 0.f, 0.f}, s1 = s0, s2 = s0;
#pragma unroll 16
      for (int k = kg * 64; k < kg * 64 + 64; ++k) {
        const f32x4 wv = __builtin_nontemporal_load((const f32x4*)(w + (size_t)k * 6144));
        const float a = sc[k], b = sc[1024 + k], c = sc[2048 + k];
#pragma unroll
        for (int e = 0; e < 4; ++e) { s0[e] += a * wv[e]; s1[e] += b * wv[e]; s2[e] += c * wv[e]; }
      }
      f32x4* r = (f32x4*)(smem + 12288);
      r[(kg * 3 + 0) * 32 + (tid & 31)] = s0; r[(kg * 3 + 1) * 32 + (tid & 31)] = s1; r[(kg * 3 + 2) * 32 + (tid & 31)] = s2;
      __syncthreads();
      if (tid < 96) {
        const int ci = tid >> 5, q = tid & 31;
        f32x4 s = {0.f, 0.f, 0.f, 0.f};
#pragma unroll
        for (int g = 0; g < 16; ++g) { const f32x4 t4 = r[(g * 3 + ci) * 32 + q]; s[0] += t4[0]; s[1] += t4[1]; s[2] += t4[2]; s[3] += t4[3]; }
        const f32x4 bb = *(const f32x4*)(p.b_ada + l * 6144 + cc * 128 + q * 4);
        float* md = (float*)(ws + O_MODS) + (size_t)(l * 3 + ci) * 6144 + cc * 128 + q * 4;
#pragma unroll
        for (int e = 0; e < 4; ++e) __hip_atomic_store(md + e, s[e] + bb[e], __ATOMIC_RELAXED, __HIP_MEMORY_SCOPE_AGENT);
      }
      asm volatile("s_waitcnt vmcnt(0)" ::: "memory");
      __syncthreads();
      if (tid == 0) __hip_atomic_fetch_add((unsigned*)(ws + O_CNT) + 2, 1u, __ATOMIC_RELAXED, __HIP_MEMORY_SCOPE_AGENT);
      continue;
    }
    j -= J_MODS;
    if (j < J_WEFF) {
      const int g = j >> 4, cch = (j >> 1) & 7, nch = j & 1;
      float* wp = (float*)smem;
      for (int i = tid; i < 2048; i += NT) wp[i] = p.w_pool[(size_t)(g * 128 + cch * 16 + (i >> 7)) * 128 + (i & 127)];
      __syncthreads();
      const int n = nch * 512 + tid;
      float a[16];
#pragma unroll
      for (int c = 0; c < 16; ++c) a[c] = 0.f;
#pragma unroll 16
      for (int e = 0; e < 128; ++e) {
        const float wo = p.w_conv_out[(size_t)(512 + g * 128 + e) * 1024 + n] * p.pool_scale[g * 128 + e];
#pragma unroll
        for (int c = 0; c < 16; ++c) a[c] += wp[c * 128 + e] * wo;
      }
      bf16_t* d = (bf16_t*)(ws + O_WCONVOUT) + (size_t)n * 1024 + 512 + g * 128 + cch * 16;
      *(u32x4*)d = (u32x4){pack2(a[0], a[1]), pack2(a[2], a[3]), pack2(a[4], a[5]), pack2(a[6], a[7])};
      *(u32x4*)(d + 8) = (u32x4){pack2(a[8], a[9]), pack2(a[10], a[11]), pack2(a[12], a[13]), pack2(a[14], a[15])};
      __syncthreads();
      continue;
    }
    j -= J_WEFF;
    if (j < J_CACHE) {
      const int rr = j * 8 + wid, b = rr >> 8, t = rr & 255;
      const size_t kr = NCTX + (size_t)b * TKL + t;
      const f32x4 a0 = *(const f32x4*)(p.cache_k + (size_t)rr * 512 + lane * 8), a1 = *(const f32x4*)(p.cache_k + (size_t)rr * 512 + lane * 8 + 4);
      *(u32x4*)((bf16_t*)(ws + O_KD) + kr * 512 + lane * 8) = (u32x4){pack2(a0[0], a0[1]), pack2(a0[2], a0[3]), pack2(a1[0], a1[1]), pack2(a1[2], a1[3])};
      const f32x4 b0 = *(const f32x4*)(p.cache_v + (size_t)rr * 512 + lane * 8), b1 = *(const f32x4*)(p.cache_v + (size_t)rr * 512 + lane * 8 + 4);
      *(u32x4*)((bf16_t*)(ws + O_VD) + kr * 512 + lane * 8) = (u32x4){pack2(b0[0], b0[1]), pack2(b0[2], b0[3]), pack2(b1[0], b1[1]), pack2(b1[2], b1[3])};
      const f32x2 cv = *(const f32x2*)(p.cache_ckv + (size_t)rr * 128 + lane * 2);
      *(unsigned*)((bf16_t*)(ws + O_CKVN) + kr * 128 + lane * 2) = pack2(cv[0], cv[1]);
      const int idx = lane & 31;
      const float x = p.cache_krope[(size_t)rr * 32 + idx];
      const unsigned pk = pack2(x, x);
#pragma unroll
      for (int k = 0; k < 4; ++k) { const int hh = (lane >> 5) + 2 * k; ((bf16_t*)(ws + O_KMLA))[kr * 768 + hh * 96 + 64 + idx] = (bf16_t)(pk & 0xffff); }
      continue;
    }
    j -= J_CACHE;
    {
      float* c16 = (float*)(ws + O_C16); float* s16 = (float*)(ws + O_S16); float* c8 = (float*)(ws + O_C8); float* s8 = (float*)(ws + O_S8);
      for (int i = tid; i < 1024 + 512; i += NT) {
        int pos, f, half;
        if (i < 1024) { pos = i >> 4; f = i & 15; half = 16; } else { const int q = i - 1024; pos = q >> 3; f = q & 7; half = 8; }
        const float inv = (float)exp(-9.210340371976184 * (double)f / (double)half);
        const float angf = (float)pos * inv;
        const double ang = (double)angf;
        const double r = ang - 6.283185307179586 * rint(ang * 0.15915494309189535);
        const float cs = (float)cos_red(r), sn = (float)sin_red(r);
        if (i < 1024) { c16[i] = cs; s16[i] = sn; } else { c8[i - 1024] = cs; s8[i - 1024] = sn; }
      }
      if (wid == 0) {
        const float d1 = wave_sum(p.lam_q1[lane] * p.lam_k1[lane]), d2 = wave_sum(p.lam_q2[lane] * p.lam_k2[lane]);
        if (lane == 0) ((float*)(ws + O_SCAL))[0] = expf(d1) - expf(d2) + 0.2f;
      }
    }
  }
  {
    float* tile = (float*)smem;
    const int G = gridDim.x;
    int j = (blockIdx.x + G - (J_SLOW % G)) % G;
    float va[16], vb[16];
    TJ ta, tb;
    if (j < J_TR) { ta = tr_decode(p, j); tr_load(ta, va); } else ta = TJ{};
    if (j + G < J_TR) { tb = tr_decode(p, j + G); tr_load(tb, vb); } else tb = ta;
#define TR_STEP(V, T, jj_) do { \
      { const int n4 = (tid & 31) * 4, kb = tid >> 5; \
        _Pragma("unroll") for (int i = 0; i < 4; ++i) \
          _Pragma("unroll") for (int e = 0; e < 4; ++e) tile[(kb + 16 * i) * 129 + n4 + e] = V[4 * i + e]; } \
      __syncthreads(); \
      const TJ cur = T; \
      if ((jj_) + 2 * G < J_TR) { T = tr_decode(p, (jj_) + 2 * G); tr_load(T, V); }     \
      _Pragma("unroll") for (int ps = 0; ps < 2; ++ps) {     \
        const int n = ps * 64 + (tid >> 3), ks = (tid & 7) * 8; \
        int gn = cur.nt * 128 + n; \
        if (cur.perm) { if (gn < 512) gn = 32 * (gn >> 4) + (gn & 15); else if (gn < 1024) { const int c = gn - 512; gn = 32 * (c >> 4) + 16 + (c & 15); } } \
        unsigned w[4]; \
        _Pragma("unroll") for (int e = 0; e < 4; ++e) w[e] = pack2(tile[(ks + 2 * e) * 129 + n], tile[(ks + 2 * e + 1) * 129 + n]); \
        *(u32x4*)(cur.dst + (size_t)gn * cur.lddst + cur.kt * 64 + ks) = (u32x4){w[0], w[1], w[2], w[3]}; } \
      __syncthreads(); } while (0)
    while (j < J_TR) {
      TR_STEP(va, ta, j);
      j += G;
      if (j >= J_TR) break;
      TR_STEP(vb, tb, j);
      j += G;
    }
#undef TR_STEP
  }
  if (tid == 0) {
    unsigned sp = 0;
    while (__hip_atomic_load((unsigned*)(ws + O_CNT) + 2, __ATOMIC_RELAXED, __HIP_MEMORY_SCOPE_AGENT) < (unsigned)J_MODS) { __builtin_amdgcn_s_sleep(2); if (++sp > (1u << 22)) break; }
  }
  __syncthreads();
  modulate_phase(p.x_prompt, p.x_sample, (const float*)(ws + O_MODS), (bf16_t*)(ws + O_HB));
}

DI void rope8(const float (&x)[8], float (&o)[8], int lane, const float* c16, const float* s16, int prow, int pcol) {
  const int L = lane & 7;
  const int pos = (L & 4) ? pcol : prow;
  const bool second = (L & 2) != 0;
  const int fb = (L & 1) * 8;
#pragma unroll
  for (int e = 0; e < 8; ++e) {
    const float y = __shfl_xor(x[e], 2);
    const float cs = c16[pos * 16 + fb + e], sn = s16[pos * 16 + fb + e];
    o[e] = second ? (y * sn + x[e] * cs) : (x[e] * cs - y * sn);
  }
}
DI void unpack8(const u32x4 w, float (&x)[8]) {
#pragma unroll
  for (int e = 0; e < 4; ++e) { x[2 * e] = bflo(w[e]); x[2 * e + 1] = bfhi(w[e]); }
}
DI u32x4 pack8(const float (&x)[8]) { return (u32x4){pack2(x[0], x[1]), pack2(x[2], x[3]), pack2(x[4], x[5]), pack2(x[6], x[7])}; }

DI void phase3(const Params& p) {
  char* ws = p.ws;
  const bf16_t* R = (const bf16_t*)(ws + O_R);
  bf16_t* Qda = (bf16_t*)(ws + O_QDA); bf16_t* Qdb = (bf16_t*)(ws + O_QDB); bf16_t* Kd = (bf16_t*)(ws + O_KD); bf16_t* Vd = (bf16_t*)(ws + O_VD);
  bf16_t* cqn = (bf16_t*)(ws + O_CQN); bf16_t* ckvn = (bf16_t*)(ws + O_CKVN); bf16_t* Km = (bf16_t*)(ws + O_KMLA);
  const float* c16 = (const float*)(ws + O_C16); const float* s16 = (const float*)(ws + O_S16); const float* c8 = (const float*)(ws + O_C8); const float* s8 = (const float*)(ws + O_S8);
  float* o_k = p.out + (size_t)NTOK * 1024; float* o_v = o_k + (size_t)NCTX * 512; float* o_ckv = o_v + (size_t)NCTX * 512; float* o_kr = o_ckv + (size_t)NCTX * 128;
  const int lane = threadIdx.x & 63, gw = blockIdx.x * NWAVE + (threadIdx.x >> 6), nw = gridDim.x * NWAVE;
  for (int row = gw; row < NTOK; row += nw) {
    const bool lat = row >= NCTX;
    const int rl = row - NCTX, b = rl >> 12, t = rl & (TLAT - 1), prow = t >> 6, pcol = t & 63;
    const size_t kr = lat ? (size_t)NCTX + (size_t)b * TKL + 256 + t : (size_t)row;
    const bf16_t* r = R + (size_t)row * RLD;
    float x[8], o[8];
    const u32x4 wq = *(const u32x4*)(r + lane * 8);
    *(u32x4*)(Qda + (size_t)row * 512 + lane * 8) = wq;
    if (lat) { unpack8(wq, x); rope8(x, o, lane, c16, s16, prow, pcol); *(u32x4*)(Qdb + (size_t)rl * 512 + lane * 8) = pack8(o); }
    const u32x4 wk = *(const u32x4*)(r + 512 + lane * 8);
    if (lat) { unpack8(wk, x); rope8(x, o, lane, c16, s16, prow, pcol); *(u32x4*)(Kd + kr * 512 + lane * 8) = pack8(o); }
    else {
      unpack8(wk, x);
      *(f32x4*)(o_k + (size_t)row * 512 + lane * 8) = (f32x4){x[0], x[1], x[2], x[3]};
      *(f32x4*)(o_k + (size_t)row * 512 + lane * 8 + 4) = (f32x4){x[4], x[5], x[6], x[7]};
      *(u32x4*)(Kd + kr * 512 + lane * 8) = wk;
    }
    const u32x4 wv = *(const u32x4*)(r + 1024 + lane * 8);
    *(u32x4*)(Vd + kr * 512 + lane * 8) = wv;
    if (!lat) {
      unpack8(wv, x);
      *(f32x4*)(o_v + (size_t)row * 512 + lane * 8) = (f32x4){x[0], x[1], x[2], x[3]};
      *(f32x4*)(o_v + (size_t)row * 512 + lane * 8 + 4) = (f32x4){x[4], x[5], x[6], x[7]};
    }
    {
      const u32x2 w = *(const u32x2*)(r + 1536 + lane * 4);
      const float a0 = bflo(w[0]), a1 = bfhi(w[0]), a2 = bflo(w[1]), a3 = bfhi(w[1]);
      const float ss = wave_sum(a0 * a0 + a1 * a1 + a2 * a2 + a3 * a3);
      const float sc = rsqrtf(ss * (1.f / 256.f) + EPS);
      const f32x4 g = *(const f32x4*)(p.q_norm_g + lane * 4);
      *(u32x2*)(cqn + (size_t)row * 256 + lane * 4) = (u32x2){pack2(a0 * sc * g[0], a1 * sc * g[1]), pack2(a2 * sc * g[2], a3 * sc * g[3])};
    }
    {
      const unsigned w = *(const unsigned*)(r + 1792 + lane * 2);
      const float a0 = bflo(w), a1 = bfhi(w);
      const float ss = wave_sum(a0 * a0 + a1 * a1);
      const float sc = rsqrtf(ss * (1.f / 128.f) + EPS);
      const f32x2 g = *(const f32x2*)(p.kv_norm_g + lane * 2);
      const float y0 = a0 * sc * g[0], y1 = a1 * sc * g[1];
      if (!lat) *(f32x2*)(o_ckv + (size_t)row * 128 + lane * 2) = (f32x2){y0, y1};
      *(unsigned*)(ckvn + kr * 128 + lane * 2) = pack2(y0, y1);
    }
    {
      const int idx = lane & 31;
      const float xv = bf2f(r[1920 + idx]);
      float ov = xv;
      if (lat) {
        const int pos = (idx & 16) ? pcol : prow;
        const int f = idx & 7;
        const float y = __shfl_xor(xv, 8);
        const float cs = c8[pos * 8 + f], sn = s8[pos * 8 + f];
        ov = (idx & 8) ? (y * sn + xv * cs) : (xv * cs - y * sn);
      } else if (lane < 32) o_kr[(size_t)row * 32 + idx] = xv;
      const bf16_t ob = (bf16_t)(pack2(ov, ov) & 0xffff);
#pragma unroll
      for (int k = 0; k < 4; ++k) { const int hh = (lane >> 5) + 2 * k; Km[kr * 768 + hh * 96 + 64 + idx] = ob; }
    }
  }
}

template <int DQK, int DV>
DI void attn_core(const bf16_t* __restrict__ Qa, const bf16_t* __restrict__ Qb, int ldq, const bf16_t* __restrict__ Kp, int ldk, const bf16_t* __restrict__ Vp, int ldv,
                  int Tk, int n_a, float c  , char* smem, f32x16 (&o)[DV / 32]) {
  constexpr int KS = DQK * 2 + 16, VS = DV * 2 + 64, BUF = 64 * (KS + VS);
  constexpr int KCH = DQK / 8, VCH = DV / 8, NKCH = 64 * KCH, NVCH = 64 * VCH, NKC = (NKCH + NT - 1) / NT, NVC = (NVCH + NT - 1) / NT;
  constexpr bool KG = (NKCH % NT) != 0, VG = (NVCH % NT) != 0;
  constexpr int NS = DQK / 16, NDT = DV / 32;
  const int tid = threadIdx.x, lane = tid & 63, wid = tid >> 6, h = lane >> 5, ql = lane & 31;
  bf16x8 qf[NS];
  {
    const bf16_t* q = Qa + (size_t)(wid * 32 + ql) * ldq + h * 8;
#pragma unroll
    for (int s = 0; s < NS; ++s) qf[s] = *(const bf16x8*)(q + s * 16);
  }
#pragma unroll
  for (int dt = 0; dt < NDT; ++dt)
#pragma unroll
    for (int r = 0; r < 16; ++r) o[dt][r] = 0.f;
  float m_run = -INFINITY, l_run = 0.f;
  u32x4 rkA[NKC], rvA[NVC], rkB[NKC], rvB[NVC];
  const int nt = Tk >> 6, ta = n_a >> 6;
  unsigned koff[NKC], voff[NVC];
#pragma unroll
  for (int i = 0; i < NKC; ++i) { const int ch = (tid + NT * i) % NKCH, row = ch / KCH, kc = ch % KCH; koff[i] = (unsigned)(row * ldk + kc * 8); }
#pragma unroll
  for (int i = 0; i < NVC; ++i) { const int ch = (tid + NT * i) % NVCH, row = ch / VCH, vc = ch % VCH; voff[i] = (unsigned)(row * ldv + vc * 8); }
  auto gload = [&](u32x4 (&rk)[NKC], u32x4 (&rv)[NVC], int t) {
    const bf16_t* kb = Kp + (size_t)t * 64 * ldk;
    const bf16_t* vbp = Vp + (size_t)t * 64 * ldv;
#pragma unroll
    for (int i = 0; i < NKC; ++i) rk[i] = *(const u32x4*)(kb + koff[i]);
#pragma unroll
    for (int i = 0; i < NVC; ++i) rv[i] = *(const u32x4*)(vbp + voff[i]);
  };
  auto lstore = [&](u32x4 (&rk)[NKC], u32x4 (&rv)[NVC], char* buf) {
#pragma unroll
    for (int i = 0; i < NKC; ++i) { const int ch = tid + NT * i, row = ch / KCH, kc = ch % KCH; if (!KG || i + 1 < NKC || ch < NKCH) *(u32x4*)(buf + row * KS + kc * 16) = rk[i]; }
#pragma unroll
    for (int i = 0; i < NVC; ++i) { const int ch = tid + NT * i, row = ch / VCH, vc = ch % VCH; if (!VG || i + 1 < NVC || ch < NVCH) *(u32x4*)(buf + 64 * KS + row * VS + vc * 16) = rv[i]; }
  };
  gload(rkA, rvA, 0); lstore(rkA, rvA, smem); lds_barrier();
  gload(rkA, rvA, min(1, nt - 1));
  const int i16 = lane & 15, tq = i16 >> 2, tp = i16 & 3, G = (lane >> 4) & 1;
  auto compute = [&](const char* cur) {
    f32x16 st[2];
    bf16x8 kf[2][NS];
#pragma unroll
    for (int kt = 0; kt < 2; ++kt)
#pragma unroll
      for (int s = 0; s < NS; ++s) kf[kt][s] = *(const bf16x8*)(cur + (kt * 32 + ql) * KS + s * 32 + h * 16);
#pragma unroll
    for (int kt = 0; kt < 2; ++kt) {
#pragma unroll
      for (int r = 0; r < 16; ++r) st[kt][r] = 0.f;
#pragma unroll
      for (int s = 0; s < NS; ++s) st[kt] = __builtin_amdgcn_mfma_f32_32x32x16_bf16(kf[kt][s], qf[s], st[kt], 0, 0, 0);
    }
    __builtin_amdgcn_sched_barrier(0);
    float mx = st[0][0];
#pragma unroll
    for (int kt = 0; kt < 2; ++kt)
#pragma unroll
      for (int r = 0; r < 16; ++r) mx = fmaxf(mx, st[kt][r]);
    mx = fmaxf(mx, __shfl_xor(mx, 32));
    const float m_new = fmaxf(m_run, mx);
    const float alpha = __builtin_amdgcn_exp2f((m_run - m_new) * c);
    const float mc = m_new * c;
    m_run = m_new;
    f32x2 ls2 = {0.f, 0.f};
#pragma unroll
    for (int kt = 0; kt < 2; ++kt) {
      const f32x16 tv = st[kt] * c - mc;
#pragma unroll
      for (int r = 0; r < 16; r += 2) {
        const f32x2 pv = {__builtin_amdgcn_exp2f(tv[r]), __builtin_amdgcn_exp2f(tv[r + 1])};
        st[kt][r] = pv[0]; st[kt][r + 1] = pv[1];
        ls2 += pv;
      }
    }
    l_run = l_run * alpha + (ls2[0] + ls2[1]);
    if (__any(alpha != 1.f)) {
#pragma unroll
      for (int dt = 0; dt < NDT; ++dt)
#pragma unroll
        for (int r = 0; r < 16; ++r) o[dt][r] *= alpha;
    }
    bf16x8 pf[2][2];
#pragma unroll
    for (int kt = 0; kt < 2; ++kt)
#pragma unroll
      for (int s2 = 0; s2 < 2; ++s2) {
        u32x4 w = {pack2(st[kt][8 * s2 + 0], st[kt][8 * s2 + 1]), pack2(st[kt][8 * s2 + 2], st[kt][8 * s2 + 3]), pack2(st[kt][8 * s2 + 4], st[kt][8 * s2 + 5]), pack2(st[kt][8 * s2 + 6], st[kt][8 * s2 + 7])};
        pf[kt][s2] = __builtin_bit_cast(bf16x8, w);
      }
    const char* vb = cur + 64 * KS + (4 * h + tq) * VS + 32 * G + 8 * tp;
    bf16x8 vfa[NDT], vfb[NDT];
#define A_VLOAD(VF, g_) do { \
      _Pragma("unroll") for (int dt = 0; dt < NDT; ++dt) { \
        const char* a0 = vb + (((g_) >> 1) * 32 + 16 * ((g_) & 1)) * VS + dt * 64; \
        const s16x4 lo = __builtin_amdgcn_ds_read_tr16_b64_v4i16((LDS_AS s16x4*)(a0)); \
        const s16x4 hi = __builtin_amdgcn_ds_read_tr16_b64_v4i16((LDS_AS s16x4*)(a0 + 8 * VS)); \
        VF[dt] = __builtin_shufflevector(lo, hi, 0, 1, 2, 3, 4, 5, 6, 7); } } while (0)
#define A_VMMA(VF, g_) do { \
      _Pragma("unroll") for (int dt = 0; dt < NDT; ++dt) o[dt] = __builtin_amdgcn_mfma_f32_32x32x16_bf16(VF[dt], pf[(g_) >> 1][(g_) & 1], o[dt], 0, 0, 0); } while (0)
    A_VLOAD(vfa, 0);
    A_VLOAD(vfb, 1);
    __builtin_amdgcn_sched_barrier(0);
    A_VMMA(vfa, 0);
    __builtin_amdgcn_sched_barrier(0);
    A_VLOAD(vfa, 2);
    __builtin_amdgcn_sched_barrier(0);
    A_VMMA(vfb, 1);
    __builtin_amdgcn_sched_barrier(0);
    A_VLOAD(vfb, 3);
    __builtin_amdgcn_sched_barrier(0);
    A_VMMA(vfa, 2);
    __builtin_amdgcn_sched_barrier(0);
    A_VMMA(vfb, 3);
#undef A_VLOAD
#undef A_VMMA
  };
  auto run_tiles = [&](int t_begin, int t_end) {
    for (int t = t_begin; t < t_end; t += 2) {
      gload(rkB, rvB, min(t + 2, nt - 1));
      compute(smem);
      lstore(rkA, rvA, smem + BUF);
      lds_barrier();
      gload(rkA, rvA, min(t + 3, nt - 1));
      compute(smem + BUF);
      lstore(rkB, rvB, smem);
      lds_barrier();
    }
  };
  if (wid >= 4) __builtin_amdgcn_s_setprio(1);
  run_tiles(0, min(ta, nt));
  if (ta < nt) {
    const bf16_t* q = Qb + (size_t)(wid * 32 + ql) * ldq + h * 8;
#pragma unroll
    for (int s = 0; s < NS; ++s) qf[s] = *(const bf16x8*)(q + s * 16);
    run_tiles(ta, nt);
  }
  __builtin_amdgcn_s_setprio(0);
  const float l = l_run + __shfl_xor(l_run, 32);
  const float inv = 1.f / l;
#pragma unroll
  for (int dt = 0; dt < NDT; ++dt)
#pragma unroll
    for (int r = 0; r < 16; ++r) o[dt][r] *= inv;
}

constexpr int U_DBIG = 128, U_MBIG = 256, U_DCTX = 64, U_MCTX = 128, U_TOTAL = U_DBIG + U_MBIG + U_DCTX + U_MCTX;

DI void phase_attn(const Params& p, char* smem, int cidx) {
  char* ws = p.ws;
  const bf16_t* Qda = (const bf16_t*)(ws + O_QDA); const bf16_t* Qdb = (const bf16_t*)(ws + O_QDB); const bf16_t* Kd = (const bf16_t*)(ws + O_KD); const bf16_t* Vd = (const bf16_t*)(ws + O_VD);
  const bf16_t* Qma = (const bf16_t*)(ws + O_QMA); const bf16_t* Qmb = (const bf16_t*)(ws + O_QMB); const bf16_t* Km = (const bf16_t*)(ws + O_KMLA); const bf16_t* Vm = (const bf16_t*)(ws + O_VMLA);
  bf16_t* cat = (bf16_t*)(ws + O_HB);
  float* otmp = (float*)(ws + O_OTMP) + (size_t)blockIdx.x * 32768;
  int* counter = (int*)(ws + O_CNT) + cidx;
  int* s_unit = (int*)(smem + 65532);
  const int tid = threadIdx.x, lane = tid & 63, wid = tid >> 6, h2 = lane >> 5, ql = lane & 31;
  const float lam = ((const float*)(ws + O_SCAL))[0];
  for (;;) {
    if (tid == 0) *s_unit = atomicAdd(counter, 1);
    __syncthreads();
    int u = __builtin_amdgcn_readfirstlane(*s_unit);
    __syncthreads();
    if (u >= U_TOTAL) break;
    bool diff; int qrow0, krow0, Tk, n_a, head; bool lat;
    if (u < U_DBIG) { diff = true; lat = true; const int b = u >> 6, hh = (u >> 4) & 3, qb = u & 15; head = hh; qrow0 = NCTX + b * TLAT + qb * 256; krow0 = NCTX + b * TKL; Tk = TKL; n_a = 256; }
    else if (u < U_DBIG + U_MBIG) { u -= U_DBIG; diff = false; lat = true; const int b = u >> 7, hh = (u >> 4) & 7, qb = u & 15; head = hh; qrow0 = NCTX + b * TLAT + qb * 256; krow0 = NCTX + b * TKL; Tk = TKL; n_a = 256; }
    else if (u < U_DBIG + U_MBIG + U_DCTX) { u -= U_DBIG + U_MBIG; diff = true; lat = false; const int sq = u >> 2, hh = u & 3; head = hh; qrow0 = sq * 256; krow0 = sq * 256; Tk = 256; n_a = 256; }
    else { u -= U_DBIG + U_MBIG + U_DCTX; diff = false; lat = false; const int sq = u >> 3, hh = u & 7; head = hh; qrow0 = sq * 256; krow0 = sq * 256; Tk = 256; n_a = 256; }
    const int qrowb = lat ? qrow0 - NCTX : 0;
    if (diff) {
      f32x16 o[4];
      const float c = 0.125f * 1.4426950408889634f;
#pragma unroll 1
      for (int m = 0; m < 2; ++m) {
        attn_core<64, 128>(Qda + (size_t)qrow0 * 512 + head * 128 + m * 64, Qdb + (size_t)qrowb * 512 + head * 128 + m * 64, 512,
                           Kd + (size_t)krow0 * 512 + head * 128 + m * 64, 512, Vd + (size_t)krow0 * 512 + head * 128, 512, Tk, n_a, c, smem, o);
        if (m == 0) {
#pragma unroll
          for (int dt = 0; dt < 4; ++dt)
#pragma unroll
            for (int rq = 0; rq < 4; ++rq) *(f32x4*)(otmp + tid * 64 + dt * 16 + rq * 4) = (f32x4){o[dt][4 * rq], o[dt][4 * rq + 1], o[dt][4 * rq + 2], o[dt][4 * rq + 3]};
        }
      }
      float ss = 0.f;
#pragma unroll
      for (int dt = 0; dt < 4; ++dt)
#pragma unroll
        for (int rq = 0; rq < 4; ++rq) {
          const f32x4 o0 = *(const f32x4*)(otmp + tid * 64 + dt * 16 + rq * 4);
#pragma unroll
          for (int e = 0; e < 4; ++e) { const float v = o0[e] - lam * o[dt][4 * rq + e]; o[dt][4 * rq + e] = v; ss += v * v; }
        }
      ss += __shfl_xor(ss, 32);
      const float sc = rsqrtf(ss * (1.f / 128.f) + EPS) * 0.8f;
      bf16_t* dst = cat + (size_t)(qrow0 + wid * 32 + ql) * 1024 + head * 128;
#pragma unroll
      for (int dt = 0; dt < 4; ++dt)
#pragma unroll
        for (int rq = 0; rq < 4; ++rq) {
          const int dv = dt * 32 + 8 * rq + 4 * h2;
          const f32x4 g = *(const f32x4*)(p.diff_norm_g + dv);
          u32x2 w = {pack2(o[dt][4 * rq] * sc * g[0], o[dt][4 * rq + 1] * sc * g[1]), pack2(o[dt][4 * rq + 2] * sc * g[2], o[dt][4 * rq + 3] * sc * g[3])};
          *(u32x2*)(dst + dv) = w;
        }
    } else {
      f32x16 o[2];
      const float c = 0.10206207261596575f * 1.4426950408889634f;
      attn_core<96, 64>(Qma + (size_t)qrow0 * 768 + head * 96, Qmb + (size_t)qrowb * 768 + head * 96, 768,
                        Km + (size_t)krow0 * 768 + head * 96, 768, Vm + (size_t)krow0 * 512 + head * 64, 512, Tk, n_a, c, smem, o);
      bf16_t* dst = cat + (size_t)(qrow0 + wid * 32 + ql) * 1024 + 512 + head * 64;
#pragma unroll
      for (int dt = 0; dt < 2; ++dt)
#pragma unroll
        for (int rq = 0; rq < 4; ++rq) {
          const int dv = dt * 32 + 8 * rq + 4 * h2;
          u32x2 w = {pack2(o[dt][4 * rq], o[dt][4 * rq + 1]), pack2(o[dt][4 * rq + 2], o[dt][4 * rq + 3])};
          *(u32x2*)(dst + dv) = w;
        }
    }
  }
}

DI void unpack8f(const u32x4 w, float (&x)[8]) {
#pragma unroll
  for (int e = 0; e < 4; ++e) { x[2 * e] = bflo(w[e]); x[2 * e + 1] = bfhi(w[e]); }
}
DI void phase_conv(const Params& p, char* smem) {
  constexpr int TT = 8;
  char* ws = p.ws;
  const bf16_t* Ug = (const bf16_t*)(ws + O_UG); const bf16_t* Pz = (const bf16_t*)(ws + O_PZ);
  bf16_t* cat = (bf16_t*)(ws + O_HB);
  const int tid = threadIdx.x, lane = tid & 63, wid = tid >> 6;
  float* wl = (float*)smem;
  {
    f32x4 wv[8];
#pragma unroll
    for (int k = 0; k < 8; ++k) { const int i4 = tid + NT * k; wv[k] = (f32x4){0.f, 0.f, 0.f, 0.f}; if (i4 < 31 * 128) wv[k] = *(const f32x4*)(p.conv_w + i4 * 4); }
#pragma unroll
    for (int k = 0; k < 8; ++k) {
      const int i4 = tid + NT * k, j = i4 >> 7, c = (i4 & 127) * 4, lc = c >> 3, hf = (c >> 2) & 1;
      if (i4 < 31 * 128) *(f32x4*)(wl + ((j * 2 + hf) * 64 + lc) * 4) = wv[k];
    }
  }
  __syncthreads();
  const int c0 = lane * 8;
  const int grp = lane >> 4, HW = 1 << grp;
  for (int u = blockIdx.x * NWAVE + wid; u < NTOK / TT; u += gridDim.x * NWAVE) {
    const int t0 = u * TT;
    const int s0 = t0 < NCTX ? (t0 & ~255) : NCTX + ((t0 - NCTX) & ~(TLAT - 1));
    const int s1 = t0 < NCTX ? s0 + 256 : s0 + TLAT;
    {
      u32x4 pr[TT + 16];
#pragma unroll
      for (int i = 0; i < TT + 16; ++i) {
        const int r = t0 - 8 + i;
        pr[i] = (u32x4){0u, 0u, 0u, 0u};
        if (r >= s0 && r < s1) pr[i] = *(const u32x4*)(Pz + (size_t)r * 512 + c0);
      }
#pragma unroll
      for (int o = 0; o < TT; ++o) {
        const int r = t0 + o, ci = o + 8;
        float s[8], x[8], ctr[8], s2[8], s4[8], s8[8];
        unpack8f(pr[ci], ctr);
        unpack8f(pr[ci - 1], x);
#pragma unroll
        for (int e = 0; e < 8; ++e) { s[e] = x[e] + ctr[e]; s2[e] = s[e]; }
#pragma unroll
        for (int d = 0; d < 2; ++d) { unpack8f(pr[d == 0 ? ci - 2 : ci + 1], x);
#pragma unroll
          for (int e = 0; e < 8; ++e) s[e] += x[e]; }
#pragma unroll
        for (int e = 0; e < 8; ++e) s4[e] = s[e];
#pragma unroll
        for (int d = 0; d < 4; ++d) { unpack8f(pr[d < 2 ? ci - 4 + d : ci + d], x);
#pragma unroll
          for (int e = 0; e < 8; ++e) s[e] += x[e]; }
#pragma unroll
        for (int e = 0; e < 8; ++e) s8[e] = s[e];
#pragma unroll
        for (int d = 0; d < 8; ++d) { unpack8f(pr[d < 4 ? ci - 8 + d : ci + d], x);
#pragma unroll
          for (int e = 0; e < 8; ++e) s[e] += x[e]; }
        const int lo = max(r - HW, s0), hi = min(r + HW - 1, s1 - 1);
        const float ic = 1.f / (float)(hi - lo + 1);
        float dv[8];
#pragma unroll
        for (int e = 0; e < 8; ++e) { const float sm = grp == 0 ? s2[e] : grp == 1 ? s4[e] : grp == 2 ? s8[e] : s[e]; dv[e] = sm * ic - ctr[e]; }
        *(u32x4*)(cat + (size_t)r * 1024 + 512 + c0) = (u32x4){pack2(dv[0], dv[1]), pack2(dv[2], dv[3]), pack2(dv[4], dv[5]), pack2(dv[6], dv[7])};
      }
    }
    f32x2 acc2[TT][4];
#pragma unroll
    for (int o = 0; o < TT; ++o)
#pragma unroll
      for (int e = 0; e < 4; ++e) acc2[o][e] = (f32x2){0.f, 0.f};
    u32x4 q0, q1, q2, q3;
#define CV_ROW(i_) ({ const int r_ = t0 - 15 + (i_); u32x4 v_ = {0u, 0u, 0u, 0u}; if ((i_) < TT + 30 && r_ >= s0 && r_ < s1) v_ = *(const u32x4*)(Ug + (size_t)r_ * 512 + c0); v_; })
    q0 = CV_ROW(0); q1 = CV_ROW(1); q2 = CV_ROW(2); q3 = CV_ROW(3);
#pragma unroll 1
    for (int i = 0; i < TT + 30; ++i) {
      const u32x4 w = q0;
      q0 = q1; q1 = q2; q2 = q3; q3 = CV_ROW(i + 4);
      f32x2 x2[4];
#pragma unroll
      for (int e = 0; e < 4; ++e) x2[e] = (f32x2){bflo(w[e]), bfhi(w[e])};
#pragma unroll
      for (int o = 0; o < TT; ++o) {
        const int j = i - o;
        if ((unsigned)j <= 30u) {
          const f32x4 w0 = *(const f32x4*)(wl + ((j * 2 + 0) * 64 + lane) * 4), w1 = *(const f32x4*)(wl + ((j * 2 + 1) * 64 + lane) * 4);
          acc2[o][0] += x2[0] * (f32x2){w0[0], w0[1]}; acc2[o][1] += x2[1] * (f32x2){w0[2], w0[3]};
          acc2[o][2] += x2[2] * (f32x2){w1[0], w1[1]}; acc2[o][3] += x2[3] * (f32x2){w1[2], w1[3]};
        }
      }
    }
#undef CV_ROW
    const f32x4 bias0 = *(const f32x4*)(p.conv_b + c0), bias1 = *(const f32x4*)(p.conv_b + c0 + 4);
    const f32x4 g0 = *(const f32x4*)(p.conv_norm_g + c0), g1 = *(const f32x4*)(p.conv_norm_g + c0 + 4);
    const f32x4 b0 = *(const f32x4*)(p.conv_norm_b + c0), b1 = *(const f32x4*)(p.conv_norm_b + c0 + 4);
#pragma unroll
    for (int o = 0; o < TT; ++o) {
      float v[8];
#pragma unroll
      for (int e = 0; e < 4; ++e) { v[e] = acc2[o][e >> 1][e & 1] + bias0[e]; v[4 + e] = acc2[o][2 + (e >> 1)][e & 1] + bias1[e]; }
      float sm = 0.f;
#pragma unroll
      for (int e = 0; e < 8; ++e) sm += v[e];
      const float mean = wave_sum(sm) * (1.f / 512.f);
      float q = 0.f;
#pragma unroll
      for (int e = 0; e < 8; ++e) { const float d = v[e] - mean; q += d * d; }
      const float rstd = rsqrtf(wave_sum(q) * (1.f / 512.f) + EPS);
      float y[8];
#pragma unroll
      for (int e = 0; e < 4; ++e) {
        const float z0 = (v[e] - mean) * rstd * g0[e] + b0[e], z1 = (v[4 + e] - mean) * rstd * g1[e] + b1[e];
        y[e] = z0 / (1.f + __expf(-z0)); y[4 + e] = z1 / (1.f + __expf(-z1));
      }
      *(u32x4*)(cat + (size_t)(t0 + o) * 1024 + c0) = (u32x4){pack2(y[0], y[1]), pack2(y[2], y[3]), pack2(y[4], y[5]), pack2(y[6], y[7])};
    }
  }
  __syncthreads();
}

__global__ void __launch_bounds__(NT, 2) fwd_kernel(Params p, int ph_lo, int ph_hi) {
  __shared__ __attribute__((aligned(16))) char smem[2 * G_STAGE + 12288];
  __shared__ uint4 xb_words;
  cg::grid_group grid = cg::this_grid();
  char* ws = p.ws;
  if (threadIdx.x == 0) xb_words = make_uint4(0u, 0u, 0u, 0u);
  __syncthreads();
  const XcdBarrier xb = xcd_barrier_post((unsigned*)(ws + O_BAR), (volatile LDS_AS unsigned*)&xb_words);
  if (ph_lo > 1000) grid.sync();
  float* mods = (float*)(ws + O_MODS);
  bf16_t* Hb = (bf16_t*)(ws + O_HB);
  float* X = p.out;
  float* xbuf = (float*)(ws + O_XBUF);
  unsigned* lncnt = (unsigned*)(ws + O_LNCNT);
  const bool fused = (gridDim.x == 256);
#define GSYNC() xcd_barrier(xb)
#define PH_BEGIN(n) if (ph_lo <= n && n < ph_hi) { if (n > ph_lo) GSYNC();
#define PH_BEGIN_IF(n, c) if (ph_lo <= n && n < ph_hi && (c)) { if (n > ph_lo) GSYNC();
#define PH_END }
#ifndef PROBE_DUP
#define PROBE_DUP 0
#endif
#ifndef PROBE_SYNCS
#define PROBE_SYNCS 0
#endif
#define DUP(n, ...) __VA_ARGS__; if ((PROBE_DUP >> n) & 1) { GSYNC(); __VA_ARGS__; }
  for (int i = 0; i < PROBE_SYNCS; ++i) GSYNC();
  PH_BEGIN(0) { DUP(0, phase0(p, smem)); } PH_END
  PH_BEGIN(2) {
    float* o_k = p.out + (size_t)NTOK * 1024; float* o_v = o_k + (size_t)NCTX * 512; float* o_ckv = o_v + (size_t)NCTX * 512; float* o_kr = o_ckv + (size_t)NCTX * 128;
    DUP(2, gemm_phase(Hb, 1024, (const bf16_t*)(ws + O_WATTIN), 1024, 1024, 64, 8,
                      EpiAttIn{(bf16_t*)(ws + O_QDA), (bf16_t*)(ws + O_QDB), (bf16_t*)(ws + O_KD), (bf16_t*)(ws + O_VD), (bf16_t*)(ws + O_CQN), (bf16_t*)(ws + O_CKVN), (bf16_t*)(ws + O_KMLA),
                               o_k, o_v, o_ckv, o_kr, (const float*)(ws + O_C16), (const float*)(ws + O_S16), (const float*)(ws + O_C8), (const float*)(ws + O_S8), p.q_norm_g, p.kv_norm_g, smem + 2 * G_STAGE}, smem));
  } PH_END
  PH_BEGIN(4) {
        const int n1 = 64 * 3, n2 = 67 * 4;
        gemm_phase((const bf16_t*)(ws + O_CQN), 256, (const bf16_t*)(ws + O_WUQ), 256, 256, 64, 3,
                   EpiUq{(bf16_t*)(ws + O_QMA), (bf16_t*)(ws + O_QMB), (const float*)(ws + O_C8), (const float*)(ws + O_S8)}, smem, 0, n1 + n2);
        gemm_phase((const bf16_t*)(ws + O_CKVN), 128, (const bf16_t*)(ws + O_WUKV), 128, 128, 67, 4,
                   EpiUkv{(bf16_t*)(ws + O_KMLA), (bf16_t*)(ws + O_VMLA), smem}, smem, n1, n1 + n2);
  } PH_END
  PH_BEGIN(5) { phase_attn(p, smem, 0); if ((PROBE_DUP >> 5) & 1) { GSYNC(); phase_attn(p, smem, 1); } } PH_END
  PH_BEGIN(6) { gemm_phase(Hb, 1024, (const bf16_t*)(ws + O_WATTOUT), 1024, 1024, 64, 4, EpiResLN{p.x_prompt, p.x_sample, mods + 2048, X, p.ln_mix_g, p.ln_mix_b, mods, 3072, 4096, Hb, xbuf, lncnt, smem + 2 * G_STAGE, fused}, smem); } PH_END
  PH_BEGIN_IF(7, !fused) { rows_phase(X, X + (size_t)NCTX * 1024, true, p.ln_mix_g, p.ln_mix_b, X, mods, 3072, 4096, Hb); } PH_END
  PH_BEGIN(8) { DUP(8, gemm_phase(Hb, 1024, (const bf16_t*)(ws + O_WMLPIN), 1024, 1024, 64, 16, EpiRelu2{(bf16_t*)(ws + O_U), smem + G_STAGE}, smem)); } PH_END
  PH_BEGIN(9) { gemm_phase((const bf16_t*)(ws + O_U), 4096, (const bf16_t*)(ws + O_WMLPOUT), 4096, 4096, 64, 4, EpiResLN{X, X + (size_t)NCTX * 1024, mods + 5120, X, p.ln_mlp_g, p.ln_mlp_b, mods + 3 * 6144, 0, 1024, Hb, xbuf + 98304, lncnt + 64, smem + 2 * G_STAGE, fused}, smem); } PH_END
  PH_BEGIN_IF(10, !fused) { rows_phase(X, X + (size_t)NCTX * 1024, true, p.ln_mlp_g, p.ln_mlp_b, X, mods + 3 * 6144, 0, 1024, Hb); } PH_END
  PH_BEGIN(11) { DUP(11, gemm_phase(Hb, 1024, (const bf16_t*)(ws + O_WCONVIN), 1024, 1024, 64, 6, EpiConv{(bf16_t*)(ws + O_UG), (bf16_t*)(ws + O_PZ), smem}, smem)); } PH_END
  PH_BEGIN(12) { DUP(12, phase_conv(p, smem)); } PH_END
  PH_BEGIN(13) { gemm_phase(Hb, 1024, (const bf16_t*)(ws + O_WCONVOUT), 1024, 1024, 64, 4, EpiResLN{X, X + (size_t)NCTX * 1024, mods + 3 * 6144 + 2048, X, p.ln_mix_g + 1024, p.ln_mix_b + 1024, mods + 3 * 6144, 3072, 4096, Hb, xbuf + 2 * 98304, lncnt + 128, smem + 2 * G_STAGE, fused}, smem); } PH_END
  PH_BEGIN_IF(14, !fused) { rows_phase(X, X + (size_t)NCTX * 1024, true, p.ln_mix_g + 1024, p.ln_mix_b + 1024, X, mods + 3 * 6144, 3072, 4096, Hb); } PH_END
  PH_BEGIN(15) { DUP(15, gemm_phase(Hb, 1024, (const bf16_t*)(ws + O_WMLPIN) + (size_t)4096 * 1024, 1024, 1024, 64, 16, EpiRelu2{(bf16_t*)(ws + O_U), smem + G_STAGE}, smem)); } PH_END
  PH_BEGIN(16) { gemm_phase((const bf16_t*)(ws + O_U), 4096, (const bf16_t*)(ws + O_WMLPOUT) + (size_t)4096 * 1024, 4096, 4096, 64, 4, EpiResLN{X, X + (size_t)NCTX * 1024, mods + 3 * 6144 + 5120, X, p.ln_mlp_g + 1024, p.ln_mlp_b + 1024, mods, 0, 0, nullptr, xbuf + 3 * 98304, lncnt + 192, smem + 2 * G_STAGE, fused}, smem); } PH_END
  PH_BEGIN_IF(17, !fused) { rows_phase(X, X + (size_t)NCTX * 1024, true, p.ln_mlp_g + 1024, p.ln_mlp_b + 1024, X, nullptr, 0, 0, nullptr); } PH_END
}

extern "C" void kernel_launch(void* const* d_in, const int* in_sizes, int n_in, void* d_out, int out_size, void* d_ws, size_t ws_size, hipStream_t stream) {
  static int grid_blocks = 0;
  if (!grid_blocks) {
    int dev = 0, cus = 0, per_cu = 0;
    hipGetDevice(&dev);
    hipDeviceGetAttribute(&cus, hipDeviceAttributeMultiprocessorCount, dev);
    hipOccupancyMaxActiveBlocksPerMultiprocessor(&per_cu, fwd_kernel, NT, 0);
    if (per_cu > 1) per_cu = 1;
    if (per_cu < 1) per_cu = 1;
    grid_blocks = cus * per_cu;
    if (grid_blocks > 256) grid_blocks = 256;
  }
  if (ws_size < WS_NEED) { fprintf(stderr, "workspace too small: %zu < %zu\n", ws_size, (size_t)WS_NEED); return; }
  Params p{};
  const float** f = (const float**)&p;
  for (int i = 0; i < 35; ++i) f[i] = (const float*)d_in[i];
  p.out = (float*)d_out;
  p.ws = (char*)d_ws;
  hipMemsetAsync(d_ws, 0, 16384, stream);
  int lo = 0, hi = NPHASE;
  void* args[] = {&p, &lo, &hi};
  hipError_t e = hipLaunchCooperativeKernel((void*)fwd_kernel, dim3(grid_blocks), dim3(NT), args, 0, stream);
  if (e != hipSuccess) fprintf(stderr, "cooperative launch failed: %s (grid %d)\n", hipGetErrorString(e), grid_blocks);
}
```

```cpp
#include <hip/hip_runtime.h>
#include <hip/hip_cooperative_groups.h>
#include <cstdio>
#include <cstdint>
namespace cg = cooperative_groups;

typedef unsigned short bf16_t;
typedef short bf16x8 __attribute__((ext_vector_type(8)));
typedef short s16x4 __attribute__((ext_vector_type(4)));
typedef float f32x4 __attribute__((ext_vector_type(4)));
typedef float f32x2 __attribute__((ext_vector_type(2)));
typedef float f32x16 __attribute__((ext_vector_type(16)));
typedef unsigned u32x4 __attribute__((ext_vector_type(4)));
typedef unsigned u32x2 __attribute__((ext_vector_type(2)));
typedef __bf16 bf16v2 __attribute__((ext_vector_type(2)));
#define DI __device__ __forceinline__
#define LDS_AS __attribute__((address_space(3)))

constexpr int NTOK = 12288, NCTX = 4096, NKEY = 12800, TLAT = 4096, TKL = 4352;
constexpr int RLD = 1952;
constexpr float ALPHA = 1.41421356237f, EPS = 1e-5f;
constexpr int NPHASE = 18;
constexpr int NT = 512, NWAVE = 8;

constexpr size_t al(size_t x) { return (x + 255) & ~(size_t)255; }
constexpr size_t O_CNT = 0;
constexpr size_t O_BAR = 256;
constexpr size_t O_LNCNT = 14336;
constexpr size_t O_MODS = 16384;
constexpr size_t O_SCAL = O_MODS + al(2 * 3 * 6144 * 4);
constexpr size_t O_C16 = O_SCAL + 256;
constexpr size_t O_S16 = O_C16 + 4096;
constexpr size_t O_C8 = O_S16 + 4096;
constexpr size_t O_S8 = O_C8 + 2048;
constexpr size_t O_XBUF = O_S8 + 2048;
constexpr size_t O_WATTIN = O_XBUF + (size_t)4 * 256 * 192 * 2 * 4;
constexpr size_t O_WUQ = O_WATTIN + (size_t)2048 * 1024 * 2;
constexpr size_t O_WUKV = O_WUQ + (size_t)768 * 256 * 2;
constexpr size_t O_WATTOUT = O_WUKV + (size_t)1024 * 128 * 2;
constexpr size_t O_WMLPIN = O_WATTOUT + (size_t)1024 * 1024 * 2;
constexpr size_t O_WMLPOUT = O_WMLPIN + (size_t)2 * 4096 * 1024 * 2;
constexpr size_t O_WCONVIN = O_WMLPOUT + (size_t)2 * 4096 * 1024 * 2;
constexpr size_t O_WCONVOUT = O_WCONVIN + (size_t)1536 * 1024 * 2;
constexpr size_t O_HB = O_WCONVOUT + (size_t)1024 * 1024 * 2;
constexpr size_t O_BIG = O_HB + (size_t)NTOK * 1024 * 2;
constexpr size_t O_R = O_BIG;
constexpr size_t O_QMA = O_R;
constexpr size_t O_QMB = O_QMA + (size_t)NTOK * 768 * 2;
constexpr size_t O_QDA = O_R + al((size_t)NTOK * RLD * 2);
constexpr size_t O_QDB = O_QDA + (size_t)NTOK * 512 * 2;
constexpr size_t O_KD = O_QDB + (size_t)8192 * 512 * 2;
constexpr size_t O_VD = O_KD + (size_t)NKEY * 512 * 2;
constexpr size_t O_CQN = O_VD + (size_t)NKEY * 512 * 2;
constexpr size_t O_CKVN = O_CQN + (size_t)NTOK * 256 * 2;
constexpr size_t O_KMLA = O_CKVN + (size_t)NKEY * 128 * 2;
constexpr size_t O_VMLA = O_KMLA + (size_t)NKEY * 768 * 2;
constexpr size_t O_OTMP = O_VMLA + (size_t)NKEY * 512 * 2;
constexpr size_t O_ATT_END = O_OTMP + (size_t)512 * 16384 * 4;
constexpr size_t O_U = O_BIG;
constexpr size_t O_U_END = O_U + (size_t)NTOK * 4096 * 2;
constexpr size_t O_UG = O_BIG;
constexpr size_t O_PZ = O_UG + (size_t)NTOK * 512 * 2;
constexpr size_t WS_NEED = (O_ATT_END > O_U_END ? O_ATT_END : O_U_END);
static_assert(O_QMB + (size_t)8192 * 768 * 2 <= O_QDA, "Qm overlay must fit in R");
static_assert(WS_NEED <= (size_t)256 * 1024 * 1024, "workspace too large");

struct Params {
  const float *x_prompt, *x_sample, *cache_k, *cache_v, *cache_ckv, *cache_krope, *c, *c_ctx;
  const float *w_ada, *b_ada, *ln_mix_g, *ln_mix_b, *ln_mlp_g, *ln_mlp_b, *w_mlp_in, *w_mlp_out;
  const float *w_att_in, *w_uq, *w_ukv, *q_norm_g, *kv_norm_g, *lam_q1, *lam_k1, *lam_q2, *lam_k2, *diff_norm_g, *w_att_out;
  const float *w_conv_in, *conv_w, *conv_b, *conv_norm_g, *conv_norm_b, *w_pool, *pool_scale, *w_conv_out;
  float* out;
  char* ws;
};

DI unsigned pack2(float lo, float hi) { f32x2 v = {lo, hi}; bf16v2 b = __builtin_convertvector(v, bf16v2); return __builtin_bit_cast(unsigned, b); }
DI float bf2f(unsigned short u) { return __uint_as_float((unsigned)u << 16); }
DI float bflo(unsigned u) { return __uint_as_float(u << 16); }
DI float bfhi(unsigned u) { return __uint_as_float(u & 0xffff0000u); }
DI float wave_sum(float v) {
#pragma unroll
  for (int o = 32; o >= 1; o >>= 1) v += __shfl_xor(v, o);
  return v;
}
DI void lds_barrier() { asm volatile("s_waitcnt lgkmcnt(0)\n\ts_barrier" ::: "memory"); }
DI void dma16(const void* gsrc, unsigned lds_dst) {
  unsigned keep;
  asm volatile("s_mov_b32 %0, m0\n\ts_mov_b32 m0, %2\n\ts_nop 0\n\tglobal_load_lds_dwordx4 %1, off\n\ts_mov_b32 m0, %0" : "=&s"(keep) : "v"(gsrc), "s"(lds_dst) : "memory");
}
DI int cond_idx(int row) { return row < NCTX ? 0 : 1 + ((row - NCTX) >> 12); }


#define XB_TMO      128
#define XB_XCNT(j)  (256  + 64 * (j))
#define XB_XSUB(j)  (1280 + 64 * (j))
#define XB_XGEN(j)  (2304 + 64 * (j))
#define XB_TOP      3328
#define XB_TOPGEN   3392
#define XCD_BAR_WORDS 3456
#define XB_SPIN_CAP (1u << 18)
DI unsigned xb_ld(unsigned* p)              { return __hip_atomic_load(p, __ATOMIC_RELAXED, __HIP_MEMORY_SCOPE_AGENT); }
DI unsigned xb_add(unsigned* p, unsigned v) { return __hip_atomic_fetch_add(p, v, __ATOMIC_RELAXED, __HIP_MEMORY_SCOPE_AGENT); }
DI unsigned xb_xcc_id() { return (unsigned)__builtin_amdgcn_s_getreg((3 << 11) | 20) & 0xFu; }
#define XB_SPIN(cond, bar) do { unsigned _sp = 0; while (cond) { __builtin_amdgcn_s_sleep(1); \
    if ((++_sp & 255u) == 0u) { if (xb_ld(&(bar)[XB_TMO])) break; if (_sp > XB_SPIN_CAP) { atomicAdd(&(bar)[XB_TMO], 1u); break; } } } } while (0)
struct XcdBarrier { unsigned* bar; unsigned x; volatile LDS_AS unsigned* st; };
DI XcdBarrier xcd_barrier_post(unsigned* bar, volatile LDS_AS unsigned* st) {
  XcdBarrier b; b.bar = bar; b.x = xb_xcc_id(); b.st = st;
  if (threadIdx.x == 0) (void)xb_add(&bar[XB_XCNT(b.x)], 1u);
  return b;
}
DI void xcd_barrier_complete(unsigned* bar, unsigned x, unsigned& nloc, unsigned& nx) {
  const unsigned G = gridDim.x * gridDim.y * gridDim.z;
  unsigned sum, cnt, mine, sp = 0u;
  for (;;) {
    sum = 0u; cnt = 0u; mine = 0u;
#pragma unroll
    for (unsigned j = 0; j < 16; ++j) { const unsigned c = xb_ld(&bar[XB_XCNT(j)]); sum += c; cnt += (c > 0u) ? 1u : 0u; mine = (j == x) ? c : mine; }
    if (sum == G) break;
    __builtin_amdgcn_s_sleep(1);
    if ((++sp & 255u) == 0u) { if (xb_ld(&bar[XB_TMO])) break; if (sp > XB_SPIN_CAP) { atomicAdd(&bar[XB_TMO], 1u); break; } }
  }
  nloc = mine > 0u ? mine : 1u; nx = cnt > 0u ? cnt : 1u;
}
DI void xcd_barrier(const XcdBarrier& b) {
  asm volatile("s_waitcnt vmcnt(0)" ::: "memory");
  __syncthreads();
  if (threadIdx.x == 0) {
    unsigned* bar = b.bar;
    __builtin_amdgcn_s_waitcnt(0);
    unsigned nloc = b.st[0], nx = b.st[1];
    if (nloc == 0u) { xcd_barrier_complete(bar, b.x, nloc, nx); b.st[0] = nloc; b.st[1] = nx; }
    const unsigned old = xb_add(&bar[XB_XSUB(b.x)], 1u);
    const unsigned gen = old / nloc;
    if (old + 1u == (gen + 1u) * nloc) {
      __builtin_amdgcn_fence(__ATOMIC_RELEASE, "agent");
      asm volatile("s_waitcnt vmcnt(0)" ::: "memory");
      const unsigned og = xb_add(&bar[XB_TOP], 1u);
      const unsigned tg = og / nx;
      if (og + 1u == (tg + 1u) * nx) xb_add(&bar[XB_TOPGEN], 1u);
      else XB_SPIN(xb_ld(&bar[XB_TOPGEN]) == tg, bar);
      __builtin_amdgcn_fence(__ATOMIC_ACQUIRE, "agent");
      xb_add(&bar[XB_XGEN(b.x)], 1u);
      asm volatile("s_waitcnt vmcnt(0)" ::: "memory");
    } else {
      XB_SPIN(xb_ld(&bar[XB_XGEN(b.x)]) == gen, bar);
      __builtin_amdgcn_fence(__ATOMIC_ACQUIRE, "agent");
      asm volatile("s_waitcnt vmcnt(0)" ::: "memory");
    }
  }
  __syncthreads();
}

DI int swz(int row, int kc) { return row * 128 + ((kc ^ ((row >> 1) & 7)) << 4); }

constexpr int G_BM = 192, G_BN = 256, G_MI = 6, G_NJ = 4, G_ABYTES = G_BM * 128, G_STAGE = G_ABYTES + G_BN * 128;
template <class Epi>
DI void gemm_tile(const bf16_t* __restrict__ A, int lda, const bf16_t* __restrict__ Bt, int ldb, int K, int row0, int col0, char* smem, const Epi& epi,
                  bool prefetched, bool has_next, int nrow0, int ncol0) {
  const int tid = threadIdx.x, lane = tid & 63, wid = tid >> 6, wr = wid >> 2, wc = wid & 3;
  const int fr = lane & 15, fq = lane >> 4;
  f32x4 acc[G_MI][G_NJ];
#pragma unroll
  for (int i = 0; i < G_MI; ++i)
#pragma unroll
    for (int j = 0; j < G_NJ; ++j) acc[i][j] = (f32x4){0.f, 0.f, 0.f, 0.f};
  const int srow = tid >> 3, skc = tid & 7;
  const int schunk = skc ^ ((srow >> 1) & 7);
  const bf16_t* ga = A + (size_t)(row0 + srow) * lda + schunk * 8;
  const bf16_t* gb = Bt + (size_t)(col0 + srow) * ldb + schunk * 8;
  const int nk = K >> 6;
  const unsigned lds0 = __builtin_amdgcn_readfirstlane((unsigned)(size_t)(LDS_AS char*)smem + (unsigned)(tid & ~63) * 16u);
#define G_DMA_P(ga_, gb_, stage_off_, kt_) do { const int k0_ = (kt_) << 6; const unsigned sb_ = lds0 + (unsigned)(stage_off_); \
    _Pragma("unroll") for (int i = 0; i < 3; ++i) dma16((ga_) + (size_t)(64 * i) * lda + k0_, sb_ + i * 8192); \
    _Pragma("unroll") for (int i = 0; i < 4; ++i) dma16((gb_) + (size_t)(64 * i) * ldb + k0_, sb_ + G_ABYTES + i * 8192); } while (0)
#define G_DMA(stage_off_, kt_) G_DMA_P(ga, gb, stage_off_, kt_)
#define G_COMPUTE(buf_) do { const char* cur = (buf_); \
    _Pragma("unroll") for (int s = 0; s < 2; ++s) { \
      bf16x8 af[G_MI], bfr[G_NJ]; \
      _Pragma("unroll") for (int i = 0; i < G_MI; ++i) af[i] = *(const bf16x8*)(cur + swz(wr * 96 + i * 16 + fr, s * 4 + fq)); \
      _Pragma("unroll") for (int j = 0; j < G_NJ; ++j) bfr[j] = *(const bf16x8*)(cur + G_ABYTES + swz(wc * 64 + j * 16 + fr, s * 4 + fq)); \
      __builtin_amdgcn_s_setprio(1); \
      _Pragma("unroll") for (int i = 0; i < G_MI; ++i) \
        _Pragma("unroll") for (int j = 0; j < G_NJ; ++j) acc[i][j] = __builtin_amdgcn_mfma_f32_16x16x32_bf16(bfr[j], af[i], acc[i][j], 0, 0, 0); \
      __builtin_amdgcn_s_setprio(0); \
    } } while (0)
  if (!prefetched) { G_DMA(0, 0); asm volatile("s_waitcnt vmcnt(0)" ::: "memory"); }
  else asm volatile("s_waitcnt vmcnt(%0)" :: "n"(Epi::kMinStores) : "memory");
  lds_barrier();
  for (int kt = 0; kt < nk; kt += 2) {
    G_DMA(G_STAGE, kt + 1);
    G_COMPUTE(smem);
    asm volatile("s_waitcnt vmcnt(0)" ::: "memory");
    lds_barrier();
    G_DMA(0, min(kt + 2, nk - 1));
    G_COMPUTE(smem + G_STAGE);
    asm volatile("s_waitcnt vmcnt(0)" ::: "memory");
    lds_barrier();
  }
  if (has_next) {
    const bf16_t* gan = A + (size_t)(nrow0 + srow) * lda + schunk * 8;
    const bf16_t* gbn = Bt + (size_t)(ncol0 + srow) * ldb + schunk * 8;
    G_DMA_P(gan, gbn, 0, 0);
  }
#undef G_DMA
#undef G_DMA_P
#undef G_COMPUTE
  epi(acc, row0 + wr * 96, col0 + wc * 64, lane);
}


template <class F>
DI void wave_rows_store(char* w, const u32x2 (&pk)[G_MI][G_NJ], int lane, F rowptr) {
  const int fr = lane & 15, fq = lane >> 4;
#pragma unroll
  for (int i = 0; i < G_MI; ++i)
#pragma unroll
    for (int j = 0; j < G_NJ; ++j) *(u32x2*)(w + (i * 16 + fr) * 144 + (j * 16 + fq * 4) * 2) = pk[i][j];
  const int rr = lane >> 3, ch = lane & 7;
#pragma unroll
  for (int it = 0; it < 12; ++it) {
    const int r = it * 8 + rr;
    const u32x4 v = *(const u32x4*)(w + r * 144 + ch * 16);
    bf16_t* d = rowptr(r);
    if (d) *(u32x4*)(d + ch * 8) = v;
  }
}
DI u32x2 pk4(const f32x4 v) { return (u32x2){pack2(v[0], v[1]), pack2(v[2], v[3])}; }

struct EpiRaw {
  static constexpr int kMinStores = 0;
  static constexpr bool kPrefetchNext = true;
  bf16_t* R;
  DI void operator()(f32x4 (&acc)[G_MI][G_NJ], int rbase, int cbase, int lane) const {
    const int fr = lane & 15, fq = lane >> 4;
#pragma unroll
    for (int i = 0; i < G_MI; ++i)
#pragma unroll
      for (int j = 0; j < G_NJ; ++j) {
        const int row = rbase + i * 16 + fr, col = cbase + j * 16 + fq * 4;
        if (col < RLD) { u32x2 w = {pack2(acc[i][j][0], acc[i][j][1]), pack2(acc[i][j][2], acc[i][j][3])}; *(u32x2*)(R + (size_t)row * RLD + col) = w; }
      }
  }
};


struct EpiAttIn {
  static constexpr int kMinStores = 0;
  static constexpr bool kPrefetchNext = true;
  bf16_t *Qda, *Qdb, *Kd, *Vd, *cqn, *ckvn, *Km; float *o_k, *o_v, *o_ckv, *o_kr;
  const float *c16, *s16, *c8, *s8, *qg, *kvg; char* smem;
  DI void operator()(f32x4 (&acc)[G_MI][G_NJ], int rbase, int cbase, int lane) const {
    const int tid = threadIdx.x, wid = tid >> 6, wr = wid >> 2, wc = wid & 3, fr = lane & 15, fq = lane >> 4;
    const int tile = (cbase - wc * 64) >> 8;
    float* part = (float*)smem;
    if (tile < 6) {
      const int which = tile >> 1, c0 = cbase & 511;
#pragma unroll
      for (int i = 0; i < G_MI; ++i) {
        const int rowf = rbase + i * 16, row = rowf + fr;
        const bool lat = rowf >= NCTX;
        const int rl = row - NCTX, b = rl >> 12, t = rl & (TLAT - 1), prow = t >> 6, pcol = t & 63;
        const size_t kr = lat ? (size_t)NCTX + (size_t)b * TKL + 256 + t : (size_t)row;
        u32x2 raw[G_NJ], rot[G_NJ];
#pragma unroll
        for (int j = 0; j < G_NJ; ++j) raw[j] = (u32x2){pack2(acc[i][j][0], acc[i][j][1]), pack2(acc[i][j][2], acc[i][j][3])};
        if (lat && which < 2) {
#pragma unroll
          for (int jp = 0; jp < 2; ++jp) {
            const int pos = jp == 0 ? prow : pcol;
            const f32x4 cs = *(const f32x4*)(c16 + pos * 16 + fq * 4), sn = *(const f32x4*)(s16 + pos * 16 + fq * 4);
            const f32x4 x1 = acc[i][2 * jp], x2 = acc[i][2 * jp + 1];
            f32x4 o1, o2;
#pragma unroll
            for (int e = 0; e < 4; ++e) { o1[e] = x1[e] * cs[e] - x2[e] * sn[e]; o2[e] = x1[e] * sn[e] + x2[e] * cs[e]; }
            rot[2 * jp] = (u32x2){pack2(o1[0], o1[1]), pack2(o1[2], o1[3])};
            rot[2 * jp + 1] = (u32x2){pack2(o2[0], o2[1]), pack2(o2[2], o2[3])};
          }
        }
#pragma unroll
        for (int j = 0; j < G_NJ; ++j) {
          const int c = c0 + j * 16 + fq * 4;
          if (which == 0) {
            *(u32x2*)(Qda + (size_t)row * 512 + c) = raw[j];
            if (lat) *(u32x2*)(Qdb + (size_t)rl * 512 + c) = rot[j];
          } else if (which == 1) {
            if (lat) *(u32x2*)(Kd + kr * 512 + c) = rot[j];
            else { *(u32x2*)(Kd + kr * 512 + c) = raw[j]; *(f32x4*)(o_k + (size_t)row * 512 + c) = acc[i][j]; }
          } else {
            *(u32x2*)(Vd + kr * 512 + c) = raw[j];
            if (!lat) *(f32x4*)(o_v + (size_t)row * 512 + c) = acc[i][j];
          }
        }
      }
      return;
    }
    const bool norm_wave = (tile == 6) || (wc < 2);
#pragma unroll
    for (int i = 0; i < G_MI; ++i) {
      float ss = 0.f;
#pragma unroll
      for (int j = 0; j < G_NJ; ++j)
#pragma unroll
        for (int e = 0; e < 4; ++e) ss += acc[i][j][e] * acc[i][j][e];
      ss += __shfl_xor(ss, 16); ss += __shfl_xor(ss, 32);
      if (fq == 0) part[(wr * 96 + i * 16 + fr) * 4 + wc] = ss;
    }
    __syncthreads();
#pragma unroll
    for (int i = 0; i < G_MI; ++i) {
      const int rowf = rbase + i * 16, row = rowf + fr;
      const bool lat = rowf >= NCTX;
      const int rl = row - NCTX, b = rl >> 12, t = rl & (TLAT - 1), prow = t >> 6, pcol = t & 63;
      const size_t kr = lat ? (size_t)NCTX + (size_t)b * TKL + 256 + t : (size_t)row;
      const f32x4 pr = *(const f32x4*)(part + (wr * 96 + i * 16 + fr) * 4);
      if (tile == 6) {
        const float sc = rsqrtf(((pr[0] + pr[1]) + (pr[2] + pr[3])) * (1.f / 256.f) + EPS);
#pragma unroll
        for (int j = 0; j < G_NJ; ++j) {
          const int c = wc * 64 + j * 16 + fq * 4;
          const f32x4 g = *(const f32x4*)(qg + c);
          *(u32x2*)(cqn + (size_t)row * 256 + c) = (u32x2){pack2(acc[i][j][0] * sc * g[0], acc[i][j][1] * sc * g[1]), pack2(acc[i][j][2] * sc * g[2], acc[i][j][3] * sc * g[3])};
        }
      } else if (norm_wave) {
        const float sc = rsqrtf((pr[0] + pr[1]) * (1.f / 128.f) + EPS);
#pragma unroll
        for (int j = 0; j < G_NJ; ++j) {
          const int c = wc * 64 + j * 16 + fq * 4;
          const f32x4 g = *(const f32x4*)(kvg + c);
          f32x4 y;
#pragma unroll
          for (int e = 0; e < 4; ++e) y[e] = acc[i][j][e] * sc * g[e];
          if (!lat) *(f32x4*)(o_ckv + (size_t)row * 128 + c) = y;
          *(u32x2*)(ckvn + kr * 128 + c) = (u32x2){pack2(y[0], y[1]), pack2(y[2], y[3])};
        }
      } else if (wc == 2) {
#pragma unroll
        for (int j = 0; j < 2; ++j) {
          f32x4 v = acc[i][j];
          if (lat) {
            const int pos = j == 0 ? prow : pcol;
            f32x4 o;
#pragma unroll
            for (int e = 0; e < 4; ++e) {
              const float pv = __shfl_xor(v[e], 32);
              const int f = (fq & 1) * 4 + e;
              const float cs = c8[pos * 8 + f], sn = s8[pos * 8 + f];
              o[e] = (fq < 2) ? (v[e] * cs - pv * sn) : (pv * sn + v[e] * cs);
            }
            v = o;
          } else *(f32x4*)(o_kr + (size_t)row * 32 + j * 16 + fq * 4) = v;
          const u32x2 w = {pack2(v[0], v[1]), pack2(v[2], v[3])};
#pragma unroll
          for (int hh = 0; hh < 8; ++hh) *(u32x2*)(Km + kr * 768 + hh * 96 + 64 + j * 16 + fq * 4) = w;
        }
      }
    }
    __syncthreads();
  }
};

struct EpiUq {
  static constexpr int kMinStores = 24;
  static constexpr bool kPrefetchNext = true;
  bf16_t *Qa, *Qb; const float *c8, *s8;
  DI void operator()(f32x4 (&acc)[G_MI][G_NJ], int rbase, int cbase, int lane) const {
    const int fr = lane & 15, fq = lane >> 4;
#pragma unroll
    for (int i = 0; i < G_MI; ++i) {
      const bool lat = (rbase + i * 16) >= NCTX;
      const int row = rbase + i * 16 + fr;
      const int t = (row - NCTX) & (TLAT - 1);
#pragma unroll
      for (int j = 0; j < G_NJ; ++j) {
        const int cf = cbase + j * 16, col = cf + fq * 4;
        f32x4 v = acc[i][j];
        u32x2 w = {pack2(v[0], v[1]), pack2(v[2], v[3])};
        *(u32x2*)(Qa + (size_t)row * 768 + col) = w;
        if (lat) {
          const int w96 = cf % 96;
          if (w96 >= 64) {
            const int pos = (w96 == 64) ? (t >> 6) : (t & 63);
            f32x4 o;
#pragma unroll
            for (int e = 0; e < 4; ++e) {
              const float pv = __shfl_xor(v[e], 32);
              const int f = (fq & 1) * 4 + e;
              const float cs = c8[pos * 8 + f], sn = s8[pos * 8 + f];
              o[e] = (fq < 2) ? (v[e] * cs - pv * sn) : (pv * sn + v[e] * cs);
            }
            w = (u32x2){pack2(o[0], o[1]), pack2(o[2], o[3])};
          }
          *(u32x2*)(Qb + (size_t)(row - NCTX) * 768 + col) = w;
        }
      }
    }
  }
};

struct EpiUkv {
  static constexpr int kMinStores = 0;
  static constexpr bool kPrefetchNext = false;
  bf16_t *Km, *Vm; char* lds;
  DI void operator()(f32x4 (&acc)[G_MI][G_NJ], int rbase, int cbase, int lane) const {
    const int h = cbase >> 7, part = (cbase >> 6) & 1;
    u32x2 pk[G_MI][G_NJ];
#pragma unroll
    for (int i = 0; i < G_MI; ++i)
#pragma unroll
      for (int j = 0; j < G_NJ; ++j) pk[i][j] = pk4(acc[i][j]);
    bf16_t* base = part == 0 ? Km + h * 96 : Vm + h * 64;
    const int ld = part == 0 ? 768 : 512;
    wave_rows_store(lds + (threadIdx.x >> 6) * (96 * 144), pk, lane, [&](int r) -> bf16_t* { const int row = rbase + r; return row < NKEY ? base + (size_t)row * ld : nullptr; });
    lds_barrier();
  }
};

struct EpiRes {
  static constexpr int kMinStores = 0;
  static constexpr bool kPrefetchNext = true;
  const float *xin_ctx, *xin_lat, *gate  ; float* X;
  DI void operator()(f32x4 (&acc)[G_MI][G_NJ], int rbase, int cbase, int lane) const {
    const int fr = lane & 15, fq = lane >> 4;
#pragma unroll
    for (int i = 0; i < G_MI; ++i) {
      const int row = rbase + i * 16 + fr;
      const float* g = gate + cond_idx(rbase + i * 16) * 6144;
      const float* xin = row < NCTX ? xin_ctx + (size_t)row * 1024 : xin_lat + (size_t)(row - NCTX) * 1024;
#pragma unroll
      for (int j = 0; j < G_NJ; ++j) {
        const int col = cbase + j * 16 + fq * 4;
        const f32x4 xv = *(const f32x4*)(xin + col), gv = *(const f32x4*)(g + col);
        f32x4 z;
#pragma unroll
        for (int e = 0; e < 4; ++e) z[e] = ALPHA * xv[e] + gv[e] * acc[i][j][e];
        *(f32x4*)(X + (size_t)row * 1024 + col) = z;
      }
    }
  }
};


struct EpiResLN {
  static constexpr int kMinStores = 0;
  static constexpr bool kPrefetchNext = true;
  const float *xin_ctx, *xin_lat, *gate; float* X;
  const float *lg, *lb, *modsL; int sh_off, sc_off; bf16_t* Hb;
  float* xbuf; unsigned* cnt; char* smem; bool fused;
  DI void operator()(f32x4 (&acc)[G_MI][G_NJ], int rbase, int cbase, int lane) const {
    const int tid = threadIdx.x, wid = tid >> 6, wr = wid >> 2, wc = wid & 3, fr = lane & 15, fq = lane >> 4;
    const int cid0 = cond_idx(rbase);
#pragma unroll
    for (int j = 0; j < G_NJ; ++j) {
      const int col = cbase + j * 16 + fq * 4;
      const f32x4 gv0 = *(const f32x4*)(gate + cid0 * 6144 + col);
#pragma unroll
      for (int i = 0; i < G_MI; ++i) {
        const int row = rbase + i * 16 + fr, cid = cond_idx(rbase + i * 16);
        const float* xin = row < NCTX ? xin_ctx + (size_t)row * 1024 : xin_lat + (size_t)(row - NCTX) * 1024;
        const f32x4 xv = *(const f32x4*)(xin + col);
        f32x4 gv = gv0;
        if (cid != cid0) gv = *(const f32x4*)(gate + cid * 6144 + col);
#pragma unroll
        for (int e = 0; e < 4; ++e) acc[i][j][e] = ALPHA * xv[e] + gv[e] * acc[i][j][e];
        if (!fused) *(f32x4*)(X + (size_t)row * 1024 + col) = acc[i][j];
      }
    }
    if (!fused) return;
    const int row0 = rbase - wr * 96, pm = row0 / G_BM, pn = (cbase - wc * 64) / G_BN;
    f32x2* part = (f32x2*)smem;
    f32x2* stat = (f32x2*)(smem + 8192);
#pragma unroll
    for (int i = 0; i < G_MI; ++i) {
      float s1 = 0.f, s2 = 0.f;
#pragma unroll
      for (int j = 0; j < G_NJ; ++j)
#pragma unroll
        for (int e = 0; e < 4; ++e) { const float v = acc[i][j][e]; s1 += v; s2 += v * v; }
      s1 += __shfl_xor(s1, 16); s2 += __shfl_xor(s2, 16);
      s1 += __shfl_xor(s1, 32); s2 += __shfl_xor(s2, 32);
      if (fq == 0) part[(wr * 96 + i * 16 + fr) * 4 + wc] = (f32x2){s1, s2};
    }
    __syncthreads();
    if (tid < G_BM) {
      const f32x2 a = part[tid * 4 + 0], b = part[tid * 4 + 1], c = part[tid * 4 + 2], d = part[tid * 4 + 3];
      const float s1 = (a[0] + b[0]) + (c[0] + d[0]), s2 = (a[1] + b[1]) + (c[1] + d[1]);
      const unsigned long long pk = ((unsigned long long)__float_as_uint(s2) << 32) | (unsigned long long)__float_as_uint(s1);
      __hip_atomic_store((unsigned long long*)(xbuf + ((size_t)(pm * 4 + pn) * G_BM + tid) * 2), pk, __ATOMIC_RELAXED, __HIP_MEMORY_SCOPE_AGENT);
    }
    asm volatile("s_waitcnt vmcnt(0)" ::: "memory");
    __syncthreads();
    if (tid == 0) {
      __hip_atomic_fetch_add(cnt + pm, 1u, __ATOMIC_RELAXED, __HIP_MEMORY_SCOPE_AGENT);
      unsigned sp = 0;
      while (__hip_atomic_load(cnt + pm, __ATOMIC_RELAXED, __HIP_MEMORY_SCOPE_AGENT) < 4u) { __builtin_amdgcn_s_sleep(1); if (++sp > (1u << 22)) break; }
    }
    __syncthreads();
    if (tid < G_BM) {
      float s1 = 0.f, s2 = 0.f;
#pragma unroll
      for (int q = 0; q < 4; ++q) {
        const unsigned long long pk = __hip_atomic_load((unsigned long long*)(xbuf + ((size_t)(pm * 4 + q) * G_BM + tid) * 2), __ATOMIC_RELAXED, __HIP_MEMORY_SCOPE_AGENT);
        s1 += __uint_as_float((unsigned)pk); s2 += __uint_as_float((unsigned)(pk >> 32));
      }
      const float mean = s1 * (1.f / 1024.f);
      const float var = fmaxf(s2 * (1.f / 1024.f) - mean * mean, 0.f);
      stat[tid] = (f32x2){mean, rsqrtf(var + EPS)};
    }
    __syncthreads();
#pragma unroll
    for (int j = 0; j < G_NJ; ++j) {
      const int col = cbase + j * 16 + fq * 4;
      const f32x4 gv = *(const f32x4*)(lg + col), bv = *(const f32x4*)(lb + col);
      f32x4 sh0 = {0.f, 0.f, 0.f, 0.f}, sc0 = sh0;
      if (Hb) { sh0 = *(const f32x4*)(modsL + cid0 * 6144 + sh_off + col); sc0 = *(const f32x4*)(modsL + cid0 * 6144 + sc_off + col); }
#pragma unroll
      for (int i = 0; i < G_MI; ++i) {
        const int row = rbase + i * 16 + fr, cid = cond_idx(rbase + i * 16);
        const f32x2 ms = stat[wr * 96 + i * 16 + fr];
        f32x4 x;
#pragma unroll
        for (int e = 0; e < 4; ++e) x[e] = (acc[i][j][e] - ms[0]) * ms[1] * gv[e] + bv[e];
        *(f32x4*)(X + (size_t)row * 1024 + col) = x;
        if (Hb) {
          f32x4 sh = sh0, sc = sc0;
          if (cid != cid0) { sh = *(const f32x4*)(modsL + cid * 6144 + sh_off + col); sc = *(const f32x4*)(modsL + cid * 6144 + sc_off + col); }
          u32x2 w = {pack2(x[0] * (1.f + sc[0]) + sh[0], x[1] * (1.f + sc[1]) + sh[1]), pack2(x[2] * (1.f + sc[2]) + sh[2], x[3] * (1.f + sc[3]) + sh[3])};
          *(u32x2*)(Hb + (size_t)row * 1024 + col) = w;
        }
      }
    }
    __syncthreads();
  }
};

struct EpiRelu2 {
  static constexpr int kMinStores = 12;
  static constexpr bool kPrefetchNext = true;
  bf16_t* U; char* lds;
  DI void operator()(f32x4 (&acc)[G_MI][G_NJ], int rbase, int cbase, int lane) const {
    const int fr = lane & 15, fq = lane >> 4, wid = threadIdx.x >> 6;
    char* w = lds + wid * (48 * 144);
    const int rr = lane >> 3, ch = lane & 7;
#pragma unroll
    for (int hf = 0; hf < 2; ++hf) {
#pragma unroll
      for (int i3 = 0; i3 < 3; ++i3)
#pragma unroll
        for (int j = 0; j < G_NJ; ++j) {
          f32x4 v = acc[hf * 3 + i3][j];
#pragma unroll
          for (int e = 0; e < 4; ++e) { const float r = fmaxf(v[e], 0.f); v[e] = r * r; }
          *(u32x2*)(w + (i3 * 16 + fr) * 144 + (j * 16 + fq * 4) * 2) = (u32x2){pack2(v[0], v[1]), pack2(v[2], v[3])};
        }
#pragma unroll
      for (int it = 0; it < 6; ++it) {
        const int r = it * 8 + rr;
        const u32x4 v = *(const u32x4*)(w + r * 144 + ch * 16);
        *(u32x4*)(U + (size_t)(rbase + hf * 48 + r) * 4096 + cbase + ch * 8) = v;
      }
    }
  }
};

struct EpiConv {
  static constexpr int kMinStores = 0;
  static constexpr bool kPrefetchNext = false;
  bf16_t *Ug, *Pz; char* lds;
  DI void operator()(f32x4 (&acc)[G_MI][G_NJ], int rbase, int cbase, int lane) const {
    const int fr = lane & 15, fq = lane >> 4;
    char* w = lds + (threadIdx.x >> 6) * (96 * 144);
    if (cbase < 1024) {
#pragma unroll
      for (int i = 0; i < G_MI; ++i)
#pragma unroll
        for (int jp = 0; jp < 2; ++jp) {
          const f32x4 a = acc[i][2 * jp], gt = acc[i][2 * jp + 1];
          f32x4 u;
#pragma unroll
          for (int e = 0; e < 4; ++e) u[e] = a[e] / (1.f + __expf(-gt[e]));
          *(u32x2*)(w + (i * 16 + fr) * 80 + (jp * 16 + fq * 4) * 2) = pk4(u);
        }
      const int rr = lane >> 2, ch = lane & 3, c0 = (cbase >> 5) * 16;
#pragma unroll
      for (int it = 0; it < 6; ++it) {
        const int r = it * 16 + rr;
        const u32x4 v = *(const u32x4*)(w + r * 80 + ch * 16);
        *(u32x4*)(Ug + (size_t)(rbase + r) * 512 + c0 + ch * 8) = v;
      }
    } else {
      u32x2 pk[G_MI][G_NJ];
#pragma unroll
      for (int i = 0; i < G_MI; ++i)
#pragma unroll
        for (int j = 0; j < G_NJ; ++j) pk[i][j] = pk4(acc[i][j]);
      wave_rows_store(w, pk, lane, [&](int r) -> bf16_t* { return Pz + (size_t)(rbase + r) * 512 + (cbase - 1024); });
    }
    lds_barrier();
  }
};

#ifndef XCD_ORDER
#define XCD_ORDER 1
#endif
template <class Epi>
DI void gemm_phase(const bf16_t* A, int lda, const bf16_t* Bt, int ldb, int K, int mt, int nt, const Epi& epi, char* smem, int tstart = 0, int ttotal = -1) {
  const int n = mt * nt;
  if (ttotal < 0) ttotal = n;
  const bool xo = XCD_ORDER && gridDim.x == 256 && (nt & 3) == 0 && (mt & 3) == 0 && n % 256 == 0;
  auto coords = [&](int u, int& r0, int& c0) {
    int pm = u / nt, pn = u - pm * nt;
    if (xo) {
      const int r = u >> 8, w = u & 255, x = w & 7, idx = w >> 3;
      const int rows_r = 256 / nt, pw = nt < 8 ? nt : 8, ph = 32 / pw, npx = nt / pw, px = x % npx, py = x / npx;
      pm = r * rows_r + py * ph + idx / pw; pn = px * pw + idx % pw;
    }
    r0 = pm * G_BM; c0 = pn * G_BN;
  };
  int t = blockIdx.x;
  while (t < tstart) t += gridDim.x;
  bool prefetched = false;
  while (t < tstart + n && t < ttotal) {
    const int tn = t + gridDim.x;
    const bool has_next = Epi::kPrefetchNext && tn < tstart + n && tn < ttotal;
    int r0, c0, nr0 = 0, nc0 = 0;
    coords(t - tstart, r0, c0);
    if (has_next) coords(tn - tstart, nr0, nc0);
    gemm_tile(A, lda, Bt, ldb, K, r0, c0, smem, epi, prefetched, has_next, nr0, nc0);
    prefetched = has_next;
    t = tn;
  }
}

DI void rows_phase(const float* src_ctx, const float* src_lat, bool do_ln, const float* lg, const float* lb, float* Xdst,
                   const float* modsL, int sh_off, int sc_off, bf16_t* Hb) {
  const int lane = threadIdx.x & 63, gw = blockIdx.x * NWAVE + (threadIdx.x >> 6), nw = gridDim.x * NWAVE;
  for (int row = gw; row < NTOK; row += nw) {
    const float* src = row < NCTX ? src_ctx + (size_t)row * 1024 : src_lat + (size_t)(row - NCTX) * 1024;
    f32x4 v[4];
#pragma unroll
    for (int i = 0; i < 4; ++i) v[i] = *(const f32x4*)(src + i * 256 + lane * 4);
    if (do_ln) {
      float s = 0.f;
#pragma unroll
      for (int i = 0; i < 4; ++i) s += (v[i][0] + v[i][1]) + (v[i][2] + v[i][3]);
      const float mean = wave_sum(s) * (1.f / 1024.f);
      float q = 0.f;
#pragma unroll
      for (int i = 0; i < 4; ++i)
#pragma unroll
        for (int e = 0; e < 4; ++e) { const float d = v[i][e] - mean; q += d * d; }
      const float rstd = rsqrtf(wave_sum(q) * (1.f / 1024.f) + EPS);
#pragma unroll
      for (int i = 0; i < 4; ++i) {
        const f32x4 g = *(const f32x4*)(lg + i * 256 + lane * 4), b = *(const f32x4*)(lb + i * 256 + lane * 4);
#pragma unroll
        for (int e = 0; e < 4; ++e) v[i][e] = (v[i][e] - mean) * rstd * g[e] + b[e];
        if (Xdst) *(f32x4*)(Xdst + (size_t)row * 1024 + i * 256 + lane * 4) = v[i];
      }
    }
    if (Hb) {
      const float* m = modsL + cond_idx(row) * 6144;
#pragma unroll
      for (int i = 0; i < 4; ++i) {
        const int col = i * 256 + lane * 4;
        const f32x4 sh = *(const f32x4*)(m + sh_off + col), sc = *(const f32x4*)(m + sc_off + col);
        f32x4 h;
#pragma unroll
        for (int e = 0; e < 4; ++e) h[e] = v[i][e] * (1.f + sc[e]) + sh[e];
        u32x2 w = {pack2(h[0], h[1]), pack2(h[2], h[3])};
        *(u32x2*)(Hb + (size_t)row * 1024 + col) = w;
      }
    }
  }
}

DI void modulate_phase(const float* __restrict__ src_ctx, const float* __restrict__ src_lat, const float* __restrict__ modsL, bf16_t* __restrict__ Hb) {
  const int lane = threadIdx.x & 63, gw = blockIdx.x * NWAVE + (threadIdx.x >> 6), nw = gridDim.x * NWAVE;
  for (int r0 = gw * 2; r0 < NTOK; r0 += nw * 2) {
    f32x4 v[2][4];
#pragma unroll
    for (int k = 0; k < 2; ++k) {
      const int row = r0 + k;
      const float* src = row < NCTX ? src_ctx + (size_t)row * 1024 : src_lat + (size_t)(row - NCTX) * 1024;
#pragma unroll
      for (int i = 0; i < 4; ++i) v[k][i] = __builtin_nontemporal_load((const f32x4*)(src + i * 256 + lane * 4));
    }
#pragma unroll
    for (int k = 0; k < 2; ++k) {
      const int row = r0 + k;
      const float* m = modsL + cond_idx(row) * 6144;
#pragma unroll
      for (int i = 0; i < 4; ++i) {
        const int col = i * 256 + lane * 4;
        const f32x4 sh = *(const f32x4*)(m + col), sc = *(const f32x4*)(m + 1024 + col);
        u32x2 w = {pack2(v[k][i][0] * (1.f + sc[0]) + sh[0], v[k][i][1] * (1.f + sc[1]) + sh[1]), pack2(v[k][i][2] * (1.f + sc[2]) + sh[2], v[k][i][3] * (1.f + sc[3]) + sh[3])};
        *(u32x2*)(Hb + (size_t)row * 1024 + col) = w;
      }
    }
  }
}

DI double sin_red(double r) {
  const double r2 = r * r; double t = -1.0 / 51090942171709440000.0;
  t = t * r2 + 1.0 / 121645100408832000.0; t = t * r2 - 1.0 / 355687428096000.0; t = t * r2 + 1.0 / 1307674368000.0; t = t * r2 - 1.0 / 6227020800.0;
  t = t * r2 + 1.0 / 39916800.0; t = t * r2 - 1.0 / 362880.0; t = t * r2 + 1.0 / 5040.0; t = t * r2 - 1.0 / 120.0; t = t * r2 + 1.0 / 6.0;
  return r * (1.0 - r2 * t);
}
DI double cos_red(double r) {
  const double r2 = r * r; double t = 1.0 / 1124000727777607680000.0;
  t = t * r2 - 1.0 / 2432902008176640000.0; t = t * r2 + 1.0 / 6402373705728000.0; t = t * r2 - 1.0 / 20922789888000.0; t = t * r2 + 1.0 / 87178291200.0;
  t = t * r2 - 1.0 / 479001600.0; t = t * r2 + 1.0 / 3628800.0; t = t * r2 - 1.0 / 40320.0; t = t * r2 + 1.0 / 720.0; t = t * r2 - 1.0 / 24.0; t = t * r2 + 0.5; t = t * r2 * -1.0 + 1.0;
  return t;
}

constexpr int J_MODS = 96, J_WEFF = 64, J_CACHE = 64, J_ROPE = 1, J_SLOW = J_MODS + J_WEFF + J_CACHE + J_ROPE;
constexpr int T_ATTIN = 16 * 16, T_UQ = 4 * 6, T_UKV = 2 * 8, T_ATTOUT = 16 * 8, T_MLPIN = 16 * 32, T_MLPOUT = 64 * 8, T_CONVIN = 16 * 12, T_CONVOUT = 8 * 8;
constexpr int J_TR = T_ATTIN + T_UQ + T_UKV + T_ATTOUT + 2 * T_MLPIN + 2 * T_MLPOUT + T_CONVIN + T_CONVOUT;

struct TJ { const float* src; bf16_t* dst; int N, nvalid, lddst, perm, kt, nt; };
DI TJ tr_decode(const Params& p, int j) {
  char* ws = p.ws;
  TJ t; t.perm = 0;
  if (j < T_ATTIN) { t.src = p.w_att_in; t.N = 1952; t.nvalid = 1952; t.dst = (bf16_t*)(ws + O_WATTIN); t.lddst = 1024; t.kt = j / 16; t.nt = j % 16; return t; }
  j -= T_ATTIN;
  if (j < T_UQ) { t.src = p.w_uq; t.N = 768; t.nvalid = 768; t.dst = (bf16_t*)(ws + O_WUQ); t.lddst = 256; t.kt = j / 6; t.nt = j % 6; return t; }
  j -= T_UQ;
  if (j < T_UKV) { t.src = p.w_ukv; t.N = 1024; t.nvalid = 1024; t.dst = (bf16_t*)(ws + O_WUKV); t.lddst = 128; t.kt = j / 8; t.nt = j % 8; return t; }
  j -= T_UKV;
  if (j < T_ATTOUT) { t.src = p.w_att_out; t.N = 1024; t.nvalid = 1024; t.dst = (bf16_t*)(ws + O_WATTOUT); t.lddst = 1024; t.kt = j / 8; t.nt = j % 8; return t; }
  j -= T_ATTOUT;
  if (j < 2 * T_MLPIN) { const int l = j / T_MLPIN, u = j % T_MLPIN; t.src = p.w_mlp_in + (size_t)l * 1024 * 4096; t.N = 4096; t.nvalid = 4096; t.dst = (bf16_t*)(ws + O_WMLPIN) + (size_t)l * 4096 * 1024; t.lddst = 1024; t.kt = u / 32; t.nt = u % 32; return t; }
  j -= 2 * T_MLPIN;
  if (j < 2 * T_MLPOUT) { const int l = j / T_MLPOUT, u = j % T_MLPOUT; t.src = p.w_mlp_out + (size_t)l * 4096 * 1024; t.N = 1024; t.nvalid = 1024; t.dst = (bf16_t*)(ws + O_WMLPOUT) + (size_t)l * 4096 * 1024; t.lddst = 4096; t.kt = u / 8; t.nt = u % 8; return t; }
  j -= 2 * T_MLPOUT;
  if (j < T_CONVIN) { t.src = p.w_conv_in; t.N = 1536; t.nvalid = 1536; t.dst = (bf16_t*)(ws + O_WCONVIN); t.lddst = 1024; t.perm = 1; t.kt = j / 12; t.nt = j % 12; return t; }
  j -= T_CONVIN;
  t.src = p.w_conv_out; t.N = 1024; t.nvalid = 1024; t.dst = (bf16_t*)(ws + O_WCONVOUT); t.lddst = 1024; t.kt = j / 8; t.nt = j % 8; return t;
}
DI void tr_load(const TJ& t, float (&v)[16]) {
  const int tid = threadIdx.x, n4 = (tid & 31) * 4, kb = tid >> 5;
  const int gn = t.nt * 128 + n4;
  const float* s = t.src + (size_t)(t.kt * 64 + kb) * t.N + gn;
#pragma unroll
  for (int i = 0; i < 4; ++i) {
    f32x4 x = {0.f, 0.f, 0.f, 0.f};
    if (gn < t.nvalid) x = *(const f32x4*)(s + (size_t)(16 * i) * t.N);
    v[4 * i] = x[0]; v[4 * i + 1] = x[1]; v[4 * i + 2] = x[2]; v[4 * i + 3] = x[3];
  }
}

DI void phase0(const Params& p, char* smem) {
  const int tid = threadIdx.x, lane = tid & 63, wid = tid >> 6;
  char* ws = p.ws;
  for (int job = blockIdx.x; job < J_SLOW; job += gridDim.x) {
    int j = job;
    if (j < J_MODS) {
      const int l = j / 48, cc = j % 48;
      float* sc = (float*)smem;
      for (int i = tid; i < 3072; i += NT) { const int ci = i >> 10, k = i & 1023; const float x = ci == 0 ? p.c_ctx[k] : p.c[(ci - 1) * 1024 + k]; sc[i] = x / (1.f + __expf(-x)); }
      __syncthreads();
      const int kg = tid >> 5, c4 = (tid & 31) * 4;
      const float* w = p.w_ada + (size_t)l * 1024 * 6144 + cc * 128 + c4;
      f32x4 s0 = {0.f, 0.f, 0.f, 0.f}, s1 = s0, s2 = s0;
#pragma unroll 16
      for (int k = kg * 64; k < kg * 64 + 64; ++k) {
        const f32x4 wv = __builtin_nontemporal_load((const f32x4*)(w + (size_t)k * 6144));
        const float a = sc[k], b = sc[1024 + k], c = sc[2048 + k];
#pragma unroll
        for (int e = 0; e < 4; ++e) { s0[e] += a * wv[e]; s1[e] += b * wv[e]; s2[e] += c * wv[e]; }
      }
      f32x4* r = (f32x4*)(smem + 12288);
      r[(kg * 3 + 0) * 32 + (tid & 31)] = s0; r[(kg * 3 + 1) * 32 + (tid & 31)] = s1; r[(kg * 3 + 2) * 32 + (tid & 31)] = s2;
      __syncthreads();
      if (tid < 96) {
        const int ci = tid >> 5, q = tid & 31;
        f32x4 s = {0.f, 0.f, 0.f, 0.f};
#pragma unroll
        for (int g = 0; g < 16; ++g) { const f32x4 t4 = r[(g * 3 + ci) * 32 + q]; s[0] += t4[0]; s[1] += t4[1]; s[2] += t4[2]; s[3] += t4[3]; }
        const f32x4 bb = *(const f32x4*)(p.b_ada + l * 6144 + cc * 128 + q * 4);
        float* md = (float*)(ws + O_MODS) + (size_t)(l * 3 + ci) * 6144 + cc * 128 + q * 4;
#pragma unroll
        for (int e = 0; e < 4; ++e) __hip_atomic_store(md + e, s[e] + bb[e], __ATOMIC_RELAXED, __HIP_MEMORY_SCOPE_AGENT);
      }
      asm volatile("s_waitcnt vmcnt(0)" ::: "memory");
      __syncthreads();
      if (tid == 0) __hip_atomic_fetch_add((unsigned*)(ws + O_CNT) + 2, 1u, __ATOMIC_RELAXED, __HIP_MEMORY_SCOPE_AGENT);
      continue;
    }
    j -= J_MODS;
    if (j < J_WEFF) {
      const int g = j >> 4, cch = (j >> 1) & 7, nch = j & 1;
      float* wp = (float*)smem;
      for (int i = tid; i < 2048; i += NT) wp[i] = p.w_pool[(size_t)(g * 128 + cch * 16 + (i >> 7)) * 128 + (i & 127)];
      __syncthreads();
      const int n = nch * 512 + tid;
      float a[16];
#pragma unroll
      for (int c = 0; c < 16; ++c) a[c] = 0.f;
#pragma unroll 16
      for (int e = 0; e < 128; ++e) {
        const float wo = p.w_conv_out[(size_t)(512 + g * 128 + e) * 1024 + n] * p.pool_scale[g * 128 + e];
#pragma unroll
        for (int c = 0; c < 16; ++c) a[c] += wp[c * 128 + e] * wo;
      }
      bf16_t* d = (bf16_t*)(ws + O_WCONVOUT) + (size_t)n * 1024 + 512 + g * 128 + cch * 16;
      *(u32x4*)d = (u32x4){pack2(a[0], a[1]), pack2(a[2], a[3]), pack2(a[4], a[5]), pack2(a[6], a[7])};
      *(u32x4*)(d + 8) = (u32x4){pack2(a[8], a[9]), pack2(a[10], a[11]), pack2(a[12], a[13]), pack2(a[14], a[15])};
      __syncthreads();
      continue;
    }
    j -= J_WEFF;
    if (j < J_CACHE) {
      const int rr = j * 8 + wid, b = rr >> 8, t = rr & 255;
      const size_t kr = NCTX + (size_t)b * TKL + t;
      const f32x4 a0 = *(const f32x4*)(p.cache_k + (size_t)rr * 512 + lane * 8), a1 = *(const f32x4*)(p.cache_k + (size_t)rr * 512 + lane * 8 + 4);
      *(u32x4*)((bf16_t*)(ws + O_KD) + kr * 512 + lane * 8) = (u32x4){pack2(a0[0], a0[1]), pack2(a0[2], a0[3]), pack2(a1[0], a1[1]), pack2(a1[2], a1[3])};
      const f32x4 b0 = *(const f32x4*)(p.cache_v + (size_t)rr * 512 + lane * 8), b1 = *(const f32x4*)(p.cache_v + (size_t)rr * 512 + lane * 8 + 4);
      *(u32x4*)((bf16_t*)(ws + O_VD) + kr * 512 + lane * 8) = (u32x4){pack2(b0[0], b0[1]), pack2(b0[2], b0[3]), pack2(b1[0], b1[1]), pack2(b1[2], b1[3])};
      const f32x2 cv = *(const f32x2*)(p.cache_ckv + (size_t)rr * 128 + lane * 2);
      *(unsigned*)((bf16_t*)(ws + O_CKVN) + kr * 128 + lane * 2) = pack2(cv[0], cv[1]);
      const int idx = lane & 31;
      const float x = p.cache_krope[(size_t)rr * 32 + idx];
      const unsigned pk = pack2(x, x);
#pragma unroll
      for (int k = 0; k < 4; ++k) { const int hh = (lane >> 5) + 2 * k; ((bf16_t*)(ws + O_KMLA))[kr * 768 + hh * 96 + 64 + idx] = (bf16_t)(pk & 0xffff); }
      continue;
    }
    j -= J_CACHE;
    {
      float* c16 = (float*)(ws + O_C16); float* s16 = (float*)(ws + O_S16); float* c8 = (float*)(ws + O_C8); float* s8 = (float*)(ws + O_S8);
      for (int i = tid; i < 1024 + 512; i += NT) {
        int pos, f, half;
        if (i < 1024) { pos = i >> 4; f = i & 15; half = 16; } else { const int q = i - 1024; pos = q >> 3; f = q & 7; half = 8; }
        const float inv = (float)exp(-9.210340371976184 * (double)f / (double)half);
        const float angf = (float)pos * inv;
        const double ang = (double)angf;
        const double r = ang - 6.283185307179586 * rint(ang * 0.15915494309189535);
        const float cs = (float)cos_red(r), sn = (float)sin_red(r);
        if (i < 1024) { c16[i] = cs; s16[i] = sn; } else { c8[i - 1024] = cs; s8[i - 1024] = sn; }
      }
      if (wid == 0) {
        const float d1 = wave_sum(p.lam_q1[lane] * p.lam_k1[lane]), d2 = wave_sum(p.lam_q2[lane] * p.lam_k2[lane]);
        if (lane == 0) ((float*)(ws + O_SCAL))[0] = expf(d1) - expf(d2) + 0.2f;
      }
    }
  }
  {
    float* tile = (float*)smem;
    const int G = gridDim.x;
    int j = (blockIdx.x + G - (J_SLOW % G)) % G;
    float va[16], vb[16];
    TJ ta, tb;
    if (j < J_TR) { ta = tr_decode(p, j); tr_load(ta, va); } else ta = TJ{};
    if (j + G < J_TR) { tb = tr_decode(p, j + G); tr_load(tb, vb); } else tb = ta;
#define TR_STEP(V, T, jj_) do { \
      { const int n4 = (tid & 31) * 4, kb = tid >> 5; \
        _Pragma("unroll") for (int i = 0; i < 4; ++i) \
          _Pragma("unroll") for (int e = 0; e < 4; ++e) tile[(kb + 16 * i) * 129 + n4 + e] = V[4 * i + e]; } \
      __syncthreads(); \
      const TJ cur = T; \
      if ((jj_) + 2 * G < J_TR) { T = tr_decode(p, (jj_) + 2 * G); tr_load(T, V); }     \
      _Pragma("unroll") for (int ps = 0; ps < 2; ++ps) {     \
        const int n = ps * 64 + (tid >> 3), ks = (tid & 7) * 8; \
        int gn = cur.nt * 128 + n; \
        if (cur.perm) { if (gn < 512) gn = 32 * (gn >> 4) + (gn & 15); else if (gn < 1024) { const int c = gn - 512; gn = 32 * (c >> 4) + 16 + (c & 15); } } \
        unsigned w[4]; \
        _Pragma("unroll") for (int e = 0; e < 4; ++e) w[e] = pack2(tile[(ks + 2 * e) * 129 + n], tile[(ks + 2 * e + 1) * 129 + n]); \
        *(u32x4*)(cur.dst + (size_t)gn * cur.lddst + cur.kt * 64 + ks) = (u32x4){w[0], w[1], w[2], w[3]}; } \
      __syncthreads(); } while (0)
    while (j < J_TR) {
      TR_STEP(va, ta, j);
      j += G;
      if (j >= J_TR) break;
      TR_STEP(vb, tb, j);
      j += G;
    }
#undef TR_STEP
  }
  if (tid == 0) {
    unsigned sp = 0;
    while (__hip_atomic_load((unsigned*)(ws + O_CNT) + 2, __ATOMIC_RELAXED, __HIP_MEMORY_SCOPE_AGENT) < (unsigned)J_MODS) { __builtin_amdgcn_s_sleep(2); if (++sp > (1u << 22)) break; }
  }
  __syncthreads();
  modulate_phase(p.x_prompt, p.x_sample, (const float*)(ws + O_MODS), (bf16_t*)(ws + O_HB));
}

DI void rope8(const float (&x)[8], float (&o)[8], int lane, const float* c16, const float* s16, int prow, int pcol) {
  const int L = lane & 7;
  const int pos = (L & 4) ? pcol : prow;
  const bool second = (L & 2) != 0;
  const int fb = (L & 1) * 8;
#pragma unroll
  for (int e = 0; e < 8; ++e) {
    const float y = __shfl_xor(x[e], 2);
    const float cs = c16[pos * 16 + fb + e], sn = s16[pos * 16 + fb + e];
    o[e] = second ? (y * sn + x[e] * cs) : (x[e] * cs - y * sn);
  }
}
DI void unpack8(const u32x4 w, float (&x)[8]) {
#pragma unroll
  for (int e = 0; e < 4; ++e) { x[2 * e] = bflo(w[e]); x[2 * e + 1] = bfhi(w[e]); }
}
DI u32x4 pack8(const float (&x)[8]) { return (u32x4){pack2(x[0], x[1]), pack2(x[2], x[3]), pack2(x[4], x[5]), pack2(x[6], x[7])}; }

DI void phase3(const Params& p) {
  char* ws = p.ws;
  const bf16_t* R = (const bf16_t*)(ws + O_R);
  bf16_t* Qda = (bf16_t*)(ws + O_QDA); bf16_t* Qdb = (bf16_t*)(ws + O_QDB); bf16_t* Kd = (bf16_t*)(ws + O_KD); bf16_t* Vd = (bf16_t*)(ws + O_VD);
  bf16_t* cqn = (bf16_t*)(ws + O_CQN); bf16_t* ckvn = (bf16_t*)(ws + O_CKVN); bf16_t* Km = (bf16_t*)(ws + O_KMLA);
  const float* c16 = (const float*)(ws + O_C16); const float* s16 = (const float*)(ws + O_S16); const float* c8 = (const float*)(ws + O_C8); const float* s8 = (const float*)(ws + O_S8);
  float* o_k = p.out + (size_t)NTOK * 1024; float* o_v = o_k + (size_t)NCTX * 512; float* o_ckv = o_v + (size_t)NCTX * 512; float* o_kr = o_ckv + (size_t)NCTX * 128;
  const int lane = threadIdx.x & 63, gw = blockIdx.x * NWAVE + (threadIdx.x >> 6), nw = gridDim.x * NWAVE;
  for (int row = gw; row < NTOK; row += nw) {
    const bool lat = row >= NCTX;
    const int rl = row - NCTX, b = rl >> 12, t = rl & (TLAT - 1), prow = t >> 6, pcol = t & 63;
    const size_t kr = lat ? (size_t)NCTX + (size_t)b * TKL + 256 + t : (size_t)row;
    const bf16_t* r = R + (size_t)row * RLD;
    float x[8], o[8];
    const u32x4 wq = *(const u32x4*)(r + lane * 8);
    *(u32x4*)(Qda + (size_t)row * 512 + lane * 8) = wq;
    if (lat) { unpack8(wq, x); rope8(x, o, lane, c16, s16, prow, pcol); *(u32x4*)(Qdb + (size_t)rl * 512 + lane * 8) = pack8(o); }
    const u32x4 wk = *(const u32x4*)(r + 512 + lane * 8);
    if (lat) { unpack8(wk, x); rope8(x, o, lane, c16, s16, prow, pcol); *(u32x4*)(Kd + kr * 512 + lane * 8) = pack8(o); }
    else {
      unpack8(wk, x);
      *(f32x4*)(o_k + (size_t)row * 512 + lane * 8) = (f32x4){x[0], x[1], x[2], x[3]};
      *(f32x4*)(o_k + (size_t)row * 512 + lane * 8 + 4) = (f32x4){x[4], x[5], x[6], x[7]};
      *(u32x4*)(Kd + kr * 512 + lane * 8) = wk;
    }
    const u32x4 wv = *(const u32x4*)(r + 1024 + lane * 8);
    *(u32x4*)(Vd + kr * 512 + lane * 8) = wv;
    if (!lat) {
      unpack8(wv, x);
      *(f32x4*)(o_v + (size_t)row * 512 + lane * 8) = (f32x4){x[0], x[1], x[2], x[3]};
      *(f32x4*)(o_v + (size_t)row * 512 + lane * 8 + 4) = (f32x4){x[4], x[5], x[6], x[7]};
    }
    {
      const u32x2 w = *(const u32x2*)(r + 1536 + lane * 4);
      const float a0 = bflo(w[0]), a1 = bfhi(w[0]), a2 = bflo(w[1]), a3 = bfhi(w[1]);
      const float ss = wave_sum(a0 * a0 + a1 * a1 + a2 * a2 + a3 * a3);
      const float sc = rsqrtf(ss * (1.f / 256.f) + EPS);
      const f32x4 g = *(const f32x4*)(p.q_norm_g + lane * 4);
      *(u32x2*)(cqn + (size_t)row * 256 + lane * 4) = (u32x2){pack2(a0 * sc * g[0], a1 * sc * g[1]), pack2(a2 * sc * g[2], a3 * sc * g[3])};
    }
    {
      const unsigned w = *(const unsigned*)(r + 1792 + lane * 2);
      const float a0 = bflo(w), a1 = bfhi(w);
      const float ss = wave_sum(a0 * a0 + a1 * a1);
      const float sc = rsqrtf(ss * (1.f / 128.f) + EPS);
      const f32x2 g = *(const f32x2*)(p.kv_norm_g + lane * 2);
      const float y0 = a0 * sc * g[0], y1 = a1 * sc * g[1];
      if (!lat) *(f32x2*)(o_ckv + (size_t)row * 128 + lane * 2) = (f32x2){y0, y1};
      *(unsigned*)(ckvn + kr * 128 + lane * 2) = pack2(y0, y1);
    }
    {
      const int idx = lane & 31;
      const float xv = bf2f(r[1920 + idx]);
      float ov = xv;
      if (lat) {
        const int pos = (idx & 16) ? pcol : prow;
        const int f = idx & 7;
        const float y = __shfl_xor(xv, 8);
        const float cs = c8[pos * 8 + f], sn = s8[pos * 8 + f];
        ov = (idx & 8) ? (y * sn + xv * cs) : (xv * cs - y * sn);
      } else if (lane < 32) o_kr[(size_t)row * 32 + idx] = xv;
      const bf16_t ob = (bf16_t)(pack2(ov, ov) & 0xffff);
#pragma unroll
      for (int k = 0; k < 4; ++k) { const int hh = (lane >> 5) + 2 * k; Km[kr * 768 + hh * 96 + 64 + idx] = ob; }
    }
  }
}

template <int DQK, int DV>
DI void attn_core(const bf16_t* __restrict__ Qa, const bf16_t* __restrict__ Qb, int ldq, const bf16_t* __restrict__ Kp, int ldk, const bf16_t* __restrict__ Vp, int ldv,
                  int Tk, int n_a, float c  , char* smem, f32x16 (&o)[DV / 32]) {
  constexpr int KS = DQK * 2 + 16, VS = DV * 2 + 64, BUF = 64 * (KS + VS);
  constexpr int KCH = DQK / 8, VCH = DV / 8, NKCH = 64 * KCH, NVCH = 64 * VCH, NKC = (NKCH + NT - 1) / NT, NVC = (NVCH + NT - 1) / NT;
  constexpr bool KG = (NKCH % NT) != 0, VG = (NVCH % NT) != 0;
  constexpr int NS = DQK / 16, NDT = DV / 32;
  const int tid = threadIdx.x, lane = tid & 63, wid = tid >> 6, h = lane >> 5, ql = lane & 31;
  bf16x8 qf[NS];
  {
    const bf16_t* q = Qa + (size_t)(wid * 32 + ql) * ldq + h * 8;
#pragma unroll
    for (int s = 0; s < NS; ++s) qf[s] = *(const bf16x8*)(q + s * 16);
  }
#pragma unroll
  for (int dt = 0; dt < NDT; ++dt)
#pragma unroll
    for (int r = 0; r < 16; ++r) o[dt][r] = 0.f;
  float m_run = -INFINITY, l_run = 0.f;
  u32x4 rkA[NKC], rvA[NVC], rkB[NKC], rvB[NVC];
  const int nt = Tk >> 6, ta = n_a >> 6;
  unsigned koff[NKC], voff[NVC];
#pragma unroll
  for (int i = 0; i < NKC; ++i) { const int ch = (tid + NT * i) % NKCH, row = ch / KCH, kc = ch % KCH; koff[i] = (unsigned)(row * ldk + kc * 8); }
#pragma unroll
  for (int i = 0; i < NVC; ++i) { const int ch = (tid + NT * i) % NVCH, row = ch / VCH, vc = ch % VCH; voff[i] = (unsigned)(row * ldv + vc * 8); }
  auto gload = [&](u32x4 (&rk)[NKC], u32x4 (&rv)[NVC], int t) {
    const bf16_t* kb = Kp + (size_t)t * 64 * ldk;
    const bf16_t* vbp = Vp + (size_t)t * 64 * ldv;
#pragma unroll
    for (int i = 0; i < NKC; ++i) rk[i] = *(const u32x4*)(kb + koff[i]);
#pragma unroll
    for (int i = 0; i < NVC; ++i) rv[i] = *(const u32x4*)(vbp + voff[i]);
  };
  auto lstore = [&](u32x4 (&rk)[NKC], u32x4 (&rv)[NVC], char* buf) {
#pragma unroll
    for (int i = 0; i < NKC; ++i) { const int ch = tid + NT * i, row = ch / KCH, kc = ch % KCH; if (!KG || i + 1 < NKC || ch < NKCH) *(u32x4*)(buf + row * KS + kc * 16) = rk[i]; }
#pragma unroll
    for (int i = 0; i < NVC; ++i) { const int ch = tid + NT * i, row = ch / VCH, vc = ch % VCH; if (!VG || i + 1 < NVC || ch < NVCH) *(u32x4*)(buf + 64 * KS + row * VS + vc * 16) = rv[i]; }
  };
  gload(rkA, rvA, 0); lstore(rkA, rvA, smem); lds_barrier();
  gload(rkA, rvA, min(1, nt - 1));
  const int i16 = lane & 15, tq = i16 >> 2, tp = i16 & 3, G = (lane >> 4) & 1;
  auto compute = [&](const char* cur) {
    f32x16 st[2];
    bf16x8 kf[2][NS];
#pragma unroll
    for (int kt = 0; kt < 2; ++kt)
#pragma unroll
      for (int s = 0; s < NS; ++s) kf[kt][s] = *(const bf16x8*)(cur + (kt * 32 + ql) * KS + s * 32 + h * 16);
#pragma unroll
    for (int kt = 0; kt < 2; ++kt) {
#pragma unroll
      for (int r = 0; r < 16; ++r) st[kt][r] = 0.f;
#pragma unroll
      for (int s = 0; s < NS; ++s) st[kt] = __builtin_amdgcn_mfma_f32_32x32x16_bf16(kf[kt][s], qf[s], st[kt], 0, 0, 0);
    }
    __builtin_amdgcn_sched_barrier(0);
    float mx = st[0][0];
#pragma unroll
    for (int kt = 0; kt < 2; ++kt)
#pragma unroll
      for (int r = 0; r < 16; ++r) mx = fmaxf(mx, st[kt][r]);
    mx = fmaxf(mx, __shfl_xor(mx, 32));
    const float m_new = fmaxf(m_run, mx);
    const float alpha = __builtin_amdgcn_exp2f((m_run - m_new) * c);
    const float mc = m_new * c;
    m_run = m_new;
    f32x2 ls2 = {0.f, 0.f};
#pragma unroll
    for (int kt = 0; kt < 2; ++kt) {
      const f32x16 tv = st[kt] * c - mc;
#pragma unroll
      for (int r = 0; r < 16; r += 2) {
        const f32x2 pv = {__builtin_amdgcn_exp2f(tv[r]), __builtin_amdgcn_exp2f(tv[r + 1])};
        st[kt][r] = pv[0]; st[kt][r + 1] = pv[1];
        ls2 += pv;
      }
    }
    l_run = l_run * alpha + (ls2[0] + ls2[1]);
    if (__any(alpha != 1.f)) {
#pragma unroll
      for (int dt = 0; dt < NDT; ++dt)
#pragma unroll
        for (int r = 0; r < 16; ++r) o[dt][r] *= alpha;
    }
    bf16x8 pf[2][2];
#pragma unroll
    for (int kt = 0; kt < 2; ++kt)
#pragma unroll
      for (int s2 = 0; s2 < 2; ++s2) {
        u32x4 w = {pack2(st[kt][8 * s2 + 0], st[kt][8 * s2 + 1]), pack2(st[kt][8 * s2 + 2], st[kt][8 * s2 + 3]), pack2(st[kt][8 * s2 + 4], st[kt][8 * s2 + 5]), pack2(st[kt][8 * s2 + 6], st[kt][8 * s2 + 7])};
        pf[kt][s2] = __builtin_bit_cast(bf16x8, w);
      }
    const char* vb = cur + 64 * KS + (4 * h + tq) * VS + 32 * G + 8 * tp;
    bf16x8 vfa[NDT], vfb[NDT];
#define A_VLOAD(VF, g_) do { \
      _Pragma("unroll") for (int dt = 0; dt < NDT; ++dt) { \
        const char* a0 = vb + (((g_) >> 1) * 32 + 16 * ((g_) & 1)) * VS + dt * 64; \
        const s16x4 lo = __builtin_amdgcn_ds_read_tr16_b64_v4i16((LDS_AS s16x4*)(a0)); \
        const s16x4 hi = __builtin_amdgcn_ds_read_tr16_b64_v4i16((LDS_AS s16x4*)(a0 + 8 * VS)); \
        VF[dt] = __builtin_shufflevector(lo, hi, 0, 1, 2, 3, 4, 5, 6, 7); } } while (0)
#define A_VMMA(VF, g_) do { \
      _Pragma("unroll") for (int dt = 0; dt < NDT; ++dt) o[dt] = __builtin_amdgcn_mfma_f32_32x32x16_bf16(VF[dt], pf[(g_) >> 1][(g_) & 1], o[dt], 0, 0, 0); } while (0)
    A_VLOAD(vfa, 0);
    A_VLOAD(vfb, 1);
    __builtin_amdgcn_sched_barrier(0);
    A_VMMA(vfa, 0);
    __builtin_amdgcn_sched_barrier(0);
    A_VLOAD(vfa, 2);
    __builtin_amdgcn_sched_barrier(0);
    A_VMMA(vfb, 1);
    __builtin_amdgcn_sched_barrier(0);
    A_VLOAD(vfb, 3);
    __builtin_amdgcn_sched_barrier(0);
    A_VMMA(vfa, 2);
    __builtin_amdgcn_sched_barrier(0);
    A_VMMA(vfb, 3);
#undef A_VLOAD
#undef A_VMMA
  };
  auto run_tiles = [&](int t_begin, int t_end) {
    for (int t = t_begin; t < t_end; t += 2) {
      gload(rkB, rvB, min(t + 2, nt - 1));
      compute(smem);
      lstore(rkA, rvA, smem + BUF);
      lds_barrier();
      gload(rkA, rvA, min(t + 3, nt - 1));
      compute(smem + BUF);
      lstore(rkB, rvB, smem);
      lds_barrier();
    }
  };
  if (wid >= 4) __builtin_amdgcn_s_setprio(1);
  run_tiles(0, min(ta, nt));
  if (ta < nt) {
    const bf16_t* q = Qb + (size_t)(wid * 32 + ql) * ldq + h * 8;
#pragma unroll
    for (int s = 0; s < NS; ++s) qf[s] = *(const bf16x8*)(q + s * 16);
    run_tiles(ta, nt);
  }
  __builtin_amdgcn_s_setprio(0);
  const float l = l_run + __shfl_xor(l_run, 32);
  const float inv = 1.f / l;
#pragma unroll
  for (int dt = 0; dt < NDT; ++dt)
#pragma unroll
    for (int r = 0; r < 16; ++r) o[dt][r] *= inv;
}

constexpr int U_DBIG = 128, U_MBIG = 256, U_DCTX = 64, U_MCTX = 128, U_TOTAL = U_DBIG + U_MBIG + U_DCTX + U_MCTX;

DI void phase_attn(const Params& p, char* smem, int cidx) {
  char* ws = p.ws;
  const bf16_t* Qda = (const bf16_t*)(ws + O_QDA); const bf16_t* Qdb = (const bf16_t*)(ws + O_QDB); const bf16_t* Kd = (const bf16_t*)(ws + O_KD); const bf16_t* Vd = (const bf16_t*)(ws + O_VD);
  const bf16_t* Qma = (const bf16_t*)(ws + O_QMA); const bf16_t* Qmb = (const bf16_t*)(ws + O_QMB); const bf16_t* Km = (const bf16_t*)(ws + O_KMLA); const bf16_t* Vm = (const bf16_t*)(ws + O_VMLA);
  bf16_t* cat = (bf16_t*)(ws + O_HB);
  float* otmp = (float*)(ws + O_OTMP) + (size_t)blockIdx.x * 32768;
  int* counter = (int*)(ws + O_CNT) + cidx;
  int* s_unit = (int*)(smem + 65532);
  const int tid = threadIdx.x, lane = tid & 63, wid = tid >> 6, h2 = lane >> 5, ql = lane & 31;
  const float lam = ((const float*)(ws + O_SCAL))[0];
  for (;;) {
    if (tid == 0) *s_unit = atomicAdd(counter, 1);
    __syncthreads();
    int u = __builtin_amdgcn_readfirstlane(*s_unit);
    __syncthreads();
    if (u >= U_TOTAL) break;
    bool diff; int qrow0, krow0, Tk, n_a, head; bool lat;
    if (u < U_DBIG) { diff = true; lat = true; const int b = u >> 6, hh = (u >> 4) & 3, qb = u & 15; head = hh; qrow0 = NCTX + b * TLAT + qb * 256; krow0 = NCTX + b * TKL; Tk = TKL; n_a = 256; }
    else if (u < U_DBIG + U_MBIG) { u -= U_DBIG; diff = false; lat = true; const int b = u >> 7, hh = (u >> 4) & 7, qb = u & 15; head = hh; qrow0 = NCTX + b * TLAT + qb * 256; krow0 = NCTX + b * TKL; Tk = TKL; n_a = 256; }
    else if (u < U_DBIG + U_MBIG + U_DCTX) { u -= U_DBIG + U_MBIG; diff = true; lat = false; const int sq = u >> 2, hh = u & 3; head = hh; qrow0 = sq * 256; krow0 = sq * 256; Tk = 256; n_a = 256; }
    else { u -= U_DBIG + U_MBIG + U_DCTX; diff = false; lat = false; const int sq = u >> 3, hh = u & 7; head = hh; qrow0 = sq * 256; krow0 = sq * 256; Tk = 256; n_a = 256; }
    const int qrowb = lat ? qrow0 - NCTX : 0;
    if (diff) {
      f32x16 o[4];
      const float c = 0.125f * 1.4426950408889634f;
#pragma unroll 1
      for (int m = 0; m < 2; ++m) {
        attn_core<64, 128>(Qda + (size_t)qrow0 * 512 + head * 128 + m * 64, Qdb + (size_t)qrowb * 512 + head * 128 + m * 64, 512,
                           Kd + (size_t)krow0 * 512 + head * 128 + m * 64, 512, Vd + (size_t)krow0 * 512 + head * 128, 512, Tk, n_a, c, smem, o);
        if (m == 0) {
#pragma unroll
          for (int dt = 0; dt < 4; ++dt)
#pragma unroll
            for (int rq = 0; rq < 4; ++rq) *(f32x4*)(otmp + tid * 64 + dt * 16 + rq * 4) = (f32x4){o[dt][4 * rq], o[dt][4 * rq + 1], o[dt][4 * rq + 2], o[dt][4 * rq + 3]};
        }
      }
      float ss = 0.f;
#pragma unroll
      for (int dt = 0; dt < 4; ++dt)
#pragma unroll
        for (int rq = 0; rq < 4; ++rq) {
          const f32x4 o0 = *(const f32x4*)(otmp + tid * 64 + dt * 16 + rq * 4);
#pragma unroll
          for (int e = 0; e < 4; ++e) { const float v = o0[e] - lam * o[dt][4 * rq + e]; o[dt][4 * rq + e] = v; ss += v * v; }
        }
      ss += __shfl_xor(ss, 32);
      const float sc = rsqrtf(ss * (1.f / 128.f) + EPS) * 0.8f;
      bf16_t* dst = cat + (size_t)(qrow0 + wid * 32 + ql) * 1024 + head * 128;
#pragma unroll
      for (int dt = 0; dt < 4; ++dt)
#pragma unroll
        for (int rq = 0; rq < 4; ++rq) {
          const int dv = dt * 32 + 8 * rq + 4 * h2;
          const f32x4 g = *(const f32x4*)(p.diff_norm_g + dv);
          u32x2 w = {pack2(o[dt][4 * rq] * sc * g[0], o[dt][4 * rq + 1] * sc * g[1]), pack2(o[dt][4 * rq + 2] * sc * g[2], o[dt][4 * rq + 3] * sc * g[3])};
          *(u32x2*)(dst + dv) = w;
        }
    } else {
      f32x16 o[2];
      const float c = 0.10206207261596575f * 1.4426950408889634f;
      attn_core<96, 64>(Qma + (size_t)qrow0 * 768 + head * 96, Qmb + (size_t)qrowb * 768 + head * 96, 768,
                        Km + (size_t)krow0 * 768 + head * 96, 768, Vm + (size_t)krow0 * 512 + head * 64, 512, Tk, n_a, c, smem, o);
      bf16_t* dst = cat + (size_t)(qrow0 + wid * 32 + ql) * 1024 + 512 + head * 64;
#pragma unroll
      for (int dt = 0; dt < 2; ++dt)
#pragma unroll
        for (int rq = 0; rq < 4; ++rq) {
          const int dv = dt * 32 + 8 * rq + 4 * h2;
          u32x2 w = {pack2(o[dt][4 * rq], o[dt][4 * rq + 1]), pack2(o[dt][4 * rq + 2], o[dt][4 * rq + 3])};
          *(u32x2*)(dst + dv) = w;
        }
    }
  }
}

DI void unpack8f(const u32x4 w, float (&x)[8]) {
#pragma unroll
  for (int e = 0; e < 4; ++e) { x[2 * e] = bflo(w[e]); x[2 * e + 1] = bfhi(w[e]); }
}
DI void phase_conv(const Params& p, char* smem) {
  constexpr int TT = 8;
  char* ws = p.ws;
  const bf16_t* Ug = (const bf16_t*)(ws + O_UG); const bf16_t* Pz = (const bf16_t*)(ws + O_PZ);
  bf16_t* cat = (bf16_t*)(ws + O_HB);
  const int tid = threadIdx.x, lane = tid & 63, wid = tid >> 6;
  float* wl = (float*)smem;
  {
    f32x4 wv[8];
#pragma unroll
    for (int k = 0; k < 8; ++k) { const int i4 = tid + NT * k; wv[k] = (f32x4){0.f, 0.f, 0.f, 0.f}; if (i4 < 31 * 128) wv[k] = *(const f32x4*)(p.conv_w + i4 * 4); }
#pragma unroll
    for (int k = 0; k < 8; ++k) {
      const int i4 = tid + NT * k, j = i4 >> 7, c = (i4 & 127) * 4, lc = c >> 3, hf = (c >> 2) & 1;
      if (i4 < 31 * 128) *(f32x4*)(wl + ((j * 2 + hf) * 64 + lc) * 4) = wv[k];
    }
  }
  __syncthreads();
  const int c0 = lane * 8;
  const int grp = lane >> 4, HW = 1 << grp;
  for (int u = blockIdx.x * NWAVE + wid; u < NTOK / TT; u += gridDim.x * NWAVE) {
    const int t0 = u * TT;
    const int s0 = t0 < NCTX ? (t0 & ~255) : NCTX + ((t0 - NCTX) & ~(TLAT - 1));
    const int s1 = t0 < NCTX ? s0 + 256 : s0 + TLAT;
    {
      u32x4 pr[TT + 16];
#pragma unroll
      for (int i = 0; i < TT + 16; ++i) {
        const int r = t0 - 8 + i;
        pr[i] = (u32x4){0u, 0u, 0u, 0u};
        if (r >= s0 && r < s1) pr[i] = *(const u32x4*)(Pz + (size_t)r * 512 + c0);
      }
#pragma unroll
      for (int o = 0; o < TT; ++o) {
        const int r = t0 + o, ci = o + 8;
        float s[8], x[8], ctr[8], s2[8], s4[8], s8[8];
        unpack8f(pr[ci], ctr);
        unpack8f(pr[ci - 1], x);
#pragma unroll
        for (int e = 0; e < 8; ++e) { s[e] = x[e] + ctr[e]; s2[e] = s[e]; }
#pragma unroll
        for (int d = 0; d < 2; ++d) { unpack8f(pr[d == 0 ? ci - 2 : ci + 1], x);
#pragma unroll
          for (int e = 0; e < 8; ++e) s[e] += x[e]; }
#pragma unroll
        for (int e = 0; e < 8; ++e) s4[e] = s[e];
#pragma unroll
        for (int d = 0; d < 4; ++d) { unpack8f(pr[d < 2 ? ci - 4 + d : ci + d], x);
#pragma unroll
          for (int e = 0; e < 8; ++e) s[e] += x[e]; }
#pragma unroll
        for (int e = 0; e < 8; ++e) s8[e] = s[e];
#pragma unroll
        for (int d = 0; d < 8; ++d) { unpack8f(pr[d < 4 ? ci - 8 + d : ci + d], x);
#pragma unroll
          for (int e = 0; e < 8; ++e) s[e] += x[e]; }
        const int lo = max(r - HW, s0), hi = min(r + HW - 1, s1 - 1);
        const float ic = 1.f / (float)(hi - lo + 1);
        float dv[8];
#pragma unroll
        for (int e = 0; e < 8; ++e) { const float sm = grp == 0 ? s2[e] : grp == 1 ? s4[e] : grp == 2 ? s8[e] : s[e]; dv[e] = sm * ic - ctr[e]; }
        *(u32x4*)(cat + (size_t)r * 1024 + 512 + c0) = (u32x4){pack2(dv[0], dv[1]), pack2(dv[2], dv[3]), pack2(dv[4], dv[5]), pack2(dv[6], dv[7])};
      }
    }
    f32x2 acc2[TT][4];
#pragma unroll
    for (int o = 0; o < TT; ++o)
#pragma unroll
      for (int e = 0; e < 4; ++e) acc2[o][e] = (f32x2){0.f, 0.f};
    u32x4 q0, q1, q2, q3;
#define CV_ROW(i_) ({ const int r_ = t0 - 15 + (i_); u32x4 v_ = {0u, 0u, 0u, 0u}; if ((i_) < TT + 30 && r_ >= s0 && r_ < s1) v_ = *(const u32x4*)(Ug + (size_t)r_ * 512 + c0); v_; })
    q0 = CV_ROW(0); q1 = CV_ROW(1); q2 = CV_ROW(2); q3 = CV_ROW(3);
#pragma unroll 1
    for (int i = 0; i < TT + 30; ++i) {
      const u32x4 w = q0;
      q0 = q1; q1 = q2; q2 = q3; q3 = CV_ROW(i + 4);
      f32x2 x2[4];
#pragma unroll
      for (int e = 0; e < 4; ++e) x2[e] = (f32x2){bflo(w[e]), bfhi(w[e])};
#pragma unroll
      for (int o = 0; o < TT; ++o) {
        const int j = i - o;
        if ((unsigned)j <= 30u) {
          const f32x4 w0 = *(const f32x4*)(wl + ((j * 2 + 0) * 64 + lane) * 4), w1 = *(const f32x4*)(wl + ((j * 2 + 1) * 64 + lane) * 4);
          acc2[o][0] += x2[0] * (f32x2){w0[0], w0[1]}; acc2[o][1] += x2[1] * (f32x2){w0[2], w0[3]};
          acc2[o][2] += x2[2] * (f32x2){w1[0], w1[1]}; acc2[o][3] += x2[3] * (f32x2){w1[2], w1[3]};
        }
      }
    }
#undef CV_ROW
    const f32x4 bias0 = *(const f32x4*)(p.conv_b + c0), bias1 = *(const f32x4*)(p.conv_b + c0 + 4);
    const f32x4 g0 = *(const f32x4*)(p.conv_norm_g + c0), g1 = *(const f32x4*)(p.conv_norm_g + c0 + 4);
    const f32x4 b0 = *(const f32x4*)(p.conv_norm_b + c0), b1 = *(const f32x4*)(p.conv_norm_b + c0 + 4);
#pragma unroll
    for (int o = 0; o < TT; ++o) {
      float v[8];
#pragma unroll
      for (int e = 0; e < 4; ++e) { v[e] = acc2[o][e >> 1][e & 1] + bias0[e]; v[4 + e] = acc2[o][2 + (e >> 1)][e & 1] + bias1[e]; }
      float sm = 0.f;
#pragma unroll
      for (int e = 0; e < 8; ++e) sm += v[e];
      const float mean = wave_sum(sm) * (1.f / 512.f);
      float q = 0.f;
#pragma unroll
      for (int e = 0; e < 8; ++e) { const float d = v[e] - mean; q += d * d; }
      const float rstd = rsqrtf(wave_sum(q) * (1.f / 512.f) + EPS);
      float y[8];
#pragma unroll
      for (int e = 0; e < 4; ++e) {
        const float z0 = (v[e] - mean) * rstd * g0[e] + b0[e], z1 = (v[4 + e] - mean) * rstd * g1[e] + b1[e];
        y[e] = z0 / (1.f + __expf(-z0)); y[4 + e] = z1 / (1.f + __expf(-z1));
      }
      *(u32x4*)(cat + (size_t)(t0 + o) * 1024 + c0) = (u32x4){pack2(y[0], y[1]), pack2(y[2], y[3]), pack2(y[4], y[5]), pack2(y[6], y[7])};
    }
  }
  __syncthreads();
}

__global__ void __launch_bounds__(NT, 2) fwd_kernel(Params p, int ph_lo, int ph_hi) {
  __shared__ __attribute__((aligned(16))) char smem[2 * G_STAGE + 12288];
  __shared__ uint4 xb_words;
  cg::grid_group grid = cg::this_grid();
  char* ws = p.ws;
  if (threadIdx.x == 0) xb_words = make_uint4(0u, 0u, 0u, 0u);
  __syncthreads();
  const XcdBarrier xb = xcd_barrier_post((unsigned*)(ws + O_BAR), (volatile LDS_AS unsigned*)&xb_words);
  if (ph_lo > 1000) grid.sync();
  float* mods = (float*)(ws + O_MODS);
  bf16_t* Hb = (bf16_t*)(ws + O_HB);
  float* X = p.out;
  float* xbuf = (float*)(ws + O_XBUF);
  unsigned* lncnt = (unsigned*)(ws + O_LNCNT);
  const bool fused = (gridDim.x == 256);
#define GSYNC() xcd_barrier(xb)
#define PH_BEGIN(n) if (ph_lo <= n && n < ph_hi) { if (n > ph_lo) GSYNC();
#define PH_BEGIN_IF(n, c) if (ph_lo <= n && n < ph_hi && (c)) { if (n > ph_lo) GSYNC();
#define PH_END }
#ifndef PROBE_DUP
#define PROBE_DUP 0
#endif
#ifndef PROBE_SYNCS
#define PROBE_SYNCS 0
#endif
#define DUP(n, ...) __VA_ARGS__; if ((PROBE_DUP >> n) & 1) { GSYNC(); __VA_ARGS__; }
  for (int i = 0; i < PROBE_SYNCS; ++i) GSYNC();
  PH_BEGIN(0) { DUP(0, phase0(p, smem)); } PH_END
  PH_BEGIN(2) {
    float* o_k = p.out + (size_t)NTOK * 1024; float* o_v = o_k + (size_t)NCTX * 512; float* o_ckv = o_v + (size_t)NCTX * 512; float* o_kr = o_ckv + (size_t)NCTX * 128;
    DUP(2, gemm_phase(Hb, 1024, (const bf16_t*)(ws + O_WATTIN), 1024, 1024, 64, 8,
                      EpiAttIn{(bf16_t*)(ws + O_QDA), (bf16_t*)(ws + O_QDB), (bf16_t*)(ws + O_KD), (bf16_t*)(ws + O_VD), (bf16_t*)(ws + O_CQN), (bf16_t*)(ws + O_CKVN), (bf16_t*)(ws + O_KMLA),
                               o_k, o_v, o_ckv, o_kr, (const float*)(ws + O_C16), (const float*)(ws + O_S16), (const float*)(ws + O_C8), (const float*)(ws + O_S8), p.q_norm_g, p.kv_norm_g, smem + 2 * G_STAGE}, smem));
  } PH_END
  PH_BEGIN(4) {
        const int n1 = 64 * 3, n2 = 67 * 4;
        gemm_phase((const bf16_t*)(ws + O_CQN), 256, (const bf16_t*)(ws + O_WUQ), 256, 256, 64, 3,
                   EpiUq{(bf16_t*)(ws + O_QMA), (bf16_t*)(ws + O_QMB), (const float*)(ws + O_C8), (const float*)(ws + O_S8)}, smem, 0, n1 + n2);
        gemm_phase((const bf16_t*)(ws + O_CKVN), 128, (const bf16_t*)(ws + O_WUKV), 128, 128, 67, 4,
                   EpiUkv{(bf16_t*)(ws + O_KMLA), (bf16_t*)(ws + O_VMLA), smem}, smem, n1, n1 + n2);
  } PH_END
  PH_BEGIN(5) { phase_attn(p, smem, 0); if ((PROBE_DUP >> 5) & 1) { GSYNC(); phase_attn(p, smem, 1); } } PH_END
  PH_BEGIN(6) { gemm_phase(Hb, 1024, (const bf16_t*)(ws + O_WATTOUT), 1024, 1024, 64, 4, EpiResLN{p.x_prompt, p.x_sample, mods + 2048, X, p.ln_mix_g, p.ln_mix_b, mods, 3072, 4096, Hb, xbuf, lncnt, smem + 2 * G_STAGE, fused}, smem); } PH_END
  PH_BEGIN_IF(7, !fused) { rows_phase(X, X + (size_t)NCTX * 1024, true, p.ln_mix_g, p.ln_mix_b, X, mods, 3072, 4096, Hb); } PH_END
  PH_BEGIN(8) { DUP(8, gemm_phase(Hb, 1024, (const bf16_t*)(ws + O_WMLPIN), 1024, 1024, 64, 16, EpiRelu2{(bf16_t*)(ws + O_U), smem + G_STAGE}, smem)); } PH_END
  PH_BEGIN(9) { gemm_phase((const bf16_t*)(ws + O_U), 4096, (const bf16_t*)(ws + O_WMLPOUT), 4096, 4096, 64, 4, EpiResLN{X, X + (size_t)NCTX * 1024, mods + 5120, X, p.ln_mlp_g, p.ln_mlp_b, mods + 3 * 6144, 0, 1024, Hb, xbuf + 98304, lncnt + 64, smem + 2 * G_STAGE, fused}, smem); } PH_END
  PH_BEGIN_IF(10, !fused) { rows_phase(X, X + (size_t)NCTX * 1024, true, p.ln_mlp_g, p.ln_mlp_b, X, mods + 3 * 6144, 0, 1024, Hb); } PH_END
  PH_BEGIN(11) { DUP(11, gemm_phase(Hb, 1024, (const bf16_t*)(ws + O_WCONVIN), 1024, 1024, 64, 6, EpiConv{(bf16_t*)(ws + O_UG), (bf16_t*)(ws + O_PZ), smem}, smem)); } PH_END
  PH_BEGIN(12) { DUP(12, phase_conv(p, smem)); } PH_END
  PH_BEGIN(13) { gemm_phase(Hb, 1024, (const bf16_t*)(ws + O_WCONVOUT), 1024, 1024, 64, 4, EpiResLN{X, X + (size_t)NCTX * 1024, mods + 3 * 6144 + 2048, X, p.ln_mix_g + 1024, p.ln_mix_b + 1024, mods + 3 * 6144, 3072, 4096, Hb, xbuf + 2 * 98304, lncnt + 128, smem + 2 * G_STAGE, fused}, smem); } PH_END
  PH_BEGIN_IF(14, !fused) { rows_phase(X, X + (size_t)NCTX * 1024, true, p.ln_mix_g + 1024, p.ln_mix_b + 1024, X, mods + 3 * 6144, 3072, 4096, Hb); } PH_END
  PH_BEGIN(15) { DUP(15, gemm_phase(Hb, 1024, (const bf16_t*)(ws + O_WMLPIN) + (size_t)4096 * 1024, 1024, 1024, 64, 16, EpiRelu2{(bf16_t*)(ws + O_U), smem + G_STAGE}, smem)); } PH_END
  PH_BEGIN(16) { gemm_phase((const bf16_t*)(ws + O_U), 4096, (const bf16_t*)(ws + O_WMLPOUT) + (size_t)4096 * 1024, 4096, 4096, 64, 4, EpiResLN{X, X + (size_t)NCTX * 1024, mods + 3 * 6144 + 5120, X, p.ln_mlp_g + 1024, p.ln_mlp_b + 1024, mods, 0, 0, nullptr, xbuf + 3 * 98304, lncnt + 192, smem + 2 * G_STAGE, fused}, smem); } PH_END
  PH_BEGIN_IF(17, !fused) { rows_phase(X, X + (size_t)NCTX * 1024, true, p.ln_mlp_g + 1024, p.ln_mlp_b + 1024, X, nullptr, 0, 0, nullptr); } PH_END
}

extern "C" void kernel_launch(void* const* d_in, const int* in_sizes, int n_in, void* d_out, int out_size, void* d_ws, size_t ws_size, hipStream_t stream) {
  static int grid_blocks = 0;
  if (!grid_blocks) {
    int dev = 0, cus = 0, per_cu = 0;
    hipGetDevice(&dev);
    hipDeviceGetAttribute(&cus, hipDeviceAttributeMultiprocessorCount, dev);
    hipOccupancyMaxActiveBlocksPerMultiprocessor(&per_cu, fwd_kernel, NT, 0);
    if (per_cu > 1) per_cu = 1;
    if (per_cu < 1) per_cu = 1;
    grid_blocks = cus * per_cu;
    if (grid_blocks > 256) grid_blocks = 256;
  }
  if (ws_size < WS_NEED) { fprintf(stderr, "workspace too small: %zu < %zu\n", ws_size, (size_t)WS_NEED); return; }
  Params p{};
  const float** f = (const float**)&p;
  for (int i = 0; i < 35; ++i) f[i] = (const float*)d_in[i];
  p.out = (float*)d_out;
  p.ws = (char*)d_ws;
  hipMemsetAsync(d_ws, 0, 16384, stream);
  int lo = 0, hi = NPHASE;
  void* args[] = {&p, &lo, &hi};
  hipError_t e = hipLaunchCooperativeKernel((void*)fwd_kernel, dim3(grid_blocks), dim3(NT), args, 0, stream);
  if (e != hipSuccess) fprintf(stderr, "cooperative launch failed: %s (grid %d)\n", hipGetErrorString(e), grid_blocks);
}
```

```cpp
#include <hip/hip_runtime.h>
#include <hip/hip_cooperative_groups.h>
#include <cstdio>
#include <cstdint>
namespace cg = cooperative_groups;

typedef unsigned short bf16_t;
typedef short bf16x8 __attribute__((ext_vector_type(8)));
typedef short s16x4 __attribute__((ext_vector_type(4)));
typedef float f32x4 __attribute__((ext_vector_type(4)));
typedef float f32x2 __attribute__((ext_vector_type(2)));
typedef float f32x16 __attribute__((ext_vector_type(16)));
typedef unsigned u32x4 __attribute__((ext_vector_type(4)));
typedef unsigned u32x2 __attribute__((ext_vector_type(2)));
typedef __bf16 bf16v2 __attribute__((ext_vector_type(2)));
#define DI __device__ __forceinline__
#define LDS_AS __attribute__((address_space(3)))

constexpr int NTOK = 12288, NCTX = 4096, NKEY = 12800, TLAT = 4096, TKL = 4352;
constexpr int RLD = 1952;
constexpr float ALPHA = 1.41421356237f, EPS = 1e-5f;
constexpr int NPHASE = 18;
constexpr int NT = 512, NWAVE = 8;

constexpr size_t al(size_t x) { return (x + 255) & ~(size_t)255; }
constexpr size_t O_CNT = 0;
constexpr size_t O_BAR = 256;
constexpr size_t O_LNCNT = 14336;
constexpr size_t O_MODS = 16384;
constexpr size_t O_SCAL = O_MODS + al(2 * 3 * 6144 * 4);
constexpr size_t O_C16 = O_SCAL + 256;
constexpr size_t O_S16 = O_C16 + 4096;
constexpr size_t O_C8 = O_S16 + 4096;
constexpr size_t O_S8 = O_C8 + 2048;
constexpr size_t O_XBUF = O_S8 + 2048;
constexpr size_t O_WATTIN = O_XBUF + (size_t)4 * 256 * 192 * 2 * 4;
constexpr size_t O_WUQ = O_WATTIN + (size_t)2048 * 1024 * 2;
constexpr size_t O_WUKV = O_WUQ + (size_t)768 * 256 * 2;
constexpr size_t O_WATTOUT = O_WUKV + (size_t)1024 * 128 * 2;
constexpr size_t O_WMLPIN = O_WATTOUT + (size_t)1024 * 1024 * 2;
constexpr size_t O_WMLPOUT = O_WMLPIN + (size_t)2 * 4096 * 1024 * 2;
constexpr size_t O_WCONVIN = O_WMLPOUT + (size_t)2 * 4096 * 1024 * 2;
constexpr size_t O_WCONVOUT = O_WCONVIN + (size_t)1536 * 1024 * 2;
constexpr size_t O_HB = O_WCONVOUT + (size_t)1024 * 1024 * 2;
constexpr size_t O_BIG = O_HB + (size_t)NTOK * 1024 * 2;
constexpr size_t O_R = O_BIG;
constexpr size_t O_QMA = O_R;
constexpr size_t O_QMB = O_QMA + (size_t)NTOK * 768 * 2;
constexpr size_t O_QDA = O_R + al((size_t)NTOK * RLD * 2);
constexpr size_t O_QDB = O_QDA + (size_t)NTOK * 512 * 2;
constexpr size_t O_KD = O_QDB + (size_t)8192 * 512 * 2;
constexpr size_t O_VD = O_KD + (size_t)NKEY * 512 * 2;
constexpr size_t O_CQN = O_VD + (size_t)NKEY * 512 * 2;
constexpr size_t O_CKVN = O_CQN + (size_t)NTOK * 256 * 2;
constexpr size_t O_KMLA = O_CKVN + (size_t)NKEY * 128 * 2;
constexpr size_t O_VMLA = O_KMLA + (size_t)NKEY * 768 * 2;
constexpr size_t O_OTMP = O_VMLA + (size_t)NKEY * 512 * 2;
constexpr size_t O_ATT_END = O_OTMP + (size_t)512 * 16384 * 4;
constexpr size_t O_U = O_BIG;
constexpr size_t O_U_END = O_U + (size_t)NTOK * 4096 * 2;
constexpr size_t O_UG = O_BIG;
constexpr size_t O_PZ = O_UG + (size_t)NTOK * 512 * 2;
constexpr size_t WS_NEED = (O_ATT_END > O_U_END ? O_ATT_END : O_U_END);
static_assert(O_QMB + (size_t)8192 * 768 * 2 <= O_QDA, "Qm overlay must fit in R");
static_assert(WS_NEED <= (size_t)256 * 1024 * 1024, "workspace too large");

struct Params {
  const float *x_prompt, *x_sample, *cache_k, *cache_v, *cache_ckv, *cache_krope, *c, *c_ctx;
  const float *w_ada, *b_ada, *ln_mix_g, *ln_mix_b, *ln_mlp_g, *ln_mlp_b, *w_mlp_in, *w_mlp_out;
  const float *w_att_in, *w_uq, *w_ukv, *q_norm_g, *kv_norm_g, *lam_q1, *lam_k1, *lam_q2, *lam_k2, *diff_norm_g, *w_att_out;
  const float *w_conv_in, *conv_w, *conv_b, *conv_norm_g, *conv_norm_b, *w_pool, *pool_scale, *w_conv_out;
  float* out;
  char* ws;
};

DI unsigned pack2(float lo, float hi) { f32x2 v = {lo, hi}; bf16v2 b = __builtin_convertvector(v, bf16v2); return __builtin_bit_cast(unsigned, b); }
DI float bf2f(unsigned short u) { return __uint_as_float((unsigned)u << 16); }
DI float bflo(unsigned u) { return __uint_as_float(u << 16); }
DI float bfhi(unsigned u) { return __uint_as_float(u & 0xffff0000u); }
DI float wave_sum(float v) {
#pragma unroll
  for (int o = 32; o >= 1; o >>= 1) v += __shfl_xor(v, o);
  return v;
}
DI void lds_barrier() { asm volatile("s_waitcnt lgkmcnt(0)\n\ts_barrier" ::: "memory"); }
DI void dma16(const void* gsrc, unsigned lds_dst) {
  unsigned keep;
  asm volatile("s_mov_b32 %0, m0\n\ts_mov_b32 m0, %2\n\ts_nop 0\n\tglobal_load_lds_dwordx4 %1, off\n\ts_mov_b32 m0, %0" : "=&s"(keep) : "v"(gsrc), "s"(lds_dst) : "memory");
}
DI int cond_idx(int row) { return row < NCTX ? 0 : 1 + ((row - NCTX) >> 12); }


#define XB_TMO      128
#define XB_XCNT(j)  (256  + 64 * (j))
#define XB_XSUB(j)  (1280 + 64 * (j))
#define XB_XGEN(j)  (2304 + 64 * (j))
#define XB_TOP      3328
#define XB_TOPGEN   3392
#define XCD_BAR_WORDS 3456
#define XB_SPIN_CAP (1u << 18)
DI unsigned xb_ld(unsigned* p)              { return __hip_atomic_load(p, __ATOMIC_RELAXED, __HIP_MEMORY_SCOPE_AGENT); }
DI unsigned xb_add(unsigned* p, unsigned v) { return __hip_atomic_fetch_add(p, v, __ATOMIC_RELAXED, __HIP_MEMORY_SCOPE_AGENT); }
DI unsigned xb_xcc_id() { return (unsigned)__builtin_amdgcn_s_getreg((3 << 11) | 20) & 0xFu; }
#define XB_SPIN(cond, bar) do { unsigned _sp = 0; while (cond) { __builtin_amdgcn_s_sleep(1); \
    if ((++_sp & 255u) == 0u) { if (xb_ld(&(bar)[XB_TMO])) break; if (_sp > XB_SPIN_CAP) { atomicAdd(&(bar)[XB_TMO], 1u); break; } } } } while (0)
struct XcdBarrier { unsigned* bar; unsigned x; volatile LDS_AS unsigned* st; };
DI XcdBarrier xcd_barrier_post(unsigned* bar, volatile LDS_AS unsigned* st) {
  XcdBarrier b; b.bar = bar; b.x = xb_xcc_id(); b.st = st;
  if (threadIdx.x == 0) (void)xb_add(&bar[XB_XCNT(b.x)], 1u);
  return b;
}
DI void xcd_barrier_complete(unsigned* bar, unsigned x, unsigned& nloc, unsigned& nx) {
  const unsigned G = gridDim.x * gridDim.y * gridDim.z;
  unsigned sum, cnt, mine, sp = 0u;
  for (;;) {
    sum = 0u; cnt = 0u; mine = 0u;
#pragma unroll
    for (unsigned j = 0; j < 16; ++j) { const unsigned c = xb_ld(&bar[XB_XCNT(j)]); sum += c; cnt += (c > 0u) ? 1u : 0u; mine = (j == x) ? c : mine; }
    if (sum == G) break;
    __builtin_amdgcn_s_sleep(1);
    if ((++sp & 255u) == 0u) { if (xb_ld(&bar[XB_TMO])) break; if (sp > XB_SPIN_CAP) { atomicAdd(&bar[XB_TMO], 1u); break; } }
  }
  nloc = mine > 0u ? mine : 1u; nx = cnt > 0u ? cnt : 1u;
}
DI void xcd_barrier(const XcdBarrier& b) {
  asm volatile("s_waitcnt vmcnt(0)" ::: "memory");
  __syncthreads();
  if (threadIdx.x == 0) {
    unsigned* bar = b.bar;
    __builtin_amdgcn_s_waitcnt(0);
    unsigned nloc = b.st[0], nx = b.st[1];
    if (nloc == 0u) { xcd_barrier_complete(bar, b.x, nloc, nx); b.st[0] = nloc; b.st[1] = nx; }
    const unsigned old = xb_add(&bar[XB_XSUB(b.x)], 1u);
    const unsigned gen = old / nloc;
    if (old + 1u == (gen + 1u) * nloc) {
      __builtin_amdgcn_fence(__ATOMIC_RELEASE, "agent");
      asm volatile("s_waitcnt vmcnt(0)" ::: "memory");
      const unsigned og = xb_add(&bar[XB_TOP], 1u);
      const unsigned tg = og / nx;
      if (og + 1u == (tg + 1u) * nx) xb_add(&bar[XB_TOPGEN], 1u);
      else XB_SPIN(xb_ld(&bar[XB_TOPGEN]) == tg, bar);
      __builtin_amdgcn_fence(__ATOMIC_ACQUIRE, "agent");
      xb_add(&bar[XB_XGEN(b.x)], 1u);
      asm volatile("s_waitcnt vmcnt(0)" ::: "memory");
    } else {
      XB_SPIN(xb_ld(&bar[XB_XGEN(b.x)]) == gen, bar);
      __builtin_amdgcn_fence(__ATOMIC_ACQUIRE, "agent");
      asm volatile("s_waitcnt vmcnt(0)" ::: "memory");
    }
  }
  __syncthreads();
}

DI int swz(int row, int kc) { return row * 128 + ((kc ^ ((row >> 1) & 7)) << 4); }

constexpr int G_BM = 192, G_BN = 256, G_MI = 6, G_NJ = 4, G_ABYTES = G_BM * 128, G_STAGE = G_ABYTES + G_BN * 128;
template <class Epi>
DI void gemm_tile(const bf16_t* __restrict__ A, int lda, const bf16_t* __restrict__ Bt, int ldb, int K, int row0, int col0, char* smem, const Epi& epi,
                  bool prefetched, bool has_next, int nrow0, int ncol0) {
  const int tid = threadIdx.x, lane = tid & 63, wid = tid >> 6, wr = wid >> 2, wc = wid & 3;
  const int fr = lane & 15, fq = lane >> 4;
  f32x4 acc[G_MI][G_NJ];
#pragma unroll
  for (int i = 0; i < G_MI; ++i)
#pragma unroll
    for (int j = 0; j < G_NJ; ++j) acc[i][j] = (f32x4){0.f, 0.f, 0.f, 0.f};
  const int srow = tid >> 3, skc = tid & 7;
  const int schunk = skc ^ ((srow >> 1) & 7);
  const bf16_t* ga = A + (size_t)(row0 + srow) * lda + schunk * 8;
  const bf16_t* gb = Bt + (size_t)(col0 + srow) * ldb + schunk * 8;
  const int nk = K >> 6;
  const unsigned lds0 = __builtin_amdgcn_readfirstlane((unsigned)(size_t)(LDS_AS char*)smem + (unsigned)(tid & ~63) * 16u);
#define G_DMA_P(ga_, gb_, stage_off_, kt_) do { const int k0_ = (kt_) << 6; const unsigned sb_ = lds0 + (unsigned)(stage_off_); \
    _Pragma("unroll") for (int i = 0; i < 3; ++i) dma16((ga_) + (size_t)(64 * i) * lda + k0_, sb_ + i * 8192); \
    _Pragma("unroll") for (int i = 0; i < 4; ++i) dma16((gb_) + (size_t)(64 * i) * ldb + k0_, sb_ + G_ABYTES + i * 8192); } while (0)
#define G_DMA(stage_off_, kt_) G_DMA_P(ga, gb, stage_off_, kt_)
#define G_COMPUTE(buf_) do { const char* cur = (buf_); \
    _Pragma("unroll") for (int s = 0; s < 2; ++s) { \
      bf16x8 af[G_MI], bfr[G_NJ]; \
      _Pragma("unroll") for (int i = 0; i < G_MI; ++i) af[i] = *(const bf16x8*)(cur + swz(wr * 96 + i * 16 + fr, s * 4 + fq)); \
      _Pragma("unroll") for (int j = 0; j < G_NJ; ++j) bfr[j] = *(const bf16x8*)(cur + G_ABYTES + swz(wc * 64 + j * 16 + fr, s * 4 + fq)); \
      __builtin_amdgcn_s_setprio(1); \
      _Pragma("unroll") for (int i = 0; i < G_MI; ++i) \
        _Pragma("unroll") for (int j = 0; j < G_NJ; ++j) acc[i][j] = __builtin_amdgcn_mfma_f32_16x16x32_bf16(bfr[j], af[i], acc[i][j], 0, 0, 0); \
      __builtin_amdgcn_s_setprio(0); \
    } } while (0)
  if (!prefetched) { G_DMA(0, 0); asm volatile("s_waitcnt vmcnt(0)" ::: "memory"); }
  else asm volatile("s_waitcnt vmcnt(%0)" :: "n"(Epi::kMinStores) : "memory");
  lds_barrier();
  for (int kt = 0; kt < nk; kt += 2) {
    G_DMA(G_STAGE, kt + 1);
    G_COMPUTE(smem);
    asm volatile("s_waitcnt vmcnt(0)" ::: "memory");
    lds_barrier();
    G_DMA(0, min(kt + 2, nk - 1));
    G_COMPUTE(smem + G_STAGE);
    asm volatile("s_waitcnt vmcnt(0)" ::: "memory");
    lds_barrier();
  }
  if (has_next) {
    const bf16_t* gan = A + (size_t)(nrow0 + srow) * lda + schunk * 8;
    const bf16_t* gbn = Bt + (size_t)(ncol0 + srow) * ldb + schunk * 8;
    G_DMA_P(gan, gbn, 0, 0);
  }
#undef G_DMA
#undef G_DMA_P
#undef G_COMPUTE
  epi(acc, row0 + wr * 96, col0 + wc * 64, lane);
}


template <class F>
DI void wave_rows_store(char* w, const u32x2 (&pk)[G_MI][G_NJ], int lane, F rowptr) {
  const int fr = lane & 15, fq = lane >> 4;
#pragma unroll
  for (int i = 0; i < G_MI; ++i)
#pragma unroll
    for (int j = 0; j < G_NJ; ++j) *(u32x2*)(w + (i * 16 + fr) * 144 + (j * 16 + fq * 4) * 2) = pk[i][j];
  const int rr = lane >> 3, ch = lane & 7;
#pragma unroll
  for (int it = 0; it < 12; ++it) {
    const int r = it * 8 + rr;
    const u32x4 v = *(const u32x4*)(w + r * 144 + ch * 16);
    bf16_t* d = rowptr(r);
    if (d) *(u32x4*)(d + ch * 8) = v;
  }
}
DI u32x2 pk4(const f32x4 v) { return (u32x2){pack2(v[0], v[1]), pack2(v[2], v[3])}; }

struct EpiRaw {
  static constexpr int kMinStores = 0;
  static constexpr bool kPrefetchNext = true;
  bf16_t* R;
  DI void operator()(f32x4 (&acc)[G_MI][G_NJ], int rbase, int cbase, int lane) const {
    const int fr = lane & 15, fq = lane >> 4;
#pragma unroll
    for (int i = 0; i < G_MI; ++i)
#pragma unroll
      for (int j = 0; j < G_NJ; ++j) {
        const int row = rbase + i * 16 + fr, col = cbase + j * 16 + fq * 4;
        if (col < RLD) { u32x2 w = {pack2(acc[i][j][0], acc[i][j][1]), pack2(acc[i][j][2], acc[i][j][3])}; *(u32x2*)(R + (size_t)row * RLD + col) = w; }
      }
  }
};


struct EpiAttIn {
  static constexpr int kMinStores = 0;
  static constexpr bool kPrefetchNext = true;
  bf16_t *Qda, *Qdb, *Kd, *Vd, *cqn, *ckvn, *Km; float *o_k, *o_v, *o_ckv, *o_kr;
  const float *c16, *s16, *c8, *s8, *qg, *kvg; char* smem;
  DI void operator()(f32x4 (&acc)[G_MI][G_NJ], int rbase, int cbase, int lane) const {
    const int tid = threadIdx.x, wid = tid >> 6, wr = wid >> 2, wc = wid & 3, fr = lane & 15, fq = lane >> 4;
    const int tile = (cbase - wc * 64) >> 8;
    float* part = (float*)smem;
    if (tile < 6) {
      const int which = tile >> 1, c0 = cbase & 511;
#pragma unroll
      for (int i = 0; i < G_MI; ++i) {
        const int rowf = rbase + i * 16, row = rowf + fr;
        const bool lat = rowf >= NCTX;
        const int rl = row - NCTX, b = rl >> 12, t = rl & (TLAT - 1), prow = t >> 6, pcol = t & 63;
        const size_t kr = lat ? (size_t)NCTX + (size_t)b * TKL + 256 + t : (size_t)row;
        u32x2 raw[G_NJ], rot[G_NJ];
#pragma unroll
        for (int j = 0; j < G_NJ; ++j) raw[j] = (u32x2){pack2(acc[i][j][0], acc[i][j][1]), pack2(acc[i][j][2], acc[i][j][3])};
        if (lat && which < 2) {
#pragma unroll
          for (int jp = 0; jp < 2; ++jp) {
            const int pos = jp == 0 ? prow : pcol;
            const f32x4 cs = *(const f32x4*)(c16 + pos * 16 + fq * 4), sn = *(const f32x4*)(s16 + pos * 16 + fq * 4);
            const f32x4 x1 = acc[i][2 * jp], x2 = acc[i][2 * jp + 1];
            f32x4 o1, o2;
#pragma unroll
            for (int e = 0; e < 4; ++e) { o1[e] = x1[e] * cs[e] - x2[e] * sn[e]; o2[e] = x1[e] * sn[e] + x2[e] * cs[e]; }
            rot[2 * jp] = (u32x2){pack2(o1[0], o1[1]), pack2(o1[2], o1[3])};
            rot[2 * jp + 1] = (u32x2){pack2(o2[0], o2[1]), pack2(o2[2], o2[3])};
          }
        }
#pragma unroll
        for (int j = 0; j < G_NJ; ++j) {
          const int c = c0 + j * 16 + fq * 4;
          if (which == 0) {
            *(u32x2*)(Qda + (size_t)row * 512 + c) = raw[j];
            if (lat) *(u32x2*)(Qdb + (size_t)rl * 512 + c) = rot[j];
          } else if (which == 1) {
            if (lat) *(u32x2*)(Kd + kr * 512 + c) = rot[j];
            else { *(u32x2*)(Kd + kr * 512 + c) = raw[j]; *(f32x4*)(o_k + (size_t)row * 512 + c) = acc[i][j]; }
          } else {
            *(u32x2*)(Vd + kr * 512 + c) = raw[j];
            if (!lat) *(f32x4*)(o_v + (size_t)row * 512 + c) = acc[i][j];
          }
        }
      }
      return;
    }
    const bool norm_wave = (tile == 6) || (wc < 2);
#pragma unroll
    for (int i = 0; i < G_MI; ++i) {
      float ss = 0.f;
#pragma unroll
      for (int j = 0; j < G_NJ; ++j)
#pragma unroll
        for (int e = 0; e < 4; ++e) ss += acc[i][j][e] * acc[i][j][e];
      ss += __shfl_xor(ss, 16); ss += __shfl_xor(ss, 32);
      if (fq == 0) part[(wr * 96 + i * 16 + fr) * 4 + wc] = ss;
    }
    __syncthreads();
#pragma unroll
    for (int i = 0; i < G_MI; ++i) {
      const int rowf = rbase + i * 16, row = rowf + fr;
      const bool lat = rowf >= NCTX;
      const int rl = row - NCTX, b = rl >> 12, t = rl & (TLAT - 1), prow = t >> 6, pcol = t & 63;
      const size_t kr = lat ? (size_t)NCTX + (size_t)b * TKL + 256 + t : (size_t)row;
      const f32x4 pr = *(const f32x4*)(part + (wr * 96 + i * 16 + fr) * 4);
      if (tile == 6) {
        const float sc = rsqrtf(((pr[0] + pr[1]) + (pr[2] + pr[3])) * (1.f / 256.f) + EPS);
#pragma unroll
        for (int j = 0; j < G_NJ; ++j) {
          const int c = wc * 64 + j * 16 + fq * 4;
          const f32x4 g = *(const f32x4*)(qg + c);
          *(u32x2*)(cqn + (size_t)row * 256 + c) = (u32x2){pack2(acc[i][j][0] * sc * g[0], acc[i][j][1] * sc * g[1]), pack2(acc[i][j][2] * sc * g[2], acc[i][j][3] * sc * g[3])};
        }
      } else if (norm_wave) {
        const float sc = rsqrtf((pr[0] + pr[1]) * (1.f / 128.f) + EPS);
#pragma unroll
        for (int j = 0; j < G_NJ; ++j) {
          const int c = wc * 64 + j * 16 + fq * 4;
          const f32x4 g = *(const f32x4*)(kvg + c);
          f32x4 y;
#pragma unroll
          for (int e = 0; e < 4; ++e) y[e] = acc[i][j][e] * sc * g[e];
          if (!lat) *(f32x4*)(o_ckv + (size_t)row * 128 + c) = y;
          *(u32x2*)(ckvn + kr * 128 + c) = (u32x2){pack2(y[0], y[1]), pack2(y[2], y[3])};
        }
      } else if (wc == 2) {
#pragma unroll
        for (int j = 0; j < 2; ++j) {
          f32x4 v = acc[i][j];
          if (lat) {
            const int pos = j == 0 ? prow : pcol;
            f32x4 o;
#pragma unroll
            for (int e = 0; e < 4; ++e) {
              const float pv = __shfl_xor(v[e], 32);
              const int f = (fq & 1) * 4 + e;
              const float cs = c8[pos * 8 + f], sn = s8[pos * 8 + f];
              o[e] = (fq < 2) ? (v[e] * cs - pv * sn) : (pv * sn + v[e] * cs);
            }
            v = o;
          } else *(f32x4*)(o_kr + (size_t)row * 32 + j * 16 + fq * 4) = v;
          const u32x2 w = {pack2(v[0], v[1]), pack2(v[2], v[3])};
#pragma unroll
          for (int hh = 0; hh < 8; ++hh) *(u32x2*)(Km + kr * 768 + hh * 96 + 64 + j * 16 + fq * 4) = w;
        }
      }
    }
    __syncthreads();
  }
};

struct EpiUq {
  static constexpr int kMinStores = 24;
  static constexpr bool kPrefetchNext = true;
  bf16_t *Qa, *Qb; const float *c8, *s8;
  DI void operator()(f32x4 (&acc)[G_MI][G_NJ], int rbase, int cbase, int lane) const {
    const int fr = lane & 15, fq = lane >> 4;
#pragma unroll
    for (int i = 0; i < G_MI; ++i) {
      const bool lat = (rbase + i * 16) >= NCTX;
      const int row = rbase + i * 16 + fr;
      const int t = (row - NCTX) & (TLAT - 1);
#pragma unroll
      for (int j = 0; j < G_NJ; ++j) {
        const int cf = cbase + j * 16, col = cf + fq * 4;
        f32x4 v = acc[i][j];
        u32x2 w = {pack2(v[0], v[1]), pack2(v[2], v[3])};
        *(u32x2*)(Qa + (size_t)row * 768 + col) = w;
        if (lat) {
          const int w96 = cf % 96;
          if (w96 >= 64) {
            const int pos = (w96 == 64) ? (t >> 6) : (t & 63);
            f32x4 o;
#pragma unroll
            for (int e = 0; e < 4; ++e) {
              const float pv = __shfl_xor(v[e], 32);
              const int f = (fq & 1) * 4 + e;
              const float cs = c8[pos * 8 + f], sn = s8[pos * 8 + f];
              o[e] = (fq < 2) ? (v[e] * cs - pv * sn) : (pv * sn + v[e] * cs);
            }
            w = (u32x2){pack2(o[0], o[1]), pack2(o[2], o[3])};
          }
          *(u32x2*)(Qb + (size_t)(row - NCTX) * 768 + col) = w;
        }
      }
    }
  }
};

struct EpiUkv {
  static constexpr int kMinStores = 0;
  static constexpr bool kPrefetchNext = false;
  bf16_t *Km, *Vm; char* lds;
  DI void operator()(f32x4 (&acc)[G_MI][G_NJ], int rbase, int cbase, int lane) const {
    const int h = cbase >> 7, part = (cbase >> 6) & 1;
    u32x2 pk[G_MI][G_NJ];
#pragma unroll
    for (int i = 0; i < G_MI; ++i)
#pragma unroll
      for (int j = 0; j < G_NJ; ++j) pk[i][j] = pk4(acc[i][j]);
    bf16_t* base = part == 0 ? Km + h * 96 : Vm + h * 64;
    const int ld = part == 0 ? 768 : 512;
    wave_rows_store(lds + (threadIdx.x >> 6) * (96 * 144), pk, lane, [&](int r) -> bf16_t* { const int row = rbase + r; return row < NKEY ? base + (size_t)row * ld : nullptr; });
    lds_barrier();
  }
};

struct EpiRes {
  static constexpr int kMinStores = 0;
  static constexpr bool kPrefetchNext = true;
  const float *xin_ctx, *xin_lat, *gate  ; float* X;
  DI void operator()(f32x4 (&acc)[G_MI][G_NJ], int rbase, int cbase, int lane) const {
    const int fr = lane & 15, fq = lane >> 4;
#pragma unroll
    for (int i = 0; i < G_MI; ++i) {
      const int row = rbase + i * 16 + fr;
      const float* g = gate + cond_idx(rbase + i * 16) * 6144;
      const float* xin = row < NCTX ? xin_ctx + (size_t)row * 1024 : xin_lat + (size_t)(row - NCTX) * 1024;
#pragma unroll
      for (int j = 0; j < G_NJ; ++j) {
        const int col = cbase + j * 16 + fq * 4;
        const f32x4 xv = *(const f32x4*)(xin + col), gv = *(const f32x4*)(g + col);
        f32x4 z;
#pragma unroll
        for (int e = 0; e < 4; ++e) z[e] = ALPHA * xv[e] + gv[e] * acc[i][j][e];
        *(f32x4*)(X + (size_t)row * 1024 + col) = z;
      }
    }
  }
};


struct EpiResLN {
  static constexpr int kMinStores = 0;
  static constexpr bool kPrefetchNext = true;
  const float *xin_ctx, *xin_lat, *gate; float* X;
  const float *lg, *lb, *modsL; int sh_off, sc_off; bf16_t* Hb;
  float* xbuf; unsigned* cnt; char* smem; bool fused;
  DI void operator()(f32x4 (&acc)[G_MI][G_NJ], int rbase, int cbase, int lane) const {
    const int tid = threadIdx.x, wid = tid >> 6, wr = wid >> 2, wc = wid & 3, fr = lane & 15, fq = lane >> 4;
    const int cid0 = cond_idx(rbase);
#pragma unroll
    for (int j = 0; j < G_NJ; ++j) {
      const int col = cbase + j * 16 + fq * 4;
      const f32x4 gv0 = *(const f32x4*)(gate + cid0 * 6144 + col);
#pragma unroll
      for (int i = 0; i < G_MI; ++i) {
        const int row = rbase + i * 16 + fr, cid = cond_idx(rbase + i * 16);
        const float* xin = row < NCTX ? xin_ctx + (size_t)row * 1024 : xin_lat + (size_t)(row - NCTX) * 1024;
        const f32x4 xv = *(const f32x4*)(xin + col);
        f32x4 gv = gv0;
        if (cid != cid0) gv = *(const f32x4*)(gate + cid * 6144 + col);
#pragma unroll
        for (int e = 0; e < 4; ++e) acc[i][j][e] = ALPHA * xv[e] + gv[e] * acc[i][j][e];
        if (!fused) *(f32x4*)(X + (size_t)row * 1024 + col) = acc[i][j];
      }
    }
    if (!fused) return;
    const int row0 = rbase - wr * 96, pm = row0 / G_BM, pn = (cbase - wc * 64) / G_BN;
    f32x2* part = (f32x2*)smem;
    f32x2* stat = (f32x2*)(smem + 8192);
#pragma unroll
    for (int i = 0; i < G_MI; ++i) {
      float s1 = 0.f, s2 = 0.f;
#pragma unroll
      for (int j = 0; j < G_NJ; ++j)
#pragma unroll
        for (int e = 0; e < 4; ++e) { const float v = acc[i][j][e]; s1 += v; s2 += v * v; }
      s1 += __shfl_xor(s1, 16); s2 += __shfl_xor(s2, 16);
      s1 += __shfl_xor(s1, 32); s2 += __shfl_xor(s2, 32);
      if (fq == 0) part[(wr * 96 + i * 16 + fr) * 4 + wc] = (f32x2){s1, s2};
    }
    __syncthreads();
    if (tid < G_BM) {
      const f32x2 a = part[tid * 4 + 0], b = part[tid * 4 + 1], c = part[tid * 4 + 2], d = part[tid * 4 + 3];
      const float s1 = (a[0] + b[0]) + (c[0] + d[0]), s2 = (a[1] + b[1]) + (c[1] + d[1]);
      const unsigned long long pk = ((unsigned long long)__float_as_uint(s2) << 32) | (unsigned long long)__float_as_uint(s1);
      __hip_atomic_store((unsigned long long*)(xbuf + ((size_t)(pm * 4 + pn) * G_BM + tid) * 2), pk, __ATOMIC_RELAXED, __HIP_MEMORY_SCOPE_AGENT);
    }
    asm volatile("s_waitcnt vmcnt(0)" ::: "memory");
    __syncthreads();
    if (tid == 0) {
      __hip_atomic_fetch_add(cnt + pm, 1u, __ATOMIC_RELAXED, __HIP_MEMORY_SCOPE_AGENT);
      unsigned sp = 0;
      while (__hip_atomic_load(cnt + pm, __ATOMIC_RELAXED, __HIP_MEMORY_SCOPE_AGENT) < 4u) { __builtin_amdgcn_s_sleep(1); if (++sp > (1u << 22)) break; }
    }
    __syncthreads();
    if (tid < G_BM) {
      float s1 = 0.f, s2 = 0.f;
#pragma unroll
      for (int q = 0; q < 4; ++q) {
        const unsigned long long pk = __hip_atomic_load((unsigned long long*)(xbuf + ((size_t)(pm * 4 + q) * G_BM + tid) * 2), __ATOMIC_RELAXED, __HIP_MEMORY_SCOPE_AGENT);
        s1 += __uint_as_float((unsigned)pk); s2 += __uint_as_float((unsigned)(pk >> 32));
      }
      const float mean = s1 * (1.f / 1024.f);
      const float var = fmaxf(s2 * (1.f / 1024.f) - mean * mean, 0.f);
      stat[tid] = (f32x2){mean, rsqrtf(var + EPS)};
    }
    __syncthreads();
#pragma unroll
    for (int j = 0; j < G_NJ; ++j) {
      const int col = cbase + j * 16 + fq * 4;
      const f32x4 gv = *(const f32x4*)(lg + col), bv = *(const f32x4*)(lb + col);
      f32x4 sh0 = {0.f, 0.f, 0.f, 0.f}, sc0 = sh0;
      if (Hb) { sh0 = *(const f32x4*)(modsL + cid0 * 6144 + sh_off + col); sc0 = *(const f32x4*)(modsL + cid0 * 6144 + sc_off + col); }
#pragma unroll
      for (int i = 0; i < G_MI; ++i) {
        const int row = rbase + i * 16 + fr, cid = cond_idx(rbase + i * 16);
        const f32x2 ms = stat[wr * 96 + i * 16 + fr];
        f32x4 x;
#pragma unroll
        for (int e = 0; e < 4; ++e) x[e] = (acc[i][j][e] - ms[0]) * ms[1] * gv[e] + bv[e];
        *(f32x4*)(X + (size_t)row * 1024 + col) = x;
        if (Hb) {
          f32x4 sh = sh0, sc = sc0;
          if (cid != cid0) { sh = *(const f32x4*)(modsL + cid * 6144 + sh_off + col); sc = *(const f32x4*)(modsL + cid * 6144 + sc_off + col); }
          u32x2 w = {pack2(x[0] * (1.f + sc[0]) + sh[0], x[1] * (1.f + sc[1]) + sh[1]), pack2(x[2] * (1.f + sc[2]) + sh[2], x[3] * (1.f + sc[3]) + sh[3])};
          *(u32x2*)(Hb + (size_t)row * 1024 + col) = w;
        }
      }
    }
    __syncthreads();
  }
};

struct EpiRelu2 {
  static constexpr int kMinStores = 12;
  static constexpr bool kPrefetchNext = true;
  bf16_t* U; char* lds;
  DI void operator()(f32x4 (&acc)[G_MI][G_NJ], int rbase, int cbase, int lane) const {
    const int fr = lane & 15, fq = lane >> 4, wid = threadIdx.x >> 6;
    char* w = lds + wid * (48 * 144);
    const int rr = lane >> 3, ch = lane & 7;
#pragma unroll
    for (int hf = 0; hf < 2; ++hf) {
#pragma unroll
      for (int i3 = 0; i3 < 3; ++i3)
#pragma unroll
        for (int j = 0; j < G_NJ; ++j) {
          f32x4 v = acc[hf * 3 + i3][j];
#pragma unroll
          for (int e = 0; e < 4; ++e) { const float r = fmaxf(v[e], 0.f); v[e] = r * r; }
          *(u32x2*)(w + (i3 * 16 + fr) * 144 + (j * 16 + fq * 4) * 2) = (u32x2){pack2(v[0], v[1]), pack2(v[2], v[3])};
        }
#pragma unroll
      for (int it = 0; it < 6; ++it) {
        const int r = it * 8 + rr;
        const u32x4 v = *(const u32x4*)(w + r * 144 + ch * 16);
        *(u32x4*)(U + (size_t)(rbase + hf * 48 + r) * 4096 + cbase + ch * 8) = v;
      }
    }
  }
};

struct EpiConv {
  static constexpr int kMinStores = 0;
  static constexpr bool kPrefetchNext = false;
  bf16_t *Ug, *Pz; char* lds;
  DI void operator()(f32x4 (&acc)[G_MI][G_NJ], int rbase, int cbase, int lane) const {
    const int fr = lane & 15, fq = lane >> 4;
    char* w = lds + (threadIdx.x >> 6) * (96 * 144);
    if (cbase < 1024) {
#pragma unroll
      for (int i = 0; i < G_MI; ++i)
#pragma unroll
        for (int jp = 0; jp < 2; ++jp) {
          const f32x4 a = acc[i][2 * jp], gt = acc[i][2 * jp + 1];
          f32x4 u;
#pragma unroll
          for (int e = 0; e < 4; ++e) u[e] = a[e] / (1.f + __expf(-gt[e]));
          *(u32x2*)(w + (i * 16 + fr) * 80 + (jp * 16 + fq * 4) * 2) = pk4(u);
        }
      const int rr = lane >> 2, ch = lane & 3, c0 = (cbase >> 5) * 16;
#pragma unroll
      for (int it = 0; it < 6; ++it) {
        const int r = it * 16 + rr;
        const u32x4 v = *(const u32x4*)(w + r * 80 + ch * 16);
        *(u32x4*)(Ug + (size_t)(rbase + r) * 512 + c0 + ch * 8) = v;
      }
    } else {
      u32x2 pk[G_MI][G_NJ];
#pragma unroll
      for (int i = 0; i < G_MI; ++i)
#pragma unroll
        for (int j = 0; j < G_NJ; ++j) pk[i][j] = pk4(acc[i][j]);
      wave_rows_store(w, pk, lane, [&](int r) -> bf16_t* { return Pz + (size_t)(rbase + r) * 512 + (cbase - 1024); });
    }
    lds_barrier();
  }
};

#ifndef XCD_ORDER
#define XCD_ORDER 1
#endif
template <class Epi>
DI void gemm_phase(const bf16_t* A, int lda, const bf16_t* Bt, int ldb, int K, int mt, int nt, const Epi& epi, char* smem, int tstart = 0, int ttotal = -1) {
  const int n = mt * nt;
  if (ttotal < 0) ttotal = n;
  const bool xo = XCD_ORDER && gridDim.x == 256 && (nt & 3) == 0 && (mt & 3) == 0 && n % 256 == 0;
  auto coords = [&](int u, int& r0, int& c0) {
    int pm = u / nt, pn = u - pm * nt;
    if (xo) {
      const int r = u >> 8, w = u & 255, x = w & 7, idx = w >> 3;
      const int rows_r = 256 / nt, pw = nt < 8 ? nt : 8, ph = 32 / pw, npx = nt / pw, px = x % npx, py = x / npx;
      pm = r * rows_r + py * ph + idx / pw; pn = px * pw + idx % pw;
    }
    r0 = pm * G_BM; c0 = pn * G_BN;
  };
  int t = blockIdx.x;
  while (t < tstart) t += gridDim.x;
  bool prefetched = false;
  while (t < tstart + n && t < ttotal) {
    const int tn = t + gridDim.x;
    const bool has_next = Epi::kPrefetchNext && tn < tstart + n && tn < ttotal;
    int r0, c0, nr0 = 0, nc0 = 0;
    coords(t - tstart, r0, c0);
    if (has_next) coords(tn - tstart, nr0, nc0);
    gemm_tile(A, lda, Bt, ldb, K, r0, c0, smem, epi, prefetched, has_next, nr0, nc0);
    prefetched = has_next;
    t = tn;
  }
}

DI void rows_phase(const float* src_ctx, const float* src_lat, bool do_ln, const float* lg, const float* lb, float* Xdst,
                   const float* modsL, int sh_off, int sc_off, bf16_t* Hb) {
  const int lane = threadIdx.x & 63, gw = blockIdx.x * NWAVE + (threadIdx.x >> 6), nw = gridDim.x * NWAVE;
  for (int row = gw; row < NTOK; row += nw) {
    const float* src = row < NCTX ? src_ctx + (size_t)row * 1024 : src_lat + (size_t)(row - NCTX) * 1024;
    f32x4 v[4];
#pragma unroll
    for (int i = 0; i < 4; ++i) v[i] = *(const f32x4*)(src + i * 256 + lane * 4);
    if (do_ln) {
      float s = 0.f;
#pragma unroll
      for (int i = 0; i < 4; ++i) s += (v[i][0] + v[i][1]) + (v[i][2] + v[i][3]);
      const float mean = wave_sum(s) * (1.f / 1024.f);
      float q = 0.f;
#pragma unroll
      for (int i = 0; i < 4; ++i)
#pragma unroll
        for (int e = 0; e < 4; ++e) { const float d = v[i][e] - mean; q += d * d; }
      const float rstd = rsqrtf(wave_sum(q) * (1.f / 1024.f) + EPS);
#pragma unroll
      for (int i = 0; i < 4; ++i) {
        const f32x4 g = *(const f32x4*)(lg + i * 256 + lane * 4), b = *(const f32x4*)(lb + i * 256 + lane * 4);
#pragma unroll
        for (int e = 0; e < 4; ++e) v[i][e] = (v[i][e] - mean) * rstd * g[e] + b[e];
        if (Xdst) *(f32x4*)(Xdst + (size_t)row * 1024 + i * 256 + lane * 4) = v[i];
      }
    }
    if (Hb) {
      const float* m = modsL + cond_idx(row) * 6144;
#pragma unroll
      for (int i = 0; i < 4; ++i) {
        const int col = i * 256 + lane * 4;
        const f32x4 sh = *(const f32x4*)(m + sh_off + col), sc = *(const f32x4*)(m + sc_off + col);
        f32x4 h;
#pragma unroll
        for (int e = 0; e < 4; ++e) h[e] = v[i][e] * (1.f + sc[e]) + sh[e];
        u32x2 w = {pack2(h[0], h[1]), pack2(h[2], h[3])};
        *(u32x2*)(Hb + (size_t)row * 1024 + col) = w;
      }
    }
  }
}

DI void modulate_phase(const float* __restrict__ src_ctx, const float* __restrict__ src_lat, const float* __restrict__ modsL, bf16_t* __restrict__ Hb) {
  const int lane = threadIdx.x & 63, gw = blockIdx.x * NWAVE + (threadIdx.x >> 6), nw = gridDim.x * NWAVE;
  for (int r0 = gw * 2; r0 < NTOK; r0 += nw * 2) {
    f32x4 v[2][4];
#pragma unroll
    for (int k = 0; k < 2; ++k) {
      const int row = r0 + k;
      const float* src = row < NCTX ? src_ctx + (size_t)row * 1024 : src_lat + (size_t)(row - NCTX) * 1024;
#pragma unroll
      for (int i = 0; i < 4; ++i) v[k][i] = __builtin_nontemporal_load((const f32x4*)(src + i * 256 + lane * 4));
    }
#pragma unroll
    for (int k = 0; k < 2; ++k) {
      const int row = r0 + k;
      const float* m = modsL + cond_idx(row) * 6144;
#pragma unroll
      for (int i = 0; i < 4; ++i) {
        const int col = i * 256 + lane * 4;
        const f32x4 sh = *(const f32x4*)(m + col), sc = *(const f32x4*)(m + 1024 + col);
        u32x2 w = {pack2(v[k][i][0] * (1.f + sc[0]) + sh[0], v[k][i][1] * (1.f + sc[1]) + sh[1]), pack2(v[k][i][2] * (1.f + sc[2]) + sh[2], v[k][i][3] * (1.f + sc[3]) + sh[3])};
        *(u32x2*)(Hb + (size_t)row * 1024 + col) = w;
      }
    }
  }
}

DI double sin_red(double r) {
  const double r2 = r * r; double t = -1.0 / 51090942171709440000.0;
  t = t * r2 + 1.0 / 121645100408832000.0; t = t * r2 - 1.0 / 355687428096000.0; t = t * r2 + 1.0 / 1307674368000.0; t = t * r2 - 1.0 / 6227020800.0;
  t = t * r2 + 1.0 / 39916800.0; t = t * r2 - 1.0 / 362880.0; t = t * r2 + 1.0 / 5040.0; t = t * r2 - 1.0 / 120.0; t = t * r2 + 1.0 / 6.0;
  return r * (1.0 - r2 * t);
}
DI double cos_red(double r) {
  const double r2 = r * r; double t = 1.0 / 1124000727777607680000.0;
  t = t * r2 - 1.0 / 2432902008176640000.0; t = t * r2 + 1.0 / 6402373705728000.0; t = t * r2 - 1.0 / 20922789888000.0; t = t * r2 + 1.0 / 87178291200.0;
  t = t * r2 - 1.0 / 479001600.0; t = t * r2 + 1.0 / 3628800.0; t = t * r2 - 1.0 / 40320.0; t = t * r2 + 1.0 / 720.0; t = t * r2 - 1.0 / 24.0; t = t * r2 + 0.5; t = t * r2 * -1.0 + 1.0;
  return t;
}

constexpr int J_MODS = 96, J_WEFF = 64, J_CACHE = 64, J_ROPE = 1, J_SLOW = J_MODS + J_WEFF + J_CACHE + J_ROPE;
constexpr int T_ATTIN = 16 * 16, T_UQ = 4 * 6, T_UKV = 2 * 8, T_ATTOUT = 16 * 8, T_MLPIN = 16 * 32, T_MLPOUT = 64 * 8, T_CONVIN = 16 * 12, T_CONVOUT = 8 * 8;
constexpr int J_TR = T_ATTIN + T_UQ + T_UKV + T_ATTOUT + 2 * T_MLPIN + 2 * T_MLPOUT + T_CONVIN + T_CONVOUT;

struct TJ { const float* src; bf16_t* dst; int N, nvalid, lddst, perm, kt, nt; };
DI TJ tr_decode(const Params& p, int j) {
  char* ws = p.ws;
  TJ t; t.perm = 0;
  if (j < T_ATTIN) { t.src = p.w_att_in; t.N = 1952; t.nvalid = 1952; t.dst = (bf16_t*)(ws + O_WATTIN); t.lddst = 1024; t.kt = j / 16; t.nt = j % 16; return t; }
  j -= T_ATTIN;
  if (j < T_UQ) { t.src = p.w_uq; t.N = 768; t.nvalid = 768; t.dst = (bf16_t*)(ws + O_WUQ); t.lddst = 256; t.kt = j / 6; t.nt = j % 6; return t; }
  j -= T_UQ;
  if (j < T_UKV) { t.src = p.w_ukv; t.N = 1024; t.nvalid = 1024; t.dst = (bf16_t*)(ws + O_WUKV); t.lddst = 128; t.kt = j / 8; t.nt = j % 8; return t; }
  j -= T_UKV;
  if (j < T_ATTOUT) { t.src = p.w_att_out; t.N = 1024; t.nvalid = 1024; t.dst = (bf16_t*)(ws + O_WATTOUT); t.lddst = 1024; t.kt = j / 8; t.nt = j % 8; return t; }
  j -= T_ATTOUT;
  if (j < 2 * T_MLPIN) { const int l = j / T_MLPIN, u = j % T_MLPIN; t.src = p.w_mlp_in + (size_t)l * 1024 * 4096; t.N = 4096; t.nvalid = 4096; t.dst = (bf16_t*)(ws + O_WMLPIN) + (size_t)l * 4096 * 1024; t.lddst = 1024; t.kt = u / 32; t.nt = u % 32; return t; }
  j -= 2 * T_MLPIN;
  if (j < 2 * T_MLPOUT) { const int l = j / T_MLPOUT, u = j % T_MLPOUT; t.src = p.w_mlp_out + (size_t)l * 4096 * 1024; t.N = 1024; t.nvalid = 1024; t.dst = (bf16_t*)(ws + O_WMLPOUT) + (size_t)l * 4096 * 1024; t.lddst = 4096; t.kt = u / 8; t.nt = u % 8; return t; }
  j -= 2 * T_MLPOUT;
  if (j < T_CONVIN) { t.src = p.w_conv_in; t.N = 1536; t.nvalid = 1536; t.dst = (bf16_t*)(ws + O_WCONVIN); t.lddst = 1024; t.perm = 1; t.kt = j / 12; t.nt = j % 12; return t; }
  j -= T_CONVIN;
  t.src = p.w_conv_out; t.N = 1024; t.nvalid = 1024; t.dst = (bf16_t*)(ws + O_WCONVOUT); t.lddst = 1024; t.kt = j / 8; t.nt = j % 8; return t;
}
DI void tr_load(const TJ& t, float (&v)[16]) {
  const int tid = threadIdx.x, n4 = (tid & 31) * 4, kb = tid >> 5;
  const int gn = t.nt * 128 + n4;
  const float* s = t.src + (size_t)(t.kt * 64 + kb) * t.N + gn;
#pragma unroll
  for (int i = 0; i < 4; ++i) {
    f32x4 x = {0.f, 0.f, 0.f, 0.f};
    if (gn < t.nvalid) x = *(const f32x4*)(s + (size_t)(16 * i) * t.N);
    v[4 * i] = x[0]; v[4 * i + 1] = x[1]; v[4 * i + 2] = x[2]; v[4 * i + 3] = x[3];
  }
}

DI void phase0(const Params& p, char* smem) {
  const int tid = threadIdx.x, lane = tid & 63, wid = tid >> 6;
  char* ws = p.ws;
  for (int job = blockIdx.x; job < J_SLOW; job += gridDim.x) {
    int j = job;
    if (j < J_MODS) {
      const int l = j / 48, cc = j % 48;
      float* sc = (float*)smem;
      for (int i = tid; i < 3072; i += NT) { const int ci = i >> 10, k = i & 1023; const float x = ci == 0 ? p.c_ctx[k] : p.c[(ci - 1) * 1024 + k]; sc[i] = x / (1.f + __expf(-x)); }
      __syncthreads();
      const int kg = tid >> 5, c4 = (tid & 31) * 4;
      const float* w = p.w_ada + (size_t)l * 1024 * 6144 + cc * 128 + c4;
      f32x4 s0 = {0.f, 0.f, 0.f, 0.f}, s1 = s0, s2 = s0;
#pragma unroll 16
      for (int k = kg * 64; k < kg * 64 + 64; ++k) {
        const f32x4 wv = __builtin_nontemporal_load((const f32x4*)(w + (size_t)k * 6144));
        const float a = sc[k], b = sc[1024 + k], c = sc[2048 + k];
#pragma unroll
        for (int e = 0; e < 4; ++e) { s0[e] += a * wv[e]; s1[e] += b * wv[e]; s2[e] += c * wv[e]; }
      }
      f32x4* r = (f32x4*)(smem + 12288);
      r[(kg * 3 + 0) * 32 + (tid & 31)] = s0; r[(kg * 3 + 1) * 32 + (tid & 31)] = s1; r[(kg * 3 + 2) * 32 + (tid & 31)] = s2;
      __syncthreads();
      if (tid < 96) {
        const int ci = tid >> 5, q = tid & 31;
        f32x4 s = {0.f, 0.f, 0.f, 0.f};
#pragma unroll
        for (int g = 0; g < 16; ++g) { const f32x4 t4 = r[(g * 3 + ci) * 32 + q]; s[0] += t4[0]; s[1] += t4[1]; s[2] += t4[2]; s[3] += t4[3]; }
        const f32x4 bb = *(const f32x4*)(p.b_ada + l * 6144 + cc * 128 + q * 4);
        float* md = (float*)(ws + O_MODS) + (size_t)(l * 3 + ci) * 6144 + cc * 128 + q * 4;
#pragma unroll
        for (int e = 0; e < 4; ++e) __hip_atomic_store(md + e, s[e] + bb[e], __ATOMIC_RELAXED, __HIP_MEMORY_SCOPE_AGENT);
      }
      asm volatile("s_waitcnt vmcnt(0)" ::: "memory");
      __syncthreads();
      if (tid == 0) __hip_atomic_fetch_add((unsigned*)(ws + O_CNT) + 2, 1u, __ATOMIC_RELAXED, __HIP_MEMORY_SCOPE_AGENT);
      continue;
    }
    j -= J_MODS;
    if (j < J_WEFF) {
      const int g = j >> 4, cch = (j >> 1) & 7, nch = j & 1;
      float* wp = (float*)smem;
      for (int i = tid; i < 2048; i += NT) wp[i] = p.w_pool[(size_t)(g * 128 + cch * 16 + (i >> 7)) * 128 + (i & 127)];
      __syncthreads();
      const int n = nch * 512 + tid;
      float a[16];
#pragma unroll
      for (int c = 0; c < 16; ++c) a[c] = 0.f;
#pragma unroll 16
      for (int e = 0; e < 128; ++e) {
        const float wo = p.w_conv_out[(size_t)(512 + g * 128 + e) * 1024 + n] * p.pool_scale[g * 128 + e];
#pragma unroll
        for (int c = 0; c < 16; ++c) a[c] += wp[c * 128 + e] * wo;
      }
      bf16_t* d = (bf16_t*)(ws + O_WCONVOUT) + (size_t)n * 1024 + 512 + g * 128 + cch * 16;
      *(u32x4*)d = (u32x4){pack2(a[0], a[1]), pack2(a[2], a[3]), pack2(a[4], a[5]), pack2(a[6], a[7])};
      *(u32x4*)(d + 8) = (u32x4){pack2(a[8], a[9]), pack2(a[10], a[11]), pack2(a[12], a[13]), pack2(a[14], a[15])};
      __syncthreads();
      continue;
    }
    j -= J_WEFF;
    if (j < J_CACHE) {
      const int rr = j * 8 + wid, b = rr >> 8, t = rr & 255;
      const size_t kr = NCTX + (size_t)b * TKL + t;
      const f32x4 a0 = *(const f32x4*)(p.cache_k + (size_t)rr * 512 + lane * 8), a1 = *(const f32x4*)(p.cache_k + (size_t)rr * 512 + lane * 8 + 4);
      *(u32x4*)((bf16_t*)(ws + O_KD) + kr * 512 + lane * 8) = (u32x4){pack2(a0[0], a0[1]), pack2(a0[2], a0[3]), pack2(a1[0], a1[1]), pack2(a1[2], a1[3])};
      const f32x4 b0 = *(const f32x4*)(p.cache_v + (size_t)rr * 512 + lane * 8), b1 = *(const f32x4*)(p.cache_v + (size_t)rr * 512 + lane * 8 + 4);
      *(u32x4*)((bf16_t*)(ws + O_VD) + kr * 512 + lane * 8) = (u32x4){pack2(b0[0], b0[1]), pack2(b0[2], b0[3]), pack2(b1[0], b1[1]), pack2(b1[2], b1[3])};
      const f32x2 cv = *(const f32x2*)(p.cache_ckv + (size_t)rr * 128 + lane * 2);
      *(unsigned*)((bf16_t*)(ws + O_CKVN) + kr * 128 + lane * 2) = pack2(cv[0], cv[1]);
      const int idx = lane & 31;
      const float x = p.cache_krope[(size_t)rr * 32 + idx];
      const unsigned pk = pack2(x, x);
#pragma unroll
      for (int k = 0; k < 4; ++k) { const int hh = (lane >> 5) + 2 * k; ((bf16_t*)(ws + O_KMLA))[kr * 768 + hh * 96 + 64 + idx] = (bf16_t)(pk & 0xffff); }
      continue;
    }
    j -= J_CACHE;
    {
      float* c16 = (float*)(ws + O_C16); float* s16 = (float*)(ws + O_S16); float* c8 = (float*)(ws + O_C8); float* s8 = (float*)(ws + O_S8);
      for (int i = tid; i < 1024 + 512; i += NT) {
        int pos, f, half;
        if (i < 1024) { pos = i >> 4; f = i & 15; half = 16; } else { const int q = i - 1024; pos = q >> 3; f = q & 7; half = 8; }
        const float inv = (float)exp(-9.210340371976184 * (double)f / (double)half);
        const float angf = (float)pos * inv;
        const double ang = (double)angf;
        const double r = ang - 6.283185307179586 * rint(ang * 0.15915494309189535);
        const float cs = (float)cos_red(r), sn = (float)sin_red(r);
        if (i < 1024) { c16[i] = cs; s16[i] = sn; } else { c8[i - 1024] = cs; s8[i - 1024] = sn; }
      }
      if (wid == 0) {
        const float d1 = wave_sum(p.lam_q1[lane] * p.lam_k1[lane]), d2 = wave_sum(p.lam_q2[lane] * p.lam_k2[lane]);
        if (lane == 0) ((float*)(ws + O_SCAL))[0] = expf(d1) - expf(d2) + 0.2f;
      }
    }
  }
  {
    float* tile = (float*)smem;
    const int G = gridDim.x;
    int j = (blockIdx.x + G - (J_SLOW % G)) % G;
    float va[16], vb[16];
    TJ ta, tb;
    if (j < J_TR) { ta = tr_decode(p, j); tr_load(ta, va); } else ta = TJ{};
    if (j + G < J_TR) { tb = tr_decode(p, j + G); tr_load(tb, vb); } else tb = ta;
#define TR_STEP(V, T, jj_) do { \
      { const int n4 = (tid & 31) * 4, kb = tid >> 5; \
        _Pragma("unroll") for (int i = 0; i < 4; ++i) \
          _Pragma("unroll") for (int e = 0; e < 4; ++e) tile[(kb + 16 * i) * 129 + n4 + e] = V[4 * i + e]; } \
      __syncthreads(); \
      const TJ cur = T; \
      if ((jj_) + 2 * G < J_TR) { T = tr_decode(p, (jj_) + 2 * G); tr_load(T, V); }     \
      _Pragma("unroll") for (int ps = 0; ps < 2; ++ps) {     \
        const int n = ps * 64 + (tid >> 3), ks = (tid & 7) * 8; \
        int gn = cur.nt * 128 + n; \
        if (cur.perm) { if (gn < 512) gn = 32 * (gn >> 4) + (gn & 15); else if (gn < 1024) { const int c = gn - 512; gn = 32 * (c >> 4) + 16 + (c & 15); } } \
        unsigned w[4]; \
        _Pragma("unroll") for (int e = 0; e < 4; ++e) w[e] = pack2(tile[(ks + 2 * e) * 129 + n], tile[(ks + 2 * e + 1) * 129 + n]); \
        *(u32x4*)(cur.dst + (size_t)gn * cur.lddst + cur.kt * 64 + ks) = (u32x4){w[0], w[1], w[2], w[3]}; } \
      __syncthreads(); } while (0)
    while (j < J_TR) {
      TR_STEP(va, ta, j);
      j += G;
      if (j >= J_TR) break;
      TR_STEP(vb, tb, j);
      j += G;
    }
#undef TR_STEP
  }
  if (tid == 0) {
    unsigned sp = 0;
    while (__hip_atomic_load((unsigned*)(ws + O_CNT) + 2, __ATOMIC_RELAXED, __HIP_MEMORY_SCOPE_AGENT) < (unsigned)J_MODS) { __builtin_amdgcn_s_sleep(2); if (++sp > (1u << 22)) break; }
  }
  __syncthreads();
  modulate_phase(p.x_prompt, p.x_sample, (const float*)(ws + O_MODS), (bf16_t*)(ws + O_HB));
}

DI void rope8(const float (&x)[8], float (&o)[8], int lane, const float* c16, const float* s16, int prow, int pcol) {
  const int L = lane & 7;
  const int pos = (L & 4) ? pcol : prow;
  const bool second = (L & 2) != 0;
  const int fb = (L & 1) * 8;
#pragma unroll
  for (int e = 0; e < 8; ++e) {
    const float y = __shfl_xor(x[e], 2);
    const float cs = c16[pos * 16 + fb + e], sn = s16[pos * 16 + fb + e];
    o[e] = second ? (y * sn + x[e] * cs) : (x[e] * cs - y * sn);
  }
}
DI void unpack8(const u32x4 w, float (&x)[8]) {
#pragma unroll
  for (int e = 0; e < 4; ++e) { x[2 * e] = bflo(w[e]); x[2 * e + 1] = bfhi(w[e]); }
}
DI u32x4 pack8(const float (&x)[8]) { return (u32x4){pack2(x[0], x[1]), pack2(x[2], x[3]), pack2(x[4], x[5]), pack2(x[6], x[7])}; }

DI void phase3(const Params& p) {
  char* ws = p.ws;
  const bf16_t* R = (const bf16_t*)(ws + O_R);
  bf16_t* Qda = (bf16_t*)(ws + O_QDA); bf16_t* Qdb = (bf16_t*)(ws + O_QDB); bf16_t* Kd = (bf16_t*)(ws + O_KD); bf16_t* Vd = (bf16_t*)(ws + O_VD);
  bf16_t* cqn = (bf16_t*)(ws + O_CQN); bf16_t* ckvn = (bf16_t*)(ws + O_CKVN); bf16_t* Km = (bf16_t*)(ws + O_KMLA);
  const float* c16 = (const float*)(ws + O_C16); const float* s16 = (const float*)(ws + O_S16); const float* c8 = (const float*)(ws + O_C8); const float* s8 = (const float*)(ws + O_S8);
  float* o_k = p.out + (size_t)NTOK * 1024; float* o_v = o_k + (size_t)NCTX * 512; float* o_ckv = o_v + (size_t)NCTX * 512; float* o_kr = o_ckv + (size_t)NCTX * 128;
  const int lane = threadIdx.x & 63, gw = blockIdx.x * NWAVE + (threadIdx.x >> 6), nw = gridDim.x * NWAVE;
  for (int row = gw; row < NTOK; row += nw) {
    const bool lat = row >= NCTX;
    const int rl = row - NCTX, b = rl >> 12, t = rl & (TLAT - 1), prow = t >> 6, pcol = t & 63;
    const size_t kr = lat ? (size_t)NCTX + (size_t)b * TKL + 256 + t : (size_t)row;
    const bf16_t* r = R + (size_t)row * RLD;
    float x[8], o[8];
    const u32x4 wq = *(const u32x4*)(r + lane * 8);
    *(u32x4*)(Qda + (size_t)row * 512 + lane * 8) = wq;
    if (lat) { unpack8(wq, x); rope8(x, o, lane, c16, s16, prow, pcol); *(u32x4*)(Qdb + (size_t)rl * 512 + lane * 8) = pack8(o); }
    const u32x4 wk = *(const u32x4*)(r + 512 + lane * 8);
    if (lat) { unpack8(wk, x); rope8(x, o, lane, c16, s16, prow, pcol); *(u32x4*)(Kd + kr * 512 + lane * 8) = pack8(o); }
    else {
      unpack8(wk, x);
      *(f32x4*)(o_k + (size_t)row * 512 + lane * 8) = (f32x4){x[0], x[1], x[2], x[3]};
      *(f32x4*)(o_k + (size_t)row * 512 + lane * 8 + 4) = (f32x4){x[4], x[5], x[6], x[7]};
      *(u32x4*)(Kd + kr * 512 + lane * 8) = wk;
    }
    const u32x4 wv = *(const u32x4*)(r + 1024 + lane * 8);
    *(u32x4*)(Vd + kr * 512 + lane * 8) = wv;
    if (!lat) {
      unpack8(wv, x);
      *(f32x4*)(o_v + (size_t)row * 512 + lane * 8) = (f32x4){x[0], x[1], x[2], x[3]};
      *(f32x4*)(o_v + (size_t)row * 512 + lane * 8 + 4) = (f32x4){x[4], x[5], x[6], x[7]};
    }
    {
      const u32x2 w = *(const u32x2*)(r + 1536 + lane * 4);
      const float a0 = bflo(w[0]), a1 = bfhi(w[0]), a2 = bflo(w[1]), a3 = bfhi(w[1]);
      const float ss = wave_sum(a0 * a0 + a1 * a1 + a2 * a2 + a3 * a3);
      const float sc = rsqrtf(ss * (1.f / 256.f) + EPS);
      const f32x4 g = *(const f32x4*)(p.q_norm_g + lane * 4);
      *(u32x2*)(cqn + (size_t)row * 256 + lane * 4) = (u32x2){pack2(a0 * sc * g[0], a1 * sc * g[1]), pack2(a2 * sc * g[2], a3 * sc * g[3])};
    }
    {
      const unsigned w = *(const unsigned*)(r + 1792 + lane * 2);
      const float a0 = bflo(w), a1 = bfhi(w);
      const float ss = wave_sum(a0 * a0 + a1 * a1);
      const float sc = rsqrtf(ss * (1.f / 128.f) + EPS);
      const f32x2 g = *(const f32x2*)(p.kv_norm_g + lane * 2);
      const float y0 = a0 * sc * g[0], y1 = a1 * sc * g[1];
      if (!lat) *(f32x2*)(o_ckv + (size_t)row * 128 + lane * 2) = (f32x2){y0, y1};
      *(unsigned*)(ckvn + kr * 128 + lane * 2) = pack2(y0, y1);
    }
    {
      const int idx = lane & 31;
      const float xv = bf2f(r[1920 + idx]);
      float ov = xv;
      if (lat) {
        const int pos = (idx & 16) ? pcol : prow;
        const int f = idx & 7;
        const float y = __shfl_xor(xv, 8);
        const float cs = c8[pos * 8 + f], sn = s8[pos * 8 + f];
        ov = (idx & 8) ? (y * sn + xv * cs) : (xv * cs - y * sn);
      } else if (lane < 32) o_kr[(size_t)row * 32 + idx] = xv;
      const bf16_t ob = (bf16_t)(pack2(ov, ov) & 0xffff);
#pragma unroll
      for (int k = 0; k < 4; ++k) { const int hh = (lane >> 5) + 2 * k; Km[kr * 768 + hh * 96 + 64 + idx] = ob; }
    }
  }
}

template <int DQK, int DV>
DI void attn_core(const bf16_t* __restrict__ Qa, const bf16_t* __restrict__ Qb, int ldq, const bf16_t* __restrict__ Kp, int ldk, const bf16_t* __restrict__ Vp, int ldv,
                  int Tk, int n_a, float c  , char* smem, f32x16 (&o)[DV / 32]) {
  constexpr int KS = DQK * 2 + 16, VS = DV * 2 + 64, BUF = 64 * (KS + VS);
  constexpr int KCH = DQK / 8, VCH = DV / 8, NKCH = 64 * KCH, NVCH = 64 * VCH, NKC = (NKCH + NT - 1) / NT, NVC = (NVCH + NT - 1) / NT;
  constexpr bool KG = (NKCH % NT) != 0, VG = (NVCH % NT) != 0;
  constexpr int NS = DQK / 16, NDT = DV / 32;
  const int tid = threadIdx.x, lane = tid & 63, wid = tid >> 6, h = lane >> 5, ql = lane & 31;
  bf16x8 qf[NS];
  {
    const bf16_t* q = Qa + (size_t)(wid * 32 + ql) * ldq + h * 8;
#pragma unroll
    for (int s = 0; s < NS; ++s) qf[s] = *(const bf16x8*)(q + s * 16);
  }
#pragma unroll
  for (int dt = 0; dt < NDT; ++dt)
#pragma unroll
    for (int r = 0; r < 16; ++r) o[dt][r] = 0.f;
  float m_run = -INFINITY, l_run = 0.f;
  u32x4 rkA[NKC], rvA[NVC], rkB[NKC], rvB[NVC];
  const int nt = Tk >> 6, ta = n_a >> 6;
  unsigned koff[NKC], voff[NVC];
#pragma unroll
  for (int i = 0; i < NKC; ++i) { const int ch = (tid + NT * i) % NKCH, row = ch / KCH, kc = ch % KCH; koff[i] = (unsigned)(row * ldk + kc * 8); }
#pragma unroll
  for (int i = 0; i < NVC; ++i) { const int ch = (tid + NT * i) % NVCH, row = ch / VCH, vc = ch % VCH; voff[i] = (unsigned)(row * ldv + vc * 8); }
  auto gload = [&](u32x4 (&rk)[NKC], u32x4 (&rv)[NVC], int t) {
    const bf16_t* kb = Kp + (size_t)t * 64 * ldk;
    const bf16_t* vbp = Vp + (size_t)t * 64 * ldv;
#pragma unroll
    for (int i = 0; i < NKC; ++i) rk[i] = *(const u32x4*)(kb + koff[i]);
#pragma unroll
    for (int i = 0; i < NVC; ++i) rv[i] = *(const u32x4*)(vbp + voff[i]);
  };
  auto lstore = [&](u32x4 (&rk)[NKC], u32x4 (&rv)[NVC], char* buf) {
#pragma unroll
    for (int i = 0; i < NKC; ++i) { const int ch = tid + NT * i, row = ch / KCH, kc = ch % KCH; if (!KG || i + 1 < NKC || ch < NKCH) *(u32x4*)(buf + row * KS + kc * 16) = rk[i]; }
#pragma unroll
    for (int i = 0; i < NVC; ++i) { const int ch = tid + NT * i, row = ch / VCH, vc = ch % VCH; if (!VG || i + 1 < NVC || ch < NVCH) *(u32x4*)(buf + 64 * KS + row * VS + vc * 16) = rv[i]; }
  };
  gload(rkA, rvA, 0); lstore(rkA, rvA, smem); lds_barrier();
  gload(rkA, rvA, min(1, nt - 1));
  const int i16 = lane & 15, tq = i16 >> 2, tp = i16 & 3, G = (lane >> 4) & 1;
  auto compute = [&](const char* cur) {
    f32x16 st[2];
    bf16x8 kf[2][NS];
#pragma unroll
    for (int kt = 0; kt < 2; ++kt)
#pragma unroll
      for (int s = 0; s < NS; ++s) kf[kt][s] = *(const bf16x8*)(cur + (kt * 32 + ql) * KS + s * 32 + h * 16);
#pragma unroll
    for (int kt = 0; kt < 2; ++kt) {
#pragma unroll
      for (int r = 0; r < 16; ++r) st[kt][r] = 0.f;
#pragma unroll
      for (int s = 0; s < NS; ++s) st[kt] = __builtin_amdgcn_mfma_f32_32x32x16_bf16(kf[kt][s], qf[s], st[kt], 0, 0, 0);
    }
    __builtin_amdgcn_sched_barrier(0);
    float mx = st[0][0];
#pragma unroll
    for (int kt = 0; kt < 2; ++kt)
#pragma unroll
      for (int r = 0; r < 16; ++r) mx = fmaxf(mx, st[kt][r]);
    mx = fmaxf(mx, __shfl_xor(mx, 32));
    const float m_new = fmaxf(m_run, mx);
    const float alpha = __builtin_amdgcn_exp2f((m_run - m_new) * c);
    const float mc = m_new * c;
    m_run = m_new;
    f32x2 ls2 = {0.f, 0.f};
#pragma unroll
    for (int kt = 0; kt < 2; ++kt) {
      const f32x16 tv = st[kt] * c - mc;
#pragma unroll
      for (int r = 0; r < 16; r += 2) {
        const f32x2 pv = {__builtin_amdgcn_exp2f(tv[r]), __builtin_amdgcn_exp2f(tv[r + 1])};
        st[kt][r] = pv[0]; st[kt][r + 1] = pv[1];
        ls2 += pv;
      }
    }
    l_run = l_run * alpha + (ls2[0] + ls2[1]);
    if (__any(alpha != 1.f)) {
#pragma unroll
      for (int dt = 0; dt < NDT; ++dt)
#pragma unroll
        for (int r = 0; r < 16; ++r) o[dt][r] *= alpha;
    }
    bf16x8 pf[2][2];
#pragma unroll
    for (int kt = 0; kt < 2; ++kt)
#pragma unroll
      for (int s2 = 0; s2 < 2; ++s2) {
        u32x4 w = {pack2(st[kt][8 * s2 + 0], st[kt][8 * s2 + 1]), pack2(st[kt][8 * s2 + 2], st[kt][8 * s2 + 3]), pack2(st[kt][8 * s2 + 4], st[kt][8 * s2 + 5]), pack2(st[kt][8 * s2 + 6], st[kt][8 * s2 + 7])};
        pf[kt][s2] = __builtin_bit_cast(bf16x8, w);
      }
    const char* vb = cur + 64 * KS + (4 * h + tq) * VS + 32 * G + 8 * tp;
    bf16x8 vfa[NDT], vfb[NDT];
#define A_VLOAD(VF, g_) do { \
      _Pragma("unroll") for (int dt = 0; dt < NDT; ++dt) { \
        const char* a0 = vb + (((g_) >> 1) * 32 + 16 * ((g_) & 1)) * VS + dt * 64; \
        const s16x4 lo = __builtin_amdgcn_ds_read_tr16_b64_v4i16((LDS_AS s16x4*)(a0)); \
        const s16x4 hi = __builtin_amdgcn_ds_read_tr16_b64_v4i16((LDS_AS s16x4*)(a0 + 8 * VS)); \
        VF[dt] = __builtin_shufflevector(lo, hi, 0, 1, 2, 3, 4, 5, 6, 7); } } while (0)
#define A_VMMA(VF, g_) do { \
      _Pragma("unroll") for (int dt = 0; dt < NDT; ++dt) o[dt] = __builtin_amdgcn_mfma_f32_32x32x16_bf16(VF[dt], pf[(g_) >> 1][(g_) & 1], o[dt], 0, 0, 0); } while (0)
    A_VLOAD(vfa, 0);
    A_VLOAD(vfb, 1);
    __builtin_amdgcn_sched_barrier(0);
    A_VMMA(vfa, 0);
    __builtin_amdgcn_sched_barrier(0);
    A_VLOAD(vfa, 2);
    __builtin_amdgcn_sched_barrier(0);
    A_VMMA(vfb, 1);
    __builtin_amdgcn_sched_barrier(0);
    A_VLOAD(vfb, 3);
    __builtin_amdgcn_sched_barrier(0);
    A_VMMA(vfa, 2);
    __builtin_amdgcn_sched_barrier(0);
    A_VMMA(vfb, 3);
#undef A_VLOAD
#undef A_VMMA
  };
  auto run_tiles = [&](int t_begin, int t_end) {
    for (int t = t_begin; t < t_end; t += 2) {
      gload(rkB, rvB, min(t + 2, nt - 1));
      compute(smem);
      lstore(rkA, rvA, smem + BUF);
      lds_barrier();
      gload(rkA, rvA, min(t + 3, nt - 1));
      compute(smem + BUF);
      lstore(rkB, rvB, smem);
      lds_barrier();
    }
  };
  if (wid >= 4) __builtin_amdgcn_s_setprio(1);
  run_tiles(0, min(ta, nt));
  if (ta < nt) {
    const bf16_t* q = Qb + (size_t)(wid * 32 + ql) * ldq + h * 8;
#pragma unroll
    for (int s = 0; s < NS; ++s) qf[s] = *(const bf16x8*)(q + s * 16);
    run_tiles(ta, nt);
  }
  __builtin_amdgcn_s_setprio(0);
  const float l = l_run + __shfl_xor(l_run, 32);
  const float inv = 1.f / l;
#pragma unroll
  for (int dt = 0; dt < NDT; ++dt)
#pragma unroll
    for (int r = 0; r < 16; ++r) o[dt][r] *= inv;
}

constexpr int U_DBIG = 128, U_MBIG = 256, U_DCTX = 64, U_MCTX = 128, U_TOTAL = U_DBIG + U_MBIG + U_DCTX + U_MCTX;

DI void phase_attn(const Params& p, char* smem, int cidx) {
  char* ws = p.ws;
  const bf16_t* Qda = (const bf16_t*)(ws + O_QDA); const bf16_t* Qdb = (const bf16_t*)(ws + O_QDB); const bf16_t* Kd = (const bf16_t*)(ws + O_KD); const bf16_t* Vd = (const bf16_t*)(ws + O_VD);
  const bf16_t* Qma = (const bf16_t*)(ws + O_QMA); const bf16_t* Qmb = (const bf16_t*)(ws + O_QMB); const bf16_t* Km = (const bf16_t*)(ws + O_KMLA); const bf16_t* Vm = (const bf16_t*)(ws + O_VMLA);
  bf16_t* cat = (bf16_t*)(ws + O_HB);
  float* otmp = (float*)(ws + O_OTMP) + (size_t)blockIdx.x * 32768;
  int* counter = (int*)(ws + O_CNT) + cidx;
  int* s_unit = (int*)(smem + 65532);
  const int tid = threadIdx.x, lane = tid & 63, wid = tid >> 6, h2 = lane >> 5, ql = lane & 31;
  const float lam = ((const float*)(ws + O_SCAL))[0];
  for (;;) {
    if (tid == 0) *s_unit = atomicAdd(counter, 1);
    __syncthreads();
    int u = __builtin_amdgcn_readfirstlane(*s_unit);
    __syncthreads();
    if (u >= U_TOTAL) break;
    bool diff; int qrow0, krow0, Tk, n_a, head; bool lat;
    if (u < U_DBIG) { diff = true; lat = true; const int b = u >> 6, hh = (u >> 4) & 3, qb = u & 15; head = hh; qrow0 = NCTX + b * TLAT + qb * 256; krow0 = NCTX + b * TKL; Tk = TKL; n_a = 256; }
    else if (u < U_DBIG + U_MBIG) { u -= U_DBIG; diff = false; lat = true; const int b = u >> 7, hh = (u >> 4) & 7, qb = u & 15; head = hh; qrow0 = NCTX + b * TLAT + qb * 256; krow0 = NCTX + b * TKL; Tk = TKL; n_a = 256; }
    else if (u < U_DBIG + U_MBIG + U_DCTX) { u -= U_DBIG + U_MBIG; diff = true; lat = false; const int sq = u >> 2, hh = u & 3; head = hh; qrow0 = sq * 256; krow0 = sq * 256; Tk = 256; n_a = 256; }
    else { u -= U_DBIG + U_MBIG + U_DCTX; diff = false; lat = false; const int sq = u >> 3, hh = u & 7; head = hh; qrow0 = sq * 256; krow0 = sq * 256; Tk = 256; n_a = 256; }
    const int qrowb = lat ? qrow0 - NCTX : 0;
    if (diff) {
      f32x16 o[4];
      const float c = 0.125f * 1.4426950408889634f;
#pragma unroll 1
      for (int m = 0; m < 2; ++m) {
        attn_core<64, 128>(Qda + (size_t)qrow0 * 512 + head * 128 + m * 64, Qdb + (size_t)qrowb * 512 + head * 128 + m * 64, 512,
                           Kd + (size_t)krow0 * 512 + head * 128 + m * 64, 512, Vd + (size_t)krow0 * 512 + head * 128, 512, Tk, n_a, c, smem, o);
        if (m == 0) {
#pragma unroll
          for (int dt = 0; dt < 4; ++dt)
#pragma unroll
            for (int rq = 0; rq < 4; ++rq) *(f32x4*)(otmp + tid * 64 + dt * 16 + rq * 4) = (f32x4){o[dt][4 * rq], o[dt][4 * rq + 1], o[dt][4 * rq + 2], o[dt][4 * rq + 3]};
        }
      }
      float ss = 0.f;
#pragma unroll
      for (int dt = 0; dt < 4; ++dt)
#pragma unroll
        for (int rq = 0; rq < 4; ++rq) {
          const f32x4 o0 = *(const f32x4*)(otmp + tid * 64 + dt * 16 + rq * 4);
#pragma unroll
          for (int e = 0; e < 4; ++e) { const float v = o0[e] - lam * o[dt][4 * rq + e]; o[dt][4 * rq + e] = v; ss += v * v; }
        }
      ss += __shfl_xor(ss, 32);
      const float sc = rsqrtf(ss * (1.f / 128.f) + EPS) * 0.8f;
      bf16_t* dst = cat + (size_t)(qrow0 + wid * 32 + ql) * 1024 + head * 128;
#pragma unroll
      for (int dt = 0; dt < 4; ++dt)
#pragma unroll
        for (int rq = 0; rq < 4; ++rq) {
          const int dv = dt * 32 + 8 * rq + 4 * h2;
          const f32x4 g = *(const f32x4*)(p.diff_norm_g + dv);
          u32x2 w = {pack2(o[dt][4 * rq] * sc * g[0], o[dt][4 * rq + 1] * sc * g[1]), pack2(o[dt][4 * rq + 2] * sc * g[2], o[dt][4 * rq + 3] * sc * g[3])};
          *(u32x2*)(dst + dv) = w;
        }
    } else {
      f32x16 o[2];
      const float c = 0.10206207261596575f * 1.4426950408889634f;
      attn_core<96, 64>(Qma + (size_t)qrow0 * 768 + head * 96, Qmb + (size_t)qrowb * 768 + head * 96, 768,
                        Km + (size_t)krow0 * 768 + head * 96, 768, Vm + (size_t)krow0 * 512 + head * 64, 512, Tk, n_a, c, smem, o);
      bf16_t* dst = cat + (size_t)(qrow0 + wid * 32 + ql) * 1024 + 512 + head * 64;
#pragma unroll
      for (int dt = 0; dt < 2; ++dt)
#pragma unroll
        for (int rq = 0; rq < 4; ++rq) {
          const int dv = dt * 32 + 8 * rq + 4 * h2;
          u32x2 w = {pack2(o[dt][4 * rq], o[dt][4 * rq + 1]), pack2(o[dt][4 * rq + 2], o[dt][4 * rq + 3])};
          *(u32x2*)(dst + dv) = w;
        }
    }
  }
}

DI void unpack8f(const u32x4 w, float (&x)[8]) {
#pragma unroll
  for (int e = 0; e < 4; ++e) { x[2 * e] = bflo(w[e]); x[2 * e + 1] = bfhi(w[e]); }
}
DI void phase_conv(const Params& p, char* smem) {
  constexpr int TT = 8;
  char* ws = p.ws;
  const bf16_t* Ug = (const bf16_t*)(ws + O_UG); const bf16_t* Pz = (const bf16_t*)(ws + O_PZ);
  bf16_t* cat = (bf16_t*)(ws + O_HB);
  const int tid = threadIdx.x, lane = tid & 63, wid = tid >> 6;
  float* wl = (float*)smem;
  {
    f32x4 wv[8];
#pragma unroll
    for (int k = 0; k < 8; ++k) { const int i4 = tid + NT * k; wv[k] = (f32x4){0.f, 0.f, 0.f, 0.f}; if (i4 < 31 * 128) wv[k] = *(const f32x4*)(p.conv_w + i4 * 4); }
#pragma unroll
    for (int k = 0; k < 8; ++k) {
      const int i4 = tid + NT * k, j = i4 >> 7, c = (i4 & 127) * 4, lc = c >> 3, hf = (c >> 2) & 1;
      if (i4 < 31 * 128) *(f32x4*)(wl + ((j * 2 + hf) * 64 + lc) * 4) = wv[k];
    }
  }
  __syncthreads();
  const int c0 = lane * 8;
  const int grp = lane >> 4, HW = 1 << grp;
  for (int u = blockIdx.x * NWAVE + wid; u < NTOK / TT; u += gridDim.x * NWAVE) {
    const int t0 = u * TT;
    const int s0 = t0 < NCTX ? (t0 & ~255) : NCTX + ((t0 - NCTX) & ~(TLAT - 1));
    const int s1 = t0 < NCTX ? s0 + 256 : s0 + TLAT;
    {
      u32x4 pr[TT + 16];
#pragma unroll
      for (int i = 0; i < TT + 16; ++i) {
        const int r = t0 - 8 + i;
        pr[i] = (u32x4){0u, 0u, 0u, 0u};
        if (r >= s0 && r < s1) pr[i] = *(const u32x4*)(Pz + (size_t)r * 512 + c0);
      }
#pragma unroll
      for (int o = 0; o < TT; ++o) {
        const int r = t0 + o, ci = o + 8;
        float s[8], x[8], ctr[8], s2[8], s4[8], s8[8];
        unpack8f(pr[ci], ctr);
        unpack8f(pr[ci - 1], x);
#pragma unroll
        for (int e = 0; e < 8; ++e) { s[e] = x[e] + ctr[e]; s2[e] = s[e]; }
#pragma unroll
        for (int d = 0; d < 2; ++d) { unpack8f(pr[d == 0 ? ci - 2 : ci + 1], x);
#pragma unroll
          for (int e = 0; e < 8; ++e) s[e] += x[e]; }
#pragma unroll
        for (int e = 0; e < 8; ++e) s4[e] = s[e];
#pragma unroll
        for (int d = 0; d < 4; ++d) { unpack8f(pr[d < 2 ? ci - 4 + d : ci + d], x);
#pragma unroll
          for (int e = 0; e < 8; ++e) s[e] += x[e]; }
#pragma unroll
        for (int e = 0; e < 8; ++e) s8[e] = s[e];
#pragma unroll
        for (int d = 0; d < 8; ++d) { unpack8f(pr[d < 4 ? ci - 8 + d : ci + d], x);
#pragma unroll
          for (int e = 0; e < 8; ++e) s[e] += x[e]; }
        const int lo = max(r - HW, s0), hi = min(r + HW - 1, s1 - 1);
        const float ic = 1.f / (float)(hi - lo + 1);
        float dv[8];
#pragma unroll
        for (int e = 0; e < 8; ++e) { const float sm = grp == 0 ? s2[e] : grp == 1 ? s4[e] : grp == 2 ? s8[e] : s[e]; dv[e] = sm * ic - ctr[e]; }
        *(u32x4*)(cat + (size_t)r * 1024 + 512 + c0) = (u32x4){pack2(dv[0], dv[1]), pack2(dv[2], dv[3]), pack2(dv[4], dv[5]), pack2(dv[6], dv[7])};
      }
    }
    f32x2 acc2[TT][4];
#pragma unroll
    for (int o = 0; o < TT; ++o)
#pragma unroll
      for (int e = 0; e < 4; ++e) acc2[o][e] = (f32x2){0.f, 0.f};
    u32x4 q0, q1, q2, q3;
#define CV_ROW(i_) ({ const int r_ = t0 - 15 + (i_); u32x4 v_ = {0u, 0u, 0u, 0u}; if ((i_) < TT + 30 && r_ >= s0 && r_ < s1) v_ = *(const u32x4*)(Ug + (size_t)r_ * 512 + c0); v_; })
    q0 = CV_ROW(0); q1 = CV_ROW(1); q2 = CV_ROW(2); q3 = CV_ROW(3);
#pragma unroll 2
    for (int i = 0; i < TT + 30; ++i) {
      const u32x4 w = q0;
      q0 = q1; q1 = q2; q2 = q3; q3 = CV_ROW(i + 4);
      f32x2 x2[4];
#pragma unroll
      for (int e = 0; e < 4; ++e) x2[e] = (f32x2){bflo(w[e]), bfhi(w[e])};
#pragma unroll
      for (int o = 0; o < TT; ++o) {
        const int j = i - o;
        if ((unsigned)j <= 30u) {
          const f32x4 w0 = *(const f32x4*)(wl + ((j * 2 + 0) * 64 + lane) * 4), w1 = *(const f32x4*)(wl + ((j * 2 + 1) * 64 + lane) * 4);
          acc2[o][0] += x2[0] * (f32x2){w0[0], w0[1]}; acc2[o][1] += x2[1] * (f32x2){w0[2], w0[3]};
          acc2[o][2] += x2[2] * (f32x2){w1[0], w1[1]}; acc2[o][3] += x2[3] * (f32x2){w1[2], w1[3]};
        }
      }
    }
#undef CV_ROW
    const f32x4 bias0 = *(const f32x4*)(p.conv_b + c0), bias1 = *(const f32x4*)(p.conv_b + c0 + 4);
    const f32x4 g0 = *(const f32x4*)(p.conv_norm_g + c0), g1 = *(const f32x4*)(p.conv_norm_g + c0 + 4);
    const f32x4 b0 = *(const f32x4*)(p.conv_norm_b + c0), b1 = *(const f32x4*)(p.conv_norm_b + c0 + 4);
#pragma unroll
    for (int o = 0; o < TT; ++o) {
      float v[8];
#pragma unroll
      for (int e = 0; e < 4; ++e) { v[e] = acc2[o][e >> 1][e & 1] + bias0[e]; v[4 + e] = acc2[o][2 + (e >> 1)][e & 1] + bias1[e]; }
      float sm = 0.f;
#pragma unroll
      for (int e = 0; e < 8; ++e) sm += v[e];
      const float mean = wave_sum(sm) * (1.f / 512.f);
      float q = 0.f;
#pragma unroll
      for (int e = 0; e < 8; ++e) { const float d = v[e] - mean; q += d * d; }
      const float rstd = rsqrtf(wave_sum(q) * (1.f / 512.f) + EPS);
      float y[8];
#pragma unroll
      for (int e = 0; e < 4; ++e) {
        const float z0 = (v[e] - mean) * rstd * g0[e] + b0[e], z1 = (v[4 + e] - mean) * rstd * g1[e] + b1[e];
        y[e] = z0 / (1.f + __expf(-z0)); y[4 + e] = z1 / (1.f + __expf(-z1));
      }
      *(u32x4*)(cat + (size_t)(t0 + o) * 1024 + c0) = (u32x4){pack2(y[0], y[1]), pack2(y[2], y[3]), pack2(y[4], y[5]), pack2(y[6], y[7])};
    }
  }
  __syncthreads();
}

__global__ void __launch_bounds__(NT, 2) fwd_kernel(Params p, int ph_lo, int ph_hi) {
  __shared__ __attribute__((aligned(16))) char smem[2 * G_STAGE + 12288];
  __shared__ uint4 xb_words;
  cg::grid_group grid = cg::this_grid();
  char* ws = p.ws;
  if (threadIdx.x == 0) xb_words = make_uint4(0u, 0u, 0u, 0u);
  __syncthreads();
  const XcdBarrier xb = xcd_barrier_post((unsigned*)(ws + O_BAR), (volatile LDS_AS unsigned*)&xb_words);
  if (ph_lo > 1000) grid.sync();
  float* mods = (float*)(ws + O_MODS);
  bf16_t* Hb = (bf16_t*)(ws + O_HB);
  float* X = p.out;
  float* xbuf = (float*)(ws + O_XBUF);
  unsigned* lncnt = (unsigned*)(ws + O_LNCNT);
  const bool fused = (gridDim.x == 256);
#define GSYNC() xcd_barrier(xb)
#define PH_BEGIN(n) if (ph_lo <= n && n < ph_hi) { if (n > ph_lo) GSYNC();
#define PH_BEGIN_IF(n, c) if (ph_lo <= n && n < ph_hi && (c)) { if (n > ph_lo) GSYNC();
#define PH_END }
#ifndef PROBE_DUP
#define PROBE_DUP 0
#endif
#ifndef PROBE_SYNCS
#define PROBE_SYNCS 0
#endif
#define DUP(n, ...) __VA_ARGS__; if ((PROBE_DUP >> n) & 1) { GSYNC(); __VA_ARGS__; }
  for (int i = 0; i < PROBE_SYNCS; ++i) GSYNC();
  PH_BEGIN(0) { DUP(0, phase0(p, smem)); } PH_END
  PH_BEGIN(2) {
    float* o_k = p.out + (size_t)NTOK * 1024; float* o_v = o_k + (size_t)NCTX * 512; float* o_ckv = o_v + (size_t)NCTX * 512; float* o_kr = o_ckv + (size_t)NCTX * 128;
    DUP(2, gemm_phase(Hb, 1024, (const bf16_t*)(ws + O_WATTIN), 1024, 1024, 64, 8,
                      EpiAttIn{(bf16_t*)(ws + O_QDA), (bf16_t*)(ws + O_QDB), (bf16_t*)(ws + O_KD), (bf16_t*)(ws + O_VD), (bf16_t*)(ws + O_CQN), (bf16_t*)(ws + O_CKVN), (bf16_t*)(ws + O_KMLA),
                               o_k, o_v, o_ckv, o_kr, (const float*)(ws + O_C16), (const float*)(ws + O_S16), (const float*)(ws + O_C8), (const float*)(ws + O_S8), p.q_norm_g, p.kv_norm_g, smem + 2 * G_STAGE}, smem));
  } PH_END
  PH_BEGIN(4) {
        const int n1 = 64 * 3, n2 = 67 * 4;
        gemm_phase((const bf16_t*)(ws + O_CQN), 256, (const bf16_t*)(ws + O_WUQ), 256, 256, 64, 3,
                   EpiUq{(bf16_t*)(ws + O_QMA), (bf16_t*)(ws + O_QMB), (const float*)(ws + O_C8), (const float*)(ws + O_S8)}, smem, 0, n1 + n2);
        gemm_phase((const bf16_t*)(ws + O_CKVN), 128, (const bf16_t*)(ws + O_WUKV), 128, 128, 67, 4,
                   EpiUkv{(bf16_t*)(ws + O_KMLA), (bf16_t*)(ws + O_VMLA), smem}, smem, n1, n1 + n2);
  } PH_END
  PH_BEGIN(5) { phase_attn(p, smem, 0); if ((PROBE_DUP >> 5) & 1) { GSYNC(); phase_attn(p, smem, 1); } } PH_END
  PH_BEGIN(6) { gemm_phase(Hb, 1024, (const bf16_t*)(ws + O_WATTOUT), 1024, 1024, 64, 4, EpiResLN{p.x_prompt, p.x_sample, mods + 2048, X, p.ln_mix_g, p.ln_mix_b, mods, 3072, 4096, Hb, xbuf, lncnt, smem + 2 * G_STAGE, fused}, smem); } PH_END
  PH_BEGIN_IF(7, !fused) { rows_phase(X, X + (size_t)NCTX * 1024, true, p.ln_mix_g, p.ln_mix_b, X, mods, 3072, 4096, Hb); } PH_END
  PH_BEGIN(8) { DUP(8, gemm_phase(Hb, 1024, (const bf16_t*)(ws + O_WMLPIN), 1024, 1024, 64, 16, EpiRelu2{(bf16_t*)(ws + O_U), smem + G_STAGE}, smem)); } PH_END
  PH_BEGIN(9) { gemm_phase((const bf16_t*)(ws + O_U), 4096, (const bf16_t*)(ws + O_WMLPOUT), 4096, 4096, 64, 4, EpiResLN{X, X + (size_t)NCTX * 1024, mods + 5120, X, p.ln_mlp_g, p.ln_mlp_b, mods + 3 * 6144, 0, 1024, Hb, xbuf + 98304, lncnt + 64, smem + 2 * G_STAGE, fused}, smem); } PH_END
  PH_BEGIN_IF(10, !fused) { rows_phase(X, X + (size_t)NCTX * 1024, true, p.ln_mlp_g, p.ln_mlp_b, X, mods + 3 * 6144, 0, 1024, Hb); } PH_END
  PH_BEGIN(11) { DUP(11, gemm_phase(Hb, 1024, (const bf16_t*)(ws + O_WCONVIN), 1024, 1024, 64, 6, EpiConv{(bf16_t*)(ws + O_UG), (bf16_t*)(ws + O_PZ), smem}, smem)); } PH_END
  PH_BEGIN(12) { DUP(12, phase_conv(p, smem)); } PH_END
  PH_BEGIN(13) { gemm_phase(Hb, 1024, (const bf16_t*)(ws + O_WCONVOUT), 1024, 1024, 64, 4, EpiResLN{X, X + (size_t)NCTX * 1024, mods + 3 * 6144 + 2048, X, p.ln_mix_g + 1024, p.ln_mix_b + 1024, mods + 3 * 6144, 3072, 4096, Hb, xbuf + 2 * 98304, lncnt + 128, smem + 2 * G_STAGE, fused}, smem); } PH_END
  PH_BEGIN_IF(14, !fused) { rows_phase(X, X + (size_t)NCTX * 1024, true, p.ln_mix_g + 1024, p.ln_mix_b + 1024, X, mods + 3 * 6144, 3072, 4096, Hb); } PH_END
  PH_BEGIN(15) { DUP(15, gemm_phase(Hb, 1024, (const bf16_t*)(ws + O_WMLPIN) + (size_t)4096 * 1024, 1024, 1024, 64, 16, EpiRelu2{(bf16_t*)(ws + O_U), smem + G_STAGE}, smem)); } PH_END
  PH_BEGIN(16) { gemm_phase((const bf16_t*)(ws + O_U), 4096, (const bf16_t*)(ws + O_WMLPOUT) + (size_t)4096 * 1024, 4096, 4096, 64, 4, EpiResLN{X, X + (size_t)NCTX * 1024, mods + 3 * 6144 + 5120, X, p.ln_mlp_g + 1024, p.ln_mlp_b + 1024, mods, 0, 0, nullptr, xbuf + 3 * 98304, lncnt + 192, smem + 2 * G_STAGE, fused}, smem); } PH_END
  PH_BEGIN_IF(17, !fused) { rows_phase(X, X + (size_t)NCTX * 1024, true, p.ln_mlp_g + 1024, p.ln_mlp_b + 1024, X, nullptr, 0, 0, nullptr); } PH_END
}

extern "C" void kernel_launch(void* const* d_in, const int* in_sizes, int n_in, void* d_out, int out_size, void* d_ws, size_t ws_size, hipStream_t stream) {
  static int grid_blocks = 0;
  if (!grid_blocks) {
    int dev = 0, cus = 0, per_cu = 0;
    hipGetDevice(&dev);
    hipDeviceGetAttribute(&cus, hipDeviceAttributeMultiprocessorCount, dev);
    hipOccupancyMaxActiveBlocksPerMultiprocessor(&per_cu, fwd_kernel, NT, 0);
    if (per_cu > 1) per_cu = 1;
    if (per_cu < 1) per_cu = 1;
    grid_blocks = cus * per_cu;
    if (grid_blocks > 256) grid_blocks = 256;
  }
  if (ws_size < WS_NEED) { fprintf(stderr, "workspace too small: %zu < %zu\n", ws_size, (size_t)WS_NEED); return; }
  Params p{};
  const float** f = (const float**)&p;
  for (int i = 0; i < 35; ++i) f[i] = (const float*)d_in[i];
  p.out = (float*)d_out;
  p.ws = (char*)d_ws;
  hipMemsetAsync(d_ws, 0, 16384, stream);
  int lo = 0, hi = NPHASE;
  void* args[] = {&p, &lo, &hi};
  hipError_t e = hipLaunchCooperativeKernel((void*)fwd_kernel, dim3(grid_blocks), dim3(NT), args, 0, stream);
  if (e != hipSuccess) fprintf(stderr, "cooperative launch failed: %s (grid %d)\n", hipGetErrorString(e), grid_blocks);
}
```

```cpp
#include <hip/hip_runtime.h>
#include <hip/hip_cooperative_groups.h>
#include <cstdio>
#include <cstdint>
namespace cg = cooperative_groups;

typedef unsigned short bf16_t;
typedef short bf16x8 __attribute__((ext_vector_type(8)));
typedef short s16x4 __attribute__((ext_vector_type(4)));
typedef float f32x4 __attribute__((ext_vector_type(4)));
typedef float f32x2 __attribute__((ext_vector_type(2)));
typedef float f32x16 __attribute__((ext_vector_type(16)));
typedef unsigned u32x4 __attribute__((ext_vector_type(4)));
typedef unsigned u32x2 __attribute__((ext_vector_type(2)));
typedef __bf16 bf16v2 __attribute__((ext_vector_type(2)));
#define DI __device__ __forceinline__
#define LDS_AS __attribute__((address_space(3)))

constexpr int NTOK = 12288, NCTX = 4096, NKEY = 12800, TLAT = 4096, TKL = 4352;
constexpr int RLD = 1952;
constexpr float ALPHA = 1.41421356237f, EPS = 1e-5f;
constexpr int NPHASE = 18;
constexpr int NT = 512, NWAVE = 8;

constexpr size_t al(size_t x) { return (x + 255) & ~(size_t)255; }
constexpr size_t O_CNT = 0;
constexpr size_t O_BAR = 256;
constexpr size_t O_LNCNT = 14336;
constexpr size_t O_MODS = 16384;
constexpr size_t O_SCAL = O_MODS + al(2 * 3 * 6144 * 4);
constexpr size_t O_C16 = O_SCAL + 256;
constexpr size_t O_S16 = O_C16 + 4096;
constexpr size_t O_C8 = O_S16 + 4096;
constexpr size_t O_S8 = O_C8 + 2048;
constexpr size_t O_XBUF = O_S8 + 2048;
constexpr size_t O_WATTIN = O_XBUF + (size_t)4 * 256 * 192 * 2 * 4;
constexpr size_t O_WUQ = O_WATTIN + (size_t)2048 * 1024 * 2;
constexpr size_t O_WUKV = O_WUQ + (size_t)768 * 256 * 2;
constexpr size_t O_WATTOUT = O_WUKV + (size_t)1024 * 128 * 2;
constexpr size_t O_WMLPIN = O_WATTOUT + (size_t)1024 * 1024 * 2;
constexpr size_t O_WMLPOUT = O_WMLPIN + (size_t)2 * 4096 * 1024 * 2;
constexpr size_t O_WCONVIN = O_WMLPOUT + (size_t)2 * 4096 * 1024 * 2;
constexpr size_t O_WCONVOUT = O_WCONVIN + (size_t)1536 * 1024 * 2;
constexpr size_t O_HB = O_WCONVOUT + (size_t)1024 * 1024 * 2;
constexpr size_t O_BIG = O_HB + (size_t)NTOK * 1024 * 2;
constexpr size_t O_R = O_BIG;
constexpr size_t O_QMA = O_R;
constexpr size_t O_QMB = O_QMA + (size_t)NTOK * 768 * 2;
constexpr size_t O_QDA = O_R + al((size_t)NTOK * RLD * 2);
constexpr size_t O_QDB = O_QDA + (size_t)NTOK * 512 * 2;
constexpr size_t O_KD = O_QDB + (size_t)8192 * 512 * 2;
constexpr size_t O_VD = O_KD + (size_t)NKEY * 512 * 2;
constexpr size_t O_CQN = O_VD + (size_t)NKEY * 512 * 2;
constexpr size_t O_CKVN = O_CQN + (size_t)NTOK * 256 * 2;
constexpr size_t O_KMLA = O_CKVN + (size_t)NKEY * 128 * 2;
constexpr size_t O_VMLA = O_KMLA + (size_t)NKEY * 768 * 2;
constexpr size_t O_OTMP = O_VMLA + (size_t)NKEY * 512 * 2;
constexpr size_t O_ATT_END = O_OTMP + (size_t)512 * 16384 * 4;
constexpr size_t O_U = O_BIG;
constexpr size_t O_U_END = O_U + (size_t)NTOK * 4096 * 2;
constexpr size_t O_UG = O_BIG;
constexpr size_t O_PZ = O_UG + (size_t)NTOK * 512 * 2;
constexpr size_t WS_NEED = (O_ATT_END > O_U_END ? O_ATT_END : O_U_END);
static_assert(O_QMB + (size_t)8192 * 768 * 2 <= O_QDA, "Qm overlay must fit in R");
static_assert(WS_NEED <= (size_t)256 * 1024 * 1024, "workspace too large");

struct Params {
  const float *x_prompt, *x_sample, *cache_k, *cache_v, *cache_ckv, *cache_krope, *c, *c_ctx;
  const float *w_ada, *b_ada, *ln_mix_g, *ln_mix_b, *ln_mlp_g, *ln_mlp_b, *w_mlp_in, *w_mlp_out;
  const float *w_att_in, *w_uq, *w_ukv, *q_norm_g, *kv_norm_g, *lam_q1, *lam_k1, *lam_q2, *lam_k2, *diff_norm_g, *w_att_out;
  const float *w_conv_in, *conv_w, *conv_b, *conv_norm_g, *conv_norm_b, *w_pool, *pool_scale, *w_conv_out;
  float* out;
  char* ws;
};

DI unsigned pack2(float lo, float hi) { f32x2 v = {lo, hi}; bf16v2 b = __builtin_convertvector(v, bf16v2); return __builtin_bit_cast(unsigned, b); }
DI float bf2f(unsigned short u) { return __uint_as_float((unsigned)u << 16); }
DI float bflo(unsigned u) { return __uint_as_float(u << 16); }
DI float bfhi(unsigned u) { return __uint_as_float(u & 0xffff0000u); }
DI float wave_sum(float v) {
#pragma unroll
  for (int o = 32; o >= 1; o >>= 1) v += __shfl_xor(v, o);
  return v;
}
DI void lds_barrier() { asm volatile("s_waitcnt lgkmcnt(0)\n\ts_barrier" ::: "memory"); }
DI void dma16(const void* gsrc, unsigned lds_dst) {
  unsigned keep;
  asm volatile("s_mov_b32 %0, m0\n\ts_mov_b32 m0, %2\n\ts_nop 0\n\tglobal_load_lds_dwordx4 %1, off\n\ts_mov_b32 m0, %0" : "=&s"(keep) : "v"(gsrc), "s"(lds_dst) : "memory");
}
DI int cond_idx(int row) { return row < NCTX ? 0 : 1 + ((row - NCTX) >> 12); }


#define XB_TMO      128
#define XB_XCNT(j)  (256  + 64 * (j))
#define XB_XSUB(j)  (1280 + 64 * (j))
#define XB_XGEN(j)  (2304 + 64 * (j))
#define XB_TOP      3328
#define XB_TOPGEN   3392
#define XCD_BAR_WORDS 3456
#define XB_SPIN_CAP (1u << 18)
DI unsigned xb_ld(unsigned* p)              { return __hip_atomic_load(p, __ATOMIC_RELAXED, __HIP_MEMORY_SCOPE_AGENT); }
DI unsigned xb_add(unsigned* p, unsigned v) { return __hip_atomic_fetch_add(p, v, __ATOMIC_RELAXED, __HIP_MEMORY_SCOPE_AGENT); }
DI unsigned xb_xcc_id() { return (unsigned)__builtin_amdgcn_s_getreg((3 << 11) | 20) & 0xFu; }
#define XB_SPIN(cond, bar) do { unsigned _sp = 0; while (cond) { __builtin_amdgcn_s_sleep(1); \
    if ((++_sp & 255u) == 0u) { if (xb_ld(&(bar)[XB_TMO])) break; if (_sp > XB_SPIN_CAP) { atomicAdd(&(bar)[XB_TMO], 1u); break; } } } } while (0)
struct XcdBarrier { unsigned* bar; unsigned x; volatile LDS_AS unsigned* st; };
DI XcdBarrier xcd_barrier_post(unsigned* bar, volatile LDS_AS unsigned* st) {
  XcdBarrier b; b.bar = bar; b.x = xb_xcc_id(); b.st = st;
  if (threadIdx.x == 0) (void)xb_add(&bar[XB_XCNT(b.x)], 1u);
  return b;
}
DI void xcd_barrier_complete(unsigned* bar, unsigned x, unsigned& nloc, unsigned& nx) {
  const unsigned G = gridDim.x * gridDim.y * gridDim.z;
  unsigned sum, cnt, mine, sp = 0u;
  for (;;) {
    sum = 0u; cnt = 0u; mine = 0u;
#pragma unroll
    for (unsigned j = 0; j < 16; ++j) { const unsigned c = xb_ld(&bar[XB_XCNT(j)]); sum += c; cnt += (c > 0u) ? 1u : 0u; mine = (j == x) ? c : mine; }
    if (sum == G) break;
    __builtin_amdgcn_s_sleep(1);
    if ((++sp & 255u) == 0u) { if (xb_ld(&bar[XB_TMO])) break; if (sp > XB_SPIN_CAP) { atomicAdd(&bar[XB_TMO], 1u); break; } }
  }
  nloc = mine > 0u ? mine : 1u; nx = cnt > 0u ? cnt : 1u;
}
DI void xcd_barrier(const XcdBarrier& b) {
  asm volatile("s_waitcnt vmcnt(0)" ::: "memory");
  __syncthreads();
  if (threadIdx.x == 0) {
    unsigned* bar = b.bar;
    __builtin_amdgcn_s_waitcnt(0);
    unsigned nloc = b.st[0], nx = b.st[1];
    if (nloc == 0u) { xcd_barrier_complete(bar, b.x, nloc, nx); b.st[0] = nloc; b.st[1] = nx; }
    const unsigned old = xb_add(&bar[XB_XSUB(b.x)], 1u);
    const unsigned gen = old / nloc;
    if (old + 1u == (gen + 1u) * nloc) {
      __builtin_amdgcn_fence(__ATOMIC_RELEASE, "agent");
      asm volatile("s_waitcnt vmcnt(0)" ::: "memory");
      const unsigned og = xb_add(&bar[XB_TOP], 1u);
      const unsigned tg = og / nx;
      if (og + 1u == (tg + 1u) * nx) xb_add(&bar[XB_TOPGEN], 1u);
      else XB_SPIN(xb_ld(&bar[XB_TOPGEN]) == tg, bar);
      __builtin_amdgcn_fence(__ATOMIC_ACQUIRE, "agent");
      xb_add(&bar[XB_XGEN(b.x)], 1u);
      asm volatile("s_waitcnt vmcnt(0)" ::: "memory");
    } else {
      XB_SPIN(xb_ld(&bar[XB_XGEN(b.x)]) == gen, bar);
      __builtin_amdgcn_fence(__ATOMIC_ACQUIRE, "agent");
      asm volatile("s_waitcnt vmcnt(0)" ::: "memory");
    }
  }
  __syncthreads();
}

DI int swz(int row, int kc) { return row * 128 + ((kc ^ ((row >> 1) & 7)) << 4); }

constexpr int G_BM = 192, G_BN = 256, G_MI = 6, G_NJ = 4, G_ABYTES = G_BM * 128, G_STAGE = G_ABYTES + G_BN * 128;
template <class Epi>
DI void gemm_tile(const bf16_t* __restrict__ A, int lda, const bf16_t* __restrict__ Bt, int ldb, int K, int row0, int col0, char* smem, const Epi& epi,
                  bool prefetched, bool has_next, int nrow0, int ncol0) {
  const int tid = threadIdx.x, lane = tid & 63, wid = tid >> 6, wr = wid >> 2, wc = wid & 3;
  const int fr = lane & 15, fq = lane >> 4;
  f32x4 acc[G_MI][G_NJ];
#pragma unroll
  for (int i = 0; i < G_MI; ++i)
#pragma unroll
    for (int j = 0; j < G_NJ; ++j) acc[i][j] = (f32x4){0.f, 0.f, 0.f, 0.f};
  const int srow = tid >> 3, skc = tid & 7;
  const int schunk = skc ^ ((srow >> 1) & 7);
  const bf16_t* ga = A + (size_t)(row0 + srow) * lda + schunk * 8;
  const bf16_t* gb = Bt + (size_t)(col0 + srow) * ldb + schunk * 8;
  const int nk = K >> 6;
  const unsigned lds0 = __builtin_amdgcn_readfirstlane((unsigned)(size_t)(LDS_AS char*)smem + (unsigned)(tid & ~63) * 16u);
#define G_DMA_P(ga_, gb_, stage_off_, kt_) do { const int k0_ = (kt_) << 6; const unsigned sb_ = lds0 + (unsigned)(stage_off_); \
    _Pragma("unroll") for (int i = 0; i < 3; ++i) dma16((ga_) + (size_t)(64 * i) * lda + k0_, sb_ + i * 8192); \
    _Pragma("unroll") for (int i = 0; i < 4; ++i) dma16((gb_) + (size_t)(64 * i) * ldb + k0_, sb_ + G_ABYTES + i * 8192); } while (0)
#define G_DMA(stage_off_, kt_) G_DMA_P(ga, gb, stage_off_, kt_)
#define G_COMPUTE(buf_) do { const char* cur = (buf_); \
    _Pragma("unroll") for (int s = 0; s < 2; ++s) { \
      bf16x8 af[G_MI], bfr[G_NJ]; \
      _Pragma("unroll") for (int i = 0; i < G_MI; ++i) af[i] = *(const bf16x8*)(cur + swz(wr * 96 + i * 16 + fr, s * 4 + fq)); \
      _Pragma("unroll") for (int j = 0; j < G_NJ; ++j) bfr[j] = *(const bf16x8*)(cur + G_ABYTES + swz(wc * 64 + j * 16 + fr, s * 4 + fq)); \
      __builtin_amdgcn_s_setprio(1); \
      _Pragma("unroll") for (int i = 0; i < G_MI; ++i) \
        _Pragma("unroll") for (int j = 0; j < G_NJ; ++j) acc[i][j] = __builtin_amdgcn_mfma_f32_16x16x32_bf16(bfr[j], af[i], acc[i][j], 0, 0, 0); \
      __builtin_amdgcn_s_setprio(0); \
    } } while (0)
  if (!prefetched) { G_DMA(0, 0); asm volatile("s_waitcnt vmcnt(0)" ::: "memory"); }
  else asm volatile("s_waitcnt vmcnt(%0)" :: "n"(Epi::kMinStores) : "memory");
  lds_barrier();
  for (int kt = 0; kt < nk; kt += 2) {
    G_DMA(G_STAGE, kt + 1);
    G_COMPUTE(smem);
    asm volatile("s_waitcnt vmcnt(0)" ::: "memory");
    lds_barrier();
    G_DMA(0, min(kt + 2, nk - 1));
    G_COMPUTE(smem + G_STAGE);
    asm volatile("s_waitcnt vmcnt(0)" ::: "memory");
    lds_barrier();
  }
  if (has_next) {
    const bf16_t* gan = A + (size_t)(nrow0 + srow) * lda + schunk * 8;
    const bf16_t* gbn = Bt + (size_t)(ncol0 + srow) * ldb + schunk * 8;
    G_DMA_P(gan, gbn, 0, 0);
  }
#undef G_DMA
#undef G_DMA_P
#undef G_COMPUTE
  epi(acc, row0 + wr * 96, col0 + wc * 64, lane);
}


template <class F>
DI void wave_rows_store(char* w, const u32x2 (&pk)[G_MI][G_NJ], int lane, F rowptr) {
  const int fr = lane & 15, fq = lane >> 4;
#pragma unroll
  for (int i = 0; i < G_MI; ++i)
#pragma unroll
    for (int j = 0; j < G_NJ; ++j) *(u32x2*)(w + (i * 16 + fr) * 144 + (j * 16 + fq * 4) * 2) = pk[i][j];
  const int rr = lane >> 3, ch = lane & 7;
#pragma unroll
  for (int it = 0; it < 12; ++it) {
    const int r = it * 8 + rr;
    const u32x4 v = *(const u32x4*)(w + r * 144 + ch * 16);
    bf16_t* d = rowptr(r);
    if (d) *(u32x4*)(d + ch * 8) = v;
  }
}
DI u32x2 pk4(const f32x4 v) { return (u32x2){pack2(v[0], v[1]), pack2(v[2], v[3])}; }

struct EpiRaw {
  static constexpr int kMinStores = 0;
  static constexpr bool kPrefetchNext = true;
  bf16_t* R;
  DI void operator()(f32x4 (&acc)[G_MI][G_NJ], int rbase, int cbase, int lane) const {
    const int fr = lane & 15, fq = lane >> 4;
#pragma unroll
    for (int i = 0; i < G_MI; ++i)
#pragma unroll
      for (int j = 0; j < G_NJ; ++j) {
        const int row = rbase + i * 16 + fr, col = cbase + j * 16 + fq * 4;
        if (col < RLD) { u32x2 w = {pack2(acc[i][j][0], acc[i][j][1]), pack2(acc[i][j][2], acc[i][j][3])}; *(u32x2*)(R + (size_t)row * RLD + col) = w; }
      }
  }
};


struct EpiAttIn {
  static constexpr int kMinStores = 0;
  static constexpr bool kPrefetchNext = true;
  bf16_t *Qda, *Qdb, *Kd, *Vd, *cqn, *ckvn, *Km; float *o_k, *o_v, *o_ckv, *o_kr;
  const float *c16, *s16, *c8, *s8, *qg, *kvg; char* smem;
  DI void operator()(f32x4 (&acc)[G_MI][G_NJ], int rbase, int cbase, int lane) const {
    const int tid = threadIdx.x, wid = tid >> 6, wr = wid >> 2, wc = wid & 3, fr = lane & 15, fq = lane >> 4;
    const int tile = (cbase - wc * 64) >> 8;
    float* part = (float*)smem;
    if (tile < 6) {
      const int which = tile >> 1, c0 = cbase & 511;
#pragma unroll
      for (int i = 0; i < G_MI; ++i) {
        const int rowf = rbase + i * 16, row = rowf + fr;
        const bool lat = rowf >= NCTX;
        const int rl = row - NCTX, b = rl >> 12, t = rl & (TLAT - 1), prow = t >> 6, pcol = t & 63;
        const size_t kr = lat ? (size_t)NCTX + (size_t)b * TKL + 256 + t : (size_t)row;
        u32x2 raw[G_NJ], rot[G_NJ];
#pragma unroll
        for (int j = 0; j < G_NJ; ++j) raw[j] = (u32x2){pack2(acc[i][j][0], acc[i][j][1]), pack2(acc[i][j][2], acc[i][j][3])};
        if (lat && which < 2) {
#pragma unroll
          for (int jp = 0; jp < 2; ++jp) {
            const int pos = jp == 0 ? prow : pcol;
            const f32x4 cs = *(const f32x4*)(c16 + pos * 16 + fq * 4), sn = *(const f32x4*)(s16 + pos * 16 + fq * 4);
            const f32x4 x1 = acc[i][2 * jp], x2 = acc[i][2 * jp + 1];
            f32x4 o1, o2;
#pragma unroll
            for (int e = 0; e < 4; ++e) { o1[e] = x1[e] * cs[e] - x2[e] * sn[e]; o2[e] = x1[e] * sn[e] + x2[e] * cs[e]; }
            rot[2 * jp] = (u32x2){pack2(o1[0], o1[1]), pack2(o1[2], o1[3])};
            rot[2 * jp + 1] = (u32x2){pack2(o2[0], o2[1]), pack2(o2[2], o2[3])};
          }
        }
#pragma unroll
        for (int j = 0; j < G_NJ; ++j) {
          const int c = c0 + j * 16 + fq * 4;
          if (which == 0) {
            *(u32x2*)(Qda + (size_t)row * 512 + c) = raw[j];
            if (lat) *(u32x2*)(Qdb + (size_t)rl * 512 + c) = rot[j];
          } else if (which == 1) {
            if (lat) *(u32x2*)(Kd + kr * 512 + c) = rot[j];
            else { *(u32x2*)(Kd + kr * 512 + c) = raw[j]; *(f32x4*)(o_k + (size_t)row * 512 + c) = acc[i][j]; }
          } else {
            *(u32x2*)(Vd + kr * 512 + c) = raw[j];
            if (!lat) *(f32x4*)(o_v + (size_t)row * 512 + c) = acc[i][j];
          }
        }
      }
      return;
    }
    const bool norm_wave = (tile == 6) || (wc < 2);
#pragma unroll
    for (int i = 0; i < G_MI; ++i) {
      float ss = 0.f;
#pragma unroll
      for (int j = 0; j < G_NJ; ++j)
#pragma unroll
        for (int e = 0; e < 4; ++e) ss += acc[i][j][e] * acc[i][j][e];
      ss += __shfl_xor(ss, 16); ss += __shfl_xor(ss, 32);
      if (fq == 0) part[(wr * 96 + i * 16 + fr) * 4 + wc] = ss;
    }
    __syncthreads();
#pragma unroll
    for (int i = 0; i < G_MI; ++i) {
      const int rowf = rbase + i * 16, row = rowf + fr;
      const bool lat = rowf >= NCTX;
      const int rl = row - NCTX, b = rl >> 12, t = rl & (TLAT - 1), prow = t >> 6, pcol = t & 63;
      const size_t kr = lat ? (size_t)NCTX + (size_t)b * TKL + 256 + t : (size_t)row;
      const f32x4 pr = *(const f32x4*)(part + (wr * 96 + i * 16 + fr) * 4);
      if (tile == 6) {
        const float sc = rsqrtf(((pr[0] + pr[1]) + (pr[2] + pr[3])) * (1.f / 256.f) + EPS);
#pragma unroll
        for (int j = 0; j < G_NJ; ++j) {
          const int c = wc * 64 + j * 16 + fq * 4;
          const f32x4 g = *(const f32x4*)(qg + c);
          *(u32x2*)(cqn + (size_t)row * 256 + c) = (u32x2){pack2(acc[i][j][0] * sc * g[0], acc[i][j][1] * sc * g[1]), pack2(acc[i][j][2] * sc * g[2], acc[i][j][3] * sc * g[3])};
        }
      } else if (norm_wave) {
        const float sc = rsqrtf((pr[0] + pr[1]) * (1.f / 128.f) + EPS);
#pragma unroll
        for (int j = 0; j < G_NJ; ++j) {
          const int c = wc * 64 + j * 16 + fq * 4;
          const f32x4 g = *(const f32x4*)(kvg + c);
          f32x4 y;
#pragma unroll
          for (int e = 0; e < 4; ++e) y[e] = acc[i][j][e] * sc * g[e];
          if (!lat) *(f32x4*)(o_ckv + (size_t)row * 128 + c) = y;
          *(u32x2*)(ckvn + kr * 128 + c) = (u32x2){pack2(y[0], y[1]), pack2(y[2], y[3])};
        }
      } else if (wc == 2) {
#pragma unroll
        for (int j = 0; j < 2; ++j) {
          f32x4 v = acc[i][j];
          if (lat) {
            const int pos = j == 0 ? prow : pcol;
            f32x4 o;
#pragma unroll
            for (int e = 0; e < 4; ++e) {
              const float pv = __shfl_xor(v[e], 32);
              const int f = (fq & 1) * 4 + e;
              const float cs = c8[pos * 8 + f], sn = s8[pos * 8 + f];
              o[e] = (fq < 2) ? (v[e] * cs - pv * sn) : (pv * sn + v[e] * cs);
            }
            v = o;
          } else *(f32x4*)(o_kr + (size_t)row * 32 + j * 16 + fq * 4) = v;
          const u32x2 w = {pack2(v[0], v[1]), pack2(v[2], v[3])};
#pragma unroll
          for (int hh = 0; hh < 8; ++hh) *(u32x2*)(Km + kr * 768 + hh * 96 + 64 + j * 16 + fq * 4) = w;
        }
      }
    }
    __syncthreads();
  }
};

struct EpiUq {
  static constexpr int kMinStores = 24;
  static constexpr bool kPrefetchNext = true;
  bf16_t *Qa, *Qb; const float *c8, *s8;
  DI void operator()(f32x4 (&acc)[G_MI][G_NJ], int rbase, int cbase, int lane) const {
    const int fr = lane & 15, fq = lane >> 4;
#pragma unroll
    for (int i = 0; i < G_MI; ++i) {
      const bool lat = (rbase + i * 16) >= NCTX;
      const int row = rbase + i * 16 + fr;
      const int t = (row - NCTX) & (TLAT - 1);
#pragma unroll
      for (int j = 0; j < G_NJ; ++j) {
        const int cf = cbase + j * 16, col = cf + fq * 4;
        f32x4 v = acc[i][j];
        u32x2 w = {pack2(v[0], v[1]), pack2(v[2], v[3])};
        *(u32x2*)(Qa + (size_t)row * 768 + col) = w;
        if (lat) {
          const int w96 = cf % 96;
          if (w96 >= 64) {
            const int pos = (w96 == 64) ? (t >> 6) : (t & 63);
            f32x4 o;
#pragma unroll
            for (int e = 0; e < 4; ++e) {
              const float pv = __shfl_xor(v[e], 32);
              const int f = (fq & 1) * 4 + e;
              const float cs = c8[pos * 8 + f], sn = s8[pos * 8 + f];
              o[e] = (fq < 2) ? (v[e] * cs - pv * sn) : (pv * sn + v[e] * cs);
            }
            w = (u32x2){pack2(o[0], o[1]), pack2(o[2], o[3])};
          }
          *(u32x2*)(Qb + (size_t)(row - NCTX) * 768 + col) = w;
        }
      }
    }
  }
};

struct EpiUkv {
  static constexpr int kMinStores = 0;
  static constexpr bool kPrefetchNext = false;
  bf16_t *Km, *Vm; char* lds;
  DI void operator()(f32x4 (&acc)[G_MI][G_NJ], int rbase, int cbase, int lane) const {
    const int h = cbase >> 7, part = (cbase >> 6) & 1;
    u32x2 pk[G_MI][G_NJ];
#pragma unroll
    for (int i = 0; i < G_MI; ++i)
#pragma unroll
      for (int j = 0; j < G_NJ; ++j) pk[i][j] = pk4(acc[i][j]);
    bf16_t* base = part == 0 ? Km + h * 96 : Vm + h * 64;
    const int ld = part == 0 ? 768 : 512;
    wave_rows_store(lds + (threadIdx.x >> 6) * (96 * 144), pk, lane, [&](int r) -> bf16_t* { const int row = rbase + r; return row < NKEY ? base + (size_t)row * ld : nullptr; });
    lds_barrier();
  }
};

struct EpiRes {
  static constexpr int kMinStores = 0;
  static constexpr bool kPrefetchNext = true;
  const float *xin_ctx, *xin_lat, *gate  ; float* X;
  DI void operator()(f32x4 (&acc)[G_MI][G_NJ], int rbase, int cbase, int lane) const {
    const int fr = lane & 15, fq = lane >> 4;
#pragma unroll
    for (int i = 0; i < G_MI; ++i) {
      const int row = rbase + i * 16 + fr;
      const float* g = gate + cond_idx(rbase + i * 16) * 6144;
      const float* xin = row < NCTX ? xin_ctx + (size_t)row * 1024 : xin_lat + (size_t)(row - NCTX) * 1024;
#pragma unroll
      for (int j = 0; j < G_NJ; ++j) {
        const int col = cbase + j * 16 + fq * 4;
        const f32x4 xv = *(const f32x4*)(xin + col), gv = *(const f32x4*)(g + col);
        f32x4 z;
#pragma unroll
        for (int e = 0; e < 4; ++e) z[e] = ALPHA * xv[e] + gv[e] * acc[i][j][e];
        *(f32x4*)(X + (size_t)row * 1024 + col) = z;
      }
    }
  }
};


struct EpiResLN {
  static constexpr int kMinStores = 0;
  static constexpr bool kPrefetchNext = true;
  const float *xin_ctx, *xin_lat, *gate; float* X;
  const float *lg, *lb, *modsL; int sh_off, sc_off; bf16_t* Hb;
  float* xbuf; unsigned* cnt; char* smem; bool fused;
  DI void operator()(f32x4 (&acc)[G_MI][G_NJ], int rbase, int cbase, int lane) const {
    const int tid = threadIdx.x, wid = tid >> 6, wr = wid >> 2, wc = wid & 3, fr = lane & 15, fq = lane >> 4;
    const int cid0 = cond_idx(rbase);
#pragma unroll
    for (int j = 0; j < G_NJ; ++j) {
      const int col = cbase + j * 16 + fq * 4;
      const f32x4 gv0 = *(const f32x4*)(gate + cid0 * 6144 + col);
#pragma unroll
      for (int i = 0; i < G_MI; ++i) {
        const int row = rbase + i * 16 + fr, cid = cond_idx(rbase + i * 16);
        const float* xin = row < NCTX ? xin_ctx + (size_t)row * 1024 : xin_lat + (size_t)(row - NCTX) * 1024;
        const f32x4 xv = *(const f32x4*)(xin + col);
        f32x4 gv = gv0;
        if (cid != cid0) gv = *(const f32x4*)(gate + cid * 6144 + col);
#pragma unroll
        for (int e = 0; e < 4; ++e) acc[i][j][e] = ALPHA * xv[e] + gv[e] * acc[i][j][e];
        if (!fused) *(f32x4*)(X + (size_t)row * 1024 + col) = acc[i][j];
      }
    }
    if (!fused) return;
    const int row0 = rbase - wr * 96, pm = row0 / G_BM, pn = (cbase - wc * 64) / G_BN;
    f32x2* part = (f32x2*)smem;
    f32x2* stat = (f32x2*)(smem + 8192);
#pragma unroll
    for (int i = 0; i < G_MI; ++i) {
      float s1 = 0.f, s2 = 0.f;
#pragma unroll
      for (int j = 0; j < G_NJ; ++j)
#pragma unroll
        for (int e = 0; e < 4; ++e) { const float v = acc[i][j][e]; s1 += v; s2 += v * v; }
      s1 += __shfl_xor(s1, 16); s2 += __shfl_xor(s2, 16);
      s1 += __shfl_xor(s1, 32); s2 += __shfl_xor(s2, 32);
      if (fq == 0) part[(wr * 96 + i * 16 + fr) * 4 + wc] = (f32x2){s1, s2};
    }
    __syncthreads();
    if (tid < G_BM) {
      const f32x2 a = part[tid * 4 + 0], b = part[tid * 4 + 1], c = part[tid * 4 + 2], d = part[tid * 4 + 3];
      const float s1 = (a[0] + b[0]) + (c[0] + d[0]), s2 = (a[1] + b[1]) + (c[1] + d[1]);
      const unsigned long long pk = ((unsigned long long)__float_as_uint(s2) << 32) | (unsigned long long)__float_as_uint(s1);
      __hip_atomic_store((unsigned long long*)(xbuf + ((size_t)(pm * 4 + pn) * G_BM + tid) * 2), pk, __ATOMIC_RELAXED, __HIP_MEMORY_SCOPE_AGENT);
    }
    asm volatile("s_waitcnt vmcnt(0)" ::: "memory");
    __syncthreads();
    if (tid == 0) {
      __hip_atomic_fetch_add(cnt + pm, 1u, __ATOMIC_RELAXED, __HIP_MEMORY_SCOPE_AGENT);
      unsigned sp = 0;
      while (__hip_atomic_load(cnt + pm, __ATOMIC_RELAXED, __HIP_MEMORY_SCOPE_AGENT) < 4u) { __builtin_amdgcn_s_sleep(1); if (++sp > (1u << 22)) break; }
    }
    __syncthreads();
    if (tid < G_BM) {
      float s1 = 0.f, s2 = 0.f;
#pragma unroll
      for (int q = 0; q < 4; ++q) {
        const unsigned long long pk = __hip_atomic_load((unsigned long long*)(xbuf + ((size_t)(pm * 4 + q) * G_BM + tid) * 2), __ATOMIC_RELAXED, __HIP_MEMORY_SCOPE_AGENT);
        s1 += __uint_as_float((unsigned)pk); s2 += __uint_as_float((unsigned)(pk >> 32));
      }
      const float mean = s1 * (1.f / 1024.f);
      const float var = fmaxf(s2 * (1.f / 1024.f) - mean * mean, 0.f);
      stat[tid] = (f32x2){mean, rsqrtf(var + EPS)};
    }
    __syncthreads();
#pragma unroll
    for (int j = 0; j < G_NJ; ++j) {
      const int col = cbase + j * 16 + fq * 4;
      const f32x4 gv = *(const f32x4*)(lg + col), bv = *(const f32x4*)(lb + col);
      f32x4 sh0 = {0.f, 0.f, 0.f, 0.f}, sc0 = sh0;
      if (Hb) { sh0 = *(const f32x4*)(modsL + cid0 * 6144 + sh_off + col); sc0 = *(const f32x4*)(modsL + cid0 * 6144 + sc_off + col); }
#pragma unroll
      for (int i = 0; i < G_MI; ++i) {
        const int row = rbase + i * 16 + fr, cid = cond_idx(rbase + i * 16);
        const f32x2 ms = stat[wr * 96 + i * 16 + fr];
        f32x4 x;
#pragma unroll
        for (int e = 0; e < 4; ++e) x[e] = (acc[i][j][e] - ms[0]) * ms[1] * gv[e] + bv[e];
        *(f32x4*)(X + (size_t)row * 1024 + col) = x;
        if (Hb) {
          f32x4 sh = sh0, sc = sc0;
          if (cid != cid0) { sh = *(const f32x4*)(modsL + cid * 6144 + sh_off + col); sc = *(const f32x4*)(modsL + cid * 6144 + sc_off + col); }
          u32x2 w = {pack2(x[0] * (1.f + sc[0]) + sh[0], x[1] * (1.f + sc[1]) + sh[1]), pack2(x[2] * (1.f + sc[2]) + sh[2], x[3] * (1.f + sc[3]) + sh[3])};
          *(u32x2*)(Hb + (size_t)row * 1024 + col) = w;
        }
      }
    }
    __syncthreads();
  }
};

struct EpiRelu2 {
  static constexpr int kMinStores = 12;
  static constexpr bool kPrefetchNext = true;
  bf16_t* U; char* lds;
  DI void operator()(f32x4 (&acc)[G_MI][G_NJ], int rbase, int cbase, int lane) const {
    const int fr = lane & 15, fq = lane >> 4, wid = threadIdx.x >> 6;
    char* w = lds + wid * (48 * 144);
    const int rr = lane >> 3, ch = lane & 7;
#pragma unroll
    for (int hf = 0; hf < 2; ++hf) {
#pragma unroll
      for (int i3 = 0; i3 < 3; ++i3)
#pragma unroll
        for (int j = 0; j < G_NJ; ++j) {
          f32x4 v = acc[hf * 3 + i3][j];
#pragma unroll
          for (int e = 0; e < 4; ++e) { const float r = fmaxf(v[e], 0.f); v[e] = r * r; }
          *(u32x2*)(w + (i3 * 16 + fr) * 144 + (j * 16 + fq * 4) * 2) = (u32x2){pack2(v[0], v[1]), pack2(v[2], v[3])};
        }
#pragma unroll
      for (int it = 0; it < 6; ++it) {
        const int r = it * 8 + rr;
        const u32x4 v = *(const u32x4*)(w + r * 144 + ch * 16);
        *(u32x4*)(U + (size_t)(rbase + hf * 48 + r) * 4096 + cbase + ch * 8) = v;
      }
    }
  }
};

struct EpiConv {
  static constexpr int kMinStores = 0;
  static constexpr bool kPrefetchNext = false;
  bf16_t *Ug, *Pz; char* lds;
  DI void operator()(f32x4 (&acc)[G_MI][G_NJ], int rbase, int cbase, int lane) const {
    const int fr = lane & 15, fq = lane >> 4;
    char* w = lds + (threadIdx.x >> 6) * (96 * 144);
    if (cbase < 1024) {
#pragma unroll
      for (int i = 0; i < G_MI; ++i)
#pragma unroll
        for (int jp = 0; jp < 2; ++jp) {
          const f32x4 a = acc[i][2 * jp], gt = acc[i][2 * jp + 1];
          f32x4 u;
#pragma unroll
          for (int e = 0; e < 4; ++e) u[e] = a[e] / (1.f + __expf(-gt[e]));
          *(u32x2*)(w + (i * 16 + fr) * 80 + (jp * 16 + fq * 4) * 2) = pk4(u);
        }
      const int rr = lane >> 2, ch = lane & 3, c0 = (cbase >> 5) * 16;
#pragma unroll
      for (int it = 0; it < 6; ++it) {
        const int r = it * 16 + rr;
        const u32x4 v = *(const u32x4*)(w + r * 80 + ch * 16);
        *(u32x4*)(Ug + (size_t)(rbase + r) * 512 + c0 + ch * 8) = v;
      }
    } else {
      u32x2 pk[G_MI][G_NJ];
#pragma unroll
      for (int i = 0; i < G_MI; ++i)
#pragma unroll
        for (int j = 0; j < G_NJ; ++j) pk[i][j] = pk4(acc[i][j]);
      wave_rows_store(w, pk, lane, [&](int r) -> bf16_t* { return Pz + (size_t)(rbase + r) * 512 + (cbase - 1024); });
    }
    lds_barrier();
  }
};

#ifndef XCD_ORDER
#define XCD_ORDER 1
#endif
template <class Epi>
DI void gemm_phase(const bf16_t* A, int lda, const bf16_t* Bt, int ldb, int K, int mt, int nt, const Epi& epi, char* smem, int tstart = 0, int ttotal = -1) {
  const int n = mt * nt;
  if (ttotal < 0) ttotal = n;
  const bool xo = XCD_ORDER && gridDim.x == 256 && (nt & 3) == 0 && (mt & 3) == 0 && n % 256 == 0;
  auto coords = [&](int u, int& r0, int& c0) {
    int pm = u / nt, pn = u - pm * nt;
    if (xo) {
      const int r = u >> 8, w = u & 255, x = w & 7, idx = w >> 3;
      const int rows_r = 256 / nt, pw = nt < 8 ? nt : 8, ph = 32 / pw, npx = nt / pw, px = x % npx, py = x / npx;
      pm = r * rows_r + py * ph + idx / pw; pn = px * pw + idx % pw;
    }
    r0 = pm * G_BM; c0 = pn * G_BN;
  };
  int t = blockIdx.x;
  while (t < tstart) t += gridDim.x;
  bool prefetched = false;
  while (t < tstart + n && t < ttotal) {
    const int tn = t + gridDim.x;
    const bool has_next = Epi::kPrefetchNext && tn < tstart + n && tn < ttotal;
    int r0, c0, nr0 = 0, nc0 = 0;
    coords(t - tstart, r0, c0);
    if (has_next) coords(tn - tstart, nr0, nc0);
    gemm_tile(A, lda, Bt, ldb, K, r0, c0, smem, epi, prefetched, has_next, nr0, nc0);
    prefetched = has_next;
    t = tn;
  }
}

DI void rows_phase(const float* src_ctx, const float* src_lat, bool do_ln, const float* lg, const float* lb, float* Xdst,
                   const float* modsL, int sh_off, int sc_off, bf16_t* Hb) {
  const int lane = threadIdx.x & 63, gw = blockIdx.x * NWAVE + (threadIdx.x >> 6), nw = gridDim.x * NWAVE;
  for (int row = gw; row < NTOK; row += nw) {
    const float* src = row < NCTX ? src_ctx + (size_t)row * 1024 : src_lat + (size_t)(row - NCTX) * 1024;
    f32x4 v[4];
#pragma unroll
    for (int i = 0; i < 4; ++i) v[i] = *(const f32x4*)(src + i * 256 + lane * 4);
    if (do_ln) {
      float s = 0.f;
#pragma unroll
      for (int i = 0; i < 4; ++i) s += (v[i][0] + v[i][1]) + (v[i][2] + v[i][3]);
      const float mean = wave_sum(s) * (1.f / 1024.f);
      float q = 0.f;
#pragma unroll
      for (int i = 0; i < 4; ++i)
#pragma unroll
        for (int e = 0; e < 4; ++e) { const float d = v[i][e] - mean; q += d * d; }
      const float rstd = rsqrtf(wave_sum(q) * (1.f / 1024.f) + EPS);
#pragma unroll
      for (int i = 0; i < 4; ++i) {
        const f32x4 g = *(const f32x4*)(lg + i * 256 + lane * 4), b = *(const f32x4*)(lb + i * 256 + lane * 4);
#pragma unroll
        for (int e = 0; e < 4; ++e) v[i][e] = (v[i][e] - mean) * rstd * g[e] + b[e];
        if (Xdst) *(f32x4*)(Xdst + (size_t)row * 1024 + i * 256 + lane * 4) = v[i];
      }
    }
    if (Hb) {
      const float* m = modsL + cond_idx(row) * 6144;
#pragma unroll
      for (int i = 0; i < 4; ++i) {
        const int col = i * 256 + lane * 4;
        const f32x4 sh = *(const f32x4*)(m + sh_off + col), sc = *(const f32x4*)(m + sc_off + col);
        f32x4 h;
#pragma unroll
        for (int e = 0; e < 4; ++e) h[e] = v[i][e] * (1.f + sc[e]) + sh[e];
        u32x2 w = {pack2(h[0], h[1]), pack2(h[2], h[3])};
        *(u32x2*)(Hb + (size_t)row * 1024 + col) = w;
      }
    }
  }
}

DI void modulate_phase(const float* __restrict__ src_ctx, const float* __restrict__ src_lat, const float* __restrict__ modsL, bf16_t* __restrict__ Hb) {
  const int lane = threadIdx.x & 63, gw = blockIdx.x * NWAVE + (threadIdx.x >> 6), nw = gridDim.x * NWAVE;
  for (int r0 = gw * 2; r0 < NTOK; r0 += nw * 2) {
    f32x4 v[2][4];
#pragma unroll
    for (int k = 0; k < 2; ++k) {
      const int row = r0 + k;
      const float* src = row < NCTX ? src_ctx + (size_t)row * 1024 : src_lat + (size_t)(row - NCTX) * 1024;
#pragma unroll
      for (int i = 0; i < 4; ++i) v[k][i] = __builtin_nontemporal_load((const f32x4*)(src + i * 256 + lane * 4));
    }
#pragma unroll
    for (int k = 0; k < 2; ++k) {
      const int row = r0 + k;
      const float* m = modsL + cond_idx(row) * 6144;
#pragma unroll
      for (int i = 0; i < 4; ++i) {
        const int col = i * 256 + lane * 4;
        const f32x4 sh = *(const f32x4*)(m + col), sc = *(const f32x4*)(m + 1024 + col);
        u32x2 w = {pack2(v[k][i][0] * (1.f + sc[0]) + sh[0], v[k][i][1] * (1.f + sc[1]) + sh[1]), pack2(v[k][i][2] * (1.f + sc[2]) + sh[2], v[k][i][3] * (1.f + sc[3]) + sh[3])};
        *(u32x2*)(Hb + (size_t)row * 1024 + col) = w;
      }
    }
  }
}

DI double sin_red(double r) {
  const double r2 = r * r; double t = -1.0 / 51090942171709440000.0;
  t = t * r2 + 1.0 / 121645100408832000.0; t = t * r2 - 1.0 / 355687428096000.0; t = t * r2 + 1.0 / 1307674368000.0; t = t * r2 - 1.0 / 6227020800.0;
  t = t * r2 + 1.0 / 39916800.0; t = t * r2 - 1.0 / 362880.0; t = t * r2 + 1.0 / 5040.0; t = t * r2 - 1.0 / 120.0; t = t * r2 + 1.0 / 6.0;
  return r * (1.0 - r2 * t);
}
DI double cos_red(double r) {
  const double r2 = r * r; double t = 1.0 / 1124000727777607680000.0;
  t = t * r2 - 1.0 / 2432902008176640000.0; t = t * r2 + 1.0 / 6402373705728000.0; t = t * r2 - 1.0 / 20922789888000.0; t = t * r2 + 1.0 / 87178291200.0;
  t = t * r2 - 1.0 / 479001600.0; t = t * r2 + 1.0 / 3628800.0; t = t * r2 - 1.0 / 40320.0; t = t * r2 + 1.0 / 720.0; t = t * r2 - 1.0 / 24.0; t = t * r2 + 0.5; t = t * r2 * -1.0 + 1.0;
  return t;
}

constexpr int J_MODS = 96, J_WEFF = 64, J_CACHE = 64, J_ROPE = 1, J_SLOW = J_MODS + J_WEFF + J_CACHE + J_ROPE;
constexpr int T_ATTIN = 16 * 16, T_UQ = 4 * 6, T_UKV = 2 * 8, T_ATTOUT = 16 * 8, T_MLPIN = 16 * 32, T_MLPOUT = 64 * 8, T_CONVIN = 16 * 12, T_CONVOUT = 8 * 8;
constexpr int J_TR = T_ATTIN + T_UQ + T_UKV + T_ATTOUT + 2 * T_MLPIN + 2 * T_MLPOUT + T_CONVIN + T_CONVOUT;

struct TJ { const float* src; bf16_t* dst; int N, nvalid, lddst, perm, kt, nt; };
DI TJ tr_decode(const Params& p, int j) {
  char* ws = p.ws;
  TJ t; t.perm = 0;
  if (j < T_ATTIN) { t.src = p.w_att_in; t.N = 1952; t.nvalid = 1952; t.dst = (bf16_t*)(ws + O_WATTIN); t.lddst = 1024; t.kt = j / 16; t.nt = j % 16; return t; }
  j -= T_ATTIN;
  if (j < T_UQ) { t.src = p.w_uq; t.N = 768; t.nvalid = 768; t.dst = (bf16_t*)(ws + O_WUQ); t.lddst = 256; t.kt = j / 6; t.nt = j % 6; return t; }
  j -= T_UQ;
  if (j < T_UKV) { t.src = p.w_ukv; t.N = 1024; t.nvalid = 1024; t.dst = (bf16_t*)(ws + O_WUKV); t.lddst = 128; t.kt = j / 8; t.nt = j % 8; return t; }
  j -= T_UKV;
  if (j < T_ATTOUT) { t.src = p.w_att_out; t.N = 1024; t.nvalid = 1024; t.dst = (bf16_t*)(ws + O_WATTOUT); t.lddst = 1024; t.kt = j / 8; t.nt = j % 8; return t; }
  j -= T_ATTOUT;
  if (j < 2 * T_MLPIN) { const int l = j / T_MLPIN, u = j % T_MLPIN; t.src = p.w_mlp_in + (size_t)l * 1024 * 4096; t.N = 4096; t.nvalid = 4096; t.dst = (bf16_t*)(ws + O_WMLPIN) + (size_t)l * 4096 * 1024; t.lddst = 1024; t.kt = u / 32; t.nt = u % 32; return t; }
  j -= 2 * T_MLPIN;
  if (j < 2 * T_MLPOUT) { const int l = j / T_MLPOUT, u = j % T_MLPOUT; t.src = p.w_mlp_out + (size_t)l * 4096 * 1024; t.N = 1024; t.nvalid = 1024; t.dst = (bf16_t*)(ws + O_WMLPOUT) + (size_t)l * 4096 * 1024; t.lddst = 4096; t.kt = u / 8; t.nt = u % 8; return t; }
  j -= 2 * T_MLPOUT;
  if (j < T_CONVIN) { t.src = p.w_conv_in; t.N = 1536; t.nvalid = 1536; t.dst = (bf16_t*)(ws + O_WCONVIN); t.lddst = 1024; t.perm = 1; t.kt = j / 12; t.nt = j % 12; return t; }
  j -= T_CONVIN;
  t.src = p.w_conv_out; t.N = 1024; t.nvalid = 1024; t.dst = (bf16_t*)(ws + O_WCONVOUT); t.lddst = 1024; t.kt = j / 8; t.nt = j % 8; return t;
}
DI void tr_load(const TJ& t, float (&v)[16]) {
  const int tid = threadIdx.x, n4 = (tid & 31) * 4, kb = tid >> 5;
  const int gn = t.nt * 128 + n4;
  const float* s = t.src + (size_t)(t.kt * 64 + kb) * t.N + gn;
#pragma unroll
  for (int i = 0; i < 4; ++i) {
    f32x4 x = {0.f, 0.f, 0.f, 0.f};
    if (gn < t.nvalid) x = __builtin_nontemporal_load((const f32x4*)(s + (size_t)(16 * i) * t.N));
    v[4 * i] = x[0]; v[4 * i + 1] = x[1]; v[4 * i + 2] = x[2]; v[4 * i + 3] = x[3];
  }
}

DI void phase0(const Params& p, char* smem) {
  const int tid = threadIdx.x, lane = tid & 63, wid = tid >> 6;
  char* ws = p.ws;
  for (int job = blockIdx.x; job < J_SLOW; job += gridDim.x) {
    int j = job;
    if (j < J_MODS) {
      const int l = j / 48, cc = j % 48;
      float* sc = (float*)smem;
      for (int i = tid; i < 3072; i += NT) { const int ci = i >> 10, k = i & 1023; const float x = ci == 0 ? p.c_ctx[k] : p.c[(ci - 1) * 1024 + k]; sc[i] = x / (1.f + __expf(-x)); }
      __syncthreads();
      const int kg = tid >> 5, c4 = (tid & 31) * 4;
      const float* w = p.w_ada + (size_t)l * 1024 * 6144 + cc * 128 + c4;
      f32x4 s0 = {0.f, 0.f, 0.f, 0.f}, s1 = s0, s2 = s0;
#pragma unroll 16
      for (int k = kg * 64; k < kg * 64 + 64; ++k) {
        const f32x4 wv = __builtin_nontemporal_load((const f32x4*)(w + (size_t)k * 6144));
        const float a = sc[k], b = sc[1024 + k], c = sc[2048 + k];
#pragma unroll
        for (int e = 0; e < 4; ++e) { s0[e] += a * wv[e]; s1[e] += b * wv[e]; s2[e] += c * wv[e]; }
      }
      f32x4* r = (f32x4*)(smem + 12288);
      r[(kg * 3 + 0) * 32 + (tid & 31)] = s0; r[(kg * 3 + 1) * 32 + (tid & 31)] = s1; r[(kg * 3 + 2) * 32 + (tid & 31)] = s2;
      __syncthreads();
      if (tid < 96) {
        const int ci = tid >> 5, q = tid & 31;
        f32x4 s = {0.f, 0.f, 0.f, 0.f};
#pragma unroll
        for (int g = 0; g < 16; ++g) { const f32x4 t4 = r[(g * 3 + ci) * 32 + q]; s[0] += t4[0]; s[1] += t4[1]; s[2] += t4[2]; s[3] += t4[3]; }
        const f32x4 bb = *(const f32x4*)(p.b_ada + l * 6144 + cc * 128 + q * 4);
        float* md = (float*)(ws + O_MODS) + (size_t)(l * 3 + ci) * 6144 + cc * 128 + q * 4;
#pragma unroll
        for (int e = 0; e < 4; ++e) __hip_atomic_store(md + e, s[e] + bb[e], __ATOMIC_RELAXED, __HIP_MEMORY_SCOPE_AGENT);
      }
      asm volatile("s_waitcnt vmcnt(0)" ::: "memory");
      __syncthreads();
      if (tid == 0) __hip_atomic_fetch_add((unsigned*)(ws + O_CNT) + 2, 1u, __ATOMIC_RELAXED, __HIP_MEMORY_SCOPE_AGENT);
      continue;
    }
    j -= J_MODS;
    if (j < J_WEFF) {
      const int g = j >> 4, cch = (j >> 1) & 7, nch = j & 1;
      float* wp = (float*)smem;
      for (int i = tid; i < 2048; i += NT) wp[i] = p.w_pool[(size_t)(g * 128 + cch * 16 + (i >> 7)) * 128 + (i & 127)];
      __syncthreads();
      const int n = nch * 512 + tid;
      float a[16];
#pragma unroll
      for (int c = 0; c < 16; ++c) a[c] = 0.f;
#pragma unroll 16
      for (int e = 0; e < 128; ++e) {
        const float wo = p.w_conv_out[(size_t)(512 + g * 128 + e) * 1024 + n] * p.pool_scale[g * 128 + e];
#pragma unroll
        for (int c = 0; c < 16; ++c) a[c] += wp[c * 128 + e] * wo;
      }
      bf16_t* d = (bf16_t*)(ws + O_WCONVOUT) + (size_t)n * 1024 + 512 + g * 128 + cch * 16;
      *(u32x4*)d = (u32x4){pack2(a[0], a[1]), pack2(a[2], a[3]), pack2(a[4], a[5]), pack2(a[6], a[7])};
      *(u32x4*)(d + 8) = (u32x4){pack2(a[8], a[9]), pack2(a[10], a[11]), pack2(a[12], a[13]), pack2(a[14], a[15])};
      __syncthreads();
      continue;
    }
    j -= J_WEFF;
    if (j < J_CACHE) {
      const int rr = j * 8 + wid, b = rr >> 8, t = rr & 255;
      const size_t kr = NCTX + (size_t)b * TKL + t;
      const f32x4 a0 = *(const f32x4*)(p.cache_k + (size_t)rr * 512 + lane * 8), a1 = *(const f32x4*)(p.cache_k + (size_t)rr * 512 + lane * 8 + 4);
      *(u32x4*)((bf16_t*)(ws + O_KD) + kr * 512 + lane * 8) = (u32x4){pack2(a0[0], a0[1]), pack2(a0[2], a0[3]), pack2(a1[0], a1[1]), pack2(a1[2], a1[3])};
      const f32x4 b0 = *(const f32x4*)(p.cache_v + (size_t)rr * 512 + lane * 8), b1 = *(const f32x4*)(p.cache_v + (size_t)rr * 512 + lane * 8 + 4);
      *(u32x4*)((bf16_t*)(ws + O_VD) + kr * 512 + lane * 8) = (u32x4){pack2(b0[0], b0[1]), pack2(b0[2], b0[3]), pack2(b1[0], b1[1]), pack2(b1[2], b1[3])};
      const f32x2 cv = *(const f32x2*)(p.cache_ckv + (size_t)rr * 128 + lane * 2);
      *(unsigned*)((bf16_t*)(ws + O_CKVN) + kr * 128 + lane * 2) = pack2(cv[0], cv[1]);
      const int idx = lane & 31;
      const float x = p.cache_krope[(size_t)rr * 32 + idx];
      const unsigned pk = pack2(x, x);
#pragma unroll
      for (int k = 0; k < 4; ++k) { const int hh = (lane >> 5) + 2 * k; ((bf16_t*)(ws + O_KMLA))[kr * 768 + hh * 96 + 64 + idx] = (bf16_t)(pk & 0xffff); }
      continue;
    }
    j -= J_CACHE;
    {
      float* c16 = (float*)(ws + O_C16); float* s16 = (float*)(ws + O_S16); float* c8 = (float*)(ws + O_C8); float* s8 = (float*)(ws + O_S8);
      for (int i = tid; i < 1024 + 512; i += NT) {
        int pos, f, half;
        if (i < 1024) { pos = i >> 4; f = i & 15; half = 16; } else { const int q = i - 1024; pos = q >> 3; f = q & 7; half = 8; }
        const float inv = (float)exp(-9.210340371976184 * (double)f / (double)half);
        const float angf = (float)pos * inv;
        const double ang = (double)angf;
        const double r = ang - 6.283185307179586 * rint(ang * 0.15915494309189535);
        const float cs = (float)cos_red(r), sn = (float)sin_red(r);
        if (i < 1024) { c16[i] = cs; s16[i] = sn; } else { c8[i - 1024] = cs; s8[i - 1024] = sn; }
      }
      if (wid == 0) {
        const float d1 = wave_sum(p.lam_q1[lane] * p.lam_k1[lane]), d2 = wave_sum(p.lam_q2[lane] * p.lam_k2[lane]);
        if (lane == 0) ((float*)(ws + O_SCAL))[0] = expf(d1) - expf(d2) + 0.2f;
      }
    }
  }
  {
    float* tile = (float*)smem;
    const int G = gridDim.x;
    int j = (blockIdx.x + G - (J_SLOW % G)) % G;
    float va[16], vb[16];
    TJ ta, tb;
    if (j < J_TR) { ta = tr_decode(p, j); tr_load(ta, va); } else ta = TJ{};
    if (j + G < J_TR) { tb = tr_decode(p, j + G); tr_load(tb, vb); } else tb = ta;
#define TR_STEP(V, T, jj_) do { \
      { const int n4 = (tid & 31) * 4, kb = tid >> 5; \
        _Pragma("unroll") for (int i = 0; i < 4; ++i) \
          _Pragma("unroll") for (int e = 0; e < 4; ++e) tile[(kb + 16 * i) * 129 + n4 + e] = V[4 * i + e]; } \
      __syncthreads(); \
      const TJ cur = T; \
      if ((jj_) + 2 * G < J_TR) { T = tr_decode(p, (jj_) + 2 * G); tr_load(T, V); }     \
      _Pragma("unroll") for (int ps = 0; ps < 2; ++ps) {     \
        const int n = ps * 64 + (tid >> 3), ks = (tid & 7) * 8; \
        int gn = cur.nt * 128 + n; \
        if (cur.perm) { if (gn < 512) gn = 32 * (gn >> 4) + (gn & 15); else if (gn < 1024) { const int c = gn - 512; gn = 32 * (c >> 4) + 16 + (c & 15); } } \
        unsigned w[4]; \
        _Pragma("unroll") for (int e = 0; e < 4; ++e) w[e] = pack2(tile[(ks + 2 * e) * 129 + n], tile[(ks + 2 * e + 1) * 129 + n]); \
        *(u32x4*)(cur.dst + (size_t)gn * cur.lddst + cur.kt * 64 + ks) = (u32x4){w[0], w[1], w[2], w[3]}; } \
      __syncthreads(); } while (0)
    while (j < J_TR) {
      TR_STEP(va, ta, j);
      j += G;
      if (j >= J_TR) break;
      TR_STEP(vb, tb, j);
      j += G;
    }
#undef TR_STEP
  }
  if (tid == 0) {
    unsigned sp = 0;
    while (__hip_atomic_load((unsigned*)(ws + O_CNT) + 2, __ATOMIC_RELAXED, __HIP_MEMORY_SCOPE_AGENT) < (unsigned)J_MODS) { __builtin_amdgcn_s_sleep(2); if (++sp > (1u << 22)) break; }
  }
  __syncthreads();
  modulate_phase(p.x_prompt, p.x_sample, (const float*)(ws + O_MODS), (bf16_t*)(ws + O_HB));
}

DI void rope8(const float (&x)[8], float (&o)[8], int lane, const float* c16, const float* s16, int prow, int pcol) {
  const int L = lane & 7;
  const int pos = (L & 4) ? pcol : prow;
  const bool second = (L & 2) != 0;
  const int fb = (L & 1) * 8;
#pragma unroll
  for (int e = 0; e < 8; ++e) {
    const float y = __shfl_xor(x[e], 2);
    const float cs = c16[pos * 16 + fb + e], sn = s16[pos * 16 + fb + e];
    o[e] = second ? (y * sn + x[e] * cs) : (x[e] * cs - y * sn);
  }
}
DI void unpack8(const u32x4 w, float (&x)[8]) {
#pragma unroll
  for (int e = 0; e < 4; ++e) { x[2 * e] = bflo(w[e]); x[2 * e + 1] = bfhi(w[e]); }
}
DI u32x4 pack8(const float (&x)[8]) { return (u32x4){pack2(x[0], x[1]), pack2(x[2], x[3]), pack2(x[4], x[5]), pack2(x[6], x[7])}; }

DI void phase3(const Params& p) {
  char* ws = p.ws;
  const bf16_t* R = (const bf16_t*)(ws + O_R);
  bf16_t* Qda = (bf16_t*)(ws + O_QDA); bf16_t* Qdb = (bf16_t*)(ws + O_QDB); bf16_t* Kd = (bf16_t*)(ws + O_KD); bf16_t* Vd = (bf16_t*)(ws + O_VD);
  bf16_t* cqn = (bf16_t*)(ws + O_CQN); bf16_t* ckvn = (bf16_t*)(ws + O_CKVN); bf16_t* Km = (bf16_t*)(ws + O_KMLA);
  const float* c16 = (const float*)(ws + O_C16); const float* s16 = (const float*)(ws + O_S16); const float* c8 = (const float*)(ws + O_C8); const float* s8 = (const float*)(ws + O_S8);
  float* o_k = p.out + (size_t)NTOK * 1024; float* o_v = o_k + (size_t)NCTX * 512; float* o_ckv = o_v + (size_t)NCTX * 512; float* o_kr = o_ckv + (size_t)NCTX * 128;
  const int lane = threadIdx.x & 63, gw = blockIdx.x * NWAVE + (threadIdx.x >> 6), nw = gridDim.x * NWAVE;
  for (int row = gw; row < NTOK; row += nw) {
    const bool lat = row >= NCTX;
    const int rl = row - NCTX, b = rl >> 12, t = rl & (TLAT - 1), prow = t >> 6, pcol = t & 63;
    const size_t kr = lat ? (size_t)NCTX + (size_t)b * TKL + 256 + t : (size_t)row;
    const bf16_t* r = R + (size_t)row * RLD;
    float x[8], o[8];
    const u32x4 wq = *(const u32x4*)(r + lane * 8);
    *(u32x4*)(Qda + (size_t)row * 512 + lane * 8) = wq;
    if (lat) { unpack8(wq, x); rope8(x, o, lane, c16, s16, prow, pcol); *(u32x4*)(Qdb + (size_t)rl * 512 + lane * 8) = pack8(o); }
    const u32x4 wk = *(const u32x4*)(r + 512 + lane * 8);
    if (lat) { unpack8(wk, x); rope8(x, o, lane, c16, s16, prow, pcol); *(u32x4*)(Kd + kr * 512 + lane * 8) = pack8(o); }
    else {
      unpack8(wk, x);
      *(f32x4*)(o_k + (size_t)row * 512 + lane * 8) = (f32x4){x[0], x[1], x[2], x[3]};
      *(f32x4*)(o_k + (size_t)row * 512 + lane * 8 + 4) = (f32x4){x[4], x[5], x[6], x[7]};
      *(u32x4*)(Kd + kr * 512 + lane * 8) = wk;
    }
    const u32x4 wv = *(const u32x4*)(r + 1024 + lane * 8);
    *(u32x4*)(Vd + kr * 512 + lane * 8) = wv;
    if (!lat) {
      unpack8(wv, x);
      *(f32x4*)(o_v + (size_t)row * 512 + lane * 8) = (f32x4){x[0], x[1], x[2], x[3]};
      *(f32x4*)(o_v + (size_t)row * 512 + lane * 8 + 4) = (f32x4){x[4], x[5], x[6], x[7]};
    }
    {
      const u32x2 w = *(const u32x2*)(r + 1536 + lane * 4);
      const float a0 = bflo(w[0]), a1 = bfhi(w[0]), a2 = bflo(w[1]), a3 = bfhi(w[1]);
      const float ss = wave_sum(a0 * a0 + a1 * a1 + a2 * a2 + a3 * a3);
      const float sc = rsqrtf(ss * (1.f / 256.f) + EPS);
      const f32x4 g = *(const f32x4*)(p.q_norm_g + lane * 4);
      *(u32x2*)(cqn + (size_t)row * 256 + lane * 4) = (u32x2){pack2(a0 * sc * g[0], a1 * sc * g[1]), pack2(a2 * sc * g[2], a3 * sc * g[3])};
    }
    {
      const unsigned w = *(const unsigned*)(r + 1792 + lane * 2);
      const float a0 = bflo(w), a1 = bfhi(w);
      const float ss = wave_sum(a0 * a0 + a1 * a1);
      const float sc = rsqrtf(ss * (1.f / 128.f) + EPS);
      const f32x2 g = *(const f32x2*)(p.kv_norm_g + lane * 2);
      const float y0 = a0 * sc * g[0], y1 = a1 * sc * g[1];
      if (!lat) *(f32x2*)(o_ckv + (size_t)row * 128 + lane * 2) = (f32x2){y0, y1};
      *(unsigned*)(ckvn + kr * 128 + lane * 2) = pack2(y0, y1);
    }
    {
      const int idx = lane & 31;
      const float xv = bf2f(r[1920 + idx]);
      float ov = xv;
      if (lat) {
        const int pos = (idx & 16) ? pcol : prow;
        const int f = idx & 7;
        const float y = __shfl_xor(xv, 8);
        const float cs = c8[pos * 8 + f], sn = s8[pos * 8 + f];
        ov = (idx & 8) ? (y * sn + xv * cs) : (xv * cs - y * sn);
      } else if (lane < 32) o_kr[(size_t)row * 32 + idx] = xv;
      const bf16_t ob = (bf16_t)(pack2(ov, ov) & 0xffff);
#pragma unroll
      for (int k = 0; k < 4; ++k) { const int hh = (lane >> 5) + 2 * k; Km[kr * 768 + hh * 96 + 64 + idx] = ob; }
    }
  }
}

template <int DQK, int DV>
DI void attn_core(const bf16_t* __restrict__ Qa, const bf16_t* __restrict__ Qb, int ldq, const bf16_t* __restrict__ Kp, int ldk, const bf16_t* __restrict__ Vp, int ldv,
                  int Tk, int n_a, float c  , char* smem, f32x16 (&o)[DV / 32]) {
  constexpr int KS = DQK * 2 + 16, VS = DV * 2 + 64, BUF = 64 * (KS + VS);
  constexpr int KCH = DQK / 8, VCH = DV / 8, NKCH = 64 * KCH, NVCH = 64 * VCH, NKC = (NKCH + NT - 1) / NT, NVC = (NVCH + NT - 1) / NT;
  constexpr bool KG = (NKCH % NT) != 0, VG = (NVCH % NT) != 0;
  constexpr int NS = DQK / 16, NDT = DV / 32;
  const int tid = threadIdx.x, lane = tid & 63, wid = tid >> 6, h = lane >> 5, ql = lane & 31;
  bf16x8 qf[NS];
  {
    const bf16_t* q = Qa + (size_t)(wid * 32 + ql) * ldq + h * 8;
#pragma unroll
    for (int s = 0; s < NS; ++s) qf[s] = *(const bf16x8*)(q + s * 16);
  }
#pragma unroll
  for (int dt = 0; dt < NDT; ++dt)
#pragma unroll
    for (int r = 0; r < 16; ++r) o[dt][r] = 0.f;
  float m_run = -INFINITY, l_run = 0.f;
  u32x4 rkA[NKC], rvA[NVC], rkB[NKC], rvB[NVC];
  const int nt = Tk >> 6, ta = n_a >> 6;
  unsigned koff[NKC], voff[NVC];
#pragma unroll
  for (int i = 0; i < NKC; ++i) { const int ch = (tid + NT * i) % NKCH, row = ch / KCH, kc = ch % KCH; koff[i] = (unsigned)(row * ldk + kc * 8); }
#pragma unroll
  for (int i = 0; i < NVC; ++i) { const int ch = (tid + NT * i) % NVCH, row = ch / VCH, vc = ch % VCH; voff[i] = (unsigned)(row * ldv + vc * 8); }
  auto gload = [&](u32x4 (&rk)[NKC], u32x4 (&rv)[NVC], int t) {
    const bf16_t* kb = Kp + (size_t)t * 64 * ldk;
    const bf16_t* vbp = Vp + (size_t)t * 64 * ldv;
#pragma unroll
    for (int i = 0; i < NKC; ++i) rk[i] = *(const u32x4*)(kb + koff[i]);
#pragma unroll
    for (int i = 0; i < NVC; ++i) rv[i] = *(const u32x4*)(vbp + voff[i]);
  };
  auto lstore = [&](u32x4 (&rk)[NKC], u32x4 (&rv)[NVC], char* buf) {
#pragma unroll
    for (int i = 0; i < NKC; ++i) { const int ch = tid + NT * i, row = ch / KCH, kc = ch % KCH; if (!KG || i + 1 < NKC || ch < NKCH) *(u32x4*)(buf + row * KS + kc * 16) = rk[i]; }
#pragma unroll
    for (int i = 0; i < NVC; ++i) { const int ch = tid + NT * i, row = ch / VCH, vc = ch % VCH; if (!VG || i + 1 < NVC || ch < NVCH) *(u32x4*)(buf + 64 * KS + row * VS + vc * 16) = rv[i]; }
  };
  gload(rkA, rvA, 0); lstore(rkA, rvA, smem); lds_barrier();
  gload(rkA, rvA, min(1, nt - 1));
  const int i16 = lane & 15, tq = i16 >> 2, tp = i16 & 3, G = (lane >> 4) & 1;
  auto compute = [&](const char* cur) {
    f32x16 st[2];
    bf16x8 kf[2][NS];
#pragma unroll
    for (int kt = 0; kt < 2; ++kt)
#pragma unroll
      for (int s = 0; s < NS; ++s) kf[kt][s] = *(const bf16x8*)(cur + (kt * 32 + ql) * KS + s * 32 + h * 16);
#pragma unroll
    for (int kt = 0; kt < 2; ++kt) {
#pragma unroll
      for (int r = 0; r < 16; ++r) st[kt][r] = 0.f;
#pragma unroll
      for (int s = 0; s < NS; ++s) st[kt] = __builtin_amdgcn_mfma_f32_32x32x16_bf16(kf[kt][s], qf[s], st[kt], 0, 0, 0);
    }
    __builtin_amdgcn_sched_barrier(0);
    float mx = st[0][0];
#pragma unroll
    for (int kt = 0; kt < 2; ++kt)
#pragma unroll
      for (int r = 0; r < 16; ++r) mx = fmaxf(mx, st[kt][r]);
    {
      typedef unsigned u32x2v __attribute__((ext_vector_type(2)));
      const u32x2v sw = __builtin_amdgcn_permlane32_swap(__float_as_uint(mx), __float_as_uint(mx), false, false);
      mx = fmaxf(__uint_as_float(sw[0]), __uint_as_float(sw[1]));
    }
    const float m_new = fmaxf(m_run, mx);
    const float alpha = __builtin_amdgcn_exp2f((m_run - m_new) * c);
    const float mc = m_new * c;
    m_run = m_new;
    f32x2 ls2 = {0.f, 0.f};
#pragma unroll
    for (int kt = 0; kt < 2; ++kt) {
      const f32x16 tv = st[kt] * c - mc;
#pragma unroll
      for (int r = 0; r < 16; r += 2) {
        const f32x2 pv = {__builtin_amdgcn_exp2f(tv[r]), __builtin_amdgcn_exp2f(tv[r + 1])};
        st[kt][r] = pv[0]; st[kt][r + 1] = pv[1];
        ls2 += pv;
      }
    }
    l_run = l_run * alpha + (ls2[0] + ls2[1]);
    if (__any(alpha != 1.f)) {
#pragma unroll
      for (int dt = 0; dt < NDT; ++dt)
#pragma unroll
        for (int r = 0; r < 16; ++r) o[dt][r] *= alpha;
    }
    bf16x8 pf[2][2];
#pragma unroll
    for (int kt = 0; kt < 2; ++kt)
#pragma unroll
      for (int s2 = 0; s2 < 2; ++s2) {
        u32x4 w = {pack2(st[kt][8 * s2 + 0], st[kt][8 * s2 + 1]), pack2(st[kt][8 * s2 + 2], st[kt][8 * s2 + 3]), pack2(st[kt][8 * s2 + 4], st[kt][8 * s2 + 5]), pack2(st[kt][8 * s2 + 6], st[kt][8 * s2 + 7])};
        pf[kt][s2] = __builtin_bit_cast(bf16x8, w);
      }
    const char* vb = cur + 64 * KS + (4 * h + tq) * VS + 32 * G + 8 * tp;
    bf16x8 vfa[NDT], vfb[NDT];
#define A_VLOAD(VF, g_) do { \
      _Pragma("unroll") for (int dt = 0; dt < NDT; ++dt) { \
        const char* a0 = vb + (((g_) >> 1) * 32 + 16 * ((g_) & 1)) * VS + dt * 64; \
        const s16x4 lo = __builtin_amdgcn_ds_read_tr16_b64_v4i16((LDS_AS s16x4*)(a0)); \
        const s16x4 hi = __builtin_amdgcn_ds_read_tr16_b64_v4i16((LDS_AS s16x4*)(a0 + 8 * VS)); \
        VF[dt] = __builtin_shufflevector(lo, hi, 0, 1, 2, 3, 4, 5, 6, 7); } } while (0)
#define A_VMMA(VF, g_) do { \
      _Pragma("unroll") for (int dt = 0; dt < NDT; ++dt) o[dt] = __builtin_amdgcn_mfma_f32_32x32x16_bf16(VF[dt], pf[(g_) >> 1][(g_) & 1], o[dt], 0, 0, 0); } while (0)
    A_VLOAD(vfa, 0);
    A_VLOAD(vfb, 1);
    __builtin_amdgcn_sched_barrier(0);
    A_VMMA(vfa, 0);
    __builtin_amdgcn_sched_barrier(0);
    A_VLOAD(vfa, 2);
    __builtin_amdgcn_sched_barrier(0);
    A_VMMA(vfb, 1);
    __builtin_amdgcn_sched_barrier(0);
    A_VLOAD(vfb, 3);
    __builtin_amdgcn_sched_barrier(0);
    A_VMMA(vfa, 2);
    __builtin_amdgcn_sched_barrier(0);
    A_VMMA(vfb, 3);
#undef A_VLOAD
#undef A_VMMA
  };
  auto run_tiles = [&](int t_begin, int t_end) {
    for (int t = t_begin; t < t_end; t += 2) {
      gload(rkB, rvB, min(t + 2, nt - 1));
      compute(smem);
      lstore(rkA, rvA, smem + BUF);
      lds_barrier();
      gload(rkA, rvA, min(t + 3, nt - 1));
      compute(smem + BUF);
      lstore(rkB, rvB, smem);
      lds_barrier();
    }
  };
  if (wid >= 4) __builtin_amdgcn_s_setprio(1);
  run_tiles(0, min(ta, nt));
  if (ta < nt) {
    const bf16_t* q = Qb + (size_t)(wid * 32 + ql) * ldq + h * 8;
#pragma unroll
    for (int s = 0; s < NS; ++s) qf[s] = *(const bf16x8*)(q + s * 16);
    run_tiles(ta, nt);
  }
  __builtin_amdgcn_s_setprio(0);
  const float l = l_run + __shfl_xor(l_run, 32);
  const float inv = 1.f / l;
#pragma unroll
  for (int dt = 0; dt < NDT; ++dt)
#pragma unroll
    for (int r = 0; r < 16; ++r) o[dt][r] *= inv;
}

DI u32x4 pair_swap16(const u32x2 xa, const u32x2 xb) {
  typedef unsigned u32x2v __attribute__((ext_vector_type(2)));
  const u32x2v s0 = __builtin_amdgcn_permlane32_swap(xa[0], xb[0], false, false);
  const u32x2v s1 = __builtin_amdgcn_permlane32_swap(xa[1], xb[1], false, false);
  return (u32x4){s0[0], s1[0], s0[1], s1[1]};
}
constexpr int U_DBIG = 128, U_MBIG = 256, U_DCTX = 64, U_MCTX = 128, U_TOTAL = U_DBIG + U_MBIG + U_DCTX + U_MCTX;

DI void phase_attn(const Params& p, char* smem, int cidx) {
  char* ws = p.ws;
  const bf16_t* Qda = (const bf16_t*)(ws + O_QDA); const bf16_t* Qdb = (const bf16_t*)(ws + O_QDB); const bf16_t* Kd = (const bf16_t*)(ws + O_KD); const bf16_t* Vd = (const bf16_t*)(ws + O_VD);
  const bf16_t* Qma = (const bf16_t*)(ws + O_QMA); const bf16_t* Qmb = (const bf16_t*)(ws + O_QMB); const bf16_t* Km = (const bf16_t*)(ws + O_KMLA); const bf16_t* Vm = (const bf16_t*)(ws + O_VMLA);
  bf16_t* cat = (bf16_t*)(ws + O_HB);
  float* otmp = (float*)(ws + O_OTMP) + (size_t)blockIdx.x * 32768;
  int* counter = (int*)(ws + O_CNT) + cidx;
  int* s_unit = (int*)(smem + 65532);
  const int tid = threadIdx.x, lane = tid & 63, wid = tid >> 6, h2 = lane >> 5, ql = lane & 31;
  const float lam = ((const float*)(ws + O_SCAL))[0];
  for (;;) {
    if (tid == 0) *s_unit = atomicAdd(counter, 1);
    __syncthreads();
    int u = __builtin_amdgcn_readfirstlane(*s_unit);
    __syncthreads();
    if (u >= U_TOTAL) break;
    bool diff; int qrow0, krow0, Tk, n_a, head; bool lat;
    if (u < U_DBIG) { diff = true; lat = true; const int b = u >> 6, hh = (u >> 4) & 3, qb = u & 15; head = hh; qrow0 = NCTX + b * TLAT + qb * 256; krow0 = NCTX + b * TKL; Tk = TKL; n_a = 256; }
    else if (u < U_DBIG + U_MBIG) { u -= U_DBIG; diff = false; lat = true; const int b = u >> 7, hh = (u >> 4) & 7, qb = u & 15; head = hh; qrow0 = NCTX + b * TLAT + qb * 256; krow0 = NCTX + b * TKL; Tk = TKL; n_a = 256; }
    else if (u < U_DBIG + U_MBIG + U_DCTX) { u -= U_DBIG + U_MBIG; diff = true; lat = false; const int sq = u >> 2, hh = u & 3; head = hh; qrow0 = sq * 256; krow0 = sq * 256; Tk = 256; n_a = 256; }
    else { u -= U_DBIG + U_MBIG + U_DCTX; diff = false; lat = false; const int sq = u >> 3, hh = u & 7; head = hh; qrow0 = sq * 256; krow0 = sq * 256; Tk = 256; n_a = 256; }
    const int qrowb = lat ? qrow0 - NCTX : 0;
    if (diff) {
      f32x16 o[4];
      const float c = 0.125f * 1.4426950408889634f;
#pragma unroll 1
      for (int m = 0; m < 2; ++m) {
        attn_core<64, 128>(Qda + (size_t)qrow0 * 512 + head * 128 + m * 64, Qdb + (size_t)qrowb * 512 + head * 128 + m * 64, 512,
                           Kd + (size_t)krow0 * 512 + head * 128 + m * 64, 512, Vd + (size_t)krow0 * 512 + head * 128, 512, Tk, n_a, c, smem, o);
        if (m == 0) {
#pragma unroll
          for (int dt = 0; dt < 4; ++dt)
#pragma unroll
            for (int rq = 0; rq < 4; ++rq) *(f32x4*)(otmp + tid * 64 + dt * 16 + rq * 4) = (f32x4){o[dt][4 * rq], o[dt][4 * rq + 1], o[dt][4 * rq + 2], o[dt][4 * rq + 3]};
        }
      }
      float ss = 0.f;
#pragma unroll
      for (int dt = 0; dt < 4; ++dt)
#pragma unroll
        for (int rq = 0; rq < 4; ++rq) {
          const f32x4 o0 = *(const f32x4*)(otmp + tid * 64 + dt * 16 + rq * 4);
#pragma unroll
          for (int e = 0; e < 4; ++e) { const float v = o0[e] - lam * o[dt][4 * rq + e]; o[dt][4 * rq + e] = v; ss += v * v; }
        }
      ss += __shfl_xor(ss, 32);
      const float sc = rsqrtf(ss * (1.f / 128.f) + EPS) * 0.8f;
      bf16_t* dst = cat + (size_t)(qrow0 + wid * 32 + ql) * 1024 + head * 128;
#pragma unroll
      for (int dt = 0; dt < 4; ++dt)
#pragma unroll
        for (int k = 0; k < 2; ++k) {
          u32x2 w[2];
#pragma unroll
          for (int q = 0; q < 2; ++q) {
            const int rq = 2 * k + q, dv = dt * 32 + 8 * rq + 4 * h2;
            const f32x4 g = *(const f32x4*)(p.diff_norm_g + dv);
            w[q] = (u32x2){pack2(o[dt][4 * rq] * sc * g[0], o[dt][4 * rq + 1] * sc * g[1]), pack2(o[dt][4 * rq + 2] * sc * g[2], o[dt][4 * rq + 3] * sc * g[3])};
          }
          *(u32x4*)(dst + dt * 32 + 16 * k + 8 * h2) = pair_swap16(w[0], w[1]);
        }
    } else {
      f32x16 o[2];
      const float c = 0.10206207261596575f * 1.4426950408889634f;
      attn_core<96, 64>(Qma + (size_t)qrow0 * 768 + head * 96, Qmb + (size_t)qrowb * 768 + head * 96, 768,
                        Km + (size_t)krow0 * 768 + head * 96, 768, Vm + (size_t)krow0 * 512 + head * 64, 512, Tk, n_a, c, smem, o);
      bf16_t* dst = cat + (size_t)(qrow0 + wid * 32 + ql) * 1024 + 512 + head * 64;
#pragma unroll
      for (int dt = 0; dt < 2; ++dt)
#pragma unroll
        for (int k = 0; k < 2; ++k) {
          const u32x2 wa = {pack2(o[dt][8 * k], o[dt][8 * k + 1]), pack2(o[dt][8 * k + 2], o[dt][8 * k + 3])};
          const u32x2 wb = {pack2(o[dt][8 * k + 4], o[dt][8 * k + 5]), pack2(o[dt][8 * k + 6], o[dt][8 * k + 7])};
          *(u32x4*)(dst + dt * 32 + 16 * k + 8 * h2) = pair_swap16(wa, wb);
        }
    }
  }
}

DI void unpack8f(const u32x4 w, float (&x)[8]) {
#pragma unroll
  for (int e = 0; e < 4; ++e) { x[2 * e] = bflo(w[e]); x[2 * e + 1] = bfhi(w[e]); }
}
template <int TT>
DI void conv_unit(const Params& p, const bf16_t* __restrict__ Ug, const bf16_t* __restrict__ Pz, bf16_t* __restrict__ cat, const float* wl, int t0, int lane) {
  const int c0 = lane * 8;
  const int grp = lane >> 4, HW = 1 << grp;
    const int s0 = t0 < NCTX ? (t0 & ~255) : NCTX + ((t0 - NCTX) & ~(TLAT - 1));
    const int s1 = t0 < NCTX ? s0 + 256 : s0 + TLAT;
    {
      u32x4 pr[TT + 16];
#pragma unroll
      for (int i = 0; i < TT + 16; ++i) {
        const int r = t0 - 8 + i;
        pr[i] = (u32x4){0u, 0u, 0u, 0u};
        if (r >= s0 && r < s1) pr[i] = *(const u32x4*)(Pz + (size_t)r * 512 + c0);
      }
#pragma unroll
      for (int o = 0; o < TT; ++o) {
        const int r = t0 + o, ci = o + 8;
        float s[8], x[8], ctr[8], s2[8], s4[8], s8[8];
        unpack8f(pr[ci], ctr);
        unpack8f(pr[ci - 1], x);
#pragma unroll
        for (int e = 0; e < 8; ++e) { s[e] = x[e] + ctr[e]; s2[e] = s[e]; }
#pragma unroll
        for (int d = 0; d < 2; ++d) { unpack8f(pr[d == 0 ? ci - 2 : ci + 1], x);
#pragma unroll
          for (int e = 0; e < 8; ++e) s[e] += x[e]; }
#pragma unroll
        for (int e = 0; e < 8; ++e) s4[e] = s[e];
#pragma unroll
        for (int d = 0; d < 4; ++d) { unpack8f(pr[d < 2 ? ci - 4 + d : ci + d], x);
#pragma unroll
          for (int e = 0; e < 8; ++e) s[e] += x[e]; }
#pragma unroll
        for (int e = 0; e < 8; ++e) s8[e] = s[e];
#pragma unroll
        for (int d = 0; d < 8; ++d) { unpack8f(pr[d < 4 ? ci - 8 + d : ci + d], x);
#pragma unroll
          for (int e = 0; e < 8; ++e) s[e] += x[e]; }
        const int lo = max(r - HW, s0), hi = min(r + HW - 1, s1 - 1);
        const float ic = 1.f / (float)(hi - lo + 1);
        float dv[8];
#pragma unroll
        for (int e = 0; e < 8; ++e) { const float sm = grp == 0 ? s2[e] : grp == 1 ? s4[e] : grp == 2 ? s8[e] : s[e]; dv[e] = sm * ic - ctr[e]; }
        *(u32x4*)(cat + (size_t)r * 1024 + 512 + c0) = (u32x4){pack2(dv[0], dv[1]), pack2(dv[2], dv[3]), pack2(dv[4], dv[5]), pack2(dv[6], dv[7])};
      }
    }
    f32x2 acc2[TT][4];
#pragma unroll
    for (int o = 0; o < TT; ++o)
#pragma unroll
      for (int e = 0; e < 4; ++e) acc2[o][e] = (f32x2){0.f, 0.f};
    u32x4 q0, q1, q2, q3;
#define CV_ROW(i_) ({ const int r_ = t0 - 15 + (i_); u32x4 v_ = {0u, 0u, 0u, 0u}; if ((i_) < TT + 30 && r_ >= s0 && r_ < s1) v_ = *(const u32x4*)(Ug + (size_t)r_ * 512 + c0); v_; })
    q0 = CV_ROW(0); q1 = CV_ROW(1); q2 = CV_ROW(2); q3 = CV_ROW(3);
#pragma unroll 2
    for (int i = 0; i < TT + 30; ++i) {
      const u32x4 w = q0;
      q0 = q1; q1 = q2; q2 = q3; q3 = CV_ROW(i + 4);
      f32x2 x2[4];
#pragma unroll
      for (int e = 0; e < 4; ++e) x2[e] = (f32x2){bflo(w[e]), bfhi(w[e])};
#pragma unroll
      for (int o = 0; o < TT; ++o) {
        const int j = i - o;
        if ((unsigned)j <= 30u) {
          const f32x4 w0 = *(const f32x4*)(wl + ((j * 2 + 0) * 64 + lane) * 4), w1 = *(const f32x4*)(wl + ((j * 2 + 1) * 64 + lane) * 4);
          acc2[o][0] += x2[0] * (f32x2){w0[0], w0[1]}; acc2[o][1] += x2[1] * (f32x2){w0[2], w0[3]};
          acc2[o][2] += x2[2] * (f32x2){w1[0], w1[1]}; acc2[o][3] += x2[3] * (f32x2){w1[2], w1[3]};
        }
      }
    }
#undef CV_ROW
    const f32x4 bias0 = *(const f32x4*)(p.conv_b + c0), bias1 = *(const f32x4*)(p.conv_b + c0 + 4);
    const f32x4 g0 = *(const f32x4*)(p.conv_norm_g + c0), g1 = *(const f32x4*)(p.conv_norm_g + c0 + 4);
    const f32x4 b0 = *(const f32x4*)(p.conv_norm_b + c0), b1 = *(const f32x4*)(p.conv_norm_b + c0 + 4);
#pragma unroll
    for (int o = 0; o < TT; ++o)
#pragma unroll
      for (int e = 0; e < 4; ++e) { acc2[o][e >> 1][e & 1] += bias0[e]; acc2[o][2 + (e >> 1)][e & 1] += bias1[e]; }
    float mean[TT], rstd[TT];
#pragma unroll
    for (int o = 0; o < TT; ++o) { const f32x2 s2 = (acc2[o][0] + acc2[o][1]) + (acc2[o][2] + acc2[o][3]); mean[o] = s2[0] + s2[1]; }
#pragma unroll
    for (int st = 32; st >= 1; st >>= 1)
#pragma unroll
      for (int o = 0; o < TT; ++o) mean[o] += __shfl_xor(mean[o], st);
#pragma unroll
    for (int o = 0; o < TT; ++o) {
      mean[o] *= (1.f / 512.f);
      float q = 0.f;
#pragma unroll
      for (int e = 0; e < 4; ++e) { const f32x2 d = acc2[o][e] - mean[o]; q += d[0] * d[0] + d[1] * d[1]; }
      rstd[o] = q;
    }
#pragma unroll
    for (int st = 32; st >= 1; st >>= 1)
#pragma unroll
      for (int o = 0; o < TT; ++o) rstd[o] += __shfl_xor(rstd[o], st);
#pragma unroll
    for (int o = 0; o < TT; ++o) {
      const float rs = rsqrtf(rstd[o] * (1.f / 512.f) + EPS);
      float y[8];
#pragma unroll
      for (int e = 0; e < 4; ++e) {
        const float z0 = (acc2[o][e >> 1][e & 1] - mean[o]) * rs * g0[e] + b0[e], z1 = (acc2[o][2 + (e >> 1)][e & 1] - mean[o]) * rs * g1[e] + b1[e];
        y[e] = z0 / (1.f + __expf(-z0)); y[4 + e] = z1 / (1.f + __expf(-z1));
      }
      *(u32x4*)(cat + (size_t)(t0 + o) * 1024 + c0) = (u32x4){pack2(y[0], y[1]), pack2(y[2], y[3]), pack2(y[4], y[5]), pack2(y[6], y[7])};
    }
}

DI void phase_conv(const Params& p, char* smem) {
  char* ws = p.ws;
  const bf16_t* Ug = (const bf16_t*)(ws + O_UG); const bf16_t* Pz = (const bf16_t*)(ws + O_PZ);
  bf16_t* cat = (bf16_t*)(ws + O_HB);
  const int tid = threadIdx.x, lane = tid & 63, wid = tid >> 6;
  float* wl = (float*)smem;
  {
    f32x4 wv[8];
#pragma unroll
    for (int k = 0; k < 8; ++k) { const int i4 = tid + NT * k; wv[k] = (f32x4){0.f, 0.f, 0.f, 0.f}; if (i4 < 31 * 128) wv[k] = *(const f32x4*)(p.conv_w + i4 * 4); }
#pragma unroll
    for (int k = 0; k < 8; ++k) {
      const int i4 = tid + NT * k, j = i4 >> 7, c = (i4 & 127) * 4, lc = c >> 3, hf = (c >> 2) & 1;
      if (i4 < 31 * 128) *(f32x4*)(wl + ((j * 2 + hf) * 64 + lc) * 4) = wv[k];
    }
  }
  __syncthreads();
  for (int g = blockIdx.x; g < NTOK / 48; g += gridDim.x) {
    if (wid < 4) conv_unit<8>(p, Ug, Pz, cat, wl, g * 48 + wid * 8, lane);
    else conv_unit<4>(p, Ug, Pz, cat, wl, g * 48 + 32 + (wid - 4) * 4, lane);
  }
  __syncthreads();
}

__global__ void __launch_bounds__(NT, 2) fwd_kernel(Params p, int ph_lo, int ph_hi) {
  __shared__ __attribute__((aligned(16))) char smem[2 * G_STAGE + 12288];
  __shared__ uint4 xb_words;
  cg::grid_group grid = cg::this_grid();
  char* ws = p.ws;
  if (threadIdx.x == 0) xb_words = make_uint4(0u, 0u, 0u, 0u);
  __syncthreads();
  const XcdBarrier xb = xcd_barrier_post((unsigned*)(ws + O_BAR), (volatile LDS_AS unsigned*)&xb_words);
  if (ph_lo > 1000) grid.sync();
  float* mods = (float*)(ws + O_MODS);
  bf16_t* Hb = (bf16_t*)(ws + O_HB);
  float* X = p.out;
  float* xbuf = (float*)(ws + O_XBUF);
  unsigned* lncnt = (unsigned*)(ws + O_LNCNT);
  const bool fused = (gridDim.x == 256);
#define GSYNC() xcd_barrier(xb)
#define PH_BEGIN(n) if (ph_lo <= n && n < ph_hi) { if (n > ph_lo) GSYNC();
#define PH_BEGIN_IF(n, c) if (ph_lo <= n && n < ph_hi && (c)) { if (n > ph_lo) GSYNC();
#define PH_END }
#ifndef PROBE_DUP
#define PROBE_DUP 0
#endif
#ifndef PROBE_SYNCS
#define PROBE_SYNCS 0
#endif
#define DUP(n, ...) __VA_ARGS__; if ((PROBE_DUP >> n) & 1) { GSYNC(); __VA_ARGS__; }
  for (int i = 0; i < PROBE_SYNCS; ++i) GSYNC();
  PH_BEGIN(0) { DUP(0, phase0(p, smem)); } PH_END
  PH_BEGIN(2) {
    float* o_k = p.out + (size_t)NTOK * 1024; float* o_v = o_k + (size_t)NCTX * 512; float* o_ckv = o_v + (size_t)NCTX * 512; float* o_kr = o_ckv + (size_t)NCTX * 128;
    DUP(2, gemm_phase(Hb, 1024, (const bf16_t*)(ws + O_WATTIN), 1024, 1024, 64, 8,
                      EpiAttIn{(bf16_t*)(ws + O_QDA), (bf16_t*)(ws + O_QDB), (bf16_t*)(ws + O_KD), (bf16_t*)(ws + O_VD), (bf16_t*)(ws + O_CQN), (bf16_t*)(ws + O_CKVN), (bf16_t*)(ws + O_KMLA),
                               o_k, o_v, o_ckv, o_kr, (const float*)(ws + O_C16), (const float*)(ws + O_S16), (const float*)(ws + O_C8), (const float*)(ws + O_S8), p.q_norm_g, p.kv_norm_g, smem + 2 * G_STAGE}, smem));
  } PH_END
  PH_BEGIN(4) {
        const int n1 = 64 * 3, n2 = 67 * 4;
        gemm_phase((const bf16_t*)(ws + O_CQN), 256, (const bf16_t*)(ws + O_WUQ), 256, 256, 64, 3,
                   EpiUq{(bf16_t*)(ws + O_QMA), (bf16_t*)(ws + O_QMB), (const float*)(ws + O_C8), (const float*)(ws + O_S8)}, smem, 0, n1 + n2);
        gemm_phase((const bf16_t*)(ws + O_CKVN), 128, (const bf16_t*)(ws + O_WUKV), 128, 128, 67, 4,
                   EpiUkv{(bf16_t*)(ws + O_KMLA), (bf16_t*)(ws + O_VMLA), smem}, smem, n1, n1 + n2);
  } PH_END
  PH_BEGIN(5) { phase_attn(p, smem, 0); if ((PROBE_DUP >> 5) & 1) { GSYNC(); phase_attn(p, smem, 1); } } PH_END
  PH_BEGIN(6) { gemm_phase(Hb, 1024, (const bf16_t*)(ws + O_WATTOUT), 1024, 1024, 64, 4, EpiResLN{p.x_prompt, p.x_sample, mods + 2048, X, p.ln_mix_g, p.ln_mix_b, mods, 3072, 4096, Hb, xbuf, lncnt, smem + 2 * G_STAGE, fused}, smem); } PH_END
  PH_BEGIN_IF(7, !fused) { rows_phase(X, X + (size_t)NCTX * 1024, true, p.ln_mix_g, p.ln_mix_b, X, mods, 3072, 4096, Hb); } PH_END
  PH_BEGIN(8) { DUP(8, gemm_phase(Hb, 1024, (const bf16_t*)(ws + O_WMLPIN), 1024, 1024, 64, 16, EpiRelu2{(bf16_t*)(ws + O_U), smem + G_STAGE}, smem)); } PH_END
  PH_BEGIN(9) { gemm_phase((const bf16_t*)(ws + O_U), 4096, (const bf16_t*)(ws + O_WMLPOUT), 4096, 4096, 64, 4, EpiResLN{X, X + (size_t)NCTX * 1024, mods + 5120, X, p.ln_mlp_g, p.ln_mlp_b, mods + 3 * 6144, 0, 1024, Hb, xbuf + 98304, lncnt + 64, smem + 2 * G_STAGE, fused}, smem); } PH_END
  PH_BEGIN_IF(10, !fused) { rows_phase(X, X + (size_t)NCTX * 1024, true, p.ln_mlp_g, p.ln_mlp_b, X, mods + 3 * 6144, 0, 1024, Hb); } PH_END
  PH_BEGIN(11) { DUP(11, gemm_phase(Hb, 1024, (const bf16_t*)(ws + O_WCONVIN), 1024, 1024, 64, 6, EpiConv{(bf16_t*)(ws + O_UG), (bf16_t*)(ws + O_PZ), smem}, smem)); } PH_END
  PH_BEGIN(12) { DUP(12, phase_conv(p, smem)); } PH_END
  PH_BEGIN(13) { gemm_phase(Hb, 1024, (const bf16_t*)(ws + O_WCONVOUT), 1024, 1024, 64, 4, EpiResLN{X, X + (size_t)NCTX * 1024, mods + 3 * 6144 + 2048, X, p.ln_mix_g + 1024, p.ln_mix_b + 1024, mods + 3 * 6144, 3072, 4096, Hb, xbuf + 2 * 98304, lncnt + 128, smem + 2 * G_STAGE, fused}, smem); } PH_END
  PH_BEGIN_IF(14, !fused) { rows_phase(X, X + (size_t)NCTX * 1024, true, p.ln_mix_g + 1024, p.ln_mix_b + 1024, X, mods + 3 * 6144, 3072, 4096, Hb); } PH_END
  PH_BEGIN(15) { DUP(15, gemm_phase(Hb, 1024, (const bf16_t*)(ws + O_WMLPIN) + (size_t)4096 * 1024, 1024, 1024, 64, 16, EpiRelu2{(bf16_t*)(ws + O_U), smem + G_STAGE}, smem)); } PH_END
  PH_BEGIN(16) { gemm_phase((const bf16_t*)(ws + O_U), 4096, (const bf16_t*)(ws + O_WMLPOUT) + (size_t)4096 * 1024, 4096, 4096, 64, 4, EpiResLN{X, X + (size_t)NCTX * 1024, mods + 3 * 6144 + 5120, X, p.ln_mlp_g + 1024, p.ln_mlp_b + 1024, mods, 0, 0, nullptr, xbuf + 3 * 98304, lncnt + 192, smem + 2 * G_STAGE, fused}, smem); } PH_END
  PH_BEGIN_IF(17, !fused) { rows_phase(X, X + (size_t)NCTX * 1024, true, p.ln_mlp_g + 1024, p.ln_mlp_b + 1024, X, nullptr, 0, 0, nullptr); } PH_END
}

extern "C" void kernel_launch(void* const* d_in, const int* in_sizes, int n_in, void* d_out, int out_size, void* d_ws, size_t ws_size, hipStream_t stream) {
  static int grid_blocks = 0;
  if (!grid_blocks) {
    int dev = 0, cus = 0, per_cu = 0;
    hipGetDevice(&dev);
    hipDeviceGetAttribute(&cus, hipDeviceAttributeMultiprocessorCount, dev);
    hipOccupancyMaxActiveBlocksPerMultiprocessor(&per_cu, fwd_kernel, NT, 0);
    if (per_cu > 1) per_cu = 1;
    if (per_cu < 1) per_cu = 1;
    grid_blocks = cus * per_cu;
    if (grid_blocks > 256) grid_blocks = 256;
  }
  if (ws_size < WS_NEED) { fprintf(stderr, "workspace too small: %zu < %zu\n", ws_size, (size_t)WS_NEED); return; }
  Params p{};
  const float** f = (const float**)&p;
  for (int i = 0; i < 35; ++i) f[i] = (const float*)d_in[i];
  p.out = (float*)d_out;
  p.ws = (char*)d_ws;
  hipMemsetAsync(d_ws, 0, 16384, stream);
  int lo = 0, hi = NPHASE;
  void* args[] = {&p, &lo, &hi};
  hipError_t e = hipLaunchCooperativeKernel((void*)fwd_kernel, dim3(grid_blocks), dim3(NT), args, 0, stream);
  if (e != hipSuccess) fprintf(stderr, "cooperative launch failed: %s (grid %d)\n", hipGetErrorString(e), grid_blocks);
}
```

```cpp
#include <hip/hip_runtime.h>
#include <hip/hip_cooperative_groups.h>
#include <cstdio>
#include <cstdint>
namespace cg = cooperative_groups;

typedef unsigned short bf16_t;
typedef short bf16x8 __attribute__((ext_vector_type(8)));
typedef short s16x4 __attribute__((ext_vector_type(4)));
typedef float f32x4 __attribute__((ext_vector_type(4)));
typedef float f32x2 __attribute__((ext_vector_type(2)));
typedef float f32x16 __attribute__((ext_vector_type(16)));
typedef unsigned u32x4 __attribute__((ext_vector_type(4)));
typedef unsigned u32x2 __attribute__((ext_vector_type(2)));
typedef __bf16 bf16v2 __attribute__((ext_vector_type(2)));
#define DI __device__ __forceinline__
#define LDS_AS __attribute__((address_space(3)))

constexpr int NTOK = 12288, NCTX = 4096, NKEY = 12800, TLAT = 4096, TKL = 4352;
constexpr int RLD = 1952;
constexpr float ALPHA = 1.41421356237f, EPS = 1e-5f;
constexpr int NPHASE = 18;
constexpr int NT = 512, NWAVE = 8;

constexpr size_t al(size_t x) { return (x + 255) & ~(size_t)255; }
constexpr size_t O_CNT = 0;
constexpr size_t O_BAR = 256;
constexpr size_t O_LNCNT = 14336;
constexpr size_t O_MODS = 16384;
constexpr size_t O_SCAL = O_MODS + al(2 * 3 * 6144 * 4);
constexpr size_t O_C16 = O_SCAL + 256;
constexpr size_t O_S16 = O_C16 + 4096;
constexpr size_t O_C8 = O_S16 + 4096;
constexpr size_t O_S8 = O_C8 + 2048;
constexpr size_t O_XBUF = O_S8 + 2048;
constexpr size_t O_WATTIN = O_XBUF + (size_t)4 * 256 * 192 * 2 * 4;
constexpr size_t O_WUQ = O_WATTIN + (size_t)2048 * 1024 * 2;
constexpr size_t O_WUKV = O_WUQ + (size_t)768 * 256 * 2;
constexpr size_t O_WATTOUT = O_WUKV + (size_t)1024 * 128 * 2;
constexpr size_t O_WMLPIN = O_WATTOUT + (size_t)1024 * 1024 * 2;
constexpr size_t O_WMLPOUT = O_WMLPIN + (size_t)2 * 4096 * 1024 * 2;
constexpr size_t O_WCONVIN = O_WMLPOUT + (size_t)2 * 4096 * 1024 * 2;
constexpr size_t O_WCONVOUT = O_WCONVIN + (size_t)1536 * 1024 * 2;
constexpr size_t O_HB = O_WCONVOUT + (size_t)1024 * 1024 * 2;
constexpr size_t O_BIG = O_HB + (size_t)NTOK * 1024 * 2;
constexpr size_t O_R = O_BIG;
constexpr size_t O_QMA = O_R;
constexpr size_t O_QMB = O_QMA + (size_t)NTOK * 768 * 2;
constexpr size_t O_QDA = O_R + al((size_t)NTOK * RLD * 2);
constexpr size_t O_QDB = O_QDA + (size_t)NTOK * 512 * 2;
constexpr size_t O_KD = O_QDB + (size_t)8192 * 512 * 2;
constexpr size_t O_VD = O_KD + (size_t)NKEY * 512 * 2;
constexpr size_t O_CQN = O_VD + (size_t)NKEY * 512 * 2;
constexpr size_t O_CKVN = O_CQN + (size_t)NTOK * 256 * 2;
constexpr size_t O_KMLA = O_CKVN + (size_t)NKEY * 128 * 2;
constexpr size_t O_VMLA = O_KMLA + (size_t)NKEY * 768 * 2;
constexpr size_t O_OTMP = O_VMLA + (size_t)NKEY * 512 * 2;
constexpr size_t O_ATT_END = O_OTMP + (size_t)512 * 16384 * 4;
constexpr size_t O_U = O_BIG;
constexpr size_t O_U_END = O_U + (size_t)NTOK * 4096 * 2;
constexpr size_t O_UG = O_BIG;
constexpr size_t O_PZ = O_UG + (size_t)NTOK * 512 * 2;
constexpr size_t WS_NEED = (O_ATT_END > O_U_END ? O_ATT_END : O_U_END);
static_assert(O_QMB + (size_t)8192 * 768 * 2 <= O_QDA, "Qm overlay must fit in R");
static_assert(WS_NEED <= (size_t)256 * 1024 * 1024, "workspace too large");

struct Params {
  const float *x_prompt, *x_sample, *cache_k, *cache_v, *cache_ckv, *cache_krope, *c, *c_ctx;
  const float *w_ada, *b_ada, *ln_mix_g, *ln_mix_b, *ln_mlp_g, *ln_mlp_b, *w_mlp_in, *w_mlp_out;
  const float *w_att_in, *w_uq, *w_ukv, *q_norm_g, *kv_norm_g, *lam_q1, *lam_k1, *lam_q2, *lam_k2, *diff_norm_g, *w_att_out;
  const float *w_conv_in, *conv_w, *conv_b, *conv_norm_g, *conv_norm_b, *w_pool, *pool_scale, *w_conv_out;
  float* out;
  char* ws;
};

DI unsigned pack2(float lo, float hi) { f32x2 v = {lo, hi}; bf16v2 b = __builtin_convertvector(v, bf16v2); return __builtin_bit_cast(unsigned, b); }
DI float bf2f(unsigned short u) { return __uint_as_float((unsigned)u << 16); }
DI float bflo(unsigned u) { return __uint_as_float(u << 16); }
DI float bfhi(unsigned u) { return __uint_as_float(u & 0xffff0000u); }
DI float wave_sum(float v) {
#pragma unroll
  for (int o = 32; o >= 1; o >>= 1) v += __shfl_xor(v, o);
  return v;
}
DI void lds_barrier() { asm volatile("s_waitcnt lgkmcnt(0)\n\ts_barrier" ::: "memory"); }
DI void dma16(const void* gsrc, unsigned lds_dst) {
  unsigned keep;
  asm volatile("s_mov_b32 %0, m0\n\ts_mov_b32 m0, %2\n\ts_nop 0\n\tglobal_load_lds_dwordx4 %1, off\n\ts_mov_b32 m0, %0" : "=&s"(keep) : "v"(gsrc), "s"(lds_dst) : "memory");
}
DI int cond_idx(int row) { return row < NCTX ? 0 : 1 + ((row - NCTX) >> 12); }


#define XB_TMO      128
#define XB_XCNT(j)  (256  + 64 * (j))
#define XB_XSUB(j)  (1280 + 64 * (j))
#define XB_XGEN(j)  (2304 + 64 * (j))
#define XB_TOP      3328
#define XB_TOPGEN   3392
#define XCD_BAR_WORDS 3456
#define XB_SPIN_CAP (1u << 18)
DI unsigned xb_ld(unsigned* p)              { return __hip_atomic_load(p, __ATOMIC_RELAXED, __HIP_MEMORY_SCOPE_AGENT); }
DI unsigned xb_add(unsigned* p, unsigned v) { return __hip_atomic_fetch_add(p, v, __ATOMIC_RELAXED, __HIP_MEMORY_SCOPE_AGENT); }
DI unsigned xb_xcc_id() { return (unsigned)__builtin_amdgcn_s_getreg((3 << 11) | 20) & 0xFu; }
#define XB_SPIN(cond, bar) do { unsigned _sp = 0; while (cond) { __builtin_amdgcn_s_sleep(1); \
    if ((++_sp & 255u) == 0u) { if (xb_ld(&(bar)[XB_TMO])) break; if (_sp > XB_SPIN_CAP) { atomicAdd(&(bar)[XB_TMO], 1u); break; } } } } while (0)
struct XcdBarrier { unsigned* bar; unsigned x; volatile LDS_AS unsigned* st; };
DI XcdBarrier xcd_barrier_post(unsigned* bar, volatile LDS_AS unsigned* st) {
  XcdBarrier b; b.bar = bar; b.x = xb_xcc_id(); b.st = st;
  if (threadIdx.x == 0) (void)xb_add(&bar[XB_XCNT(b.x)], 1u);
  return b;
}
DI void xcd_barrier_complete(unsigned* bar, unsigned x, unsigned& nloc, unsigned& nx) {
  const unsigned G = gridDim.x * gridDim.y * gridDim.z;
  unsigned sum, cnt, mine, sp = 0u;
  for (;;) {
    sum = 0u; cnt = 0u; mine = 0u;
#pragma unroll
    for (unsigned j = 0; j < 16; ++j) { const unsigned c = xb_ld(&bar[XB_XCNT(j)]); sum += c; cnt += (c > 0u) ? 1u : 0u; mine = (j == x) ? c : mine; }
    if (sum == G) break;
    __builtin_amdgcn_s_sleep(1);
    if ((++sp & 255u) == 0u) { if (xb_ld(&bar[XB_TMO])) break; if (sp > XB_SPIN_CAP) { atomicAdd(&bar[XB_TMO], 1u); break; } }
  }
  nloc = mine > 0u ? mine : 1u; nx = cnt > 0u ? cnt : 1u;
}
DI void xcd_barrier(const XcdBarrier& b) {
  asm volatile("s_waitcnt vmcnt(0)" ::: "memory");
  __syncthreads();
  if (threadIdx.x == 0) {
    unsigned* bar = b.bar;
    __builtin_amdgcn_s_waitcnt(0);
    unsigned nloc = b.st[0], nx = b.st[1];
    if (nloc == 0u) { xcd_barrier_complete(bar, b.x, nloc, nx); b.st[0] = nloc; b.st[1] = nx; }
    const unsigned old = xb_add(&bar[XB_XSUB(b.x)], 1u);
    const unsigned gen = old / nloc;
    if (old + 1u == (gen + 1u) * nloc) {
      __builtin_amdgcn_fence(__ATOMIC_RELEASE, "agent");
      asm volatile("s_waitcnt vmcnt(0)" ::: "memory");
      const unsigned og = xb_add(&bar[XB_TOP], 1u);
      const unsigned tg = og / nx;
      if (og + 1u == (tg + 1u) * nx) xb_add(&bar[XB_TOPGEN], 1u);
      else XB_SPIN(xb_ld(&bar[XB_TOPGEN]) == tg, bar);
      __builtin_amdgcn_fence(__ATOMIC_ACQUIRE, "agent");
      xb_add(&bar[XB_XGEN(b.x)], 1u);
      asm volatile("s_waitcnt vmcnt(0)" ::: "memory");
    } else {
      XB_SPIN(xb_ld(&bar[XB_XGEN(b.x)]) == gen, bar);
      __builtin_amdgcn_fence(__ATOMIC_ACQUIRE, "agent");
      asm volatile("s_waitcnt vmcnt(0)" ::: "memory");
    }
  }
  __syncthreads();
}

DI int swz(int row, int kc) { return row * 128 + ((kc ^ ((row >> 1) & 7)) << 4); }

constexpr int G_BM = 192, G_BN = 256, G_MI = 6, G_NJ = 4, G_ABYTES = G_BM * 128, G_STAGE = G_ABYTES + G_BN * 128;
template <class Epi>
DI void gemm_tile(const bf16_t* __restrict__ A, int lda, const bf16_t* __restrict__ Bt, int ldb, int K, int row0, int col0, char* smem, const Epi& epi,
                  bool prefetched, bool has_next, int nrow0, int ncol0) {
  const int tid = threadIdx.x, lane = tid & 63, wid = tid >> 6, wr = wid >> 2, wc = wid & 3;
  const int fr = lane & 15, fq = lane >> 4;
  f32x4 acc[G_MI][G_NJ];
#pragma unroll
  for (int i = 0; i < G_MI; ++i)
#pragma unroll
    for (int j = 0; j < G_NJ; ++j) acc[i][j] = (f32x4){0.f, 0.f, 0.f, 0.f};
  const int srow = tid >> 3, skc = tid & 7;
  const int schunk = skc ^ ((srow >> 1) & 7);
  const bf16_t* ga = A + (size_t)(row0 + srow) * lda + schunk * 8;
  const bf16_t* gb = Bt + (size_t)(col0 + srow) * ldb + schunk * 8;
  const int nk = K >> 6;
  const unsigned lds0 = __builtin_amdgcn_readfirstlane((unsigned)(size_t)(LDS_AS char*)smem + (unsigned)(tid & ~63) * 16u);
#define G_DMA_P(ga_, gb_, stage_off_, kt_) do { const int k0_ = (kt_) << 6; const unsigned sb_ = lds0 + (unsigned)(stage_off_); \
    _Pragma("unroll") for (int i = 0; i < 3; ++i) dma16((ga_) + (size_t)(64 * i) * lda + k0_, sb_ + i * 8192); \
    _Pragma("unroll") for (int i = 0; i < 4; ++i) dma16((gb_) + (size_t)(64 * i) * ldb + k0_, sb_ + G_ABYTES + i * 8192); } while (0)
#define G_DMA(stage_off_, kt_) G_DMA_P(ga, gb, stage_off_, kt_)
#define G_COMPUTE(buf_) do { const char* cur = (buf_); \
    _Pragma("unroll") for (int s = 0; s < 2; ++s) { \
      bf16x8 af[G_MI], bfr[G_NJ]; \
      _Pragma("unroll") for (int i = 0; i < G_MI; ++i) af[i] = *(const bf16x8*)(cur + swz(wr * 96 + i * 16 + fr, s * 4 + fq)); \
      _Pragma("unroll") for (int j = 0; j < G_NJ; ++j) bfr[j] = *(const bf16x8*)(cur + G_ABYTES + swz(wc * 64 + j * 16 + fr, s * 4 + fq)); \
      __builtin_amdgcn_s_setprio(1); \
      _Pragma("unroll") for (int i = 0; i < G_MI; ++i) \
        _Pragma("unroll") for (int j = 0; j < G_NJ; ++j) acc[i][j] = __builtin_amdgcn_mfma_f32_16x16x32_bf16(bfr[j], af[i], acc[i][j], 0, 0, 0); \
      __builtin_amdgcn_s_setprio(0); \
    } } while (0)
  if (!prefetched) { G_DMA(0, 0); asm volatile("s_waitcnt vmcnt(0)" ::: "memory"); }
  else asm volatile("s_waitcnt vmcnt(%0)" :: "n"(Epi::kMinStores) : "memory");
  lds_barrier();
  for (int kt = 0; kt < nk; kt += 2) {
    G_DMA(G_STAGE, kt + 1);
    G_COMPUTE(smem);
    asm volatile("s_waitcnt vmcnt(0)" ::: "memory");
    lds_barrier();
    G_DMA(0, min(kt + 2, nk - 1));
    G_COMPUTE(smem + G_STAGE);
    asm volatile("s_waitcnt vmcnt(0)" ::: "memory");
    lds_barrier();
  }
  if (has_next) {
    const bf16_t* gan = A + (size_t)(nrow0 + srow) * lda + schunk * 8;
    const bf16_t* gbn = Bt + (size_t)(ncol0 + srow) * ldb + schunk * 8;
    G_DMA_P(gan, gbn, 0, 0);
  }
#undef G_DMA
#undef G_DMA_P
#undef G_COMPUTE
  epi(acc, row0 + wr * 96, col0 + wc * 64, lane);
}


template <class F>
DI void wave_rows_store(char* w, const u32x2 (&pk)[G_MI][G_NJ], int lane, F rowptr) {
  const int fr = lane & 15, fq = lane >> 4;
#pragma unroll
  for (int i = 0; i < G_MI; ++i)
#pragma unroll
    for (int j = 0; j < G_NJ; ++j) *(u32x2*)(w + (i * 16 + fr) * 144 + (j * 16 + fq * 4) * 2) = pk[i][j];
  const int rr = lane >> 3, ch = lane & 7;
#pragma unroll
  for (int it = 0; it < 12; ++it) {
    const int r = it * 8 + rr;
    const u32x4 v = *(const u32x4*)(w + r * 144 + ch * 16);
    bf16_t* d = rowptr(r);
    if (d) *(u32x4*)(d + ch * 8) = v;
  }
}
DI u32x2 pk4(const f32x4 v) { return (u32x2){pack2(v[0], v[1]), pack2(v[2], v[3])}; }

struct EpiRaw {
  static constexpr int kMinStores = 0;
  static constexpr bool kPrefetchNext = true;
  bf16_t* R;
  DI void operator()(f32x4 (&acc)[G_MI][G_NJ], int rbase, int cbase, int lane) const {
    const int fr = lane & 15, fq = lane >> 4;
#pragma unroll
    for (int i = 0; i < G_MI; ++i)
#pragma unroll
      for (int j = 0; j < G_NJ; ++j) {
        const int row = rbase + i * 16 + fr, col = cbase + j * 16 + fq * 4;
        if (col < RLD) { u32x2 w = {pack2(acc[i][j][0], acc[i][j][1]), pack2(acc[i][j][2], acc[i][j][3])}; *(u32x2*)(R + (size_t)row * RLD + col) = w; }
      }
  }
};


struct EpiAttIn {
  static constexpr int kMinStores = 0;
  static constexpr bool kPrefetchNext = true;
  bf16_t *Qda, *Qdb, *Kd, *Vd, *cqn, *ckvn, *Km; float *o_k, *o_v, *o_ckv, *o_kr;
  const float *c16, *s16, *c8, *s8, *qg, *kvg; char* smem;
  DI void operator()(f32x4 (&acc)[G_MI][G_NJ], int rbase, int cbase, int lane) const {
    const int tid = threadIdx.x, wid = tid >> 6, wr = wid >> 2, wc = wid & 3, fr = lane & 15, fq = lane >> 4;
    const int tile = (cbase - wc * 64) >> 8;
    float* part = (float*)smem;
    if (tile < 6) {
      const int which = tile >> 1, c0 = cbase & 511;
#pragma unroll
      for (int i = 0; i < G_MI; ++i) {
        const int rowf = rbase + i * 16, row = rowf + fr;
        const bool lat = rowf >= NCTX;
        const int rl = row - NCTX, b = rl >> 12, t = rl & (TLAT - 1), prow = t >> 6, pcol = t & 63;
        const size_t kr = lat ? (size_t)NCTX + (size_t)b * TKL + 256 + t : (size_t)row;
        u32x2 raw[G_NJ], rot[G_NJ];
#pragma unroll
        for (int j = 0; j < G_NJ; ++j) raw[j] = (u32x2){pack2(acc[i][j][0], acc[i][j][1]), pack2(acc[i][j][2], acc[i][j][3])};
        if (lat && which < 2) {
#pragma unroll
          for (int jp = 0; jp < 2; ++jp) {
            const int pos = jp == 0 ? prow : pcol;
            const f32x4 cs = *(const f32x4*)(c16 + pos * 16 + fq * 4), sn = *(const f32x4*)(s16 + pos * 16 + fq * 4);
            const f32x4 x1 = acc[i][2 * jp], x2 = acc[i][2 * jp + 1];
            f32x4 o1, o2;
#pragma unroll
            for (int e = 0; e < 4; ++e) { o1[e] = x1[e] * cs[e] - x2[e] * sn[e]; o2[e] = x1[e] * sn[e] + x2[e] * cs[e]; }
            rot[2 * jp] = (u32x2){pack2(o1[0], o1[1]), pack2(o1[2], o1[3])};
            rot[2 * jp + 1] = (u32x2){pack2(o2[0], o2[1]), pack2(o2[2], o2[3])};
          }
        }
#pragma unroll
        for (int j = 0; j < G_NJ; ++j) {
          const int c = c0 + j * 16 + fq * 4;
          if (which == 0) {
            *(u32x2*)(Qda + (size_t)row * 512 + c) = raw[j];
            if (lat) *(u32x2*)(Qdb + (size_t)rl * 512 + c) = rot[j];
          } else if (which == 1) {
            if (lat) *(u32x2*)(Kd + kr * 512 + c) = rot[j];
            else { *(u32x2*)(Kd + kr * 512 + c) = raw[j]; *(f32x4*)(o_k + (size_t)row * 512 + c) = acc[i][j]; }
          } else {
            *(u32x2*)(Vd + kr * 512 + c) = raw[j];
            if (!lat) *(f32x4*)(o_v + (size_t)row * 512 + c) = acc[i][j];
          }
        }
      }
      return;
    }
    const bool norm_wave = (tile == 6) || (wc < 2);
#pragma unroll
    for (int i = 0; i < G_MI; ++i) {
      float ss = 0.f;
#pragma unroll
      for (int j = 0; j < G_NJ; ++j)
#pragma unroll
        for (int e = 0; e < 4; ++e) ss += acc[i][j][e] * acc[i][j][e];
      ss += __shfl_xor(ss, 16); ss += __shfl_xor(ss, 32);
      if (fq == 0) part[(wr * 96 + i * 16 + fr) * 4 + wc] = ss;
    }
    __syncthreads();
#pragma unroll
    for (int i = 0; i < G_MI; ++i) {
      const int rowf = rbase + i * 16, row = rowf + fr;
      const bool lat = rowf >= NCTX;
      const int rl = row - NCTX, b = rl >> 12, t = rl & (TLAT - 1), prow = t >> 6, pcol = t & 63;
      const size_t kr = lat ? (size_t)NCTX + (size_t)b * TKL + 256 + t : (size_t)row;
      const f32x4 pr = *(const f32x4*)(part + (wr * 96 + i * 16 + fr) * 4);
      if (tile == 6) {
        const float sc = rsqrtf(((pr[0] + pr[1]) + (pr[2] + pr[3])) * (1.f / 256.f) + EPS);
#pragma unroll
        for (int j = 0; j < G_NJ; ++j) {
          const int c = wc * 64 + j * 16 + fq * 4;
          const f32x4 g = *(const f32x4*)(qg + c);
          *(u32x2*)(cqn + (size_t)row * 256 + c) = (u32x2){pack2(acc[i][j][0] * sc * g[0], acc[i][j][1] * sc * g[1]), pack2(acc[i][j][2] * sc * g[2], acc[i][j][3] * sc * g[3])};
        }
      } else if (norm_wave) {
        const float sc = rsqrtf((pr[0] + pr[1]) * (1.f / 128.f) + EPS);
#pragma unroll
        for (int j = 0; j < G_NJ; ++j) {
          const int c = wc * 64 + j * 16 + fq * 4;
          const f32x4 g = *(const f32x4*)(kvg + c);
          f32x4 y;
#pragma unroll
          for (int e = 0; e < 4; ++e) y[e] = acc[i][j][e] * sc * g[e];
          if (!lat) *(f32x4*)(o_ckv + (size_t)row * 128 + c) = y;
          *(u32x2*)(ckvn + kr * 128 + c) = (u32x2){pack2(y[0], y[1]), pack2(y[2], y[3])};
        }
      } else if (wc == 2) {
#pragma unroll
        for (int j = 0; j < 2; ++j) {
          f32x4 v = acc[i][j];
          if (lat) {
            const int pos = j == 0 ? prow : pcol;
            f32x4 o;
#pragma unroll
            for (int e = 0; e < 4; ++e) {
              const float pv = __shfl_xor(v[e], 32);
              const int f = (fq & 1) * 4 + e;
              const float cs = c8[pos * 8 + f], sn = s8[pos * 8 + f];
              o[e] = (fq < 2) ? (v[e] * cs - pv * sn) : (pv * sn + v[e] * cs);
            }
            v = o;
          } else *(f32x4*)(o_kr + (size_t)row * 32 + j * 16 + fq * 4) = v;
          const u32x2 w = {pack2(v[0], v[1]), pack2(v[2], v[3])};
#pragma unroll
          for (int hh = 0; hh < 8; ++hh) *(u32x2*)(Km + kr * 768 + hh * 96 + 64 + j * 16 + fq * 4) = w;
        }
      }
    }
    __syncthreads();
  }
};

struct EpiUq {
  static constexpr int kMinStores = 24;
  static constexpr bool kPrefetchNext = true;
  bf16_t *Qa, *Qb; const float *c8, *s8;
  DI void operator()(f32x4 (&acc)[G_MI][G_NJ], int rbase, int cbase, int lane) const {
    const int fr = lane & 15, fq = lane >> 4;
#pragma unroll
    for (int i = 0; i < G_MI; ++i) {
      const bool lat = (rbase + i * 16) >= NCTX;
      const int row = rbase + i * 16 + fr;
      const int t = (row - NCTX) & (TLAT - 1);
#pragma unroll
      for (int j = 0; j < G_NJ; ++j) {
        const int cf = cbase + j * 16, col = cf + fq * 4;
        f32x4 v = acc[i][j];
        u32x2 w = {pack2(v[0], v[1]), pack2(v[2], v[3])};
        *(u32x2*)(Qa + (size_t)row * 768 + col) = w;
        if (lat) {
          const int w96 = cf % 96;
          if (w96 >= 64) {
            const int pos = (w96 == 64) ? (t >> 6) : (t & 63);
            f32x4 o;
#pragma unroll
            for (int e = 0; e < 4; ++e) {
              const float pv = __shfl_xor(v[e], 32);
              const int f = (fq & 1) * 4 + e;
              const float cs = c8[pos * 8 + f], sn = s8[pos * 8 + f];
              o[e] = (fq < 2) ? (v[e] * cs - pv * sn) : (pv * sn + v[e] * cs);
            }
            w = (u32x2){pack2(o[0], o[1]), pack2(o[2], o[3])};
          }
          *(u32x2*)(Qb + (size_t)(row - NCTX) * 768 + col) = w;
        }
      }
    }
  }
};

struct EpiUkv {
  static constexpr int kMinStores = 0;
  static constexpr bool kPrefetchNext = false;
  bf16_t *Km, *Vm; char* lds;
  DI void operator()(f32x4 (&acc)[G_MI][G_NJ], int rbase, int cbase, int lane) const {
    const int h = cbase >> 7, part = (cbase >> 6) & 1;
    u32x2 pk[G_MI][G_NJ];
#pragma unroll
    for (int i = 0; i < G_MI; ++i)
#pragma unroll
      for (int j = 0; j < G_NJ; ++j) pk[i][j] = pk4(acc[i][j]);
    bf16_t* base = part == 0 ? Km + h * 96 : Vm + h * 64;
    const int ld = part == 0 ? 768 : 512;
    wave_rows_store(lds + (threadIdx.x >> 6) * (96 * 144), pk, lane, [&](int r) -> bf16_t* { const int row = rbase + r; return row < NKEY ? base + (size_t)row * ld : nullptr; });
    lds_barrier();
  }
};

struct EpiRes {
  static constexpr int kMinStores = 0;
  static constexpr bool kPrefetchNext = true;
  const float *xin_ctx, *xin_lat, *gate  ; float* X;
  DI void operator()(f32x4 (&acc)[G_MI][G_NJ], int rbase, int cbase, int lane) const {
    const int fr = lane & 15, fq = lane >> 4;
#pragma unroll
    for (int i = 0; i < G_MI; ++i) {
      const int row = rbase + i * 16 + fr;
      const float* g = gate + cond_idx(rbase + i * 16) * 6144;
      const float* xin = row < NCTX ? xin_ctx + (size_t)row * 1024 : xin_lat + (size_t)(row - NCTX) * 1024;
#pragma unroll
      for (int j = 0; j < G_NJ; ++j) {
        const int col = cbase + j * 16 + fq * 4;
        const f32x4 xv = *(const f32x4*)(xin + col), gv = *(const f32x4*)(g + col);
        f32x4 z;
#pragma unroll
        for (int e = 0; e < 4; ++e) z[e] = ALPHA * xv[e] + gv[e] * acc[i][j][e];
        *(f32x4*)(X + (size_t)row * 1024 + col) = z;
      }
    }
  }
};


struct EpiResLN {
  static constexpr int kMinStores = 0;
  static constexpr bool kPrefetchNext = true;
  const float *xin_ctx, *xin_lat, *gate; float* X;
  const float *lg, *lb, *modsL; int sh_off, sc_off; bf16_t* Hb;
  float* xbuf; unsigned* cnt; char* smem; bool fused;
  DI void operator()(f32x4 (&acc)[G_MI][G_NJ], int rbase, int cbase, int lane) const {
    const int tid = threadIdx.x, wid = tid >> 6, wr = wid >> 2, wc = wid & 3, fr = lane & 15, fq = lane >> 4;
    const int cid0 = cond_idx(rbase);
#pragma unroll
    for (int j = 0; j < G_NJ; ++j) {
      const int col = cbase + j * 16 + fq * 4;
      const f32x4 gv0 = *(const f32x4*)(gate + cid0 * 6144 + col);
#pragma unroll
      for (int i = 0; i < G_MI; ++i) {
        const int row = rbase + i * 16 + fr, cid = cond_idx(rbase + i * 16);
        const float* xin = row < NCTX ? xin_ctx + (size_t)row * 1024 : xin_lat + (size_t)(row - NCTX) * 1024;
        const f32x4 xv = *(const f32x4*)(xin + col);
        f32x4 gv = gv0;
        if (cid != cid0) gv = *(const f32x4*)(gate + cid * 6144 + col);
#pragma unroll
        for (int e = 0; e < 4; ++e) acc[i][j][e] = ALPHA * xv[e] + gv[e] * acc[i][j][e];
        if (!fused) *(f32x4*)(X + (size_t)row * 1024 + col) = acc[i][j];
      }
    }
    if (!fused) return;
    const int row0 = rbase - wr * 96, pm = row0 / G_BM, pn = (cbase - wc * 64) / G_BN;
    f32x2* part = (f32x2*)smem;
    f32x2* stat = (f32x2*)(smem + 8192);
#pragma unroll
    for (int i = 0; i < G_MI; ++i) {
      float s1 = 0.f, s2 = 0.f;
#pragma unroll
      for (int j = 0; j < G_NJ; ++j)
#pragma unroll
        for (int e = 0; e < 4; ++e) { const float v = acc[i][j][e]; s1 += v; s2 += v * v; }
      s1 += __shfl_xor(s1, 16); s2 += __shfl_xor(s2, 16);
      s1 += __shfl_xor(s1, 32); s2 += __shfl_xor(s2, 32);
      if (fq == 0) part[(wr * 96 + i * 16 + fr) * 4 + wc] = (f32x2){s1, s2};
    }
    __syncthreads();
    if (tid < G_BM) {
      const f32x2 a = part[tid * 4 + 0], b = part[tid * 4 + 1], c = part[tid * 4 + 2], d = part[tid * 4 + 3];
      const float s1 = (a[0] + b[0]) + (c[0] + d[0]), s2 = (a[1] + b[1]) + (c[1] + d[1]);
      const unsigned long long pk = ((unsigned long long)__float_as_uint(s2) << 32) | (unsigned long long)__float_as_uint(s1);
      __hip_atomic_store((unsigned long long*)(xbuf + ((size_t)(pm * 4 + pn) * G_BM + tid) * 2), pk, __ATOMIC_RELAXED, __HIP_MEMORY_SCOPE_AGENT);
    }
    asm volatile("s_waitcnt vmcnt(0)" ::: "memory");
    __syncthreads();
    if (tid == 0) {
      __hip_atomic_fetch_add(cnt + pm, 1u, __ATOMIC_RELAXED, __HIP_MEMORY_SCOPE_AGENT);
      unsigned sp = 0;
      while (__hip_atomic_load(cnt + pm, __ATOMIC_RELAXED, __HIP_MEMORY_SCOPE_AGENT) < 4u) { __builtin_amdgcn_s_sleep(1); if (++sp > (1u << 22)) break; }
    }
    __syncthreads();
    if (tid < G_BM) {
      float s1 = 0.f, s2 = 0.f;
#pragma unroll
      for (int q = 0; q < 4; ++q) {
        const unsigned long long pk = __hip_atomic_load((unsigned long long*)(xbuf + ((size_t)(pm * 4 + q) * G_BM + tid) * 2), __ATOMIC_RELAXED, __HIP_MEMORY_SCOPE_AGENT);
        s1 += __uint_as_float((unsigned)pk); s2 += __uint_as_float((unsigned)(pk >> 32));
      }
      const float mean = s1 * (1.f / 1024.f);
      const float var = fmaxf(s2 * (1.f / 1024.f) - mean * mean, 0.f);
      stat[tid] = (f32x2){mean, rsqrtf(var + EPS)};
    }
    __syncthreads();
#pragma unroll
    for (int j = 0; j < G_NJ; ++j) {
      const int col = cbase + j * 16 + fq * 4;
      const f32x4 gv = *(const f32x4*)(lg + col), bv = *(const f32x4*)(lb + col);
      f32x4 sh0 = {0.f, 0.f, 0.f, 0.f}, sc0 = sh0;
      if (Hb) { sh0 = *(const f32x4*)(modsL + cid0 * 6144 + sh_off + col); sc0 = *(const f32x4*)(modsL + cid0 * 6144 + sc_off + col); }
#pragma unroll
      for (int i = 0; i < G_MI; ++i) {
        const int row = rbase + i * 16 + fr, cid = cond_idx(rbase + i * 16);
        const f32x2 ms = stat[wr * 96 + i * 16 + fr];
        f32x4 x;
#pragma unroll
        for (int e = 0; e < 4; ++e) x[e] = (acc[i][j][e] - ms[0]) * ms[1] * gv[e] + bv[e];
        *(f32x4*)(X + (size_t)row * 1024 + col) = x;
        if (Hb) {
          f32x4 sh = sh0, sc = sc0;
          if (cid != cid0) { sh = *(const f32x4*)(modsL + cid * 6144 + sh_off + col); sc = *(const f32x4*)(modsL + cid * 6144 + sc_off + col); }
          u32x2 w = {pack2(x[0] * (1.f + sc[0]) + sh[0], x[1] * (1.f + sc[1]) + sh[1]), pack2(x[2] * (1.f + sc[2]) + sh[2], x[3] * (1.f + sc[3]) + sh[3])};
          *(u32x2*)(Hb + (size_t)row * 1024 + col) = w;
        }
      }
    }
    __syncthreads();
  }
};

struct EpiRelu2 {
  static constexpr int kMinStores = 12;
  static constexpr bool kPrefetchNext = true;
  bf16_t* U; char* lds;
  DI void operator()(f32x4 (&acc)[G_MI][G_NJ], int rbase, int cbase, int lane) const {
    const int fr = lane & 15, fq = lane >> 4, wid = threadIdx.x >> 6;
    char* w = lds + wid * (48 * 144);
    const int rr = lane >> 3, ch = lane & 7;
#pragma unroll
    for (int hf = 0; hf < 2; ++hf) {
#pragma unroll
      for (int i3 = 0; i3 < 3; ++i3)
#pragma unroll
        for (int j = 0; j < G_NJ; ++j) {
          f32x4 v = acc[hf * 3 + i3][j];
#pragma unroll
          for (int e = 0; e < 4; ++e) { const float r = fmaxf(v[e], 0.f); v[e] = r * r; }
          *(u32x2*)(w + (i3 * 16 + fr) * 144 + (j * 16 + fq * 4) * 2) = (u32x2){pack2(v[0], v[1]), pack2(v[2], v[3])};
        }
#pragma unroll
      for (int it = 0; it < 6; ++it) {
        const int r = it * 8 + rr;
        const u32x4 v = *(const u32x4*)(w + r * 144 + ch * 16);
        *(u32x4*)(U + (size_t)(rbase + hf * 48 + r) * 4096 + cbase + ch * 8) = v;
      }
    }
  }
};

struct EpiConv {
  static constexpr int kMinStores = 0;
  static constexpr bool kPrefetchNext = false;
  bf16_t *Ug, *Pz; char* lds;
  DI void operator()(f32x4 (&acc)[G_MI][G_NJ], int rbase, int cbase, int lane) const {
    const int fr = lane & 15, fq = lane >> 4;
    char* w = lds + (threadIdx.x >> 6) * (96 * 144);
    if (cbase < 1024) {
#pragma unroll
      for (int i = 0; i < G_MI; ++i)
#pragma unroll
        for (int jp = 0; jp < 2; ++jp) {
          const f32x4 a = acc[i][2 * jp], gt = acc[i][2 * jp + 1];
          f32x4 u;
#pragma unroll
          for (int e = 0; e < 4; ++e) u[e] = a[e] / (1.f + __expf(-gt[e]));
          *(u32x2*)(w + (i * 16 + fr) * 80 + (jp * 16 + fq * 4) * 2) = pk4(u);
        }
      const int rr = lane >> 2, ch = lane & 3, c0 = (cbase >> 5) * 16;
#pragma unroll
      for (int it = 0; it < 6; ++it) {
        const int r = it * 16 + rr;
        const u32x4 v = *(const u32x4*)(w + r * 80 + ch * 16);
        *(u32x4*)(Ug + (size_t)(rbase + r) * 512 + c0 + ch * 8) = v;
      }
    } else {
      u32x2 pk[G_MI][G_NJ];
#pragma unroll
      for (int i = 0; i < G_MI; ++i)
#pragma unroll
        for (int j = 0; j < G_NJ; ++j) pk[i][j] = pk4(acc[i][j]);
      wave_rows_store(w, pk, lane, [&](int r) -> bf16_t* { return Pz + (size_t)(rbase + r) * 512 + (cbase - 1024); });
    }
    lds_barrier();
  }
};

#ifndef XCD_ORDER
#define XCD_ORDER 1
#endif
template <class Epi>
DI void gemm_phase(const bf16_t* A, int lda, const bf16_t* Bt, int ldb, int K, int mt, int nt, const Epi& epi, char* smem, int tstart = 0, int ttotal = -1) {
  const int n = mt * nt;
  if (ttotal < 0) ttotal = n;
  const bool xo = XCD_ORDER && gridDim.x == 256 && (nt & 3) == 0 && (mt & 3) == 0 && n % 256 == 0;
  auto coords = [&](int u, int& r0, int& c0) {
    int pm = u / nt, pn = u - pm * nt;
    if (xo) {
      const int r = u >> 8, w = u & 255, x = w & 7, idx = w >> 3;
      const int rows_r = 256 / nt, pw = nt < 8 ? nt : 8, ph = 32 / pw, npx = nt / pw, px = x % npx, py = x / npx;
      pm = r * rows_r + py * ph + idx / pw; pn = px * pw + idx % pw;
    }
    r0 = pm * G_BM; c0 = pn * G_BN;
  };
  int t = blockIdx.x;
  while (t < tstart) t += gridDim.x;
  bool prefetched = false;
  while (t < tstart + n && t < ttotal) {
    const int tn = t + gridDim.x;
    const bool has_next = Epi::kPrefetchNext && tn < tstart + n && tn < ttotal;
    int r0, c0, nr0 = 0, nc0 = 0;
    coords(t - tstart, r0, c0);
    if (has_next) coords(tn - tstart, nr0, nc0);
    gemm_tile(A, lda, Bt, ldb, K, r0, c0, smem, epi, prefetched, has_next, nr0, nc0);
    prefetched = has_next;
    t = tn;
  }
}

DI void rows_phase(const float* src_ctx, const float* src_lat, bool do_ln, const float* lg, const float* lb, float* Xdst,
                   const float* modsL, int sh_off, int sc_off, bf16_t* Hb) {
  const int lane = threadIdx.x & 63, gw = blockIdx.x * NWAVE + (threadIdx.x >> 6), nw = gridDim.x * NWAVE;
  for (int row = gw; row < NTOK; row += nw) {
    const float* src = row < NCTX ? src_ctx + (size_t)row * 1024 : src_lat + (size_t)(row - NCTX) * 1024;
    f32x4 v[4];
#pragma unroll
    for (int i = 0; i < 4; ++i) v[i] = *(const f32x4*)(src + i * 256 + lane * 4);
    if (do_ln) {
      float s = 0.f;
#pragma unroll
      for (int i = 0; i < 4; ++i) s += (v[i][0] + v[i][1]) + (v[i][2] + v[i][3]);
      const float mean = wave_sum(s) * (1.f / 1024.f);
      float q = 0.f;
#pragma unroll
      for (int i = 0; i < 4; ++i)
#pragma unroll
        for (int e = 0; e < 4; ++e) { const float d = v[i][e] - mean; q += d * d; }
      const float rstd = rsqrtf(wave_sum(q) * (1.f / 1024.f) + EPS);
#pragma unroll
      for (int i = 0; i < 4; ++i) {
        const f32x4 g = *(const f32x4*)(lg + i * 256 + lane * 4), b = *(const f32x4*)(lb + i * 256 + lane * 4);
#pragma unroll
        for (int e = 0; e < 4; ++e) v[i][e] = (v[i][e] - mean) * rstd * g[e] + b[e];
        if (Xdst) *(f32x4*)(Xdst + (size_t)row * 1024 + i * 256 + lane * 4) = v[i];
      }
    }
    if (Hb) {
      const float* m = modsL + cond_idx(row) * 6144;
#pragma unroll
      for (int i = 0; i < 4; ++i) {
        const int col = i * 256 + lane * 4;
        const f32x4 sh = *(const f32x4*)(m + sh_off + col), sc = *(const f32x4*)(m + sc_off + col);
        f32x4 h;
#pragma unroll
        for (int e = 0; e < 4; ++e) h[e] = v[i][e] * (1.f + sc[e]) + sh[e];
        u32x2 w = {pack2(h[0], h[1]), pack2(h[2], h[3])};
        *(u32x2*)(Hb + (size_t)row * 1024 + col) = w;
      }
    }
  }
}

DI void modulate_phase(const float* __restrict__ src_ctx, const float* __restrict__ src_lat, const float* __restrict__ modsL, bf16_t* __restrict__ Hb) {
  const int lane = threadIdx.x & 63, gw = blockIdx.x * NWAVE + (threadIdx.x >> 6), nw = gridDim.x * NWAVE;
  for (int r0 = gw * 2; r0 < NTOK; r0 += nw * 2) {
    f32x4 v[2][4];
#pragma unroll
    for (int k = 0; k < 2; ++k) {
      const int row = r0 + k;
      const float* src = row < NCTX ? src_ctx + (size_t)row * 1024 : src_lat + (size_t)(row - NCTX) * 1024;
#pragma unroll
      for (int i = 0; i < 4; ++i) v[k][i] = __builtin_nontemporal_load((const f32x4*)(src + i * 256 + lane * 4));
    }
#pragma unroll
    for (int k = 0; k < 2; ++k) {
      const int row = r0 + k;
      const float* m = modsL + cond_idx(row) * 6144;
#pragma unroll
      for (int i = 0; i < 4; ++i) {
        const int col = i * 256 + lane * 4;
        const f32x4 sh = *(const f32x4*)(m + col), sc = *(const f32x4*)(m + 1024 + col);
        u32x2 w = {pack2(v[k][i][0] * (1.f + sc[0]) + sh[0], v[k][i][1] * (1.f + sc[1]) + sh[1]), pack2(v[k][i][2] * (1.f + sc[2]) + sh[2], v[k][i][3] * (1.f + sc[3]) + sh[3])};
        *(u32x2*)(Hb + (size_t)row * 1024 + col) = w;
      }
    }
  }
}

DI double sin_red(double r) {
  const double r2 = r * r; double t = -1.0 / 51090942171709440000.0;
  t = t * r2 + 1.0 / 121645100408832000.0; t = t * r2 - 1.0 / 355687428096000.0; t = t * r2 + 1.0 / 1307674368000.0; t = t * r2 - 1.0 / 6227020800.0;
  t = t * r2 + 1.0 / 39916800.0; t = t * r2 - 1.0 / 362880.0; t = t * r2 + 1.0 / 5040.0; t = t * r2 - 1.0 / 120.0; t = t * r2 + 1.0 / 6.0;
  return r * (1.0 - r2 * t);
}
DI double cos_red(double r) {
  const double r2 = r * r; double t = 1.0 / 1124000727777607680000.0;
  t = t * r2 - 1.0 / 2432902008176640000.0; t = t * r2 + 1.0 / 6402373705728000.0; t = t * r2 - 1.0 / 20922789888000.0; t = t * r2 + 1.0 / 87178291200.0;
  t = t * r2 - 1.0 / 479001600.0; t = t * r2 + 1.0 / 3628800.0; t = t * r2 - 1.0 / 40320.0; t = t * r2 + 1.0 / 720.0; t = t * r2 - 1.0 / 24.0; t = t * r2 + 0.5; t = t * r2 * -1.0 + 1.0;
  return t;
}

constexpr int J_MODS = 96, J_WEFF = 64, J_CACHE = 64, J_ROPE = 1, J_SLOW = J_MODS + J_WEFF + J_CACHE + J_ROPE;
constexpr int T_ATTIN = 16 * 16, T_UQ = 4 * 6, T_UKV = 2 * 8, T_ATTOUT = 16 * 8, T_MLPIN = 16 * 32, T_MLPOUT = 64 * 8, T_CONVIN = 16 * 12, T_CONVOUT = 8 * 8;
constexpr int J_TR = T_ATTIN + T_UQ + T_UKV + T_ATTOUT + 2 * T_MLPIN + 2 * T_MLPOUT + T_CONVIN + T_CONVOUT;

struct TJ { const float* src; bf16_t* dst; int N, nvalid, lddst, perm, kt, nt; };
DI TJ tr_decode(const Params& p, int j) {
  char* ws = p.ws;
  TJ t; t.perm = 0;
  if (j < T_ATTIN) { t.src = p.w_att_in; t.N = 1952; t.nvalid = 1952; t.dst = (bf16_t*)(ws + O_WATTIN); t.lddst = 1024; t.kt = j / 16; t.nt = j % 16; return t; }
  j -= T_ATTIN;
  if (j < T_UQ) { t.src = p.w_uq; t.N = 768; t.nvalid = 768; t.dst = (bf16_t*)(ws + O_WUQ); t.lddst = 256; t.kt = j / 6; t.nt = j % 6; return t; }
  j -= T_UQ;
  if (j < T_UKV) { t.src = p.w_ukv; t.N = 1024; t.nvalid = 1024; t.dst = (bf16_t*)(ws + O_WUKV); t.lddst = 128; t.kt = j / 8; t.nt = j % 8; return t; }
  j -= T_UKV;
  if (j < T_ATTOUT) { t.src = p.w_att_out; t.N = 1024; t.nvalid = 1024; t.dst = (bf16_t*)(ws + O_WATTOUT); t.lddst = 1024; t.kt = j / 8; t.nt = j % 8; return t; }
  j -= T_ATTOUT;
  if (j < 2 * T_MLPIN) { const int l = j / T_MLPIN, u = j % T_MLPIN; t.src = p.w_mlp_in + (size_t)l * 1024 * 4096; t.N = 4096; t.nvalid = 4096; t.dst = (bf16_t*)(ws + O_WMLPIN) + (size_t)l * 4096 * 1024; t.lddst = 1024; t.kt = u / 32; t.nt = u % 32; return t; }
  j -= 2 * T_MLPIN;
  if (j < 2 * T_MLPOUT) { const int l = j / T_MLPOUT, u = j % T_MLPOUT; t.src = p.w_mlp_out + (size_t)l * 4096 * 1024; t.N = 1024; t.nvalid = 1024; t.dst = (bf16_t*)(ws + O_WMLPOUT) + (size_t)l * 4096 * 1024; t.lddst = 4096; t.kt = u / 8; t.nt = u % 8; return t; }
  j -= 2 * T_MLPOUT;
  if (j < T_CONVIN) { t.src = p.w_conv_in; t.N = 1536; t.nvalid = 1536; t.dst = (bf16_t*)(ws + O_WCONVIN); t.lddst = 1024; t.perm = 1; t.kt = j / 12; t.nt = j % 12; return t; }
  j -= T_CONVIN;
  t.src = p.w_conv_out; t.N = 1024; t.nvalid = 1024; t.dst = (bf16_t*)(ws + O_WCONVOUT); t.lddst = 1024; t.kt = j / 8; t.nt = j % 8; return t;
}
DI void tr_load(const TJ& t, float (&v)[16]) {
  const int tid = threadIdx.x, n4 = (tid & 31) * 4, kb = tid >> 5;
  const int gn = t.nt * 128 + n4;
  const float* s = t.src + (size_t)(t.kt * 64 + kb) * t.N + gn;
#pragma unroll
  for (int i = 0; i < 4; ++i) {
    f32x4 x = {0.f, 0.f, 0.f, 0.f};
    if (gn < t.nvalid) x = __builtin_nontemporal_load((const f32x4*)(s + (size_t)(16 * i) * t.N));
    v[4 * i] = x[0]; v[4 * i + 1] = x[1]; v[4 * i + 2] = x[2]; v[4 * i + 3] = x[3];
  }
}

DI void phase0(const Params& p, char* smem) {
  const int tid = threadIdx.x, lane = tid & 63, wid = tid >> 6;
  char* ws = p.ws;
  for (int job = blockIdx.x; job < J_SLOW; job += gridDim.x) {
    int j = job;
    if (j < J_MODS) {
      const int l = j / 48, cc = j % 48;
      float* sc = (float*)smem;
      for (int i = tid; i < 3072; i += NT) { const int ci = i >> 10, k = i & 1023; const float x = ci == 0 ? p.c_ctx[k] : p.c[(ci - 1) * 1024 + k]; sc[i] = x / (1.f + __expf(-x)); }
      __syncthreads();
      const int kg = tid >> 5, c4 = (tid & 31) * 4;
      const float* w = p.w_ada + (size_t)l * 1024 * 6144 + cc * 128 + c4;
      f32x4 s0 = {0.f, 0.f, 0.f, 0.f}, s1 = s0, s2 = s0;
#pragma unroll 16
      for (int k = kg * 64; k < kg * 64 + 64; ++k) {
        const f32x4 wv = __builtin_nontemporal_load((const f32x4*)(w + (size_t)k * 6144));
        const float a = sc[k], b = sc[1024 + k], c = sc[2048 + k];
#pragma unroll
        for (int e = 0; e < 4; ++e) { s0[e] += a * wv[e]; s1[e] += b * wv[e]; s2[e] += c * wv[e]; }
      }
      f32x4* r = (f32x4*)(smem + 12288);
      r[(kg * 3 + 0) * 32 + (tid & 31)] = s0; r[(kg * 3 + 1) * 32 + (tid & 31)] = s1; r[(kg * 3 + 2) * 32 + (tid & 31)] = s2;
      __syncthreads();
      if (tid < 96) {
        const int ci = tid >> 5, q = tid & 31;
        f32x4 s = {0.f, 0.f, 0.f, 0.f};
#pragma unroll
        for (int g = 0; g < 16; ++g) { const f32x4 t4 = r[(g * 3 + ci) * 32 + q]; s[0] += t4[0]; s[1] += t4[1]; s[2] += t4[2]; s[3] += t4[3]; }
        const f32x4 bb = *(const f32x4*)(p.b_ada + l * 6144 + cc * 128 + q * 4);
        float* md = (float*)(ws + O_MODS) + (size_t)(l * 3 + ci) * 6144 + cc * 128 + q * 4;
#pragma unroll
        for (int e = 0; e < 4; ++e) __hip_atomic_store(md + e, s[e] + bb[e], __ATOMIC_RELAXED, __HIP_MEMORY_SCOPE_AGENT);
      }
      asm volatile("s_waitcnt vmcnt(0)" ::: "memory");
      __syncthreads();
      if (tid == 0) __hip_atomic_fetch_add((unsigned*)(ws + O_CNT) + 2, 1u, __ATOMIC_RELAXED, __HIP_MEMORY_SCOPE_AGENT);
      continue;
    }
    j -= J_MODS;
    if (j < J_WEFF) {
      const int g = j >> 4, cch = (j >> 1) & 7, nch = j & 1;
      float* wp = (float*)smem;
      for (int i = tid; i < 2048; i += NT) wp[i] = p.w_pool[(size_t)(g * 128 + cch * 16 + (i >> 7)) * 128 + (i & 127)];
      __syncthreads();
      const int n = nch * 512 + tid;
      float a[16];
#pragma unroll
      for (int c = 0; c < 16; ++c) a[c] = 0.f;
#pragma unroll 16
      for (int e = 0; e < 128; ++e) {
        const float wo = p.w_conv_out[(size_t)(512 + g * 128 + e) * 1024 + n] * p.pool_scale[g * 128 + e];
#pragma unroll
        for (int c = 0; c < 16; ++c) a[c] += wp[c * 128 + e] * wo;
      }
      bf16_t* d = (bf16_t*)(ws + O_WCONVOUT) + (size_t)n * 1024 + 512 + g * 128 + cch * 16;
      *(u32x4*)d = (u32x4){pack2(a[0], a[1]), pack2(a[2], a[3]), pack2(a[4], a[5]), pack2(a[6], a[7])};
      *(u32x4*)(d + 8) = (u32x4){pack2(a[8], a[9]), pack2(a[10], a[11]), pack2(a[12], a[13]), pack2(a[14], a[15])};
      __syncthreads();
      continue;
    }
    j -= J_WEFF;
    if (j < J_CACHE) {
      const int rr = j * 8 + wid, b = rr >> 8, t = rr & 255;
      const size_t kr = NCTX + (size_t)b * TKL + t;
      const f32x4 a0 = *(const f32x4*)(p.cache_k + (size_t)rr * 512 + lane * 8), a1 = *(const f32x4*)(p.cache_k + (size_t)rr * 512 + lane * 8 + 4);
      *(u32x4*)((bf16_t*)(ws + O_KD) + kr * 512 + lane * 8) = (u32x4){pack2(a0[0], a0[1]), pack2(a0[2], a0[3]), pack2(a1[0], a1[1]), pack2(a1[2], a1[3])};
      const f32x4 b0 = *(const f32x4*)(p.cache_v + (size_t)rr * 512 + lane * 8), b1 = *(const f32x4*)(p.cache_v + (size_t)rr * 512 + lane * 8 + 4);
      *(u32x4*)((bf16_t*)(ws + O_VD) + kr * 512 + lane * 8) = (u32x4){pack2(b0[0], b0[1]), pack2(b0[2], b0[3]), pack2(b1[0], b1[1]), pack2(b1[2], b1[3])};
      const f32x2 cv = *(const f32x2*)(p.cache_ckv + (size_t)rr * 128 + lane * 2);
      *(unsigned*)((bf16_t*)(ws + O_CKVN) + kr * 128 + lane * 2) = pack2(cv[0], cv[1]);
      const int idx = lane & 31;
      const float x = p.cache_krope[(size_t)rr * 32 + idx];
      const unsigned pk = pack2(x, x);
#pragma unroll
      for (int k = 0; k < 4; ++k) { const int hh = (lane >> 5) + 2 * k; ((bf16_t*)(ws + O_KMLA))[kr * 768 + hh * 96 + 64 + idx] = (bf16_t)(pk & 0xffff); }
      continue;
    }
    j -= J_CACHE;
    {
      float* c16 = (float*)(ws + O_C16); float* s16 = (float*)(ws + O_S16); float* c8 = (float*)(ws + O_C8); float* s8 = (float*)(ws + O_S8);
      for (int i = tid; i < 1024 + 512; i += NT) {
        int pos, f, half;
        if (i < 1024) { pos = i >> 4; f = i & 15; half = 16; } else { const int q = i - 1024; pos = q >> 3; f = q & 7; half = 8; }
        const float inv = (float)exp(-9.210340371976184 * (double)f / (double)half);
        const float angf = (float)pos * inv;
        const double ang = (double)angf;
        const double r = ang - 6.283185307179586 * rint(ang * 0.15915494309189535);
        const float cs = (float)cos_red(r), sn = (float)sin_red(r);
        if (i < 1024) { c16[i] = cs; s16[i] = sn; } else { c8[i - 1024] = cs; s8[i - 1024] = sn; }
      }
      if (wid == 0) {
        const float d1 = wave_sum(p.lam_q1[lane] * p.lam_k1[lane]), d2 = wave_sum(p.lam_q2[lane] * p.lam_k2[lane]);
        if (lane == 0) ((float*)(ws + O_SCAL))[0] = expf(d1) - expf(d2) + 0.2f;
      }
    }
  }
  {
    float* tile = (float*)smem;
    const int G = gridDim.x;
    int j = (blockIdx.x + G - (J_SLOW % G)) % G;
    float va[16], vb[16];
    TJ ta, tb;
    if (j < J_TR) { ta = tr_decode(p, j); tr_load(ta, va); } else ta = TJ{};
    if (j + G < J_TR) { tb = tr_decode(p, j + G); tr_load(tb, vb); } else tb = ta;
#define TR_STEP(V, T, jj_) do { \
      { const int n4 = (tid & 31) * 4, kb = tid >> 5; \
        _Pragma("unroll") for (int i = 0; i < 4; ++i) \
          _Pragma("unroll") for (int e = 0; e < 4; ++e) tile[(kb + 16 * i) * 129 + n4 + e] = V[4 * i + e]; } \
      __syncthreads(); \
      const TJ cur = T; \
      if ((jj_) + 2 * G < J_TR) { T = tr_decode(p, (jj_) + 2 * G); tr_load(T, V); }     \
      _Pragma("unroll") for (int ps = 0; ps < 2; ++ps) {     \
        const int n = ps * 64 + (tid >> 3), ks = (tid & 7) * 8; \
        int gn = cur.nt * 128 + n; \
        if (cur.perm) { if (gn < 512) gn = 32 * (gn >> 4) + (gn & 15); else if (gn < 1024) { const int c = gn - 512; gn = 32 * (c >> 4) + 16 + (c & 15); } } \
        unsigned w[4]; \
        _Pragma("unroll") for (int e = 0; e < 4; ++e) w[e] = pack2(tile[(ks + 2 * e) * 129 + n], tile[(ks + 2 * e + 1) * 129 + n]); \
        *(u32x4*)(cur.dst + (size_t)gn * cur.lddst + cur.kt * 64 + ks) = (u32x4){w[0], w[1], w[2], w[3]}; } \
      __syncthreads(); } while (0)
    while (j < J_TR) {
      TR_STEP(va, ta, j);
      j += G;
      if (j >= J_TR) break;
      TR_STEP(vb, tb, j);
      j += G;
    }
#undef TR_STEP
  }
  if (tid == 0) {
    unsigned sp = 0;
    while (__hip_atomic_load((unsigned*)(ws + O_CNT) + 2, __ATOMIC_RELAXED, __HIP_MEMORY_SCOPE_AGENT) < (unsigned)J_MODS) { __builtin_amdgcn_s_sleep(2); if (++sp > (1u << 22)) break; }
  }
  __syncthreads();
  modulate_phase(p.x_prompt, p.x_sample, (const float*)(ws + O_MODS), (bf16_t*)(ws + O_HB));
}

DI void rope8(const float (&x)[8], float (&o)[8], int lane, const float* c16, const float* s16, int prow, int pcol) {
  const int L = lane & 7;
  const int pos = (L & 4) ? pcol : prow;
  const bool second = (L & 2) != 0;
  const int fb = (L & 1) * 8;
#pragma unroll
  for (int e = 0; e < 8; ++e) {
    const float y = __shfl_xor(x[e], 2);
    const float cs = c16[pos * 16 + fb + e], sn = s16[pos * 16 + fb + e];
    o[e] = second ? (y * sn + x[e] * cs) : (x[e] * cs - y * sn);
  }
}
DI void unpack8(const u32x4 w, float (&x)[8]) {
#pragma unroll
  for (int e = 0; e < 4; ++e) { x[2 * e] = bflo(w[e]); x[2 * e + 1] = bfhi(w[e]); }
}
DI u32x4 pack8(const float (&x)[8]) { return (u32x4){pack2(x[0], x[1]), pack2(x[2], x[3]), pack2(x[4], x[5]), pack2(x[6], x[7])}; }

DI void phase3(const Params& p) {
  char* ws = p.ws;
  const bf16_t* R = (const bf16_t*)(ws + O_R);
  bf16_t* Qda = (bf16_t*)(ws + O_QDA); bf16_t* Qdb = (bf16_t*)(ws + O_QDB); bf16_t* Kd = (bf16_t*)(ws + O_KD); bf16_t* Vd = (bf16_t*)(ws + O_VD);
  bf16_t* cqn = (bf16_t*)(ws + O_CQN); bf16_t* ckvn = (bf16_t*)(ws + O_CKVN); bf16_t* Km = (bf16_t*)(ws + O_KMLA);
  const float* c16 = (const float*)(ws + O_C16); const float* s16 = (const float*)(ws + O_S16); const float* c8 = (const float*)(ws + O_C8); const float* s8 = (const float*)(ws + O_S8);
  float* o_k = p.out + (size_t)NTOK * 1024; float* o_v = o_k + (size_t)NCTX * 512; float* o_ckv = o_v + (size_t)NCTX * 512; float* o_kr = o_ckv + (size_t)NCTX * 128;
  const int lane = threadIdx.x & 63, gw = blockIdx.x * NWAVE + (threadIdx.x >> 6), nw = gridDim.x * NWAVE;
  for (int row = gw; row < NTOK; row += nw) {
    const bool lat = row >= NCTX;
    const int rl = row - NCTX, b = rl >> 12, t = rl & (TLAT - 1), prow = t >> 6, pcol = t & 63;
    const size_t kr = lat ? (size_t)NCTX + (size_t)b * TKL + 256 + t : (size_t)row;
    const bf16_t* r = R + (size_t)row * RLD;
    float x[8], o[8];
    const u32x4 wq = *(const u32x4*)(r + lane * 8);
    *(u32x4*)(Qda + (size_t)row * 512 + lane * 8) = wq;
    if (lat) { unpack8(wq, x); rope8(x, o, lane, c16, s16, prow, pcol); *(u32x4*)(Qdb + (size_t)rl * 512 + lane * 8) = pack8(o); }
    const u32x4 wk = *(const u32x4*)(r + 512 + lane * 8);
    if (lat) { unpack8(wk, x); rope8(x, o, lane, c16, s16, prow, pcol); *(u32x4*)(Kd + kr * 512 + lane * 8) = pack8(o); }
    else {
      unpack8(wk, x);
      *(f32x4*)(o_k + (size_t)row * 512 + lane * 8) = (f32x4){x[0], x[1], x[2], x[3]};
      *(f32x4*)(o_k + (size_t)row * 512 + lane * 8 + 4) = (f32x4){x[4], x[5], x[6], x[7]};
      *(u32x4*)(Kd + kr * 512 + lane * 8) = wk;
    }
    const u32x4 wv = *(const u32x4*)(r + 1024 + lane * 8);
    *(u32x4*)(Vd + kr * 512 + lane * 8) = wv;
    if (!lat) {
      unpack8(wv, x);
      *(f32x4*)(o_v + (size_t)row * 512 + lane * 8) = (f32x4){x[0], x[1], x[2], x[3]};
      *(f32x4*)(o_v + (size_t)row * 512 + lane * 8 + 4) = (f32x4){x[4], x[5], x[6], x[7]};
    }
    {
      const u32x2 w = *(const u32x2*)(r + 1536 + lane * 4);
      const float a0 = bflo(w[0]), a1 = bfhi(w[0]), a2 = bflo(w[1]), a3 = bfhi(w[1]);
      const float ss = wave_sum(a0 * a0 + a1 * a1 + a2 * a2 + a3 * a3);
      const float sc = rsqrtf(ss * (1.f / 256.f) + EPS);
      const f32x4 g = *(const f32x4*)(p.q_norm_g + lane * 4);
      *(u32x2*)(cqn + (size_t)row * 256 + lane * 4) = (u32x2){pack2(a0 * sc * g[0], a1 * sc * g[1]), pack2(a2 * sc * g[2], a3 * sc * g[3])};
    }
    {
      const unsigned w = *(const unsigned*)(r + 1792 + lane * 2);
      const float a0 = bflo(w), a1 = bfhi(w);
      const float ss = wave_sum(a0 * a0 + a1 * a1);
      const float sc = rsqrtf(ss * (1.f / 128.f) + EPS);
      const f32x2 g = *(const f32x2*)(p.kv_norm_g + lane * 2);
      const float y0 = a0 * sc * g[0], y1 = a1 * sc * g[1];
      if (!lat) *(f32x2*)(o_ckv + (size_t)row * 128 + lane * 2) = (f32x2){y0, y1};
      *(unsigned*)(ckvn + kr * 128 + lane * 2) = pack2(y0, y1);
    }
    {
      const int idx = lane & 31;
      const float xv = bf2f(r[1920 + idx]);
      float ov = xv;
      if (lat) {
        const int pos = (idx & 16) ? pcol : prow;
        const int f = idx & 7;
        const float y = __shfl_xor(xv, 8);
        const float cs = c8[pos * 8 + f], sn = s8[pos * 8 + f];
        ov = (idx & 8) ? (y * sn + xv * cs) : (xv * cs - y * sn);
      } else if (lane < 32) o_kr[(size_t)row * 32 + idx] = xv;
      const bf16_t ob = (bf16_t)(pack2(ov, ov) & 0xffff);
#pragma unroll
      for (int k = 0; k < 4; ++k) { const int hh = (lane >> 5) + 2 * k; Km[kr * 768 + hh * 96 + 64 + idx] = ob; }
    }
  }
}

template <int DQK, int DV>
DI void attn_core(const bf16_t* __restrict__ Qa, const bf16_t* __restrict__ Qb, int ldq, const bf16_t* __restrict__ Kp, int ldk, const bf16_t* __restrict__ Vp, int ldv,
                  int Tk, int n_a, float c  , char* smem, f32x16 (&o)[DV / 32]) {
  constexpr int KS = DQK * 2 + 16, VS = DV * 2 + 64, BUF = 64 * (KS + VS);
  constexpr int KCH = DQK / 8, VCH = DV / 8, NKCH = 64 * KCH, NVCH = 64 * VCH, NKC = (NKCH + NT - 1) / NT, NVC = (NVCH + NT - 1) / NT;
  constexpr bool KG = (NKCH % NT) != 0, VG = (NVCH % NT) != 0;
  constexpr int NS = DQK / 16, NDT = DV / 32;
  const int tid = threadIdx.x, lane = tid & 63, wid = tid >> 6, h = lane >> 5, ql = lane & 31;
  bf16x8 qf[NS];
  {
    const bf16_t* q = Qa + (size_t)(wid * 32 + ql) * ldq + h * 8;
#pragma unroll
    for (int s = 0; s < NS; ++s) qf[s] = *(const bf16x8*)(q + s * 16);
  }
#pragma unroll
  for (int dt = 0; dt < NDT; ++dt)
#pragma unroll
    for (int r = 0; r < 16; ++r) o[dt][r] = 0.f;
  float m_run = -INFINITY, l_run = 0.f;
  u32x4 rkA[NKC], rvA[NVC], rkB[NKC], rvB[NVC];
  const int nt = Tk >> 6, ta = n_a >> 6;
  unsigned koff[NKC], voff[NVC];
#pragma unroll
  for (int i = 0; i < NKC; ++i) { const int ch = (tid + NT * i) % NKCH, row = ch / KCH, kc = ch % KCH; koff[i] = (unsigned)(row * ldk + kc * 8); }
#pragma unroll
  for (int i = 0; i < NVC; ++i) { const int ch = (tid + NT * i) % NVCH, row = ch / VCH, vc = ch % VCH; voff[i] = (unsigned)(row * ldv + vc * 8); }
  auto gload = [&](u32x4 (&rk)[NKC], u32x4 (&rv)[NVC], int t) {
    const bf16_t* kb = Kp + (size_t)t * 64 * ldk;
    const bf16_t* vbp = Vp + (size_t)t * 64 * ldv;
#pragma unroll
    for (int i = 0; i < NKC; ++i) rk[i] = *(const u32x4*)(kb + koff[i]);
#pragma unroll
    for (int i = 0; i < NVC; ++i) rv[i] = *(const u32x4*)(vbp + voff[i]);
  };
  auto lstore = [&](u32x4 (&rk)[NKC], u32x4 (&rv)[NVC], char* buf) {
#pragma unroll
    for (int i = 0; i < NKC; ++i) { const int ch = tid + NT * i, row = ch / KCH, kc = ch % KCH; if (!KG || i + 1 < NKC || ch < NKCH) *(u32x4*)(buf + row * KS + kc * 16) = rk[i]; }
#pragma unroll
    for (int i = 0; i < NVC; ++i) { const int ch = tid + NT * i, row = ch / VCH, vc = ch % VCH; if (!VG || i + 1 < NVC || ch < NVCH) *(u32x4*)(buf + 64 * KS + row * VS + vc * 16) = rv[i]; }
  };
  gload(rkA, rvA, 0); lstore(rkA, rvA, smem); lds_barrier();
  gload(rkA, rvA, min(1, nt - 1));
  const int i16 = lane & 15, tq = i16 >> 2, tp = i16 & 3, G = (lane >> 4) & 1;
  auto compute = [&](const char* cur) {
    f32x16 st[2];
    bf16x8 kf[2][NS];
#pragma unroll
    for (int kt = 0; kt < 2; ++kt)
#pragma unroll
      for (int s = 0; s < NS; ++s) kf[kt][s] = *(const bf16x8*)(cur + (kt * 32 + ql) * KS + s * 32 + h * 16);
#pragma unroll
    for (int kt = 0; kt < 2; ++kt) {
#pragma unroll
      for (int r = 0; r < 16; ++r) st[kt][r] = 0.f;
#pragma unroll
      for (int s = 0; s < NS; ++s) st[kt] = __builtin_amdgcn_mfma_f32_32x32x16_bf16(kf[kt][s], qf[s], st[kt], 0, 0, 0);
    }
    __builtin_amdgcn_sched_barrier(0);
    float mx = st[0][0];
#pragma unroll
    for (int kt = 0; kt < 2; ++kt)
#pragma unroll
      for (int r = 0; r < 16; ++r) mx = fmaxf(mx, st[kt][r]);
    {
      typedef unsigned u32x2v __attribute__((ext_vector_type(2)));
      const u32x2v sw = __builtin_amdgcn_permlane32_swap(__float_as_uint(mx), __float_as_uint(mx), false, false);
      mx = fmaxf(__uint_as_float(sw[0]), __uint_as_float(sw[1]));
    }
    const float m_new = fmaxf(m_run, mx);
    const float alpha = __builtin_amdgcn_exp2f((m_run - m_new) * c);
    const float mc = m_new * c;
    m_run = m_new;
    f32x2 ls2 = {0.f, 0.f};
#pragma unroll
    for (int kt = 0; kt < 2; ++kt) {
      const f32x16 tv = st[kt] * c - mc;
#pragma unroll
      for (int r = 0; r < 16; r += 2) {
        const f32x2 pv = {__builtin_amdgcn_exp2f(tv[r]), __builtin_amdgcn_exp2f(tv[r + 1])};
        st[kt][r] = pv[0]; st[kt][r + 1] = pv[1];
        ls2 += pv;
      }
    }
    l_run = l_run * alpha + (ls2[0] + ls2[1]);
    if (__any(alpha != 1.f)) {
#pragma unroll
      for (int dt = 0; dt < NDT; ++dt)
#pragma unroll
        for (int r = 0; r < 16; ++r) o[dt][r] *= alpha;
    }
    bf16x8 pf[2][2];
#pragma unroll
    for (int kt = 0; kt < 2; ++kt)
#pragma unroll
      for (int s2 = 0; s2 < 2; ++s2) {
        u32x4 w = {pack2(st[kt][8 * s2 + 0], st[kt][8 * s2 + 1]), pack2(st[kt][8 * s2 + 2], st[kt][8 * s2 + 3]), pack2(st[kt][8 * s2 + 4], st[kt][8 * s2 + 5]), pack2(st[kt][8 * s2 + 6], st[kt][8 * s2 + 7])};
        pf[kt][s2] = __builtin_bit_cast(bf16x8, w);
      }
    const char* vb = cur + 64 * KS + (4 * h + tq) * VS + 32 * G + 8 * tp;
    bf16x8 vfa[NDT], vfb[NDT];
#define A_VLOAD(VF, g_) do { \
      _Pragma("unroll") for (int dt = 0; dt < NDT; ++dt) { \
        const char* a0 = vb + (((g_) >> 1) * 32 + 16 * ((g_) & 1)) * VS + dt * 64; \
        const s16x4 lo = __builtin_amdgcn_ds_read_tr16_b64_v4i16((LDS_AS s16x4*)(a0)); \
        const s16x4 hi = __builtin_amdgcn_ds_read_tr16_b64_v4i16((LDS_AS s16x4*)(a0 + 8 * VS)); \
        VF[dt] = __builtin_shufflevector(lo, hi, 0, 1, 2, 3, 4, 5, 6, 7); } } while (0)
#define A_VMMA(VF, g_) do { \
      _Pragma("unroll") for (int dt = 0; dt < NDT; ++dt) o[dt] = __builtin_amdgcn_mfma_f32_32x32x16_bf16(VF[dt], pf[(g_) >> 1][(g_) & 1], o[dt], 0, 0, 0); } while (0)
    A_VLOAD(vfa, 0);
    A_VLOAD(vfb, 1);
    __builtin_amdgcn_sched_barrier(0);
    A_VMMA(vfa, 0);
    __builtin_amdgcn_sched_barrier(0);
    A_VLOAD(vfa, 2);
    __builtin_amdgcn_sched_barrier(0);
    A_VMMA(vfb, 1);
    __builtin_amdgcn_sched_barrier(0);
    A_VLOAD(vfb, 3);
    __builtin_amdgcn_sched_barrier(0);
    A_VMMA(vfa, 2);
    __builtin_amdgcn_sched_barrier(0);
    A_VMMA(vfb, 3);
#undef A_VLOAD
#undef A_VMMA
  };
  auto run_tiles = [&](int t_begin, int t_end) {
    for (int t = t_begin; t < t_end; t += 2) {
      gload(rkB, rvB, min(t + 2, nt - 1));
      compute(smem);
      lstore(rkA, rvA, smem + BUF);
      lds_barrier();
      gload(rkA, rvA, min(t + 3, nt - 1));
      compute(smem + BUF);
      lstore(rkB, rvB, smem);
      lds_barrier();
    }
  };
  if (wid >= 4) __builtin_amdgcn_s_setprio(1);
  run_tiles(0, min(ta, nt));
  if (ta < nt) {
    const bf16_t* q = Qb + (size_t)(wid * 32 + ql) * ldq + h * 8;
#pragma unroll
    for (int s = 0; s < NS; ++s) qf[s] = *(const bf16x8*)(q + s * 16);
    run_tiles(ta, nt);
  }
  __builtin_amdgcn_s_setprio(0);
  const float l = l_run + __shfl_xor(l_run, 32);
  const float inv = 1.f / l;
#pragma unroll
  for (int dt = 0; dt < NDT; ++dt)
#pragma unroll
    for (int r = 0; r < 16; ++r) o[dt][r] *= inv;
}

DI u32x4 pair_swap16(const u32x2 xa, const u32x2 xb) {
  typedef unsigned u32x2v __attribute__((ext_vector_type(2)));
  const u32x2v s0 = __builtin_amdgcn_permlane32_swap(xa[0], xb[0], false, false);
  const u32x2v s1 = __builtin_amdgcn_permlane32_swap(xa[1], xb[1], false, false);
  return (u32x4){s0[0], s1[0], s0[1], s1[1]};
}
constexpr int U_DBIG = 128, U_MBIG = 256, U_DCTX = 64, U_MCTX = 128, U_TOTAL = U_DBIG + U_MBIG + U_DCTX + U_MCTX;

DI void phase_attn(const Params& p, char* smem, int cidx) {
  char* ws = p.ws;
  const bf16_t* Qda = (const bf16_t*)(ws + O_QDA); const bf16_t* Qdb = (const bf16_t*)(ws + O_QDB); const bf16_t* Kd = (const bf16_t*)(ws + O_KD); const bf16_t* Vd = (const bf16_t*)(ws + O_VD);
  const bf16_t* Qma = (const bf16_t*)(ws + O_QMA); const bf16_t* Qmb = (const bf16_t*)(ws + O_QMB); const bf16_t* Km = (const bf16_t*)(ws + O_KMLA); const bf16_t* Vm = (const bf16_t*)(ws + O_VMLA);
  bf16_t* cat = (bf16_t*)(ws + O_HB);
  float* otmp = (float*)(ws + O_OTMP) + (size_t)blockIdx.x * 32768;
  int* counter = (int*)(ws + O_CNT) + cidx;
  int* s_unit = (int*)(smem + 65532);
  const int tid = threadIdx.x, lane = tid & 63, wid = tid >> 6, h2 = lane >> 5, ql = lane & 31;
  const float lam = ((const float*)(ws + O_SCAL))[0];
  for (;;) {
    if (tid == 0) *s_unit = atomicAdd(counter, 1);
    __syncthreads();
    int u = __builtin_amdgcn_readfirstlane(*s_unit);
    __syncthreads();
    if (u >= U_TOTAL) break;
    bool diff; int qrow0, krow0, Tk, n_a, head; bool lat;
    if (u < U_DBIG) { diff = true; lat = true; const int b = u >> 6, hh = (u >> 4) & 3, qb = u & 15; head = hh; qrow0 = NCTX + b * TLAT + qb * 256; krow0 = NCTX + b * TKL; Tk = TKL; n_a = 256; }
    else if (u < U_DBIG + U_MBIG) { u -= U_DBIG; diff = false; lat = true; const int b = u >> 7, hh = (u >> 4) & 7, qb = u & 15; head = hh; qrow0 = NCTX + b * TLAT + qb * 256; krow0 = NCTX + b * TKL; Tk = TKL; n_a = 256; }
    else if (u < U_DBIG + U_MBIG + U_DCTX) { u -= U_DBIG + U_MBIG; diff = true; lat = false; const int sq = u >> 2, hh = u & 3; head = hh; qrow0 = sq * 256; krow0 = sq * 256; Tk = 256; n_a = 256; }
    else { u -= U_DBIG + U_MBIG + U_DCTX; diff = false; lat = false; const int sq = u >> 3, hh = u & 7; head = hh; qrow0 = sq * 256; krow0 = sq * 256; Tk = 256; n_a = 256; }
    const int qrowb = lat ? qrow0 - NCTX : 0;
    if (diff) {
      f32x16 o[4];
      const float c = 0.125f * 1.4426950408889634f;
#pragma unroll 1
      for (int m = 0; m < 2; ++m) {
        attn_core<64, 128>(Qda + (size_t)qrow0 * 512 + head * 128 + m * 64, Qdb + (size_t)qrowb * 512 + head * 128 + m * 64, 512,
                           Kd + (size_t)krow0 * 512 + head * 128 + m * 64, 512, Vd + (size_t)krow0 * 512 + head * 128, 512, Tk, n_a, c, smem, o);
        if (m == 0) {
#pragma unroll
          for (int dt = 0; dt < 4; ++dt)
#pragma unroll
            for (int rq = 0; rq < 4; ++rq) *(f32x4*)(otmp + tid * 64 + dt * 16 + rq * 4) = (f32x4){o[dt][4 * rq], o[dt][4 * rq + 1], o[dt][4 * rq + 2], o[dt][4 * rq + 3]};
        }
      }
      float ss = 0.f;
#pragma unroll
      for (int dt = 0; dt < 4; ++dt)
#pragma unroll
        for (int rq = 0; rq < 4; ++rq) {
          const f32x4 o0 = *(const f32x4*)(otmp + tid * 64 + dt * 16 + rq * 4);
#pragma unroll
          for (int e = 0; e < 4; ++e) { const float v = o0[e] - lam * o[dt][4 * rq + e]; o[dt][4 * rq + e] = v; ss += v * v; }
        }
      ss += __shfl_xor(ss, 32);
      const float sc = rsqrtf(ss * (1.f / 128.f) + EPS) * 0.8f;
      bf16_t* dst = cat + (size_t)(qrow0 + wid * 32 + ql) * 1024 + head * 128;
#pragma unroll
      for (int dt = 0; dt < 4; ++dt)
#pragma unroll
        for (int k = 0; k < 2; ++k) {
          u32x2 w[2];
#pragma unroll
          for (int q = 0; q < 2; ++q) {
            const int rq = 2 * k + q, dv = dt * 32 + 8 * rq + 4 * h2;
            const f32x4 g = *(const f32x4*)(p.diff_norm_g + dv);
            w[q] = (u32x2){pack2(o[dt][4 * rq] * sc * g[0], o[dt][4 * rq + 1] * sc * g[1]), pack2(o[dt][4 * rq + 2] * sc * g[2], o[dt][4 * rq + 3] * sc * g[3])};
          }
          *(u32x4*)(dst + dt * 32 + 16 * k + 8 * h2) = pair_swap16(w[0], w[1]);
        }
    } else {
      f32x16 o[2];
      const float c = 0.10206207261596575f * 1.4426950408889634f;
      attn_core<96, 64>(Qma + (size_t)qrow0 * 768 + head * 96, Qmb + (size_t)qrowb * 768 + head * 96, 768,
                        Km + (size_t)krow0 * 768 + head * 96, 768, Vm + (size_t)krow0 * 512 + head * 64, 512, Tk, n_a, c, smem, o);
      bf16_t* dst = cat + (size_t)(qrow0 + wid * 32 + ql) * 1024 + 512 + head * 64;
#pragma unroll
      for (int dt = 0; dt < 2; ++dt)
#pragma unroll
        for (int k = 0; k < 2; ++k) {
          const u32x2 wa = {pack2(o[dt][8 * k], o[dt][8 * k + 1]), pack2(o[dt][8 * k + 2], o[dt][8 * k + 3])};
          const u32x2 wb = {pack2(o[dt][8 * k + 4], o[dt][8 * k + 5]), pack2(o[dt][8 * k + 6], o[dt][8 * k + 7])};
          *(u32x4*)(dst + dt * 32 + 16 * k + 8 * h2) = pair_swap16(wa, wb);
        }
    }
  }
}

DI void unpack8f(const u32x4 w, float (&x)[8]) {
#pragma unroll
  for (int e = 0; e < 4; ++e) { x[2 * e] = bflo(w[e]); x[2 * e + 1] = bfhi(w[e]); }
}
template <int TT>
DI void pool_unit_w(const bf16_t* __restrict__ Pz, bf16_t* __restrict__ cat, int t0, int lane) {
  const int c0 = lane * 8;
  const int s0 = t0 < NCTX ? (t0 & ~255) : NCTX + ((t0 - NCTX) & ~(TLAT - 1));
  const int s1 = t0 < NCTX ? s0 + 256 : s0 + TLAT;
  const int grp = lane >> 4, HW = 1 << grp;
    {
      u32x4 pr[TT + 16];
#pragma unroll
      for (int i = 0; i < TT + 16; ++i) {
        const int r = t0 - 8 + i;
        pr[i] = (u32x4){0u, 0u, 0u, 0u};
        if (r >= s0 && r < s1) pr[i] = *(const u32x4*)(Pz + (size_t)r * 512 + c0);
      }
#pragma unroll
      for (int o = 0; o < TT; ++o) {
        const int r = t0 + o, ci = o + 8;
        float s[8], x[8], ctr[8], s2[8], s4[8], s8[8];
        unpack8f(pr[ci], ctr);
        unpack8f(pr[ci - 1], x);
#pragma unroll
        for (int e = 0; e < 8; ++e) { s[e] = x[e] + ctr[e]; s2[e] = s[e]; }
#pragma unroll
        for (int d = 0; d < 2; ++d) { unpack8f(pr[d == 0 ? ci - 2 : ci + 1], x);
#pragma unroll
          for (int e = 0; e < 8; ++e) s[e] += x[e]; }
#pragma unroll
        for (int e = 0; e < 8; ++e) s4[e] = s[e];
#pragma unroll
        for (int d = 0; d < 4; ++d) { unpack8f(pr[d < 2 ? ci - 4 + d : ci + d], x);
#pragma unroll
          for (int e = 0; e < 8; ++e) s[e] += x[e]; }
#pragma unroll
        for (int e = 0; e < 8; ++e) s8[e] = s[e];
#pragma unroll
        for (int d = 0; d < 8; ++d) { unpack8f(pr[d < 4 ? ci - 8 + d : ci + d], x);
#pragma unroll
          for (int e = 0; e < 8; ++e) s[e] += x[e]; }
        const int lo = max(r - HW, s0), hi = min(r + HW - 1, s1 - 1);
        const float ic = 1.f / (float)(hi - lo + 1);
        float dv[8];
#pragma unroll
        for (int e = 0; e < 8; ++e) { const float sm = grp == 0 ? s2[e] : grp == 1 ? s4[e] : grp == 2 ? s8[e] : s[e]; dv[e] = sm * ic - ctr[e]; }
        *(u32x4*)(cat + (size_t)r * 1024 + 512 + c0) = (u32x4){pack2(dv[0], dv[1]), pack2(dv[2], dv[3]), pack2(dv[4], dv[5]), pack2(dv[6], dv[7])};
      }
    }
}

template <int TT>
DI void conv_unit(const Params& p, const bf16_t* __restrict__ Ug, bf16_t* __restrict__ cat, const float* wl, int t0, int lane) {
  const int c0 = lane * 8;
  const int s0 = t0 < NCTX ? (t0 & ~255) : NCTX + ((t0 - NCTX) & ~(TLAT - 1));
  const int s1 = t0 < NCTX ? s0 + 256 : s0 + TLAT;
    f32x2 acc2[TT][4];
#pragma unroll
    for (int o = 0; o < TT; ++o)
#pragma unroll
      for (int e = 0; e < 4; ++e) acc2[o][e] = (f32x2){0.f, 0.f};
    u32x4 q0, q1, q2, q3;
#define CV_ROW(i_) ({ const int r_ = t0 - 15 + (i_); u32x4 v_ = {0u, 0u, 0u, 0u}; if ((i_) < TT + 30 && r_ >= s0 && r_ < s1) v_ = *(const u32x4*)(Ug + (size_t)r_ * 512 + c0); v_; })
    q0 = CV_ROW(0); q1 = CV_ROW(1); q2 = CV_ROW(2); q3 = CV_ROW(3);
#pragma unroll 2
    for (int i = 0; i < TT + 30; ++i) {
      const u32x4 w = q0;
      q0 = q1; q1 = q2; q2 = q3; q3 = CV_ROW(i + 4);
      f32x2 x2[4];
#pragma unroll
      for (int e = 0; e < 4; ++e) x2[e] = (f32x2){bflo(w[e]), bfhi(w[e])};
#pragma unroll
      for (int o = 0; o < TT; ++o) {
        const int j = i - o;
        if ((unsigned)j <= 30u) {
          const f32x4 w0 = *(const f32x4*)(wl + ((j * 2 + 0) * 64 + lane) * 4), w1 = *(const f32x4*)(wl + ((j * 2 + 1) * 64 + lane) * 4);
          acc2[o][0] += x2[0] * (f32x2){w0[0], w0[1]}; acc2[o][1] += x2[1] * (f32x2){w0[2], w0[3]};
          acc2[o][2] += x2[2] * (f32x2){w1[0], w1[1]}; acc2[o][3] += x2[3] * (f32x2){w1[2], w1[3]};
        }
      }
    }
#undef CV_ROW
    const f32x4 bias0 = *(const f32x4*)(p.conv_b + c0), bias1 = *(const f32x4*)(p.conv_b + c0 + 4);
    const f32x4 g0 = *(const f32x4*)(p.conv_norm_g + c0), g1 = *(const f32x4*)(p.conv_norm_g + c0 + 4);
    const f32x4 b0 = *(const f32x4*)(p.conv_norm_b + c0), b1 = *(const f32x4*)(p.conv_norm_b + c0 + 4);
#pragma unroll
    for (int o = 0; o < TT; ++o)
#pragma unroll
      for (int e = 0; e < 4; ++e) { acc2[o][e >> 1][e & 1] += bias0[e]; acc2[o][2 + (e >> 1)][e & 1] += bias1[e]; }
    float mean[TT], rstd[TT];
#pragma unroll
    for (int o = 0; o < TT; ++o) { const f32x2 s2 = (acc2[o][0] + acc2[o][1]) + (acc2[o][2] + acc2[o][3]); mean[o] = s2[0] + s2[1]; }
#pragma unroll
    for (int st = 32; st >= 1; st >>= 1)
#pragma unroll
      for (int o = 0; o < TT; ++o) mean[o] += __shfl_xor(mean[o], st);
#pragma unroll
    for (int o = 0; o < TT; ++o) {
      mean[o] *= (1.f / 512.f);
      float q = 0.f;
#pragma unroll
      for (int e = 0; e < 4; ++e) { const f32x2 d = acc2[o][e] - mean[o]; q += d[0] * d[0] + d[1] * d[1]; }
      rstd[o] = q;
    }
#pragma unroll
    for (int st = 32; st >= 1; st >>= 1)
#pragma unroll
      for (int o = 0; o < TT; ++o) rstd[o] += __shfl_xor(rstd[o], st);
#pragma unroll
    for (int o = 0; o < TT; ++o) {
      const float rs = rsqrtf(rstd[o] * (1.f / 512.f) + EPS);
      float y[8];
#pragma unroll
      for (int e = 0; e < 4; ++e) {
        const float z0 = (acc2[o][e >> 1][e & 1] - mean[o]) * rs * g0[e] + b0[e], z1 = (acc2[o][2 + (e >> 1)][e & 1] - mean[o]) * rs * g1[e] + b1[e];
        y[e] = z0 / (1.f + __expf(-z0)); y[4 + e] = z1 / (1.f + __expf(-z1));
      }
      *(u32x4*)(cat + (size_t)(t0 + o) * 1024 + c0) = (u32x4){pack2(y[0], y[1]), pack2(y[2], y[3]), pack2(y[4], y[5]), pack2(y[6], y[7])};
    }
}

DI void phase_conv(const Params& p, char* smem) {
  char* ws = p.ws;
  const bf16_t* Ug = (const bf16_t*)(ws + O_UG); const bf16_t* Pz = (const bf16_t*)(ws + O_PZ);
  bf16_t* cat = (bf16_t*)(ws + O_HB);
  const int tid = threadIdx.x, lane = tid & 63, wid = tid >> 6;
  float* wl = (float*)smem;
  {
    f32x4 wv[8];
#pragma unroll
    for (int k = 0; k < 8; ++k) { const int i4 = tid + NT * k; wv[k] = (f32x4){0.f, 0.f, 0.f, 0.f}; if (i4 < 31 * 128) wv[k] = *(const f32x4*)(p.conv_w + i4 * 4); }
#pragma unroll
    for (int k = 0; k < 8; ++k) {
      const int i4 = tid + NT * k, j = i4 >> 7, c = (i4 & 127) * 4, lc = c >> 3, hf = (c >> 2) & 1;
      if (i4 < 31 * 128) *(f32x4*)(wl + ((j * 2 + hf) * 64 + lc) * 4) = wv[k];
    }
  }
  for (int g = blockIdx.x; g < NTOK / 48; g += gridDim.x) {
    if (wid < 4) pool_unit_w<8>(Pz, cat, g * 48 + wid * 8, lane);
    else pool_unit_w<4>(Pz, cat, g * 48 + 32 + (wid - 4) * 4, lane);
  }
  __syncthreads();
  for (int g = blockIdx.x; g < NTOK / 48; g += gridDim.x) {
    if (wid < 4) conv_unit<8>(p, Ug, cat, wl, g * 48 + wid * 8, lane);
    else conv_unit<4>(p, Ug, cat, wl, g * 48 + 32 + (wid - 4) * 4, lane);
  }
  __syncthreads();
}

__global__ void __launch_bounds__(NT, 2) fwd_kernel(Params p, int ph_lo, int ph_hi) {
  __shared__ __attribute__((aligned(16))) char smem[2 * G_STAGE + 12288];
  __shared__ uint4 xb_words;
  cg::grid_group grid = cg::this_grid();
  char* ws = p.ws;
  if (threadIdx.x == 0) xb_words = make_uint4(0u, 0u, 0u, 0u);
  __syncthreads();
  const XcdBarrier xb = xcd_barrier_post((unsigned*)(ws + O_BAR), (volatile LDS_AS unsigned*)&xb_words);
  if (ph_lo > 1000) grid.sync();
  float* mods = (float*)(ws + O_MODS);
  bf16_t* Hb = (bf16_t*)(ws + O_HB);
  float* X = p.out;
  float* xbuf = (float*)(ws + O_XBUF);
  unsigned* lncnt = (unsigned*)(ws + O_LNCNT);
  const bool fused = (gridDim.x == 256);
#define GSYNC() xcd_barrier(xb)
#define PH_BEGIN(n) if (ph_lo <= n && n < ph_hi) { if (n > ph_lo) GSYNC();
#define PH_BEGIN_IF(n, c) if (ph_lo <= n && n < ph_hi && (c)) { if (n > ph_lo) GSYNC();
#define PH_END }
#ifndef PROBE_DUP
#define PROBE_DUP 0
#endif
#ifndef PROBE_SYNCS
#define PROBE_SYNCS 0
#endif
#define DUP(n, ...) __VA_ARGS__; if ((PROBE_DUP >> n) & 1) { GSYNC(); __VA_ARGS__; }
  for (int i = 0; i < PROBE_SYNCS; ++i) GSYNC();
  PH_BEGIN(0) { DUP(0, phase0(p, smem)); } PH_END
  PH_BEGIN(2) {
    float* o_k = p.out + (size_t)NTOK * 1024; float* o_v = o_k + (size_t)NCTX * 512; float* o_ckv = o_v + (size_t)NCTX * 512; float* o_kr = o_ckv + (size_t)NCTX * 128;
    DUP(2, gemm_phase(Hb, 1024, (const bf16_t*)(ws + O_WATTIN), 1024, 1024, 64, 8,
                      EpiAttIn{(bf16_t*)(ws + O_QDA), (bf16_t*)(ws + O_QDB), (bf16_t*)(ws + O_KD), (bf16_t*)(ws + O_VD), (bf16_t*)(ws + O_CQN), (bf16_t*)(ws + O_CKVN), (bf16_t*)(ws + O_KMLA),
                               o_k, o_v, o_ckv, o_kr, (const float*)(ws + O_C16), (const float*)(ws + O_S16), (const float*)(ws + O_C8), (const float*)(ws + O_S8), p.q_norm_g, p.kv_norm_g, smem + 2 * G_STAGE}, smem));
  } PH_END
  PH_BEGIN(4) {
        const int n1 = 64 * 3, n2 = 67 * 4;
        gemm_phase((const bf16_t*)(ws + O_CQN), 256, (const bf16_t*)(ws + O_WUQ), 256, 256, 64, 3,
                   EpiUq{(bf16_t*)(ws + O_QMA), (bf16_t*)(ws + O_QMB), (const float*)(ws + O_C8), (const float*)(ws + O_S8)}, smem, 0, n1 + n2);
        gemm_phase((const bf16_t*)(ws + O_CKVN), 128, (const bf16_t*)(ws + O_WUKV), 128, 128, 67, 4,
                   EpiUkv{(bf16_t*)(ws + O_KMLA), (bf16_t*)(ws + O_VMLA), smem}, smem, n1, n1 + n2);
  } PH_END
  PH_BEGIN(5) { phase_attn(p, smem, 0); if ((PROBE_DUP >> 5) & 1) { GSYNC(); phase_attn(p, smem, 1); } } PH_END
  PH_BEGIN(6) { gemm_phase(Hb, 1024, (const bf16_t*)(ws + O_WATTOUT), 1024, 1024, 64, 4, EpiResLN{p.x_prompt, p.x_sample, mods + 2048, X, p.ln_mix_g, p.ln_mix_b, mods, 3072, 4096, Hb, xbuf, lncnt, smem + 2 * G_STAGE, fused}, smem); } PH_END
  PH_BEGIN_IF(7, !fused) { rows_phase(X, X + (size_t)NCTX * 1024, true, p.ln_mix_g, p.ln_mix_b, X, mods, 3072, 4096, Hb); } PH_END
  PH_BEGIN(8) { DUP(8, gemm_phase(Hb, 1024, (const bf16_t*)(ws + O_WMLPIN), 1024, 1024, 64, 16, EpiRelu2{(bf16_t*)(ws + O_U), smem + G_STAGE}, smem)); } PH_END
  PH_BEGIN(9) { gemm_phase((const bf16_t*)(ws + O_U), 4096, (const bf16_t*)(ws + O_WMLPOUT), 4096, 4096, 64, 4, EpiResLN{X, X + (size_t)NCTX * 1024, mods + 5120, X, p.ln_mlp_g, p.ln_mlp_b, mods + 3 * 6144, 0, 1024, Hb, xbuf + 98304, lncnt + 64, smem + 2 * G_STAGE, fused}, smem); } PH_END
  PH_BEGIN_IF(10, !fused) { rows_phase(X, X + (size_t)NCTX * 1024, true, p.ln_mlp_g, p.ln_mlp_b, X, mods + 3 * 6144, 0, 1024, Hb); } PH_END
  PH_BEGIN(11) { DUP(11, gemm_phase(Hb, 1024, (const bf16_t*)(ws + O_WCONVIN), 1024, 1024, 64, 6, EpiConv{(bf16_t*)(ws + O_UG), (bf16_t*)(ws + O_PZ), smem}, smem)); } PH_END
  PH_BEGIN(12) { DUP(12, phase_conv(p, smem)); } PH_END
  PH_BEGIN(13) { gemm_phase(Hb, 1024, (const bf16_t*)(ws + O_WCONVOUT), 1024, 1024, 64, 4, EpiResLN{X, X + (size_t)NCTX * 1024, mods + 3 * 6144 + 2048, X, p.ln_mix_g + 1024, p.ln_mix_b + 1024, mods + 3 * 6144, 3072, 4096, Hb, xbuf + 2 * 98304, lncnt + 128, smem + 2 * G_STAGE, fused}, smem); } PH_END
  PH_BEGIN_IF(14, !fused) { rows_phase(X, X + (size_t)NCTX * 1024, true, p.ln_mix_g + 1024, p.ln_mix_b + 1024, X, mods + 3 * 6144, 3072, 4096, Hb); } PH_END
  PH_BEGIN(15) { DUP(15, gemm_phase(Hb, 1024, (const bf16_t*)(ws + O_WMLPIN) + (size_t)4096 * 1024, 1024, 1024, 64, 16, EpiRelu2{(bf16_t*)(ws + O_U), smem + G_STAGE}, smem)); } PH_END
  PH_BEGIN(16) { gemm_phase((const bf16_t*)(ws + O_U), 4096, (const bf16_t*)(ws + O_WMLPOUT) + (size_t)4096 * 1024, 4096, 4096, 64, 4, EpiResLN{X, X + (size_t)NCTX * 1024, mods + 3 * 6144 + 5120, X, p.ln_mlp_g + 1024, p.ln_mlp_b + 1024, mods, 0, 0, nullptr, xbuf + 3 * 98304, lncnt + 192, smem + 2 * G_STAGE, fused}, smem); } PH_END
  PH_BEGIN_IF(17, !fused) { rows_phase(X, X + (size_t)NCTX * 1024, true, p.ln_mlp_g + 1024, p.ln_mlp_b + 1024, X, nullptr, 0, 0, nullptr); } PH_END
}

extern "C" void kernel_launch(void* const* d_in, const int* in_sizes, int n_in, void* d_out, int out_size, void* d_ws, size_t ws_size, hipStream_t stream) {
  static int grid_blocks = 0;
  if (!grid_blocks) {
    int dev = 0, cus = 0, per_cu = 0;
    hipGetDevice(&dev);
    hipDeviceGetAttribute(&cus, hipDeviceAttributeMultiprocessorCount, dev);
    hipOccupancyMaxActiveBlocksPerMultiprocessor(&per_cu, fwd_kernel, NT, 0);
    if (per_cu > 1) per_cu = 1;
    if (per_cu < 1) per_cu = 1;
    grid_blocks = cus * per_cu;
    if (grid_blocks > 256) grid_blocks = 256;
  }
  if (ws_size < WS_NEED) { fprintf(stderr, "workspace too small: %zu < %zu\n", ws_size, (size_t)WS_NEED); return; }
  Params p{};
  const float** f = (const float**)&p;
  for (int i = 0; i < 35; ++i) f[i] = (const float*)d_in[i];
  p.out = (float*)d_out;
  p.ws = (char*)d_ws;
  hipMemsetAsync(d_ws, 0, 16384, stream);
  int lo = 0, hi = NPHASE;
  void* args[] = {&p, &lo, &hi};
  hipError_t e = hipLaunchCooperativeKernel((void*)fwd_kernel, dim3(grid_blocks), dim3(NT), args, 0, stream);
  if (e != hipSuccess) fprintf(stderr, "cooperative launch failed: %s (grid %d)\n", hipGetErrorString(e), grid_blocks);
}
```
